# Optimizing an MI355X kernel written in HIP

```python
import math
import jax, jax.numpy as jnp
from jax import lax
import numpy as np

D_MODEL = 1024
BATCH = 8
SEQ = 4096
DEPTH = 2
DEC_BATCH = 8
DEC_SEQ = 64
PAST_LEN = 2048

CHUNK = 64
N_HEADS = 8
N_KV_HEADS = 2
HEAD_DIM = 64
GROUP = N_HEADS // N_KV_HEADS
ATT_WIDTH = N_HEADS * HEAD_DIM
KV_WIDTH = N_KV_HEADS * HEAD_DIM
WINDOW = 128
WINDOW_CHUNKS = WINDOW // CHUNK
BAND = (WINDOW_CHUNKS + 1) * CHUNK
CONV_WIDTH = 512
CONV_K = 3
NUM_BUCKETS = 32
MAX_DISTANCE = 128
N_EXPERTS = 32
TOP_K = 4
D_FF = 1024
SWIGLU_LIMIT = 7.0
SWIGLU_ALPHA = 1.702
MOE_BLOCK = 256
LN_EPS = 1e-5
NEG_INF = -1e30
DEEPNORM_ALPHA = (2 * DEPTH) ** 0.25
DEEPNORM_BETA = (8 * DEPTH) ** -0.25
IN_SIZES = (ATT_WIDTH, KV_WIDTH, KV_WIDTH, CONV_WIDTH, CONV_WIDTH, CONV_WIDTH, D_MODEL, D_MODEL)
IN_WIDTH = sum(IN_SIZES)
IN_SPLITS = tuple(int(s) for s in np.cumsum(IN_SIZES)[:-1])

kernel_name = "chunk_causal_swa_shortconv_moe_step"


def _layernorm(x, g, b):
    xf = x.astype(jnp.float32)
    mu = jnp.mean(xf, axis=-1, keepdims=True)
    var = jnp.mean(jnp.square(xf - mu), axis=-1, keepdims=True)
    return ((xf - mu) * lax.rsqrt(var + LN_EPS)).astype(x.dtype) * g + b


def _rel_bucket(rel):
    half = NUM_BUCKETS // 2
    max_exact = half // 2
    n = jnp.abs(rel)
    n_f = jnp.maximum(n, 1).astype(jnp.float32)
    large = max_exact + (jnp.log(n_f / max_exact) / math.log(MAX_DISTANCE / max_exact)
                         * (half - max_exact)).astype(jnp.int32)
    large = jnp.minimum(large, half - 1)
    return jnp.where(rel > 0, half, 0) + jnp.where(n < max_exact, n, large)


def _attn_bias(rel, rel_table):
    q_len, k_len = rel.shape
    b = rel_table[_rel_bucket(rel)]
    return jnp.transpose(b, (2, 0, 1)).reshape(N_KV_HEADS, GROUP, q_len, k_len)


def _sink_softmax(s, sink):
    sink_b = jnp.broadcast_to(sink.astype(jnp.float32)[:, :, None, None], s.shape[:-1] + (1,))
    p = jax.nn.softmax(jnp.concatenate([s, sink_b], axis=-1), axis=-1)
    return p[..., :-1]


def _attn_prompt(q, k, v, sink, rel_table):
    b, t, _ = q.shape
    nc = t // CHUNK
    q = q.reshape(b, nc, CHUNK, N_KV_HEADS, GROUP, HEAD_DIM)
    k = k.reshape(b, nc, CHUNK, N_KV_HEADS, HEAD_DIM)
    v = v.reshape(b, nc, CHUNK, N_KV_HEADS, HEAD_DIM)
    pad = ((0, 0), (WINDOW_CHUNKS, 0), (0, 0), (0, 0), (0, 0))
    kp, vp = jnp.pad(k, pad), jnp.pad(v, pad)
    kb = jnp.concatenate([kp[:, w:w + nc] for w in range(WINDOW_CHUNKS + 1)], axis=2)
    vb = jnp.concatenate([vp[:, w:w + nc] for w in range(WINDOW_CHUNKS + 1)], axis=2)
    rel = jnp.arange(BAND)[None, :] - WINDOW - jnp.arange(CHUNK)[:, None]
    bias = _attn_bias(rel, rel_table)
    valid = (jnp.arange(nc)[:, None] * CHUNK + jnp.arange(BAND)[None, :] - WINDOW) >= 0
    s = jnp.einsum('bnqkgd,bnskd->bnkgqs', q, kb, preferred_element_type=jnp.float32) * (HEAD_DIM ** -0.5)
    s = jnp.where(valid[None, :, None, None, None, :], s + bias[None, None], NEG_INF)
    p = _sink_softmax(s, sink.reshape(N_KV_HEADS, GROUP))
    o = jnp.einsum('bnkgqs,bnskd->bnqkgd', p.astype(vb.dtype), vb)
    return o.reshape(b, t, ATT_WIDTH)


def _attn_sample(q, k_new, v_new, k_cache, v_cache, sink, rel_table):
    b, s_len, _ = q.shape
    w = k_cache.shape[1]
    k_all = jnp.concatenate([k_cache, k_new.reshape(b, s_len, N_KV_HEADS, HEAD_DIM)], axis=1)
    v_all = jnp.concatenate([v_cache, v_new.reshape(b, s_len, N_KV_HEADS, HEAD_DIM)], axis=1)
    rel = jnp.arange(w + s_len)[None, :] - w - jnp.arange(s_len)[:, None]
    bias = _attn_bias(rel, rel_table)
    qh = q.reshape(b, s_len, N_KV_HEADS, GROUP, HEAD_DIM)
    s = jnp.einsum('bqkgd,bskd->bkgqs', qh, k_all, preferred_element_type=jnp.float32) * (HEAD_DIM ** -0.5) + bias[None]
    p = _sink_softmax(s, sink.reshape(N_KV_HEADS, GROUP))
    o = jnp.einsum('bkgqs,bskd->bqkgd', p.astype(v_all.dtype), v_all)
    return o.reshape(b, s_len, ATT_WIDTH), k_all[:, -w:], v_all[:, -w:]


def _short_conv(u, hist, conv_w):
    full = jnp.concatenate([hist, u], axis=1)
    y = lax.conv_general_dilated(full, conv_w.astype(u.dtype)[:, None, :], window_strides=(1,),
                                 padding='VALID', dimension_numbers=('NWC', 'WIO', 'NWC'),
                                 feature_group_count=CONV_WIDTH)
    return y, full[:, -(CONV_K - 1):]


def _moe(h, w_router, b_router, w_gu, b_gu, w_down, b_down):
    n, d = h.shape
    logits = (h @ w_router + b_router).astype(jnp.float32)
    top_val, top_idx = lax.top_k(logits, TOP_K)
    gates = jax.nn.softmax(top_val, axis=-1)
    nk = n * TOP_K
    flat_e = top_idx.reshape(nk)
    order = jnp.argsort(flat_e)
    e_sorted = flat_e[order]
    tok = order // TOP_K
    counts = jnp.bincount(flat_e, length=N_EXPERTS)
    padded = (counts + MOE_BLOCK - 1) // MOE_BLOCK * MOE_BLOCK
    pad_end = jnp.cumsum(padded)
    pad_start = pad_end - padded
    start = jnp.cumsum(counts) - counts
    dest = pad_start[e_sorted] + jnp.arange(nk) - start[e_sorted]
    n_blocks = -(-nk // MOE_BLOCK) + N_EXPERTS
    xs = jnp.zeros((n_blocks * MOE_BLOCK, d), h.dtype).at[dest].set(h[tok])
    block_e = jnp.minimum(jnp.searchsorted(pad_end, jnp.arange(n_blocks) * MOE_BLOCK, side='right'),
                          N_EXPERTS - 1)

    def expert_block(args):
        xb, e = args
        gu = xb @ w_gu[e] + b_gu[e]
        g, lin = jnp.split(gu, 2, axis=-1)
        g = jnp.minimum(g, SWIGLU_LIMIT)
        lin = jnp.clip(lin, -SWIGLU_LIMIT, SWIGLU_LIMIT)
        a = g * jax.nn.sigmoid(SWIGLU_ALPHA * g) * (lin + 1)
        return a @ w_down[e] + b_down[e]

    ys = lax.map(expert_block, (xs.reshape(n_blocks, MOE_BLOCK, d), block_e)).reshape(-1, d)
    contrib = ys[dest] * gates.reshape(nk)[order][:, None].astype(ys.dtype)
    return jax.ops.segment_sum(contrib, tok, num_segments=n)


def _layer(x, c, hist_k, hist_v, hist_u, rel_table, w_ada, b_ada, w_in, b_in, sink, conv_w,
           w_oa, w_ob, w_o, ln1_g, ln1_b, w_router, b_router, w_gu, b_gu, w_down, b_down, ln2_g, ln2_b):
    b, t, d = x.shape
    mod = (jax.nn.silu(c) @ w_ada + b_ada)[:, None, :]
    sh1, sc1, g1, sh2, sc2, g2 = jnp.split(mod, 6, axis=-1)
    h = x * (1 + sc1) + sh1
    z = h @ w_in + b_in
    q, k, v, cb, cc, cx, ga, gb = jnp.split(z, IN_SPLITS, axis=-1)
    if hist_k is None:
        ya = _attn_prompt(q, k, v, sink, rel_table)
        new_k = k.reshape(b, t, N_KV_HEADS, HEAD_DIM)[:, -WINDOW:]
        new_v = v.reshape(b, t, N_KV_HEADS, HEAD_DIM)[:, -WINDOW:]
        hist_u = jnp.zeros((b, CONV_K - 1, CONV_WIDTH), cx.dtype)
    else:
        ya, new_k, new_v = _attn_sample(q, k, v, hist_k, hist_v, sink, rel_table)
    yc, new_u = _short_conv(cc * cx, hist_u, conv_w)
    yb = cb * yc
    mix = (jax.nn.sigmoid(ga) * (ya @ w_oa) + jax.nn.sigmoid(gb) * (yb @ w_ob)) @ w_o
    x = _layernorm(DEEPNORM_ALPHA * x + (1 + g1) * mix, ln1_g, ln1_b)
    h = x * (1 + sc2) + sh2
    ff = _moe(h.reshape(b * t, d), w_router, b_router, w_gu, b_gu, w_down, b_down).reshape(b, t, d)
    x = _layernorm(DEEPNORM_ALPHA * x + (1 + g2) * ff, ln2_g, ln2_b)
    return x, new_k, new_v, new_u


def setup_inputs(seed: int = 0) -> dict:
    key = jax.random.key(seed)
    ks = jax.random.split(key, 32)

    def nrm(k, shape, s):
        return jax.random.normal(k, shape, jnp.float32) * s

    w_cache = min(WINDOW, PAST_LEN)
    col_scale = jnp.concatenate([jnp.full((n,), DEEPNORM_BETA if i == 2 else 1.0, jnp.float32)
                                 for i, n in enumerate(IN_SIZES)])
    return {
        "x_prompt": nrm(ks[0], (BATCH, SEQ, D_MODEL), 1.0),
        "x_sample": nrm(ks[1], (DEC_BATCH, DEC_SEQ, D_MODEL), 1.0),
        "c_prompt": nrm(ks[2], (BATCH, D_MODEL), 1.0),
        "c_sample": nrm(ks[3], (DEC_BATCH, D_MODEL), 1.0),
        "cache_k": nrm(ks[4], (DEPTH, DEC_BATCH, w_cache, N_KV_HEADS, HEAD_DIM), 1.0),
        "cache_v": nrm(ks[5], (DEPTH, DEC_BATCH, w_cache, N_KV_HEADS, HEAD_DIM), 1.0),
        "state_conv": nrm(ks[6], (DEPTH, DEC_BATCH, CONV_K - 1, CONV_WIDTH), 1.0),
        "rel_table": nrm(ks[7], (NUM_BUCKETS, N_HEADS), 0.5),
        "ln0_g": 1.0 + nrm(ks[8], (D_MODEL,), 0.01),
        "ln0_b": nrm(ks[9], (D_MODEL,), 0.01),
        "w_ada": nrm(ks[10], (DEPTH, D_MODEL, 6 * D_MODEL), 0.1 * D_MODEL ** -0.5),
        "b_ada": nrm(ks[11], (DEPTH, 6 * D_MODEL), 0.01),
        "w_in": nrm(ks[12], (DEPTH, D_MODEL, IN_WIDTH), D_MODEL ** -0.5) * col_scale,
        "b_in": nrm(ks[13], (DEPTH, IN_WIDTH), 0.01),
        "sinks": nrm(ks[14], (DEPTH, N_HEADS), 1.0),
        "conv_w": nrm(ks[15], (DEPTH, CONV_K, CONV_WIDTH), CONV_K ** -0.5),
        "w_oa": nrm(ks[16], (DEPTH, ATT_WIDTH, D_MODEL), DEEPNORM_BETA * ATT_WIDTH ** -0.5),
        "w_ob": nrm(ks[17], (DEPTH, CONV_WIDTH, D_MODEL), DEEPNORM_BETA * CONV_WIDTH ** -0.5),
        "w_o": nrm(ks[18], (DEPTH, D_MODEL, D_MODEL), DEEPNORM_BETA * D_MODEL ** -0.5),
        "ln1_g": 1.0 + nrm(ks[19], (DEPTH, D_MODEL), 0.01),
        "ln1_b": nrm(ks[20], (DEPTH, D_MODEL), 0.01),
        "w_router": nrm(ks[21], (DEPTH, D_MODEL, N_EXPERTS), D_MODEL ** -0.5),
        "b_router": nrm(ks[22], (DEPTH, N_EXPERTS), 0.01),
        "w_gu": nrm(ks[23], (DEPTH, N_EXPERTS, D_MODEL, 2 * D_FF), DEEPNORM_BETA * D_MODEL ** -0.5),
        "b_gu": nrm(ks[24], (DEPTH, N_EXPERTS, 2 * D_FF), 0.01),
        "w_down": nrm(ks[25], (DEPTH, N_EXPERTS, D_FF, D_MODEL), DEEPNORM_BETA * D_FF ** -0.5),
        "b_down": nrm(ks[26], (DEPTH, N_EXPERTS, D_MODEL), 0.01),
        "ln2_g": 1.0 + nrm(ks[27], (DEPTH, D_MODEL), 0.01),
        "ln2_b": nrm(ks[28], (DEPTH, D_MODEL), 0.01),
    }


def reference(x_prompt, x_sample, c_prompt, c_sample, cache_k, cache_v, state_conv, rel_table,
              ln0_g, ln0_b, w_ada, b_ada, w_in, b_in, sinks, conv_w, w_oa, w_ob, w_o, ln1_g, ln1_b,
              w_router, b_router, w_gu, b_gu, w_down, b_down, ln2_g, ln2_b):
    y_prompt = _layernorm(x_prompt, ln0_g, ln0_b)
    y_sample = _layernorm(x_sample, ln0_g, ln0_b)
    kp, vp, up, ksm, vsm, usm = [], [], [], [], [], []
    for l in range(DEPTH):
        lw = (w_ada[l], b_ada[l], w_in[l], b_in[l], sinks[l], conv_w[l], w_oa[l], w_ob[l], w_o[l],
              ln1_g[l], ln1_b[l], w_router[l], b_router[l], w_gu[l], b_gu[l], w_down[l], b_down[l],
              ln2_g[l], ln2_b[l])
        y_prompt, k1, v1, u1 = _layer(y_prompt, c_prompt, None, None, None, rel_table, *lw)
        y_sample, k2, v2, u2 = _layer(y_sample, c_sample, cache_k[l], cache_v[l], state_conv[l], rel_table, *lw)
        kp.append(k1); vp.append(v1); up.append(u1)
        ksm.append(k2); vsm.append(v2); usm.append(u2)
    return (y_prompt, y_sample, jnp.stack(kp), jnp.stack(vp), jnp.stack(up),
            jnp.stack(ksm), jnp.stack(vsm), jnp.stack(usm))
```

```cpp
#include <hip/hip_runtime.h>
#include <hip/hip_cooperative_groups.h>
#include <cstdio>
#include <cstdint>
namespace cg = cooperative_groups;

#define LAS __attribute__((address_space(3)))
typedef unsigned short bf16_t;
typedef short bf16x8 __attribute__((ext_vector_type(8)));
typedef float f32x4 __attribute__((ext_vector_type(4)));
typedef float f32x16 __attribute__((ext_vector_type(16)));
typedef unsigned u32x4 __attribute__((ext_vector_type(4)));
typedef unsigned u32x2 __attribute__((ext_vector_type(2)));

constexpr int D = 1024, NPROMPT = 32768, NT = 33280, INW = 4352, NEXP = 32;
constexpr float ALPHA = 1.41421356237f, LN_EPS = 1e-5f;
constexpr int NWAVES = 8, NTHREADS = 512;
constexpr int LDS_BYTES = 147456;
constexpr int LDS_BLK = 131072;
constexpr int LDS_IDX = 131072 + 256;
constexpr int MAXU = 24;
constexpr size_t OKP = 34078720, OVP = 34340864, OCP = 34603008, OKS = 34619392, OVS = 34881536, OCS = 35143680;
constexpr size_t MiB = 1u << 20;
constexpr size_t WS_CNT = 0;
constexpr size_t WS_MOD = 65536;
constexpr size_t WS_ZERO_BYTES = 1 * MiB;
constexpr size_t WS_BIAS = 1 * MiB;
constexpr size_t WS_SLOT = 2 * MiB;
constexpr size_t WS_TOK = 3 * MiB;
constexpr size_t WS_GATE = 8 * MiB;
constexpr size_t WS_WIN = 16 * MiB;
constexpr size_t WS_WOA = 34 * MiB;
constexpr size_t WS_WOB = 36 * MiB;
constexpr size_t WS_WO = 38 * MiB;
constexpr size_t WS_WGU = 48 * MiB;
constexpr size_t WS_WDN = 304 * MiB;
constexpr size_t WS_H = 432 * MiB;
constexpr size_t WS_Z = 498 * MiB;
constexpr size_t WS_YA = 776 * MiB;
constexpr size_t WS_YB = 810 * MiB;
constexpr size_t WS_T1 = 844 * MiB;
constexpr size_t WS_MIX = 976 * MiB;
constexpr size_t WS_ACT = 1042 * MiB;
constexpr size_t WS_YS = 1320 * MiB;
constexpr size_t WS_END = 1598 * MiB;

struct Params { const float* in[29]; float* out; unsigned char* ws; };

__device__ __forceinline__ unsigned cvt_pk_bf16(float lo, float hi) { unsigned r; asm volatile("v_cvt_pk_bf16_f32 %0, %1, %2" : "=v"(r) : "v"(lo), "v"(hi)); return r; }
__device__ __forceinline__ float bf_lo(unsigned w) { return __uint_as_float(w << 16); }
__device__ __forceinline__ float bf_hi(unsigned w) { return __uint_as_float(w & 0xffff0000u); }
__device__ __forceinline__ float sigmoidf_(float x) { return __builtin_amdgcn_rcpf(1.0f + __expf(-x)); }
__device__ __forceinline__ float wave_sum(float v) {
#pragma unroll
    for (int o = 1; o < 64; o <<= 1) v += __shfl_xor(v, o);
    return v;
}
__device__ __forceinline__ int batch_of(int row) { return row < NPROMPT ? (row >> 12) : 8 + ((row - NPROMPT) >> 6); }

namespace pg8 {
constexpr int BM = 256, BK = 64, HALF = 128, HTB = HALF * BK * 2, NXCD = 8, WGM = 8;
__device__ __forceinline__ int lds_byte(int r, int c) { const int st = (r >> 4) * 2 + (c >> 5), rr = r & 15, cc = c & 31, ob = rr * 64 + cc * 2; return st * 1024 + (ob ^ (((ob >> 9) & 1) << 5)); }
__device__ __forceinline__ void stage_rc(int b, int& R, int& C) { const int st = b / 1024, sb = b % 1024, swz = sb ^ (((sb >> 9) & 1) << 5); R = (st >> 1) * 16 + swz / 64; C = (st & 1) * 32 + (swz % 64) / 2; }
__device__ __forceinline__ int perm32(int rho) { const int n = rho >> 4, i = rho & 15; return 8 * (i >> 2) + 4 * n + (i & 3); }

struct Unit { int pm, pn, e; const char* b; };

struct SchedDense {
    int nM, nN, nwg, G, c; const char* Bt; size_t tstepB;
    __device__ __forceinline__ void init(int M, int N, int K, int G_, int c_, const void* Bt_) { nM = M / BM; nN = N / BM; nwg = nM * nN; G = G_; c = c_; Bt = (const char*)Bt_; tstepB = (size_t)BM * K * 2; }
    __device__ __forceinline__ bool next(int i, Unit& u) const {
        const long L = (long)i * G + c; if (L >= nwg) return false;
        int wgid = (int)L; { const int q = nwg / NXCD, r = nwg % NXCD, xcd = wgid % NXCD, off = wgid / NXCD; wgid = (xcd < r ? xcd * (q + 1) : r * (q + 1) + (xcd - r) * q) + off; }
        const int nig = WGM * nN, gid = wgid / nig, fm = gid * WGM, gsz = (nM - fm) < WGM ? (nM - fm) : WGM;
        u.pm = fm + ((wgid % nig) % gsz); u.pn = (wgid % nig) / gsz; u.e = 0; u.b = Bt + (size_t)u.pn * tstepB; return true;
    }
    __device__ __forceinline__ unsigned rowidx(int, const Unit& u, int r) const { return (unsigned)(u.pm * BM + r); }
};
template <bool GATHER> struct SchedMoE {
    const LAS int* blk; const LAS unsigned short* idx; int NB, RBX, NPN, NXs, perx, cx, cj; const char* Bt; size_t estep, tstepB;
    __device__ __forceinline__ void init(const LAS int* blk_, const LAS unsigned short* idx_, int NPN_, int K, int G, int c, const void* Bt_, size_t estep_) {
        blk = blk_; idx = idx_; NB = blk_[32]; NPN = NPN_; Bt = (const char*)Bt_; estep = estep_; tstepB = (size_t)BM * K * 2;
        if ((G & 7) == 0) { NXs = 8; perx = G >> 3; cx = c & 7; cj = c >> 3; } else { NXs = 1; perx = G; cx = 0; cj = c; }
        RBX = (NB + NXs - 1) / NXs;
    }
    __device__ __forceinline__ bool next(int i, Unit& u) const {
        const int j = i * perx + cj, rbl = j / NPN; if (rbl >= RBX) return false;
        const int rb = cx * RBX + rbl; if (rb >= NB) return false;
        int e = 0;
        for (int q = 1; q < 32; ++q) e = (blk[q] <= rb) ? q : e;
        u.pm = rb; u.pn = j - rbl * NPN; u.e = e; u.b = Bt + (size_t)e * estep + (size_t)u.pn * tstepB; return true;
    }
    __device__ __forceinline__ unsigned rowidx(int ui, const Unit& u, int r) const { if (GATHER) return (unsigned)idx[ui * 256 + r]; return (unsigned)(u.pm * BM + r); }
};

template <class Epi, class Sched>
__device__ __forceinline__ void gemm_phase(LAS unsigned char* lds, const char* Abase, const int K, const Sched& S, const Epi& E) {
    int tid_ = threadIdx.x; asm volatile("" : "+v"(tid_));
    const int tid = tid_, wid = __builtin_amdgcn_readfirstlane(tid >> 6), lane = tid & 63, wr = wid >> 2, wc = wid & 3, fr = lane & 15, fq = lane >> 4;
    const int nt = K / BK;
    unsigned voffB[2]; int RA[2], CA[2];
#pragma unroll
    for (int i = 0; i < 2; ++i) { int R, C; stage_rc(tid * 16 + i * 8192, R, C); const int Rb = Epi::PERM ? ((R & ~31) + perm32(R & 31)) : R;
        voffB[i] = (unsigned)(Rb * K + C) * 2u; RA[i] = R; CA[i] = C * 2; }
    const size_t kstep = (size_t)(BK * 2);
    const size_t hstep = (size_t)HALF * K * 2;
    const unsigned ldsw = (unsigned)wid * 1024u;
    const unsigned rowb = (unsigned)K * 2u;
    const int aoff = lds_byte(wr * 64 + fr, fq * 8), boff = lds_byte(wc * 32 + fr, fq * 8);
#define PG8_SA(b, h) (((b) * 2 + (h)) * HTB)
#define PG8_SB(b, h) ((4 + (b) * 2 + (h)) * HTB)
#define PG8_STAGE(bufoff, gbase, voff) do { _Pragma("unroll") for (int _i = 0; _i < 2; ++_i) \
        __builtin_amdgcn_global_load_lds((const unsigned*)((const char*)(gbase) + (voff)[_i]), (LAS unsigned*)(lds + (bufoff) + ldsw + _i * 8192), 16, 0, 0); } while (0)
#define PG8_LDA(dst, b, h) do { _Pragma("unroll") for (int m = 0; m < 4; ++m) _Pragma("unroll") for (int k = 0; k < 2; ++k) dst[m][k] = *(const LAS bf16x8*)(lds + PG8_SA(b, h) + aoff + m * 2048 + k * 1024); } while (0)
#define PG8_LDB(dst, b, h) do { _Pragma("unroll") for (int n = 0; n < 2; ++n) _Pragma("unroll") for (int k = 0; k < 2; ++k) dst[n][k] = *(const LAS bf16x8*)(lds + PG8_SB(b, h) + boff + n * 2048 + k * 1024); } while (0)
#define PG8_MMA(ai, bj, At, Bt) do { __builtin_amdgcn_s_setprio(1); _Pragma("unroll") for (int m = 0; m < 4; ++m) _Pragma("unroll") for (int n = 0; n < 2; ++n) _Pragma("unroll") for (int k = 0; k < 2; ++k) \
        acc[ai][bj][m][n] = __builtin_amdgcn_mfma_f32_16x16x32_bf16(Bt[n][k], At[m][k], acc[ai][bj][m][n], 0, 0, 0); __builtin_amdgcn_s_setprio(0); } while (0)
#define PG8_WAIT_V(n) asm volatile("s_waitcnt vmcnt(" #n ")" ::: "memory")
#define PG8_WAIT_L(n) asm volatile("s_waitcnt lgkmcnt(" #n ")" ::: "memory")
#define PG8_BAR __builtin_amdgcn_s_barrier()
#define PG8_SCHED __builtin_amdgcn_sched_barrier(0)
#define PG8_LOADVA(ui_, u_) do { _Pragma("unroll") for (int _h = 0; _h < 2; ++_h) _Pragma("unroll") for (int _i = 0; _i < 2; ++_i) \
        vA[_h][_i] = S.rowidx((ui_), (u_), _h * HALF + RA[_i]) * rowb + (unsigned)CA[_i]; } while (0)
    Unit cur, nxt; int ui = 0;
    if (!S.next(0, cur)) return;
    f32x4 acc[2][2][4][2];
#pragma unroll
    for (int a = 0; a < 2; ++a)
#pragma unroll
        for (int b = 0; b < 2; ++b)
#pragma unroll
            for (int m = 0; m < 4; ++m)
#pragma unroll
                for (int n = 0; n < 2; ++n) acc[a][b][m][n] = (f32x4){0.f, 0.f, 0.f, 0.f};
    bf16x8 At[4][2], B0[2][2], B1[2][2];
    unsigned vA[2][2];
    PG8_LOADVA(0, cur);
    const char* cB = cur.b;
    PG8_STAGE(PG8_SB(0, 0), cB, voffB); PG8_STAGE(PG8_SB(0, 1), cB + hstep, voffB); PG8_STAGE(PG8_SA(0, 0), Abase, vA[0]); PG8_STAGE(PG8_SA(0, 1), Abase, vA[1]);
    if (wr == 1) PG8_BAR;
    PG8_WAIT_V(2); PG8_BAR;
    PG8_STAGE(PG8_SB(1, 0), cB + kstep, voffB); PG8_STAGE(PG8_SA(1, 0), Abase + kstep, vA[0]); PG8_STAGE(PG8_SB(1, 1), cB + hstep + kstep, voffB);
    PG8_WAIT_V(6); PG8_BAR;
    for (;;) {
        const bool has_next = S.next(ui + 1, nxt);
        const char* nB = has_next ? nxt.b : cB;
        for (int t = 0; t < nt; t += 2) {
            const bool last = (t == nt - 2);
            const char* a1 = Abase + (size_t)(t + 1) * kstep;
            const char* a2 = last ? Abase : Abase + (size_t)(t + 2) * kstep;
            const char* b2 = last ? nB : cB + (size_t)(t + 2) * kstep;
            const char* a3 = a2 + kstep; const char* b3 = b2 + kstep;
            PG8_LDB(B0, 0, 0); PG8_LDB(B1, 0, 1); PG8_SCHED; PG8_LDA(At, 0, 0); PG8_STAGE(PG8_SA(1, 1), a1, vA[1]);
            if (last && has_next) { PG8_LOADVA(ui + 1, nxt); }
            PG8_WAIT_V(8); PG8_WAIT_L(0); PG8_BAR; PG8_MMA(0, 0, At, B0); PG8_MMA(0, 1, At, B1); PG8_BAR; PG8_SCHED;
            PG8_LDA(At, 0, 1); PG8_STAGE(PG8_SB(0, 0), b2, voffB); PG8_STAGE(PG8_SB(0, 1), b2 + hstep, voffB); PG8_STAGE(PG8_SA(0, 0), a2, vA[0]);
            PG8_WAIT_V(8); PG8_WAIT_L(0); PG8_BAR; PG8_MMA(1, 0, At, B0); PG8_MMA(1, 1, At, B1); PG8_BAR; PG8_SCHED;
            PG8_LDB(B0, 1, 0); PG8_LDB(B1, 1, 1); PG8_SCHED; PG8_LDA(At, 1, 0); PG8_STAGE(PG8_SA(0, 1), a2, vA[1]);
            PG8_WAIT_V(8); PG8_WAIT_L(0); PG8_BAR; PG8_MMA(0, 0, At, B0); PG8_MMA(0, 1, At, B1); PG8_BAR; PG8_SCHED;
            PG8_LDA(At, 1, 1); PG8_STAGE(PG8_SB(1, 0), b3, voffB); PG8_STAGE(PG8_SB(1, 1), b3 + hstep, voffB); PG8_STAGE(PG8_SA(1, 0), a3, vA[0]);
            PG8_WAIT_V(8); PG8_WAIT_L(0); PG8_BAR; PG8_MMA(1, 0, At, B0); PG8_MMA(1, 1, At, B1); PG8_BAR; PG8_SCHED;
        }
        if (wr == 0) PG8_BAR;
        E(acc, cur, wr, wc, fr, fq);
        if (!has_next) break;
#pragma unroll
        for (int a = 0; a < 2; ++a)
#pragma unroll
            for (int b = 0; b < 2; ++b)
#pragma unroll
                for (int m = 0; m < 4; ++m)
#pragma unroll
                    for (int n = 0; n < 2; ++n) acc[a][b][m][n] = (f32x4){0.f, 0.f, 0.f, 0.f};
        cur = nxt; cB = nB; ++ui;
        if (wr == 1) PG8_BAR;
    }
    PG8_WAIT_V(0);
    PG8_BAR;
#undef PG8_SA
#undef PG8_SB
#undef PG8_STAGE
#undef PG8_LDA
#undef PG8_LDB
#undef PG8_MMA
#undef PG8_WAIT_V
#undef PG8_WAIT_L
#undef PG8_BAR
#undef PG8_SCHED
#undef PG8_LOADVA
}

typedef f32x4 Acc[2][2][4][2];

struct EpiZ {
    static constexpr bool PERM = true;
    bf16_t* Z; const float* bias; float* out; int l;
    __device__ __forceinline__ void operator()(const Acc& acc, const Unit& u, int wr, int wc, int fr, int fq) const {
        const int row0 = u.pm * 256 + wr * 64 + fr, col0 = u.pn * 256 + wc * 32 + 8 * fq;
        f32x4 bv[2][2];
#pragma unroll
        for (int bj = 0; bj < 2; ++bj)
#pragma unroll
            for (int n = 0; n < 2; ++n) bv[bj][n] = *(const f32x4*)(bias + col0 + bj * 128 + 4 * n);
#pragma unroll
        for (int ai = 0; ai < 2; ++ai)
#pragma unroll
            for (int m = 0; m < 4; ++m) {
                const int row = row0 + ai * 128 + m * 16;
                bf16_t* rowp = Z + (size_t)row * INW + col0;
                float* ko = nullptr; float* vo = nullptr;
                if (u.pn == 2) {
                    if (row < NPROMPT) { const int t = row & 4095; if (t >= 3968) { const size_t o = ((size_t)(l * 8 + (row >> 12)) * 128 + (t - 3968)) * 128 + wc * 32 + 8 * fq; ko = out + OKP + o; vo = out + OVP + o; } }
                    else { const int rr = row - NPROMPT; const size_t o = ((size_t)(l * 8 + (rr >> 6)) * 128 + 64 + (rr & 63)) * 128 + wc * 32 + 8 * fq; ko = out + OKS + o; vo = out + OVS + o; }
                }
#pragma unroll
                for (int bj = 0; bj < 2; ++bj) {
                    const f32x4 v0 = acc[ai][bj][m][0] + bv[bj][0], v1 = acc[ai][bj][m][1] + bv[bj][1];
                    u32x4 w; w.x = cvt_pk_bf16(v0[0], v0[1]); w.y = cvt_pk_bf16(v0[2], v0[3]); w.z = cvt_pk_bf16(v1[0], v1[1]); w.w = cvt_pk_bf16(v1[2], v1[3]);
                    *(u32x4*)(rowp + bj * 128) = w;
                    float* o = bj == 0 ? ko : vo;
                    if (o) { *(f32x4*)o = v0; *(f32x4*)(o + 4) = v1; }
                }
                asm volatile("" ::: "memory");
            }
    }
};
struct EpiT1 {
    static constexpr bool PERM = true;
    float* T1; const bf16_t* Z;
    __device__ __forceinline__ void operator()(const Acc& acc, const Unit& u, int wr, int wc, int fr, int fq) const {
        const int row0 = u.pm * 256 + wr * 64 + fr, col0 = u.pn * 256 + wc * 32 + 8 * fq;
#pragma unroll
        for (int ai = 0; ai < 2; ++ai)
#pragma unroll
            for (int m = 0; m < 4; ++m) {
                const int row = row0 + ai * 128 + m * 16;
#pragma unroll
                for (int bj = 0; bj < 2; ++bj) {
                    const u32x4 g = *(const u32x4*)(Z + (size_t)row * INW + 2304 + col0 + bj * 128);
                    f32x4 v0 = acc[ai][bj][m][0], v1 = acc[ai][bj][m][1];
                    v0[0] *= sigmoidf_(bf_lo(g.x)); v0[1] *= sigmoidf_(bf_hi(g.x)); v0[2] *= sigmoidf_(bf_lo(g.y)); v0[3] *= sigmoidf_(bf_hi(g.y));
                    v1[0] *= sigmoidf_(bf_lo(g.z)); v1[1] *= sigmoidf_(bf_hi(g.z)); v1[2] *= sigmoidf_(bf_lo(g.w)); v1[3] *= sigmoidf_(bf_hi(g.w));
                    float* o = T1 + (size_t)row * D + col0 + bj * 128;
                    *(f32x4*)o = v0; *(f32x4*)(o + 4) = v1;
                    asm volatile("" ::: "memory");
                }
            }
    }
};
struct EpiMix {
    static constexpr bool PERM = true;
    const float* T1; const bf16_t* Z; bf16_t* MIX;
    __device__ __forceinline__ void operator()(const Acc& acc, const Unit& u, int wr, int wc, int fr, int fq) const {
        const int row0 = u.pm * 256 + wr * 64 + fr, col0 = u.pn * 256 + wc * 32 + 8 * fq;
#pragma unroll
        for (int ai = 0; ai < 2; ++ai)
#pragma unroll
            for (int m = 0; m < 4; ++m) {
                const int row = row0 + ai * 128 + m * 16;
#pragma unroll
                for (int bj = 0; bj < 2; ++bj) {
                    const u32x4 g = *(const u32x4*)(Z + (size_t)row * INW + 3328 + col0 + bj * 128);
                    const float* tp = T1 + (size_t)row * D + col0 + bj * 128;
                    f32x4 v0 = *(const f32x4*)tp, v1 = *(const f32x4*)(tp + 4);
                    const f32x4 a0 = acc[ai][bj][m][0], a1 = acc[ai][bj][m][1];
                    v0[0] += a0[0] * sigmoidf_(bf_lo(g.x)); v0[1] += a0[1] * sigmoidf_(bf_hi(g.x)); v0[2] += a0[2] * sigmoidf_(bf_lo(g.y)); v0[3] += a0[3] * sigmoidf_(bf_hi(g.y));
                    v1[0] += a1[0] * sigmoidf_(bf_lo(g.z)); v1[1] += a1[1] * sigmoidf_(bf_hi(g.z)); v1[2] += a1[2] * sigmoidf_(bf_lo(g.w)); v1[3] += a1[3] * sigmoidf_(bf_hi(g.w));
                    u32x4 w; w.x = cvt_pk_bf16(v0[0], v0[1]); w.y = cvt_pk_bf16(v0[2], v0[3]); w.z = cvt_pk_bf16(v1[0], v1[1]); w.w = cvt_pk_bf16(v1[2], v1[3]);
                    *(u32x4*)(MIX + (size_t)row * D + col0 + bj * 128) = w;
                    asm volatile("" ::: "memory");
                }
            }
    }
};
struct EpiX {
    static constexpr bool PERM = false;
    float* X; const float* modl;
    __device__ __forceinline__ void operator()(const Acc& acc, const Unit& u, int wr, int wc, int fr, int fq) const {
        const int row0 = u.pm * 256 + wr * 64 + fr, col0 = u.pn * 256 + wc * 32 + 4 * fq;
#pragma unroll
        for (int ai = 0; ai < 2; ++ai)
#pragma unroll
            for (int m = 0; m < 4; ++m) {
                const int row = row0 + ai * 128 + m * 16;
                const float* gp = modl + (size_t)batch_of(row) * 6144 + 2048 + col0;
                float* xp = X + (size_t)row * D + col0;
#pragma unroll
                for (int bj = 0; bj < 2; ++bj)
#pragma unroll
                    for (int n = 0; n < 2; ++n) {
                        const f32x4 g = *(const f32x4*)(gp + bj * 128 + n * 16);
                        const f32x4 x = *(const f32x4*)(xp + bj * 128 + n * 16);
                        *(f32x4*)(xp + bj * 128 + n * 16) = x * ALPHA + (g + 1.0f) * acc[ai][bj][m][n];
                    }
                asm volatile("" ::: "memory");
            }
    }
};
struct EpiAct {
    static constexpr bool PERM = true;
    bf16_t* ACT; const float* bgu;
    __device__ __forceinline__ void operator()(const Acc& acc, const Unit& u, int wr, int wc, int fr, int fq) const {
        const int row0 = u.pm * 256 + wr * 64 + fr, c0 = u.pn * 128 + wc * 32 + 8 * fq;
        const float* bp = bgu + (size_t)u.e * 2048 + c0;
        f32x4 bg[2], bl[2];
#pragma unroll
        for (int n = 0; n < 2; ++n) { bg[n] = *(const f32x4*)(bp + 4 * n); bl[n] = *(const f32x4*)(bp + 1024 + 4 * n); }
#pragma unroll
        for (int ai = 0; ai < 2; ++ai)
#pragma unroll
            for (int m = 0; m < 4; ++m) {
                const int row = row0 + ai * 128 + m * 16;
                float a[8];
#pragma unroll
                for (int n = 0; n < 2; ++n)
#pragma unroll
                    for (int j = 0; j < 4; ++j) {
                        float g = acc[ai][0][m][n][j] + bg[n][j], li = acc[ai][1][m][n][j] + bl[n][j];
                        g = fminf(g, 7.0f); li = fminf(fmaxf(li, -7.0f), 7.0f);
                        a[n * 4 + j] = g * sigmoidf_(1.702f * g) * (li + 1.0f);
                    }
                u32x4 w; w.x = cvt_pk_bf16(a[0], a[1]); w.y = cvt_pk_bf16(a[2], a[3]); w.z = cvt_pk_bf16(a[4], a[5]); w.w = cvt_pk_bf16(a[6], a[7]);
                *(u32x4*)(ACT + (size_t)row * D + c0) = w;
                asm volatile("" ::: "memory");
            }
    }
};
struct EpiYs {
    static constexpr bool PERM = true;
    bf16_t* YS; const float* bdn; const float* gate; const unsigned* cnt; const LAS int* blk;
    __device__ __forceinline__ void operator()(const Acc& acc, const Unit& u, int wr, int wc, int fr, int fq) const {
        const int r0 = wr * 64 + fr, col0 = u.pn * 256 + wc * 32 + 8 * fq;
        const int rank0 = (u.pm - blk[u.e]) * 256; const int ce = (int)cnt[u.e];
        f32x4 bv[2][2];
#pragma unroll
        for (int bj = 0; bj < 2; ++bj)
#pragma unroll
            for (int n = 0; n < 2; ++n) bv[bj][n] = *(const f32x4*)(bdn + (size_t)u.e * D + col0 + bj * 128 + 4 * n);
#pragma unroll
        for (int ai = 0; ai < 2; ++ai)
#pragma unroll
            for (int m = 0; m < 4; ++m) {
                const int r = r0 + ai * 128 + m * 16, rank = rank0 + r;
                const float gt = rank < ce ? gate[(size_t)u.e * NT + rank] : 0.0f;
                bf16_t* rowp = YS + (size_t)(u.pm * 256 + r) * D + col0;
#pragma unroll
                for (int bj = 0; bj < 2; ++bj) {
                    const f32x4 v0 = (acc[ai][bj][m][0] + bv[bj][0]) * gt, v1 = (acc[ai][bj][m][1] + bv[bj][1]) * gt;
                    u32x4 w; w.x = cvt_pk_bf16(v0[0], v0[1]); w.y = cvt_pk_bf16(v0[2], v0[3]); w.z = cvt_pk_bf16(v1[0], v1[1]); w.w = cvt_pk_bf16(v1[2], v1[3]);
                    *(u32x4*)(rowp + bj * 128) = w;
                }
                asm volatile("" ::: "memory");
            }
    }
};
}

struct Ctx {
    LAS unsigned char* lds; int tid, lane, wave, G, bx;
    const float* const* in; float* out; unsigned char* ws;
};
#define LDS_WAIT() asm volatile("s_waitcnt lgkmcnt(0)" ::: "memory")

__device__ __forceinline__ void transpose_item(const float* W, int K, int N, bf16_t* WT, int kind, LAS float* scr, int item, int lane) {
    const int nblk = N / 32, kb = item / nblk, nb = item % nblk, k0 = 64 * kb, n0 = 32 * nb;
#pragma unroll 8
    for (int i = 0; i < 32; ++i) { const int kk = 2 * i + (lane >> 5); scr[kk * 33 + (lane & 31)] = W[(size_t)(k0 + kk) * N + n0 + (lane & 31)]; }
    LDS_WAIT(); asm volatile("" ::: "memory");
    const int c = lane & 7;
#pragma unroll
    for (int j = 0; j < 4; ++j) { const int nl = (lane >> 3) + 8 * j; const LAS float* s = scr + (8 * c) * 33 + nl;
        u32x4 o; o.x = cvt_pk_bf16(s[0 * 33], s[1 * 33]); o.y = cvt_pk_bf16(s[2 * 33], s[3 * 33]); o.z = cvt_pk_bf16(s[4 * 33], s[5 * 33]); o.w = cvt_pk_bf16(s[6 * 33], s[7 * 33]);
        const int n = n0 + nl; int dr = n;
        if (kind == 1) { dr = (n < 1024) ? ((n >> 7) * 256 + (n & 127)) : (((n - 1024) >> 7) * 256 + 128 + (n & 127)); }
        *(u32x4*)(WT + (size_t)dr * K + k0 + 8 * c) = o; }
    LDS_WAIT(); asm volatile("" ::: "memory");
}

__device__ __forceinline__ int rel_bucket(int rel) {
    const int n = rel < 0 ? -rel : rel;
    int v;
    if (n < 8) v = n;
    else { const float nf = (float)n; int large = 8 + (int)(logf(nf / 8.0f) / 2.7725887298583984f * 8.0f); v = large < 15 ? large : 15; }
    return (rel > 0 ? 16 : 0) + v;
}

__device__ __forceinline__ void phase0a(Ctx& F) {
    LAS float* scr = (LAS float*)(F.lds + F.wave * 16384);
    const int gw = F.bx * NWAVES + F.wave, NGW = F.G * NWAVES;
    unsigned char* ws = F.ws;
    {
        float* mod = (float*)(ws + WS_MOD);
        for (int it = gw; it < 2 * 96 * 8; it += NGW) {
            const int kc = it & 7, cgp = (it >> 3) % 96, l = it / (8 * 96), k0 = kc * 128, n0 = cgp * 64;
#pragma unroll 4
            for (int j = 0; j < 32; ++j) { const int idx = F.lane + 64 * j, r = idx >> 7, kk = idx & 127;
                const float c = r < 8 ? F.in[2][r * 1024 + k0 + kk] : F.in[3][(r - 8) * 1024 + k0 + kk];
                scr[kk * 16 + r] = c * sigmoidf_(c); }
            LDS_WAIT(); asm volatile("" ::: "memory");
            float a[16];
#pragma unroll
            for (int r = 0; r < 16; ++r) a[r] = 0.f;
            const float* wp = F.in[10] + ((size_t)l * 1024 + k0) * 6144 + n0 + F.lane;
#pragma unroll 4
            for (int kk = 0; kk < 128; ++kk) {
                const float w = wp[(size_t)kk * 6144];
                const LAS f32x4* sp = (const LAS f32x4*)(scr + kk * 16);
                const f32x4 s0 = sp[0], s1 = sp[1], s2 = sp[2], s3 = sp[3];
                a[0] += s0[0] * w; a[1] += s0[1] * w; a[2] += s0[2] * w; a[3] += s0[3] * w;
                a[4] += s1[0] * w; a[5] += s1[1] * w; a[6] += s1[2] * w; a[7] += s1[3] * w;
                a[8] += s2[0] * w; a[9] += s2[1] * w; a[10] += s2[2] * w; a[11] += s2[3] * w;
                a[12] += s3[0] * w; a[13] += s3[1] * w; a[14] += s3[2] * w; a[15] += s3[3] * w;
            }
            const float bb = (kc == 0) ? F.in[11][l * 6144 + n0 + F.lane] : 0.f;
#pragma unroll
            for (int r = 0; r < 16; ++r) atomicAdd(mod + ((size_t)(l * 16 + r)) * 6144 + n0 + F.lane, a[r] + bb);
            LDS_WAIT(); asm volatile("" ::: "memory");
        }
    }
    if (F.bx == 0) {
        float* bt = (float*)(ws + WS_BIAS);
        for (int i = F.tid; i < 8 * 256; i += NTHREADS) { const int h = i >> 8, ri = i & 255; const int rel = ri - 191;
            bt[i] = (ri < 255) ? F.in[7][rel_bucket(rel) * 8 + h] : 0.f; }
    }
    for (int i = F.bx * NTHREADS + F.tid; i < 2 * 8 * 64 * 128; i += F.G * NTHREADS) {
        const int lb = i >> 13, rem = i & 8191;
        F.out[OKS + (size_t)lb * 16384 + rem] = F.in[4][(size_t)lb * 16384 + 8192 + rem];
        F.out[OVS + (size_t)lb * 16384 + rem] = F.in[5][(size_t)lb * 16384 + 8192 + rem];
    }
    constexpr int I_GU = 65536, I_DN = 32768, I_IN = 4352, I_O = 1024, I_OA = 512, I_OB = 512;
    constexpr int NITEMS = I_GU + I_DN + I_IN + I_O + I_OA + I_OB;
    for (int it = gw; it < NITEMS; it += NGW) {
        int r = it;
        if (r < I_GU) { const int m = r >> 10; transpose_item(F.in[23] + (size_t)m * 1024 * 2048, 1024, 2048, (bf16_t*)(ws + WS_WGU) + (size_t)m * 2048 * 1024, 1, scr, r & 1023, F.lane); continue; } r -= I_GU;
        if (r < I_DN) { const int m = r >> 9; transpose_item(F.in[25] + (size_t)m * 1024 * 1024, 1024, 1024, (bf16_t*)(ws + WS_WDN) + (size_t)m * 1024 * 1024, 0, scr, r & 511, F.lane); continue; } r -= I_DN;
        if (r < I_IN) { const int m = r / 2176; transpose_item(F.in[12] + (size_t)m * 1024 * INW, 1024, INW, (bf16_t*)(ws + WS_WIN) + (size_t)m * INW * 1024, 0, scr, r % 2176, F.lane); continue; } r -= I_IN;
        if (r < I_O) { const int m = r >> 9; transpose_item(F.in[18] + (size_t)m * 1024 * 1024, 1024, 1024, (bf16_t*)(ws + WS_WO) + (size_t)m * 1024 * 1024, 0, scr, r & 511, F.lane); continue; } r -= I_O;
        if (r < I_OA) { const int m = r >> 8; transpose_item(F.in[16] + (size_t)m * 512 * 1024, 512, 1024, (bf16_t*)(ws + WS_WOA) + (size_t)m * 1024 * 512, 0, scr, r & 255, F.lane); continue; } r -= I_OA;
        { const int m = r >> 8; transpose_item(F.in[17] + (size_t)m * 512 * 1024, 512, 1024, (bf16_t*)(ws + WS_WOB) + (size_t)m * 1024 * 512, 0, scr, r & 255, F.lane); }
    }
}

__device__ __forceinline__ void ln_row(f32x4 (&v)[4], const float* g, const float* b, int lane) {
    float s = 0.f;
#pragma unroll
    for (int j = 0; j < 4; ++j) s += (v[j][0] + v[j][1]) + (v[j][2] + v[j][3]);
    const float mean = wave_sum(s) * (1.0f / D); float s2 = 0.f;
#pragma unroll
    for (int j = 0; j < 4; ++j) { v[j] = v[j] - mean; s2 += (v[j][0] * v[j][0] + v[j][1] * v[j][1]) + (v[j][2] * v[j][2] + v[j][3] * v[j][3]); }
    const float rstd = 1.0f / sqrtf(wave_sum(s2) * (1.0f / D) + LN_EPS);
#pragma unroll
    for (int j = 0; j < 4; ++j) { const f32x4 gg = *(const f32x4*)(g + 4 * lane + 256 * j), bb = *(const f32x4*)(b + 4 * lane + 256 * j); v[j] = v[j] * rstd * gg + bb; }
}
__device__ __forceinline__ void store_mod_row(const f32x4 (&v)[4], const float* sh, const float* sc, bf16_t* hrow, int lane) {
#pragma unroll
    for (int j = 0; j < 4; ++j) { const f32x4 a = *(const f32x4*)(sc + 4 * lane + 256 * j), b = *(const f32x4*)(sh + 4 * lane + 256 * j);
        const f32x4 h = v[j] * (a + 1.0f) + b; u32x2 w; w.x = cvt_pk_bf16(h[0], h[1]); w.y = cvt_pk_bf16(h[2], h[3]);
        *(u32x2*)(hrow + 4 * lane + 256 * j) = w; }
}

__device__ __forceinline__ void phase0b(Ctx& F) {
    const int gw = F.bx * NWAVES + F.wave, NGW = F.G * NWAVES;
    const float* mod = (const float*)(F.ws + WS_MOD);
    bf16_t* H = (bf16_t*)(F.ws + WS_H);
    for (int row = gw; row < NT; row += NGW) {
        const float* xr = row < NPROMPT ? F.in[0] + (size_t)row * D : F.in[1] + (size_t)(row - NPROMPT) * D;
        f32x4 v[4];
#pragma unroll
        for (int j = 0; j < 4; ++j) v[j] = *(const f32x4*)(xr + 4 * F.lane + 256 * j);
        ln_row(v, F.in[8], F.in[9], F.lane);
#pragma unroll
        for (int j = 0; j < 4; ++j) *(f32x4*)(F.out + (size_t)row * D + 4 * F.lane + 256 * j) = v[j];
        const float* mb = mod + (size_t)batch_of(row) * 6144;
        store_mod_row(v, mb, mb + 1024, H + (size_t)row * D, F.lane);
    }
}

__device__ __forceinline__ void phase_attn(Ctx& F, int l) {
    const bf16_t* Z = (const bf16_t*)(F.ws + WS_Z);
    bf16_t* YA = (bf16_t*)(F.ws + WS_YA);
    bf16_t* YB = (bf16_t*)(F.ws + WS_YB);
    const float* biasr = (const float*)(F.ws + WS_BIAS);
    LAS unsigned char* Ks = F.lds;
    LAS unsigned char* Vt = F.lds + 27648;
    LAS float* bt = (LAS float*)(F.lds + 53248);
    const int lane = F.lane, tid = F.tid;
    for (int au = F.bx; au < 1040; au += F.G) {
        const bool isS = au >= 1024;
        const int kv = au & 1;
        const int b = isS ? ((au - 1024) >> 1) : (au >> 7);
        const int n = isS ? 0 : ((au & 127) >> 1);
        __syncthreads();
        for (int i = tid; i < 1024; i += NTHREADS) bt[i] = biasr[(kv * 4 + (i >> 8)) * 256 + (i & 255)];
#pragma unroll
        for (int jj = 0; jj < 3; ++jj) {
            const int p = tid + NTHREADS * jj, key = p >> 3, ds = p & 7;
            u32x4 kq = (u32x4){0u, 0u, 0u, 0u}, vq = (u32x4){0u, 0u, 0u, 0u};
            if (!isS) {
                const int t = n * 64 + key - 128;
                if (t >= 0) { const bf16_t* zr = Z + (size_t)(b * 4096 + t) * INW + kv * 64 + ds * 8; kq = *(const u32x4*)(zr + 512); vq = *(const u32x4*)(zr + 640); }
            } else if (key < 128) {
                const size_t o = ((size_t)((l * 8 + b) * 128 + key) * 2 + kv) * 64 + ds * 8;
                const f32x4 k0 = *(const f32x4*)(F.in[4] + o), k1 = *(const f32x4*)(F.in[4] + o + 4), v0 = *(const f32x4*)(F.in[5] + o), v1 = *(const f32x4*)(F.in[5] + o + 4);
                kq.x = cvt_pk_bf16(k0[0], k0[1]); kq.y = cvt_pk_bf16(k0[2], k0[3]); kq.z = cvt_pk_bf16(k1[0], k1[1]); kq.w = cvt_pk_bf16(k1[2], k1[3]);
                vq.x = cvt_pk_bf16(v0[0], v0[1]); vq.y = cvt_pk_bf16(v0[2], v0[3]); vq.z = cvt_pk_bf16(v1[0], v1[1]); vq.w = cvt_pk_bf16(v1[2], v1[3]);
            } else {
                const bf16_t* zr = Z + (size_t)(NPROMPT + b * 64 + key - 128) * INW + kv * 64 + ds * 8; kq = *(const u32x4*)(zr + 512); vq = *(const u32x4*)(zr + 640);
            }
            *(LAS u32x4*)(Ks + key * 144 + ds * 16) = kq;
            LAS unsigned short* vp = (LAS unsigned short*)Vt + (ds * 8) * 200 + key;
            vp[0 * 200] = (unsigned short)(vq.x & 0xffffu); vp[1 * 200] = (unsigned short)(vq.x >> 16);
            vp[2 * 200] = (unsigned short)(vq.y & 0xffffu); vp[3 * 200] = (unsigned short)(vq.y >> 16);
            vp[4 * 200] = (unsigned short)(vq.z & 0xffffu); vp[5 * 200] = (unsigned short)(vq.z >> 16);
            vp[6 * 200] = (unsigned short)(vq.w & 0xffffu); vp[7 * 200] = (unsigned short)(vq.w >> 16);
        }
        __syncthreads();
        const int g = F.wave >> 1, qi = (F.wave & 1) * 32 + (lane & 31), hh = lane >> 5, head = kv * 4 + g;
        const int qrow = isS ? NPROMPT + b * 64 + qi : b * 4096 + n * 64 + qi;
        bf16x8 Qf[4];
#pragma unroll
        for (int ks = 0; ks < 4; ++ks) Qf[ks] = *(const bf16x8*)(Z + (size_t)qrow * INW + head * 64 + ks * 16 + hh * 8);
        f32x16 S[6];
#pragma unroll
        for (int kb = 0; kb < 6; ++kb) {
#pragma unroll
            for (int j = 0; j < 16; ++j) S[kb][j] = 0.f;
#pragma unroll
            for (int ks = 0; ks < 4; ++ks) {
                const bf16x8 A = *(const LAS bf16x8*)(Ks + (kb * 32 + (lane & 31)) * 144 + (ks * 16 + hh * 8) * 2);
                S[kb] = __builtin_amdgcn_mfma_f32_32x32x16_bf16(A, Qf[ks], S[kb], 0, 0, 0);
            }
        }
        const float sinkv = F.in[14][l * 8 + head];
        float mx = sinkv;
        const int kmin = isS ? 0 : (128 - n * 64);
#pragma unroll
        for (int kb = 0; kb < 6; ++kb)
#pragma unroll
            for (int j = 0; j < 16; ++j) {
                const int key = kb * 32 + 8 * (j >> 2) + 4 * hh + (j & 3);
                float sv = S[kb][j] * 0.125f + bt[g * 256 + key - qi + 63];
                sv = key >= kmin ? sv : -1e30f;
                S[kb][j] = sv; mx = fmaxf(mx, sv);
            }
        mx = fmaxf(mx, __shfl_xor(mx, 32));
        float sum = 0.f;
#pragma unroll
        for (int kb = 0; kb < 6; ++kb)
#pragma unroll
            for (int j = 0; j < 16; ++j) { const float p = __expf(S[kb][j] - mx); S[kb][j] = p; sum += p; }
        sum += __shfl_xor(sum, 32);
        sum += __expf(sinkv - mx);
        const float inv = 1.0f / sum;
        f32x16 O[2];
#pragma unroll
        for (int db = 0; db < 2; ++db)
#pragma unroll
            for (int j = 0; j < 16; ++j) O[db][j] = 0.f;
#pragma unroll
        for (int kb = 0; kb < 6; ++kb)
#pragma unroll
            for (int s2 = 0; s2 < 2; ++s2) {
                union { bf16x8 v; unsigned u[4]; } P;
#pragma unroll
                for (int q = 0; q < 4; ++q) P.u[q] = cvt_pk_bf16(S[kb][8 * s2 + 2 * q], S[kb][8 * s2 + 2 * q + 1]);
#pragma unroll
                for (int db = 0; db < 2; ++db) {
                    const LAS unsigned char* vb = Vt + (db * 32 + (lane & 31)) * 400 + (kb * 32 + 16 * s2 + 4 * hh) * 2;
                    union { bf16x8 v; u32x2 h[2]; } Vf;
                    Vf.h[0] = *(const LAS u32x2*)vb; Vf.h[1] = *(const LAS u32x2*)(vb + 16);
                    O[db] = __builtin_amdgcn_mfma_f32_32x32x16_bf16(Vf.v, P.v, O[db], 0, 0, 0);
                }
            }
        bf16_t* orow = YA + (size_t)qrow * 512 + head * 64 + 4 * hh;
#pragma unroll
        for (int db = 0; db < 2; ++db)
#pragma unroll
            for (int jq = 0; jq < 4; ++jq) {
                u32x2 w; w.x = cvt_pk_bf16(O[db][4 * jq] * inv, O[db][4 * jq + 1] * inv); w.y = cvt_pk_bf16(O[db][4 * jq + 2] * inv, O[db][4 * jq + 3] * inv);
                *(u32x2*)(orow + db * 32 + 8 * jq) = w;
            }
    }
    const int gw = F.bx * NWAVES + F.wave, NGW = F.G * NWAVES;
    const float* cw = F.in[15] + (size_t)l * 3 * 512 + 8 * lane;
    float w0[8], w1[8], w2[8];
#pragma unroll
    for (int e = 0; e < 8; ++e) { w0[e] = cw[e]; w1[e] = cw[512 + e]; w2[e] = cw[1024 + e]; }
    for (int row = gw; row < NT; row += NGW) {
        const bool isS = row >= NPROMPT; const int b = isS ? ((row - NPROMPT) >> 6) : (row >> 12), t = isS ? ((row - NPROMPT) & 63) : (row & 4095);
        const bf16_t* zr = Z + (size_t)row * INW + 8 * lane;
        const u32x4 cb = *(const u32x4*)(zr + 768);
        float u[3][8];
#pragma unroll
        for (int d = 0; d < 3; ++d) {
            if (t - d >= 0) {
                const bf16_t* zz = zr - (size_t)d * INW; const u32x4 cc = *(const u32x4*)(zz + 1280), cx = *(const u32x4*)(zz + 1792);
                u[d][0] = bf_lo(cc.x) * bf_lo(cx.x); u[d][1] = bf_hi(cc.x) * bf_hi(cx.x); u[d][2] = bf_lo(cc.y) * bf_lo(cx.y); u[d][3] = bf_hi(cc.y) * bf_hi(cx.y);
                u[d][4] = bf_lo(cc.z) * bf_lo(cx.z); u[d][5] = bf_hi(cc.z) * bf_hi(cx.z); u[d][6] = bf_lo(cc.w) * bf_lo(cx.w); u[d][7] = bf_hi(cc.w) * bf_hi(cx.w);
            } else if (isS) {
                const float* hp = F.in[6] + ((size_t)(l * 8 + b) * 2 + (2 + t - d)) * 512 + 8 * lane;
                const f32x4 h0 = *(const f32x4*)hp, h1 = *(const f32x4*)(hp + 4);
#pragma unroll
                for (int e = 0; e < 4; ++e) { u[d][e] = h0[e]; u[d][4 + e] = h1[e]; }
            } else {
#pragma unroll
                for (int e = 0; e < 8; ++e) u[d][e] = 0.f;
            }
        }
        const float cbf[8] = {bf_lo(cb.x), bf_hi(cb.x), bf_lo(cb.y), bf_hi(cb.y), bf_lo(cb.z), bf_hi(cb.z), bf_lo(cb.w), bf_hi(cb.w)};
        float y[8];
#pragma unroll
        for (int e = 0; e < 8; ++e) y[e] = cbf[e] * (w0[e] * u[2][e] + w1[e] * u[1][e] + w2[e] * u[0][e]);
        u32x4 w; w.x = cvt_pk_bf16(y[0], y[1]); w.y = cvt_pk_bf16(y[2], y[3]); w.z = cvt_pk_bf16(y[4], y[5]); w.w = cvt_pk_bf16(y[6], y[7]);
        *(u32x4*)(YB + (size_t)row * 512 + 8 * lane) = w;
        const int tl = isS ? 62 : 4094;
        if (t >= tl) {
            float* o = F.out + (isS ? OCS : OCP) + ((size_t)(l * 8 + b) * 2 + (t - tl)) * 512 + 8 * lane;
            *(f32x4*)o = (f32x4){u[0][0], u[0][1], u[0][2], u[0][3]}; *(f32x4*)(o + 4) = (f32x4){u[0][4], u[0][5], u[0][6], u[0][7]};
        }
    }
}

__device__ __forceinline__ void phase_ln_router(Ctx& F, int l) {
    float* X = F.out; bf16_t* H = (bf16_t*)(F.ws + WS_H);
    const float* mod = (const float*)(F.ws + WS_MOD) + (size_t)l * 16 * 6144;
    unsigned* cnt = (unsigned*)(F.ws + WS_CNT) + l * 32;
    unsigned* tok = (unsigned*)(F.ws + WS_TOK); float* gate = (float*)(F.ws + WS_GATE); unsigned* slot = (unsigned*)(F.ws + WS_SLOT);
    const float* Wr = F.in[21] + (size_t)l * 1024 * 32;
    LAS float* hf = (LAS float*)F.lds;
    const int lane = F.lane, w = F.wave;
    for (int tile = F.bx; tile < NT / 32; tile += F.G) {
        __syncthreads();
        for (int rr = 0; rr < 4; ++rr) {
            const int rl = w * 4 + rr, row = tile * 32 + rl;
            f32x4 v[4];
#pragma unroll
            for (int j = 0; j < 4; ++j) v[j] = *(const f32x4*)(X + (size_t)row * D + 4 * lane + 256 * j);
            ln_row(v, F.in[19] + l * D, F.in[20] + l * D, lane);
#pragma unroll
            for (int j = 0; j < 4; ++j) *(f32x4*)(X + (size_t)row * D + 4 * lane + 256 * j) = v[j];
            const float* mb = mod + (size_t)batch_of(row) * 6144;
#pragma unroll
            for (int j = 0; j < 4; ++j) { const f32x4 a = *(const f32x4*)(mb + 4096 + 4 * lane + 256 * j), b = *(const f32x4*)(mb + 3072 + 4 * lane + 256 * j);
                const f32x4 h = v[j] * (a + 1.0f) + b; u32x2 pk; pk.x = cvt_pk_bf16(h[0], h[1]); pk.y = cvt_pk_bf16(h[2], h[3]);
                *(u32x2*)(H + (size_t)row * D + 4 * lane + 256 * j) = pk;
                LAS float* hp = hf + rl * 1025 + 4 * lane + 256 * j; hp[0] = h[0]; hp[1] = h[1]; hp[2] = h[2]; hp[3] = h[3]; }
        }
        __syncthreads();
        f32x16 acc;
#pragma unroll
        for (int j = 0; j < 16; ++j) acc[j] = 0.f;
        {
            const LAS float* ap = hf + (lane & 31) * 1025 + 128 * w + (lane >> 5);
            const float* bp = Wr + (size_t)(128 * w) * 32 + lane;
#pragma unroll 8
            for (int s = 0; s < 64; ++s) acc = __builtin_amdgcn_mfma_f32_32x32x2f32(ap[2 * s], bp[64 * s], acc, 0, 0, 0);
        }
        __syncthreads();
        LAS float* red = hf;
#pragma unroll
        for (int j = 0; j < 16; ++j) red[(w * 32 + 8 * (j >> 2) + 4 * (lane >> 5) + (j & 3)) * 33 + (lane & 31)] = acc[j];
        __syncthreads();
        for (int rr = 0; rr < 4; ++rr) {
            const int tk = w * 4 + rr, row = tile * 32 + tk;
            float val = -INFINITY;
            if (lane < 32) { float sacc = F.in[22][l * 32 + lane];
#pragma unroll
                for (int ww = 0; ww < 8; ++ww) sacc += red[(ww * 32 + tk) * 33 + lane];
                val = sacc; }
            float tv[4]; int te[4];
#pragma unroll
            for (int it = 0; it < 4; ++it) {
                float bv = val; int bi = lane;
#pragma unroll
                for (int off = 32; off >= 1; off >>= 1) { const float ov = __shfl_xor(bv, off); const int oi = __shfl_xor(bi, off);
                    if (ov > bv || (ov == bv && oi < bi)) { bv = ov; bi = oi; } }
                tv[it] = bv; te[it] = bi; if (lane == bi) val = -INFINITY;
            }
            const float e1 = __expf(tv[1] - tv[0]), e2 = __expf(tv[2] - tv[0]), e3 = __expf(tv[3] - tv[0]);
            const float rs = 1.0f / (1.0f + e1 + e2 + e3);
            if (lane < 4) {
                const int e = lane == 0 ? te[0] : lane == 1 ? te[1] : lane == 2 ? te[2] : te[3];
                const float gk = (lane == 0 ? 1.0f : lane == 1 ? e1 : lane == 2 ? e2 : e3) * rs;
                const unsigned rank = atomicAdd(cnt + e, 1u);
                tok[(size_t)e * NT + rank] = (unsigned)row; gate[(size_t)e * NT + rank] = gk; slot[(size_t)row * 4 + lane] = ((unsigned)e << 24) | rank;
            }
        }
    }
}

__device__ __forceinline__ void build_blk(Ctx& F, int l) {
    LAS int* blk = (LAS int*)(F.lds + LDS_BLK);
    const unsigned* cnt = (const unsigned*)(F.ws + WS_CNT) + l * 32;
    __syncthreads();
    if (F.tid == 0) { int s = 0; for (int e = 0; e < 32; ++e) { blk[e] = s; s += ((int)cnt[e] + 255) >> 8; } blk[32] = s; }
    __syncthreads();
}

__device__ __forceinline__ void phase_combine(Ctx& F, int l) {
    const LAS int* blk = (const LAS int*)(F.lds + LDS_BLK);
    float* X = F.out; bf16_t* H = (bf16_t*)(F.ws + WS_H); const bf16_t* YS = (const bf16_t*)(F.ws + WS_YS);
    const unsigned* slot = (const unsigned*)(F.ws + WS_SLOT);
    const float* mod = (const float*)(F.ws + WS_MOD);
    const int gw = F.bx * NWAVES + F.wave, NGW = F.G * NWAVES, lane = F.lane;
    for (int row = gw; row < NT; row += NGW) {
        f32x4 ff[4];
#pragma unroll
        for (int j = 0; j < 4; ++j) ff[j] = (f32x4){0.f, 0.f, 0.f, 0.f};
#pragma unroll
        for (int k = 0; k < 4; ++k) {
            const unsigned s = slot[(size_t)row * 4 + k]; const int e = (int)(s >> 24), rank = (int)(s & 0xffffffu);
            const bf16_t* yr = YS + ((size_t)blk[e] * 256 + rank) * D + 4 * lane;
#pragma unroll
            for (int j = 0; j < 4; ++j) { const u32x2 wv = *(const u32x2*)(yr + 256 * j); ff[j][0] += bf_lo(wv.x); ff[j][1] += bf_hi(wv.x); ff[j][2] += bf_lo(wv.y); ff[j][3] += bf_hi(wv.y); }
        }
        const int bi = batch_of(row);
        const float* mb = mod + (size_t)(l * 16 + bi) * 6144;
        f32x4 v[4];
#pragma unroll
        for (int j = 0; j < 4; ++j) { const f32x4 x = *(const f32x4*)(X + (size_t)row * D + 4 * lane + 256 * j), g2 = *(const f32x4*)(mb + 5120 + 4 * lane + 256 * j);
            v[j] = x * ALPHA + (g2 + 1.0f) * ff[j]; }
        ln_row(v, F.in[27] + l * D, F.in[28] + l * D, lane);
#pragma unroll
        for (int j = 0; j < 4; ++j) *(f32x4*)(X + (size_t)row * D + 4 * lane + 256 * j) = v[j];
        if (l == 0) { const float* mn = mod + (size_t)(16 + bi) * 6144; store_mod_row(v, mn, mn + 1024, H + (size_t)row * D, lane); }
    }
}

#ifndef PH_MASK
#define PH_MASK 0xFFFF
#endif
#define PH(b) ((PH_MASK >> (b)) & 1)
#define RELOAD() do { int t_ = threadIdx.x; asm volatile("" : "+v"(t_)); F.tid = t_; F.lane = t_ & 63; F.wave = __builtin_amdgcn_readfirstlane(t_ >> 6); \
    unsigned z_; asm volatile("s_mov_b32 %0, 0" : "=s"(z_)); F.in = p.in; F.out = p.out + z_; F.ws = p.ws + z_; } while (0)
#define LAYER_BODY(l) do { \
          \
        RELOAD(); \
        if (PH(2)) { \
            pg8::SchedDense S; S.init(NT, INW, D, F.G, F.bx, (const bf16_t*)(F.ws + WS_WIN) + (size_t)l * INW * D); \
            pg8::EpiZ E{(bf16_t*)(F.ws + WS_Z), F.in[13] + l * INW, F.out, l}; \
            pg8::gemm_phase(F.lds, (const char*)(F.ws + WS_H), D, S, E); \
        } \
        grid.sync(); \
        RELOAD(); \
        if (PH(3)) phase_attn(F, l); \
        grid.sync(); \
          \
        RELOAD(); \
        if (PH(4)) { \
            pg8::SchedDense S; S.init(NT, D, 512, F.G, F.bx, (const bf16_t*)(F.ws + WS_WOA) + (size_t)l * D * 512); \
            pg8::EpiT1 E{(float*)(F.ws + WS_T1), (const bf16_t*)(F.ws + WS_Z)}; \
            pg8::gemm_phase(F.lds, (const char*)(F.ws + WS_YA), 512, S, E); \
        } \
        RELOAD(); \
        if (PH(5)) { \
            pg8::SchedDense S; S.init(NT, D, 512, F.G, F.bx, (const bf16_t*)(F.ws + WS_WOB) + (size_t)l * D * 512); \
            pg8::EpiMix E{(const float*)(F.ws + WS_T1), (const bf16_t*)(F.ws + WS_Z), (bf16_t*)(F.ws + WS_MIX)}; \
            pg8::gemm_phase(F.lds, (const char*)(F.ws + WS_YB), 512, S, E); \
        } \
        grid.sync(); \
          \
        RELOAD(); \
        if (PH(6)) { \
            pg8::SchedDense S; S.init(NT, D, D, F.G, F.bx, (const bf16_t*)(F.ws + WS_WO) + (size_t)l * D * D); \
            pg8::EpiX E{F.out, (const float*)(F.ws + WS_MOD) + (size_t)l * 16 * 6144}; \
            pg8::gemm_phase(F.lds, (const char*)(F.ws + WS_MIX), D, S, E); \
        } \
        grid.sync(); \
        RELOAD(); \
        if (PH(7)) phase_ln_router(F, l); \
        grid.sync(); \
          \
        RELOAD(); \
        build_blk(F, l); \
        if (PH(8)) { \
            LAS int* blk = (LAS int*)(F.lds + LDS_BLK); \
            LAS unsigned short* idx = (LAS unsigned short*)(F.lds + LDS_IDX); \
            pg8::SchedMoE<true> S; S.init(blk, idx, 8, D, F.G, F.bx, (const bf16_t*)(F.ws + WS_WGU) + (size_t)l * 32 * 2048 * D, (size_t)2048 * D * 2); \
            const unsigned* cnt = (const unsigned*)(F.ws + WS_CNT) + l * 32; const unsigned* tok = (const unsigned*)(F.ws + WS_TOK); \
            for (int i = 0; i < MAXU; ++i) { pg8::Unit u; if (!S.next(i, u)) break; \
                if (F.tid < 256) { int rank = (u.pm - blk[u.e]) * 256 + F.tid; const int ce = (int)cnt[u.e]; rank = rank < ce ? rank : ce - 1; \
                    idx[i * 256 + F.tid] = (unsigned short)tok[(size_t)u.e * NT + rank]; } } \
            __syncthreads(); \
            pg8::EpiAct E{(bf16_t*)(F.ws + WS_ACT), F.in[24] + (size_t)l * 32 * 2048}; \
            pg8::gemm_phase(F.lds, (const char*)(F.ws + WS_H), D, S, E); \
        } \
        grid.sync(); \
          \
        RELOAD(); \
        if (PH(9)) { \
            LAS int* blk = (LAS int*)(F.lds + LDS_BLK); \
            LAS unsigned short* idx = (LAS unsigned short*)(F.lds + LDS_IDX); \
            pg8::SchedMoE<false> S; S.init(blk, idx, 4, D, F.G, F.bx, (const bf16_t*)(F.ws + WS_WDN) + (size_t)l * 32 * D * D, (size_t)D * D * 2); \
            pg8::EpiYs E{(bf16_t*)(F.ws + WS_YS), F.in[26] + (size_t)l * 32 * D, (const float*)(F.ws + WS_GATE), (const unsigned*)(F.ws + WS_CNT) + l * 32, blk}; \
            pg8::gemm_phase(F.lds, (const char*)(F.ws + WS_ACT), D, S, E); \
        } \
        grid.sync(); \
        RELOAD(); \
        if (PH(10)) phase_combine(F, l); \
        if (l == 0) grid.sync(); \
 \
    } while (0)
__global__ void __launch_bounds__(NTHREADS, 2) fwd_megakernel(Params p) {
    extern __shared__ __attribute__((aligned(16))) unsigned char lds_raw[];
    cg::grid_group grid = cg::this_grid();
    Ctx F;
    F.lds = (LAS unsigned char*)lds_raw;
    F.G = gridDim.x; F.bx = blockIdx.x;
    RELOAD();
    if (PH(0)) phase0a(F);
    grid.sync();
    RELOAD();
    if (PH(1)) phase0b(F);
    grid.sync();

    LAYER_BODY(0);
    LAYER_BODY(1);
}

extern "C" void kernel_launch(void* const* d_in, const int* in_sizes, int n_in, void* d_out, int out_size, void* d_ws, size_t ws_size, hipStream_t stream) {
    static int grid = 0;
    if (grid == 0) {
        if (n_in != 29 || ws_size < WS_END) { fprintf(stderr, "kernel_launch: unexpected n_in %d / ws_size %zu (need %zu)\n", n_in, ws_size, (size_t)WS_END); grid = -1; return; }
        int dev = 0, cus = 0, per_cu = 0;
        hipGetDevice(&dev);
        hipDeviceGetAttribute(&cus, hipDeviceAttributeMultiprocessorCount, dev);
        if (hipFuncSetAttribute((const void*)fwd_megakernel, hipFuncAttributeMaxDynamicSharedMemorySize, LDS_BYTES) != hipSuccess) { fprintf(stderr, "kernel_launch: hipFuncSetAttribute failed\n"); grid = -1; return; }
        if (hipOccupancyMaxActiveBlocksPerMultiprocessor(&per_cu, (const void*)fwd_megakernel, NTHREADS, LDS_BYTES) != hipSuccess || per_cu < 1) { fprintf(stderr, "kernel_launch: occupancy query says %d blocks per CU\n", per_cu); per_cu = 1; }
        (void)hipGetLastError();
        grid = cus;
        if (grid != 256) fprintf(stderr, "kernel_launch: note: %d CUs (built for 256)\n", grid);
    }
    if (grid < 0) return;
    hipMemsetAsync((char*)d_ws, 0, WS_ZERO_BYTES, stream);
    Params p{};
    for (int i = 0; i < 29; ++i) p.in[i] = (const float*)d_in[i];
    p.out = (float*)d_out; p.ws = (unsigned char*)d_ws;
    void* args[] = {&p};
    hipError_t e = hipLaunchCooperativeKernel((const void*)fwd_megakernel, dim3(grid), dim3(NTHREADS), args, LDS_BYTES, stream);
    if (e != hipSuccess) fprintf(stderr, "kernel_launch: cooperative launch failed: %s (grid %d)\n", hipGetErrorString(e), grid);
}
```

```cpp
#include <hip/hip_runtime.h>
#include <hip/hip_cooperative_groups.h>
#include <cstdio>
#include <cstdint>
namespace cg = cooperative_groups;

#define LAS __attribute__((address_space(3)))
typedef unsigned short bf16_t;
typedef short bf16x8 __attribute__((ext_vector_type(8)));
typedef float f32x4 __attribute__((ext_vector_type(4)));
typedef float f32x16 __attribute__((ext_vector_type(16)));
typedef unsigned u32x4 __attribute__((ext_vector_type(4)));
typedef unsigned u32x2 __attribute__((ext_vector_type(2)));
typedef int i32x4 __attribute__((ext_vector_type(4)));
typedef int i32x8 __attribute__((ext_vector_type(8)));

constexpr int D = 1024, NPROMPT = 32768, NT = 33280, INW = 4352, NEXP = 32;
constexpr float ALPHA = 1.41421356237f, LN_EPS = 1e-5f;
constexpr int NWAVES = 8, NTHREADS = 512;
constexpr int LDS_BYTES = 147456;
constexpr int LDS_BLK = 131072;
constexpr int LDS_IDX = 131072 + 256;
constexpr int MAXU = 24;
constexpr size_t OKP = 34078720, OVP = 34340864, OCP = 34603008, OKS = 34619392, OVS = 34881536, OCS = 35143680;
constexpr size_t MiB = 1u << 20;
constexpr size_t WS_CNT = 0;
constexpr size_t WS_MOD = 65536;
constexpr size_t WS_ZERO_BYTES = 1 * MiB;
constexpr size_t WS_BIAS = 1 * MiB;
constexpr size_t WS_SLOT = 2 * MiB;
constexpr size_t WS_TOK = 3 * MiB;
constexpr size_t WS_GATE = 8 * MiB;
constexpr size_t WS_WIN = 16 * MiB;
constexpr size_t WS_WOA = 34 * MiB;
constexpr size_t WS_WOB = 36 * MiB;
constexpr size_t WS_WO = 38 * MiB;
constexpr size_t WS_WGU = 48 * MiB;
constexpr size_t WS_WDN = 304 * MiB;
constexpr size_t WS_H = 432 * MiB;
constexpr size_t WS_H8 = 1600 * MiB;
constexpr size_t WS_Z = 498 * MiB;
constexpr size_t WS_YA = 776 * MiB;
constexpr size_t WS_YB = 810 * MiB;
constexpr size_t WS_T1 = 844 * MiB;
constexpr size_t WS_MIX = 976 * MiB;
constexpr size_t WS_ACT = 1042 * MiB;
constexpr size_t WS_YS = 1320 * MiB;
constexpr size_t WS_END = 1634 * MiB;

struct Params { const float* in[29]; float* out; unsigned char* ws; };

__device__ __forceinline__ unsigned cvt_pk_bf16(float lo, float hi) { unsigned r; asm volatile("v_cvt_pk_bf16_f32 %0, %1, %2" : "=v"(r) : "v"(lo), "v"(hi)); return r; }
__device__ __forceinline__ unsigned pk4_fp8(float a, float b, float c, float d) { unsigned w = 0u; w = __builtin_amdgcn_cvt_pk_fp8_f32(a, b, w, false); w = __builtin_amdgcn_cvt_pk_fp8_f32(c, d, w, true); return w; }
__device__ __forceinline__ float bf_lo(unsigned w) { return __uint_as_float(w << 16); }
__device__ __forceinline__ float bf_hi(unsigned w) { return __uint_as_float(w & 0xffff0000u); }
__device__ __forceinline__ float sigmoidf_(float x) { return __builtin_amdgcn_rcpf(1.0f + __expf(-x)); }
__device__ __forceinline__ float wave_sum(float v) {
#pragma unroll
    for (int o = 1; o < 64; o <<= 1) v += __shfl_xor(v, o);
    return v;
}
__device__ __forceinline__ int batch_of(int row) { return row < NPROMPT ? (row >> 12) : 8 + ((row - NPROMPT) >> 6); }

namespace pg8 {
constexpr int BM = 256, BK = 64, HALF = 128, HTB = HALF * BK * 2, NXCD = 8, WGM = 8;
__device__ __forceinline__ int lds_byte(int r, int c) { const int st = (r >> 4) * 2 + (c >> 5), rr = r & 15, cc = c & 31, ob = rr * 64 + cc * 2; return st * 1024 + (ob ^ (((ob >> 9) & 1) << 5)); }
__device__ __forceinline__ void stage_rc(int b, int& R, int& C) { const int st = b / 1024, sb = b % 1024, swz = sb ^ (((sb >> 9) & 1) << 5); R = (st >> 1) * 16 + swz / 64; C = (st & 1) * 32 + (swz % 64) / 2; }
__device__ __forceinline__ int perm32(int rho) { const int n = rho >> 4, i = rho & 15; return 8 * (i >> 2) + 4 * n + (i & 3); }

struct Unit { int pm, pn, e; const char* b; };

struct SchedDense {
    int nM, nN, nwg, G, c; const char* Bt; size_t tstepB;
    __device__ __forceinline__ void init(int M, int N, int K, int G_, int c_, const void* Bt_) { nM = M / BM; nN = N / BM; nwg = nM * nN; G = G_; c = c_; Bt = (const char*)Bt_; tstepB = (size_t)BM * K * 2; }
    __device__ __forceinline__ bool next(int i, Unit& u) const {
        const long L = (long)i * G + c; if (L >= nwg) return false;
        int wgid = (int)L; { const int q = nwg / NXCD, r = nwg % NXCD, xcd = wgid % NXCD, off = wgid / NXCD; wgid = (xcd < r ? xcd * (q + 1) : r * (q + 1) + (xcd - r) * q) + off; }
        const int nig = WGM * nN, gid = wgid / nig, fm = gid * WGM, gsz = (nM - fm) < WGM ? (nM - fm) : WGM;
        u.pm = fm + ((wgid % nig) % gsz); u.pn = (wgid % nig) / gsz; u.e = 0; u.b = Bt + (size_t)u.pn * tstepB; return true;
    }
    __device__ __forceinline__ unsigned rowidx(int, const Unit& u, int r) const { return (unsigned)(u.pm * BM + r); }
};
template <bool GATHER> struct SchedMoE {
    const LAS int* blk; const LAS unsigned short* idx; int NB, RBX, NPN, NXs, perx, cx, cj; const char* Bt; size_t estep, tstepB;
    __device__ __forceinline__ void init(const LAS int* blk_, const LAS unsigned short* idx_, int NPN_, int K, int G, int c, const void* Bt_, size_t estep_) {
        blk = blk_; idx = idx_; NB = blk_[32]; NPN = NPN_; Bt = (const char*)Bt_; estep = estep_; tstepB = (size_t)BM * K * 2;
        if ((G & 7) == 0) { NXs = 8; perx = G >> 3; cx = c & 7; cj = c >> 3; } else { NXs = 1; perx = G; cx = 0; cj = c; }
        RBX = (NB + NXs - 1) / NXs;
    }
    __device__ __forceinline__ bool next(int i, Unit& u) const {
        const int j = i * perx + cj, rbl = j / NPN; if (rbl >= RBX) return false;
        const int rb = cx * RBX + rbl; if (rb >= NB) return false;
        int e = 0;
        for (int q = 1; q < 32; ++q) e = (blk[q] <= rb) ? q : e;
        u.pm = rb; u.pn = j - rbl * NPN; u.e = e; u.b = Bt + (size_t)e * estep + (size_t)u.pn * tstepB; return true;
    }
    __device__ __forceinline__ unsigned rowidx(int ui, const Unit& u, int r) const { if (GATHER) return (unsigned)idx[ui * 256 + r]; return (unsigned)(u.pm * BM + r); }
};

template <bool FP8, class Epi, class Sched>
__device__ __forceinline__ void gemm_phase(LAS unsigned char* lds, const char* Abase, const int K, const Sched& S, const Epi& E) {
    int tid_ = threadIdx.x; asm volatile("" : "+v"(tid_));
    const int tid = tid_, wid = __builtin_amdgcn_readfirstlane(tid >> 6), lane = tid & 63, wr = wid >> 2, wc = wid & 3, fr = lane & 15, fq = lane >> 4;
    const int nt = K / BK;
    unsigned voffB[2]; int RA[2], CA[2];
#pragma unroll
    for (int i = 0; i < 2; ++i) { int R, C; stage_rc(tid * 16 + i * 8192, R, C); const int Rb = Epi::PERM ? ((R & ~31) + perm32(R & 31)) : R;
        voffB[i] = (unsigned)(Rb * K + C) * 2u; RA[i] = R; CA[i] = C * 2; }
    const size_t kstep = (size_t)(BK * 2);
    const size_t hstep = (size_t)HALF * K * 2;
    const unsigned ldsw = (unsigned)wid * 1024u;
    const unsigned rowb = (unsigned)K * 2u;
    const int aoff = lds_byte(wr * 64 + fr, fq * 8), boff = lds_byte(wc * 32 + fr, fq * 8);
#define PG8_SA(b, h) (((b) * 2 + (h)) * HTB)
#define PG8_SB(b, h) ((4 + (b) * 2 + (h)) * HTB)
#define PG8_STAGE(bufoff, gbase, voff) do { _Pragma("unroll") for (int _i = 0; _i < 2; ++_i) \
        __builtin_amdgcn_global_load_lds((const unsigned*)((const char*)(gbase) + (voff)[_i]), (LAS unsigned*)(lds + (bufoff) + ldsw + _i * 8192), 16, 0, 0); } while (0)
#define PG8_LDA(dst, b, h) do { _Pragma("unroll") for (int m = 0; m < 4; ++m) _Pragma("unroll") for (int k = 0; k < 2; ++k) dst[m][k] = *(const LAS bf16x8*)(lds + PG8_SA(b, h) + aoff + m * 2048 + k * 1024); } while (0)
#define PG8_LDB(dst, b, h) do { _Pragma("unroll") for (int n = 0; n < 2; ++n) _Pragma("unroll") for (int k = 0; k < 2; ++k) dst[n][k] = *(const LAS bf16x8*)(lds + PG8_SB(b, h) + boff + n * 2048 + k * 1024); } while (0)
#define PG8_MMA(ai, bj, At, Bt) do { __builtin_amdgcn_s_setprio(1); _Pragma("unroll") for (int m = 0; m < 4; ++m) _Pragma("unroll") for (int n = 0; n < 2; ++n) { \
        if constexpr (FP8) { \
            const i32x8 wf_ = __builtin_shufflevector((i32x4)Bt[n][0], (i32x4)Bt[n][1], 0, 1, 2, 3, 4, 5, 6, 7), af_ = __builtin_shufflevector((i32x4)At[m][0], (i32x4)At[m][1], 0, 1, 2, 3, 4, 5, 6, 7); \
            acc[ai][bj][m][n] = __builtin_amdgcn_mfma_scale_f32_16x16x128_f8f6f4(wf_, af_, acc[ai][bj][m][n], 0, 0, 0, 0x79797979, 0, 0x7f7f7f7f); \
        } else { _Pragma("unroll") for (int k = 0; k < 2; ++k) \
            acc[ai][bj][m][n] = __builtin_amdgcn_mfma_f32_16x16x32_bf16(Bt[n][k], At[m][k], acc[ai][bj][m][n], 0, 0, 0); } } \
        __builtin_amdgcn_s_setprio(0); } while (0)
#define PG8_WAIT_V(n) asm volatile("s_waitcnt vmcnt(" #n ")" ::: "memory")
#define PG8_WAIT_L(n) asm volatile("s_waitcnt lgkmcnt(" #n ")" ::: "memory")
#define PG8_BAR __builtin_amdgcn_s_barrier()
#define PG8_SCHED __builtin_amdgcn_sched_barrier(0)
#define PG8_LOADVA(ui_, u_) do { _Pragma("unroll") for (int _h = 0; _h < 2; ++_h) _Pragma("unroll") for (int _i = 0; _i < 2; ++_i) \
        vA[_h][_i] = S.rowidx((ui_), (u_), _h * HALF + RA[_i]) * rowb + (unsigned)CA[_i]; } while (0)
    Unit cur, nxt; int ui = 0;
    if (!S.next(0, cur)) return;
    f32x4 acc[2][2][4][2];
#pragma unroll
    for (int a = 0; a < 2; ++a)
#pragma unroll
        for (int b = 0; b < 2; ++b)
#pragma unroll
            for (int m = 0; m < 4; ++m)
#pragma unroll
                for (int n = 0; n < 2; ++n) acc[a][b][m][n] = (f32x4){0.f, 0.f, 0.f, 0.f};
    bf16x8 At[4][2], B0[2][2], B1[2][2];
    unsigned vA[2][2];
    PG8_LOADVA(0, cur);
    const char* cB = cur.b;
    PG8_STAGE(PG8_SB(0, 0), cB, voffB); PG8_STAGE(PG8_SB(0, 1), cB + hstep, voffB); PG8_STAGE(PG8_SA(0, 0), Abase, vA[0]); PG8_STAGE(PG8_SA(0, 1), Abase, vA[1]);
    if (wr == 1) PG8_BAR;
    PG8_WAIT_V(2); PG8_BAR;
    PG8_STAGE(PG8_SB(1, 0), cB + kstep, voffB); PG8_STAGE(PG8_SA(1, 0), Abase + kstep, vA[0]); PG8_STAGE(PG8_SB(1, 1), cB + hstep + kstep, voffB);
    PG8_WAIT_V(6); PG8_BAR;
    for (;;) {
        const bool has_next = S.next(ui + 1, nxt);
        const char* nB = has_next ? nxt.b : cB;
        for (int t = 0; t < nt; t += 2) {
            const bool last = (t == nt - 2);
            const char* a1 = Abase + (size_t)(t + 1) * kstep;
            const char* a2 = last ? Abase : Abase + (size_t)(t + 2) * kstep;
            const char* b2 = last ? nB : cB + (size_t)(t + 2) * kstep;
            const char* a3 = a2 + kstep; const char* b3 = b2 + kstep;
            PG8_LDB(B0, 0, 0); PG8_LDB(B1, 0, 1); PG8_SCHED; PG8_LDA(At, 0, 0); PG8_STAGE(PG8_SA(1, 1), a1, vA[1]);
            if (last && has_next) { PG8_LOADVA(ui + 1, nxt); }
            PG8_WAIT_V(8); PG8_WAIT_L(0); PG8_BAR; PG8_MMA(0, 0, At, B0); PG8_MMA(0, 1, At, B1); PG8_BAR; PG8_SCHED;
            PG8_LDA(At, 0, 1); PG8_STAGE(PG8_SB(0, 0), b2, voffB); PG8_STAGE(PG8_SB(0, 1), b2 + hstep, voffB); PG8_STAGE(PG8_SA(0, 0), a2, vA[0]);
            PG8_WAIT_V(8); PG8_WAIT_L(0); PG8_BAR; PG8_MMA(1, 0, At, B0); PG8_MMA(1, 1, At, B1); PG8_BAR; PG8_SCHED;
            PG8_LDB(B0, 1, 0); PG8_LDB(B1, 1, 1); PG8_SCHED; PG8_LDA(At, 1, 0); PG8_STAGE(PG8_SA(0, 1), a2, vA[1]);
            PG8_WAIT_V(8); PG8_WAIT_L(0); PG8_BAR; PG8_MMA(0, 0, At, B0); PG8_MMA(0, 1, At, B1); PG8_BAR; PG8_SCHED;
            PG8_LDA(At, 1, 1); PG8_STAGE(PG8_SB(1, 0), b3, voffB); PG8_STAGE(PG8_SB(1, 1), b3 + hstep, voffB); PG8_STAGE(PG8_SA(1, 0), a3, vA[0]);
            PG8_WAIT_V(8); PG8_WAIT_L(0); PG8_BAR; PG8_MMA(1, 0, At, B0); PG8_MMA(1, 1, At, B1); PG8_BAR; PG8_SCHED;
        }
        if (wr == 0) PG8_BAR;
        E(acc, cur, wr, wc, fr, fq);
        if (!has_next) break;
#pragma unroll
        for (int a = 0; a < 2; ++a)
#pragma unroll
            for (int b = 0; b < 2; ++b)
#pragma unroll
                for (int m = 0; m < 4; ++m)
#pragma unroll
                    for (int n = 0; n < 2; ++n) acc[a][b][m][n] = (f32x4){0.f, 0.f, 0.f, 0.f};
        cur = nxt; cB = nB; ++ui;
        if (wr == 1) PG8_BAR;
    }
    PG8_WAIT_V(0);
    PG8_BAR;
#undef PG8_SA
#undef PG8_SB
#undef PG8_STAGE
#undef PG8_LDA
#undef PG8_LDB
#undef PG8_MMA
#undef PG8_WAIT_V
#undef PG8_WAIT_L
#undef PG8_BAR
#undef PG8_SCHED
#undef PG8_LOADVA
}

typedef f32x4 Acc[2][2][4][2];

struct EpiZ {
    static constexpr bool PERM = true;
    bf16_t* Z; const float* bias; float* out; int l;
    __device__ __forceinline__ void operator()(const Acc& acc, const Unit& u, int wr, int wc, int fr, int fq) const {
        const int row0 = u.pm * 256 + wr * 64 + fr, col0 = u.pn * 256 + wc * 32 + 8 * fq;
        f32x4 bv[2][2];
#pragma unroll
        for (int bj = 0; bj < 2; ++bj)
#pragma unroll
            for (int n = 0; n < 2; ++n) bv[bj][n] = *(const f32x4*)(bias + col0 + bj * 128 + 4 * n);
#pragma unroll
        for (int ai = 0; ai < 2; ++ai)
#pragma unroll
            for (int m = 0; m < 4; ++m) {
                const int row = row0 + ai * 128 + m * 16;
                bf16_t* rowp = Z + (size_t)row * INW + col0;
                float* ko = nullptr; float* vo = nullptr;
                if (u.pn == 2) {
                    if (row < NPROMPT) { const int t = row & 4095; if (t >= 3968) { const size_t o = ((size_t)(l * 8 + (row >> 12)) * 128 + (t - 3968)) * 128 + wc * 32 + 8 * fq; ko = out + OKP + o; vo = out + OVP + o; } }
                    else { const int rr = row - NPROMPT; const size_t o = ((size_t)(l * 8 + (rr >> 6)) * 128 + 64 + (rr & 63)) * 128 + wc * 32 + 8 * fq; ko = out + OKS + o; vo = out + OVS + o; }
                }
#pragma unroll
                for (int bj = 0; bj < 2; ++bj) {
                    const f32x4 v0 = acc[ai][bj][m][0] + bv[bj][0], v1 = acc[ai][bj][m][1] + bv[bj][1];
                    u32x4 w; w.x = cvt_pk_bf16(v0[0], v0[1]); w.y = cvt_pk_bf16(v0[2], v0[3]); w.z = cvt_pk_bf16(v1[0], v1[1]); w.w = cvt_pk_bf16(v1[2], v1[3]);
                    *(u32x4*)(rowp + bj * 128) = w;
                    float* o = bj == 0 ? ko : vo;
                    if (o) { *(f32x4*)o = v0; *(f32x4*)(o + 4) = v1; }
                }
                asm volatile("" ::: "memory");
            }
    }
};
struct EpiT1 {
    static constexpr bool PERM = true;
    float* T1; const bf16_t* Z;
    __device__ __forceinline__ void operator()(const Acc& acc, const Unit& u, int wr, int wc, int fr, int fq) const {
        const int row0 = u.pm * 256 + wr * 64 + fr, col0 = u.pn * 256 + wc * 32 + 8 * fq;
#pragma unroll
        for (int ai = 0; ai < 2; ++ai)
#pragma unroll
            for (int m = 0; m < 4; ++m) {
                const int row = row0 + ai * 128 + m * 16;
#pragma unroll
                for (int bj = 0; bj < 2; ++bj) {
                    const u32x4 g = *(const u32x4*)(Z + (size_t)row * INW + 2304 + col0 + bj * 128);
                    f32x4 v0 = acc[ai][bj][m][0], v1 = acc[ai][bj][m][1];
                    v0[0] *= sigmoidf_(bf_lo(g.x)); v0[1] *= sigmoidf_(bf_hi(g.x)); v0[2] *= sigmoidf_(bf_lo(g.y)); v0[3] *= sigmoidf_(bf_hi(g.y));
                    v1[0] *= sigmoidf_(bf_lo(g.z)); v1[1] *= sigmoidf_(bf_hi(g.z)); v1[2] *= sigmoidf_(bf_lo(g.w)); v1[3] *= sigmoidf_(bf_hi(g.w));
                    float* o = T1 + (size_t)row * D + col0 + bj * 128;
                    *(f32x4*)o = v0; *(f32x4*)(o + 4) = v1;
                    asm volatile("" ::: "memory");
                }
            }
    }
};
struct EpiMix {
    static constexpr bool PERM = true;
    const float* T1; const bf16_t* Z; bf16_t* MIX;
    __device__ __forceinline__ void operator()(const Acc& acc, const Unit& u, int wr, int wc, int fr, int fq) const {
        const int row0 = u.pm * 256 + wr * 64 + fr, col0 = u.pn * 256 + wc * 32 + 8 * fq;
#pragma unroll
        for (int ai = 0; ai < 2; ++ai)
#pragma unroll
            for (int m = 0; m < 4; ++m) {
                const int row = row0 + ai * 128 + m * 16;
#pragma unroll
                for (int bj = 0; bj < 2; ++bj) {
                    const u32x4 g = *(const u32x4*)(Z + (size_t)row * INW + 3328 + col0 + bj * 128);
                    const float* tp = T1 + (size_t)row * D + col0 + bj * 128;
                    f32x4 v0 = *(const f32x4*)tp, v1 = *(const f32x4*)(tp + 4);
                    const f32x4 a0 = acc[ai][bj][m][0], a1 = acc[ai][bj][m][1];
                    v0[0] += a0[0] * sigmoidf_(bf_lo(g.x)); v0[1] += a0[1] * sigmoidf_(bf_hi(g.x)); v0[2] += a0[2] * sigmoidf_(bf_lo(g.y)); v0[3] += a0[3] * sigmoidf_(bf_hi(g.y));
                    v1[0] += a1[0] * sigmoidf_(bf_lo(g.z)); v1[1] += a1[1] * sigmoidf_(bf_hi(g.z)); v1[2] += a1[2] * sigmoidf_(bf_lo(g.w)); v1[3] += a1[3] * sigmoidf_(bf_hi(g.w));
                    u32x4 w; w.x = cvt_pk_bf16(v0[0], v0[1]); w.y = cvt_pk_bf16(v0[2], v0[3]); w.z = cvt_pk_bf16(v1[0], v1[1]); w.w = cvt_pk_bf16(v1[2], v1[3]);
                    *(u32x4*)(MIX + (size_t)row * D + col0 + bj * 128) = w;
                    asm volatile("" ::: "memory");
                }
            }
    }
};
struct EpiX {
    static constexpr bool PERM = false;
    float* X; const float* modl;
    __device__ __forceinline__ void operator()(const Acc& acc, const Unit& u, int wr, int wc, int fr, int fq) const {
        const int row0 = u.pm * 256 + wr * 64 + fr, col0 = u.pn * 256 + wc * 32 + 4 * fq;
#pragma unroll
        for (int ai = 0; ai < 2; ++ai)
#pragma unroll
            for (int m = 0; m < 4; ++m) {
                const int row = row0 + ai * 128 + m * 16;
                const float* gp = modl + (size_t)batch_of(row) * 6144 + 2048 + col0;
                float* xp = X + (size_t)row * D + col0;
#pragma unroll
                for (int bj = 0; bj < 2; ++bj)
#pragma unroll
                    for (int n = 0; n < 2; ++n) {
                        const f32x4 g = *(const f32x4*)(gp + bj * 128 + n * 16);
                        const f32x4 x = *(const f32x4*)(xp + bj * 128 + n * 16);
                        *(f32x4*)(xp + bj * 128 + n * 16) = x * ALPHA + (g + 1.0f) * acc[ai][bj][m][n];
                    }
                asm volatile("" ::: "memory");
            }
    }
};
struct EpiAct {
    static constexpr bool PERM = true;
    unsigned char* ACT; const float* bgu;
    __device__ __forceinline__ void operator()(const Acc& acc, const Unit& u, int wr, int wc, int fr, int fq) const {
        const int row0 = u.pm * 256 + wr * 64 + fr, c0 = u.pn * 128 + wc * 32 + 8 * fq;
        const float* bp = bgu + (size_t)u.e * 2048 + c0;
        f32x4 bg[2], bl[2];
#pragma unroll
        for (int n = 0; n < 2; ++n) { bg[n] = *(const f32x4*)(bp + 4 * n); bl[n] = *(const f32x4*)(bp + 1024 + 4 * n); }
#pragma unroll
        for (int ai = 0; ai < 2; ++ai)
#pragma unroll
            for (int m = 0; m < 4; ++m) {
                const int row = row0 + ai * 128 + m * 16;
                float a[8];
#pragma unroll
                for (int n = 0; n < 2; ++n)
#pragma unroll
                    for (int j = 0; j < 4; ++j) {
                        float g = acc[ai][0][m][n][j] + bg[n][j], li = acc[ai][1][m][n][j] + bl[n][j];
                        g = fminf(g, 7.0f); li = fminf(fmaxf(li, -7.0f), 7.0f);
                        a[n * 4 + j] = g * sigmoidf_(1.702f * g) * (li + 1.0f);
                    }
                u32x2 w; w.x = pk4_fp8(a[0], a[1], a[2], a[3]); w.y = pk4_fp8(a[4], a[5], a[6], a[7]);
                *(u32x2*)(ACT + (size_t)row * D + c0) = w;
                asm volatile("" ::: "memory");
            }
    }
};
struct EpiYs {
    static constexpr bool PERM = true;
    bf16_t* YS; const float* bdn; const float* gate; const unsigned* cnt; const LAS int* blk;
    __device__ __forceinline__ void operator()(const Acc& acc, const Unit& u, int wr, int wc, int fr, int fq) const {
        const int r0 = wr * 64 + fr, col0 = u.pn * 256 + wc * 32 + 8 * fq;
        const int rank0 = (u.pm - blk[u.e]) * 256; const int ce = (int)cnt[u.e * 64];
        f32x4 bv[2][2];
#pragma unroll
        for (int bj = 0; bj < 2; ++bj)
#pragma unroll
            for (int n = 0; n < 2; ++n) bv[bj][n] = *(const f32x4*)(bdn + (size_t)u.e * D + col0 + bj * 128 + 4 * n);
#pragma unroll
        for (int ai = 0; ai < 2; ++ai)
#pragma unroll
            for (int m = 0; m < 4; ++m) {
                const int r = r0 + ai * 128 + m * 16, rank = rank0 + r;
                const float gt = rank < ce ? gate[(size_t)u.e * NT + rank] : 0.0f;
                bf16_t* rowp = YS + (size_t)(u.pm * 256 + r) * D + col0;
#pragma unroll
                for (int bj = 0; bj < 2; ++bj) {
                    const f32x4 v0 = (acc[ai][bj][m][0] + bv[bj][0]) * gt, v1 = (acc[ai][bj][m][1] + bv[bj][1]) * gt;
                    u32x4 w; w.x = cvt_pk_bf16(v0[0], v0[1]); w.y = cvt_pk_bf16(v0[2], v0[3]); w.z = cvt_pk_bf16(v1[0], v1[1]); w.w = cvt_pk_bf16(v1[2], v1[3]);
                    *(u32x4*)(rowp + bj * 128) = w;
                }
                asm volatile("" ::: "memory");
            }
    }
};
}

struct Ctx {
    LAS unsigned char* lds; int tid, lane, wave, G, bx;
    const float* const* in; float* out; unsigned char* ws;
};
#define LDS_WAIT() asm volatile("s_waitcnt lgkmcnt(0)" ::: "memory")

__device__ __forceinline__ void transpose_item(const float* W, int K, int N, bf16_t* WT, int kind, LAS float* scr, int item, int lane) {
    const int nblk = N / 32, kb = item / nblk, nb = item % nblk, k0 = 64 * kb, n0 = 32 * nb;
#pragma unroll 8
    for (int i = 0; i < 32; ++i) { const int kk = 2 * i + (lane >> 5); scr[kk * 33 + (lane & 31)] = W[(size_t)(k0 + kk) * N + n0 + (lane & 31)]; }
    LDS_WAIT(); asm volatile("" ::: "memory");
    const int c = lane & 7;
#pragma unroll
    for (int j = 0; j < 4; ++j) { const int nl = (lane >> 3) + 8 * j; const LAS float* s = scr + (8 * c) * 33 + nl;
        u32x4 o; o.x = cvt_pk_bf16(s[0 * 33], s[1 * 33]); o.y = cvt_pk_bf16(s[2 * 33], s[3 * 33]); o.z = cvt_pk_bf16(s[4 * 33], s[5 * 33]); o.w = cvt_pk_bf16(s[6 * 33], s[7 * 33]);
        const int n = n0 + nl; int dr = n;
        if (kind == 1) { dr = (n < 1024) ? ((n >> 7) * 256 + (n & 127)) : (((n - 1024) >> 7) * 256 + 128 + (n & 127)); }
        *(u32x4*)(WT + (size_t)dr * K + k0 + 8 * c) = o; }
    LDS_WAIT(); asm volatile("" ::: "memory");
}

__device__ __forceinline__ void transpose_item_fp8(const float* W, int K, int N, unsigned char* WT, int kind, LAS float* scr, int item, int lane) {
    const int nblk = N / 32, kb = item / nblk, nb = item % nblk, k0 = 64 * kb, n0 = 32 * nb;
#pragma unroll 8
    for (int i = 0; i < 32; ++i) { const int kk = 2 * i + (lane >> 5); scr[kk * 33 + (lane & 31)] = W[(size_t)(k0 + kk) * N + n0 + (lane & 31)] * 64.0f; }
    LDS_WAIT(); asm volatile("" ::: "memory");
    const int c = lane & 7;
#pragma unroll
    for (int j = 0; j < 4; ++j) { const int nl = (lane >> 3) + 8 * j; const LAS float* s = scr + (8 * c) * 33 + nl;
        u32x2 o; o.x = pk4_fp8(s[0 * 33], s[1 * 33], s[2 * 33], s[3 * 33]); o.y = pk4_fp8(s[4 * 33], s[5 * 33], s[6 * 33], s[7 * 33]);
        const int n = n0 + nl; int dr = n;
        if (kind == 1) { dr = (n < 1024) ? ((n >> 7) * 256 + (n & 127)) : (((n - 1024) >> 7) * 256 + 128 + (n & 127)); }
        *(u32x2*)(WT + (size_t)dr * K + k0 + 8 * c) = o; }
    LDS_WAIT(); asm volatile("" ::: "memory");
}

__device__ __forceinline__ int rel_bucket(int rel) {
    const int n = rel < 0 ? -rel : rel;
    int v;
    if (n < 8) v = n;
    else { const float nf = (float)n; int large = 8 + (int)(logf(nf / 8.0f) / 2.7725887298583984f * 8.0f); v = large < 15 ? large : 15; }
    return (rel > 0 ? 16 : 0) + v;
}

__device__ __forceinline__ void phase0a(Ctx& F) {
    LAS float* scr = (LAS float*)(F.lds + F.wave * 16384);
    const int gw = F.bx * NWAVES + F.wave, NGW = F.G * NWAVES;
    unsigned char* ws = F.ws;
    {
        float* mod = (float*)(ws + WS_MOD);
        for (int it = gw; it < 2 * 96 * 8; it += NGW) {
            const int kc = it & 7, cgp = (it >> 3) % 96, l = it / (8 * 96), k0 = kc * 128, n0 = cgp * 64;
#pragma unroll 4
            for (int j = 0; j < 32; ++j) { const int idx = F.lane + 64 * j, r = idx >> 7, kk = idx & 127;
                const float c = r < 8 ? F.in[2][r * 1024 + k0 + kk] : F.in[3][(r - 8) * 1024 + k0 + kk];
                scr[kk * 16 + r] = c * sigmoidf_(c); }
            LDS_WAIT(); asm volatile("" ::: "memory");
            float a[16];
#pragma unroll
            for (int r = 0; r < 16; ++r) a[r] = 0.f;
            const float* wp = F.in[10] + ((size_t)l * 1024 + k0) * 6144 + n0 + F.lane;
#pragma unroll 4
            for (int kk = 0; kk < 128; ++kk) {
                const float w = wp[(size_t)kk * 6144];
                const LAS f32x4* sp = (const LAS f32x4*)(scr + kk * 16);
                const f32x4 s0 = sp[0], s1 = sp[1], s2 = sp[2], s3 = sp[3];
                a[0] += s0[0] * w; a[1] += s0[1] * w; a[2] += s0[2] * w; a[3] += s0[3] * w;
                a[4] += s1[0] * w; a[5] += s1[1] * w; a[6] += s1[2] * w; a[7] += s1[3] * w;
                a[8] += s2[0] * w; a[9] += s2[1] * w; a[10] += s2[2] * w; a[11] += s2[3] * w;
                a[12] += s3[0] * w; a[13] += s3[1] * w; a[14] += s3[2] * w; a[15] += s3[3] * w;
            }
            const float bb = (kc == 0) ? F.in[11][l * 6144 + n0 + F.lane] : 0.f;
#pragma unroll
            for (int r = 0; r < 16; ++r) atomicAdd(mod + ((size_t)(l * 16 + r)) * 6144 + n0 + F.lane, a[r] + bb);
            LDS_WAIT(); asm volatile("" ::: "memory");
        }
    }
    if (F.bx == 0) {
        float* bt = (float*)(ws + WS_BIAS);
        for (int i = F.tid; i < 8 * 256; i += NTHREADS) { const int h = i >> 8, ri = i & 255; const int rel = ri - 191;
            bt[i] = (ri < 255) ? F.in[7][rel_bucket(rel) * 8 + h] : 0.f; }
    }
    for (int i = F.bx * NTHREADS + F.tid; i < 2 * 8 * 64 * 128; i += F.G * NTHREADS) {
        const int lb = i >> 13, rem = i & 8191;
        F.out[OKS + (size_t)lb * 16384 + rem] = F.in[4][(size_t)lb * 16384 + 8192 + rem];
        F.out[OVS + (size_t)lb * 16384 + rem] = F.in[5][(size_t)lb * 16384 + 8192 + rem];
    }
    constexpr int I_GU = 65536, I_DN = 32768, I_IN = 4352, I_O = 1024, I_OA = 512, I_OB = 512;
    constexpr int NITEMS = I_GU + I_DN + I_IN + I_O + I_OA + I_OB;
    for (int it = gw; it < NITEMS; it += NGW) {
        int r = it;
        if (r < I_GU) { const int m = r >> 10; transpose_item_fp8(F.in[23] + (size_t)m * 1024 * 2048, 1024, 2048, (unsigned char*)(ws + WS_WGU) + (size_t)m * 2048 * 1024, 1, scr, r & 1023, F.lane); continue; } r -= I_GU;
        if (r < I_DN) { const int m = r >> 9; transpose_item_fp8(F.in[25] + (size_t)m * 1024 * 1024, 1024, 1024, (unsigned char*)(ws + WS_WDN) + (size_t)m * 1024 * 1024, 0, scr, r & 511, F.lane); continue; } r -= I_DN;
        if (r < I_IN) { const int m = r / 2176; transpose_item(F.in[12] + (size_t)m * 1024 * INW, 1024, INW, (bf16_t*)(ws + WS_WIN) + (size_t)m * INW * 1024, 0, scr, r % 2176, F.lane); continue; } r -= I_IN;
        if (r < I_O) { const int m = r >> 9; transpose_item(F.in[18] + (size_t)m * 1024 * 1024, 1024, 1024, (bf16_t*)(ws + WS_WO) + (size_t)m * 1024 * 1024, 0, scr, r & 511, F.lane); continue; } r -= I_O;
        if (r < I_OA) { const int m = r >> 8; transpose_item(F.in[16] + (size_t)m * 512 * 1024, 512, 1024, (bf16_t*)(ws + WS_WOA) + (size_t)m * 1024 * 512, 0, scr, r & 255, F.lane); continue; } r -= I_OA;
        { const int m = r >> 8; transpose_item(F.in[17] + (size_t)m * 512 * 1024, 512, 1024, (bf16_t*)(ws + WS_WOB) + (size_t)m * 1024 * 512, 0, scr, r & 255, F.lane); }
    }
}

__device__ __forceinline__ void ln_row(f32x4 (&v)[4], const float* g, const float* b, int lane) {
    float s = 0.f;
#pragma unroll
    for (int j = 0; j < 4; ++j) s += (v[j][0] + v[j][1]) + (v[j][2] + v[j][3]);
    const float mean = wave_sum(s) * (1.0f / D); float s2 = 0.f;
#pragma unroll
    for (int j = 0; j < 4; ++j) { v[j] = v[j] - mean; s2 += (v[j][0] * v[j][0] + v[j][1] * v[j][1]) + (v[j][2] * v[j][2] + v[j][3] * v[j][3]); }
    const float rstd = 1.0f / sqrtf(wave_sum(s2) * (1.0f / D) + LN_EPS);
#pragma unroll
    for (int j = 0; j < 4; ++j) { const f32x4 gg = *(const f32x4*)(g + 4 * lane + 256 * j), bb = *(const f32x4*)(b + 4 * lane + 256 * j); v[j] = v[j] * rstd * gg + bb; }
}
__device__ __forceinline__ void store_mod_row(const f32x4 (&v)[4], const float* sh, const float* sc, bf16_t* hrow, int lane) {
#pragma unroll
    for (int j = 0; j < 4; ++j) { const f32x4 a = *(const f32x4*)(sc + 4 * lane + 256 * j), b = *(const f32x4*)(sh + 4 * lane + 256 * j);
        const f32x4 h = v[j] * (a + 1.0f) + b; u32x2 w; w.x = cvt_pk_bf16(h[0], h[1]); w.y = cvt_pk_bf16(h[2], h[3]);
        *(u32x2*)(hrow + 4 * lane + 256 * j) = w; }
}

__device__ __forceinline__ void phase0b(Ctx& F) {
    const int gw = F.bx * NWAVES + F.wave, NGW = F.G * NWAVES;
    const float* mod = (const float*)(F.ws + WS_MOD);
    bf16_t* H = (bf16_t*)(F.ws + WS_H);
    for (int row = gw; row < NT; row += NGW) {
        const float* xr = row < NPROMPT ? F.in[0] + (size_t)row * D : F.in[1] + (size_t)(row - NPROMPT) * D;
        f32x4 v[4];
#pragma unroll
        for (int j = 0; j < 4; ++j) v[j] = *(const f32x4*)(xr + 4 * F.lane + 256 * j);
        ln_row(v, F.in[8], F.in[9], F.lane);
#pragma unroll
        for (int j = 0; j < 4; ++j) *(f32x4*)(F.out + (size_t)row * D + 4 * F.lane + 256 * j) = v[j];
        const float* mb = mod + (size_t)batch_of(row) * 6144;
        store_mod_row(v, mb, mb + 1024, H + (size_t)row * D, F.lane);
    }
}

__device__ __forceinline__ void phase_attn(Ctx& F, int l) {
    const bf16_t* Z = (const bf16_t*)(F.ws + WS_Z);
    bf16_t* YA = (bf16_t*)(F.ws + WS_YA);
    bf16_t* YB = (bf16_t*)(F.ws + WS_YB);
    const float* biasr = (const float*)(F.ws + WS_BIAS);
    LAS unsigned char* Ks = F.lds;
    LAS unsigned char* Vt = F.lds + 27648;
    LAS float* bt = (LAS float*)(F.lds + 53248);
    const int lane = F.lane, tid = F.tid;
    for (int au = F.bx; au < 1040; au += F.G) {
        const bool isS = au >= 1024;
        const int kv = au & 1;
        const int b = isS ? ((au - 1024) >> 1) : (au >> 7);
        const int n = isS ? 0 : ((au & 127) >> 1);
        __syncthreads();
        for (int i = tid; i < 1024; i += NTHREADS) bt[i] = biasr[(kv * 4 + (i >> 8)) * 256 + (i & 255)];
#pragma unroll
        for (int jj = 0; jj < 3; ++jj) {
            const int p = tid + NTHREADS * jj, key = p >> 3, ds = p & 7;
            u32x4 kq = (u32x4){0u, 0u, 0u, 0u}, vq = (u32x4){0u, 0u, 0u, 0u};
            if (!isS) {
                const int t = n * 64 + key - 128;
                if (t >= 0) { const bf16_t* zr = Z + (size_t)(b * 4096 + t) * INW + kv * 64 + ds * 8; kq = *(const u32x4*)(zr + 512); vq = *(const u32x4*)(zr + 640); }
            } else if (key < 128) {
                const size_t o = ((size_t)((l * 8 + b) * 128 + key) * 2 + kv) * 64 + ds * 8;
                const f32x4 k0 = *(const f32x4*)(F.in[4] + o), k1 = *(const f32x4*)(F.in[4] + o + 4), v0 = *(const f32x4*)(F.in[5] + o), v1 = *(const f32x4*)(F.in[5] + o + 4);
                kq.x = cvt_pk_bf16(k0[0], k0[1]); kq.y = cvt_pk_bf16(k0[2], k0[3]); kq.z = cvt_pk_bf16(k1[0], k1[1]); kq.w = cvt_pk_bf16(k1[2], k1[3]);
                vq.x = cvt_pk_bf16(v0[0], v0[1]); vq.y = cvt_pk_bf16(v0[2], v0[3]); vq.z = cvt_pk_bf16(v1[0], v1[1]); vq.w = cvt_pk_bf16(v1[2], v1[3]);
            } else {
                const bf16_t* zr = Z + (size_t)(NPROMPT + b * 64 + key - 128) * INW + kv * 64 + ds * 8; kq = *(const u32x4*)(zr + 512); vq = *(const u32x4*)(zr + 640);
            }
            *(LAS u32x4*)(Ks + key * 144 + ds * 16) = kq;
            LAS unsigned short* vp = (LAS unsigned short*)Vt + (ds * 8) * 200 + key;
            vp[0 * 200] = (unsigned short)(vq.x & 0xffffu); vp[1 * 200] = (unsigned short)(vq.x >> 16);
            vp[2 * 200] = (unsigned short)(vq.y & 0xffffu); vp[3 * 200] = (unsigned short)(vq.y >> 16);
            vp[4 * 200] = (unsigned short)(vq.z & 0xffffu); vp[5 * 200] = (unsigned short)(vq.z >> 16);
            vp[6 * 200] = (unsigned short)(vq.w & 0xffffu); vp[7 * 200] = (unsigned short)(vq.w >> 16);
        }
        __syncthreads();
        const int g = F.wave >> 1, qi = (F.wave & 1) * 32 + (lane & 31), hh = lane >> 5, head = kv * 4 + g;
        const int qrow = isS ? NPROMPT + b * 64 + qi : b * 4096 + n * 64 + qi;
        bf16x8 Qf[4];
#pragma unroll
        for (int ks = 0; ks < 4; ++ks) Qf[ks] = *(const bf16x8*)(Z + (size_t)qrow * INW + head * 64 + ks * 16 + hh * 8);
        f32x16 S[6];
#pragma unroll
        for (int kb = 0; kb < 6; ++kb) {
#pragma unroll
            for (int j = 0; j < 16; ++j) S[kb][j] = 0.f;
#pragma unroll
            for (int ks = 0; ks < 4; ++ks) {
                const bf16x8 A = *(const LAS bf16x8*)(Ks + (kb * 32 + (lane & 31)) * 144 + (ks * 16 + hh * 8) * 2);
                S[kb] = __builtin_amdgcn_mfma_f32_32x32x16_bf16(A, Qf[ks], S[kb], 0, 0, 0);
            }
        }
        const float sinkv = F.in[14][l * 8 + head];
        float mx = sinkv;
        const int kmin = isS ? 0 : (128 - n * 64);
#pragma unroll
        for (int kb = 0; kb < 6; ++kb)
#pragma unroll
            for (int j = 0; j < 16; ++j) {
                const int key = kb * 32 + 8 * (j >> 2) + 4 * hh + (j & 3);
                float sv = S[kb][j] * 0.125f + bt[g * 256 + key - qi + 63];
                sv = key >= kmin ? sv : -1e30f;
                S[kb][j] = sv; mx = fmaxf(mx, sv);
            }
        mx = fmaxf(mx, __shfl_xor(mx, 32));
        float sum = 0.f;
#pragma unroll
        for (int kb = 0; kb < 6; ++kb)
#pragma unroll
            for (int j = 0; j < 16; ++j) { const float p = __expf(S[kb][j] - mx); S[kb][j] = p; sum += p; }
        sum += __shfl_xor(sum, 32);
        sum += __expf(sinkv - mx);
        const float inv = 1.0f / sum;
        f32x16 O[2];
#pragma unroll
        for (int db = 0; db < 2; ++db)
#pragma unroll
            for (int j = 0; j < 16; ++j) O[db][j] = 0.f;
#pragma unroll
        for (int kb = 0; kb < 6; ++kb)
#pragma unroll
            for (int s2 = 0; s2 < 2; ++s2) {
                union { bf16x8 v; unsigned u[4]; } P;
#pragma unroll
                for (int q = 0; q < 4; ++q) P.u[q] = cvt_pk_bf16(S[kb][8 * s2 + 2 * q], S[kb][8 * s2 + 2 * q + 1]);
#pragma unroll
                for (int db = 0; db < 2; ++db) {
                    const LAS unsigned char* vb = Vt + (db * 32 + (lane & 31)) * 400 + (kb * 32 + 16 * s2 + 4 * hh) * 2;
                    union { bf16x8 v; u32x2 h[2]; } Vf;
                    Vf.h[0] = *(const LAS u32x2*)vb; Vf.h[1] = *(const LAS u32x2*)(vb + 16);
                    O[db] = __builtin_amdgcn_mfma_f32_32x32x16_bf16(Vf.v, P.v, O[db], 0, 0, 0);
                }
            }
        bf16_t* orow = YA + (size_t)qrow * 512 + head * 64 + 4 * hh;
#pragma unroll
        for (int db = 0; db < 2; ++db)
#pragma unroll
            for (int jq = 0; jq < 4; ++jq) {
                u32x2 w; w.x = cvt_pk_bf16(O[db][4 * jq] * inv, O[db][4 * jq + 1] * inv); w.y = cvt_pk_bf16(O[db][4 * jq + 2] * inv, O[db][4 * jq + 3] * inv);
                *(u32x2*)(orow + db * 32 + 8 * jq) = w;
            }
    }
    const int gw = F.bx * NWAVES + F.wave, NGW = F.G * NWAVES;
    const float* cw = F.in[15] + (size_t)l * 3 * 512 + 8 * lane;
    float w0[8], w1[8], w2[8];
#pragma unroll
    for (int e = 0; e < 8; ++e) { w0[e] = cw[e]; w1[e] = cw[512 + e]; w2[e] = cw[1024 + e]; }
    for (int row = gw; row < NT; row += NGW) {
        const bool isS = row >= NPROMPT; const int b = isS ? ((row - NPROMPT) >> 6) : (row >> 12), t = isS ? ((row - NPROMPT) & 63) : (row & 4095);
        const bf16_t* zr = Z + (size_t)row * INW + 8 * lane;
        const u32x4 cb = *(const u32x4*)(zr + 768);
        float u[3][8];
#pragma unroll
        for (int d = 0; d < 3; ++d) {
            if (t - d >= 0) {
                const bf16_t* zz = zr - (size_t)d * INW; const u32x4 cc = *(const u32x4*)(zz + 1280), cx = *(const u32x4*)(zz + 1792);
                u[d][0] = bf_lo(cc.x) * bf_lo(cx.x); u[d][1] = bf_hi(cc.x) * bf_hi(cx.x); u[d][2] = bf_lo(cc.y) * bf_lo(cx.y); u[d][3] = bf_hi(cc.y) * bf_hi(cx.y);
                u[d][4] = bf_lo(cc.z) * bf_lo(cx.z); u[d][5] = bf_hi(cc.z) * bf_hi(cx.z); u[d][6] = bf_lo(cc.w) * bf_lo(cx.w); u[d][7] = bf_hi(cc.w) * bf_hi(cx.w);
            } else if (isS) {
                const float* hp = F.in[6] + ((size_t)(l * 8 + b) * 2 + (2 + t - d)) * 512 + 8 * lane;
                const f32x4 h0 = *(const f32x4*)hp, h1 = *(const f32x4*)(hp + 4);
#pragma unroll
                for (int e = 0; e < 4; ++e) { u[d][e] = h0[e]; u[d][4 + e] = h1[e]; }
            } else {
#pragma unroll
                for (int e = 0; e < 8; ++e) u[d][e] = 0.f;
            }
        }
        const float cbf[8] = {bf_lo(cb.x), bf_hi(cb.x), bf_lo(cb.y), bf_hi(cb.y), bf_lo(cb.z), bf_hi(cb.z), bf_lo(cb.w), bf_hi(cb.w)};
        float y[8];
#pragma unroll
        for (int e = 0; e < 8; ++e) y[e] = cbf[e] * (w0[e] * u[2][e] + w1[e] * u[1][e] + w2[e] * u[0][e]);
        u32x4 w; w.x = cvt_pk_bf16(y[0], y[1]); w.y = cvt_pk_bf16(y[2], y[3]); w.z = cvt_pk_bf16(y[4], y[5]); w.w = cvt_pk_bf16(y[6], y[7]);
        *(u32x4*)(YB + (size_t)row * 512 + 8 * lane) = w;
        const int tl = isS ? 62 : 4094;
        if (t >= tl) {
            float* o = F.out + (isS ? OCS : OCP) + ((size_t)(l * 8 + b) * 2 + (t - tl)) * 512 + 8 * lane;
            *(f32x4*)o = (f32x4){u[0][0], u[0][1], u[0][2], u[0][3]}; *(f32x4*)(o + 4) = (f32x4){u[0][4], u[0][5], u[0][6], u[0][7]};
        }
    }
}

__device__ __forceinline__ void phase_ln_router(Ctx& F, int l) {
    float* X = F.out; unsigned char* H8 = (unsigned char*)(F.ws + WS_H8);
    const float* mod = (const float*)(F.ws + WS_MOD) + (size_t)l * 16 * 6144;
    unsigned* cnt = (unsigned*)(F.ws + WS_CNT) + l * 2048;
    unsigned* tok = (unsigned*)(F.ws + WS_TOK); float* gate = (float*)(F.ws + WS_GATE); unsigned* slot = (unsigned*)(F.ws + WS_SLOT);
    const float* Wr = F.in[21] + (size_t)l * 1024 * 32;
    LAS float* hf = (LAS float*)F.lds;
    LAS unsigned* hist = (LAS unsigned*)(F.lds + 139264); LAS unsigned* hbase = hist + 32;
    const int lane = F.lane, w = F.wave;
    for (int tile = F.bx; tile < NT / 32; tile += F.G) {
        __syncthreads();
        if (F.tid < 32) hist[F.tid] = 0u;
        for (int rr = 0; rr < 4; ++rr) {
            const int rl = w * 4 + rr, row = tile * 32 + rl;
            f32x4 v[4];
#pragma unroll
            for (int j = 0; j < 4; ++j) v[j] = *(const f32x4*)(X + (size_t)row * D + 4 * lane + 256 * j);
            ln_row(v, F.in[19] + l * D, F.in[20] + l * D, lane);
#pragma unroll
            for (int j = 0; j < 4; ++j) *(f32x4*)(X + (size_t)row * D + 4 * lane + 256 * j) = v[j];
            const float* mb = mod + (size_t)batch_of(row) * 6144;
#pragma unroll
            for (int j = 0; j < 4; ++j) { const f32x4 a = *(const f32x4*)(mb + 4096 + 4 * lane + 256 * j), b = *(const f32x4*)(mb + 3072 + 4 * lane + 256 * j);
                const f32x4 h = v[j] * (a + 1.0f) + b;
                *(unsigned*)(H8 + (size_t)row * D + 4 * lane + 256 * j) = pk4_fp8(h[0], h[1], h[2], h[3]);
                LAS float* hp = hf + rl * 1025 + 4 * lane + 256 * j; hp[0] = h[0]; hp[1] = h[1]; hp[2] = h[2]; hp[3] = h[3]; }
        }
        __syncthreads();
        f32x16 acc;
#pragma unroll
        for (int j = 0; j < 16; ++j) acc[j] = 0.f;
        {
            const LAS float* ap = hf + (lane & 31) * 1025 + 128 * w + (lane >> 5);
            const float* bp = Wr + (size_t)(128 * w) * 32 + lane;
#pragma unroll 8
            for (int s = 0; s < 64; ++s) acc = __builtin_amdgcn_mfma_f32_32x32x2f32(ap[2 * s], bp[64 * s], acc, 0, 0, 0);
        }
        __syncthreads();
        LAS float* red = hf;
#pragma unroll
        for (int j = 0; j < 16; ++j) red[(w * 32 + 8 * (j >> 2) + 4 * (lane >> 5) + (j & 3)) * 33 + (lane & 31)] = acc[j];
        __syncthreads();
        int e_sel[4]; float g_sel[4]; unsigned loc[4];
#pragma unroll
        for (int rr = 0; rr < 4; ++rr) {
            const int tk = w * 4 + rr;
            float val = -INFINITY;
            if (lane < 32) { float sacc = F.in[22][l * 32 + lane];
#pragma unroll
                for (int ww = 0; ww < 8; ++ww) sacc += red[(ww * 32 + tk) * 33 + lane];
                val = sacc; }
            float tv[4]; int te[4];
#pragma unroll
            for (int it = 0; it < 4; ++it) {
                float bv = val; int bi = lane;
#pragma unroll
                for (int off = 32; off >= 1; off >>= 1) { const float ov = __shfl_xor(bv, off); const int oi = __shfl_xor(bi, off);
                    if (ov > bv || (ov == bv && oi < bi)) { bv = ov; bi = oi; } }
                tv[it] = bv; te[it] = bi; if (lane == bi) val = -INFINITY;
            }
            const float e1 = __expf(tv[1] - tv[0]), e2 = __expf(tv[2] - tv[0]), e3 = __expf(tv[3] - tv[0]);
            const float rs = 1.0f / (1.0f + e1 + e2 + e3);
            e_sel[rr] = lane == 0 ? te[0] : lane == 1 ? te[1] : lane == 2 ? te[2] : te[3];
            g_sel[rr] = (lane == 0 ? 1.0f : lane == 1 ? e1 : lane == 2 ? e2 : e3) * rs;
            loc[rr] = 0u;
            if (lane < 4) loc[rr] = atomicAdd((unsigned*)&hist[e_sel[rr]], 1u);
        }
        __syncthreads();
        if (F.tid < 32) { const unsigned hcount = hist[F.tid]; hbase[F.tid] = hcount ? atomicAdd(cnt + F.tid * 64, hcount) : 0u; }
        __syncthreads();
        if (lane < 4) {
#pragma unroll
            for (int rr = 0; rr < 4; ++rr) {
                const int row = tile * 32 + w * 4 + rr, e = e_sel[rr]; const unsigned rank = hbase[e] + loc[rr];
                tok[(size_t)e * NT + rank] = (unsigned)row; gate[(size_t)e * NT + rank] = g_sel[rr]; slot[(size_t)row * 4 + lane] = ((unsigned)e << 24) | rank;
            }
        }
    }
}

__device__ __forceinline__ void build_blk(Ctx& F, int l) {
    LAS int* blk = (LAS int*)(F.lds + LDS_BLK);
    const unsigned* cnt = (const unsigned*)(F.ws + WS_CNT) + l * 2048;
    __syncthreads();
    if (F.tid == 0) { int s = 0; for (int e = 0; e < 32; ++e) { blk[e] = s; s += ((int)cnt[e * 64] + 255) >> 8; } blk[32] = s; }
    __syncthreads();
}

__device__ __forceinline__ void phase_combine(Ctx& F, int l) {
    const LAS int* blk = (const LAS int*)(F.lds + LDS_BLK);
    float* X = F.out; bf16_t* H = (bf16_t*)(F.ws + WS_H); const bf16_t* YS = (const bf16_t*)(F.ws + WS_YS);
    const unsigned* slot = (const unsigned*)(F.ws + WS_SLOT);
    const float* mod = (const float*)(F.ws + WS_MOD);
    const int gw = F.bx * NWAVES + F.wave, NGW = F.G * NWAVES, lane = F.lane;
    for (int row = gw; row < NT; row += NGW) {
        f32x4 ff[4];
#pragma unroll
        for (int j = 0; j < 4; ++j) ff[j] = (f32x4){0.f, 0.f, 0.f, 0.f};
#pragma unroll
        for (int k = 0; k < 4; ++k) {
            const unsigned s = slot[(size_t)row * 4 + k]; const int e = (int)(s >> 24), rank = (int)(s & 0xffffffu);
            const bf16_t* yr = YS + ((size_t)blk[e] * 256 + rank) * D + 4 * lane;
#pragma unroll
            for (int j = 0; j < 4; ++j) { const u32x2 wv = *(const u32x2*)(yr + 256 * j); ff[j][0] += bf_lo(wv.x); ff[j][1] += bf_hi(wv.x); ff[j][2] += bf_lo(wv.y); ff[j][3] += bf_hi(wv.y); }
        }
        const int bi = batch_of(row);
        const float* mb = mod + (size_t)(l * 16 + bi) * 6144;
        f32x4 v[4];
#pragma unroll
        for (int j = 0; j < 4; ++j) { const f32x4 x = *(const f32x4*)(X + (size_t)row * D + 4 * lane + 256 * j), g2 = *(const f32x4*)(mb + 5120 + 4 * lane + 256 * j);
            v[j] = x * ALPHA + (g2 + 1.0f) * ff[j]; }
        ln_row(v, F.in[27] + l * D, F.in[28] + l * D, lane);
#pragma unroll
        for (int j = 0; j < 4; ++j) *(f32x4*)(X + (size_t)row * D + 4 * lane + 256 * j) = v[j];
        if (l == 0) { const float* mn = mod + (size_t)(16 + bi) * 6144; store_mod_row(v, mn, mn + 1024, H + (size_t)row * D, lane); }
    }
}

#ifndef PH_MASK
#define PH_MASK 0xFFFF
#endif
#define PH(b) ((PH_MASK >> (b)) & 1)
#define RELOAD() do { int t_ = threadIdx.x; asm volatile("" : "+v"(t_)); F.tid = t_; F.lane = t_ & 63; F.wave = __builtin_amdgcn_readfirstlane(t_ >> 6); \
    unsigned z_; asm volatile("s_mov_b32 %0, 0" : "=s"(z_)); F.in = p.in; F.out = p.out + z_; F.ws = p.ws + z_; } while (0)
#define LAYER_BODY(l) do { \
          \
        RELOAD(); \
        if (PH(2)) { \
            pg8::SchedDense S; S.init(NT, INW, D, F.G, F.bx, (const bf16_t*)(F.ws + WS_WIN) + (size_t)l * INW * D); \
            pg8::EpiZ E{(bf16_t*)(F.ws + WS_Z), F.in[13] + l * INW, F.out, l}; \
            pg8::gemm_phase<false>(F.lds, (const char*)(F.ws + WS_H), D, S, E); \
        } \
        grid.sync(); \
        RELOAD(); \
        if (PH(3)) phase_attn(F, l); \
        grid.sync(); \
          \
        RELOAD(); \
        if (PH(4)) { \
            pg8::SchedDense S; S.init(NT, D, 512, F.G, F.bx, (const bf16_t*)(F.ws + WS_WOA) + (size_t)l * D * 512); \
            pg8::EpiT1 E{(float*)(F.ws + WS_T1), (const bf16_t*)(F.ws + WS_Z)}; \
            pg8::gemm_phase<false>(F.lds, (const char*)(F.ws + WS_YA), 512, S, E); \
        } \
        RELOAD(); \
        if (PH(5)) { \
            pg8::SchedDense S; S.init(NT, D, 512, F.G, F.bx, (const bf16_t*)(F.ws + WS_WOB) + (size_t)l * D * 512); \
            pg8::EpiMix E{(const float*)(F.ws + WS_T1), (const bf16_t*)(F.ws + WS_Z), (bf16_t*)(F.ws + WS_MIX)}; \
            pg8::gemm_phase<false>(F.lds, (const char*)(F.ws + WS_YB), 512, S, E); \
        } \
        grid.sync(); \
          \
        RELOAD(); \
        if (PH(6)) { \
            pg8::SchedDense S; S.init(NT, D, D, F.G, F.bx, (const bf16_t*)(F.ws + WS_WO) + (size_t)l * D * D); \
            pg8::EpiX E{F.out, (const float*)(F.ws + WS_MOD) + (size_t)l * 16 * 6144}; \
            pg8::gemm_phase<false>(F.lds, (const char*)(F.ws + WS_MIX), D, S, E); \
        } \
        grid.sync(); \
        RELOAD(); \
        if (PH(7)) phase_ln_router(F, l); \
        grid.sync(); \
          \
        RELOAD(); \
        build_blk(F, l); \
        if (PH(8)) { \
            LAS int* blk = (LAS int*)(F.lds + LDS_BLK); \
            LAS unsigned short* idx = (LAS unsigned short*)(F.lds + LDS_IDX); \
            pg8::SchedMoE<true> S; S.init(blk, idx, 8, 512, F.G, F.bx, (const unsigned char*)(F.ws + WS_WGU) + (size_t)l * 32 * 2048 * D, (size_t)2048 * D); \
            const unsigned* cnt = (const unsigned*)(F.ws + WS_CNT) + l * 2048; const unsigned* tok = (const unsigned*)(F.ws + WS_TOK); \
            for (int i = 0; i < MAXU; ++i) { pg8::Unit u; if (!S.next(i, u)) break; \
                if (F.tid < 256) { int rank = (u.pm - blk[u.e]) * 256 + F.tid; const int ce = (int)cnt[u.e * 64]; rank = rank < ce ? rank : ce - 1; \
                    idx[i * 256 + F.tid] = (unsigned short)tok[(size_t)u.e * NT + rank]; } } \
            __syncthreads(); \
            pg8::EpiAct E{(unsigned char*)(F.ws + WS_ACT), F.in[24] + (size_t)l * 32 * 2048}; \
            pg8::gemm_phase<true>(F.lds, (const char*)(F.ws + WS_H8), 512, S, E); \
        } \
        grid.sync(); \
          \
        RELOAD(); \
        if (PH(9)) { \
            LAS int* blk = (LAS int*)(F.lds + LDS_BLK); \
            LAS unsigned short* idx = (LAS unsigned short*)(F.lds + LDS_IDX); \
            pg8::SchedMoE<false> S; S.init(blk, idx, 4, 512, F.G, F.bx, (const unsigned char*)(F.ws + WS_WDN) + (size_t)l * 32 * D * D, (size_t)D * D); \
            pg8::EpiYs E{(bf16_t*)(F.ws + WS_YS), F.in[26] + (size_t)l * 32 * D, (const float*)(F.ws + WS_GATE), (const unsigned*)(F.ws + WS_CNT) + l * 2048, blk}; \
            pg8::gemm_phase<true>(F.lds, (const char*)(F.ws + WS_ACT), 512, S, E); \
        } \
        grid.sync(); \
        RELOAD(); \
        if (PH(10)) phase_combine(F, l); \
        if (l == 0) grid.sync(); \
 \
    } while (0)
__global__ void __launch_bounds__(NTHREADS, 2) fwd_megakernel(Params p) {
    extern __shared__ __attribute__((aligned(16))) unsigned char lds_raw[];
    cg::grid_group grid = cg::this_grid();
    Ctx F;
    F.lds = (LAS unsigned char*)lds_raw;
    F.G = gridDim.x; F.bx = blockIdx.x;
    RELOAD();
    if (PH(0)) phase0a(F);
    grid.sync();
    RELOAD();
    if (PH(1)) phase0b(F);
    grid.sync();

    LAYER_BODY(0);
    LAYER_BODY(1);
}

extern "C" void kernel_launch(void* const* d_in, const int* in_sizes, int n_in, void* d_out, int out_size, void* d_ws, size_t ws_size, hipStream_t stream) {
    static int grid = 0;
    if (grid == 0) {
        if (n_in != 29 || ws_size < WS_END) { fprintf(stderr, "kernel_launch: unexpected n_in %d / ws_size %zu (need %zu)\n", n_in, ws_size, (size_t)WS_END); grid = -1; return; }
        int dev = 0, cus = 0, per_cu = 0;
        hipGetDevice(&dev);
        hipDeviceGetAttribute(&cus, hipDeviceAttributeMultiprocessorCount, dev);
        if (hipFuncSetAttribute((const void*)fwd_megakernel, hipFuncAttributeMaxDynamicSharedMemorySize, LDS_BYTES) != hipSuccess) { fprintf(stderr, "kernel_launch: hipFuncSetAttribute failed\n"); grid = -1; return; }
        if (hipOccupancyMaxActiveBlocksPerMultiprocessor(&per_cu, (const void*)fwd_megakernel, NTHREADS, LDS_BYTES) != hipSuccess || per_cu < 1) { fprintf(stderr, "kernel_launch: occupancy query says %d blocks per CU\n", per_cu); per_cu = 1; }
        (void)hipGetLastError();
        grid = cus;
        if (grid != 256) fprintf(stderr, "kernel_launch: note: %d CUs (built for 256)\n", grid);
    }
    if (grid < 0) return;
    hipMemsetAsync((char*)d_ws, 0, WS_ZERO_BYTES, stream);
    Params p{};
    for (int i = 0; i < 29; ++i) p.in[i] = (const float*)d_in[i];
    p.out = (float*)d_out; p.ws = (unsigned char*)d_ws;
    void* args[] = {&p};
    hipError_t e = hipLaunchCooperativeKernel((const void*)fwd_megakernel, dim3(grid), dim3(NTHREADS), args, LDS_BYTES, stream);
    if (e != hipSuccess) fprintf(stderr, "kernel_launch: cooperative launch failed: %s (grid %d)\n", hipGetErrorString(e), grid);
}
```

```cpp
#include <hip/hip_runtime.h>
#include <hip/hip_cooperative_groups.h>
#include <cstdio>
#include <cstdint>
namespace cg = cooperative_groups;

#define LAS __attribute__((address_space(3)))
typedef unsigned short bf16_t;
typedef short bf16x8 __attribute__((ext_vector_type(8)));
typedef float f32x4 __attribute__((ext_vector_type(4)));
typedef float f32x16 __attribute__((ext_vector_type(16)));
typedef unsigned u32x4 __attribute__((ext_vector_type(4)));
typedef unsigned u32x2 __attribute__((ext_vector_type(2)));
typedef int i32x4 __attribute__((ext_vector_type(4)));
typedef int i32x8 __attribute__((ext_vector_type(8)));

constexpr int D = 1024, NPROMPT = 32768, NT = 33280, INW = 4352, NEXP = 32;
constexpr float ALPHA = 1.41421356237f, LN_EPS = 1e-5f;
constexpr int NWAVES = 8, NTHREADS = 512;
constexpr int LDS_BYTES = 147456;
constexpr int LDS_BLK = 131072;
constexpr int LDS_IDX = 131072 + 256;
constexpr int MAXU = 24;
constexpr size_t OKP = 34078720, OVP = 34340864, OCP = 34603008, OKS = 34619392, OVS = 34881536, OCS = 35143680;
constexpr size_t MiB = 1u << 20;
constexpr size_t WS_CNT = 0;
constexpr size_t WS_BAR = 16384;
constexpr size_t WS_MOD = 65536;
constexpr size_t WS_ZERO_BYTES = 1 * MiB;
constexpr size_t WS_BIAS = 1 * MiB;
constexpr size_t WS_SLOT = 2 * MiB;
constexpr size_t WS_TOK = 3 * MiB;
constexpr size_t WS_GATE = 8 * MiB;
constexpr size_t WS_WIN = 16 * MiB;
constexpr size_t WS_WOA = 34 * MiB;
constexpr size_t WS_WOB = 36 * MiB;
constexpr size_t WS_WO = 38 * MiB;
constexpr size_t WS_WGU = 48 * MiB;
constexpr size_t WS_WDN = 304 * MiB;
constexpr size_t WS_H = 432 * MiB;
constexpr size_t WS_H8 = 1600 * MiB;
constexpr size_t WS_Z = 498 * MiB;
constexpr size_t WS_YA = 776 * MiB;
constexpr size_t WS_YB = 810 * MiB;
constexpr size_t WS_T1 = 844 * MiB;
constexpr size_t WS_MIX = 976 * MiB;
constexpr size_t WS_ACT = 1042 * MiB;
constexpr size_t WS_YS = 1320 * MiB;
constexpr size_t WS_END = 1634 * MiB;

struct Params { const float* in[29]; float* out; unsigned char* ws; };

__device__ __forceinline__ unsigned cvt_pk_bf16(float lo, float hi) { unsigned r; asm volatile("v_cvt_pk_bf16_f32 %0, %1, %2" : "=v"(r) : "v"(lo), "v"(hi)); return r; }
__device__ __forceinline__ unsigned pk4_fp8(float a, float b, float c, float d) { unsigned w = 0u; w = __builtin_amdgcn_cvt_pk_fp8_f32(a, b, w, false); w = __builtin_amdgcn_cvt_pk_fp8_f32(c, d, w, true); return w; }
__device__ __forceinline__ float bf_lo(unsigned w) { return __uint_as_float(w << 16); }
__device__ __forceinline__ float bf_hi(unsigned w) { return __uint_as_float(w & 0xffff0000u); }
__device__ __forceinline__ float sigmoidf_(float x) { return __builtin_amdgcn_rcpf(1.0f + __expf(-x)); }
__device__ __forceinline__ float wave_sum(float v) {
#pragma unroll
    for (int o = 1; o < 64; o <<= 1) v += __shfl_xor(v, o);
    return v;
}
__device__ __forceinline__ int batch_of(int row) { return row < NPROMPT ? (row >> 12) : 8 + ((row - NPROMPT) >> 6); }

namespace pg8 {
constexpr int BM = 256, BK = 64, HALF = 128, HTB = HALF * BK * 2, NXCD = 8, WGM = 8;
__device__ __forceinline__ int lds_byte(int r, int c) { const int st = (r >> 4) * 2 + (c >> 5), rr = r & 15, cc = c & 31, ob = rr * 64 + cc * 2; return st * 1024 + (ob ^ (((ob >> 9) & 1) << 5)); }
__device__ __forceinline__ void stage_rc(int b, int& R, int& C) { const int st = b / 1024, sb = b % 1024, swz = sb ^ (((sb >> 9) & 1) << 5); R = (st >> 1) * 16 + swz / 64; C = (st & 1) * 32 + (swz % 64) / 2; }
__device__ __forceinline__ int perm32(int rho) { const int n = rho >> 4, i = rho & 15; return 8 * (i >> 2) + 4 * n + (i & 3); }

struct Unit { int pm, pn, e; const char* b; };

struct SchedDense {
    int nM, nN, nwg, G, c; const char* Bt; size_t tstepB;
    __device__ __forceinline__ void init(int M, int N, int K, int G_, int c_, const void* Bt_) { nM = M / BM; nN = N / BM; nwg = nM * nN; G = G_; c = c_; Bt = (const char*)Bt_; tstepB = (size_t)BM * K * 2; }
    __device__ __forceinline__ bool next(int i, Unit& u) const {
        const long L = (long)i * G + c; if (L >= nwg) return false;
        int wgid = (int)L; { const int q = nwg / NXCD, r = nwg % NXCD, xcd = wgid % NXCD, off = wgid / NXCD; wgid = (xcd < r ? xcd * (q + 1) : r * (q + 1) + (xcd - r) * q) + off; }
        const int nig = WGM * nN, gid = wgid / nig, fm = gid * WGM, gsz = (nM - fm) < WGM ? (nM - fm) : WGM;
        u.pm = fm + ((wgid % nig) % gsz); u.pn = (wgid % nig) / gsz; u.e = 0; u.b = Bt + (size_t)u.pn * tstepB; return true;
    }
    __device__ __forceinline__ unsigned rowidx(int, const Unit& u, int r) const { return (unsigned)(u.pm * BM + r); }
};
template <bool GATHER> struct SchedMoE {
    const LAS int* blk; const LAS unsigned short* idx; int NB, RBX, NPN, NXs, perx, cx, cj; const char* Bt; size_t estep, tstepB;
    __device__ __forceinline__ void init(const LAS int* blk_, const LAS unsigned short* idx_, int NPN_, int K, int G, int c, const void* Bt_, size_t estep_) {
        blk = blk_; idx = idx_; NB = blk_[32]; NPN = NPN_; Bt = (const char*)Bt_; estep = estep_; tstepB = (size_t)BM * K * 2;
        if ((G & 7) == 0) { NXs = 8; perx = G >> 3; cx = c & 7; cj = c >> 3; } else { NXs = 1; perx = G; cx = 0; cj = c; }
        RBX = (NB + NXs - 1) / NXs;
    }
    __device__ __forceinline__ bool next(int i, Unit& u) const {
        const int j = i * perx + cj, rbl = j / NPN; if (rbl >= RBX) return false;
        const int rb = cx * RBX + rbl; if (rb >= NB) return false;
        int e = 0;
        for (int q = 1; q < 32; ++q) e = (blk[q] <= rb) ? q : e;
        u.pm = rb; u.pn = j - rbl * NPN; u.e = e; u.b = Bt + (size_t)e * estep + (size_t)u.pn * tstepB; return true;
    }
    __device__ __forceinline__ unsigned rowidx(int ui, const Unit& u, int r) const { if (GATHER) return (unsigned)idx[ui * 256 + r]; return (unsigned)(u.pm * BM + r); }
};

template <bool FP8, unsigned ASCALE, class Epi, class Sched>
__device__ __forceinline__ void gemm_phase(LAS unsigned char* lds, const char* Abase, const int K, const Sched& S, const Epi& E) {
    int tid_ = threadIdx.x; asm volatile("" : "+v"(tid_));
    const int tid = tid_, wid = __builtin_amdgcn_readfirstlane(tid >> 6), lane = tid & 63, wr = wid >> 2, wc = wid & 3, fr = lane & 15, fq = lane >> 4;
    int nt_ = K / BK; asm volatile("" : "+s"(nt_)); const int nt = nt_;
    unsigned voffB[2]; int RA[2], CA[2];
#pragma unroll
    for (int i = 0; i < 2; ++i) { int R, C; stage_rc(tid * 16 + i * 8192, R, C); const int Rb = Epi::PERM ? ((R & ~31) + perm32(R & 31)) : R;
        voffB[i] = (unsigned)(Rb * K + C) * 2u; RA[i] = R; CA[i] = C * 2; }
    const size_t kstep = (size_t)(BK * 2);
    const size_t hstep = (size_t)HALF * K * 2;
    const unsigned ldsw = (unsigned)wid * 1024u;
    const unsigned rowb = (unsigned)K * 2u;
    const int aoff = lds_byte(wr * 64 + fr, fq * 8), boff = lds_byte(wc * 32 + fr, fq * 8);
#define PG8_SA(b, h) (((b) * 2 + (h)) * HTB)
#define PG8_SB(b, h) ((4 + (b) * 2 + (h)) * HTB)
#define PG8_STAGE(bufoff, gbase, voff) do { _Pragma("unroll") for (int _i = 0; _i < 2; ++_i) \
        __builtin_amdgcn_global_load_lds((const unsigned*)((const char*)(gbase) + (voff)[_i]), (LAS unsigned*)(lds + (bufoff) + ldsw + _i * 8192), 16, 0, 0); } while (0)
#define PG8_LDA(dst, b, h) do { _Pragma("unroll") for (int m = 0; m < 4; ++m) _Pragma("unroll") for (int k = 0; k < 2; ++k) dst[m][k] = *(const LAS bf16x8*)(lds + PG8_SA(b, h) + aoff + m * 2048 + k * 1024); } while (0)
#define PG8_LDB(dst, b, h) do { _Pragma("unroll") for (int n = 0; n < 2; ++n) _Pragma("unroll") for (int k = 0; k < 2; ++k) dst[n][k] = *(const LAS bf16x8*)(lds + PG8_SB(b, h) + boff + n * 2048 + k * 1024); } while (0)
#define PG8_MMA(ai, bj, At, Bt) do { __builtin_amdgcn_s_setprio(1); _Pragma("unroll") for (int m = 0; m < 4; ++m) _Pragma("unroll") for (int n = 0; n < 2; ++n) { \
        if constexpr (FP8) { \
            const i32x8 wf_ = __builtin_shufflevector((i32x4)Bt[n][0], (i32x4)Bt[n][1], 0, 1, 2, 3, 4, 5, 6, 7), af_ = __builtin_shufflevector((i32x4)At[m][0], (i32x4)At[m][1], 0, 1, 2, 3, 4, 5, 6, 7); \
            acc[ai][bj][m][n] = __builtin_amdgcn_mfma_scale_f32_16x16x128_f8f6f4(wf_, af_, acc[ai][bj][m][n], 0, 0, 0, 0x79797979, 0, (int)ASCALE); \
        } else { _Pragma("unroll") for (int k = 0; k < 2; ++k) \
            acc[ai][bj][m][n] = __builtin_amdgcn_mfma_f32_16x16x32_bf16(Bt[n][k], At[m][k], acc[ai][bj][m][n], 0, 0, 0); } } \
        __builtin_amdgcn_s_setprio(0); } while (0)
#define PG8_WAIT_V(n) asm volatile("s_waitcnt vmcnt(" #n ")" ::: "memory")
#define PG8_WAIT_L(n) asm volatile("s_waitcnt lgkmcnt(" #n ")" ::: "memory")
#define PG8_BAR __builtin_amdgcn_s_barrier()
#define PG8_SCHED __builtin_amdgcn_sched_barrier(0)
#define PG8_LOADVA(ui_, u_) do { _Pragma("unroll") for (int _h = 0; _h < 2; ++_h) _Pragma("unroll") for (int _i = 0; _i < 2; ++_i) \
        vA[_h][_i] = S.rowidx((ui_), (u_), _h * HALF + RA[_i]) * rowb + (unsigned)CA[_i]; } while (0)
    Unit cur, nxt; int ui = 0;
    if (!S.next(0, cur)) return;
    f32x4 acc[2][2][4][2];
#pragma unroll
    for (int a = 0; a < 2; ++a)
#pragma unroll
        for (int b = 0; b < 2; ++b)
#pragma unroll
            for (int m = 0; m < 4; ++m)
#pragma unroll
                for (int n = 0; n < 2; ++n) acc[a][b][m][n] = (f32x4){0.f, 0.f, 0.f, 0.f};
    bf16x8 At[4][2], B0[2][2], B1[2][2];
    unsigned vA[2][2];
    PG8_LOADVA(0, cur);
    const char* cB = cur.b;
    PG8_STAGE(PG8_SB(0, 0), cB, voffB); PG8_STAGE(PG8_SB(0, 1), cB + hstep, voffB); PG8_STAGE(PG8_SA(0, 0), Abase, vA[0]); PG8_STAGE(PG8_SA(0, 1), Abase, vA[1]);
    if (wr == 1) PG8_BAR;
    PG8_WAIT_V(2); PG8_BAR;
    PG8_STAGE(PG8_SB(1, 0), cB + kstep, voffB); PG8_STAGE(PG8_SA(1, 0), Abase + kstep, vA[0]); PG8_STAGE(PG8_SB(1, 1), cB + hstep + kstep, voffB);
    PG8_WAIT_V(6); PG8_BAR;
    for (;;) {
        const bool has_next = S.next(ui + 1, nxt);
        const char* nB = has_next ? nxt.b : cB;
#pragma unroll 1
        for (int t = 0; t < nt; t += 2) {
            const bool last = (t == nt - 2);
            const char* a1 = Abase + (size_t)(t + 1) * kstep;
            const char* a2 = last ? Abase : Abase + (size_t)(t + 2) * kstep;
            const char* b2 = last ? nB : cB + (size_t)(t + 2) * kstep;
            const char* a3 = a2 + kstep; const char* b3 = b2 + kstep;
            PG8_LDB(B0, 0, 0); PG8_LDB(B1, 0, 1); PG8_SCHED; PG8_LDA(At, 0, 0); PG8_STAGE(PG8_SA(1, 1), a1, vA[1]);
            if (last && has_next) { PG8_LOADVA(ui + 1, nxt); }
            PG8_WAIT_V(8); PG8_WAIT_L(0); PG8_BAR; PG8_MMA(0, 0, At, B0); PG8_MMA(0, 1, At, B1); PG8_BAR; PG8_SCHED;
            PG8_LDA(At, 0, 1); PG8_STAGE(PG8_SB(0, 0), b2, voffB); PG8_STAGE(PG8_SB(0, 1), b2 + hstep, voffB); PG8_STAGE(PG8_SA(0, 0), a2, vA[0]);
            PG8_WAIT_V(8); PG8_WAIT_L(0); PG8_BAR; PG8_MMA(1, 0, At, B0); PG8_MMA(1, 1, At, B1); PG8_BAR; PG8_SCHED;
            PG8_LDB(B0, 1, 0); PG8_LDB(B1, 1, 1); PG8_SCHED; PG8_LDA(At, 1, 0); PG8_STAGE(PG8_SA(0, 1), a2, vA[1]);
            PG8_WAIT_V(8); PG8_WAIT_L(0); PG8_BAR; PG8_MMA(0, 0, At, B0); PG8_MMA(0, 1, At, B1); PG8_BAR; PG8_SCHED;
            PG8_LDA(At, 1, 1); PG8_STAGE(PG8_SB(1, 0), b3, voffB); PG8_STAGE(PG8_SB(1, 1), b3 + hstep, voffB); PG8_STAGE(PG8_SA(1, 0), a3, vA[0]);
            PG8_WAIT_V(8); PG8_WAIT_L(0); PG8_BAR; PG8_MMA(1, 0, At, B0); PG8_MMA(1, 1, At, B1); PG8_BAR; PG8_SCHED;
        }
        if (wr == 0) PG8_BAR;
        E(acc, cur, wr, wc, fr, fq);
        if (!has_next) break;
#pragma unroll
        for (int a = 0; a < 2; ++a)
#pragma unroll
            for (int b = 0; b < 2; ++b)
#pragma unroll
                for (int m = 0; m < 4; ++m)
#pragma unroll
                    for (int n = 0; n < 2; ++n) acc[a][b][m][n] = (f32x4){0.f, 0.f, 0.f, 0.f};
        cur = nxt; cB = nB; ++ui;
        if (wr == 1) PG8_BAR;
    }
    PG8_WAIT_V(0);
    PG8_BAR;
#undef PG8_SA
#undef PG8_SB
#undef PG8_STAGE
#undef PG8_LDA
#undef PG8_LDB
#undef PG8_MMA
#undef PG8_WAIT_V
#undef PG8_WAIT_L
#undef PG8_BAR
#undef PG8_SCHED
#undef PG8_LOADVA
}

typedef f32x4 Acc[2][2][4][2];

struct EpiZ {
    static constexpr bool PERM = true;
    bf16_t* Z; const float* bias; float* out; int l;
    __device__ __forceinline__ void operator()(const Acc& acc, const Unit& u, int wr, int wc, int fr, int fq) const {
        const int row0 = u.pm * 256 + wr * 64 + fr, col0 = u.pn * 256 + wc * 32 + 8 * fq;
        f32x4 bv[2][2];
#pragma unroll
        for (int bj = 0; bj < 2; ++bj)
#pragma unroll
            for (int n = 0; n < 2; ++n) bv[bj][n] = *(const f32x4*)(bias + col0 + bj * 128 + 4 * n);
#pragma unroll
        for (int ai = 0; ai < 2; ++ai)
#pragma unroll
            for (int m = 0; m < 4; ++m) {
                const int row = row0 + ai * 128 + m * 16;
                bf16_t* rowp = Z + (size_t)row * INW + col0;
                float* ko = nullptr; float* vo = nullptr;
                if (u.pn == 2) {
                    if (row < NPROMPT) { const int t = row & 4095; if (t >= 3968) { const size_t o = ((size_t)(l * 8 + (row >> 12)) * 128 + (t - 3968)) * 128 + wc * 32 + 8 * fq; ko = out + OKP + o; vo = out + OVP + o; } }
                    else { const int rr = row - NPROMPT; const size_t o = ((size_t)(l * 8 + (rr >> 6)) * 128 + 64 + (rr & 63)) * 128 + wc * 32 + 8 * fq; ko = out + OKS + o; vo = out + OVS + o; }
                }
#pragma unroll
                for (int bj = 0; bj < 2; ++bj) {
                    const f32x4 v0 = acc[ai][bj][m][0] + bv[bj][0], v1 = acc[ai][bj][m][1] + bv[bj][1];
                    u32x4 w; w.x = cvt_pk_bf16(v0[0], v0[1]); w.y = cvt_pk_bf16(v0[2], v0[3]); w.z = cvt_pk_bf16(v1[0], v1[1]); w.w = cvt_pk_bf16(v1[2], v1[3]);
                    *(u32x4*)(rowp + bj * 128) = w;
                    float* o = bj == 0 ? ko : vo;
                    if (o) { *(f32x4*)o = v0; *(f32x4*)(o + 4) = v1; }
                }
                asm volatile("" ::: "memory");
            }
    }
};
struct EpiT1 {
    static constexpr bool PERM = true;
    float* T1; const bf16_t* Z;
    __device__ __forceinline__ void operator()(const Acc& acc, const Unit& u, int wr, int wc, int fr, int fq) const {
        const int row0 = u.pm * 256 + wr * 64 + fr, col0 = u.pn * 256 + wc * 32 + 8 * fq;
#pragma unroll
        for (int ai = 0; ai < 2; ++ai)
#pragma unroll
            for (int m = 0; m < 4; ++m) {
                const int row = row0 + ai * 128 + m * 16;
#pragma unroll
                for (int bj = 0; bj < 2; ++bj) {
                    const u32x4 g = *(const u32x4*)(Z + (size_t)row * INW + 2304 + col0 + bj * 128);
                    f32x4 v0 = acc[ai][bj][m][0], v1 = acc[ai][bj][m][1];
                    v0[0] *= sigmoidf_(bf_lo(g.x)); v0[1] *= sigmoidf_(bf_hi(g.x)); v0[2] *= sigmoidf_(bf_lo(g.y)); v0[3] *= sigmoidf_(bf_hi(g.y));
                    v1[0] *= sigmoidf_(bf_lo(g.z)); v1[1] *= sigmoidf_(bf_hi(g.z)); v1[2] *= sigmoidf_(bf_lo(g.w)); v1[3] *= sigmoidf_(bf_hi(g.w));
                    float* o = T1 + (size_t)row * D + col0 + bj * 128;
                    *(f32x4*)o = v0; *(f32x4*)(o + 4) = v1;
                    asm volatile("" ::: "memory");
                }
            }
    }
};
struct EpiMix {
    static constexpr bool PERM = true;
    const float* T1; const bf16_t* Z; unsigned char* MIX;
    __device__ __forceinline__ void operator()(const Acc& acc, const Unit& u, int wr, int wc, int fr, int fq) const {
        const int row0 = u.pm * 256 + wr * 64 + fr, col0 = u.pn * 256 + wc * 32 + 8 * fq;
#pragma unroll
        for (int ai = 0; ai < 2; ++ai)
#pragma unroll
            for (int m = 0; m < 4; ++m) {
                const int row = row0 + ai * 128 + m * 16;
#pragma unroll
                for (int bj = 0; bj < 2; ++bj) {
                    const u32x4 g = *(const u32x4*)(Z + (size_t)row * INW + 3328 + col0 + bj * 128);
                    const float* tp = T1 + (size_t)row * D + col0 + bj * 128;
                    f32x4 v0 = *(const f32x4*)tp, v1 = *(const f32x4*)(tp + 4);
                    const f32x4 a0 = acc[ai][bj][m][0], a1 = acc[ai][bj][m][1];
                    v0[0] += a0[0] * sigmoidf_(bf_lo(g.x)); v0[1] += a0[1] * sigmoidf_(bf_hi(g.x)); v0[2] += a0[2] * sigmoidf_(bf_lo(g.y)); v0[3] += a0[3] * sigmoidf_(bf_hi(g.y));
                    v1[0] += a1[0] * sigmoidf_(bf_lo(g.z)); v1[1] += a1[1] * sigmoidf_(bf_hi(g.z)); v1[2] += a1[2] * sigmoidf_(bf_lo(g.w)); v1[3] += a1[3] * sigmoidf_(bf_hi(g.w));
                    u32x2 w; w.x = pk4_fp8(v0[0], v0[1], v0[2], v0[3]); w.y = pk4_fp8(v1[0], v1[1], v1[2], v1[3]);
                    *(u32x2*)(MIX + (size_t)row * D + col0 + bj * 128) = w;
                    asm volatile("" ::: "memory");
                }
            }
    }
};
struct EpiX {
    static constexpr bool PERM = false;
    float* X; const float* modl;
    __device__ __forceinline__ void operator()(const Acc& acc, const Unit& u, int wr, int wc, int fr, int fq) const {
        const int row0 = u.pm * 256 + wr * 64 + fr, col0 = u.pn * 256 + wc * 32 + 4 * fq;
#pragma unroll
        for (int ai = 0; ai < 2; ++ai)
#pragma unroll
            for (int m = 0; m < 4; ++m) {
                const int row = row0 + ai * 128 + m * 16;
                const float* gp = modl + (size_t)batch_of(row) * 6144 + 2048 + col0;
                float* xp = X + (size_t)row * D + col0;
#pragma unroll
                for (int bj = 0; bj < 2; ++bj)
#pragma unroll
                    for (int n = 0; n < 2; ++n) {
                        const f32x4 g = *(const f32x4*)(gp + bj * 128 + n * 16);
                        const f32x4 x = *(const f32x4*)(xp + bj * 128 + n * 16);
                        *(f32x4*)(xp + bj * 128 + n * 16) = x * ALPHA + (g + 1.0f) * acc[ai][bj][m][n];
                    }
                asm volatile("" ::: "memory");
            }
    }
};
struct EpiAct {
    static constexpr bool PERM = true;
    unsigned char* ACT; const float* bgu;
    __device__ __forceinline__ void operator()(const Acc& acc, const Unit& u, int wr, int wc, int fr, int fq) const {
        const int row0 = u.pm * 256 + wr * 64 + fr, c0 = u.pn * 128 + wc * 32 + 8 * fq;
        const float* bp = bgu + (size_t)u.e * 2048 + c0;
        f32x4 bg[2], bl[2];
#pragma unroll
        for (int n = 0; n < 2; ++n) { bg[n] = *(const f32x4*)(bp + 4 * n); bl[n] = *(const f32x4*)(bp + 1024 + 4 * n); }
#pragma unroll
        for (int ai = 0; ai < 2; ++ai)
#pragma unroll
            for (int m = 0; m < 4; ++m) {
                const int row = row0 + ai * 128 + m * 16;
                float a[8];
#pragma unroll
                for (int n = 0; n < 2; ++n)
#pragma unroll
                    for (int j = 0; j < 4; ++j) {
                        float g = acc[ai][0][m][n][j] + bg[n][j], li = acc[ai][1][m][n][j] + bl[n][j];
                        g = fminf(g, 7.0f); li = fminf(fmaxf(li, -7.0f), 7.0f);
                        a[n * 4 + j] = g * sigmoidf_(1.702f * g) * (li + 1.0f);
                    }
                u32x2 w; w.x = pk4_fp8(a[0], a[1], a[2], a[3]); w.y = pk4_fp8(a[4], a[5], a[6], a[7]);
                *(u32x2*)(ACT + (size_t)row * D + c0) = w;
                asm volatile("" ::: "memory");
            }
    }
};
struct EpiYs {
    static constexpr bool PERM = true;
    bf16_t* YS; const float* bdn; const float* gate; const unsigned* cnt; const LAS int* blk;
    __device__ __forceinline__ void operator()(const Acc& acc, const Unit& u, int wr, int wc, int fr, int fq) const {
        const int r0 = wr * 64 + fr, col0 = u.pn * 256 + wc * 32 + 8 * fq;
        const int rank0 = (u.pm - blk[u.e]) * 256; const int ce = (int)cnt[u.e * 64];
        f32x4 bv[2][2];
#pragma unroll
        for (int bj = 0; bj < 2; ++bj)
#pragma unroll
            for (int n = 0; n < 2; ++n) bv[bj][n] = *(const f32x4*)(bdn + (size_t)u.e * D + col0 + bj * 128 + 4 * n);
#pragma unroll
        for (int ai = 0; ai < 2; ++ai)
#pragma unroll
            for (int m = 0; m < 4; ++m) {
                const int r = r0 + ai * 128 + m * 16, rank = rank0 + r;
                const float gt = rank < ce ? gate[(size_t)u.e * NT + rank] : 0.0f;
                bf16_t* rowp = YS + (size_t)(u.pm * 256 + r) * D + col0;
#pragma unroll
                for (int bj = 0; bj < 2; ++bj) {
                    const f32x4 v0 = (acc[ai][bj][m][0] + bv[bj][0]) * gt, v1 = (acc[ai][bj][m][1] + bv[bj][1]) * gt;
                    u32x4 w; w.x = cvt_pk_bf16(v0[0], v0[1]); w.y = cvt_pk_bf16(v0[2], v0[3]); w.z = cvt_pk_bf16(v1[0], v1[1]); w.w = cvt_pk_bf16(v1[2], v1[3]);
                    *(u32x4*)(rowp + bj * 128) = w;
                }
                asm volatile("" ::: "memory");
            }
    }
};
}


#define XB_TMO      128
#define XB_XCNT(j)  (256  + 64 * (j))
#define XB_XSUB(j)  (1280 + 64 * (j))
#define XB_XGEN(j)  (2304 + 64 * (j))
#define XB_TOP      3328
#define XB_TOPGEN   3392
#define XCD_BAR_WORDS 3456
#define XB_SPIN_CAP (1u << 21)
__device__ __forceinline__ unsigned xb_ld(unsigned* p)              { return __hip_atomic_load(p, __ATOMIC_RELAXED, __HIP_MEMORY_SCOPE_AGENT); }
__device__ __forceinline__ unsigned xb_add(unsigned* p, unsigned v) { return __hip_atomic_fetch_add(p, v, __ATOMIC_RELAXED, __HIP_MEMORY_SCOPE_AGENT); }
__device__ __forceinline__ unsigned xb_xcc_id() { return (unsigned)__builtin_amdgcn_s_getreg((3 << 11) | 20) & 0xFu; }
#define XB_SPIN(cond, bar) do { unsigned _sp = 0; while (cond) { __builtin_amdgcn_s_sleep(1); \
    if ((++_sp & 255u) == 0u) { if (xb_ld(&(bar)[XB_TMO])) break; if (_sp > XB_SPIN_CAP) { atomicAdd(&(bar)[XB_TMO], 1u); break; } } } } while (0)
struct XcdBarrier { unsigned* bar; unsigned x; volatile LAS unsigned* st; };
__device__ __forceinline__ XcdBarrier xcd_barrier_post(unsigned* bar, volatile LAS unsigned* st) {
    XcdBarrier b; b.bar = bar; b.x = xb_xcc_id(); b.st = st;
    if (threadIdx.x == 0) (void)xb_add(&bar[XB_XCNT(b.x)], 1u);
    return b;
}
__device__ __forceinline__ void xcd_barrier_complete(unsigned* bar, unsigned x, unsigned& nloc, unsigned& nx) {
    const unsigned G = gridDim.x * gridDim.y * gridDim.z;
    unsigned sum, cnt, mine, sp = 0u;
    for (;;) {
        sum = 0u; cnt = 0u; mine = 0u;
#pragma unroll
        for (unsigned j = 0; j < 16; ++j) { const unsigned c = xb_ld(&bar[XB_XCNT(j)]); sum += c; cnt += (c > 0u) ? 1u : 0u; mine = (j == x) ? c : mine; }
        if (sum == G) break;
        __builtin_amdgcn_s_sleep(1);
        if ((++sp & 255u) == 0u) { if (xb_ld(&bar[XB_TMO])) break; if (sp > XB_SPIN_CAP) { atomicAdd(&bar[XB_TMO], 1u); break; } }
    }
    nloc = mine > 0u ? mine : 1u; nx = cnt > 0u ? cnt : 1u;
}
__device__ __forceinline__ void xcd_barrier(const XcdBarrier& b) {
    asm volatile("s_waitcnt vmcnt(0)" ::: "memory");
    __syncthreads();
    if (threadIdx.x == 0) {
        unsigned* bar = b.bar;
        __builtin_amdgcn_s_waitcnt(0);
        unsigned nloc = b.st[0], nx = b.st[1];
        if (nloc == 0u) { xcd_barrier_complete(bar, b.x, nloc, nx); b.st[0] = nloc; b.st[1] = nx; }
        const unsigned old = xb_add(&bar[XB_XSUB(b.x)], 1u);
        const unsigned gen = old / nloc;
        if (old + 1u == (gen + 1u) * nloc) {
            __builtin_amdgcn_fence(__ATOMIC_RELEASE, "agent");
            asm volatile("s_waitcnt vmcnt(0)" ::: "memory");
            const unsigned og = xb_add(&bar[XB_TOP], 1u);
            const unsigned tg = og / nx;
            if (og + 1u == (tg + 1u) * nx) xb_add(&bar[XB_TOPGEN], 1u);
            else XB_SPIN(xb_ld(&bar[XB_TOPGEN]) == tg, bar);
            __builtin_amdgcn_fence(__ATOMIC_ACQUIRE, "agent");
            xb_add(&bar[XB_XGEN(b.x)], 1u);
            asm volatile("s_waitcnt vmcnt(0)" ::: "memory");
        } else {
            XB_SPIN(xb_ld(&bar[XB_XGEN(b.x)]) == gen, bar);
            __builtin_amdgcn_fence(__ATOMIC_ACQUIRE, "agent");
            asm volatile("s_waitcnt vmcnt(0)" ::: "memory");
        }
    }
    __syncthreads();
}

struct Ctx {
    LAS unsigned char* lds; int tid, lane, wave, G, bx;
    const float* const* in; float* out; unsigned char* ws;
};
#define LDS_WAIT() asm volatile("s_waitcnt lgkmcnt(0)" ::: "memory")

template <bool F8>
__device__ __forceinline__ void transpose64(const float* W, int K, int N, unsigned char* WT, int kind, LAS unsigned char* scr, int item, int lane) {
    const int nblk = N >> 6, kb = item / nblk, nb = item - kb * nblk, k0 = kb * 64, n0 = nb * 64;
    const float* src = W + (size_t)k0 * N + n0 + lane;
    float v[64];
#pragma unroll
    for (int kk = 0; kk < 64; ++kk) v[kk] = src[(size_t)kk * N];
    if (F8) {
        LAS unsigned char* wp = scr + lane * 80;
#pragma unroll
        for (int q = 0; q < 4; ++q) { u32x4 o;
            o.x = pk4_fp8(64.f * v[16 * q + 0], 64.f * v[16 * q + 1], 64.f * v[16 * q + 2], 64.f * v[16 * q + 3]);
            o.y = pk4_fp8(64.f * v[16 * q + 4], 64.f * v[16 * q + 5], 64.f * v[16 * q + 6], 64.f * v[16 * q + 7]);
            o.z = pk4_fp8(64.f * v[16 * q + 8], 64.f * v[16 * q + 9], 64.f * v[16 * q + 10], 64.f * v[16 * q + 11]);
            o.w = pk4_fp8(64.f * v[16 * q + 12], 64.f * v[16 * q + 13], 64.f * v[16 * q + 14], 64.f * v[16 * q + 15]);
            *(LAS u32x4*)(wp + q * 16) = o; }
        LDS_WAIT(); asm volatile("" ::: "memory");
        const int c = lane & 3;
#pragma unroll
        for (int j = 0; j < 4; ++j) { const int nl = (lane >> 2) + 16 * j; const u32x4 o = *(const LAS u32x4*)(scr + nl * 80 + c * 16);
            const int n = n0 + nl; int dr = n;
            if (kind == 1) { dr = (n < 1024) ? ((n >> 7) * 256 + (n & 127)) : (((n - 1024) >> 7) * 256 + 128 + (n & 127)); }
            *(u32x4*)(WT + (size_t)dr * K + k0 + c * 16) = o; }
    } else {
        LAS unsigned char* wp = scr + lane * 144;
#pragma unroll
        for (int q = 0; q < 8; ++q) { u32x4 o;
            o.x = cvt_pk_bf16(v[8 * q + 0], v[8 * q + 1]); o.y = cvt_pk_bf16(v[8 * q + 2], v[8 * q + 3]); o.z = cvt_pk_bf16(v[8 * q + 4], v[8 * q + 5]); o.w = cvt_pk_bf16(v[8 * q + 6], v[8 * q + 7]);
            *(LAS u32x4*)(wp + q * 16) = o; }
        LDS_WAIT(); asm volatile("" ::: "memory");
        const int c = lane & 7;
#pragma unroll
        for (int j = 0; j < 8; ++j) { const int nl = (lane >> 3) + 8 * j; const u32x4 o = *(const LAS u32x4*)(scr + nl * 144 + c * 16);
            const int n = n0 + nl; int dr = n;
            if (kind == 1) { dr = (n < 1024) ? ((n >> 7) * 256 + (n & 127)) : (((n - 1024) >> 7) * 256 + 128 + (n & 127)); }
            *(u32x4*)(WT + ((size_t)dr * K + k0) * 2 + c * 16) = o; }
    }
    LDS_WAIT(); asm volatile("" ::: "memory");
}

__device__ __forceinline__ int rel_bucket(int rel) {
    const int n = rel < 0 ? -rel : rel;
    int v;
    if (n < 8) v = n;
    else { const float nf = (float)n; int large = 8 + (int)(logf(nf / 8.0f) / 2.7725887298583984f * 8.0f); v = large < 15 ? large : 15; }
    return (rel > 0 ? 16 : 0) + v;
}

__device__ __forceinline__ void phase0a(Ctx& F) {
    LAS float* scr = (LAS float*)(F.lds + F.wave * 16384);
    const int gw = F.bx * NWAVES + F.wave, NGW = F.G * NWAVES;
    unsigned char* ws = F.ws;
    {
        float* mod = (float*)(ws + WS_MOD);
        for (int it = gw; it < 2 * 96 * 8; it += NGW) {
            const int kc = it & 7, cgp = (it >> 3) % 96, l = it / (8 * 96), k0 = kc * 128, n0 = cgp * 64;
#pragma unroll 4
            for (int j = 0; j < 32; ++j) { const int idx = F.lane + 64 * j, r = idx >> 7, kk = idx & 127;
                const float c = r < 8 ? F.in[2][r * 1024 + k0 + kk] : F.in[3][(r - 8) * 1024 + k0 + kk];
                scr[kk * 16 + r] = c * sigmoidf_(c); }
            LDS_WAIT(); asm volatile("" ::: "memory");
            float a[16];
#pragma unroll
            for (int r = 0; r < 16; ++r) a[r] = 0.f;
            const float* wp = F.in[10] + ((size_t)l * 1024 + k0) * 6144 + n0 + F.lane;
#pragma unroll 16
            for (int kk = 0; kk < 128; ++kk) {
                const float w = wp[(size_t)kk * 6144];
                const LAS f32x4* sp = (const LAS f32x4*)(scr + kk * 16);
                const f32x4 s0 = sp[0], s1 = sp[1], s2 = sp[2], s3 = sp[3];
                a[0] += s0[0] * w; a[1] += s0[1] * w; a[2] += s0[2] * w; a[3] += s0[3] * w;
                a[4] += s1[0] * w; a[5] += s1[1] * w; a[6] += s1[2] * w; a[7] += s1[3] * w;
                a[8] += s2[0] * w; a[9] += s2[1] * w; a[10] += s2[2] * w; a[11] += s2[3] * w;
                a[12] += s3[0] * w; a[13] += s3[1] * w; a[14] += s3[2] * w; a[15] += s3[3] * w;
            }
            const float bb = (kc == 0) ? F.in[11][l * 6144 + n0 + F.lane] : 0.f;
#pragma unroll
            for (int r = 0; r < 16; ++r) unsafeAtomicAdd(mod + ((size_t)(l * 16 + r)) * 6144 + n0 + F.lane, a[r] + bb);
            LDS_WAIT(); asm volatile("" ::: "memory");
        }
    }
    if (F.bx == 0) {
        float* bt = (float*)(ws + WS_BIAS);
        for (int i = F.tid; i < 8 * 256; i += NTHREADS) { const int h = i >> 8, ri = i & 255; const int rel = ri - 191;
            bt[i] = (ri < 255) ? F.in[7][rel_bucket(rel) * 8 + h] : 0.f; }
    }
    for (int i = F.bx * NTHREADS + F.tid; i < 2 * 8 * 64 * 128; i += F.G * NTHREADS) {
        const int lb = i >> 13, rem = i & 8191;
        F.out[OKS + (size_t)lb * 16384 + rem] = F.in[4][(size_t)lb * 16384 + 8192 + rem];
        F.out[OVS + (size_t)lb * 16384 + rem] = F.in[5][(size_t)lb * 16384 + 8192 + rem];
    }
    LAS unsigned char* scrb = F.lds + F.wave * 16384;
    constexpr int I_GU = 32768, I_DN = 16384, I_IN = 2176, I_O = 512, I_OA = 256, I_OB = 256;
    constexpr int NITEMS = I_GU + I_DN + I_IN + I_O + I_OA + I_OB;
    for (int it = gw; it < NITEMS; it += NGW) {
        int r = it;
        if (r < I_GU) { const int m = r >> 9; transpose64<true>(F.in[23] + (size_t)m * 1024 * 2048, 1024, 2048, ws + WS_WGU + (size_t)m * 2048 * 1024, 1, scrb, r & 511, F.lane); continue; } r -= I_GU;
        if (r < I_DN) { const int m = r >> 8; transpose64<true>(F.in[25] + (size_t)m * 1024 * 1024, 1024, 1024, ws + WS_WDN + (size_t)m * 1024 * 1024, 0, scrb, r & 255, F.lane); continue; } r -= I_DN;
        if (r < I_IN) { const int m = r / 1088; transpose64<false>(F.in[12] + (size_t)m * 1024 * INW, 1024, INW, ws + WS_WIN + (size_t)m * INW * 1024 * 2, 0, scrb, r % 1088, F.lane); continue; } r -= I_IN;
        if (r < I_O) { const int m = r >> 8; transpose64<true>(F.in[18] + (size_t)m * 1024 * 1024, 1024, 1024, ws + WS_WO + (size_t)m * 1024 * 1024, 0, scrb, r & 255, F.lane); continue; } r -= I_O;
        if (r < I_OA) { const int m = r >> 7; transpose64<true>(F.in[16] + (size_t)m * 512 * 1024, 512, 1024, ws + WS_WOA + (size_t)m * 1024 * 512, 0, scrb, r & 127, F.lane); continue; } r -= I_OA;
        { const int m = r >> 7; transpose64<true>(F.in[17] + (size_t)m * 512 * 1024, 512, 1024, ws + WS_WOB + (size_t)m * 1024 * 512, 0, scrb, r & 127, F.lane); }
    }
}

__device__ __forceinline__ void ln_row(f32x4 (&v)[4], const float* g, const float* b, int lane) {
    float s = 0.f;
#pragma unroll
    for (int j = 0; j < 4; ++j) s += (v[j][0] + v[j][1]) + (v[j][2] + v[j][3]);
    const float mean = wave_sum(s) * (1.0f / D); float s2 = 0.f;
#pragma unroll
    for (int j = 0; j < 4; ++j) { v[j] = v[j] - mean; s2 += (v[j][0] * v[j][0] + v[j][1] * v[j][1]) + (v[j][2] * v[j][2] + v[j][3] * v[j][3]); }
    const float rstd = 1.0f / sqrtf(wave_sum(s2) * (1.0f / D) + LN_EPS);
#pragma unroll
    for (int j = 0; j < 4; ++j) { const f32x4 gg = *(const f32x4*)(g + 4 * lane + 256 * j), bb = *(const f32x4*)(b + 4 * lane + 256 * j); v[j] = v[j] * rstd * gg + bb; }
}
__device__ __forceinline__ void store_mod_row(const f32x4 (&v)[4], const float* sh, const float* sc, bf16_t* hrow, int lane) {
#pragma unroll
    for (int j = 0; j < 4; ++j) { const f32x4 a = *(const f32x4*)(sc + 4 * lane + 256 * j), b = *(const f32x4*)(sh + 4 * lane + 256 * j);
        const f32x4 h = v[j] * (a + 1.0f) + b; u32x2 w; w.x = cvt_pk_bf16(h[0], h[1]); w.y = cvt_pk_bf16(h[2], h[3]);
        *(u32x2*)(hrow + 4 * lane + 256 * j) = w; }
}

__device__ __forceinline__ void phase0b(Ctx& F) {
    const int gw = F.bx * NWAVES + F.wave, NGW = F.G * NWAVES;
    const float* mod = (const float*)(F.ws + WS_MOD);
    bf16_t* H = (bf16_t*)(F.ws + WS_H);
    for (int row = gw; row < NT; row += NGW) {
        const float* xr = row < NPROMPT ? F.in[0] + (size_t)row * D : F.in[1] + (size_t)(row - NPROMPT) * D;
        f32x4 v[4];
#pragma unroll
        for (int j = 0; j < 4; ++j) v[j] = *(const f32x4*)(xr + 4 * F.lane + 256 * j);
        ln_row(v, F.in[8], F.in[9], F.lane);
#pragma unroll
        for (int j = 0; j < 4; ++j) *(f32x4*)(F.out + (size_t)row * D + 4 * F.lane + 256 * j) = v[j];
        const float* mb = mod + (size_t)batch_of(row) * 6144;
        store_mod_row(v, mb, mb + 1024, H + (size_t)row * D, F.lane);
    }
}

__device__ __forceinline__ void phase_attn(Ctx& F, int l) {
    const bf16_t* Z = (const bf16_t*)(F.ws + WS_Z);
    unsigned char* YA = F.ws + WS_YA;
    unsigned char* YB = F.ws + WS_YB;
    const float* biasr = (const float*)(F.ws + WS_BIAS);
    LAS unsigned char* Ks = F.lds;
    LAS unsigned char* Vt = F.lds + 27648;
    LAS float* bt = (LAS float*)(F.lds + 53248);
    const int lane = F.lane, tid = F.tid;
    for (int au = F.bx; au < 1040; au += F.G) {
        const bool isS = au >= 1024;
        const int kv = au & 1;
        const int b = isS ? ((au - 1024) >> 1) : (au >> 7);
        const int n = isS ? 0 : ((au & 127) >> 1);
        __syncthreads();
        for (int i = tid; i < 1024; i += NTHREADS) bt[i] = biasr[(kv * 4 + (i >> 8)) * 256 + (i & 255)];
#pragma unroll
        for (int jj = 0; jj < 3; ++jj) {
            const int p = tid + NTHREADS * jj, key = p >> 3, ds = p & 7;
            u32x4 kq = (u32x4){0u, 0u, 0u, 0u}, vq = (u32x4){0u, 0u, 0u, 0u};
            if (!isS) {
                const int t = n * 64 + key - 128;
                if (t >= 0) { const bf16_t* zr = Z + (size_t)(b * 4096 + t) * INW + kv * 64 + ds * 8; kq = *(const u32x4*)(zr + 512); vq = *(const u32x4*)(zr + 640); }
            } else if (key < 128) {
                const size_t o = ((size_t)((l * 8 + b) * 128 + key) * 2 + kv) * 64 + ds * 8;
                const f32x4 k0 = *(const f32x4*)(F.in[4] + o), k1 = *(const f32x4*)(F.in[4] + o + 4), v0 = *(const f32x4*)(F.in[5] + o), v1 = *(const f32x4*)(F.in[5] + o + 4);
                kq.x = cvt_pk_bf16(k0[0], k0[1]); kq.y = cvt_pk_bf16(k0[2], k0[3]); kq.z = cvt_pk_bf16(k1[0], k1[1]); kq.w = cvt_pk_bf16(k1[2], k1[3]);
                vq.x = cvt_pk_bf16(v0[0], v0[1]); vq.y = cvt_pk_bf16(v0[2], v0[3]); vq.z = cvt_pk_bf16(v1[0], v1[1]); vq.w = cvt_pk_bf16(v1[2], v1[3]);
            } else {
                const bf16_t* zr = Z + (size_t)(NPROMPT + b * 64 + key - 128) * INW + kv * 64 + ds * 8; kq = *(const u32x4*)(zr + 512); vq = *(const u32x4*)(zr + 640);
            }
            *(LAS u32x4*)(Ks + key * 144 + ds * 16) = kq;
            LAS unsigned short* vp = (LAS unsigned short*)Vt + (ds * 8) * 200 + key;
            vp[0 * 200] = (unsigned short)(vq.x & 0xffffu); vp[1 * 200] = (unsigned short)(vq.x >> 16);
            vp[2 * 200] = (unsigned short)(vq.y & 0xffffu); vp[3 * 200] = (unsigned short)(vq.y >> 16);
            vp[4 * 200] = (unsigned short)(vq.z & 0xffffu); vp[5 * 200] = (unsigned short)(vq.z >> 16);
            vp[6 * 200] = (unsigned short)(vq.w & 0xffffu); vp[7 * 200] = (unsigned short)(vq.w >> 16);
        }
        __syncthreads();
        const int g = F.wave >> 1, qi = (F.wave & 1) * 32 + (lane & 31), hh = lane >> 5, head = kv * 4 + g;
        const int qrow = isS ? NPROMPT + b * 64 + qi : b * 4096 + n * 64 + qi;
        bf16x8 Qf[4];
#pragma unroll
        for (int ks = 0; ks < 4; ++ks) Qf[ks] = *(const bf16x8*)(Z + (size_t)qrow * INW + head * 64 + ks * 16 + hh * 8);
        f32x16 S[6];
#pragma unroll
        for (int kb = 0; kb < 6; ++kb) {
#pragma unroll
            for (int j = 0; j < 16; ++j) S[kb][j] = 0.f;
#pragma unroll
            for (int ks = 0; ks < 4; ++ks) {
                const bf16x8 A = *(const LAS bf16x8*)(Ks + (kb * 32 + (lane & 31)) * 144 + (ks * 16 + hh * 8) * 2);
                S[kb] = __builtin_amdgcn_mfma_f32_32x32x16_bf16(A, Qf[ks], S[kb], 0, 0, 0);
            }
        }
        const float sinkv = F.in[14][l * 8 + head];
        float mx = sinkv;
        const int kmin = isS ? 0 : (128 - n * 64);
#pragma unroll
        for (int kb = 0; kb < 6; ++kb)
#pragma unroll
            for (int j = 0; j < 16; ++j) {
                const int key = kb * 32 + 8 * (j >> 2) + 4 * hh + (j & 3);
                float sv = S[kb][j] * 0.125f + bt[g * 256 + key - qi + 63];
                sv = key >= kmin ? sv : -1e30f;
                S[kb][j] = sv; mx = fmaxf(mx, sv);
            }
        mx = fmaxf(mx, __shfl_xor(mx, 32));
        float sum = 0.f;
#pragma unroll
        for (int kb = 0; kb < 6; ++kb)
#pragma unroll
            for (int j = 0; j < 16; ++j) { const float p = __expf(S[kb][j] - mx); S[kb][j] = p; sum += p; }
        sum += __shfl_xor(sum, 32);
        sum += __expf(sinkv - mx);
        const float inv = 1.0f / sum;
        f32x16 O[2];
#pragma unroll
        for (int db = 0; db < 2; ++db)
#pragma unroll
            for (int j = 0; j < 16; ++j) O[db][j] = 0.f;
#pragma unroll
        for (int kb = 0; kb < 6; ++kb)
#pragma unroll
            for (int s2 = 0; s2 < 2; ++s2) {
                union { bf16x8 v; unsigned u[4]; } P;
#pragma unroll
                for (int q = 0; q < 4; ++q) P.u[q] = cvt_pk_bf16(S[kb][8 * s2 + 2 * q], S[kb][8 * s2 + 2 * q + 1]);
#pragma unroll
                for (int db = 0; db < 2; ++db) {
                    const LAS unsigned char* vb = Vt + (db * 32 + (lane & 31)) * 400 + (kb * 32 + 16 * s2 + 4 * hh) * 2;
                    union { bf16x8 v; u32x2 h[2]; } Vf;
                    Vf.h[0] = *(const LAS u32x2*)vb; Vf.h[1] = *(const LAS u32x2*)(vb + 16);
                    O[db] = __builtin_amdgcn_mfma_f32_32x32x16_bf16(Vf.v, P.v, O[db], 0, 0, 0);
                }
            }
        unsigned char* orow = YA + (size_t)qrow * 512 + head * 64 + 4 * hh; const float inv8 = inv * 8.0f;
#pragma unroll
        for (int db = 0; db < 2; ++db)
#pragma unroll
            for (int jq = 0; jq < 4; ++jq) {
                *(unsigned*)(orow + db * 32 + 8 * jq) = pk4_fp8(O[db][4 * jq] * inv8, O[db][4 * jq + 1] * inv8, O[db][4 * jq + 2] * inv8, O[db][4 * jq + 3] * inv8);
            }
    }
    const int gw = F.bx * NWAVES + F.wave, NGW = F.G * NWAVES;
    const float* cw = F.in[15] + (size_t)l * 3 * 512 + 8 * lane;
    float w0[8], w1[8], w2[8];
#pragma unroll
    for (int e = 0; e < 8; ++e) { w0[e] = cw[e]; w1[e] = cw[512 + e]; w2[e] = cw[1024 + e]; }
    for (int row = gw; row < NT; row += NGW) {
        const bool isS = row >= NPROMPT; const int b = isS ? ((row - NPROMPT) >> 6) : (row >> 12), t = isS ? ((row - NPROMPT) & 63) : (row & 4095);
        const bf16_t* zr = Z + (size_t)row * INW + 8 * lane;
        const u32x4 cb = *(const u32x4*)(zr + 768);
        float u[3][8];
#pragma unroll
        for (int d = 0; d < 3; ++d) {
            if (t - d >= 0) {
                const bf16_t* zz = zr - (size_t)d * INW; const u32x4 cc = *(const u32x4*)(zz + 1280), cx = *(const u32x4*)(zz + 1792);
                u[d][0] = bf_lo(cc.x) * bf_lo(cx.x); u[d][1] = bf_hi(cc.x) * bf_hi(cx.x); u[d][2] = bf_lo(cc.y) * bf_lo(cx.y); u[d][3] = bf_hi(cc.y) * bf_hi(cx.y);
                u[d][4] = bf_lo(cc.z) * bf_lo(cx.z); u[d][5] = bf_hi(cc.z) * bf_hi(cx.z); u[d][6] = bf_lo(cc.w) * bf_lo(cx.w); u[d][7] = bf_hi(cc.w) * bf_hi(cx.w);
            } else if (isS) {
                const float* hp = F.in[6] + ((size_t)(l * 8 + b) * 2 + (2 + t - d)) * 512 + 8 * lane;
                const f32x4 h0 = *(const f32x4*)hp, h1 = *(const f32x4*)(hp + 4);
#pragma unroll
                for (int e = 0; e < 4; ++e) { u[d][e] = h0[e]; u[d][4 + e] = h1[e]; }
            } else {
#pragma unroll
                for (int e = 0; e < 8; ++e) u[d][e] = 0.f;
            }
        }
        const float cbf[8] = {bf_lo(cb.x), bf_hi(cb.x), bf_lo(cb.y), bf_hi(cb.y), bf_lo(cb.z), bf_hi(cb.z), bf_lo(cb.w), bf_hi(cb.w)};
        float y[8];
#pragma unroll
        for (int e = 0; e < 8; ++e) y[e] = cbf[e] * (w0[e] * u[2][e] + w1[e] * u[1][e] + w2[e] * u[0][e]);
        u32x2 w; w.x = pk4_fp8(y[0], y[1], y[2], y[3]); w.y = pk4_fp8(y[4], y[5], y[6], y[7]);
        *(u32x2*)(YB + (size_t)row * 512 + 8 * lane) = w;
        const int tl = isS ? 62 : 4094;
        if (t >= tl) {
            float* o = F.out + (isS ? OCS : OCP) + ((size_t)(l * 8 + b) * 2 + (t - tl)) * 512 + 8 * lane;
            *(f32x4*)o = (f32x4){u[0][0], u[0][1], u[0][2], u[0][3]}; *(f32x4*)(o + 4) = (f32x4){u[0][4], u[0][5], u[0][6], u[0][7]};
        }
    }
}

__device__ __forceinline__ void phase_ln_router(Ctx& F, int l) {
    float* X = F.out; unsigned char* H8 = (unsigned char*)(F.ws + WS_H8);
    const float* mod = (const float*)(F.ws + WS_MOD) + (size_t)l * 16 * 6144;
    unsigned* cnt = (unsigned*)(F.ws + WS_CNT) + l * 2048;
    unsigned* tok = (unsigned*)(F.ws + WS_TOK); float* gate = (float*)(F.ws + WS_GATE); unsigned* slot = (unsigned*)(F.ws + WS_SLOT);
    const float* Wr = F.in[21] + (size_t)l * 1024 * 32;
    LAS float* hf = (LAS float*)F.lds;
    LAS unsigned* hist = (LAS unsigned*)(F.lds + 139264); LAS unsigned* hbase = hist + 32;
    const int lane = F.lane, w = F.wave;
    for (int tile = F.bx; tile < NT / 32; tile += F.G) {
        __syncthreads();
        if (F.tid < 32) hist[F.tid] = 0u;
        for (int rr = 0; rr < 4; ++rr) {
            const int rl = w * 4 + rr, row = tile * 32 + rl;
            f32x4 v[4];
#pragma unroll
            for (int j = 0; j < 4; ++j) v[j] = *(const f32x4*)(X + (size_t)row * D + 4 * lane + 256 * j);
            ln_row(v, F.in[19] + l * D, F.in[20] + l * D, lane);
#pragma unroll
            for (int j = 0; j < 4; ++j) *(f32x4*)(X + (size_t)row * D + 4 * lane + 256 * j) = v[j];
            const float* mb = mod + (size_t)batch_of(row) * 6144;
#pragma unroll
            for (int j = 0; j < 4; ++j) { const f32x4 a = *(const f32x4*)(mb + 4096 + 4 * lane + 256 * j), b = *(const f32x4*)(mb + 3072 + 4 * lane + 256 * j);
                const f32x4 h = v[j] * (a + 1.0f) + b;
                *(unsigned*)(H8 + (size_t)row * D + 4 * lane + 256 * j) = pk4_fp8(h[0], h[1], h[2], h[3]);
                LAS float* hp = hf + rl * 1025 + 4 * lane + 256 * j; hp[0] = h[0]; hp[1] = h[1]; hp[2] = h[2]; hp[3] = h[3]; }
        }
        __syncthreads();
        f32x16 acc;
#pragma unroll
        for (int j = 0; j < 16; ++j) acc[j] = 0.f;
        {
            const LAS float* ap = hf + (lane & 31) * 1025 + 128 * w + (lane >> 5);
            const float* bp = Wr + (size_t)(128 * w) * 32 + lane;
#pragma unroll 8
            for (int s = 0; s < 64; ++s) acc = __builtin_amdgcn_mfma_f32_32x32x2f32(ap[2 * s], bp[64 * s], acc, 0, 0, 0);
        }
        __syncthreads();
        LAS float* red = hf;
#pragma unroll
        for (int j = 0; j < 16; ++j) red[(w * 32 + 8 * (j >> 2) + 4 * (lane >> 5) + (j & 3)) * 33 + (lane & 31)] = acc[j];
        __syncthreads();
        int e_sel[4]; float g_sel[4]; unsigned loc[4];
#pragma unroll
        for (int rr = 0; rr < 4; ++rr) {
            const int tk = w * 4 + rr;
            float val = -INFINITY;
            if (lane < 32) { float sacc = F.in[22][l * 32 + lane];
#pragma unroll
                for (int ww = 0; ww < 8; ++ww) sacc += red[(ww * 32 + tk) * 33 + lane];
                val = sacc; }
            float tv[4]; int te[4];
#pragma unroll
            for (int it = 0; it < 4; ++it) {
                float bv = val; int bi = lane;
#pragma unroll
                for (int off = 32; off >= 1; off >>= 1) { const float ov = __shfl_xor(bv, off); const int oi = __shfl_xor(bi, off);
                    if (ov > bv || (ov == bv && oi < bi)) { bv = ov; bi = oi; } }
                tv[it] = bv; te[it] = bi; if (lane == bi) val = -INFINITY;
            }
            const float e1 = __expf(tv[1] - tv[0]), e2 = __expf(tv[2] - tv[0]), e3 = __expf(tv[3] - tv[0]);
            const float rs = 1.0f / (1.0f + e1 + e2 + e3);
            e_sel[rr] = lane == 0 ? te[0] : lane == 1 ? te[1] : lane == 2 ? te[2] : te[3];
            g_sel[rr] = (lane == 0 ? 1.0f : lane == 1 ? e1 : lane == 2 ? e2 : e3) * rs;
            loc[rr] = 0u;
            if (lane < 4) loc[rr] = atomicAdd((unsigned*)&hist[e_sel[rr]], 1u);
        }
        __syncthreads();
        if (F.tid < 32) { const unsigned hcount = hist[F.tid]; hbase[F.tid] = hcount ? atomicAdd(cnt + F.tid * 64, hcount) : 0u; }
        __syncthreads();
        if (lane < 4) {
#pragma unroll
            for (int rr = 0; rr < 4; ++rr) {
                const int row = tile * 32 + w * 4 + rr, e = e_sel[rr]; const unsigned rank = hbase[e] + loc[rr];
                tok[(size_t)e * NT + rank] = (unsigned)row; gate[(size_t)e * NT + rank] = g_sel[rr]; slot[(size_t)row * 4 + lane] = ((unsigned)e << 24) | rank;
            }
        }
    }
}

__device__ __forceinline__ void build_blk(Ctx& F, int l) {
    LAS int* blk = (LAS int*)(F.lds + LDS_BLK);
    const unsigned* cnt = (const unsigned*)(F.ws + WS_CNT) + l * 2048;
    __syncthreads();
    if (F.tid == 0) { int s = 0; for (int e = 0; e < 32; ++e) { blk[e] = s; s += ((int)cnt[e * 64] + 255) >> 8; } blk[32] = s; }
    __syncthreads();
}

__device__ __forceinline__ void phase_combine(Ctx& F, int l) {
    const LAS int* blk = (const LAS int*)(F.lds + LDS_BLK);
    float* X = F.out; bf16_t* H = (bf16_t*)(F.ws + WS_H); const bf16_t* YS = (const bf16_t*)(F.ws + WS_YS);
    const unsigned* slot = (const unsigned*)(F.ws + WS_SLOT);
    const float* mod = (const float*)(F.ws + WS_MOD);
    const int gw = F.bx * NWAVES + F.wave, NGW = F.G * NWAVES, lane = F.lane;
    for (int row = gw; row < NT; row += NGW) {
        f32x4 ff[4];
#pragma unroll
        for (int j = 0; j < 4; ++j) ff[j] = (f32x4){0.f, 0.f, 0.f, 0.f};
#pragma unroll
        for (int k = 0; k < 4; ++k) {
            const unsigned s = slot[(size_t)row * 4 + k]; const int e = (int)(s >> 24), rank = (int)(s & 0xffffffu);
            const bf16_t* yr = YS + ((size_t)blk[e] * 256 + rank) * D + 4 * lane;
#pragma unroll
            for (int j = 0; j < 4; ++j) { const u32x2 wv = *(const u32x2*)(yr + 256 * j); ff[j][0] += bf_lo(wv.x); ff[j][1] += bf_hi(wv.x); ff[j][2] += bf_lo(wv.y); ff[j][3] += bf_hi(wv.y); }
        }
        const int bi = batch_of(row);
        const float* mb = mod + (size_t)(l * 16 + bi) * 6144;
        f32x4 v[4];
#pragma unroll
        for (int j = 0; j < 4; ++j) { const f32x4 x = *(const f32x4*)(X + (size_t)row * D + 4 * lane + 256 * j), g2 = *(const f32x4*)(mb + 5120 + 4 * lane + 256 * j);
            v[j] = x * ALPHA + (g2 + 1.0f) * ff[j]; }
        ln_row(v, F.in[27] + l * D, F.in[28] + l * D, lane);
#pragma unroll
        for (int j = 0; j < 4; ++j) *(f32x4*)(X + (size_t)row * D + 4 * lane + 256 * j) = v[j];
        if (l == 0) { const float* mn = mod + (size_t)(16 + bi) * 6144; store_mod_row(v, mn, mn + 1024, H + (size_t)row * D, lane); }
    }
}

#ifndef PH_MASK
#define PH_MASK 0xFFFF
#endif
#define PH(b) ((PH_MASK >> (b)) & 1)
#ifndef PROBE_MASK
#define PROBE_MASK 0
#endif
#define PB0(id) do { if ((PROBE_MASK >> (id)) & 1) pb_t0 = __builtin_amdgcn_s_memrealtime(); } while (0)
#define PB1(id) do { if ((PROBE_MASK >> (id)) & 1) pb_acc += __builtin_amdgcn_s_memrealtime() - pb_t0; } while (0)
#define RELOAD() do { int t_ = threadIdx.x; asm volatile("" : "+v"(t_)); F.tid = t_; F.lane = t_ & 63; F.wave = __builtin_amdgcn_readfirstlane(t_ >> 6); \
    unsigned z_; asm volatile("s_mov_b32 %0, 0" : "=s"(z_)); F.in = p.in; F.out = p.out + z_; F.ws = p.ws + z_; } while (0)
#define LAYER_BODY(l) do { \
          \
        PB0(2); RELOAD(); \
        if (PH(2)) { \
            pg8::SchedDense S; S.init(NT, INW, D, F.G, F.bx, (const bf16_t*)(F.ws + WS_WIN) + (size_t)l * INW * D); \
            pg8::EpiZ E{(bf16_t*)(F.ws + WS_Z), F.in[13] + l * INW, F.out, l}; \
            pg8::gemm_phase<false, 0u>(F.lds, (const char*)(F.ws + WS_H), D, S, E); \
        } \
        xcd_barrier(xbar); PB1(2); PB0(3); \
        RELOAD(); \
        if (PH(3)) phase_attn(F, l); \
        xcd_barrier(xbar); PB1(3); PB0(4); \
          \
        RELOAD(); \
        if (PH(4)) { \
            pg8::SchedDense S; S.init(NT, D, 256, F.G, F.bx, F.ws + WS_WOA + (size_t)l * D * 512); \
            pg8::EpiT1 E{(float*)(F.ws + WS_T1), (const bf16_t*)(F.ws + WS_Z)}; \
            pg8::gemm_phase<true, 0x7c7c7c7cu>(F.lds, (const char*)(F.ws + WS_YA), 256, S, E); \
        } \
        RELOAD(); \
        if (PH(5)) { \
            pg8::SchedDense S; S.init(NT, D, 256, F.G, F.bx, F.ws + WS_WOB + (size_t)l * D * 512); \
            pg8::EpiMix E{(const float*)(F.ws + WS_T1), (const bf16_t*)(F.ws + WS_Z), F.ws + WS_MIX}; \
            pg8::gemm_phase<true, 0x7f7f7f7fu>(F.lds, (const char*)(F.ws + WS_YB), 256, S, E); \
        } \
        xcd_barrier(xbar); PB1(4); PB0(5); \
          \
        RELOAD(); \
        if (PH(6)) { \
            pg8::SchedDense S; S.init(NT, D, 512, F.G, F.bx, F.ws + WS_WO + (size_t)l * D * D); \
            pg8::EpiX E{F.out, (const float*)(F.ws + WS_MOD) + (size_t)l * 16 * 6144}; \
            pg8::gemm_phase<true, 0x7f7f7f7fu>(F.lds, (const char*)(F.ws + WS_MIX), 512, S, E); \
        } \
        xcd_barrier(xbar); PB1(5); PB0(6); \
        RELOAD(); \
        if (PH(7)) phase_ln_router(F, l); \
        xcd_barrier(xbar); PB1(6); PB0(7); \
          \
        RELOAD(); \
        build_blk(F, l); \
        if (PH(8)) { \
            LAS int* blk = (LAS int*)(F.lds + LDS_BLK); \
            LAS unsigned short* idx = (LAS unsigned short*)(F.lds + LDS_IDX); \
            pg8::SchedMoE<true> S; S.init(blk, idx, 8, 512, F.G, F.bx, (const unsigned char*)(F.ws + WS_WGU) + (size_t)l * 32 * 2048 * D, (size_t)2048 * D); \
            const unsigned* cnt = (const unsigned*)(F.ws + WS_CNT) + l * 2048; const unsigned* tok = (const unsigned*)(F.ws + WS_TOK); \
            for (int i = 0; i < MAXU; ++i) { pg8::Unit u; if (!S.next(i, u)) break; \
                if (F.tid < 256) { int rank = (u.pm - blk[u.e]) * 256 + F.tid; const int ce = (int)cnt[u.e * 64]; rank = rank < ce ? rank : ce - 1; \
                    idx[i * 256 + F.tid] = (unsigned short)tok[(size_t)u.e * NT + rank]; } } \
            __syncthreads(); \
            pg8::EpiAct E{(unsigned char*)(F.ws + WS_ACT), F.in[24] + (size_t)l * 32 * 2048}; \
            pg8::gemm_phase<true, 0x7f7f7f7fu>(F.lds, (const char*)(F.ws + WS_H8), 512, S, E); \
        } \
        xcd_barrier(xbar); PB1(7); PB0(8); \
          \
        RELOAD(); \
        if (PH(9)) { \
            LAS int* blk = (LAS int*)(F.lds + LDS_BLK); \
            LAS unsigned short* idx = (LAS unsigned short*)(F.lds + LDS_IDX); \
            pg8::SchedMoE<false> S; S.init(blk, idx, 4, 512, F.G, F.bx, (const unsigned char*)(F.ws + WS_WDN) + (size_t)l * 32 * D * D, (size_t)D * D); \
            pg8::EpiYs E{(bf16_t*)(F.ws + WS_YS), F.in[26] + (size_t)l * 32 * D, (const float*)(F.ws + WS_GATE), (const unsigned*)(F.ws + WS_CNT) + l * 2048, blk}; \
            pg8::gemm_phase<true, 0x7f7f7f7fu>(F.lds, (const char*)(F.ws + WS_ACT), 512, S, E); \
        } \
        xcd_barrier(xbar); PB1(8); PB0(9); \
        RELOAD(); \
        if (PH(10)) phase_combine(F, l); \
        if (l == 0) xcd_barrier(xbar); \
        PB1(9); \
 \
    } while (0)
__global__ void __launch_bounds__(NTHREADS, 2) fwd_megakernel(Params p) {
    extern __shared__ __attribute__((aligned(16))) unsigned char lds_raw[];
    cg::grid_group grid = cg::this_grid();
    Ctx F;
    F.lds = (LAS unsigned char*)lds_raw;
    F.G = gridDim.x; F.bx = blockIdx.x;
    volatile LAS unsigned* bst = (volatile LAS unsigned*)(F.lds + 147392);
    if (threadIdx.x < 2) bst[threadIdx.x] = 0u;
    __syncthreads();
    const XcdBarrier xbar = xcd_barrier_post((unsigned*)(p.ws + WS_BAR), bst);
    unsigned long long pb_t0 = 0, pb_acc = 0;
    PB0(0); RELOAD();
    if (PH(0)) phase0a(F);
    grid.sync();
    PB1(0); PB0(1); RELOAD();
    if (PH(1)) phase0b(F);
    xcd_barrier(xbar); PB1(1);

    LAYER_BODY(0);
    LAYER_BODY(1);
    if (PROBE_MASK != 0 && blockIdx.x == 0) { const unsigned long long te = __builtin_amdgcn_s_memrealtime(); while (__builtin_amdgcn_s_memrealtime() - te < pb_acc) __builtin_amdgcn_s_sleep(8); }
    (void)pb_t0; (void)pb_acc;
}

extern "C" void kernel_launch(void* const* d_in, const int* in_sizes, int n_in, void* d_out, int out_size, void* d_ws, size_t ws_size, hipStream_t stream) {
    static int grid = 0;
    if (grid == 0) {
        if (n_in != 29 || ws_size < WS_END) { fprintf(stderr, "kernel_launch: unexpected n_in %d / ws_size %zu (need %zu)\n", n_in, ws_size, (size_t)WS_END); grid = -1; return; }
        int dev = 0, cus = 0, per_cu = 0;
        hipGetDevice(&dev);
        hipDeviceGetAttribute(&cus, hipDeviceAttributeMultiprocessorCount, dev);
        if (hipFuncSetAttribute((const void*)fwd_megakernel, hipFuncAttributeMaxDynamicSharedMemorySize, LDS_BYTES) != hipSuccess) { fprintf(stderr, "kernel_launch: hipFuncSetAttribute failed\n"); grid = -1; return; }
        if (hipOccupancyMaxActiveBlocksPerMultiprocessor(&per_cu, (const void*)fwd_megakernel, NTHREADS, LDS_BYTES) != hipSuccess || per_cu < 1) { fprintf(stderr, "kernel_launch: occupancy query says %d blocks per CU\n", per_cu); per_cu = 1; }
        (void)hipGetLastError();
        grid = cus;
        if (grid != 256) fprintf(stderr, "kernel_launch: note: %d CUs (built for 256)\n", grid);
    }
    if (grid < 0) return;
    hipMemsetAsync((char*)d_ws, 0, WS_ZERO_BYTES, stream);
    Params p{};
    for (int i = 0; i < 29; ++i) p.in[i] = (const float*)d_in[i];
    p.out = (float*)d_out; p.ws = (unsigned char*)d_ws;
    void* args[] = {&p};
    hipError_t e = hipLaunchCooperativeKernel((const void*)fwd_megakernel, dim3(grid), dim3(NTHREADS), args, LDS_BYTES, stream);
    if (e != hipSuccess) fprintf(stderr, "kernel_launch: cooperative launch failed: %s (grid %d)\n", hipGetErrorString(e), grid);
}
```

```cpp
#include <hip/hip_runtime.h>
#include <hip/hip_cooperative_groups.h>
#include <cstdio>
#include <cstdint>
namespace cg = cooperative_groups;

#define LAS __attribute__((address_space(3)))
typedef unsigned short bf16_t;
typedef short bf16x8 __attribute__((ext_vector_type(8)));
typedef float f32x4 __attribute__((ext_vector_type(4)));
typedef float f32x16 __attribute__((ext_vector_type(16)));
typedef unsigned u32x4 __attribute__((ext_vector_type(4)));
typedef unsigned u32x2 __attribute__((ext_vector_type(2)));
typedef float f32x2 __attribute__((ext_vector_type(2)));
typedef int i32x4 __attribute__((ext_vector_type(4)));
typedef int i32x8 __attribute__((ext_vector_type(8)));

constexpr int D = 1024, NPROMPT = 32768, NT = 33280, INW = 4352, NEXP = 32;
constexpr float ALPHA = 1.41421356237f, LN_EPS = 1e-5f;
constexpr int NWAVES = 8, NTHREADS = 512;
constexpr int LDS_BYTES = 147456;
constexpr int LDS_BLK = 131072;
constexpr int LDS_IDX = 131072 + 256;
constexpr int MAXU = 24;
constexpr size_t OKP = 34078720, OVP = 34340864, OCP = 34603008, OKS = 34619392, OVS = 34881536, OCS = 35143680;
constexpr size_t MiB = 1u << 20;
constexpr size_t WS_CNT = 0;
constexpr size_t WS_BAR = 16384;
constexpr size_t WS_MOD = 65536;
constexpr size_t WS_MODP = 192 * MiB;
constexpr size_t WS_ZERO_BYTES = 1 * MiB;
constexpr size_t WS_BIAS = 1 * MiB;
constexpr size_t WS_SLOT = 2 * MiB;
constexpr size_t WS_TOK = 3 * MiB;
constexpr size_t WS_GATE = 8 * MiB;
constexpr size_t WS_WIN = 16 * MiB;
constexpr size_t WS_WIN8 = 180 * MiB;
constexpr size_t WS_WOA = 34 * MiB;
constexpr size_t WS_WOB = 36 * MiB;
constexpr size_t WS_WO = 38 * MiB;
constexpr size_t WS_WGU = 48 * MiB;
constexpr size_t WS_WDN = 304 * MiB;
constexpr size_t WS_H = 432 * MiB;
constexpr size_t WS_H8 = 1600 * MiB;
constexpr size_t WS_Z = 498 * MiB;
constexpr size_t WS_YA = 776 * MiB;
constexpr size_t WS_YB = 810 * MiB;
constexpr size_t WS_T1 = 844 * MiB;
constexpr size_t WS_V16 = 910 * MiB;
constexpr size_t WS_MIX = 976 * MiB;
constexpr size_t WS_ACT = 1042 * MiB;
constexpr size_t WS_YS = 1320 * MiB;
constexpr size_t WS_END = 1634 * MiB;

struct Params { const float* in[29]; float* out; unsigned char* ws; };

__device__ __forceinline__ unsigned cvt_pk_bf16(float lo, float hi) { unsigned r; asm volatile("v_cvt_pk_bf16_f32 %0, %1, %2" : "=v"(r) : "v"(lo), "v"(hi)); return r; }
__device__ __forceinline__ unsigned pk4_fp8(float a, float b, float c, float d) { unsigned w = 0u; w = __builtin_amdgcn_cvt_pk_fp8_f32(a, b, w, false); w = __builtin_amdgcn_cvt_pk_fp8_f32(c, d, w, true); return w; }
__device__ __forceinline__ float bf_lo(unsigned w) { return __uint_as_float(w << 16); }
__device__ __forceinline__ float bf_hi(unsigned w) { return __uint_as_float(w & 0xffff0000u); }
__device__ __forceinline__ float sigmoidf_(float x) { return __builtin_amdgcn_rcpf(1.0f + __expf(-x)); }
__device__ __forceinline__ float wave_sum(float v) {
#pragma unroll
    for (int o = 1; o < 64; o <<= 1) v += __shfl_xor(v, o);
    return v;
}
__device__ __forceinline__ int batch_of(int row) { return row < NPROMPT ? (row >> 12) : 8 + ((row - NPROMPT) >> 6); }

namespace pg8 {
constexpr int BM = 256, BK = 64, HALF = 128, HTB = HALF * BK * 2, NXCD = 8, WGM = 8;
__device__ __forceinline__ int lds_byte(int r, int c) { const int st = (r >> 4) * 2 + (c >> 5), rr = r & 15, cc = c & 31, ob = rr * 64 + cc * 2; return st * 1024 + (ob ^ (((ob >> 9) & 1) << 5)); }
__device__ __forceinline__ void stage_rc(int b, int& R, int& C) { const int st = b / 1024, sb = b % 1024, swz = sb ^ (((sb >> 9) & 1) << 5); R = (st >> 1) * 16 + swz / 64; C = (st & 1) * 32 + (swz % 64) / 2; }
__device__ __forceinline__ int perm32(int rho) { const int n = rho >> 4, i = rho & 15; return 8 * (i >> 2) + 4 * n + (i & 3); }

struct Unit { int pm, pn, e; const char* b; };

struct SchedDense {
    int nM, nN, nwg, G, c, cbase, csplit, cskip; const char* Bt; size_t tstepB;
    __device__ __forceinline__ void init(int M, int N, int K, int G_, int c_, const void* Bt_, int cbase_ = 0, int csplit_ = 1 << 20, int cskip_ = 0) { nM = M / BM; nN = N / BM; nwg = nM * nN; G = G_; c = c_; Bt = (const char*)Bt_; tstepB = (size_t)BM * K * 2; cbase = cbase_; csplit = csplit_; cskip = cskip_; }
    __device__ __forceinline__ bool next(int i, Unit& u) const {
        const long L = (long)i * G + c; if (L >= nwg) return false;
        int wgid = (int)L; { const int q = nwg / NXCD, r = nwg % NXCD, xcd = wgid % NXCD, off = wgid / NXCD; wgid = (xcd < r ? xcd * (q + 1) : r * (q + 1) + (xcd - r) * q) + off; }
        const int nig = WGM * nN, gid = wgid / nig, fm = gid * WGM, gsz = (nM - fm) < WGM ? (nM - fm) : WGM;
        u.pm = fm + ((wgid % nig) % gsz); const int j = (wgid % nig) / gsz; u.pn = j < csplit ? j + cbase : j + cbase + cskip; u.e = 0; u.b = Bt + (size_t)u.pn * tstepB; return true;
    }
    __device__ __forceinline__ unsigned rowidx(int, const Unit& u, int r) const { return (unsigned)(u.pm * BM + r); }
};
template <bool GATHER> struct SchedMoE {
    const LAS int* blk; const LAS unsigned short* idx; int NB, RBX, NPN, NXs, perx, cx, cj; const char* Bt; size_t estep, tstepB;
    __device__ __forceinline__ void init(const LAS int* blk_, const LAS unsigned short* idx_, int NPN_, int K, int G, int c, const void* Bt_, size_t estep_) {
        blk = blk_; idx = idx_; NB = blk_[32]; NPN = NPN_; Bt = (const char*)Bt_; estep = estep_; tstepB = (size_t)BM * K * 2;
        if ((G & 7) == 0) { NXs = 8; perx = G >> 3; cx = c & 7; cj = c >> 3; } else { NXs = 1; perx = G; cx = 0; cj = c; }
        RBX = (NB + NXs - 1) / NXs;
    }
    __device__ __forceinline__ bool next(int i, Unit& u) const {
        const int j = i * perx + cj, rbl = j / NPN; if (rbl >= RBX) return false;
        const int rb = cx * RBX + rbl; if (rb >= NB) return false;
        int e = 0;
        for (int q = 1; q < 32; ++q) e = (blk[q] <= rb) ? q : e;
        u.pm = rb; u.pn = j - rbl * NPN; u.e = e; u.b = Bt + (size_t)e * estep + (size_t)u.pn * tstepB; return true;
    }
    __device__ __forceinline__ unsigned rowidx(int ui, const Unit& u, int r) const { if (GATHER) return (unsigned)idx[ui * 256 + r]; return (unsigned)(u.pm * BM + r); }
};

template <bool FP8, unsigned ASCALE, class Epi, class Sched>
__device__ __forceinline__ void gemm_phase(LAS unsigned char* lds, const char* Abase, const int K, const Sched& S, const Epi& E) {
    int tid_ = threadIdx.x; asm volatile("" : "+v"(tid_));
    const int tid = tid_, wid = __builtin_amdgcn_readfirstlane(tid >> 6), lane = tid & 63, wr = wid >> 2, wc = wid & 3, fr = lane & 15, fq = lane >> 4;
    int nt_ = K / BK; asm volatile("" : "+s"(nt_)); const int nt = nt_;
    unsigned voffB[2]; int RA[2], CA[2];
#pragma unroll
    for (int i = 0; i < 2; ++i) { int R, C; stage_rc(tid * 16 + i * 8192, R, C); const int Rb = Epi::PERM ? ((R & ~31) + perm32(R & 31)) : R;
        voffB[i] = (unsigned)(Rb * K + C) * 2u; RA[i] = R; CA[i] = C * 2; }
    const size_t kstep = (size_t)(BK * 2);
    const size_t hstep = (size_t)HALF * K * 2;
    const unsigned ldsw = (unsigned)wid * 1024u;
    const unsigned rowb = (unsigned)K * 2u;
    const int aoff = lds_byte(wr * 64 + fr, fq * 8), boff = lds_byte(wc * 32 + fr, fq * 8);
#define PG8_SA(b, h) (((b) * 2 + (h)) * HTB)
#define PG8_SB(b, h) ((4 + (b) * 2 + (h)) * HTB)
#define PG8_STAGE(bufoff, gbase, voff) do { _Pragma("unroll") for (int _i = 0; _i < 2; ++_i) \
        __builtin_amdgcn_global_load_lds((const unsigned*)((const char*)(gbase) + (voff)[_i]), (LAS unsigned*)(lds + (bufoff) + ldsw + _i * 8192), 16, 0, 0); } while (0)
#define PG8_LDA(dst, b, h) do { _Pragma("unroll") for (int m = 0; m < 4; ++m) _Pragma("unroll") for (int k = 0; k < 2; ++k) dst[m][k] = *(const LAS bf16x8*)(lds + PG8_SA(b, h) + aoff + m * 2048 + k * 1024); } while (0)
#define PG8_LDB(dst, b, h) do { _Pragma("unroll") for (int n = 0; n < 2; ++n) _Pragma("unroll") for (int k = 0; k < 2; ++k) dst[n][k] = *(const LAS bf16x8*)(lds + PG8_SB(b, h) + boff + n * 2048 + k * 1024); } while (0)
#define PG8_MMA(ai, bj, At, Bt) do { __builtin_amdgcn_s_setprio(1); _Pragma("unroll") for (int m = 0; m < 4; ++m) _Pragma("unroll") for (int n = 0; n < 2; ++n) { \
        if constexpr (FP8) { \
            const i32x8 wf_ = __builtin_shufflevector((i32x4)Bt[n][0], (i32x4)Bt[n][1], 0, 1, 2, 3, 4, 5, 6, 7), af_ = __builtin_shufflevector((i32x4)At[m][0], (i32x4)At[m][1], 0, 1, 2, 3, 4, 5, 6, 7); \
            acc[ai][bj][m][n] = __builtin_amdgcn_mfma_scale_f32_16x16x128_f8f6f4(wf_, af_, acc[ai][bj][m][n], 0, 0, 0, 0x79797979, 0, (int)ASCALE); \
        } else { _Pragma("unroll") for (int k = 0; k < 2; ++k) \
            acc[ai][bj][m][n] = __builtin_amdgcn_mfma_f32_16x16x32_bf16(Bt[n][k], At[m][k], acc[ai][bj][m][n], 0, 0, 0); } } \
        __builtin_amdgcn_s_setprio(0); } while (0)
#define PG8_WAIT_V(n) asm volatile("s_waitcnt vmcnt(" #n ")" ::: "memory")
#define PG8_WAIT_L(n) asm volatile("s_waitcnt lgkmcnt(" #n ")" ::: "memory")
#define PG8_BAR __builtin_amdgcn_s_barrier()
#define PG8_SCHED __builtin_amdgcn_sched_barrier(0)
#define PG8_LOADVA(ui_, u_) do { _Pragma("unroll") for (int _h = 0; _h < 2; ++_h) _Pragma("unroll") for (int _i = 0; _i < 2; ++_i) \
        vA[_h][_i] = S.rowidx((ui_), (u_), _h * HALF + RA[_i]) * rowb + (unsigned)CA[_i]; } while (0)
    Unit cur, nxt; int ui = 0;
    if (!S.next(0, cur)) return;
    f32x4 acc[2][2][4][2];
#pragma unroll
    for (int a = 0; a < 2; ++a)
#pragma unroll
        for (int b = 0; b < 2; ++b)
#pragma unroll
            for (int m = 0; m < 4; ++m)
#pragma unroll
                for (int n = 0; n < 2; ++n) acc[a][b][m][n] = (f32x4){0.f, 0.f, 0.f, 0.f};
    bf16x8 At[4][2], B0[2][2], B1[2][2];
    unsigned vA[2][2];
    PG8_LOADVA(0, cur);
    const char* cB = cur.b;
    PG8_STAGE(PG8_SB(0, 0), cB, voffB); PG8_STAGE(PG8_SB(0, 1), cB + hstep, voffB); PG8_STAGE(PG8_SA(0, 0), Abase, vA[0]); PG8_STAGE(PG8_SA(0, 1), Abase, vA[1]);
    if (wr == 1) PG8_BAR;
    PG8_WAIT_V(2); PG8_BAR;
    PG8_STAGE(PG8_SB(1, 0), cB + kstep, voffB); PG8_STAGE(PG8_SA(1, 0), Abase + kstep, vA[0]); PG8_STAGE(PG8_SB(1, 1), cB + hstep + kstep, voffB);
    PG8_WAIT_V(6); PG8_BAR;
    for (;;) {
        const bool has_next = S.next(ui + 1, nxt);
        const char* nB = has_next ? nxt.b : cB;
#pragma unroll 1
        for (int t = 0; t < nt; t += 2) {
            const bool last = (t == nt - 2);
            const char* a1 = Abase + (size_t)(t + 1) * kstep;
            const char* a2 = last ? Abase : Abase + (size_t)(t + 2) * kstep;
            const char* b2 = last ? nB : cB + (size_t)(t + 2) * kstep;
            const char* a3 = a2 + kstep; const char* b3 = b2 + kstep;
            PG8_LDB(B0, 0, 0); PG8_LDB(B1, 0, 1); PG8_SCHED; PG8_LDA(At, 0, 0); PG8_STAGE(PG8_SA(1, 1), a1, vA[1]);
            if (last && has_next) { PG8_LOADVA(ui + 1, nxt); }
            PG8_WAIT_V(8); PG8_WAIT_L(0); PG8_BAR; PG8_MMA(0, 0, At, B0); PG8_MMA(0, 1, At, B1); PG8_BAR; PG8_SCHED;
            PG8_LDA(At, 0, 1); PG8_STAGE(PG8_SB(0, 0), b2, voffB); PG8_STAGE(PG8_SB(0, 1), b2 + hstep, voffB); PG8_STAGE(PG8_SA(0, 0), a2, vA[0]);
            PG8_WAIT_V(8); PG8_WAIT_L(0); PG8_BAR; PG8_MMA(1, 0, At, B0); PG8_MMA(1, 1, At, B1); PG8_BAR; PG8_SCHED;
            PG8_LDB(B0, 1, 0); PG8_LDB(B1, 1, 1); PG8_SCHED; PG8_LDA(At, 1, 0); PG8_STAGE(PG8_SA(0, 1), a2, vA[1]);
            PG8_WAIT_V(8); PG8_WAIT_L(0); PG8_BAR; PG8_MMA(0, 0, At, B0); PG8_MMA(0, 1, At, B1); PG8_BAR; PG8_SCHED;
            PG8_LDA(At, 1, 1); PG8_STAGE(PG8_SB(1, 0), b3, voffB); PG8_STAGE(PG8_SB(1, 1), b3 + hstep, voffB); PG8_STAGE(PG8_SA(1, 0), a3, vA[0]);
            PG8_WAIT_V(8); PG8_WAIT_L(0); PG8_BAR; PG8_MMA(1, 0, At, B0); PG8_MMA(1, 1, At, B1); PG8_BAR; PG8_SCHED;
        }
        if (wr == 0) PG8_BAR;
        E(acc, cur, wr, wc, fr, fq);
        if (!has_next) break;
#pragma unroll
        for (int a = 0; a < 2; ++a)
#pragma unroll
            for (int b = 0; b < 2; ++b)
#pragma unroll
                for (int m = 0; m < 4; ++m)
#pragma unroll
                    for (int n = 0; n < 2; ++n) acc[a][b][m][n] = (f32x4){0.f, 0.f, 0.f, 0.f};
        cur = nxt; cB = nB; ++ui;
        if (wr == 1) PG8_BAR;
    }
    PG8_WAIT_V(0);
    PG8_BAR;
#undef PG8_SA
#undef PG8_SB
#undef PG8_STAGE
#undef PG8_LDA
#undef PG8_LDB
#undef PG8_MMA
#undef PG8_WAIT_V
#undef PG8_WAIT_L
#undef PG8_BAR
#undef PG8_SCHED
#undef PG8_LOADVA
}

typedef f32x4 Acc[2][2][4][2];

struct EpiZ {
    static constexpr bool PERM = true;
    bf16_t* Z; const float* bias; float* out; int l;
    __device__ __forceinline__ void operator()(const Acc& acc, const Unit& u, int wr, int wc, int fr, int fq) const {
        const int row0 = u.pm * 256 + wr * 64 + fr, col0 = u.pn * 256 + wc * 32 + 8 * fq;
        f32x4 bv[2][2];
#pragma unroll
        for (int bj = 0; bj < 2; ++bj)
#pragma unroll
            for (int n = 0; n < 2; ++n) bv[bj][n] = *(const f32x4*)(bias + col0 + bj * 128 + 4 * n);
#pragma unroll
        for (int ai = 0; ai < 2; ++ai)
#pragma unroll
            for (int m = 0; m < 4; ++m) {
                const int row = row0 + ai * 128 + m * 16;
                bf16_t* rowp = Z + (size_t)row * INW + col0;
                float* ko = nullptr; float* vo = nullptr;
                if (u.pn == 2) {
                    if (row < NPROMPT) { const int t = row & 4095; if (t >= 3968) { const size_t o = ((size_t)(l * 8 + (row >> 12)) * 128 + (t - 3968)) * 128 + wc * 32 + 8 * fq; ko = out + OKP + o; vo = out + OVP + o; } }
                    else { const int rr = row - NPROMPT; const size_t o = ((size_t)(l * 8 + (rr >> 6)) * 128 + 64 + (rr & 63)) * 128 + wc * 32 + 8 * fq; ko = out + OKS + o; vo = out + OVS + o; }
                }
#pragma unroll
                for (int bj = 0; bj < 2; ++bj) {
                    const f32x4 v0 = acc[ai][bj][m][0] + bv[bj][0], v1 = acc[ai][bj][m][1] + bv[bj][1];
                    u32x4 w; w.x = cvt_pk_bf16(v0[0], v0[1]); w.y = cvt_pk_bf16(v0[2], v0[3]); w.z = cvt_pk_bf16(v1[0], v1[1]); w.w = cvt_pk_bf16(v1[2], v1[3]);
                    *(u32x4*)(rowp + bj * 128) = w;
                    float* o = bj == 0 ? ko : vo;
                    if (o) { *(f32x4*)o = v0; *(f32x4*)(o + 4) = v1; }
                }
                asm volatile("" ::: "memory");
            }
    }
};
struct EpiT1 {
    static constexpr bool PERM = true;
    bf16_t* T1; const bf16_t* Z;
    __device__ __forceinline__ void operator()(const Acc& acc, const Unit& u, int wr, int wc, int fr, int fq) const {
        const int row0 = u.pm * 256 + wr * 64 + fr, col0 = u.pn * 256 + wc * 32 + 8 * fq;
        u32x4 g[2][4][2];
#pragma unroll
        for (int ai = 0; ai < 2; ++ai)
#pragma unroll
            for (int m = 0; m < 4; ++m)
#pragma unroll
                for (int bj = 0; bj < 2; ++bj) g[ai][m][bj] = *(const u32x4*)(Z + (size_t)(row0 + ai * 128 + m * 16) * INW + 2304 + col0 + bj * 128);
        asm volatile("" ::: "memory");
#pragma unroll
        for (int ai = 0; ai < 2; ++ai)
#pragma unroll
            for (int m = 0; m < 4; ++m) {
                const int row = row0 + ai * 128 + m * 16;
#pragma unroll
                for (int bj = 0; bj < 2; ++bj) {
                    const u32x4 gg = g[ai][m][bj];
                    f32x4 v0 = acc[ai][bj][m][0], v1 = acc[ai][bj][m][1];
                    v0[0] *= sigmoidf_(bf_lo(gg.x)); v0[1] *= sigmoidf_(bf_hi(gg.x)); v0[2] *= sigmoidf_(bf_lo(gg.y)); v0[3] *= sigmoidf_(bf_hi(gg.y));
                    v1[0] *= sigmoidf_(bf_lo(gg.z)); v1[1] *= sigmoidf_(bf_hi(gg.z)); v1[2] *= sigmoidf_(bf_lo(gg.w)); v1[3] *= sigmoidf_(bf_hi(gg.w));
                    u32x4 w; w.x = cvt_pk_bf16(v0[0], v0[1]); w.y = cvt_pk_bf16(v0[2], v0[3]); w.z = cvt_pk_bf16(v1[0], v1[1]); w.w = cvt_pk_bf16(v1[2], v1[3]);
                    *(u32x4*)(T1 + (size_t)row * D + col0 + bj * 128) = w;
                }
            }
    }
};
struct EpiMix {
    static constexpr bool PERM = true;
    const bf16_t* T1; const bf16_t* Z; unsigned char* MIX;
    __device__ __forceinline__ void operator()(const Acc& acc, const Unit& u, int wr, int wc, int fr, int fq) const {
        const int row0 = u.pm * 256 + wr * 64 + fr, col0 = u.pn * 256 + wc * 32 + 8 * fq;
#pragma unroll
        for (int ai = 0; ai < 2; ++ai)
#pragma unroll
        for (int mh = 0; mh < 2; ++mh) {
            u32x4 g[4][2]; u32x4 t[4][2];
#pragma unroll
            for (int m = 2 * mh; m < 2 * mh + 2; ++m)
#pragma unroll
                for (int bj = 0; bj < 2; ++bj) {
                    const int row = row0 + ai * 128 + m * 16;
                    g[m][bj] = *(const u32x4*)(Z + (size_t)row * INW + 3328 + col0 + bj * 128);
                    t[m][bj] = *(const u32x4*)(T1 + (size_t)row * D + col0 + bj * 128);
                }
            asm volatile("" ::: "memory");
#pragma unroll
            for (int m = 2 * mh; m < 2 * mh + 2; ++m)
#pragma unroll
                for (int bj = 0; bj < 2; ++bj) {
                    const int row = row0 + ai * 128 + m * 16;
                    const u32x4 gg = g[m][bj];
                    const u32x4 tt = t[m][bj];
                    f32x4 v0 = (f32x4){bf_lo(tt.x), bf_hi(tt.x), bf_lo(tt.y), bf_hi(tt.y)}, v1 = (f32x4){bf_lo(tt.z), bf_hi(tt.z), bf_lo(tt.w), bf_hi(tt.w)};
                    const f32x4 a0 = acc[ai][bj][m][0], a1 = acc[ai][bj][m][1];
                    v0[0] += a0[0] * sigmoidf_(bf_lo(gg.x)); v0[1] += a0[1] * sigmoidf_(bf_hi(gg.x)); v0[2] += a0[2] * sigmoidf_(bf_lo(gg.y)); v0[3] += a0[3] * sigmoidf_(bf_hi(gg.y));
                    v1[0] += a1[0] * sigmoidf_(bf_lo(gg.z)); v1[1] += a1[1] * sigmoidf_(bf_hi(gg.z)); v1[2] += a1[2] * sigmoidf_(bf_lo(gg.w)); v1[3] += a1[3] * sigmoidf_(bf_hi(gg.w));
                    u32x2 w; w.x = pk4_fp8(v0[0], v0[1], v0[2], v0[3]); w.y = pk4_fp8(v1[0], v1[1], v1[2], v1[3]);
                    *(u32x2*)(MIX + (size_t)row * D + col0 + bj * 128) = w;
                }
            asm volatile("" ::: "memory");
        }
    }
};
struct EpiX {
    static constexpr bool PERM = true;
    const float* X; bf16_t* V; const float* modl;
    __device__ __forceinline__ void operator()(const Acc& acc, const Unit& u, int wr, int wc, int fr, int fq) const {
        const int row0 = u.pm * 256 + wr * 64 + fr, col0 = u.pn * 256 + wc * 32 + 8 * fq;
        const bool uni = u.pm < 128;
        f32x4 g[2][2];
        if (uni) { const float* gp = modl + (size_t)(u.pm >> 4) * 6144 + 2048 + col0;
#pragma unroll
            for (int bj = 0; bj < 2; ++bj)
#pragma unroll
                for (int n = 0; n < 2; ++n) g[bj][n] = *(const f32x4*)(gp + bj * 128 + 4 * n) + 1.0f; }
#pragma unroll
        for (int ai = 0; ai < 2; ++ai)
#pragma unroll
        for (int mh = 0; mh < 2; ++mh) {
            f32x4 x[4][2][2];
#pragma unroll
            for (int m = 2 * mh; m < 2 * mh + 2; ++m)
#pragma unroll
                for (int bj = 0; bj < 2; ++bj)
#pragma unroll
                    for (int n = 0; n < 2; ++n) x[m][bj][n] = *(const f32x4*)(X + (size_t)(row0 + ai * 128 + m * 16) * D + col0 + bj * 128 + 4 * n);
            asm volatile("" ::: "memory");
#pragma unroll
            for (int m = 2 * mh; m < 2 * mh + 2; ++m) {
                const int row = row0 + ai * 128 + m * 16;
                if (!uni) { const float* gp = modl + (size_t)batch_of(row) * 6144 + 2048 + col0;
#pragma unroll
                    for (int bj = 0; bj < 2; ++bj)
#pragma unroll
                        for (int n = 0; n < 2; ++n) g[bj][n] = *(const f32x4*)(gp + bj * 128 + 4 * n) + 1.0f; }
#pragma unroll
                for (int bj = 0; bj < 2; ++bj) {
                    const f32x4 v0 = x[m][bj][0] * ALPHA + g[bj][0] * acc[ai][bj][m][0], v1 = x[m][bj][1] * ALPHA + g[bj][1] * acc[ai][bj][m][1];
                    u32x4 w; w.x = cvt_pk_bf16(v0[0], v0[1]); w.y = cvt_pk_bf16(v0[2], v0[3]); w.z = cvt_pk_bf16(v1[0], v1[1]); w.w = cvt_pk_bf16(v1[2], v1[3]);
                    *(u32x4*)(V + (size_t)row * D + col0 + bj * 128) = w;
                }
            }
            asm volatile("" ::: "memory");
        }
    }
};
struct EpiAct {
    static constexpr bool PERM = true;
    unsigned char* ACT; const float* bgu;
    __device__ __forceinline__ void operator()(const Acc& acc, const Unit& u, int wr, int wc, int fr, int fq) const {
        const int row0 = u.pm * 256 + wr * 64 + fr, c0 = u.pn * 128 + wc * 32 + 8 * fq;
        const float* bp = bgu + (size_t)u.e * 2048 + c0;
        f32x4 bg[2], bl[2];
#pragma unroll
        for (int n = 0; n < 2; ++n) { bg[n] = *(const f32x4*)(bp + 4 * n); bl[n] = *(const f32x4*)(bp + 1024 + 4 * n); }
#pragma unroll
        for (int ai = 0; ai < 2; ++ai)
#pragma unroll
            for (int m = 0; m < 4; ++m) {
                const int row = row0 + ai * 128 + m * 16;
                float a[8];
#pragma unroll
                for (int n = 0; n < 2; ++n)
#pragma unroll
                    for (int j = 0; j < 4; ++j) {
                        float g = acc[ai][0][m][n][j] + bg[n][j], li = acc[ai][1][m][n][j] + bl[n][j];
                        g = fminf(g, 7.0f); li = fminf(fmaxf(li, -7.0f), 7.0f);
                        a[n * 4 + j] = g * sigmoidf_(1.702f * g) * (li + 1.0f);
                    }
                u32x2 w; w.x = pk4_fp8(a[0], a[1], a[2], a[3]); w.y = pk4_fp8(a[4], a[5], a[6], a[7]);
                *(u32x2*)(ACT + (size_t)row * D + c0) = w;
                asm volatile("" ::: "memory");
            }
    }
};
struct EpiYs {
    static constexpr bool PERM = true;
    unsigned char* YS; const float* bdn; const float* gate; const unsigned* cnt; const LAS int* blk;
    __device__ __forceinline__ void operator()(const Acc& acc, const Unit& u, int wr, int wc, int fr, int fq) const {
        const int r0 = wr * 64 + fr, col0 = u.pn * 256 + wc * 32 + 8 * fq;
        const int rank0 = (u.pm - blk[u.e]) * 256; const int ce = (int)cnt[u.e * 64];
        f32x4 bv[2][2];
#pragma unroll
        for (int bj = 0; bj < 2; ++bj)
#pragma unroll
            for (int n = 0; n < 2; ++n) bv[bj][n] = *(const f32x4*)(bdn + (size_t)u.e * D + col0 + bj * 128 + 4 * n);
        float gts[2][4];
#pragma unroll
        for (int ai = 0; ai < 2; ++ai)
#pragma unroll
            for (int m = 0; m < 4; ++m) { const int rank = rank0 + r0 + ai * 128 + m * 16; gts[ai][m] = rank < ce ? 16.0f * gate[(size_t)u.e * NT + rank] : 0.0f; }
        asm volatile("" ::: "memory");
#pragma unroll
        for (int ai = 0; ai < 2; ++ai)
#pragma unroll
            for (int m = 0; m < 4; ++m) {
                const int r = r0 + ai * 128 + m * 16;
                const float gt = gts[ai][m];
                unsigned char* rowp = YS + (size_t)(u.pm * 256 + r) * D + col0;
#pragma unroll
                for (int bj = 0; bj < 2; ++bj) {
                    const f32x4 v0 = (acc[ai][bj][m][0] + bv[bj][0]) * gt, v1 = (acc[ai][bj][m][1] + bv[bj][1]) * gt;
                    u32x2 w; w.x = pk4_fp8(v0[0], v0[1], v0[2], v0[3]); w.y = pk4_fp8(v1[0], v1[1], v1[2], v1[3]);
                    *(u32x2*)(rowp + bj * 128) = w;
                }
                asm volatile("" ::: "memory");
            }
    }
};
}


#define XB_TMO      128
#define XB_XCNT(j)  (256  + 64 * (j))
#define XB_XSUB(j)  (1280 + 64 * (j))
#define XB_XGEN(j)  (2304 + 64 * (j))
#define XB_TOP      3328
#define XB_TOPGEN   3392
#define XCD_BAR_WORDS 3456
#define XB_SPIN_CAP (1u << 21)
__device__ __forceinline__ unsigned xb_ld(unsigned* p)              { return __hip_atomic_load(p, __ATOMIC_RELAXED, __HIP_MEMORY_SCOPE_AGENT); }
__device__ __forceinline__ unsigned xb_add(unsigned* p, unsigned v) { return __hip_atomic_fetch_add(p, v, __ATOMIC_RELAXED, __HIP_MEMORY_SCOPE_AGENT); }
__device__ __forceinline__ unsigned xb_xcc_id() { return (unsigned)__builtin_amdgcn_s_getreg((3 << 11) | 20) & 0xFu; }
#define XB_SPIN(cond, bar) do { unsigned _sp = 0; while (cond) { __builtin_amdgcn_s_sleep(1); \
    if ((++_sp & 255u) == 0u) { if (xb_ld(&(bar)[XB_TMO])) break; if (_sp > XB_SPIN_CAP) { atomicAdd(&(bar)[XB_TMO], 1u); break; } } } } while (0)
struct XcdBarrier { unsigned* bar; unsigned x; volatile LAS unsigned* st; };
__device__ __forceinline__ XcdBarrier xcd_barrier_post(unsigned* bar, volatile LAS unsigned* st) {
    XcdBarrier b; b.bar = bar; b.x = xb_xcc_id(); b.st = st;
    if (threadIdx.x == 0) (void)xb_add(&bar[XB_XCNT(b.x)], 1u);
    return b;
}
__device__ __forceinline__ void xcd_barrier_complete(unsigned* bar, unsigned x, unsigned& nloc, unsigned& nx) {
    const unsigned G = gridDim.x * gridDim.y * gridDim.z;
    unsigned sum, cnt, mine, sp = 0u;
    for (;;) {
        sum = 0u; cnt = 0u; mine = 0u;
#pragma unroll
        for (unsigned j = 0; j < 16; ++j) { const unsigned c = xb_ld(&bar[XB_XCNT(j)]); sum += c; cnt += (c > 0u) ? 1u : 0u; mine = (j == x) ? c : mine; }
        if (sum == G) break;
        __builtin_amdgcn_s_sleep(1);
        if ((++sp & 255u) == 0u) { if (xb_ld(&bar[XB_TMO])) break; if (sp > XB_SPIN_CAP) { atomicAdd(&bar[XB_TMO], 1u); break; } }
    }
    nloc = mine > 0u ? mine : 1u; nx = cnt > 0u ? cnt : 1u;
}
__device__ __forceinline__ void xcd_barrier(const XcdBarrier& b) {
    asm volatile("s_waitcnt vmcnt(0)" ::: "memory");
    __syncthreads();
    if (threadIdx.x == 0) {
        unsigned* bar = b.bar;
        __builtin_amdgcn_s_waitcnt(0);
        unsigned nloc = b.st[0], nx = b.st[1];
        if (nloc == 0u) { xcd_barrier_complete(bar, b.x, nloc, nx); b.st[0] = nloc; b.st[1] = nx; }
        const unsigned old = xb_add(&bar[XB_XSUB(b.x)], 1u);
        const unsigned gen = old / nloc;
        if (old + 1u == (gen + 1u) * nloc) {
            __builtin_amdgcn_fence(__ATOMIC_RELEASE, "agent");
            asm volatile("s_waitcnt vmcnt(0)" ::: "memory");
            const unsigned og = xb_add(&bar[XB_TOP], 1u);
            const unsigned tg = og / nx;
            if (og + 1u == (tg + 1u) * nx) xb_add(&bar[XB_TOPGEN], 1u);
            else XB_SPIN(xb_ld(&bar[XB_TOPGEN]) == tg, bar);
            __builtin_amdgcn_fence(__ATOMIC_ACQUIRE, "agent");
            xb_add(&bar[XB_XGEN(b.x)], 1u);
            asm volatile("s_waitcnt vmcnt(0)" ::: "memory");
        } else {
            XB_SPIN(xb_ld(&bar[XB_XGEN(b.x)]) == gen, bar);
            __builtin_amdgcn_fence(__ATOMIC_ACQUIRE, "agent");
            asm volatile("s_waitcnt vmcnt(0)" ::: "memory");
        }
    }
    __syncthreads();
}

struct Ctx {
    LAS unsigned char* lds; int tid, lane, wave, G, bx;
    const float* const* in; float* out; unsigned char* ws;
};
#define LDS_WAIT() asm volatile("s_waitcnt lgkmcnt(0)" ::: "memory")

template <bool F8>
__device__ __forceinline__ void transpose64(const float* W, int K, int N, unsigned char* WT, int kind, LAS unsigned char* scr, int item, int lane) {
    const int nblk = N >> 6, kb = item / nblk, nb = item - kb * nblk, k0 = kb * 64, n0 = nb * 64;
    const float* src = W + (size_t)k0 * N + n0 + lane;
    float v[64];
#pragma unroll
    for (int kk = 0; kk < 64; ++kk) v[kk] = src[(size_t)kk * N];
    if (F8) {
        LAS unsigned char* wp = scr + lane * 80;
#pragma unroll
        for (int q = 0; q < 4; ++q) { u32x4 o;
            o.x = pk4_fp8(64.f * v[16 * q + 0], 64.f * v[16 * q + 1], 64.f * v[16 * q + 2], 64.f * v[16 * q + 3]);
            o.y = pk4_fp8(64.f * v[16 * q + 4], 64.f * v[16 * q + 5], 64.f * v[16 * q + 6], 64.f * v[16 * q + 7]);
            o.z = pk4_fp8(64.f * v[16 * q + 8], 64.f * v[16 * q + 9], 64.f * v[16 * q + 10], 64.f * v[16 * q + 11]);
            o.w = pk4_fp8(64.f * v[16 * q + 12], 64.f * v[16 * q + 13], 64.f * v[16 * q + 14], 64.f * v[16 * q + 15]);
            *(LAS u32x4*)(wp + q * 16) = o; }
        LDS_WAIT(); asm volatile("" ::: "memory");
        const int c = lane & 3;
#pragma unroll
        for (int j = 0; j < 4; ++j) { const int nl = (lane >> 2) + 16 * j; const u32x4 o = *(const LAS u32x4*)(scr + nl * 80 + c * 16);
            const int n = n0 + nl; int dr = n;
            if (kind == 1) { dr = (n < 1024) ? ((n >> 7) * 256 + (n & 127)) : (((n - 1024) >> 7) * 256 + 128 + (n & 127)); }
            *(u32x4*)(WT + (size_t)dr * K + k0 + c * 16) = o; }
    } else {
        LAS unsigned char* wp = scr + lane * 144;
#pragma unroll
        for (int q = 0; q < 8; ++q) { u32x4 o;
            o.x = cvt_pk_bf16(v[8 * q + 0], v[8 * q + 1]); o.y = cvt_pk_bf16(v[8 * q + 2], v[8 * q + 3]); o.z = cvt_pk_bf16(v[8 * q + 4], v[8 * q + 5]); o.w = cvt_pk_bf16(v[8 * q + 6], v[8 * q + 7]);
            *(LAS u32x4*)(wp + q * 16) = o; }
        LDS_WAIT(); asm volatile("" ::: "memory");
        const int c = lane & 7;
#pragma unroll
        for (int j = 0; j < 8; ++j) { const int nl = (lane >> 3) + 8 * j; const u32x4 o = *(const LAS u32x4*)(scr + nl * 144 + c * 16);
            const int n = n0 + nl; int dr = n;
            if (kind == 1) { dr = (n < 1024) ? ((n >> 7) * 256 + (n & 127)) : (((n - 1024) >> 7) * 256 + 128 + (n & 127)); }
            *(u32x4*)(WT + ((size_t)dr * K + k0) * 2 + c * 16) = o; }
    }
    LDS_WAIT(); asm volatile("" ::: "memory");
}

__device__ __forceinline__ int rel_bucket(int rel) {
    const int n = rel < 0 ? -rel : rel;
    int v;
    if (n < 8) v = n;
    else { const float nf = (float)n; int large = 8 + (int)(logf(nf / 8.0f) / 2.7725887298583984f * 8.0f); v = large < 15 ? large : 15; }
    return (rel > 0 ? 16 : 0) + v;
}

__device__ __forceinline__ void phase0a(Ctx& F) {
    LAS float* scr = (LAS float*)(F.lds + F.wave * 16384);
    const int gw = F.bx * NWAVES + F.wave, NGW = F.G * NWAVES;
    unsigned char* ws = F.ws;
    {
        float* modp = (float*)(ws + WS_MODP);
        for (int it = gw; it < 2 * 96 * 8; it += NGW) {
            const int kc = it & 7, cgp = (it >> 3) % 96, l = it / (8 * 96), k0 = kc * 128, n0 = cgp * 64;
#pragma unroll 4
            for (int j = 0; j < 32; ++j) { const int idx = F.lane + 64 * j, r = idx >> 7, kk = idx & 127;
                const float c = r < 8 ? F.in[2][r * 1024 + k0 + kk] : F.in[3][(r - 8) * 1024 + k0 + kk];
                scr[kk * 16 + r] = c * sigmoidf_(c); }
            LDS_WAIT(); asm volatile("" ::: "memory");
            float a[16];
#pragma unroll
            for (int r = 0; r < 16; ++r) a[r] = 0.f;
            const float* wp = F.in[10] + ((size_t)l * 1024 + k0) * 6144 + n0 + F.lane;
#pragma unroll 16
            for (int kk = 0; kk < 128; ++kk) {
                const float w = wp[(size_t)kk * 6144];
                const LAS f32x4* sp = (const LAS f32x4*)(scr + kk * 16);
                const f32x4 s0 = sp[0], s1 = sp[1], s2 = sp[2], s3 = sp[3];
                a[0] += s0[0] * w; a[1] += s0[1] * w; a[2] += s0[2] * w; a[3] += s0[3] * w;
                a[4] += s1[0] * w; a[5] += s1[1] * w; a[6] += s1[2] * w; a[7] += s1[3] * w;
                a[8] += s2[0] * w; a[9] += s2[1] * w; a[10] += s2[2] * w; a[11] += s2[3] * w;
                a[12] += s3[0] * w; a[13] += s3[1] * w; a[14] += s3[2] * w; a[15] += s3[3] * w;
            }
            const float bb = (kc == 0) ? F.in[11][l * 6144 + n0 + F.lane] : 0.f;
#pragma unroll
            for (int r = 0; r < 16; ++r) modp[(size_t)kc * (2 * 16 * 6144) + ((size_t)(l * 16 + r)) * 6144 + n0 + F.lane] = a[r] + bb;
            LDS_WAIT(); asm volatile("" ::: "memory");
        }
    }
    if (F.bx == 0) {
        float* bt = (float*)(ws + WS_BIAS);
        for (int i = F.tid; i < 8 * 256; i += NTHREADS) { const int h = i >> 8, ri = i & 255; const int rel = ri - 191;
            bt[i] = (ri < 255) ? F.in[7][rel_bucket(rel) * 8 + h] : 0.f; }
    }
    for (int i = F.bx * NTHREADS + F.tid; i < 2 * 8 * 64 * 128; i += F.G * NTHREADS) {
        const int lb = i >> 13, rem = i & 8191;
        F.out[OKS + (size_t)lb * 16384 + rem] = F.in[4][(size_t)lb * 16384 + 8192 + rem];
        F.out[OVS + (size_t)lb * 16384 + rem] = F.in[5][(size_t)lb * 16384 + 8192 + rem];
    }
    LAS unsigned char* scrb = F.lds + F.wave * 16384;
    constexpr int I_GU = 32768, I_DN = 16384, I_IN = 2176, I_O = 512, I_OA = 256, I_OB = 256;
    constexpr int NITEMS = I_GU + I_DN + I_IN + I_IN + I_O + I_OA + I_OB;
    for (int it = gw; it < NITEMS; it += NGW) {
        int r = it;
        if (r < I_GU) { const int m = r >> 9; transpose64<true>(F.in[23] + (size_t)m * 1024 * 2048, 1024, 2048, ws + WS_WGU + (size_t)m * 2048 * 1024, 1, scrb, r & 511, F.lane); continue; } r -= I_GU;
        if (r < I_DN) { const int m = r >> 8; transpose64<true>(F.in[25] + (size_t)m * 1024 * 1024, 1024, 1024, ws + WS_WDN + (size_t)m * 1024 * 1024, 0, scrb, r & 255, F.lane); continue; } r -= I_DN;
        if (r < I_IN) { const int m = r / 1088; transpose64<false>(F.in[12] + (size_t)m * 1024 * INW, 1024, INW, ws + WS_WIN + (size_t)m * INW * 1024 * 2, 0, scrb, r % 1088, F.lane); continue; } r -= I_IN;
        if (r < I_IN) { const int m = r / 1088; transpose64<true>(F.in[12] + (size_t)m * 1024 * INW, 1024, INW, ws + WS_WIN8 + (size_t)m * INW * 1024, 0, scrb, r % 1088, F.lane); continue; } r -= I_IN;
        if (r < I_O) { const int m = r >> 8; transpose64<true>(F.in[18] + (size_t)m * 1024 * 1024, 1024, 1024, ws + WS_WO + (size_t)m * 1024 * 1024, 0, scrb, r & 255, F.lane); continue; } r -= I_O;
        if (r < I_OA) { const int m = r >> 7; transpose64<true>(F.in[16] + (size_t)m * 512 * 1024, 512, 1024, ws + WS_WOA + (size_t)m * 1024 * 512, 0, scrb, r & 127, F.lane); continue; } r -= I_OA;
        { const int m = r >> 7; transpose64<true>(F.in[17] + (size_t)m * 512 * 1024, 512, 1024, ws + WS_WOB + (size_t)m * 1024 * 512, 0, scrb, r & 127, F.lane); }
    }
}

__device__ __forceinline__ void ln_row(f32x4 (&v)[4], const float* g, const float* b, int lane) {
    float s = 0.f;
#pragma unroll
    for (int j = 0; j < 4; ++j) s += (v[j][0] + v[j][1]) + (v[j][2] + v[j][3]);
    const float mean = wave_sum(s) * (1.0f / D); float s2 = 0.f;
#pragma unroll
    for (int j = 0; j < 4; ++j) { v[j] = v[j] - mean; s2 += (v[j][0] * v[j][0] + v[j][1] * v[j][1]) + (v[j][2] * v[j][2] + v[j][3] * v[j][3]); }
    const float rstd = 1.0f / sqrtf(wave_sum(s2) * (1.0f / D) + LN_EPS);
#pragma unroll
    for (int j = 0; j < 4; ++j) { const f32x4 gg = *(const f32x4*)(g + 4 * lane + 256 * j), bb = *(const f32x4*)(b + 4 * lane + 256 * j); v[j] = v[j] * rstd * gg + bb; }
}
__device__ __forceinline__ void store_mod_row(const f32x4 (&v)[4], const float* sh, const float* sc, bf16_t* hrow, unsigned char* h8row, int lane) {
#pragma unroll
    for (int j = 0; j < 4; ++j) { const f32x4 a = *(const f32x4*)(sc + 4 * lane + 256 * j), b = *(const f32x4*)(sh + 4 * lane + 256 * j);
        const f32x4 h = v[j] * (a + 1.0f) + b; u32x2 w; w.x = cvt_pk_bf16(h[0], h[1]); w.y = cvt_pk_bf16(h[2], h[3]);
        *(u32x2*)(hrow + 4 * lane + 256 * j) = w;
        *(unsigned*)(h8row + 4 * lane + 256 * j) = pk4_fp8(h[0], h[1], h[2], h[3]); }
}

__device__ __forceinline__ void phase0b(Ctx& F) {
    const int gw = F.bx * NWAVES + F.wave, NGW = F.G * NWAVES;
    const float* mod = (const float*)(F.ws + WS_MOD);
    bf16_t* H = (bf16_t*)(F.ws + WS_H);
    for (int row = gw; row < NT; row += NGW) {
        const float* xr = row < NPROMPT ? F.in[0] + (size_t)row * D : F.in[1] + (size_t)(row - NPROMPT) * D;
        f32x4 v[4];
#pragma unroll
        for (int j = 0; j < 4; ++j) v[j] = *(const f32x4*)(xr + 4 * F.lane + 256 * j);
        ln_row(v, F.in[8], F.in[9], F.lane);
#pragma unroll
        for (int j = 0; j < 4; ++j) *(f32x4*)(F.out + (size_t)row * D + 4 * F.lane + 256 * j) = v[j];
        const float* mb = mod + (size_t)batch_of(row) * 6144;
        store_mod_row(v, mb, mb + 1024, H + (size_t)row * D, F.ws + WS_H8 + (size_t)row * D, F.lane);
    }
}

__device__ __forceinline__ void phase_attn(Ctx& F, int l) {
    const bf16_t* Z = (const bf16_t*)(F.ws + WS_Z);
    unsigned char* YA = F.ws + WS_YA;
    unsigned char* YB = F.ws + WS_YB;
    const float* biasr = (const float*)(F.ws + WS_BIAS);
    LAS unsigned char* Ks = F.lds;
    LAS unsigned char* Vt = F.lds + 27648;
    LAS float* bt = (LAS float*)(F.lds + 53248);
    const int lane = F.lane, tid = F.tid;
    for (int au = F.bx; au < 1040; au += F.G) {
        const bool isS = au >= 1024;
        const int kv = au & 1;
        const int b = isS ? ((au - 1024) >> 1) : (au >> 7);
        const int n = isS ? 0 : ((au & 127) >> 1);
        __syncthreads();
        for (int i = tid; i < 1024; i += NTHREADS) bt[i] = biasr[(kv * 4 + (i >> 8)) * 256 + (i & 255)];
#pragma unroll
        for (int jj = 0; jj < 3; ++jj) {
            const int p = tid + NTHREADS * jj, key = p >> 3, ds = p & 7;
            u32x4 kq = (u32x4){0u, 0u, 0u, 0u}, vq = (u32x4){0u, 0u, 0u, 0u};
            if (!isS) {
                const int t = n * 64 + key - 128;
                if (t >= 0) { const bf16_t* zr = Z + (size_t)(b * 4096 + t) * INW + kv * 64 + ds * 8; kq = *(const u32x4*)(zr + 512); vq = *(const u32x4*)(zr + 640); }
            } else if (key < 128) {
                const size_t o = ((size_t)((l * 8 + b) * 128 + key) * 2 + kv) * 64 + ds * 8;
                const f32x4 k0 = *(const f32x4*)(F.in[4] + o), k1 = *(const f32x4*)(F.in[4] + o + 4), v0 = *(const f32x4*)(F.in[5] + o), v1 = *(const f32x4*)(F.in[5] + o + 4);
                kq.x = cvt_pk_bf16(k0[0], k0[1]); kq.y = cvt_pk_bf16(k0[2], k0[3]); kq.z = cvt_pk_bf16(k1[0], k1[1]); kq.w = cvt_pk_bf16(k1[2], k1[3]);
                vq.x = cvt_pk_bf16(v0[0], v0[1]); vq.y = cvt_pk_bf16(v0[2], v0[3]); vq.z = cvt_pk_bf16(v1[0], v1[1]); vq.w = cvt_pk_bf16(v1[2], v1[3]);
            } else {
                const bf16_t* zr = Z + (size_t)(NPROMPT + b * 64 + key - 128) * INW + kv * 64 + ds * 8; kq = *(const u32x4*)(zr + 512); vq = *(const u32x4*)(zr + 640);
            }
            *(LAS u32x4*)(Ks + key * 144 + ds * 16) = kq;
            LAS unsigned short* vp = (LAS unsigned short*)Vt + (ds * 8) * 200 + key;
            vp[0 * 200] = (unsigned short)(vq.x & 0xffffu); vp[1 * 200] = (unsigned short)(vq.x >> 16);
            vp[2 * 200] = (unsigned short)(vq.y & 0xffffu); vp[3 * 200] = (unsigned short)(vq.y >> 16);
            vp[4 * 200] = (unsigned short)(vq.z & 0xffffu); vp[5 * 200] = (unsigned short)(vq.z >> 16);
            vp[6 * 200] = (unsigned short)(vq.w & 0xffffu); vp[7 * 200] = (unsigned short)(vq.w >> 16);
        }
        __syncthreads();
        const int g = F.wave >> 1, qi = (F.wave & 1) * 32 + (lane & 31), hh = lane >> 5, head = kv * 4 + g;
        const int qrow = isS ? NPROMPT + b * 64 + qi : b * 4096 + n * 64 + qi;
        bf16x8 Qf[4];
#pragma unroll
        for (int ks = 0; ks < 4; ++ks) Qf[ks] = *(const bf16x8*)(Z + (size_t)qrow * INW + head * 64 + ks * 16 + hh * 8);
        f32x16 S[6];
#pragma unroll
        for (int kb = 0; kb < 6; ++kb) {
#pragma unroll
            for (int j = 0; j < 16; ++j) S[kb][j] = 0.f;
#pragma unroll
            for (int ks = 0; ks < 4; ++ks) {
                const bf16x8 A = *(const LAS bf16x8*)(Ks + (kb * 32 + (lane & 31)) * 144 + (ks * 16 + hh * 8) * 2);
                S[kb] = __builtin_amdgcn_mfma_f32_32x32x16_bf16(A, Qf[ks], S[kb], 0, 0, 0);
            }
        }
        const float sinkv = F.in[14][l * 8 + head];
        float mx = sinkv;
        const int kmin = isS ? 0 : (128 - n * 64);
#pragma unroll
        for (int kb = 0; kb < 6; ++kb)
#pragma unroll
            for (int j = 0; j < 16; ++j) {
                const int key = kb * 32 + 8 * (j >> 2) + 4 * hh + (j & 3);
                float sv = S[kb][j] * 0.125f + bt[g * 256 + key - qi + 63];
                sv = key >= kmin ? sv : -1e30f;
                S[kb][j] = sv; mx = fmaxf(mx, sv);
            }
        mx = fmaxf(mx, __shfl_xor(mx, 32));
        float sum = 0.f;
#pragma unroll
        for (int kb = 0; kb < 6; ++kb)
#pragma unroll
            for (int j = 0; j < 16; ++j) { const float p = __expf(S[kb][j] - mx); S[kb][j] = p; sum += p; }
        sum += __shfl_xor(sum, 32);
        sum += __expf(sinkv - mx);
        const float inv = 1.0f / sum;
        f32x16 O[2];
#pragma unroll
        for (int db = 0; db < 2; ++db)
#pragma unroll
            for (int j = 0; j < 16; ++j) O[db][j] = 0.f;
#pragma unroll
        for (int kb = 0; kb < 6; ++kb)
#pragma unroll
            for (int s2 = 0; s2 < 2; ++s2) {
                union { bf16x8 v; unsigned u[4]; } P;
#pragma unroll
                for (int q = 0; q < 4; ++q) P.u[q] = cvt_pk_bf16(S[kb][8 * s2 + 2 * q], S[kb][8 * s2 + 2 * q + 1]);
#pragma unroll
                for (int db = 0; db < 2; ++db) {
                    const LAS unsigned char* vb = Vt + (db * 32 + (lane & 31)) * 400 + (kb * 32 + 16 * s2 + 4 * hh) * 2;
                    union { bf16x8 v; u32x2 h[2]; } Vf;
                    Vf.h[0] = *(const LAS u32x2*)vb; Vf.h[1] = *(const LAS u32x2*)(vb + 16);
                    O[db] = __builtin_amdgcn_mfma_f32_32x32x16_bf16(Vf.v, P.v, O[db], 0, 0, 0);
                }
            }
        unsigned char* orow = YA + (size_t)qrow * 512 + head * 64 + 4 * hh; const float inv8 = inv * 8.0f;
#pragma unroll
        for (int db = 0; db < 2; ++db)
#pragma unroll
            for (int jq = 0; jq < 4; ++jq) {
                *(unsigned*)(orow + db * 32 + 8 * jq) = pk4_fp8(O[db][4 * jq] * inv8, O[db][4 * jq + 1] * inv8, O[db][4 * jq + 2] * inv8, O[db][4 * jq + 3] * inv8);
            }
    }
    const int gw = F.bx * NWAVES + F.wave, NGW = F.G * NWAVES;
    const float* cw = F.in[15] + (size_t)l * 3 * 512 + 8 * lane;
    float w0[8], w1[8], w2[8];
#pragma unroll
    for (int e = 0; e < 8; ++e) { w0[e] = cw[e]; w1[e] = cw[512 + e]; w2[e] = cw[1024 + e]; }
    for (int row = gw; row < NT; row += NGW) {
        const bool isS = row >= NPROMPT; const int b = isS ? ((row - NPROMPT) >> 6) : (row >> 12), t = isS ? ((row - NPROMPT) & 63) : (row & 4095);
        const bf16_t* zr = Z + (size_t)row * INW + 8 * lane;
        const u32x4 cb = *(const u32x4*)(zr + 768);
        float u[3][8];
#pragma unroll
        for (int d = 0; d < 3; ++d) {
            if (t - d >= 0) {
                const bf16_t* zz = zr - (size_t)d * INW; const u32x4 cc = *(const u32x4*)(zz + 1280), cx = *(const u32x4*)(zz + 1792);
                u[d][0] = bf_lo(cc.x) * bf_lo(cx.x); u[d][1] = bf_hi(cc.x) * bf_hi(cx.x); u[d][2] = bf_lo(cc.y) * bf_lo(cx.y); u[d][3] = bf_hi(cc.y) * bf_hi(cx.y);
                u[d][4] = bf_lo(cc.z) * bf_lo(cx.z); u[d][5] = bf_hi(cc.z) * bf_hi(cx.z); u[d][6] = bf_lo(cc.w) * bf_lo(cx.w); u[d][7] = bf_hi(cc.w) * bf_hi(cx.w);
            } else if (isS) {
                const float* hp = F.in[6] + ((size_t)(l * 8 + b) * 2 + (2 + t - d)) * 512 + 8 * lane;
                const f32x4 h0 = *(const f32x4*)hp, h1 = *(const f32x4*)(hp + 4);
#pragma unroll
                for (int e = 0; e < 4; ++e) { u[d][e] = h0[e]; u[d][4 + e] = h1[e]; }
            } else {
#pragma unroll
                for (int e = 0; e < 8; ++e) u[d][e] = 0.f;
            }
        }
        const float cbf[8] = {bf_lo(cb.x), bf_hi(cb.x), bf_lo(cb.y), bf_hi(cb.y), bf_lo(cb.z), bf_hi(cb.z), bf_lo(cb.w), bf_hi(cb.w)};
        float y[8];
#pragma unroll
        for (int e = 0; e < 8; ++e) y[e] = cbf[e] * (w0[e] * u[2][e] + w1[e] * u[1][e] + w2[e] * u[0][e]);
        u32x2 w; w.x = pk4_fp8(y[0], y[1], y[2], y[3]); w.y = pk4_fp8(y[4], y[5], y[6], y[7]);
        *(u32x2*)(YB + (size_t)row * 512 + 8 * lane) = w;
        const int tl = isS ? 62 : 4094;
        if (t >= tl) {
            float* o = F.out + (isS ? OCS : OCP) + ((size_t)(l * 8 + b) * 2 + (t - tl)) * 512 + 8 * lane;
            *(f32x4*)o = (f32x4){u[0][0], u[0][1], u[0][2], u[0][3]}; *(f32x4*)(o + 4) = (f32x4){u[0][4], u[0][5], u[0][6], u[0][7]};
        }
    }
}

__device__ __forceinline__ void phase_ln_router(Ctx& F, int l) {
    float* X = F.out; unsigned char* H8 = (unsigned char*)(F.ws + WS_H8); const bf16_t* V16 = (const bf16_t*)(F.ws + WS_V16);
    const float* mod = (const float*)(F.ws + WS_MOD) + (size_t)l * 16 * 6144;
    unsigned* cnt = (unsigned*)(F.ws + WS_CNT) + l * 2048;
    unsigned* tok = (unsigned*)(F.ws + WS_TOK); float* gate = (float*)(F.ws + WS_GATE); unsigned* slot = (unsigned*)(F.ws + WS_SLOT);
    const float* Wr = F.in[21] + (size_t)l * 1024 * 32;
    LAS float* hf = (LAS float*)F.lds;
    LAS unsigned* hist = (LAS unsigned*)(F.lds + 139264); LAS unsigned* hbase = hist + 32;
    const int lane = F.lane, w = F.wave;
    for (int tile = F.bx; tile < NT / 32; tile += F.G) {
        __syncthreads();
        if (F.tid < 32) hist[F.tid] = 0u;
        for (int rr = 0; rr < 4; ++rr) {
            const int rl = w * 4 + rr, row = tile * 32 + rl;
            f32x4 v[4];
#pragma unroll
            for (int j = 0; j < 4; ++j) { const u32x2 pv = *(const u32x2*)(V16 + (size_t)row * D + 4 * lane + 256 * j); v[j] = (f32x4){bf_lo(pv.x), bf_hi(pv.x), bf_lo(pv.y), bf_hi(pv.y)}; }
            ln_row(v, F.in[19] + l * D, F.in[20] + l * D, lane);
#pragma unroll
            for (int j = 0; j < 4; ++j) *(f32x4*)(X + (size_t)row * D + 4 * lane + 256 * j) = v[j];
            const float* mb = mod + (size_t)batch_of(row) * 6144;
#pragma unroll
            for (int j = 0; j < 4; ++j) { const f32x4 a = *(const f32x4*)(mb + 4096 + 4 * lane + 256 * j), b = *(const f32x4*)(mb + 3072 + 4 * lane + 256 * j);
                const f32x4 h = v[j] * (a + 1.0f) + b;
                *(unsigned*)(H8 + (size_t)row * D + 4 * lane + 256 * j) = pk4_fp8(h[0], h[1], h[2], h[3]);
                LAS float* hp = hf + rl * 1025 + 4 * lane + 256 * j; hp[0] = h[0]; hp[1] = h[1]; hp[2] = h[2]; hp[3] = h[3]; }
        }
        __syncthreads();
        f32x16 acc;
#pragma unroll
        for (int j = 0; j < 16; ++j) acc[j] = 0.f;
        {
            const LAS float* ap = hf + (lane & 31) * 1025 + 128 * w + (lane >> 5);
            const float* bp = Wr + (size_t)(128 * w) * 32 + lane;
#pragma unroll 8
            for (int s = 0; s < 64; ++s) acc = __builtin_amdgcn_mfma_f32_32x32x2f32(ap[2 * s], bp[64 * s], acc, 0, 0, 0);
        }
        __syncthreads();
        LAS float* red = hf;
#pragma unroll
        for (int j = 0; j < 16; ++j) red[(w * 32 + 8 * (j >> 2) + 4 * (lane >> 5) + (j & 3)) * 33 + (lane & 31)] = acc[j];
        __syncthreads();
        int e_sel[4]; float g_sel[4]; unsigned loc[4];
#pragma unroll
        for (int rr = 0; rr < 4; ++rr) {
            const int tk = w * 4 + rr;
            float val = -INFINITY;
            if (lane < 32) { float sacc = F.in[22][l * 32 + lane];
#pragma unroll
                for (int ww = 0; ww < 8; ++ww) sacc += red[(ww * 32 + tk) * 33 + lane];
                val = sacc; }
            float tv[4]; int te[4];
#pragma unroll
            for (int it = 0; it < 4; ++it) {
                float bv = val; int bi = lane;
#pragma unroll
                for (int off = 32; off >= 1; off >>= 1) { const float ov = __shfl_xor(bv, off); const int oi = __shfl_xor(bi, off);
                    if (ov > bv || (ov == bv && oi < bi)) { bv = ov; bi = oi; } }
                tv[it] = bv; te[it] = bi; if (lane == bi) val = -INFINITY;
            }
            const float e1 = __expf(tv[1] - tv[0]), e2 = __expf(tv[2] - tv[0]), e3 = __expf(tv[3] - tv[0]);
            const float rs = 1.0f / (1.0f + e1 + e2 + e3);
            e_sel[rr] = lane == 0 ? te[0] : lane == 1 ? te[1] : lane == 2 ? te[2] : te[3];
            g_sel[rr] = (lane == 0 ? 1.0f : lane == 1 ? e1 : lane == 2 ? e2 : e3) * rs;
            loc[rr] = 0u;
            if (lane < 4) loc[rr] = atomicAdd((unsigned*)&hist[e_sel[rr]], 1u);
        }
        __syncthreads();
        if (F.tid < 32) { const unsigned hcount = hist[F.tid]; hbase[F.tid] = hcount ? atomicAdd(cnt + F.tid * 64, hcount) : 0u; }
        __syncthreads();
        if (lane < 4) {
#pragma unroll
            for (int rr = 0; rr < 4; ++rr) {
                const int row = tile * 32 + w * 4 + rr, e = e_sel[rr]; const unsigned rank = hbase[e] + loc[rr];
                tok[(size_t)e * NT + rank] = (unsigned)row; gate[(size_t)e * NT + rank] = g_sel[rr]; slot[(size_t)row * 4 + lane] = ((unsigned)e << 24) | rank;
            }
        }
    }
}

__device__ __forceinline__ void build_blk(Ctx& F, int l) {
    LAS int* blk = (LAS int*)(F.lds + LDS_BLK);
    const unsigned* cnt = (const unsigned*)(F.ws + WS_CNT) + l * 2048;
    __syncthreads();
    if (F.tid == 0) { int s = 0; for (int e = 0; e < 32; ++e) { blk[e] = s; s += ((int)cnt[e * 64] + 255) >> 8; } blk[32] = s; }
    __syncthreads();
}

__device__ __forceinline__ void phase_combine(Ctx& F, int l) {
    const LAS int* blk = (const LAS int*)(F.lds + LDS_BLK);
    float* X = F.out; bf16_t* H = (bf16_t*)(F.ws + WS_H); const unsigned char* YS = F.ws + WS_YS;
    const unsigned* slot = (const unsigned*)(F.ws + WS_SLOT);
    const float* mod = (const float*)(F.ws + WS_MOD);
    const int gw = F.bx * NWAVES + F.wave, NGW = F.G * NWAVES, lane = F.lane;
    for (int row = gw; row < NT; row += NGW) {
        f32x4 ff[4];
#pragma unroll
        for (int j = 0; j < 4; ++j) ff[j] = (f32x4){0.f, 0.f, 0.f, 0.f};
#pragma unroll
        for (int k = 0; k < 4; ++k) {
            const unsigned s = slot[(size_t)row * 4 + k]; const int e = (int)(s >> 24), rank = (int)(s & 0xffffffu);
            const unsigned char* yr = YS + ((size_t)blk[e] * 256 + rank) * D + 4 * lane;
#pragma unroll
            for (int j = 0; j < 4; ++j) { const unsigned wv = *(const unsigned*)(yr + 256 * j); const f32x2 lo = __builtin_amdgcn_cvt_pk_f32_fp8(wv, false), hi = __builtin_amdgcn_cvt_pk_f32_fp8(wv, true);
                ff[j][0] += lo.x; ff[j][1] += lo.y; ff[j][2] += hi.x; ff[j][3] += hi.y; }
        }
        const int bi = batch_of(row);
        const float* mb = mod + (size_t)(l * 16 + bi) * 6144;
        f32x4 v[4];
#pragma unroll
        for (int j = 0; j < 4; ++j) { const f32x4 x = *(const f32x4*)(X + (size_t)row * D + 4 * lane + 256 * j), g2 = *(const f32x4*)(mb + 5120 + 4 * lane + 256 * j);
            v[j] = x * ALPHA + (g2 + 1.0f) * (ff[j] * 0.0625f); }
        ln_row(v, F.in[27] + l * D, F.in[28] + l * D, lane);
#pragma unroll
        for (int j = 0; j < 4; ++j) *(f32x4*)(X + (size_t)row * D + 4 * lane + 256 * j) = v[j];
        if (l == 0) { const float* mn = mod + (size_t)(16 + bi) * 6144; store_mod_row(v, mn, mn + 1024, H + (size_t)row * D, F.ws + WS_H8 + (size_t)row * D, lane); }
    }
}

#ifndef PH_MASK
#define PH_MASK 0xFFFF
#endif
#define PH(b) ((PH_MASK >> (b)) & 1)
#ifndef PROBE_MASK
#define PROBE_MASK 0
#endif
#define PB0(id) do { if ((PROBE_MASK >> (id)) & 1) pb_t0 = __builtin_amdgcn_s_memrealtime(); } while (0)
#define PB1(id) do { if ((PROBE_MASK >> (id)) & 1) pb_acc += __builtin_amdgcn_s_memrealtime() - pb_t0; } while (0)
#define RELOAD() do { int t_ = threadIdx.x; asm volatile("" : "+v"(t_)); F.tid = t_; F.lane = t_ & 63; F.wave = __builtin_amdgcn_readfirstlane(t_ >> 6); \
    unsigned z_; asm volatile("s_mov_b32 %0, 0" : "=s"(z_)); F.in = p.in; F.out = p.out + z_; F.ws = p.ws + z_; } while (0)
#define LAYER_BODY(l) do { \
          \
        PB0(2); RELOAD(); \
        if (PH(2)) { \
              \
            pg8::SchedDense S; S.init(NT, 7 * 256, D, F.G, F.bx, (const bf16_t*)(F.ws + WS_WIN) + (size_t)l * INW * D, 2); \
            pg8::EpiZ E{(bf16_t*)(F.ws + WS_Z), F.in[13] + l * INW, F.out, l}; \
            pg8::gemm_phase<false, 0u>(F.lds, (const char*)(F.ws + WS_H), D, S, E); \
        } \
        RELOAD(); \
        if (PH(2)) { \
              \
            pg8::SchedDense S; S.init(NT, 10 * 256, 512, F.G, (F.G == 256) ? ((F.bx + 112) & 255) : F.bx, F.ws + WS_WIN8 + (size_t)l * INW * D, 0, 2, 7); \
            pg8::EpiZ E{(bf16_t*)(F.ws + WS_Z), F.in[13] + l * INW, F.out, l}; \
            pg8::gemm_phase<true, 0x7f7f7f7fu>(F.lds, (const char*)(F.ws + WS_H8), 512, S, E); \
        } \
        xcd_barrier(xbar); PB1(2); PB0(3); \
        RELOAD(); \
        if (PH(3)) phase_attn(F, l); \
        xcd_barrier(xbar); PB1(3); PB0(4); \
          \
        RELOAD(); \
        if (PH(4)) { \
            pg8::SchedDense S; S.init(NT, D, 256, F.G, F.bx, F.ws + WS_WOA + (size_t)l * D * 512); \
            pg8::EpiT1 E{(bf16_t*)(F.ws + WS_T1), (const bf16_t*)(F.ws + WS_Z)}; \
            pg8::gemm_phase<true, 0x7c7c7c7cu>(F.lds, (const char*)(F.ws + WS_YA), 256, S, E); \
        } \
        RELOAD(); \
        if (PH(5)) { \
            pg8::SchedDense S; S.init(NT, D, 256, F.G, F.bx, F.ws + WS_WOB + (size_t)l * D * 512); \
            pg8::EpiMix E{(const bf16_t*)(F.ws + WS_T1), (const bf16_t*)(F.ws + WS_Z), F.ws + WS_MIX}; \
            pg8::gemm_phase<true, 0x7f7f7f7fu>(F.lds, (const char*)(F.ws + WS_YB), 256, S, E); \
        } \
        xcd_barrier(xbar); PB1(4); PB0(5); \
          \
        RELOAD(); \
        if (PH(6)) { \
            pg8::SchedDense S; S.init(NT, D, 512, F.G, F.bx, F.ws + WS_WO + (size_t)l * D * D); \
            pg8::EpiX E{F.out, (bf16_t*)(F.ws + WS_V16), (const float*)(F.ws + WS_MOD) + (size_t)l * 16 * 6144}; \
            pg8::gemm_phase<true, 0x7f7f7f7fu>(F.lds, (const char*)(F.ws + WS_MIX), 512, S, E); \
        } \
        xcd_barrier(xbar); PB1(5); PB0(6); \
        RELOAD(); \
        if (PH(7)) phase_ln_router(F, l); \
        xcd_barrier(xbar); PB1(6); PB0(7); \
          \
        RELOAD(); \
        build_blk(F, l); \
        if (PH(8)) { \
            LAS int* blk = (LAS int*)(F.lds + LDS_BLK); \
            LAS unsigned short* idx = (LAS unsigned short*)(F.lds + LDS_IDX); \
            pg8::SchedMoE<true> S; S.init(blk, idx, 8, 512, F.G, F.bx, (const unsigned char*)(F.ws + WS_WGU) + (size_t)l * 32 * 2048 * D, (size_t)2048 * D); \
            const unsigned* cnt = (const unsigned*)(F.ws + WS_CNT) + l * 2048; const unsigned* tok = (const unsigned*)(F.ws + WS_TOK); \
            for (int i = 0; i < MAXU; ++i) { pg8::Unit u; if (!S.next(i, u)) break; \
                if (F.tid < 256) { int rank = (u.pm - blk[u.e]) * 256 + F.tid; const int ce = (int)cnt[u.e * 64]; rank = rank < ce ? rank : ce - 1; \
                    idx[i * 256 + F.tid] = (unsigned short)tok[(size_t)u.e * NT + rank]; } } \
            __syncthreads(); \
            pg8::EpiAct E{(unsigned char*)(F.ws + WS_ACT), F.in[24] + (size_t)l * 32 * 2048}; \
            pg8::gemm_phase<true, 0x7f7f7f7fu>(F.lds, (const char*)(F.ws + WS_H8), 512, S, E); \
        } \
        xcd_barrier(xbar); PB1(7); PB0(8); \
          \
        RELOAD(); \
        if (PH(9)) { \
            LAS int* blk = (LAS int*)(F.lds + LDS_BLK); \
            LAS unsigned short* idx = (LAS unsigned short*)(F.lds + LDS_IDX); \
            pg8::SchedMoE<false> S; S.init(blk, idx, 4, 512, F.G, F.bx, (const unsigned char*)(F.ws + WS_WDN) + (size_t)l * 32 * D * D, (size_t)D * D); \
            pg8::EpiYs E{F.ws + WS_YS, F.in[26] + (size_t)l * 32 * D, (const float*)(F.ws + WS_GATE), (const unsigned*)(F.ws + WS_CNT) + l * 2048, blk}; \
            pg8::gemm_phase<true, 0x7f7f7f7fu>(F.lds, (const char*)(F.ws + WS_ACT), 512, S, E); \
        } \
        xcd_barrier(xbar); PB1(8); PB0(9); \
        RELOAD(); \
        if (PH(10)) phase_combine(F, l); \
        if (l == 0) xcd_barrier(xbar); \
        PB1(9); \
 \
    } while (0)
__global__ void __launch_bounds__(NTHREADS, 2) fwd_megakernel(Params p) {
    extern __shared__ __attribute__((aligned(16))) unsigned char lds_raw[];
    cg::grid_group grid = cg::this_grid();
    Ctx F;
    F.lds = (LAS unsigned char*)lds_raw;
    F.G = gridDim.x; F.bx = blockIdx.x;
    volatile LAS unsigned* bst = (volatile LAS unsigned*)(F.lds + 147392);
    if (threadIdx.x < 2) bst[threadIdx.x] = 0u;
    __syncthreads();
    const XcdBarrier xbar = xcd_barrier_post((unsigned*)(p.ws + WS_BAR), bst);
    unsigned long long pb_t0 = 0, pb_acc = 0;
    PB0(0); RELOAD();
    if (PH(0)) phase0a(F);
    grid.sync();
    PB1(0); PB0(1); RELOAD();
    { const float* modp = (const float*)(F.ws + WS_MODP); float* mod = (float*)(F.ws + WS_MOD);
      for (int i = F.bx * NTHREADS + F.tid; i < 2 * 16 * 6144; i += F.G * NTHREADS) { float sm = 0.f;
#pragma unroll
          for (int kc = 0; kc < 8; ++kc) sm += modp[(size_t)kc * (2 * 16 * 6144) + i];
          mod[i] = sm; } }
    xcd_barrier(xbar);
    RELOAD();
    if (PH(1)) phase0b(F);
    xcd_barrier(xbar); PB1(1);

    LAYER_BODY(0);
    LAYER_BODY(1);
    if (PROBE_MASK != 0 && blockIdx.x == 0) { const unsigned long long te = __builtin_amdgcn_s_memrealtime(); while (__builtin_amdgcn_s_memrealtime() - te < pb_acc) __builtin_amdgcn_s_sleep(8); }
    (void)pb_t0; (void)pb_acc;
}

extern "C" void kernel_launch(void* const* d_in, const int* in_sizes, int n_in, void* d_out, int out_size, void* d_ws, size_t ws_size, hipStream_t stream) {
    static int grid = 0;
    if (grid == 0) {
        if (n_in != 29 || ws_size < WS_END) { fprintf(stderr, "kernel_launch: unexpected n_in %d / ws_size %zu (need %zu)\n", n_in, ws_size, (size_t)WS_END); grid = -1; return; }
        int dev = 0, cus = 0, per_cu = 0;
        hipGetDevice(&dev);
        hipDeviceGetAttribute(&cus, hipDeviceAttributeMultiprocessorCount, dev);
        if (hipFuncSetAttribute((const void*)fwd_megakernel, hipFuncAttributeMaxDynamicSharedMemorySize, LDS_BYTES) != hipSuccess) { fprintf(stderr, "kernel_launch: hipFuncSetAttribute failed\n"); grid = -1; return; }
        if (hipOccupancyMaxActiveBlocksPerMultiprocessor(&per_cu, (const void*)fwd_megakernel, NTHREADS, LDS_BYTES) != hipSuccess || per_cu < 1) { fprintf(stderr, "kernel_launch: occupancy query says %d blocks per CU\n", per_cu); per_cu = 1; }
        (void)hipGetLastError();
        grid = cus;
        if (grid != 256) fprintf(stderr, "kernel_launch: note: %d CUs (built for 256)\n", grid);
    }
    if (grid < 0) return;
    hipMemsetAsync((char*)d_ws, 0, WS_ZERO_BYTES, stream);
    Params p{};
    for (int i = 0; i < 29; ++i) p.in[i] = (const float*)d_in[i];
    p.out = (float*)d_out; p.ws = (unsigned char*)d_ws;
    void* args[] = {&p};
    hipError_t e = hipLaunchCooperativeKernel((const void*)fwd_megakernel, dim3(grid), dim3(NTHREADS), args, LDS_BYTES, stream);
    if (e != hipSuccess) fprintf(stderr, "kernel_launch: cooperative launch failed: %s (grid %d)\n", hipGetErrorString(e), grid);
}
```

```cpp
#include <hip/hip_runtime.h>
#include <hip/hip_cooperative_groups.h>
#include <cstdio>
#include <cstdint>
namespace cg = cooperative_groups;

#define LAS __attribute__((address_space(3)))
typedef unsigned short bf16_t;
typedef short bf16x8 __attribute__((ext_vector_type(8)));
typedef float f32x4 __attribute__((ext_vector_type(4)));
typedef float f32x16 __attribute__((ext_vector_type(16)));
typedef unsigned u32x4 __attribute__((ext_vector_type(4)));
typedef unsigned u32x2 __attribute__((ext_vector_type(2)));
typedef float f32x2 __attribute__((ext_vector_type(2)));
typedef int i32x4 __attribute__((ext_vector_type(4)));
typedef int i32x8 __attribute__((ext_vector_type(8)));

constexpr int D = 1024, NPROMPT = 32768, NT = 33280, INW = 4352, NEXP = 32;
constexpr float ALPHA = 1.41421356237f, LN_EPS = 1e-5f;
constexpr int NWAVES = 8, NTHREADS = 512;
constexpr int LDS_BYTES = 147456;
constexpr int LDS_BLK = 131072;
constexpr int LDS_IDX = 131072 + 256;
constexpr int MAXU = 24;
constexpr size_t OKP = 34078720, OVP = 34340864, OCP = 34603008, OKS = 34619392, OVS = 34881536, OCS = 35143680;
constexpr size_t MiB = 1u << 20;
constexpr size_t WS_CNT = 0;
constexpr size_t WS_BAR = 16384;
constexpr size_t WS_MOD = 65536;
constexpr size_t WS_MODP = 192 * MiB;
constexpr size_t WS_ZERO_BYTES = 1 * MiB;
constexpr size_t WS_BIAS = 1 * MiB;
constexpr size_t WS_SLOT = 2 * MiB;
constexpr size_t WS_TOK = 3 * MiB;
constexpr size_t WS_GATE = 8 * MiB;
constexpr size_t WS_WIN = 16 * MiB;
constexpr size_t WS_WIN8 = 180 * MiB;
constexpr size_t WS_WOA = 34 * MiB;
constexpr size_t WS_WOB = 36 * MiB;
constexpr size_t WS_WO = 38 * MiB;
constexpr size_t WS_WGU = 48 * MiB;
constexpr size_t WS_WDN = 304 * MiB;
constexpr size_t WS_H = 432 * MiB;
constexpr size_t WS_H8 = 1600 * MiB;
constexpr size_t WS_Z = 498 * MiB;
constexpr size_t WS_YA = 776 * MiB;
constexpr size_t WS_YB = 810 * MiB;
constexpr size_t WS_T1 = 844 * MiB;
constexpr size_t WS_V16 = 910 * MiB;
constexpr size_t WS_XB = 1200 * MiB;
constexpr size_t WS_MIX = 976 * MiB;
constexpr size_t WS_ACT = 1042 * MiB;
constexpr size_t WS_YS = 1320 * MiB;
constexpr size_t WS_END = 1634 * MiB;

struct Params { const float* in[29]; float* out; unsigned char* ws; };

__device__ __forceinline__ unsigned cvt_pk_bf16(float lo, float hi) { unsigned r; asm volatile("v_cvt_pk_bf16_f32 %0, %1, %2" : "=v"(r) : "v"(lo), "v"(hi)); return r; }
__device__ __forceinline__ unsigned pk4_fp8(float a, float b, float c, float d) { unsigned w = 0u; w = __builtin_amdgcn_cvt_pk_fp8_f32(a, b, w, false); w = __builtin_amdgcn_cvt_pk_fp8_f32(c, d, w, true); return w; }
__device__ __forceinline__ float bf_lo(unsigned w) { return __uint_as_float(w << 16); }
__device__ __forceinline__ float bf_hi(unsigned w) { return __uint_as_float(w & 0xffff0000u); }
__device__ __forceinline__ float sigmoidf_(float x) { return __builtin_amdgcn_rcpf(1.0f + __expf(-x)); }
__device__ __forceinline__ float wave_sum(float v) {
#pragma unroll
    for (int o = 1; o < 64; o <<= 1) v += __shfl_xor(v, o);
    return v;
}
__device__ __forceinline__ int batch_of(int row) { return row < NPROMPT ? (row >> 12) : 8 + ((row - NPROMPT) >> 6); }

namespace pg8 {
constexpr int BM = 256, BK = 64, HALF = 128, HTB = HALF * BK * 2, NXCD = 8, WGM = 8;
__device__ __forceinline__ int lds_byte(int r, int c) { const int st = (r >> 4) * 2 + (c >> 5), rr = r & 15, cc = c & 31, ob = rr * 64 + cc * 2; return st * 1024 + (ob ^ (((ob >> 9) & 1) << 5)); }
__device__ __forceinline__ void stage_rc(int b, int& R, int& C) { const int st = b / 1024, sb = b % 1024, swz = sb ^ (((sb >> 9) & 1) << 5); R = (st >> 1) * 16 + swz / 64; C = (st & 1) * 32 + (swz % 64) / 2; }
__device__ __forceinline__ int perm32(int rho) { const int n = rho >> 4, i = rho & 15; return 8 * (i >> 2) + 4 * n + (i & 3); }

struct Unit { int pm, pn, e; const char* b; };

struct SchedDense {
    int nM, nN, nwg, G, c, cbase, csplit, cskip; const char* Bt; size_t tstepB;
    __device__ __forceinline__ void init(int M, int N, int K, int G_, int c_, const void* Bt_, int cbase_ = 0, int csplit_ = 1 << 20, int cskip_ = 0) { nM = M / BM; nN = N / BM; nwg = nM * nN; G = G_; c = c_; Bt = (const char*)Bt_; tstepB = (size_t)BM * K * 2; cbase = cbase_; csplit = csplit_; cskip = cskip_; }
    __device__ __forceinline__ bool next(int i, Unit& u) const {
        const long L = (long)i * G + c; if (L >= nwg) return false;
        int wgid = (int)L; { const int q = nwg / NXCD, r = nwg % NXCD, xcd = wgid % NXCD, off = wgid / NXCD; wgid = (xcd < r ? xcd * (q + 1) : r * (q + 1) + (xcd - r) * q) + off; }
        const int nig = WGM * nN, gid = wgid / nig, fm = gid * WGM, gsz = (nM - fm) < WGM ? (nM - fm) : WGM;
        u.pm = fm + ((wgid % nig) % gsz); const int j = (wgid % nig) / gsz; u.pn = j < csplit ? j + cbase : j + cbase + cskip; u.e = 0; u.b = Bt + (size_t)u.pn * tstepB; return true;
    }
    __device__ __forceinline__ unsigned rowidx(int, const Unit& u, int r) const { return (unsigned)(u.pm * BM + r); }
};
template <bool GATHER> struct SchedMoE {
    const LAS int* blk; const LAS unsigned short* idx; int NB, RBX, NPN, NXs, perx, cx, cj; const char* Bt; size_t estep, tstepB;
    __device__ __forceinline__ void init(const LAS int* blk_, const LAS unsigned short* idx_, int NPN_, int K, int G, int c, const void* Bt_, size_t estep_) {
        blk = blk_; idx = idx_; NB = blk_[32]; NPN = NPN_; Bt = (const char*)Bt_; estep = estep_; tstepB = (size_t)BM * K * 2;
        if ((G & 7) == 0) { NXs = 8; perx = G >> 3; cx = c & 7; cj = c >> 3; } else { NXs = 1; perx = G; cx = 0; cj = c; }
        RBX = (NB + NXs - 1) / NXs;
    }
    __device__ __forceinline__ bool next(int i, Unit& u) const {
        const int j = i * perx + cj, rbl = j / NPN; if (rbl >= RBX) return false;
        const int rb = cx * RBX + rbl; if (rb >= NB) return false;
        int e = 0;
        for (int q = 1; q < 32; ++q) e = (blk[q] <= rb) ? q : e;
        u.pm = rb; u.pn = j - rbl * NPN; u.e = e; u.b = Bt + (size_t)e * estep + (size_t)u.pn * tstepB; return true;
    }
    __device__ __forceinline__ unsigned rowidx(int ui, const Unit& u, int r) const { if (GATHER) return (unsigned)idx[ui * 256 + r]; return (unsigned)(u.pm * BM + r); }
};

template <bool FP8, unsigned ASCALE, class Epi, class Sched>
__device__ __forceinline__ void gemm_phase(LAS unsigned char* lds, const char* Abase, const int K, const Sched& S, const Epi& E) {
    int tid_ = threadIdx.x; asm volatile("" : "+v"(tid_));
    const int tid = tid_, wid = __builtin_amdgcn_readfirstlane(tid >> 6), lane = tid & 63, wr = wid >> 2, wc = wid & 3, fr = lane & 15, fq = lane >> 4;
    int nt_ = K / BK; asm volatile("" : "+s"(nt_)); const int nt = nt_;
    unsigned voffB[2]; int RA[2], CA[2];
#pragma unroll
    for (int i = 0; i < 2; ++i) { int R, C; stage_rc(tid * 16 + i * 8192, R, C); const int Rb = Epi::PERM ? ((R & ~31) + perm32(R & 31)) : R;
        voffB[i] = (unsigned)(Rb * K + C) * 2u; RA[i] = R; CA[i] = C * 2; }
    const size_t kstep = (size_t)(BK * 2);
    const size_t hstep = (size_t)HALF * K * 2;
    const unsigned ldsw = (unsigned)wid * 1024u;
    const unsigned rowb = (unsigned)K * 2u;
    const int aoff = lds_byte(wr * 64 + fr, fq * 8), boff = lds_byte(wc * 32 + fr, fq * 8);
#define PG8_SA(b, h) (((b) * 2 + (h)) * HTB)
#define PG8_SB(b, h) ((4 + (b) * 2 + (h)) * HTB)
#define PG8_STAGE(bufoff, gbase, voff) do { _Pragma("unroll") for (int _i = 0; _i < 2; ++_i) \
        __builtin_amdgcn_global_load_lds((const unsigned*)((const char*)(gbase) + (voff)[_i]), (LAS unsigned*)(lds + (bufoff) + ldsw + _i * 8192), 16, 0, 0); } while (0)
#define PG8_LDA(dst, b, h) do { _Pragma("unroll") for (int m = 0; m < 4; ++m) _Pragma("unroll") for (int k = 0; k < 2; ++k) dst[m][k] = *(const LAS bf16x8*)(lds + PG8_SA(b, h) + aoff + m * 2048 + k * 1024); } while (0)
#define PG8_LDB(dst, b, h) do { _Pragma("unroll") for (int n = 0; n < 2; ++n) _Pragma("unroll") for (int k = 0; k < 2; ++k) dst[n][k] = *(const LAS bf16x8*)(lds + PG8_SB(b, h) + boff + n * 2048 + k * 1024); } while (0)
#define PG8_MMA(ai, bj, At, Bt) do { __builtin_amdgcn_s_setprio(1); _Pragma("unroll") for (int m = 0; m < 4; ++m) _Pragma("unroll") for (int n = 0; n < 2; ++n) { \
        if constexpr (FP8) { \
            const i32x8 wf_ = __builtin_shufflevector((i32x4)Bt[n][0], (i32x4)Bt[n][1], 0, 1, 2, 3, 4, 5, 6, 7), af_ = __builtin_shufflevector((i32x4)At[m][0], (i32x4)At[m][1], 0, 1, 2, 3, 4, 5, 6, 7); \
            acc[ai][bj][m][n] = __builtin_amdgcn_mfma_scale_f32_16x16x128_f8f6f4(wf_, af_, acc[ai][bj][m][n], 0, 0, 0, 0x79797979, 0, (int)ASCALE); \
        } else { _Pragma("unroll") for (int k = 0; k < 2; ++k) \
            acc[ai][bj][m][n] = __builtin_amdgcn_mfma_f32_16x16x32_bf16(Bt[n][k], At[m][k], acc[ai][bj][m][n], 0, 0, 0); } } \
        __builtin_amdgcn_s_setprio(0); } while (0)
#define PG8_WAIT_V(n) asm volatile("s_waitcnt vmcnt(" #n ")" ::: "memory")
#define PG8_WAIT_L(n) asm volatile("s_waitcnt lgkmcnt(" #n ")" ::: "memory")
#define PG8_BAR __builtin_amdgcn_s_barrier()
#define PG8_SCHED __builtin_amdgcn_sched_barrier(0)
#define PG8_LOADVA(ui_, u_) do { _Pragma("unroll") for (int _h = 0; _h < 2; ++_h) _Pragma("unroll") for (int _i = 0; _i < 2; ++_i) \
        vA[_h][_i] = S.rowidx((ui_), (u_), _h * HALF + RA[_i]) * rowb + (unsigned)CA[_i]; } while (0)
    Unit cur, nxt; int ui = 0;
    if (!S.next(0, cur)) return;
    f32x4 acc[2][2][4][2];
#pragma unroll
    for (int a = 0; a < 2; ++a)
#pragma unroll
        for (int b = 0; b < 2; ++b)
#pragma unroll
            for (int m = 0; m < 4; ++m)
#pragma unroll
                for (int n = 0; n < 2; ++n) acc[a][b][m][n] = (f32x4){0.f, 0.f, 0.f, 0.f};
    bf16x8 At[4][2], B0[2][2], B1[2][2];
    unsigned vA[2][2];
    PG8_LOADVA(0, cur);
    const char* cB = cur.b;
    PG8_STAGE(PG8_SB(0, 0), cB, voffB); PG8_STAGE(PG8_SB(0, 1), cB + hstep, voffB); PG8_STAGE(PG8_SA(0, 0), Abase, vA[0]); PG8_STAGE(PG8_SA(0, 1), Abase, vA[1]);
    if (wr == 1) PG8_BAR;
    PG8_WAIT_V(2); PG8_BAR;
    PG8_STAGE(PG8_SB(1, 0), cB + kstep, voffB); PG8_STAGE(PG8_SA(1, 0), Abase + kstep, vA[0]); PG8_STAGE(PG8_SB(1, 1), cB + hstep + kstep, voffB);
    PG8_WAIT_V(6); PG8_BAR;
    for (;;) {
        const bool has_next = S.next(ui + 1, nxt);
        const char* nB = has_next ? nxt.b : cB;
#pragma unroll 1
        for (int t = 0; t < nt; t += 2) {
            const bool last = (t == nt - 2);
            const char* a1 = Abase + (size_t)(t + 1) * kstep;
            const char* a2 = last ? Abase : Abase + (size_t)(t + 2) * kstep;
            const char* b2 = last ? nB : cB + (size_t)(t + 2) * kstep;
            const char* a3 = a2 + kstep; const char* b3 = b2 + kstep;
            PG8_LDB(B0, 0, 0); PG8_LDB(B1, 0, 1); PG8_SCHED; PG8_LDA(At, 0, 0); PG8_STAGE(PG8_SA(1, 1), a1, vA[1]);
            if (last && has_next) { PG8_LOADVA(ui + 1, nxt); }
            PG8_WAIT_V(8); PG8_WAIT_L(0); PG8_BAR; PG8_MMA(0, 0, At, B0); PG8_MMA(0, 1, At, B1); PG8_BAR; PG8_SCHED;
            PG8_LDA(At, 0, 1); PG8_STAGE(PG8_SB(0, 0), b2, voffB); PG8_STAGE(PG8_SB(0, 1), b2 + hstep, voffB); PG8_STAGE(PG8_SA(0, 0), a2, vA[0]);
            PG8_WAIT_V(8); PG8_WAIT_L(0); PG8_BAR; PG8_MMA(1, 0, At, B0); PG8_MMA(1, 1, At, B1); PG8_BAR; PG8_SCHED;
            PG8_LDB(B0, 1, 0); PG8_LDB(B1, 1, 1); PG8_SCHED; PG8_LDA(At, 1, 0); PG8_STAGE(PG8_SA(0, 1), a2, vA[1]);
            PG8_WAIT_V(8); PG8_WAIT_L(0); PG8_BAR; PG8_MMA(0, 0, At, B0); PG8_MMA(0, 1, At, B1); PG8_BAR; PG8_SCHED;
            PG8_LDA(At, 1, 1); PG8_STAGE(PG8_SB(1, 0), b3, voffB); PG8_STAGE(PG8_SB(1, 1), b3 + hstep, voffB); PG8_STAGE(PG8_SA(1, 0), a3, vA[0]);
            PG8_WAIT_V(8); PG8_WAIT_L(0); PG8_BAR; PG8_MMA(1, 0, At, B0); PG8_MMA(1, 1, At, B1); PG8_BAR; PG8_SCHED;
        }
        if (wr == 0) PG8_BAR;
        E(acc, cur, wr, wc, fr, fq);
        if (!has_next) break;
#pragma unroll
        for (int a = 0; a < 2; ++a)
#pragma unroll
            for (int b = 0; b < 2; ++b)
#pragma unroll
                for (int m = 0; m < 4; ++m)
#pragma unroll
                    for (int n = 0; n < 2; ++n) acc[a][b][m][n] = (f32x4){0.f, 0.f, 0.f, 0.f};
        cur = nxt; cB = nB; ++ui;
        if (wr == 1) PG8_BAR;
    }
    PG8_WAIT_V(0);
    PG8_BAR;
#undef PG8_SA
#undef PG8_SB
#undef PG8_STAGE
#undef PG8_LDA
#undef PG8_LDB
#undef PG8_MMA
#undef PG8_WAIT_V
#undef PG8_WAIT_L
#undef PG8_BAR
#undef PG8_SCHED
#undef PG8_LOADVA
}

typedef f32x4 Acc[2][2][4][2];

struct EpiZ {
    static constexpr bool PERM = true;
    bf16_t* Z; const float* bias; float* out; int l;
    __device__ __forceinline__ void operator()(const Acc& acc, const Unit& u, int wr, int wc, int fr, int fq) const {
        const int row0 = u.pm * 256 + wr * 64 + fr, col0 = u.pn * 256 + wc * 32 + 8 * fq;
        f32x4 bv[2][2];
#pragma unroll
        for (int bj = 0; bj < 2; ++bj)
#pragma unroll
            for (int n = 0; n < 2; ++n) bv[bj][n] = *(const f32x4*)(bias + col0 + bj * 128 + 4 * n);
#pragma unroll
        for (int ai = 0; ai < 2; ++ai)
#pragma unroll
            for (int m = 0; m < 4; ++m) {
                const int row = row0 + ai * 128 + m * 16;
                bf16_t* rowp = Z + (size_t)row * INW + col0;
                float* ko = nullptr; float* vo = nullptr;
                if (u.pn == 2) {
                    if (row < NPROMPT) { const int t = row & 4095; if (t >= 3968) { const size_t o = ((size_t)(l * 8 + (row >> 12)) * 128 + (t - 3968)) * 128 + wc * 32 + 8 * fq; ko = out + OKP + o; vo = out + OVP + o; } }
                    else { const int rr = row - NPROMPT; const size_t o = ((size_t)(l * 8 + (rr >> 6)) * 128 + 64 + (rr & 63)) * 128 + wc * 32 + 8 * fq; ko = out + OKS + o; vo = out + OVS + o; }
                }
#pragma unroll
                for (int bj = 0; bj < 2; ++bj) {
                    const f32x4 v0 = acc[ai][bj][m][0] + bv[bj][0], v1 = acc[ai][bj][m][1] + bv[bj][1];
                    u32x4 w; w.x = cvt_pk_bf16(v0[0], v0[1]); w.y = cvt_pk_bf16(v0[2], v0[3]); w.z = cvt_pk_bf16(v1[0], v1[1]); w.w = cvt_pk_bf16(v1[2], v1[3]);
                    *(u32x4*)(rowp + bj * 128) = w;
                    float* o = bj == 0 ? ko : vo;
                    if (o) { *(f32x4*)o = v0; *(f32x4*)(o + 4) = v1; }
                }
                asm volatile("" ::: "memory");
            }
    }
};
struct EpiT1 {
    static constexpr bool PERM = true;
    bf16_t* T1; const bf16_t* Z;
    __device__ __forceinline__ void operator()(const Acc& acc, const Unit& u, int wr, int wc, int fr, int fq) const {
        const int row0 = u.pm * 256 + wr * 64 + fr, col0 = u.pn * 256 + wc * 32 + 8 * fq;
        u32x4 g[2][4][2];
#pragma unroll
        for (int ai = 0; ai < 2; ++ai)
#pragma unroll
            for (int m = 0; m < 4; ++m)
#pragma unroll
                for (int bj = 0; bj < 2; ++bj) g[ai][m][bj] = *(const u32x4*)(Z + (size_t)(row0 + ai * 128 + m * 16) * INW + 2304 + col0 + bj * 128);
        asm volatile("" ::: "memory");
#pragma unroll
        for (int ai = 0; ai < 2; ++ai)
#pragma unroll
            for (int m = 0; m < 4; ++m) {
                const int row = row0 + ai * 128 + m * 16;
#pragma unroll
                for (int bj = 0; bj < 2; ++bj) {
                    const u32x4 gg = g[ai][m][bj];
                    f32x4 v0 = acc[ai][bj][m][0], v1 = acc[ai][bj][m][1];
                    v0[0] *= sigmoidf_(bf_lo(gg.x)); v0[1] *= sigmoidf_(bf_hi(gg.x)); v0[2] *= sigmoidf_(bf_lo(gg.y)); v0[3] *= sigmoidf_(bf_hi(gg.y));
                    v1[0] *= sigmoidf_(bf_lo(gg.z)); v1[1] *= sigmoidf_(bf_hi(gg.z)); v1[2] *= sigmoidf_(bf_lo(gg.w)); v1[3] *= sigmoidf_(bf_hi(gg.w));
                    u32x4 w; w.x = cvt_pk_bf16(v0[0], v0[1]); w.y = cvt_pk_bf16(v0[2], v0[3]); w.z = cvt_pk_bf16(v1[0], v1[1]); w.w = cvt_pk_bf16(v1[2], v1[3]);
                    *(u32x4*)(T1 + (size_t)row * D + col0 + bj * 128) = w;
                }
            }
    }
};
struct EpiMix {
    static constexpr bool PERM = true;
    const bf16_t* T1; const bf16_t* Z; unsigned char* MIX;
    __device__ __forceinline__ void operator()(const Acc& acc, const Unit& u, int wr, int wc, int fr, int fq) const {
        const int row0 = u.pm * 256 + wr * 64 + fr, col0 = u.pn * 256 + wc * 32 + 8 * fq;
#pragma unroll
        for (int ai = 0; ai < 2; ++ai)
#pragma unroll
        for (int mh = 0; mh < 2; ++mh) {
            u32x4 g[4][2]; u32x4 t[4][2];
#pragma unroll
            for (int m = 2 * mh; m < 2 * mh + 2; ++m)
#pragma unroll
                for (int bj = 0; bj < 2; ++bj) {
                    const int row = row0 + ai * 128 + m * 16;
                    g[m][bj] = *(const u32x4*)(Z + (size_t)row * INW + 3328 + col0 + bj * 128);
                    t[m][bj] = *(const u32x4*)(T1 + (size_t)row * D + col0 + bj * 128);
                }
            asm volatile("" ::: "memory");
#pragma unroll
            for (int m = 2 * mh; m < 2 * mh + 2; ++m)
#pragma unroll
                for (int bj = 0; bj < 2; ++bj) {
                    const int row = row0 + ai * 128 + m * 16;
                    const u32x4 gg = g[m][bj];
                    const u32x4 tt = t[m][bj];
                    f32x4 v0 = (f32x4){bf_lo(tt.x), bf_hi(tt.x), bf_lo(tt.y), bf_hi(tt.y)}, v1 = (f32x4){bf_lo(tt.z), bf_hi(tt.z), bf_lo(tt.w), bf_hi(tt.w)};
                    const f32x4 a0 = acc[ai][bj][m][0], a1 = acc[ai][bj][m][1];
                    v0[0] += a0[0] * sigmoidf_(bf_lo(gg.x)); v0[1] += a0[1] * sigmoidf_(bf_hi(gg.x)); v0[2] += a0[2] * sigmoidf_(bf_lo(gg.y)); v0[3] += a0[3] * sigmoidf_(bf_hi(gg.y));
                    v1[0] += a1[0] * sigmoidf_(bf_lo(gg.z)); v1[1] += a1[1] * sigmoidf_(bf_hi(gg.z)); v1[2] += a1[2] * sigmoidf_(bf_lo(gg.w)); v1[3] += a1[3] * sigmoidf_(bf_hi(gg.w));
                    u32x2 w; w.x = pk4_fp8(v0[0], v0[1], v0[2], v0[3]); w.y = pk4_fp8(v1[0], v1[1], v1[2], v1[3]);
                    *(u32x2*)(MIX + (size_t)row * D + col0 + bj * 128) = w;
                }
            asm volatile("" ::: "memory");
        }
    }
};
struct EpiX {
    static constexpr bool PERM = true;
    const bf16_t* X; bf16_t* V; const float* modl;
    __device__ __forceinline__ void operator()(const Acc& acc, const Unit& u, int wr, int wc, int fr, int fq) const {
        const int row0 = u.pm * 256 + wr * 64 + fr, col0 = u.pn * 256 + wc * 32 + 8 * fq;
        const bool uni = u.pm < 128;
        f32x4 g[2][2];
        if (uni) { const float* gp = modl + (size_t)(u.pm >> 4) * 6144 + 2048 + col0;
#pragma unroll
            for (int bj = 0; bj < 2; ++bj)
#pragma unroll
                for (int n = 0; n < 2; ++n) g[bj][n] = *(const f32x4*)(gp + bj * 128 + 4 * n) + 1.0f; }
#pragma unroll
        for (int ai = 0; ai < 2; ++ai)
#pragma unroll
        for (int mh = 0; mh < 2; ++mh) {
            u32x4 x[4][2];
#pragma unroll
            for (int m = 2 * mh; m < 2 * mh + 2; ++m)
#pragma unroll
                for (int bj = 0; bj < 2; ++bj) x[m][bj] = *(const u32x4*)(X + (size_t)(row0 + ai * 128 + m * 16) * D + col0 + bj * 128);
            asm volatile("" ::: "memory");
#pragma unroll
            for (int m = 2 * mh; m < 2 * mh + 2; ++m) {
                const int row = row0 + ai * 128 + m * 16;
                if (!uni) { const float* gp = modl + (size_t)batch_of(row) * 6144 + 2048 + col0;
#pragma unroll
                    for (int bj = 0; bj < 2; ++bj)
#pragma unroll
                        for (int n = 0; n < 2; ++n) g[bj][n] = *(const f32x4*)(gp + bj * 128 + 4 * n) + 1.0f; }
#pragma unroll
                for (int bj = 0; bj < 2; ++bj) {
                    const u32x4 xx = x[m][bj];
                    const f32x4 x0 = (f32x4){bf_lo(xx.x), bf_hi(xx.x), bf_lo(xx.y), bf_hi(xx.y)}, x1 = (f32x4){bf_lo(xx.z), bf_hi(xx.z), bf_lo(xx.w), bf_hi(xx.w)};
                    const f32x4 v0 = x0 * ALPHA + g[bj][0] * acc[ai][bj][m][0], v1 = x1 * ALPHA + g[bj][1] * acc[ai][bj][m][1];
                    u32x4 w; w.x = cvt_pk_bf16(v0[0], v0[1]); w.y = cvt_pk_bf16(v0[2], v0[3]); w.z = cvt_pk_bf16(v1[0], v1[1]); w.w = cvt_pk_bf16(v1[2], v1[3]);
                    *(u32x4*)(V + (size_t)row * D + col0 + bj * 128) = w;
                }
            }
            asm volatile("" ::: "memory");
        }
    }
};
struct EpiAct {
    static constexpr bool PERM = true;
    unsigned char* ACT; const float* bgu;
    __device__ __forceinline__ void operator()(const Acc& acc, const Unit& u, int wr, int wc, int fr, int fq) const {
        const int row0 = u.pm * 256 + wr * 64 + fr, c0 = u.pn * 128 + wc * 32 + 8 * fq;
        const float* bp = bgu + (size_t)u.e * 2048 + c0;
        f32x4 bg[2], bl[2];
#pragma unroll
        for (int n = 0; n < 2; ++n) { bg[n] = *(const f32x4*)(bp + 4 * n); bl[n] = *(const f32x4*)(bp + 1024 + 4 * n); }
#pragma unroll
        for (int ai = 0; ai < 2; ++ai)
#pragma unroll
            for (int m = 0; m < 4; ++m) {
                const int row = row0 + ai * 128 + m * 16;
                float a[8];
#pragma unroll
                for (int n = 0; n < 2; ++n)
#pragma unroll
                    for (int j = 0; j < 4; ++j) {
                        float g = acc[ai][0][m][n][j] + bg[n][j], li = acc[ai][1][m][n][j] + bl[n][j];
                        g = fminf(g, 7.0f); li = fminf(fmaxf(li, -7.0f), 7.0f);
                        a[n * 4 + j] = g * sigmoidf_(1.702f * g) * (li + 1.0f);
                    }
                u32x2 w; w.x = pk4_fp8(a[0], a[1], a[2], a[3]); w.y = pk4_fp8(a[4], a[5], a[6], a[7]);
                *(u32x2*)(ACT + (size_t)row * D + c0) = w;
                asm volatile("" ::: "memory");
            }
    }
};
struct EpiYs {
    static constexpr bool PERM = true;
    unsigned char* YS; const float* bdn; const float* gate; const unsigned* cnt; const LAS int* blk;
    __device__ __forceinline__ void operator()(const Acc& acc, const Unit& u, int wr, int wc, int fr, int fq) const {
        const int r0 = wr * 64 + fr, col0 = u.pn * 256 + wc * 32 + 8 * fq;
        const int rank0 = (u.pm - blk[u.e]) * 256; const int ce = (int)cnt[u.e * 64];
        f32x4 bv[2][2];
#pragma unroll
        for (int bj = 0; bj < 2; ++bj)
#pragma unroll
            for (int n = 0; n < 2; ++n) bv[bj][n] = *(const f32x4*)(bdn + (size_t)u.e * D + col0 + bj * 128 + 4 * n);
        float gts[2][4];
#pragma unroll
        for (int ai = 0; ai < 2; ++ai)
#pragma unroll
            for (int m = 0; m < 4; ++m) { const int rank = rank0 + r0 + ai * 128 + m * 16; gts[ai][m] = rank < ce ? 16.0f * gate[(size_t)u.e * NT + rank] : 0.0f; }
        asm volatile("" ::: "memory");
#pragma unroll
        for (int ai = 0; ai < 2; ++ai)
#pragma unroll
            for (int m = 0; m < 4; ++m) {
                const int r = r0 + ai * 128 + m * 16;
                const float gt = gts[ai][m];
                unsigned char* rowp = YS + (size_t)(u.pm * 256 + r) * D + col0;
#pragma unroll
                for (int bj = 0; bj < 2; ++bj) {
                    const f32x4 v0 = (acc[ai][bj][m][0] + bv[bj][0]) * gt, v1 = (acc[ai][bj][m][1] + bv[bj][1]) * gt;
                    u32x2 w; w.x = pk4_fp8(v0[0], v0[1], v0[2], v0[3]); w.y = pk4_fp8(v1[0], v1[1], v1[2], v1[3]);
                    *(u32x2*)(rowp + bj * 128) = w;
                }
                asm volatile("" ::: "memory");
            }
    }
};
}


#define XB_TMO      128
#define XB_XCNT(j)  (256  + 64 * (j))
#define XB_XSUB(j)  (1280 + 64 * (j))
#define XB_XGEN(j)  (2304 + 64 * (j))
#define XB_TOP      3328
#define XB_TOPGEN   3392
#define XCD_BAR_WORDS 3456
#define XB_SPIN_CAP (1u << 21)
__device__ __forceinline__ unsigned xb_ld(unsigned* p)              { return __hip_atomic_load(p, __ATOMIC_RELAXED, __HIP_MEMORY_SCOPE_AGENT); }
__device__ __forceinline__ unsigned xb_add(unsigned* p, unsigned v) { return __hip_atomic_fetch_add(p, v, __ATOMIC_RELAXED, __HIP_MEMORY_SCOPE_AGENT); }
__device__ __forceinline__ unsigned xb_xcc_id() { return (unsigned)__builtin_amdgcn_s_getreg((3 << 11) | 20) & 0xFu; }
#define XB_SPIN(cond, bar) do { unsigned _sp = 0; while (cond) { __builtin_amdgcn_s_sleep(1); \
    if ((++_sp & 255u) == 0u) { if (xb_ld(&(bar)[XB_TMO])) break; if (_sp > XB_SPIN_CAP) { atomicAdd(&(bar)[XB_TMO], 1u); break; } } } } while (0)
struct XcdBarrier { unsigned* bar; unsigned x; volatile LAS unsigned* st; };
__device__ __forceinline__ XcdBarrier xcd_barrier_post(unsigned* bar, volatile LAS unsigned* st) {
    XcdBarrier b; b.bar = bar; b.x = xb_xcc_id(); b.st = st;
    if (threadIdx.x == 0) (void)xb_add(&bar[XB_XCNT(b.x)], 1u);
    return b;
}
__device__ __forceinline__ void xcd_barrier_complete(unsigned* bar, unsigned x, unsigned& nloc, unsigned& nx) {
    const unsigned G = gridDim.x * gridDim.y * gridDim.z;
    unsigned sum, cnt, mine, sp = 0u;
    for (;;) {
        sum = 0u; cnt = 0u; mine = 0u;
#pragma unroll
        for (unsigned j = 0; j < 16; ++j) { const unsigned c = xb_ld(&bar[XB_XCNT(j)]); sum += c; cnt += (c > 0u) ? 1u : 0u; mine = (j == x) ? c : mine; }
        if (sum == G) break;
        __builtin_amdgcn_s_sleep(1);
        if ((++sp & 255u) == 0u) { if (xb_ld(&bar[XB_TMO])) break; if (sp > XB_SPIN_CAP) { atomicAdd(&bar[XB_TMO], 1u); break; } }
    }
    nloc = mine > 0u ? mine : 1u; nx = cnt > 0u ? cnt : 1u;
}
__device__ __forceinline__ void xcd_barrier(const XcdBarrier& b) {
    asm volatile("s_waitcnt vmcnt(0)" ::: "memory");
    __syncthreads();
    if (threadIdx.x == 0) {
        unsigned* bar = b.bar;
        __builtin_amdgcn_s_waitcnt(0);
        unsigned nloc = b.st[0], nx = b.st[1];
        if (nloc == 0u) { xcd_barrier_complete(bar, b.x, nloc, nx); b.st[0] = nloc; b.st[1] = nx; }
        const unsigned old = xb_add(&bar[XB_XSUB(b.x)], 1u);
        const unsigned gen = old / nloc;
        if (old + 1u == (gen + 1u) * nloc) {
            __builtin_amdgcn_fence(__ATOMIC_RELEASE, "agent");
            asm volatile("s_waitcnt vmcnt(0)" ::: "memory");
            const unsigned og = xb_add(&bar[XB_TOP], 1u);
            const unsigned tg = og / nx;
            if (og + 1u == (tg + 1u) * nx) xb_add(&bar[XB_TOPGEN], 1u);
            else XB_SPIN(xb_ld(&bar[XB_TOPGEN]) == tg, bar);
            __builtin_amdgcn_fence(__ATOMIC_ACQUIRE, "agent");
            xb_add(&bar[XB_XGEN(b.x)], 1u);
            asm volatile("s_waitcnt vmcnt(0)" ::: "memory");
        } else {
            XB_SPIN(xb_ld(&bar[XB_XGEN(b.x)]) == gen, bar);
            __builtin_amdgcn_fence(__ATOMIC_ACQUIRE, "agent");
            asm volatile("s_waitcnt vmcnt(0)" ::: "memory");
        }
    }
    __syncthreads();
}

struct Ctx {
    LAS unsigned char* lds; int tid, lane, wave, G, bx;
    const float* const* in; float* out; unsigned char* ws;
};
#define LDS_WAIT() asm volatile("s_waitcnt lgkmcnt(0)" ::: "memory")

struct TDesc { const float* src; unsigned char* dst; int N, K, k0, n0, kind, f8; };
__device__ __forceinline__ void t64_load(const TDesc& d, float (&v)[64], int lane) {
    const float* src = d.src + (size_t)d.k0 * d.N + d.n0 + lane;
#pragma unroll
    for (int kk = 0; kk < 64; ++kk) v[kk] = src[(size_t)kk * d.N];
}
__device__ __forceinline__ void t64_finish(const TDesc& d, const float (&v)[64], LAS unsigned char* scr, int lane) {
    if (d.f8) {
        LAS unsigned char* wp = scr + lane * 80;
#pragma unroll
        for (int q = 0; q < 4; ++q) { u32x4 o;
            o.x = pk4_fp8(64.f * v[16 * q + 0], 64.f * v[16 * q + 1], 64.f * v[16 * q + 2], 64.f * v[16 * q + 3]);
            o.y = pk4_fp8(64.f * v[16 * q + 4], 64.f * v[16 * q + 5], 64.f * v[16 * q + 6], 64.f * v[16 * q + 7]);
            o.z = pk4_fp8(64.f * v[16 * q + 8], 64.f * v[16 * q + 9], 64.f * v[16 * q + 10], 64.f * v[16 * q + 11]);
            o.w = pk4_fp8(64.f * v[16 * q + 12], 64.f * v[16 * q + 13], 64.f * v[16 * q + 14], 64.f * v[16 * q + 15]);
            *(LAS u32x4*)(wp + q * 16) = o; }
        LDS_WAIT(); asm volatile("" ::: "memory");
        const int c = lane & 3;
#pragma unroll
        for (int j = 0; j < 4; ++j) { const int nl = (lane >> 2) + 16 * j; const u32x4 o = *(const LAS u32x4*)(scr + nl * 80 + c * 16);
            const int n = d.n0 + nl; int dr = n;
            if (d.kind == 1) { dr = (n < 1024) ? ((n >> 7) * 256 + (n & 127)) : (((n - 1024) >> 7) * 256 + 128 + (n & 127)); }
            *(u32x4*)(d.dst + (size_t)dr * d.K + d.k0 + c * 16) = o; }
    } else {
        LAS unsigned char* wp = scr + lane * 144;
#pragma unroll
        for (int q = 0; q < 8; ++q) { u32x4 o;
            o.x = cvt_pk_bf16(v[8 * q + 0], v[8 * q + 1]); o.y = cvt_pk_bf16(v[8 * q + 2], v[8 * q + 3]); o.z = cvt_pk_bf16(v[8 * q + 4], v[8 * q + 5]); o.w = cvt_pk_bf16(v[8 * q + 6], v[8 * q + 7]);
            *(LAS u32x4*)(wp + q * 16) = o; }
        LDS_WAIT(); asm volatile("" ::: "memory");
        const int c = lane & 7;
#pragma unroll
        for (int j = 0; j < 8; ++j) { const int nl = (lane >> 3) + 8 * j; const u32x4 o = *(const LAS u32x4*)(scr + nl * 144 + c * 16);
            *(u32x4*)(d.dst + ((size_t)(d.n0 + nl) * d.K + d.k0) * 2 + c * 16) = o; }
    }
    LDS_WAIT(); asm volatile("" ::: "memory");
}
__device__ __forceinline__ TDesc t64_decode(const float* const* in, unsigned char* ws, int it) {
    TDesc d; int r = it, item, nblk;
    if (r < 32768) { const int m = r >> 9; item = r & 511; d.src = in[23] + (size_t)m * 1024 * 2048; d.dst = ws + WS_WGU + (size_t)m * 2048 * 1024; d.N = 2048; d.K = 1024; d.kind = 1; d.f8 = 1; }
    else if ((r -= 32768) < 16384) { const int m = r >> 8; item = r & 255; d.src = in[25] + (size_t)m * 1024 * 1024; d.dst = ws + WS_WDN + (size_t)m * 1024 * 1024; d.N = 1024; d.K = 1024; d.kind = 0; d.f8 = 1; }
    else if ((r -= 16384) < 2176) { const int m = r / 1088; item = r % 1088; d.src = in[12] + (size_t)m * 1024 * INW; d.dst = ws + WS_WIN + (size_t)m * INW * 1024 * 2; d.N = INW; d.K = 1024; d.kind = 0; d.f8 = 0; }
    else if ((r -= 2176) < 2176) { const int m = r / 1088; item = r % 1088; d.src = in[12] + (size_t)m * 1024 * INW; d.dst = ws + WS_WIN8 + (size_t)m * INW * 1024; d.N = INW; d.K = 1024; d.kind = 0; d.f8 = 1; }
    else if ((r -= 2176) < 512) { const int m = r >> 8; item = r & 255; d.src = in[18] + (size_t)m * 1024 * 1024; d.dst = ws + WS_WO + (size_t)m * 1024 * 1024; d.N = 1024; d.K = 1024; d.kind = 0; d.f8 = 1; }
    else if ((r -= 512) < 256) { const int m = r >> 7; item = r & 127; d.src = in[16] + (size_t)m * 512 * 1024; d.dst = ws + WS_WOA + (size_t)m * 1024 * 512; d.N = 1024; d.K = 512; d.kind = 0; d.f8 = 1; }
    else { r -= 256; const int m = r >> 7; item = r & 127; d.src = in[17] + (size_t)m * 512 * 1024; d.dst = ws + WS_WOB + (size_t)m * 1024 * 512; d.N = 1024; d.K = 512; d.kind = 0; d.f8 = 1; }
    nblk = d.N >> 6; const int kb = item / nblk; d.k0 = kb * 64; d.n0 = (item - kb * nblk) * 64;
    return d;
}

__device__ __forceinline__ int rel_bucket(int rel) {
    const int n = rel < 0 ? -rel : rel;
    int v;
    if (n < 8) v = n;
    else { const float nf = (float)n; int large = 8 + (int)(logf(nf / 8.0f) / 2.7725887298583984f * 8.0f); v = large < 15 ? large : 15; }
    return (rel > 0 ? 16 : 0) + v;
}

__device__ __forceinline__ void phase0a(Ctx& F) {
    LAS float* scr = (LAS float*)(F.lds + F.wave * 16384);
    const int gw = F.bx * NWAVES + F.wave, NGW = F.G * NWAVES;
    unsigned char* ws = F.ws;
    {
        float* modp = (float*)(ws + WS_MODP);
        for (int it = gw; it < 2 * 96 * 8; it += NGW) {
            const int kc = it & 7, cgp = (it >> 3) % 96, l = it / (8 * 96), k0 = kc * 128, n0 = cgp * 64;
#pragma unroll 4
            for (int j = 0; j < 32; ++j) { const int idx = F.lane + 64 * j, r = idx >> 7, kk = idx & 127;
                const float c = r < 8 ? F.in[2][r * 1024 + k0 + kk] : F.in[3][(r - 8) * 1024 + k0 + kk];
                scr[kk * 16 + r] = c * sigmoidf_(c); }
            LDS_WAIT(); asm volatile("" ::: "memory");
            float a[16];
#pragma unroll
            for (int r = 0; r < 16; ++r) a[r] = 0.f;
            const float* wp = F.in[10] + ((size_t)l * 1024 + k0) * 6144 + n0 + F.lane;
#pragma unroll 16
            for (int kk = 0; kk < 128; ++kk) {
                const float w = wp[(size_t)kk * 6144];
                const LAS f32x4* sp = (const LAS f32x4*)(scr + kk * 16);
                const f32x4 s0 = sp[0], s1 = sp[1], s2 = sp[2], s3 = sp[3];
                a[0] += s0[0] * w; a[1] += s0[1] * w; a[2] += s0[2] * w; a[3] += s0[3] * w;
                a[4] += s1[0] * w; a[5] += s1[1] * w; a[6] += s1[2] * w; a[7] += s1[3] * w;
                a[8] += s2[0] * w; a[9] += s2[1] * w; a[10] += s2[2] * w; a[11] += s2[3] * w;
                a[12] += s3[0] * w; a[13] += s3[1] * w; a[14] += s3[2] * w; a[15] += s3[3] * w;
            }
            const float bb = (kc == 0) ? F.in[11][l * 6144 + n0 + F.lane] : 0.f;
#pragma unroll
            for (int r = 0; r < 16; ++r) modp[(size_t)kc * (2 * 16 * 6144) + ((size_t)(l * 16 + r)) * 6144 + n0 + F.lane] = a[r] + bb;
            LDS_WAIT(); asm volatile("" ::: "memory");
        }
    }
    if (F.bx == 0) {
        float* bt = (float*)(ws + WS_BIAS);
        for (int i = F.tid; i < 8 * 256; i += NTHREADS) { const int h = i >> 8, ri = i & 255; const int rel = ri - 191;
            bt[i] = (ri < 255) ? F.in[7][rel_bucket(rel) * 8 + h] : 0.f; }
    }
    for (int i = F.bx * NTHREADS + F.tid; i < 2 * 8 * 64 * 128; i += F.G * NTHREADS) {
        const int lb = i >> 13, rem = i & 8191;
        F.out[OKS + (size_t)lb * 16384 + rem] = F.in[4][(size_t)lb * 16384 + 8192 + rem];
        F.out[OVS + (size_t)lb * 16384 + rem] = F.in[5][(size_t)lb * 16384 + 8192 + rem];
    }
    LAS unsigned char* scrb = F.lds + F.wave * 16384;
    constexpr int NITEMS = 32768 + 16384 + 2176 + 2176 + 512 + 256 + 256;
    {
        float va[64], vb[64]; TDesc da, db;
        int it = gw;
        if (it < NITEMS) { da = t64_decode(F.in, ws, it); t64_load(da, va, F.lane); }
        while (it < NITEMS) {
            int itn = it + NGW;
            if (itn < NITEMS) { db = t64_decode(F.in, ws, itn); t64_load(db, vb, F.lane); }
            t64_finish(da, va, scrb, F.lane);
            it = itn; if (it >= NITEMS) break;
            itn = it + NGW;
            if (itn < NITEMS) { da = t64_decode(F.in, ws, itn); t64_load(da, va, F.lane); }
            t64_finish(db, vb, scrb, F.lane);
            it = itn;
        }
    }
}

__device__ __forceinline__ void ln_row(f32x4 (&v)[4], const float* g, const float* b, int lane) {
    float s = 0.f;
#pragma unroll
    for (int j = 0; j < 4; ++j) s += (v[j][0] + v[j][1]) + (v[j][2] + v[j][3]);
    const float mean = wave_sum(s) * (1.0f / D); float s2 = 0.f;
#pragma unroll
    for (int j = 0; j < 4; ++j) { v[j] = v[j] - mean; s2 += (v[j][0] * v[j][0] + v[j][1] * v[j][1]) + (v[j][2] * v[j][2] + v[j][3] * v[j][3]); }
    const float rstd = 1.0f / sqrtf(wave_sum(s2) * (1.0f / D) + LN_EPS);
#pragma unroll
    for (int j = 0; j < 4; ++j) { const f32x4 gg = *(const f32x4*)(g + 4 * lane + 256 * j), bb = *(const f32x4*)(b + 4 * lane + 256 * j); v[j] = v[j] * rstd * gg + bb; }
}
__device__ __forceinline__ void store_mod_row(const f32x4 (&v)[4], const float* sh, const float* sc, bf16_t* hrow, unsigned char* h8row, int lane) {
#pragma unroll
    for (int j = 0; j < 4; ++j) { const f32x4 a = *(const f32x4*)(sc + 4 * lane + 256 * j), b = *(const f32x4*)(sh + 4 * lane + 256 * j);
        const f32x4 h = v[j] * (a + 1.0f) + b; u32x2 w; w.x = cvt_pk_bf16(h[0], h[1]); w.y = cvt_pk_bf16(h[2], h[3]);
        *(u32x2*)(hrow + 4 * lane + 256 * j) = w;
        *(unsigned*)(h8row + 4 * lane + 256 * j) = pk4_fp8(h[0], h[1], h[2], h[3]); }
}

__device__ __forceinline__ void phase0b(Ctx& F) {
    const int gw = F.bx * NWAVES + F.wave, NGW = F.G * NWAVES;
    const float* mod = (const float*)(F.ws + WS_MOD);
    bf16_t* H = (bf16_t*)(F.ws + WS_H);
    for (int row = gw; row < NT; row += NGW) {
        const float* xr = row < NPROMPT ? F.in[0] + (size_t)row * D : F.in[1] + (size_t)(row - NPROMPT) * D;
        f32x4 v[4];
#pragma unroll
        for (int j = 0; j < 4; ++j) v[j] = *(const f32x4*)(xr + 4 * F.lane + 256 * j);
        ln_row(v, F.in[8], F.in[9], F.lane);
#pragma unroll
        for (int j = 0; j < 4; ++j) { u32x2 w; w.x = cvt_pk_bf16(v[j][0], v[j][1]); w.y = cvt_pk_bf16(v[j][2], v[j][3]); *(u32x2*)((bf16_t*)(F.ws + WS_XB) + (size_t)row * D + 4 * F.lane + 256 * j) = w; }
        const float* mb = mod + (size_t)batch_of(row) * 6144;
        store_mod_row(v, mb, mb + 1024, H + (size_t)row * D, F.ws + WS_H8 + (size_t)row * D, F.lane);
    }
}

__device__ __forceinline__ void phase_attn(Ctx& F, int l) {
    const bf16_t* Z = (const bf16_t*)(F.ws + WS_Z);
    unsigned char* YA = F.ws + WS_YA;
    unsigned char* YB = F.ws + WS_YB;
    const float* biasr = (const float*)(F.ws + WS_BIAS);
    LAS unsigned char* Ks = F.lds;
    LAS unsigned char* Vt = F.lds + 27648;
    LAS float* bt = (LAS float*)(F.lds + 53248);
    const int lane = F.lane, tid = F.tid;
    for (int au = F.bx; au < 1040; au += F.G) {
        const bool isS = au >= 1024;
        const int kv = au & 1;
        const int b = isS ? ((au - 1024) >> 1) : (au >> 7);
        const int n = isS ? 0 : ((au & 127) >> 1);
        __syncthreads();
        for (int i = tid; i < 1024; i += NTHREADS) bt[i] = biasr[(kv * 4 + (i >> 8)) * 256 + (i & 255)];
#pragma unroll
        for (int jj = 0; jj < 3; ++jj) {
            const int p = tid + NTHREADS * jj, key = p >> 3, ds = p & 7;
            u32x4 kq = (u32x4){0u, 0u, 0u, 0u}, vq = (u32x4){0u, 0u, 0u, 0u};
            if (!isS) {
                const int t = n * 64 + key - 128;
                if (t >= 0) { const bf16_t* zr = Z + (size_t)(b * 4096 + t) * INW + kv * 64 + ds * 8; kq = *(const u32x4*)(zr + 512); vq = *(const u32x4*)(zr + 640); }
            } else if (key < 128) {
                const size_t o = ((size_t)((l * 8 + b) * 128 + key) * 2 + kv) * 64 + ds * 8;
                const f32x4 k0 = *(const f32x4*)(F.in[4] + o), k1 = *(const f32x4*)(F.in[4] + o + 4), v0 = *(const f32x4*)(F.in[5] + o), v1 = *(const f32x4*)(F.in[5] + o + 4);
                kq.x = cvt_pk_bf16(k0[0], k0[1]); kq.y = cvt_pk_bf16(k0[2], k0[3]); kq.z = cvt_pk_bf16(k1[0], k1[1]); kq.w = cvt_pk_bf16(k1[2], k1[3]);
                vq.x = cvt_pk_bf16(v0[0], v0[1]); vq.y = cvt_pk_bf16(v0[2], v0[3]); vq.z = cvt_pk_bf16(v1[0], v1[1]); vq.w = cvt_pk_bf16(v1[2], v1[3]);
            } else {
                const bf16_t* zr = Z + (size_t)(NPROMPT + b * 64 + key - 128) * INW + kv * 64 + ds * 8; kq = *(const u32x4*)(zr + 512); vq = *(const u32x4*)(zr + 640);
            }
            *(LAS u32x4*)(Ks + key * 144 + ds * 16) = kq;
            LAS unsigned short* vp = (LAS unsigned short*)Vt + (ds * 8) * 200 + key;
            vp[0 * 200] = (unsigned short)(vq.x & 0xffffu); vp[1 * 200] = (unsigned short)(vq.x >> 16);
            vp[2 * 200] = (unsigned short)(vq.y & 0xffffu); vp[3 * 200] = (unsigned short)(vq.y >> 16);
            vp[4 * 200] = (unsigned short)(vq.z & 0xffffu); vp[5 * 200] = (unsigned short)(vq.z >> 16);
            vp[6 * 200] = (unsigned short)(vq.w & 0xffffu); vp[7 * 200] = (unsigned short)(vq.w >> 16);
        }
        __syncthreads();
        const int g = F.wave >> 1, qi = (F.wave & 1) * 32 + (lane & 31), hh = lane >> 5, head = kv * 4 + g;
        const int qrow = isS ? NPROMPT + b * 64 + qi : b * 4096 + n * 64 + qi;
        bf16x8 Qf[4];
#pragma unroll
        for (int ks = 0; ks < 4; ++ks) Qf[ks] = *(const bf16x8*)(Z + (size_t)qrow * INW + head * 64 + ks * 16 + hh * 8);
        f32x16 S[6];
#pragma unroll
        for (int kb = 0; kb < 6; ++kb) {
#pragma unroll
            for (int j = 0; j < 16; ++j) S[kb][j] = 0.f;
#pragma unroll
            for (int ks = 0; ks < 4; ++ks) {
                const bf16x8 A = *(const LAS bf16x8*)(Ks + (kb * 32 + (lane & 31)) * 144 + (ks * 16 + hh * 8) * 2);
                S[kb] = __builtin_amdgcn_mfma_f32_32x32x16_bf16(A, Qf[ks], S[kb], 0, 0, 0);
            }
        }
        const float sinkv = F.in[14][l * 8 + head];
        float mx = sinkv;
        const int kmin = isS ? 0 : (128 - n * 64);
#pragma unroll
        for (int kb = 0; kb < 6; ++kb)
#pragma unroll
            for (int j = 0; j < 16; ++j) {
                const int key = kb * 32 + 8 * (j >> 2) + 4 * hh + (j & 3);
                float sv = S[kb][j] * 0.125f + bt[g * 256 + key - qi + 63];
                sv = key >= kmin ? sv : -1e30f;
                S[kb][j] = sv; mx = fmaxf(mx, sv);
            }
        mx = fmaxf(mx, __shfl_xor(mx, 32));
        float sum = 0.f;
#pragma unroll
        for (int kb = 0; kb < 6; ++kb)
#pragma unroll
            for (int j = 0; j < 16; ++j) { const float p = __expf(S[kb][j] - mx); S[kb][j] = p; sum += p; }
        sum += __shfl_xor(sum, 32);
        sum += __expf(sinkv - mx);
        const float inv = 1.0f / sum;
        f32x16 O[2];
#pragma unroll
        for (int db = 0; db < 2; ++db)
#pragma unroll
            for (int j = 0; j < 16; ++j) O[db][j] = 0.f;
#pragma unroll
        for (int kb = 0; kb < 6; ++kb)
#pragma unroll
            for (int s2 = 0; s2 < 2; ++s2) {
                union { bf16x8 v; unsigned u[4]; } P;
#pragma unroll
                for (int q = 0; q < 4; ++q) P.u[q] = cvt_pk_bf16(S[kb][8 * s2 + 2 * q], S[kb][8 * s2 + 2 * q + 1]);
#pragma unroll
                for (int db = 0; db < 2; ++db) {
                    const LAS unsigned char* vb = Vt + (db * 32 + (lane & 31)) * 400 + (kb * 32 + 16 * s2 + 4 * hh) * 2;
                    union { bf16x8 v; u32x2 h[2]; } Vf;
                    Vf.h[0] = *(const LAS u32x2*)vb; Vf.h[1] = *(const LAS u32x2*)(vb + 16);
                    O[db] = __builtin_amdgcn_mfma_f32_32x32x16_bf16(Vf.v, P.v, O[db], 0, 0, 0);
                }
            }
        unsigned char* orow = YA + (size_t)qrow * 512 + head * 64 + 4 * hh; const float inv8 = inv * 8.0f;
#pragma unroll
        for (int db = 0; db < 2; ++db)
#pragma unroll
            for (int jq = 0; jq < 4; ++jq) {
                *(unsigned*)(orow + db * 32 + 8 * jq) = pk4_fp8(O[db][4 * jq] * inv8, O[db][4 * jq + 1] * inv8, O[db][4 * jq + 2] * inv8, O[db][4 * jq + 3] * inv8);
            }
    }
    const int gw = F.bx * NWAVES + F.wave, NGW = F.G * NWAVES;
    const float* cw = F.in[15] + (size_t)l * 3 * 512 + 8 * lane;
    float w0[8], w1[8], w2[8];
#pragma unroll
    for (int e = 0; e < 8; ++e) { w0[e] = cw[e]; w1[e] = cw[512 + e]; w2[e] = cw[1024 + e]; }
    for (int row = gw; row < NT; row += NGW) {
        const bool isS = row >= NPROMPT; const int b = isS ? ((row - NPROMPT) >> 6) : (row >> 12), t = isS ? ((row - NPROMPT) & 63) : (row & 4095);
        const bf16_t* zr = Z + (size_t)row * INW + 8 * lane;
        const u32x4 cb = *(const u32x4*)(zr + 768);
        float u[3][8];
#pragma unroll
        for (int d = 0; d < 3; ++d) {
            if (t - d >= 0) {
                const bf16_t* zz = zr - (size_t)d * INW; const u32x4 cc = *(const u32x4*)(zz + 1280), cx = *(const u32x4*)(zz + 1792);
                u[d][0] = bf_lo(cc.x) * bf_lo(cx.x); u[d][1] = bf_hi(cc.x) * bf_hi(cx.x); u[d][2] = bf_lo(cc.y) * bf_lo(cx.y); u[d][3] = bf_hi(cc.y) * bf_hi(cx.y);
                u[d][4] = bf_lo(cc.z) * bf_lo(cx.z); u[d][5] = bf_hi(cc.z) * bf_hi(cx.z); u[d][6] = bf_lo(cc.w) * bf_lo(cx.w); u[d][7] = bf_hi(cc.w) * bf_hi(cx.w);
            } else if (isS) {
                const float* hp = F.in[6] + ((size_t)(l * 8 + b) * 2 + (2 + t - d)) * 512 + 8 * lane;
                const f32x4 h0 = *(const f32x4*)hp, h1 = *(const f32x4*)(hp + 4);
#pragma unroll
                for (int e = 0; e < 4; ++e) { u[d][e] = h0[e]; u[d][4 + e] = h1[e]; }
            } else {
#pragma unroll
                for (int e = 0; e < 8; ++e) u[d][e] = 0.f;
            }
        }
        const float cbf[8] = {bf_lo(cb.x), bf_hi(cb.x), bf_lo(cb.y), bf_hi(cb.y), bf_lo(cb.z), bf_hi(cb.z), bf_lo(cb.w), bf_hi(cb.w)};
        float y[8];
#pragma unroll
        for (int e = 0; e < 8; ++e) y[e] = cbf[e] * (w0[e] * u[2][e] + w1[e] * u[1][e] + w2[e] * u[0][e]);
        u32x2 w; w.x = pk4_fp8(y[0], y[1], y[2], y[3]); w.y = pk4_fp8(y[4], y[5], y[6], y[7]);
        *(u32x2*)(YB + (size_t)row * 512 + 8 * lane) = w;
        const int tl = isS ? 62 : 4094;
        if (t >= tl) {
            float* o = F.out + (isS ? OCS : OCP) + ((size_t)(l * 8 + b) * 2 + (t - tl)) * 512 + 8 * lane;
            *(f32x4*)o = (f32x4){u[0][0], u[0][1], u[0][2], u[0][3]}; *(f32x4*)(o + 4) = (f32x4){u[0][4], u[0][5], u[0][6], u[0][7]};
        }
    }
}

__device__ __forceinline__ void phase_ln_router(Ctx& F, int l) {
    bf16_t* XB = (bf16_t*)(F.ws + WS_XB); unsigned char* H8 = (unsigned char*)(F.ws + WS_H8); const bf16_t* V16 = (const bf16_t*)(F.ws + WS_V16);
    const float* mod = (const float*)(F.ws + WS_MOD) + (size_t)l * 16 * 6144;
    unsigned* cnt = (unsigned*)(F.ws + WS_CNT) + l * 2048;
    unsigned* tok = (unsigned*)(F.ws + WS_TOK); float* gate = (float*)(F.ws + WS_GATE); unsigned* slot = (unsigned*)(F.ws + WS_SLOT);
    const float* Wr = F.in[21] + (size_t)l * 1024 * 32;
    LAS float* hf = (LAS float*)F.lds;
    LAS unsigned* hist = (LAS unsigned*)(F.lds + 139264); LAS unsigned* hbase = hist + 32;
    const int lane = F.lane, w = F.wave;
    for (int tile = F.bx; tile < NT / 32; tile += F.G) {
        __syncthreads();
        if (F.tid < 32) hist[F.tid] = 0u;
        {
            u32x2 pv[4][4];
#pragma unroll
            for (int rr = 0; rr < 4; ++rr)
#pragma unroll
                for (int j = 0; j < 4; ++j) pv[rr][j] = *(const u32x2*)(V16 + (size_t)(tile * 32 + w * 4 + rr) * D + 4 * lane + 256 * j);
#pragma unroll
            for (int rr = 0; rr < 4; ++rr) {
                const int rl = w * 4 + rr, row = tile * 32 + rl;
                f32x4 v[4];
#pragma unroll
                for (int j = 0; j < 4; ++j) v[j] = (f32x4){bf_lo(pv[rr][j].x), bf_hi(pv[rr][j].x), bf_lo(pv[rr][j].y), bf_hi(pv[rr][j].y)};
                ln_row(v, F.in[19] + l * D, F.in[20] + l * D, lane);
#pragma unroll
                for (int j = 0; j < 4; ++j) { u32x2 wq; wq.x = cvt_pk_bf16(v[j][0], v[j][1]); wq.y = cvt_pk_bf16(v[j][2], v[j][3]); *(u32x2*)(XB + (size_t)row * D + 4 * lane + 256 * j) = wq; }
                const float* mb = mod + (size_t)batch_of(row) * 6144;
#pragma unroll
                for (int j = 0; j < 4; ++j) { const f32x4 a = *(const f32x4*)(mb + 4096 + 4 * lane + 256 * j), b = *(const f32x4*)(mb + 3072 + 4 * lane + 256 * j);
                    const f32x4 h = v[j] * (a + 1.0f) + b;
                    *(unsigned*)(H8 + (size_t)row * D + 4 * lane + 256 * j) = pk4_fp8(h[0], h[1], h[2], h[3]);
                    LAS float* hp = hf + rl * 1025 + 4 * lane + 256 * j; hp[0] = h[0]; hp[1] = h[1]; hp[2] = h[2]; hp[3] = h[3]; }
            }
        }
        __syncthreads();
        f32x16 acc;
#pragma unroll
        for (int j = 0; j < 16; ++j) acc[j] = 0.f;
        {
            const LAS float* ap = hf + (lane & 31) * 1025 + 128 * w + (lane >> 5);
            const float* bp = Wr + (size_t)(128 * w) * 32 + lane;
#pragma unroll 8
            for (int s = 0; s < 64; ++s) acc = __builtin_amdgcn_mfma_f32_32x32x2f32(ap[2 * s], bp[64 * s], acc, 0, 0, 0);
        }
        __syncthreads();
        LAS float* red = hf;
#pragma unroll
        for (int j = 0; j < 16; ++j) red[(w * 32 + 8 * (j >> 2) + 4 * (lane >> 5) + (j & 3)) * 33 + (lane & 31)] = acc[j];
        __syncthreads();
        int e_sel[4]; float g_sel[4]; unsigned loc[4];
#pragma unroll
        for (int rr = 0; rr < 4; ++rr) {
            const int tk = w * 4 + rr;
            float val = -INFINITY;
            if (lane < 32) { float sacc = F.in[22][l * 32 + lane];
#pragma unroll
                for (int ww = 0; ww < 8; ++ww) sacc += red[(ww * 32 + tk) * 33 + lane];
                val = sacc; }
            float tv[4]; int te[4];
            {
                const int vbits = __float_as_int(val); int rank = 0;
#pragma unroll
                for (int j = 0; j < 32; ++j) { const float vj = __int_as_float(__builtin_amdgcn_readlane(vbits, j)); rank += (vj > val || (vj == val && j < lane)) ? 1 : 0; }
#pragma unroll
                for (int it = 0; it < 4; ++it) { const unsigned long long mk = __ballot(rank == it); const int ln = mk ? (__ffsll((long long)mk) - 1) : 0;
                    te[it] = ln; tv[it] = __int_as_float(__builtin_amdgcn_readlane(vbits, ln)); }
            }
            const float e1 = __expf(tv[1] - tv[0]), e2 = __expf(tv[2] - tv[0]), e3 = __expf(tv[3] - tv[0]);
            const float rs = 1.0f / (1.0f + e1 + e2 + e3);
            e_sel[rr] = lane == 0 ? te[0] : lane == 1 ? te[1] : lane == 2 ? te[2] : te[3];
            g_sel[rr] = (lane == 0 ? 1.0f : lane == 1 ? e1 : lane == 2 ? e2 : e3) * rs;
            loc[rr] = 0u;
            if (lane < 4) loc[rr] = atomicAdd((unsigned*)&hist[e_sel[rr]], 1u);
        }
        __syncthreads();
        if (F.tid < 32) { const unsigned hcount = hist[F.tid]; hbase[F.tid] = hcount ? atomicAdd(cnt + F.tid * 64, hcount) : 0u; }
        __syncthreads();
        if (lane < 4) {
#pragma unroll
            for (int rr = 0; rr < 4; ++rr) {
                const int row = tile * 32 + w * 4 + rr, e = e_sel[rr]; const unsigned rank = hbase[e] + loc[rr];
                tok[(size_t)e * NT + rank] = (unsigned)row; gate[(size_t)e * NT + rank] = g_sel[rr]; slot[(size_t)row * 4 + lane] = ((unsigned)e << 24) | rank;
            }
        }
    }
}

__device__ __forceinline__ void build_blk(Ctx& F, int l) {
    LAS int* blk = (LAS int*)(F.lds + LDS_BLK);
    const unsigned* cnt = (const unsigned*)(F.ws + WS_CNT) + l * 2048;
    __syncthreads();
    if (F.tid == 0) { int s = 0; for (int e = 0; e < 32; ++e) { blk[e] = s; s += ((int)cnt[e * 64] + 255) >> 8; } blk[32] = s; }
    __syncthreads();
}

__device__ __forceinline__ void phase_combine(Ctx& F, int l) {
    const LAS int* blk = (const LAS int*)(F.lds + LDS_BLK);
    float* X = F.out; bf16_t* XB = (bf16_t*)(F.ws + WS_XB); bf16_t* H = (bf16_t*)(F.ws + WS_H); const unsigned char* YS = F.ws + WS_YS;
    const unsigned* slot = (const unsigned*)(F.ws + WS_SLOT);
    const float* mod = (const float*)(F.ws + WS_MOD);
    const int gw = F.bx * NWAVES + F.wave, NGW = F.G * NWAVES, lane = F.lane;
    for (int row = gw; row < NT; row += NGW) {
        f32x4 ff[4];
#pragma unroll
        for (int j = 0; j < 4; ++j) ff[j] = (f32x4){0.f, 0.f, 0.f, 0.f};
#pragma unroll
        for (int k = 0; k < 4; ++k) {
            const unsigned s = slot[(size_t)row * 4 + k]; const int e = (int)(s >> 24), rank = (int)(s & 0xffffffu);
            const unsigned char* yr = YS + ((size_t)blk[e] * 256 + rank) * D + 4 * lane;
#pragma unroll
            for (int j = 0; j < 4; ++j) { const unsigned wv = *(const unsigned*)(yr + 256 * j); const f32x2 lo = __builtin_amdgcn_cvt_pk_f32_fp8(wv, false), hi = __builtin_amdgcn_cvt_pk_f32_fp8(wv, true);
                ff[j][0] += lo.x; ff[j][1] += lo.y; ff[j][2] += hi.x; ff[j][3] += hi.y; }
        }
        const int bi = batch_of(row);
        const float* mb = mod + (size_t)(l * 16 + bi) * 6144;
        f32x4 v[4];
#pragma unroll
        for (int j = 0; j < 4; ++j) { const u32x2 xw = *(const u32x2*)(XB + (size_t)row * D + 4 * lane + 256 * j); const f32x4 x = (f32x4){bf_lo(xw.x), bf_hi(xw.x), bf_lo(xw.y), bf_hi(xw.y)}, g2 = *(const f32x4*)(mb + 5120 + 4 * lane + 256 * j);
            v[j] = x * ALPHA + (g2 + 1.0f) * (ff[j] * 0.0625f); }
        ln_row(v, F.in[27] + l * D, F.in[28] + l * D, lane);
#pragma unroll
        for (int j = 0; j < 4; ++j) { if (l == 0) { u32x2 w; w.x = cvt_pk_bf16(v[j][0], v[j][1]); w.y = cvt_pk_bf16(v[j][2], v[j][3]); *(u32x2*)(XB + (size_t)row * D + 4 * lane + 256 * j) = w; }
            else *(f32x4*)(X + (size_t)row * D + 4 * lane + 256 * j) = v[j]; }
        if (l == 0) { const float* mn = mod + (size_t)(16 + bi) * 6144; store_mod_row(v, mn, mn + 1024, H + (size_t)row * D, F.ws + WS_H8 + (size_t)row * D, lane); }
    }
}

#ifndef PH_MASK
#define PH_MASK 0xFFFF
#endif
#define PH(b) ((PH_MASK >> (b)) & 1)
#ifndef PROBE_MASK
#define PROBE_MASK 0
#endif
#define PB0(id) do { if ((PROBE_MASK >> (id)) & 1) pb_t0 = __builtin_amdgcn_s_memrealtime(); } while (0)
#define PB1(id) do { if ((PROBE_MASK >> (id)) & 1) pb_acc += __builtin_amdgcn_s_memrealtime() - pb_t0; } while (0)
#define RELOAD() do { int t_ = threadIdx.x; asm volatile("" : "+v"(t_)); F.tid = t_; F.lane = t_ & 63; F.wave = __builtin_amdgcn_readfirstlane(t_ >> 6); \
    unsigned z_; asm volatile("s_mov_b32 %0, 0" : "=s"(z_)); F.in = p.in; F.out = p.out + z_; F.ws = p.ws + z_; } while (0)
#define LAYER_BODY(l) do { \
          \
        PB0(2); RELOAD(); \
        if (PH(2)) { \
              \
            pg8::SchedDense S; S.init(NT, 7 * 256, D, F.G, F.bx, (const bf16_t*)(F.ws + WS_WIN) + (size_t)l * INW * D, 2); \
            pg8::EpiZ E{(bf16_t*)(F.ws + WS_Z), F.in[13] + l * INW, F.out, l}; \
            pg8::gemm_phase<false, 0u>(F.lds, (const char*)(F.ws + WS_H), D, S, E); \
        } \
        RELOAD(); \
        if (PH(2)) { \
              \
            pg8::SchedDense S; S.init(NT, 10 * 256, 512, F.G, (F.G == 256) ? ((F.bx + 112) & 255) : F.bx, F.ws + WS_WIN8 + (size_t)l * INW * D, 0, 2, 7); \
            pg8::EpiZ E{(bf16_t*)(F.ws + WS_Z), F.in[13] + l * INW, F.out, l}; \
            pg8::gemm_phase<true, 0x7f7f7f7fu>(F.lds, (const char*)(F.ws + WS_H8), 512, S, E); \
        } \
        xcd_barrier(xbar); PB1(2); PB0(3); \
        RELOAD(); \
        if (PH(3)) phase_attn(F, l); \
        xcd_barrier(xbar); PB1(3); PB0(4); \
          \
        RELOAD(); \
        if (PH(4)) { \
            pg8::SchedDense S; S.init(NT, D, 256, F.G, F.bx, F.ws + WS_WOA + (size_t)l * D * 512); \
            pg8::EpiT1 E{(bf16_t*)(F.ws + WS_T1), (const bf16_t*)(F.ws + WS_Z)}; \
            pg8::gemm_phase<true, 0x7c7c7c7cu>(F.lds, (const char*)(F.ws + WS_YA), 256, S, E); \
        } \
        RELOAD(); \
        if (PH(5)) { \
            pg8::SchedDense S; S.init(NT, D, 256, F.G, F.bx, F.ws + WS_WOB + (size_t)l * D * 512); \
            pg8::EpiMix E{(const bf16_t*)(F.ws + WS_T1), (const bf16_t*)(F.ws + WS_Z), F.ws + WS_MIX}; \
            pg8::gemm_phase<true, 0x7f7f7f7fu>(F.lds, (const char*)(F.ws + WS_YB), 256, S, E); \
        } \
        xcd_barrier(xbar); PB1(4); PB0(5); \
          \
        RELOAD(); \
        if (PH(6)) { \
            pg8::SchedDense S; S.init(NT, D, 512, F.G, F.bx, F.ws + WS_WO + (size_t)l * D * D); \
            pg8::EpiX E{(const bf16_t*)(F.ws + WS_XB), (bf16_t*)(F.ws + WS_V16), (const float*)(F.ws + WS_MOD) + (size_t)l * 16 * 6144}; \
            pg8::gemm_phase<true, 0x7f7f7f7fu>(F.lds, (const char*)(F.ws + WS_MIX), 512, S, E); \
        } \
        xcd_barrier(xbar); PB1(5); PB0(6); \
        RELOAD(); \
        if (PH(7)) phase_ln_router(F, l); \
        xcd_barrier(xbar); PB1(6); PB0(7); \
          \
        RELOAD(); \
        build_blk(F, l); \
        if (PH(8)) { \
            LAS int* blk = (LAS int*)(F.lds + LDS_BLK); \
            LAS unsigned short* idx = (LAS unsigned short*)(F.lds + LDS_IDX); \
            pg8::SchedMoE<true> S; S.init(blk, idx, 8, 512, F.G, F.bx, (const unsigned char*)(F.ws + WS_WGU) + (size_t)l * 32 * 2048 * D, (size_t)2048 * D); \
            const unsigned* cnt = (const unsigned*)(F.ws + WS_CNT) + l * 2048; const unsigned* tok = (const unsigned*)(F.ws + WS_TOK); \
            for (int i = 0; i < MAXU; ++i) { pg8::Unit u; if (!S.next(i, u)) break; \
                if (F.tid < 256) { int rank = (u.pm - blk[u.e]) * 256 + F.tid; const int ce = (int)cnt[u.e * 64]; rank = rank < ce ? rank : ce - 1; \
                    idx[i * 256 + F.tid] = (unsigned short)tok[(size_t)u.e * NT + rank]; } } \
            __syncthreads(); \
            pg8::EpiAct E{(unsigned char*)(F.ws + WS_ACT), F.in[24] + (size_t)l * 32 * 2048}; \
            pg8::gemm_phase<true, 0x7f7f7f7fu>(F.lds, (const char*)(F.ws + WS_H8), 512, S, E); \
        } \
        xcd_barrier(xbar); PB1(7); PB0(8); \
          \
        RELOAD(); \
        if (PH(9)) { \
            LAS int* blk = (LAS int*)(F.lds + LDS_BLK); \
            LAS unsigned short* idx = (LAS unsigned short*)(F.lds + LDS_IDX); \
            pg8::SchedMoE<false> S; S.init(blk, idx, 4, 512, F.G, F.bx, (const unsigned char*)(F.ws + WS_WDN) + (size_t)l * 32 * D * D, (size_t)D * D); \
            pg8::EpiYs E{F.ws + WS_YS, F.in[26] + (size_t)l * 32 * D, (const float*)(F.ws + WS_GATE), (const unsigned*)(F.ws + WS_CNT) + l * 2048, blk}; \
            pg8::gemm_phase<true, 0x7f7f7f7fu>(F.lds, (const char*)(F.ws + WS_ACT), 512, S, E); \
        } \
        xcd_barrier(xbar); PB1(8); PB0(9); \
        RELOAD(); \
        if (PH(10)) phase_combine(F, l); \
        if (l == 0) xcd_barrier(xbar); \
        PB1(9); \
 \
    } while (0)
__global__ void __launch_bounds__(NTHREADS, 2) fwd_megakernel(Params p) {
    extern __shared__ __attribute__((aligned(16))) unsigned char lds_raw[];
    cg::grid_group grid = cg::this_grid();
    Ctx F;
    F.lds = (LAS unsigned char*)lds_raw;
    F.G = gridDim.x; F.bx = blockIdx.x;
    volatile LAS unsigned* bst = (volatile LAS unsigned*)(F.lds + 147392);
    if (threadIdx.x < 2) bst[threadIdx.x] = 0u;
    __syncthreads();
    const XcdBarrier xbar = xcd_barrier_post((unsigned*)(p.ws + WS_BAR), bst);
    unsigned long long pb_t0 = 0, pb_acc = 0;
    PB0(0); RELOAD();
    if (PH(0)) phase0a(F);
    grid.sync();
    PB1(0); PB0(1); RELOAD();
    { const float* modp = (const float*)(F.ws + WS_MODP); float* mod = (float*)(F.ws + WS_MOD);
      for (int i = F.bx * NTHREADS + F.tid; i < 2 * 16 * 6144; i += F.G * NTHREADS) { float sm = 0.f;
#pragma unroll
          for (int kc = 0; kc < 8; ++kc) sm += modp[(size_t)kc * (2 * 16 * 6144) + i];
          mod[i] = sm; } }
    xcd_barrier(xbar);
    RELOAD();
    if (PH(1)) phase0b(F);
    xcd_barrier(xbar); PB1(1);

    LAYER_BODY(0);
    LAYER_BODY(1);
    if (PROBE_MASK != 0 && blockIdx.x == 0) { const unsigned long long te = __builtin_amdgcn_s_memrealtime(); while (__builtin_amdgcn_s_memrealtime() - te < pb_acc) __builtin_amdgcn_s_sleep(8); }
    (void)pb_t0; (void)pb_acc;
}

extern "C" void kernel_launch(void* const* d_in, const int* in_sizes, int n_in, void* d_out, int out_size, void* d_ws, size_t ws_size, hipStream_t stream) {
    static int grid = 0;
    if (grid == 0) {
        if (n_in != 29 || ws_size < WS_END) { fprintf(stderr, "kernel_launch: unexpected n_in %d / ws_size %zu (need %zu)\n", n_in, ws_size, (size_t)WS_END); grid = -1; return; }
        int dev = 0, cus = 0, per_cu = 0;
        hipGetDevice(&dev);
        hipDeviceGetAttribute(&cus, hipDeviceAttributeMultiprocessorCount, dev);
        if (hipFuncSetAttribute((const void*)fwd_megakernel, hipFuncAttributeMaxDynamicSharedMemorySize, LDS_BYTES) != hipSuccess) { fprintf(stderr, "kernel_launch: hipFuncSetAttribute failed\n"); grid = -1; return; }
        if (hipOccupancyMaxActiveBlocksPerMultiprocessor(&per_cu, (const void*)fwd_megakernel, NTHREADS, LDS_BYTES) != hipSuccess || per_cu < 1) { fprintf(stderr, "kernel_launch: occupancy query says %d blocks per CU\n", per_cu); per_cu = 1; }
        (void)hipGetLastError();
        grid = cus;
        if (grid != 256) fprintf(stderr, "kernel_launch: note: %d CUs (built for 256)\n", grid);
    }
    if (grid < 0) return;
    hipMemsetAsync((char*)d_ws, 0, WS_ZERO_BYTES, stream);
    Params p{};
    for (int i = 0; i < 29; ++i) p.in[i] = (const float*)d_in[i];
    p.out = (float*)d_out; p.ws = (unsigned char*)d_ws;
    void* args[] = {&p};
    hipError_t e = hipLaunchCooperativeKernel((const void*)fwd_megakernel, dim3(grid), dim3(NTHREADS), args, LDS_BYTES, stream);
    if (e != hipSuccess) fprintf(stderr, "kernel_launch: cooperative launch failed: %s (grid %d)\n", hipGetErrorString(e), grid);
}
```

```cpp
#include <hip/hip_runtime.h>
#include <hip/hip_cooperative_groups.h>
#include <cstdio>
#include <cstdint>
namespace cg = cooperative_groups;

#define LAS __attribute__((address_space(3)))
typedef unsigned short bf16_t;
typedef short bf16x8 __attribute__((ext_vector_type(8)));
typedef float f32x4 __attribute__((ext_vector_type(4)));
typedef float f32x16 __attribute__((ext_vector_type(16)));
typedef unsigned u32x4 __attribute__((ext_vector_type(4)));
typedef unsigned u32x2 __attribute__((ext_vector_type(2)));
typedef float f32x2 __attribute__((ext_vector_type(2)));
typedef int i32x4 __attribute__((ext_vector_type(4)));
typedef int i32x8 __attribute__((ext_vector_type(8)));

constexpr int D = 1024, NPROMPT = 32768, NT = 33280, INW = 4352, NEXP = 32;
constexpr float ALPHA = 1.41421356237f, LN_EPS = 1e-5f;
constexpr int NWAVES = 8, NTHREADS = 512;
constexpr int LDS_BYTES = 147456;
constexpr int LDS_BLK = 131072;
constexpr int LDS_IDX = 131072 + 256;
constexpr int MAXU = 24;
constexpr size_t OKP = 34078720, OVP = 34340864, OCP = 34603008, OKS = 34619392, OVS = 34881536, OCS = 35143680;
constexpr size_t MiB = 1u << 20;
constexpr size_t WS_CNT = 0;
constexpr size_t WS_BAR = 16384;
constexpr size_t WS_MOD = 65536;
constexpr size_t WS_MODP = 192 * MiB;
constexpr size_t WS_ZERO_BYTES = 1 * MiB;
constexpr size_t WS_BIAS = 1 * MiB;
constexpr size_t WS_SLOT = 2 * MiB;
constexpr size_t WS_TOK = 3 * MiB;
constexpr size_t WS_GATE = 8 * MiB;
constexpr size_t WS_WIN = 16 * MiB;
constexpr size_t WS_WIN8 = 180 * MiB;
constexpr size_t WS_WOA = 34 * MiB;
constexpr size_t WS_WOB = 36 * MiB;
constexpr size_t WS_WO = 38 * MiB;
constexpr size_t WS_WGU = 48 * MiB;
constexpr size_t WS_WDN = 304 * MiB;
constexpr size_t WS_H = 432 * MiB;
constexpr size_t WS_H8 = 1600 * MiB;
constexpr size_t WS_Z = 498 * MiB;
constexpr size_t WS_YA = 776 * MiB;
constexpr size_t WS_YB = 810 * MiB;
constexpr size_t WS_T1 = 844 * MiB;
constexpr size_t WS_V16 = 910 * MiB;
constexpr size_t WS_XB = 1200 * MiB;
constexpr size_t WS_MIX = 976 * MiB;
constexpr size_t WS_ACT = 1042 * MiB;
constexpr size_t WS_YS = 1320 * MiB;
constexpr size_t WS_END = 1634 * MiB;

struct Params { const float* in[29]; float* out; unsigned char* ws; };

__device__ __forceinline__ unsigned cvt_pk_bf16(float lo, float hi) { unsigned r; asm volatile("v_cvt_pk_bf16_f32 %0, %1, %2" : "=v"(r) : "v"(lo), "v"(hi)); return r; }
__device__ __forceinline__ unsigned pk4_fp8(float a, float b, float c, float d) { unsigned w = 0u; w = __builtin_amdgcn_cvt_pk_fp8_f32(a, b, w, false); w = __builtin_amdgcn_cvt_pk_fp8_f32(c, d, w, true); return w; }
__device__ __forceinline__ float bf_lo(unsigned w) { return __uint_as_float(w << 16); }
__device__ __forceinline__ float bf_hi(unsigned w) { return __uint_as_float(w & 0xffff0000u); }
__device__ __forceinline__ float sigmoidf_(float x) { return __builtin_amdgcn_rcpf(1.0f + __expf(-x)); }
__device__ __forceinline__ float wave_sum(float v) {
#pragma unroll
    for (int o = 1; o < 64; o <<= 1) v += __shfl_xor(v, o);
    return v;
}
__device__ __forceinline__ int batch_of(int row) { return row < NPROMPT ? (row >> 12) : 8 + ((row - NPROMPT) >> 6); }

namespace pg8 {
constexpr int BM = 256, BK = 64, HALF = 128, HTB = HALF * BK * 2, NXCD = 8, WGM = 8;
__device__ __forceinline__ int lds_byte(int r, int c) { const int st = (r >> 4) * 2 + (c >> 5), rr = r & 15, cc = c & 31, ob = rr * 64 + cc * 2; return st * 1024 + (ob ^ (((ob >> 9) & 1) << 5)); }
__device__ __forceinline__ void stage_rc(int b, int& R, int& C) { const int st = b / 1024, sb = b % 1024, swz = sb ^ (((sb >> 9) & 1) << 5); R = (st >> 1) * 16 + swz / 64; C = (st & 1) * 32 + (swz % 64) / 2; }
__device__ __forceinline__ int perm32(int rho) { const int n = rho >> 4, i = rho & 15; return 8 * (i >> 2) + 4 * n + (i & 3); }

struct Unit { int pm, pn, e; const char* b; };

struct SchedDense {
    int nM, nN, nwg, G, c, cbase, csplit, cskip; const char* Bt; size_t tstepB;
    __device__ __forceinline__ void init(int M, int N, int K, int G_, int c_, const void* Bt_, int cbase_ = 0, int csplit_ = 1 << 20, int cskip_ = 0) { nM = M / BM; nN = N / BM; nwg = nM * nN; G = G_; c = c_; Bt = (const char*)Bt_; tstepB = (size_t)BM * K * 2; cbase = cbase_; csplit = csplit_; cskip = cskip_; }
    __device__ __forceinline__ bool next(int i, Unit& u) const {
        const long L = (long)i * G + c; if (L >= nwg) return false;
        int wgid = (int)L; { const int q = nwg / NXCD, r = nwg % NXCD, xcd = wgid % NXCD, off = wgid / NXCD; wgid = (xcd < r ? xcd * (q + 1) : r * (q + 1) + (xcd - r) * q) + off; }
        const int nig = WGM * nN, gid = wgid / nig, fm = gid * WGM, gsz = (nM - fm) < WGM ? (nM - fm) : WGM;
        u.pm = fm + ((wgid % nig) % gsz); const int j = (wgid % nig) / gsz; u.pn = j < csplit ? j + cbase : j + cbase + cskip; u.e = 0; u.b = Bt + (size_t)u.pn * tstepB; return true;
    }
    __device__ __forceinline__ unsigned rowidx(int, const Unit& u, int r) const { return (unsigned)(u.pm * BM + r); }
};
template <bool GATHER> struct SchedMoE {
    const LAS int* blk; const LAS unsigned short* idx; int NB, RBX, NPN, NXs, perx, cx, cj; const char* Bt; size_t estep, tstepB;
    __device__ __forceinline__ void init(const LAS int* blk_, const LAS unsigned short* idx_, int NPN_, int K, int G, int c, const void* Bt_, size_t estep_) {
        blk = blk_; idx = idx_; NB = blk_[32]; NPN = NPN_; Bt = (const char*)Bt_; estep = estep_; tstepB = (size_t)BM * K * 2;
        if ((G & 7) == 0) { NXs = 8; perx = G >> 3; cx = c & 7; cj = c >> 3; } else { NXs = 1; perx = G; cx = 0; cj = c; }
        RBX = (NB + NXs - 1) / NXs;
    }
    __device__ __forceinline__ bool next(int i, Unit& u) const {
        const int j = i * perx + cj, rbl = j / NPN; if (rbl >= RBX) return false;
        const int rb = cx * RBX + rbl; if (rb >= NB) return false;
        int e = 0;
        for (int q = 1; q < 32; ++q) e = (blk[q] <= rb) ? q : e;
        u.pm = rb; u.pn = j - rbl * NPN; u.e = e; u.b = Bt + (size_t)e * estep + (size_t)u.pn * tstepB; return true;
    }
    __device__ __forceinline__ unsigned rowidx(int ui, const Unit& u, int r) const { if (GATHER) return (unsigned)idx[ui * 256 + r]; return (unsigned)(u.pm * BM + r); }
};

template <bool FP8, unsigned ASCALE, class Epi, class Sched>
__device__ __forceinline__ void gemm_phase(LAS unsigned char* lds, const char* Abase, const int K, const Sched& S, const Epi& E) {
    int tid_ = threadIdx.x; asm volatile("" : "+v"(tid_));
    const int tid = tid_, wid = __builtin_amdgcn_readfirstlane(tid >> 6), lane = tid & 63, wr = wid >> 2, wc = wid & 3, fr = lane & 15, fq = lane >> 4;
    int nt_ = K / BK; asm volatile("" : "+s"(nt_)); const int nt = nt_;
    unsigned voffB[2]; int RA[2], CA[2];
#pragma unroll
    for (int i = 0; i < 2; ++i) { int R, C; stage_rc(tid * 16 + i * 8192, R, C); const int Rb = Epi::PERM ? ((R & ~31) + perm32(R & 31)) : R;
        voffB[i] = (unsigned)(Rb * K + C) * 2u; RA[i] = R; CA[i] = C * 2; }
    const size_t kstep = (size_t)(BK * 2);
    const size_t hstep = (size_t)HALF * K * 2;
    const unsigned ldsw = (unsigned)wid * 1024u;
    const unsigned rowb = (unsigned)K * 2u;
    const int aoff = lds_byte(wr * 64 + fr, fq * 8), boff = lds_byte(wc * 32 + fr, fq * 8);
#define PG8_SA(b, h) (((b) * 2 + (h)) * HTB)
#define PG8_SB(b, h) ((4 + (b) * 2 + (h)) * HTB)
#define PG8_STAGE(bufoff, gbase, voff) do { _Pragma("unroll") for (int _i = 0; _i < 2; ++_i) \
        __builtin_amdgcn_global_load_lds((const unsigned*)((const char*)(gbase) + (voff)[_i]), (LAS unsigned*)(lds + (bufoff) + ldsw + _i * 8192), 16, 0, 0); } while (0)
#define PG8_LDA(dst, b, h) do { _Pragma("unroll") for (int m = 0; m < 4; ++m) _Pragma("unroll") for (int k = 0; k < 2; ++k) dst[m][k] = *(const LAS bf16x8*)(lds + PG8_SA(b, h) + aoff + m * 2048 + k * 1024); } while (0)
#define PG8_LDB(dst, b, h) do { _Pragma("unroll") for (int n = 0; n < 2; ++n) _Pragma("unroll") for (int k = 0; k < 2; ++k) dst[n][k] = *(const LAS bf16x8*)(lds + PG8_SB(b, h) + boff + n * 2048 + k * 1024); } while (0)
#define PG8_MMA(ai, bj, At, Bt) do { __builtin_amdgcn_s_setprio(1); _Pragma("unroll") for (int m = 0; m < 4; ++m) _Pragma("unroll") for (int n = 0; n < 2; ++n) { \
        if constexpr (FP8) { \
            const i32x8 wf_ = __builtin_shufflevector((i32x4)Bt[n][0], (i32x4)Bt[n][1], 0, 1, 2, 3, 4, 5, 6, 7), af_ = __builtin_shufflevector((i32x4)At[m][0], (i32x4)At[m][1], 0, 1, 2, 3, 4, 5, 6, 7); \
            acc[ai][bj][m][n] = __builtin_amdgcn_mfma_scale_f32_16x16x128_f8f6f4(wf_, af_, acc[ai][bj][m][n], 0, 0, 0, 0x79797979, 0, (int)ASCALE); \
        } else { _Pragma("unroll") for (int k = 0; k < 2; ++k) \
            acc[ai][bj][m][n] = __builtin_amdgcn_mfma_f32_16x16x32_bf16(Bt[n][k], At[m][k], acc[ai][bj][m][n], 0, 0, 0); } } \
        __builtin_amdgcn_s_setprio(0); } while (0)
#define PG8_WAIT_V(n) asm volatile("s_waitcnt vmcnt(" #n ")" ::: "memory")
#define PG8_WAIT_L(n) asm volatile("s_waitcnt lgkmcnt(" #n ")" ::: "memory")
#define PG8_BAR __builtin_amdgcn_s_barrier()
#define PG8_SCHED __builtin_amdgcn_sched_barrier(0)
#define PG8_LOADVA(ui_, u_) do { _Pragma("unroll") for (int _h = 0; _h < 2; ++_h) _Pragma("unroll") for (int _i = 0; _i < 2; ++_i) \
        vA[_h][_i] = S.rowidx((ui_), (u_), _h * HALF + RA[_i]) * rowb + (unsigned)CA[_i]; } while (0)
    Unit cur, nxt; int ui = 0;
    if (!S.next(0, cur)) return;
    f32x4 acc[2][2][4][2];
#pragma unroll
    for (int a = 0; a < 2; ++a)
#pragma unroll
        for (int b = 0; b < 2; ++b)
#pragma unroll
            for (int m = 0; m < 4; ++m)
#pragma unroll
                for (int n = 0; n < 2; ++n) acc[a][b][m][n] = (f32x4){0.f, 0.f, 0.f, 0.f};
    bf16x8 At[4][2], B0[2][2], B1[2][2];
    unsigned vA[2][2];
    PG8_LOADVA(0, cur);
    const char* cB = cur.b;
    PG8_STAGE(PG8_SB(0, 0), cB, voffB); PG8_STAGE(PG8_SB(0, 1), cB + hstep, voffB); PG8_STAGE(PG8_SA(0, 0), Abase, vA[0]); PG8_STAGE(PG8_SA(0, 1), Abase, vA[1]);
    if (wr == 1) PG8_BAR;
    PG8_WAIT_V(2); PG8_BAR;
    PG8_STAGE(PG8_SB(1, 0), cB + kstep, voffB); PG8_STAGE(PG8_SA(1, 0), Abase + kstep, vA[0]); PG8_STAGE(PG8_SB(1, 1), cB + hstep + kstep, voffB);
    PG8_WAIT_V(6); PG8_BAR;
    for (;;) {
        const bool has_next = S.next(ui + 1, nxt);
        const char* nB = has_next ? nxt.b : cB;
#pragma unroll 1
        for (int t = 0; t < nt; t += 2) {
            const bool last = (t == nt - 2);
            const char* a1 = Abase + (size_t)(t + 1) * kstep;
            const char* a2 = last ? Abase : Abase + (size_t)(t + 2) * kstep;
            const char* b2 = last ? nB : cB + (size_t)(t + 2) * kstep;
            const char* a3 = a2 + kstep; const char* b3 = b2 + kstep;
            PG8_LDB(B0, 0, 0); PG8_LDB(B1, 0, 1); PG8_SCHED; PG8_LDA(At, 0, 0); PG8_STAGE(PG8_SA(1, 1), a1, vA[1]);
            if (last && has_next) { PG8_LOADVA(ui + 1, nxt); }
            PG8_WAIT_V(8); PG8_WAIT_L(0); PG8_BAR; PG8_MMA(0, 0, At, B0); PG8_MMA(0, 1, At, B1); PG8_BAR; PG8_SCHED;
            PG8_LDA(At, 0, 1); PG8_STAGE(PG8_SB(0, 0), b2, voffB); PG8_STAGE(PG8_SB(0, 1), b2 + hstep, voffB); PG8_STAGE(PG8_SA(0, 0), a2, vA[0]);
            PG8_WAIT_V(8); PG8_WAIT_L(0); PG8_BAR; PG8_MMA(1, 0, At, B0); PG8_MMA(1, 1, At, B1); PG8_BAR; PG8_SCHED;
            PG8_LDB(B0, 1, 0); PG8_LDB(B1, 1, 1); PG8_SCHED; PG8_LDA(At, 1, 0); PG8_STAGE(PG8_SA(0, 1), a2, vA[1]);
            PG8_WAIT_V(8); PG8_WAIT_L(0); PG8_BAR; PG8_MMA(0, 0, At, B0); PG8_MMA(0, 1, At, B1); PG8_BAR; PG8_SCHED;
            PG8_LDA(At, 1, 1); PG8_STAGE(PG8_SB(1, 0), b3, voffB); PG8_STAGE(PG8_SB(1, 1), b3 + hstep, voffB); PG8_STAGE(PG8_SA(1, 0), a3, vA[0]);
            PG8_WAIT_V(8); PG8_WAIT_L(0); PG8_BAR; PG8_MMA(1, 0, At, B0); PG8_MMA(1, 1, At, B1); PG8_BAR; PG8_SCHED;
        }
        if (wr == 0) PG8_BAR;
        E(acc, cur, wr, wc, fr, fq);
        if (!has_next) break;
#pragma unroll
        for (int a = 0; a < 2; ++a)
#pragma unroll
            for (int b = 0; b < 2; ++b)
#pragma unroll
                for (int m = 0; m < 4; ++m)
#pragma unroll
                    for (int n = 0; n < 2; ++n) acc[a][b][m][n] = (f32x4){0.f, 0.f, 0.f, 0.f};
        cur = nxt; cB = nB; ++ui;
        if (wr == 1) PG8_BAR;
    }
    PG8_WAIT_V(0);
    PG8_BAR;
#undef PG8_SA
#undef PG8_SB
#undef PG8_STAGE
#undef PG8_LDA
#undef PG8_LDB
#undef PG8_MMA
#undef PG8_WAIT_V
#undef PG8_WAIT_L
#undef PG8_BAR
#undef PG8_SCHED
#undef PG8_LOADVA
}

typedef f32x4 Acc[2][2][4][2];

struct EpiZ {
    static constexpr bool PERM = true;
    bf16_t* Z; const float* bias; float* out; int l;
    __device__ __forceinline__ void operator()(const Acc& acc, const Unit& u, int wr, int wc, int fr, int fq) const {
        const int row0 = u.pm * 256 + wr * 64 + fr, col0 = u.pn * 256 + wc * 32 + 8 * fq;
        f32x4 bv[2][2];
#pragma unroll
        for (int bj = 0; bj < 2; ++bj)
#pragma unroll
            for (int n = 0; n < 2; ++n) bv[bj][n] = *(const f32x4*)(bias + col0 + bj * 128 + 4 * n);
#pragma unroll
        for (int ai = 0; ai < 2; ++ai)
#pragma unroll
            for (int m = 0; m < 4; ++m) {
                const int row = row0 + ai * 128 + m * 16;
                bf16_t* rowp = Z + (size_t)row * INW + col0;
                float* ko = nullptr; float* vo = nullptr;
                if (u.pn == 2) {
                    if (row < NPROMPT) { const int t = row & 4095; if (t >= 3968) { const size_t o = ((size_t)(l * 8 + (row >> 12)) * 128 + (t - 3968)) * 128 + wc * 32 + 8 * fq; ko = out + OKP + o; vo = out + OVP + o; } }
                    else { const int rr = row - NPROMPT; const size_t o = ((size_t)(l * 8 + (rr >> 6)) * 128 + 64 + (rr & 63)) * 128 + wc * 32 + 8 * fq; ko = out + OKS + o; vo = out + OVS + o; }
                }
#pragma unroll
                for (int bj = 0; bj < 2; ++bj) {
                    const f32x4 v0 = acc[ai][bj][m][0] + bv[bj][0], v1 = acc[ai][bj][m][1] + bv[bj][1];
                    u32x4 w; w.x = cvt_pk_bf16(v0[0], v0[1]); w.y = cvt_pk_bf16(v0[2], v0[3]); w.z = cvt_pk_bf16(v1[0], v1[1]); w.w = cvt_pk_bf16(v1[2], v1[3]);
                    *(u32x4*)(rowp + bj * 128) = w;
                    float* o = bj == 0 ? ko : vo;
                    if (o) { *(f32x4*)o = v0; *(f32x4*)(o + 4) = v1; }
                }
                asm volatile("" ::: "memory");
            }
    }
};
struct EpiT1 {
    static constexpr bool PERM = true;
    bf16_t* T1; const bf16_t* Z;
    __device__ __forceinline__ void operator()(const Acc& acc, const Unit& u, int wr, int wc, int fr, int fq) const {
        const int row0 = u.pm * 256 + wr * 64 + fr, col0 = u.pn * 256 + wc * 32 + 8 * fq;
        u32x4 g[2][4][2];
#pragma unroll
        for (int ai = 0; ai < 2; ++ai)
#pragma unroll
            for (int m = 0; m < 4; ++m)
#pragma unroll
                for (int bj = 0; bj < 2; ++bj) g[ai][m][bj] = *(const u32x4*)(Z + (size_t)(row0 + ai * 128 + m * 16) * INW + 2304 + col0 + bj * 128);
        asm volatile("" ::: "memory");
#pragma unroll
        for (int ai = 0; ai < 2; ++ai)
#pragma unroll
            for (int m = 0; m < 4; ++m) {
                const int row = row0 + ai * 128 + m * 16;
#pragma unroll
                for (int bj = 0; bj < 2; ++bj) {
                    const u32x4 gg = g[ai][m][bj];
                    f32x4 v0 = acc[ai][bj][m][0], v1 = acc[ai][bj][m][1];
                    v0[0] *= sigmoidf_(bf_lo(gg.x)); v0[1] *= sigmoidf_(bf_hi(gg.x)); v0[2] *= sigmoidf_(bf_lo(gg.y)); v0[3] *= sigmoidf_(bf_hi(gg.y));
                    v1[0] *= sigmoidf_(bf_lo(gg.z)); v1[1] *= sigmoidf_(bf_hi(gg.z)); v1[2] *= sigmoidf_(bf_lo(gg.w)); v1[3] *= sigmoidf_(bf_hi(gg.w));
                    u32x4 w; w.x = cvt_pk_bf16(v0[0], v0[1]); w.y = cvt_pk_bf16(v0[2], v0[3]); w.z = cvt_pk_bf16(v1[0], v1[1]); w.w = cvt_pk_bf16(v1[2], v1[3]);
                    *(u32x4*)(T1 + (size_t)row * D + col0 + bj * 128) = w;
                }
            }
    }
};
struct EpiMix {
    static constexpr bool PERM = true;
    const bf16_t* T1; const bf16_t* Z; unsigned char* MIX;
    __device__ __forceinline__ void operator()(const Acc& acc, const Unit& u, int wr, int wc, int fr, int fq) const {
        const int row0 = u.pm * 256 + wr * 64 + fr, col0 = u.pn * 256 + wc * 32 + 8 * fq;
#pragma unroll
        for (int ai = 0; ai < 2; ++ai)
#pragma unroll
        for (int mh = 0; mh < 2; ++mh) {
            u32x4 g[4][2]; u32x4 t[4][2];
#pragma unroll
            for (int m = 2 * mh; m < 2 * mh + 2; ++m)
#pragma unroll
                for (int bj = 0; bj < 2; ++bj) {
                    const int row = row0 + ai * 128 + m * 16;
                    g[m][bj] = *(const u32x4*)(Z + (size_t)row * INW + 3328 + col0 + bj * 128);
                    t[m][bj] = *(const u32x4*)(T1 + (size_t)row * D + col0 + bj * 128);
                }
            asm volatile("" ::: "memory");
#pragma unroll
            for (int m = 2 * mh; m < 2 * mh + 2; ++m)
#pragma unroll
                for (int bj = 0; bj < 2; ++bj) {
                    const int row = row0 + ai * 128 + m * 16;
                    const u32x4 gg = g[m][bj];
                    const u32x4 tt = t[m][bj];
                    f32x4 v0 = (f32x4){bf_lo(tt.x), bf_hi(tt.x), bf_lo(tt.y), bf_hi(tt.y)}, v1 = (f32x4){bf_lo(tt.z), bf_hi(tt.z), bf_lo(tt.w), bf_hi(tt.w)};
                    const f32x4 a0 = acc[ai][bj][m][0], a1 = acc[ai][bj][m][1];
                    v0[0] += a0[0] * sigmoidf_(bf_lo(gg.x)); v0[1] += a0[1] * sigmoidf_(bf_hi(gg.x)); v0[2] += a0[2] * sigmoidf_(bf_lo(gg.y)); v0[3] += a0[3] * sigmoidf_(bf_hi(gg.y));
                    v1[0] += a1[0] * sigmoidf_(bf_lo(gg.z)); v1[1] += a1[1] * sigmoidf_(bf_hi(gg.z)); v1[2] += a1[2] * sigmoidf_(bf_lo(gg.w)); v1[3] += a1[3] * sigmoidf_(bf_hi(gg.w));
                    u32x2 w; w.x = pk4_fp8(v0[0], v0[1], v0[2], v0[3]); w.y = pk4_fp8(v1[0], v1[1], v1[2], v1[3]);
                    *(u32x2*)(MIX + (size_t)row * D + col0 + bj * 128) = w;
                }
            asm volatile("" ::: "memory");
        }
    }
};
struct EpiX {
    static constexpr bool PERM = true;
    const bf16_t* X; bf16_t* V; const float* modl;
    __device__ __forceinline__ void operator()(const Acc& acc, const Unit& u, int wr, int wc, int fr, int fq) const {
        const int row0 = u.pm * 256 + wr * 64 + fr, col0 = u.pn * 256 + wc * 32 + 8 * fq;
        const bool uni = u.pm < 128;
        f32x4 g[2][2];
        if (uni) { const float* gp = modl + (size_t)(u.pm >> 4) * 6144 + 2048 + col0;
#pragma unroll
            for (int bj = 0; bj < 2; ++bj)
#pragma unroll
                for (int n = 0; n < 2; ++n) g[bj][n] = *(const f32x4*)(gp + bj * 128 + 4 * n) + 1.0f; }
#pragma unroll
        for (int ai = 0; ai < 2; ++ai)
#pragma unroll
        for (int mh = 0; mh < 2; ++mh) {
            u32x4 x[4][2];
#pragma unroll
            for (int m = 2 * mh; m < 2 * mh + 2; ++m)
#pragma unroll
                for (int bj = 0; bj < 2; ++bj) x[m][bj] = *(const u32x4*)(X + (size_t)(row0 + ai * 128 + m * 16) * D + col0 + bj * 128);
            asm volatile("" ::: "memory");
#pragma unroll
            for (int m = 2 * mh; m < 2 * mh + 2; ++m) {
                const int row = row0 + ai * 128 + m * 16;
                if (!uni) { const float* gp = modl + (size_t)batch_of(row) * 6144 + 2048 + col0;
#pragma unroll
                    for (int bj = 0; bj < 2; ++bj)
#pragma unroll
                        for (int n = 0; n < 2; ++n) g[bj][n] = *(const f32x4*)(gp + bj * 128 + 4 * n) + 1.0f; }
#pragma unroll
                for (int bj = 0; bj < 2; ++bj) {
                    const u32x4 xx = x[m][bj];
                    const f32x4 x0 = (f32x4){bf_lo(xx.x), bf_hi(xx.x), bf_lo(xx.y), bf_hi(xx.y)}, x1 = (f32x4){bf_lo(xx.z), bf_hi(xx.z), bf_lo(xx.w), bf_hi(xx.w)};
                    const f32x4 v0 = x0 * ALPHA + g[bj][0] * acc[ai][bj][m][0], v1 = x1 * ALPHA + g[bj][1] * acc[ai][bj][m][1];
                    u32x4 w; w.x = cvt_pk_bf16(v0[0], v0[1]); w.y = cvt_pk_bf16(v0[2], v0[3]); w.z = cvt_pk_bf16(v1[0], v1[1]); w.w = cvt_pk_bf16(v1[2], v1[3]);
                    *(u32x4*)(V + (size_t)row * D + col0 + bj * 128) = w;
                }
            }
            asm volatile("" ::: "memory");
        }
    }
};
struct EpiAct {
    static constexpr bool PERM = true;
    unsigned char* ACT; const float* bgu;
    __device__ __forceinline__ void operator()(const Acc& acc, const Unit& u, int wr, int wc, int fr, int fq) const {
        const int row0 = u.pm * 256 + wr * 64 + fr, c0 = u.pn * 128 + wc * 32 + 8 * fq;
        const float* bp = bgu + (size_t)u.e * 2048 + c0;
        f32x4 bg[2], bl[2];
#pragma unroll
        for (int n = 0; n < 2; ++n) { bg[n] = *(const f32x4*)(bp + 4 * n); bl[n] = *(const f32x4*)(bp + 1024 + 4 * n); }
#pragma unroll
        for (int ai = 0; ai < 2; ++ai)
#pragma unroll
            for (int m = 0; m < 4; ++m) {
                const int row = row0 + ai * 128 + m * 16;
                float a[8];
#pragma unroll
                for (int n = 0; n < 2; ++n)
#pragma unroll
                    for (int jp = 0; jp < 2; ++jp) {
                        f32x2 g = (f32x2){acc[ai][0][m][n][2 * jp], acc[ai][0][m][n][2 * jp + 1]} + (f32x2){bg[n][2 * jp], bg[n][2 * jp + 1]};
                        f32x2 li = (f32x2){acc[ai][1][m][n][2 * jp], acc[ai][1][m][n][2 * jp + 1]} + (f32x2){bl[n][2 * jp], bl[n][2 * jp + 1]};
                        g = __builtin_elementwise_min(g, (f32x2){7.0f, 7.0f});
                        li = __builtin_elementwise_min(__builtin_elementwise_max(li, (f32x2){-7.0f, -7.0f}), (f32x2){7.0f, 7.0f});
                        const f32x2 t = g * (-1.702f * 1.44269504089f);
                        f32x2 e; e.x = __builtin_amdgcn_exp2f(t.x); e.y = __builtin_amdgcn_exp2f(t.y);
                        const f32x2 dd = e + 1.0f;
                        f32x2 r; r.x = __builtin_amdgcn_rcpf(dd.x); r.y = __builtin_amdgcn_rcpf(dd.y);
                        const f32x2 av = (g * r) * (li + 1.0f);
                        a[n * 4 + 2 * jp] = av.x; a[n * 4 + 2 * jp + 1] = av.y;
                    }
                u32x2 w; w.x = pk4_fp8(a[0], a[1], a[2], a[3]); w.y = pk4_fp8(a[4], a[5], a[6], a[7]);
                *(u32x2*)(ACT + (size_t)row * D + c0) = w;
                asm volatile("" ::: "memory");
            }
    }
};
struct EpiYs {
    static constexpr bool PERM = true;
    unsigned char* YS; const float* bdn; const float* gate; const unsigned* cnt; const LAS int* blk;
    __device__ __forceinline__ void operator()(const Acc& acc, const Unit& u, int wr, int wc, int fr, int fq) const {
        const int r0 = wr * 64 + fr, col0 = u.pn * 256 + wc * 32 + 8 * fq;
        const int rank0 = (u.pm - blk[u.e]) * 256; const int ce = (int)cnt[u.e * 64];
        f32x4 bv[2][2];
#pragma unroll
        for (int bj = 0; bj < 2; ++bj)
#pragma unroll
            for (int n = 0; n < 2; ++n) bv[bj][n] = *(const f32x4*)(bdn + (size_t)u.e * D + col0 + bj * 128 + 4 * n);
        float gts[2][4];
#pragma unroll
        for (int ai = 0; ai < 2; ++ai)
#pragma unroll
            for (int m = 0; m < 4; ++m) { const int rank = rank0 + r0 + ai * 128 + m * 16; gts[ai][m] = rank < ce ? 16.0f * gate[(size_t)u.e * NT + rank] : 0.0f; }
        asm volatile("" ::: "memory");
#pragma unroll
        for (int ai = 0; ai < 2; ++ai)
#pragma unroll
            for (int m = 0; m < 4; ++m) {
                const int r = r0 + ai * 128 + m * 16;
                const float gt = gts[ai][m];
                unsigned char* rowp = YS + (size_t)(u.pm * 256 + r) * D + col0;
#pragma unroll
                for (int bj = 0; bj < 2; ++bj) {
                    const f32x4 v0 = (acc[ai][bj][m][0] + bv[bj][0]) * gt, v1 = (acc[ai][bj][m][1] + bv[bj][1]) * gt;
                    u32x2 w; w.x = pk4_fp8(v0[0], v0[1], v0[2], v0[3]); w.y = pk4_fp8(v1[0], v1[1], v1[2], v1[3]);
                    *(u32x2*)(rowp + bj * 128) = w;
                }
                asm volatile("" ::: "memory");
            }
    }
};
}


#define XB_TMO      128
#define XB_XCNT(j)  (256  + 64 * (j))
#define XB_XSUB(j)  (1280 + 64 * (j))
#define XB_XGEN(j)  (2304 + 64 * (j))
#define XB_TOP      3328
#define XB_TOPGEN   3392
#define XCD_BAR_WORDS 3456
#define XB_SPIN_CAP (1u << 21)
__device__ __forceinline__ unsigned xb_ld(unsigned* p)              { return __hip_atomic_load(p, __ATOMIC_RELAXED, __HIP_MEMORY_SCOPE_AGENT); }
__device__ __forceinline__ unsigned xb_add(unsigned* p, unsigned v) { return __hip_atomic_fetch_add(p, v, __ATOMIC_RELAXED, __HIP_MEMORY_SCOPE_AGENT); }
__device__ __forceinline__ unsigned xb_xcc_id() { return (unsigned)__builtin_amdgcn_s_getreg((3 << 11) | 20) & 0xFu; }
#define XB_SPIN(cond, bar) do { unsigned _sp = 0; while (cond) { __builtin_amdgcn_s_sleep(1); \
    if ((++_sp & 255u) == 0u) { if (xb_ld(&(bar)[XB_TMO])) break; if (_sp > XB_SPIN_CAP) { atomicAdd(&(bar)[XB_TMO], 1u); break; } } } } while (0)
struct XcdBarrier { unsigned* bar; unsigned x; volatile LAS unsigned* st; };
__device__ __forceinline__ XcdBarrier xcd_barrier_post(unsigned* bar, volatile LAS unsigned* st) {
    XcdBarrier b; b.bar = bar; b.x = xb_xcc_id(); b.st = st;
    if (threadIdx.x == 0) (void)xb_add(&bar[XB_XCNT(b.x)], 1u);
    return b;
}
__device__ __forceinline__ void xcd_barrier_complete(unsigned* bar, unsigned x, unsigned& nloc, unsigned& nx) {
    const unsigned G = gridDim.x * gridDim.y * gridDim.z;
    unsigned sum, cnt, mine, sp = 0u;
    for (;;) {
        sum = 0u; cnt = 0u; mine = 0u;
#pragma unroll
        for (unsigned j = 0; j < 16; ++j) { const unsigned c = xb_ld(&bar[XB_XCNT(j)]); sum += c; cnt += (c > 0u) ? 1u : 0u; mine = (j == x) ? c : mine; }
        if (sum == G) break;
        __builtin_amdgcn_s_sleep(1);
        if ((++sp & 255u) == 0u) { if (xb_ld(&bar[XB_TMO])) break; if (sp > XB_SPIN_CAP) { atomicAdd(&bar[XB_TMO], 1u); break; } }
    }
    nloc = mine > 0u ? mine : 1u; nx = cnt > 0u ? cnt : 1u;
}
__device__ __forceinline__ void xcd_barrier(const XcdBarrier& b) {
    asm volatile("s_waitcnt vmcnt(0)" ::: "memory");
    __syncthreads();
    if (threadIdx.x == 0) {
        unsigned* bar = b.bar;
        __builtin_amdgcn_s_waitcnt(0);
        unsigned nloc = b.st[0], nx = b.st[1];
        if (nloc == 0u) { xcd_barrier_complete(bar, b.x, nloc, nx); b.st[0] = nloc; b.st[1] = nx; }
        const unsigned old = xb_add(&bar[XB_XSUB(b.x)], 1u);
        const unsigned gen = old / nloc;
        if (old + 1u == (gen + 1u) * nloc) {
            __builtin_amdgcn_fence(__ATOMIC_RELEASE, "agent");
            asm volatile("s_waitcnt vmcnt(0)" ::: "memory");
            const unsigned og = xb_add(&bar[XB_TOP], 1u);
            const unsigned tg = og / nx;
            if (og + 1u == (tg + 1u) * nx) xb_add(&bar[XB_TOPGEN], 1u);
            else XB_SPIN(xb_ld(&bar[XB_TOPGEN]) == tg, bar);
            __builtin_amdgcn_fence(__ATOMIC_ACQUIRE, "agent");
            xb_add(&bar[XB_XGEN(b.x)], 1u);
            asm volatile("s_waitcnt vmcnt(0)" ::: "memory");
        } else {
            XB_SPIN(xb_ld(&bar[XB_XGEN(b.x)]) == gen, bar);
            __builtin_amdgcn_fence(__ATOMIC_ACQUIRE, "agent");
            asm volatile("s_waitcnt vmcnt(0)" ::: "memory");
        }
    }
    __syncthreads();
}

struct Ctx {
    LAS unsigned char* lds; int tid, lane, wave, G, bx;
    const float* const* in; float* out; unsigned char* ws;
};
#define LDS_WAIT() asm volatile("s_waitcnt lgkmcnt(0)" ::: "memory")

struct TDesc { const float* src; unsigned char* dst; int N, K, k0, n0, kind, f8; };
__device__ __forceinline__ void t64_load(const TDesc& d, float (&v)[64], int lane) {
    const float* src = d.src + (size_t)d.k0 * d.N + d.n0 + lane;
#pragma unroll
    for (int kk = 0; kk < 64; ++kk) v[kk] = src[(size_t)kk * d.N];
}
__device__ __forceinline__ void t64_finish(const TDesc& d, const float (&v)[64], LAS unsigned char* scr, int lane) {
    if (d.f8) {
        LAS unsigned char* wp = scr + lane * 80;
#pragma unroll
        for (int q = 0; q < 4; ++q) { u32x4 o;
            o.x = pk4_fp8(64.f * v[16 * q + 0], 64.f * v[16 * q + 1], 64.f * v[16 * q + 2], 64.f * v[16 * q + 3]);
            o.y = pk4_fp8(64.f * v[16 * q + 4], 64.f * v[16 * q + 5], 64.f * v[16 * q + 6], 64.f * v[16 * q + 7]);
            o.z = pk4_fp8(64.f * v[16 * q + 8], 64.f * v[16 * q + 9], 64.f * v[16 * q + 10], 64.f * v[16 * q + 11]);
            o.w = pk4_fp8(64.f * v[16 * q + 12], 64.f * v[16 * q + 13], 64.f * v[16 * q + 14], 64.f * v[16 * q + 15]);
            *(LAS u32x4*)(wp + q * 16) = o; }
        LDS_WAIT(); asm volatile("" ::: "memory");
        const int c = lane & 3;
#pragma unroll
        for (int j = 0; j < 4; ++j) { const int nl = (lane >> 2) + 16 * j; const u32x4 o = *(const LAS u32x4*)(scr + nl * 80 + c * 16);
            const int n = d.n0 + nl; int dr = n;
            if (d.kind == 1) { dr = (n < 1024) ? ((n >> 7) * 256 + (n & 127)) : (((n - 1024) >> 7) * 256 + 128 + (n & 127)); }
            *(u32x4*)(d.dst + (size_t)dr * d.K + d.k0 + c * 16) = o; }
    } else {
        LAS unsigned char* wp = scr + lane * 144;
#pragma unroll
        for (int q = 0; q < 8; ++q) { u32x4 o;
            o.x = cvt_pk_bf16(v[8 * q + 0], v[8 * q + 1]); o.y = cvt_pk_bf16(v[8 * q + 2], v[8 * q + 3]); o.z = cvt_pk_bf16(v[8 * q + 4], v[8 * q + 5]); o.w = cvt_pk_bf16(v[8 * q + 6], v[8 * q + 7]);
            *(LAS u32x4*)(wp + q * 16) = o; }
        LDS_WAIT(); asm volatile("" ::: "memory");
        const int c = lane & 7;
#pragma unroll
        for (int j = 0; j < 8; ++j) { const int nl = (lane >> 3) + 8 * j; const u32x4 o = *(const LAS u32x4*)(scr + nl * 144 + c * 16);
            *(u32x4*)(d.dst + ((size_t)(d.n0 + nl) * d.K + d.k0) * 2 + c * 16) = o; }
    }
    LDS_WAIT(); asm volatile("" ::: "memory");
}
__device__ __forceinline__ TDesc t64_decode(const float* const* in, unsigned char* ws, int it) {
    TDesc d; int r = it, item, nblk;
    if (r < 32768) { const int m = r >> 9; item = r & 511; d.src = in[23] + (size_t)m * 1024 * 2048; d.dst = ws + WS_WGU + (size_t)m * 2048 * 1024; d.N = 2048; d.K = 1024; d.kind = 1; d.f8 = 1; }
    else if ((r -= 32768) < 16384) { const int m = r >> 8; item = r & 255; d.src = in[25] + (size_t)m * 1024 * 1024; d.dst = ws + WS_WDN + (size_t)m * 1024 * 1024; d.N = 1024; d.K = 1024; d.kind = 0; d.f8 = 1; }
    else if ((r -= 16384) < 2176) { const int m = r / 1088; item = r % 1088; d.src = in[12] + (size_t)m * 1024 * INW; d.dst = ws + WS_WIN + (size_t)m * INW * 1024 * 2; d.N = INW; d.K = 1024; d.kind = 0; d.f8 = 0; }
    else if ((r -= 2176) < 2176) { const int m = r / 1088; item = r % 1088; d.src = in[12] + (size_t)m * 1024 * INW; d.dst = ws + WS_WIN8 + (size_t)m * INW * 1024; d.N = INW; d.K = 1024; d.kind = 0; d.f8 = 1; }
    else if ((r -= 2176) < 512) { const int m = r >> 8; item = r & 255; d.src = in[18] + (size_t)m * 1024 * 1024; d.dst = ws + WS_WO + (size_t)m * 1024 * 1024; d.N = 1024; d.K = 1024; d.kind = 0; d.f8 = 1; }
    else if ((r -= 512) < 256) { const int m = r >> 7; item = r & 127; d.src = in[16] + (size_t)m * 512 * 1024; d.dst = ws + WS_WOA + (size_t)m * 1024 * 512; d.N = 1024; d.K = 512; d.kind = 0; d.f8 = 1; }
    else { r -= 256; const int m = r >> 7; item = r & 127; d.src = in[17] + (size_t)m * 512 * 1024; d.dst = ws + WS_WOB + (size_t)m * 1024 * 512; d.N = 1024; d.K = 512; d.kind = 0; d.f8 = 1; }
    nblk = d.N >> 6; const int kb = item / nblk; d.k0 = kb * 64; d.n0 = (item - kb * nblk) * 64;
    return d;
}

__device__ __forceinline__ int rel_bucket(int rel) {
    const int n = rel < 0 ? -rel : rel;
    int v;
    if (n < 8) v = n;
    else { const float nf = (float)n; int large = 8 + (int)(logf(nf / 8.0f) / 2.7725887298583984f * 8.0f); v = large < 15 ? large : 15; }
    return (rel > 0 ? 16 : 0) + v;
}

__device__ __forceinline__ void phase0a(Ctx& F) {
    LAS float* scr = (LAS float*)(F.lds + F.wave * 16384);
    const int gw = F.bx * NWAVES + F.wave, NGW = F.G * NWAVES;
    unsigned char* ws = F.ws;
    {
        float* modp = (float*)(ws + WS_MODP);
        for (int it = gw; it < 2 * 96 * 8; it += NGW) {
            const int kc = it & 7, cgp = (it >> 3) % 96, l = it / (8 * 96), k0 = kc * 128, n0 = cgp * 64;
#pragma unroll 4
            for (int j = 0; j < 32; ++j) { const int idx = F.lane + 64 * j, r = idx >> 7, kk = idx & 127;
                const float c = r < 8 ? F.in[2][r * 1024 + k0 + kk] : F.in[3][(r - 8) * 1024 + k0 + kk];
                scr[kk * 16 + r] = c * sigmoidf_(c); }
            LDS_WAIT(); asm volatile("" ::: "memory");
            float a[16];
#pragma unroll
            for (int r = 0; r < 16; ++r) a[r] = 0.f;
            const float* wp = F.in[10] + ((size_t)l * 1024 + k0) * 6144 + n0 + F.lane;
#pragma unroll 16
            for (int kk = 0; kk < 128; ++kk) {
                const float w = wp[(size_t)kk * 6144];
                const LAS f32x4* sp = (const LAS f32x4*)(scr + kk * 16);
                const f32x4 s0 = sp[0], s1 = sp[1], s2 = sp[2], s3 = sp[3];
                a[0] += s0[0] * w; a[1] += s0[1] * w; a[2] += s0[2] * w; a[3] += s0[3] * w;
                a[4] += s1[0] * w; a[5] += s1[1] * w; a[6] += s1[2] * w; a[7] += s1[3] * w;
                a[8] += s2[0] * w; a[9] += s2[1] * w; a[10] += s2[2] * w; a[11] += s2[3] * w;
                a[12] += s3[0] * w; a[13] += s3[1] * w; a[14] += s3[2] * w; a[15] += s3[3] * w;
            }
            const float bb = (kc == 0) ? F.in[11][l * 6144 + n0 + F.lane] : 0.f;
#pragma unroll
            for (int r = 0; r < 16; ++r) modp[(size_t)kc * (2 * 16 * 6144) + ((size_t)(l * 16 + r)) * 6144 + n0 + F.lane] = a[r] + bb;
            LDS_WAIT(); asm volatile("" ::: "memory");
        }
    }
    if (F.bx == 0) {
        float* bt = (float*)(ws + WS_BIAS);
        for (int i = F.tid; i < 8 * 256; i += NTHREADS) { const int h = i >> 8, ri = i & 255; const int rel = ri - 191;
            bt[i] = (ri < 255) ? F.in[7][rel_bucket(rel) * 8 + h] : 0.f; }
    }
    for (int i = F.bx * NTHREADS + F.tid; i < 2 * 8 * 64 * 128; i += F.G * NTHREADS) {
        const int lb = i >> 13, rem = i & 8191;
        F.out[OKS + (size_t)lb * 16384 + rem] = F.in[4][(size_t)lb * 16384 + 8192 + rem];
        F.out[OVS + (size_t)lb * 16384 + rem] = F.in[5][(size_t)lb * 16384 + 8192 + rem];
    }
    LAS unsigned char* scrb = F.lds + F.wave * 16384;
    constexpr int NITEMS = 32768 + 16384 + 2176 + 2176 + 512 + 256 + 256;
    {
        float va[64], vb[64]; TDesc da, db;
        int it = gw;
        if (it < NITEMS) { da = t64_decode(F.in, ws, it); t64_load(da, va, F.lane); }
        while (it < NITEMS) {
            int itn = it + NGW;
            if (itn < NITEMS) { db = t64_decode(F.in, ws, itn); t64_load(db, vb, F.lane); }
            t64_finish(da, va, scrb, F.lane);
            it = itn; if (it >= NITEMS) break;
            itn = it + NGW;
            if (itn < NITEMS) { da = t64_decode(F.in, ws, itn); t64_load(da, va, F.lane); }
            t64_finish(db, vb, scrb, F.lane);
            it = itn;
        }
    }
}

__device__ __forceinline__ void ln_row(f32x4 (&v)[4], const float* g, const float* b, int lane) {
    float s = 0.f;
#pragma unroll
    for (int j = 0; j < 4; ++j) s += (v[j][0] + v[j][1]) + (v[j][2] + v[j][3]);
    const float mean = wave_sum(s) * (1.0f / D); float s2 = 0.f;
#pragma unroll
    for (int j = 0; j < 4; ++j) { v[j] = v[j] - mean; s2 += (v[j][0] * v[j][0] + v[j][1] * v[j][1]) + (v[j][2] * v[j][2] + v[j][3] * v[j][3]); }
    const float rstd = 1.0f / sqrtf(wave_sum(s2) * (1.0f / D) + LN_EPS);
#pragma unroll
    for (int j = 0; j < 4; ++j) { const f32x4 gg = *(const f32x4*)(g + 4 * lane + 256 * j), bb = *(const f32x4*)(b + 4 * lane + 256 * j); v[j] = v[j] * rstd * gg + bb; }
}
__device__ __forceinline__ void store_mod_row(const f32x4 (&v)[4], const float* sh, const float* sc, bf16_t* hrow, unsigned char* h8row, int lane) {
#pragma unroll
    for (int j = 0; j < 4; ++j) { const f32x4 a = *(const f32x4*)(sc + 4 * lane + 256 * j), b = *(const f32x4*)(sh + 4 * lane + 256 * j);
        const f32x4 h = v[j] * (a + 1.0f) + b; u32x2 w; w.x = cvt_pk_bf16(h[0], h[1]); w.y = cvt_pk_bf16(h[2], h[3]);
        *(u32x2*)(hrow + 4 * lane + 256 * j) = w;
        *(unsigned*)(h8row + 4 * lane + 256 * j) = pk4_fp8(h[0], h[1], h[2], h[3]); }
}

__device__ __forceinline__ void phase0b(Ctx& F) {
    const int gw = F.bx * NWAVES + F.wave, NGW = F.G * NWAVES;
    const float* mod = (const float*)(F.ws + WS_MOD);
    bf16_t* H = (bf16_t*)(F.ws + WS_H);
    for (int row = gw; row < NT; row += NGW) {
        const float* xr = row < NPROMPT ? F.in[0] + (size_t)row * D : F.in[1] + (size_t)(row - NPROMPT) * D;
        f32x4 v[4];
#pragma unroll
        for (int j = 0; j < 4; ++j) v[j] = *(const f32x4*)(xr + 4 * F.lane + 256 * j);
        ln_row(v, F.in[8], F.in[9], F.lane);
#pragma unroll
        for (int j = 0; j < 4; ++j) { u32x2 w; w.x = cvt_pk_bf16(v[j][0], v[j][1]); w.y = cvt_pk_bf16(v[j][2], v[j][3]); *(u32x2*)((bf16_t*)(F.ws + WS_XB) + (size_t)row * D + 4 * F.lane + 256 * j) = w; }
        const float* mb = mod + (size_t)batch_of(row) * 6144;
        store_mod_row(v, mb, mb + 1024, H + (size_t)row * D, F.ws + WS_H8 + (size_t)row * D, F.lane);
    }
}

__device__ __forceinline__ void phase_attn(Ctx& F, int l) {
    const bf16_t* Z = (const bf16_t*)(F.ws + WS_Z);
    unsigned char* YA = F.ws + WS_YA;
    unsigned char* YB = F.ws + WS_YB;
    const float* biasr = (const float*)(F.ws + WS_BIAS);
    LAS unsigned char* Ks = F.lds;
    LAS unsigned char* Vt = F.lds + 27648;
    LAS float* bt = (LAS float*)(F.lds + 53248);
    const int lane = F.lane, tid = F.tid;
    for (int au = F.bx; au < 1040; au += F.G) {
        const bool isS = au >= 1024;
        const int kv = au & 1;
        const int b = isS ? ((au - 1024) >> 1) : (au >> 7);
        const int n = isS ? 0 : ((au & 127) >> 1);
        __syncthreads();
        for (int i = tid; i < 1024; i += NTHREADS) bt[i] = biasr[(kv * 4 + (i >> 8)) * 256 + (i & 255)];
#pragma unroll
        for (int jj = 0; jj < 3; ++jj) {
            const int p = tid + NTHREADS * jj, key = p >> 3, ds = p & 7;
            u32x4 kq = (u32x4){0u, 0u, 0u, 0u}, vq = (u32x4){0u, 0u, 0u, 0u};
            if (!isS) {
                const int t = n * 64 + key - 128;
                if (t >= 0) { const bf16_t* zr = Z + (size_t)(b * 4096 + t) * INW + kv * 64 + ds * 8; kq = *(const u32x4*)(zr + 512); vq = *(const u32x4*)(zr + 640); }
            } else if (key < 128) {
                const size_t o = ((size_t)((l * 8 + b) * 128 + key) * 2 + kv) * 64 + ds * 8;
                const f32x4 k0 = *(const f32x4*)(F.in[4] + o), k1 = *(const f32x4*)(F.in[4] + o + 4), v0 = *(const f32x4*)(F.in[5] + o), v1 = *(const f32x4*)(F.in[5] + o + 4);
                kq.x = cvt_pk_bf16(k0[0], k0[1]); kq.y = cvt_pk_bf16(k0[2], k0[3]); kq.z = cvt_pk_bf16(k1[0], k1[1]); kq.w = cvt_pk_bf16(k1[2], k1[3]);
                vq.x = cvt_pk_bf16(v0[0], v0[1]); vq.y = cvt_pk_bf16(v0[2], v0[3]); vq.z = cvt_pk_bf16(v1[0], v1[1]); vq.w = cvt_pk_bf16(v1[2], v1[3]);
            } else {
                const bf16_t* zr = Z + (size_t)(NPROMPT + b * 64 + key - 128) * INW + kv * 64 + ds * 8; kq = *(const u32x4*)(zr + 512); vq = *(const u32x4*)(zr + 640);
            }
            *(LAS u32x4*)(Ks + key * 144 + ds * 16) = kq;
            LAS unsigned short* vp = (LAS unsigned short*)Vt + (ds * 8) * 200 + key;
            vp[0 * 200] = (unsigned short)(vq.x & 0xffffu); vp[1 * 200] = (unsigned short)(vq.x >> 16);
            vp[2 * 200] = (unsigned short)(vq.y & 0xffffu); vp[3 * 200] = (unsigned short)(vq.y >> 16);
            vp[4 * 200] = (unsigned short)(vq.z & 0xffffu); vp[5 * 200] = (unsigned short)(vq.z >> 16);
            vp[6 * 200] = (unsigned short)(vq.w & 0xffffu); vp[7 * 200] = (unsigned short)(vq.w >> 16);
        }
        __syncthreads();
        const int g = F.wave >> 1, qi = (F.wave & 1) * 32 + (lane & 31), hh = lane >> 5, head = kv * 4 + g;
        const int qrow = isS ? NPROMPT + b * 64 + qi : b * 4096 + n * 64 + qi;
        bf16x8 Qf[4];
#pragma unroll
        for (int ks = 0; ks < 4; ++ks) Qf[ks] = *(const bf16x8*)(Z + (size_t)qrow * INW + head * 64 + ks * 16 + hh * 8);
        f32x16 S[6];
#pragma unroll
        for (int kb = 0; kb < 6; ++kb) {
#pragma unroll
            for (int j = 0; j < 16; ++j) S[kb][j] = 0.f;
#pragma unroll
            for (int ks = 0; ks < 4; ++ks) {
                const bf16x8 A = *(const LAS bf16x8*)(Ks + (kb * 32 + (lane & 31)) * 144 + (ks * 16 + hh * 8) * 2);
                S[kb] = __builtin_amdgcn_mfma_f32_32x32x16_bf16(A, Qf[ks], S[kb], 0, 0, 0);
            }
        }
        const float sinkv = F.in[14][l * 8 + head];
        float mx = sinkv;
        const int kmin = isS ? 0 : (128 - n * 64);
#pragma unroll
        for (int kb = 0; kb < 6; ++kb)
#pragma unroll
            for (int j = 0; j < 16; ++j) {
                const int key = kb * 32 + 8 * (j >> 2) + 4 * hh + (j & 3);
                float sv = S[kb][j] * 0.125f + bt[g * 256 + key - qi + 63];
                sv = key >= kmin ? sv : -1e30f;
                S[kb][j] = sv; mx = fmaxf(mx, sv);
            }
        mx = fmaxf(mx, __shfl_xor(mx, 32));
        float sum = 0.f;
#pragma unroll
        for (int kb = 0; kb < 6; ++kb)
#pragma unroll
            for (int j = 0; j < 16; ++j) { const float p = __expf(S[kb][j] - mx); S[kb][j] = p; sum += p; }
        sum += __shfl_xor(sum, 32);
        sum += __expf(sinkv - mx);
        const float inv = 1.0f / sum;
        f32x16 O[2];
#pragma unroll
        for (int db = 0; db < 2; ++db)
#pragma unroll
            for (int j = 0; j < 16; ++j) O[db][j] = 0.f;
#pragma unroll
        for (int kb = 0; kb < 6; ++kb)
#pragma unroll
            for (int s2 = 0; s2 < 2; ++s2) {
                union { bf16x8 v; unsigned u[4]; } P;
#pragma unroll
                for (int q = 0; q < 4; ++q) P.u[q] = cvt_pk_bf16(S[kb][8 * s2 + 2 * q], S[kb][8 * s2 + 2 * q + 1]);
#pragma unroll
                for (int db = 0; db < 2; ++db) {
                    const LAS unsigned char* vb = Vt + (db * 32 + (lane & 31)) * 400 + (kb * 32 + 16 * s2 + 4 * hh) * 2;
                    union { bf16x8 v; u32x2 h[2]; } Vf;
                    Vf.h[0] = *(const LAS u32x2*)vb; Vf.h[1] = *(const LAS u32x2*)(vb + 16);
                    O[db] = __builtin_amdgcn_mfma_f32_32x32x16_bf16(Vf.v, P.v, O[db], 0, 0, 0);
                }
            }
        unsigned char* orow = YA + (size_t)qrow * 512 + head * 64 + 4 * hh; const float inv8 = inv * 8.0f;
#pragma unroll
        for (int db = 0; db < 2; ++db)
#pragma unroll
            for (int jq = 0; jq < 4; ++jq) {
                *(unsigned*)(orow + db * 32 + 8 * jq) = pk4_fp8(O[db][4 * jq] * inv8, O[db][4 * jq + 1] * inv8, O[db][4 * jq + 2] * inv8, O[db][4 * jq + 3] * inv8);
            }
    }
    int nxtra = 1040 % F.G; if (1040 < F.G || 2 * nxtra > F.G) nxtra = 0;
    if (F.bx < nxtra) return;
    const int gw = (F.bx - nxtra) * NWAVES + F.wave, NGW = (F.G - nxtra) * NWAVES;
    const float* cw = F.in[15] + (size_t)l * 3 * 512 + 8 * lane;
    float w0[8], w1[8], w2[8];
#pragma unroll
    for (int e = 0; e < 8; ++e) { w0[e] = cw[e]; w1[e] = cw[512 + e]; w2[e] = cw[1024 + e]; }
    for (int row = gw; row < NT; row += NGW) {
        const bool isS = row >= NPROMPT; const int b = isS ? ((row - NPROMPT) >> 6) : (row >> 12), t = isS ? ((row - NPROMPT) & 63) : (row & 4095);
        const bf16_t* zr = Z + (size_t)row * INW + 8 * lane;
        const u32x4 cb = *(const u32x4*)(zr + 768);
        float u[3][8];
#pragma unroll
        for (int d = 0; d < 3; ++d) {
            if (t - d >= 0) {
                const bf16_t* zz = zr - (size_t)d * INW; const u32x4 cc = *(const u32x4*)(zz + 1280), cx = *(const u32x4*)(zz + 1792);
                u[d][0] = bf_lo(cc.x) * bf_lo(cx.x); u[d][1] = bf_hi(cc.x) * bf_hi(cx.x); u[d][2] = bf_lo(cc.y) * bf_lo(cx.y); u[d][3] = bf_hi(cc.y) * bf_hi(cx.y);
                u[d][4] = bf_lo(cc.z) * bf_lo(cx.z); u[d][5] = bf_hi(cc.z) * bf_hi(cx.z); u[d][6] = bf_lo(cc.w) * bf_lo(cx.w); u[d][7] = bf_hi(cc.w) * bf_hi(cx.w);
            } else if (isS) {
                const float* hp = F.in[6] + ((size_t)(l * 8 + b) * 2 + (2 + t - d)) * 512 + 8 * lane;
                const f32x4 h0 = *(const f32x4*)hp, h1 = *(const f32x4*)(hp + 4);
#pragma unroll
                for (int e = 0; e < 4; ++e) { u[d][e] = h0[e]; u[d][4 + e] = h1[e]; }
            } else {
#pragma unroll
                for (int e = 0; e < 8; ++e) u[d][e] = 0.f;
            }
        }
        const float cbf[8] = {bf_lo(cb.x), bf_hi(cb.x), bf_lo(cb.y), bf_hi(cb.y), bf_lo(cb.z), bf_hi(cb.z), bf_lo(cb.w), bf_hi(cb.w)};
        float y[8];
#pragma unroll
        for (int e = 0; e < 8; ++e) y[e] = cbf[e] * (w0[e] * u[2][e] + w1[e] * u[1][e] + w2[e] * u[0][e]);
        u32x2 w; w.x = pk4_fp8(y[0], y[1], y[2], y[3]); w.y = pk4_fp8(y[4], y[5], y[6], y[7]);
        *(u32x2*)(YB + (size_t)row * 512 + 8 * lane) = w;
        const int tl = isS ? 62 : 4094;
        if (t >= tl) {
            float* o = F.out + (isS ? OCS : OCP) + ((size_t)(l * 8 + b) * 2 + (t - tl)) * 512 + 8 * lane;
            *(f32x4*)o = (f32x4){u[0][0], u[0][1], u[0][2], u[0][3]}; *(f32x4*)(o + 4) = (f32x4){u[0][4], u[0][5], u[0][6], u[0][7]};
        }
    }
}

__device__ __forceinline__ void phase_ln_router(Ctx& F, int l) {
    bf16_t* XB = (bf16_t*)(F.ws + WS_XB); unsigned char* H8 = (unsigned char*)(F.ws + WS_H8); const bf16_t* V16 = (const bf16_t*)(F.ws + WS_V16);
    const float* mod = (const float*)(F.ws + WS_MOD) + (size_t)l * 16 * 6144;
    unsigned* cnt = (unsigned*)(F.ws + WS_CNT) + l * 2048;
    unsigned* tok = (unsigned*)(F.ws + WS_TOK); float* gate = (float*)(F.ws + WS_GATE); unsigned* slot = (unsigned*)(F.ws + WS_SLOT);
    const float* Wr = F.in[21] + (size_t)l * 1024 * 32;
    LAS float* hf = (LAS float*)F.lds;
    LAS unsigned* hist = (LAS unsigned*)(F.lds + 139264); LAS unsigned* hbase = hist + 32;
    const int lane = F.lane, w = F.wave;
    for (int tile = F.bx; tile < NT / 32; tile += F.G) {
        __syncthreads();
        if (F.tid < 32) hist[F.tid] = 0u;
        {
            u32x2 pv[4][4];
#pragma unroll
            for (int rr = 0; rr < 4; ++rr)
#pragma unroll
                for (int j = 0; j < 4; ++j) pv[rr][j] = *(const u32x2*)(V16 + (size_t)(tile * 32 + w * 4 + rr) * D + 4 * lane + 256 * j);
#pragma unroll
            for (int rr = 0; rr < 4; ++rr) {
                const int rl = w * 4 + rr, row = tile * 32 + rl;
                f32x4 v[4];
#pragma unroll
                for (int j = 0; j < 4; ++j) v[j] = (f32x4){bf_lo(pv[rr][j].x), bf_hi(pv[rr][j].x), bf_lo(pv[rr][j].y), bf_hi(pv[rr][j].y)};
                ln_row(v, F.in[19] + l * D, F.in[20] + l * D, lane);
#pragma unroll
                for (int j = 0; j < 4; ++j) { u32x2 wq; wq.x = cvt_pk_bf16(v[j][0], v[j][1]); wq.y = cvt_pk_bf16(v[j][2], v[j][3]); *(u32x2*)(XB + (size_t)row * D + 4 * lane + 256 * j) = wq; }
                const float* mb = mod + (size_t)batch_of(row) * 6144;
#pragma unroll
                for (int j = 0; j < 4; ++j) { const f32x4 a = *(const f32x4*)(mb + 4096 + 4 * lane + 256 * j), b = *(const f32x4*)(mb + 3072 + 4 * lane + 256 * j);
                    const f32x4 h = v[j] * (a + 1.0f) + b;
                    *(unsigned*)(H8 + (size_t)row * D + 4 * lane + 256 * j) = pk4_fp8(h[0], h[1], h[2], h[3]);
                    LAS float* hp = hf + rl * 1025 + 4 * lane + 256 * j; hp[0] = h[0]; hp[1] = h[1]; hp[2] = h[2]; hp[3] = h[3]; }
            }
        }
        __syncthreads();
        f32x16 acc;
#pragma unroll
        for (int j = 0; j < 16; ++j) acc[j] = 0.f;
        {
            const LAS float* ap = hf + (lane & 31) * 1025 + 128 * w + (lane >> 5);
            const float* bp = Wr + (size_t)(128 * w) * 32 + lane;
#pragma unroll 8
            for (int s = 0; s < 64; ++s) acc = __builtin_amdgcn_mfma_f32_32x32x2f32(ap[2 * s], bp[64 * s], acc, 0, 0, 0);
        }
        __syncthreads();
        LAS float* red = hf;
#pragma unroll
        for (int j = 0; j < 16; ++j) red[(w * 32 + 8 * (j >> 2) + 4 * (lane >> 5) + (j & 3)) * 33 + (lane & 31)] = acc[j];
        __syncthreads();
        int e_sel[4]; float g_sel[4]; unsigned loc[4];
#pragma unroll
        for (int rr = 0; rr < 4; ++rr) {
            const int tk = w * 4 + rr;
            float val = -INFINITY;
            if (lane < 32) { float sacc = F.in[22][l * 32 + lane];
#pragma unroll
                for (int ww = 0; ww < 8; ++ww) sacc += red[(ww * 32 + tk) * 33 + lane];
                val = sacc; }
            float tv[4]; int te[4];
            {
                const int vbits = __float_as_int(val); int rank = 0;
#pragma unroll
                for (int j = 0; j < 32; ++j) { const float vj = __int_as_float(__builtin_amdgcn_readlane(vbits, j)); rank += (vj > val || (vj == val && j < lane)) ? 1 : 0; }
#pragma unroll
                for (int it = 0; it < 4; ++it) { const unsigned long long mk = __ballot(rank == it); const int ln = mk ? (__ffsll((long long)mk) - 1) : 0;
                    te[it] = ln; tv[it] = __int_as_float(__builtin_amdgcn_readlane(vbits, ln)); }
            }
            const float e1 = __expf(tv[1] - tv[0]), e2 = __expf(tv[2] - tv[0]), e3 = __expf(tv[3] - tv[0]);
            const float rs = 1.0f / (1.0f + e1 + e2 + e3);
            e_sel[rr] = lane == 0 ? te[0] : lane == 1 ? te[1] : lane == 2 ? te[2] : te[3];
            g_sel[rr] = (lane == 0 ? 1.0f : lane == 1 ? e1 : lane == 2 ? e2 : e3) * rs;
            loc[rr] = 0u;
            if (lane < 4) loc[rr] = atomicAdd((unsigned*)&hist[e_sel[rr]], 1u);
        }
        __syncthreads();
        if (F.tid < 32) { const unsigned hcount = hist[F.tid]; hbase[F.tid] = hcount ? atomicAdd(cnt + F.tid * 64, hcount) : 0u; }
        __syncthreads();
        if (lane < 4) {
#pragma unroll
            for (int rr = 0; rr < 4; ++rr) {
                const int row = tile * 32 + w * 4 + rr, e = e_sel[rr]; const unsigned rank = hbase[e] + loc[rr];
                tok[(size_t)e * NT + rank] = (unsigned)row; gate[(size_t)e * NT + rank] = g_sel[rr]; slot[(size_t)row * 4 + lane] = ((unsigned)e << 24) | rank;
            }
        }
    }
}

__device__ __forceinline__ void build_blk(Ctx& F, int l) {
    LAS int* blk = (LAS int*)(F.lds + LDS_BLK);
    const unsigned* cnt = (const unsigned*)(F.ws + WS_CNT) + l * 2048;
    __syncthreads();
    if (F.tid == 0) { int s = 0; for (int e = 0; e < 32; ++e) { blk[e] = s; s += ((int)cnt[e * 64] + 255) >> 8; } blk[32] = s; }
    __syncthreads();
}

__device__ __forceinline__ void phase_combine(Ctx& F, int l) {
    const LAS int* blk = (const LAS int*)(F.lds + LDS_BLK);
    float* X = F.out; bf16_t* XB = (bf16_t*)(F.ws + WS_XB); bf16_t* H = (bf16_t*)(F.ws + WS_H); const unsigned char* YS = F.ws + WS_YS;
    const unsigned* slot = (const unsigned*)(F.ws + WS_SLOT);
    const float* mod = (const float*)(F.ws + WS_MOD);
    const int gw = F.bx * NWAVES + F.wave, NGW = F.G * NWAVES, lane = F.lane;
    for (int row = gw; row < NT; row += NGW) {
        f32x4 ff[4];
#pragma unroll
        for (int j = 0; j < 4; ++j) ff[j] = (f32x4){0.f, 0.f, 0.f, 0.f};
#pragma unroll
        for (int k = 0; k < 4; ++k) {
            const unsigned s = slot[(size_t)row * 4 + k]; const int e = (int)(s >> 24), rank = (int)(s & 0xffffffu);
            const unsigned char* yr = YS + ((size_t)blk[e] * 256 + rank) * D + 4 * lane;
#pragma unroll
            for (int j = 0; j < 4; ++j) { const unsigned wv = *(const unsigned*)(yr + 256 * j); const f32x2 lo = __builtin_amdgcn_cvt_pk_f32_fp8(wv, false), hi = __builtin_amdgcn_cvt_pk_f32_fp8(wv, true);
                ff[j][0] += lo.x; ff[j][1] += lo.y; ff[j][2] += hi.x; ff[j][3] += hi.y; }
        }
        const int bi = batch_of(row);
        const float* mb = mod + (size_t)(l * 16 + bi) * 6144;
        f32x4 v[4];
#pragma unroll
        for (int j = 0; j < 4; ++j) { const u32x2 xw = *(const u32x2*)(XB + (size_t)row * D + 4 * lane + 256 * j); const f32x4 x = (f32x4){bf_lo(xw.x), bf_hi(xw.x), bf_lo(xw.y), bf_hi(xw.y)}, g2 = *(const f32x4*)(mb + 5120 + 4 * lane + 256 * j);
            v[j] = x * ALPHA + (g2 + 1.0f) * (ff[j] * 0.0625f); }
        ln_row(v, F.in[27] + l * D, F.in[28] + l * D, lane);
#pragma unroll
        for (int j = 0; j < 4; ++j) { if (l == 0) { u32x2 w; w.x = cvt_pk_bf16(v[j][0], v[j][1]); w.y = cvt_pk_bf16(v[j][2], v[j][3]); *(u32x2*)(XB + (size_t)row * D + 4 * lane + 256 * j) = w; }
            else *(f32x4*)(X + (size_t)row * D + 4 * lane + 256 * j) = v[j]; }
        if (l == 0) { const float* mn = mod + (size_t)(16 + bi) * 6144; store_mod_row(v, mn, mn + 1024, H + (size_t)row * D, F.ws + WS_H8 + (size_t)row * D, lane); }
    }
}

#ifndef PH_MASK
#define PH_MASK 0xFFFF
#endif
#define PH(b) ((PH_MASK >> (b)) & 1)
#ifndef PROBE_MASK
#define PROBE_MASK 0
#endif
#define PB0(id) do { if ((PROBE_MASK >> (id)) & 1) pb_t0 = __builtin_amdgcn_s_memrealtime(); } while (0)
#define PB1(id) do { if ((PROBE_MASK >> (id)) & 1) pb_acc += __builtin_amdgcn_s_memrealtime() - pb_t0; } while (0)
#define RELOAD() do { int t_ = threadIdx.x; asm volatile("" : "+v"(t_)); F.tid = t_; F.lane = t_ & 63; F.wave = __builtin_amdgcn_readfirstlane(t_ >> 6); \
    unsigned z_; asm volatile("s_mov_b32 %0, 0" : "=s"(z_)); F.in = p.in; F.out = p.out + z_; F.ws = p.ws + z_; } while (0)
#define LAYER_BODY(l) do { \
          \
        PB0(2); RELOAD(); \
        if (PH(2)) { \
              \
            pg8::SchedDense S; S.init(NT, 7 * 256, D, F.G, F.bx, (const bf16_t*)(F.ws + WS_WIN) + (size_t)l * INW * D, 2); \
            pg8::EpiZ E{(bf16_t*)(F.ws + WS_Z), F.in[13] + l * INW, F.out, l}; \
            pg8::gemm_phase<false, 0u>(F.lds, (const char*)(F.ws + WS_H), D, S, E); \
        } \
        RELOAD(); \
        if (PH(2)) { \
              \
            pg8::SchedDense S; S.init(NT, 10 * 256, 512, F.G, (F.G == 256) ? ((F.bx + 112) & 255) : F.bx, F.ws + WS_WIN8 + (size_t)l * INW * D, 0, 2, 7); \
            pg8::EpiZ E{(bf16_t*)(F.ws + WS_Z), F.in[13] + l * INW, F.out, l}; \
            pg8::gemm_phase<true, 0x7f7f7f7fu>(F.lds, (const char*)(F.ws + WS_H8), 512, S, E); \
        } \
        xcd_barrier(xbar); PB1(2); PB0(3); \
        RELOAD(); \
        if (PH(3)) phase_attn(F, l); \
        xcd_barrier(xbar); PB1(3); PB0(4); \
          \
        RELOAD(); \
        if (PH(4)) { \
            pg8::SchedDense S; S.init(NT, D, 256, F.G, F.bx, F.ws + WS_WOA + (size_t)l * D * 512); \
            pg8::EpiT1 E{(bf16_t*)(F.ws + WS_T1), (const bf16_t*)(F.ws + WS_Z)}; \
            pg8::gemm_phase<true, 0x7c7c7c7cu>(F.lds, (const char*)(F.ws + WS_YA), 256, S, E); \
        } \
        RELOAD(); \
        if (PH(5)) { \
            pg8::SchedDense S; S.init(NT, D, 256, F.G, F.bx, F.ws + WS_WOB + (size_t)l * D * 512); \
            pg8::EpiMix E{(const bf16_t*)(F.ws + WS_T1), (const bf16_t*)(F.ws + WS_Z), F.ws + WS_MIX}; \
            pg8::gemm_phase<true, 0x7f7f7f7fu>(F.lds, (const char*)(F.ws + WS_YB), 256, S, E); \
        } \
        xcd_barrier(xbar); PB1(4); PB0(5); \
          \
        RELOAD(); \
        if (PH(6)) { \
            pg8::SchedDense S; S.init(NT, D, 512, F.G, F.bx, F.ws + WS_WO + (size_t)l * D * D); \
            pg8::EpiX E{(const bf16_t*)(F.ws + WS_XB), (bf16_t*)(F.ws + WS_V16), (const float*)(F.ws + WS_MOD) + (size_t)l * 16 * 6144}; \
            pg8::gemm_phase<true, 0x7f7f7f7fu>(F.lds, (const char*)(F.ws + WS_MIX), 512, S, E); \
        } \
        xcd_barrier(xbar); PB1(5); PB0(6); \
        RELOAD(); \
        if (PH(7)) phase_ln_router(F, l); \
        xcd_barrier(xbar); PB1(6); PB0(7); \
          \
        RELOAD(); \
        build_blk(F, l); \
        if (PH(8)) { \
            LAS int* blk = (LAS int*)(F.lds + LDS_BLK); \
            LAS unsigned short* idx = (LAS unsigned short*)(F.lds + LDS_IDX); \
            pg8::SchedMoE<true> S; S.init(blk, idx, 8, 512, F.G, F.bx, (const unsigned char*)(F.ws + WS_WGU) + (size_t)l * 32 * 2048 * D, (size_t)2048 * D); \
            const unsigned* cnt = (const unsigned*)(F.ws + WS_CNT) + l * 2048; const unsigned* tok = (const unsigned*)(F.ws + WS_TOK); \
            for (int i = 0; i < MAXU; ++i) { pg8::Unit u; if (!S.next(i, u)) break; \
                if (F.tid < 256) { int rank = (u.pm - blk[u.e]) * 256 + F.tid; const int ce = (int)cnt[u.e * 64]; rank = rank < ce ? rank : ce - 1; \
                    idx[i * 256 + F.tid] = (unsigned short)tok[(size_t)u.e * NT + rank]; } } \
            __syncthreads(); \
            pg8::EpiAct E{(unsigned char*)(F.ws + WS_ACT), F.in[24] + (size_t)l * 32 * 2048}; \
            pg8::gemm_phase<true, 0x7f7f7f7fu>(F.lds, (const char*)(F.ws + WS_H8), 512, S, E); \
        } \
        xcd_barrier(xbar); PB1(7); PB0(8); \
          \
        RELOAD(); \
        if (PH(9)) { \
            LAS int* blk = (LAS int*)(F.lds + LDS_BLK); \
            LAS unsigned short* idx = (LAS unsigned short*)(F.lds + LDS_IDX); \
            pg8::SchedMoE<false> S; S.init(blk, idx, 4, 512, F.G, F.bx, (const unsigned char*)(F.ws + WS_WDN) + (size_t)l * 32 * D * D, (size_t)D * D); \
            pg8::EpiYs E{F.ws + WS_YS, F.in[26] + (size_t)l * 32 * D, (const float*)(F.ws + WS_GATE), (const unsigned*)(F.ws + WS_CNT) + l * 2048, blk}; \
            pg8::gemm_phase<true, 0x7f7f7f7fu>(F.lds, (const char*)(F.ws + WS_ACT), 512, S, E); \
        } \
        xcd_barrier(xbar); PB1(8); PB0(9); \
        RELOAD(); \
        if (PH(10)) phase_combine(F, l); \
        if (l == 0) xcd_barrier(xbar); \
        PB1(9); \
 \
    } while (0)
__global__ void __launch_bounds__(NTHREADS, 2) fwd_megakernel(Params p) {
    extern __shared__ __attribute__((aligned(16))) unsigned char lds_raw[];
    cg::grid_group grid = cg::this_grid();
    Ctx F;
    F.lds = (LAS unsigned char*)lds_raw;
    F.G = gridDim.x; F.bx = blockIdx.x;
    volatile LAS unsigned* bst = (volatile LAS unsigned*)(F.lds + 147392);
    if (threadIdx.x < 2) bst[threadIdx.x] = 0u;
    __syncthreads();
    const XcdBarrier xbar = xcd_barrier_post((unsigned*)(p.ws + WS_BAR), bst);
    unsigned long long pb_t0 = 0, pb_acc = 0;
    PB0(0); RELOAD();
    if (PH(0)) phase0a(F);
    grid.sync();
    PB1(0); PB0(1); RELOAD();
    { const float* modp = (const float*)(F.ws + WS_MODP); float* mod = (float*)(F.ws + WS_MOD);
      for (int i = F.bx * NTHREADS + F.tid; i < 2 * 16 * 6144; i += F.G * NTHREADS) { float sm = 0.f;
#pragma unroll
          for (int kc = 0; kc < 8; ++kc) sm += modp[(size_t)kc * (2 * 16 * 6144) + i];
          mod[i] = sm; } }
    xcd_barrier(xbar);
    RELOAD();
    if (PH(1)) phase0b(F);
    xcd_barrier(xbar); PB1(1);

    LAYER_BODY(0);
    LAYER_BODY(1);
    if (PROBE_MASK != 0 && blockIdx.x == 0) { const unsigned long long te = __builtin_amdgcn_s_memrealtime(); while (__builtin_amdgcn_s_memrealtime() - te < pb_acc) __builtin_amdgcn_s_sleep(8); }
    (void)pb_t0; (void)pb_acc;
}

extern "C" void kernel_launch(void* const* d_in, const int* in_sizes, int n_in, void* d_out, int out_size, void* d_ws, size_t ws_size, hipStream_t stream) {
    static int grid = 0;
    if (grid == 0) {
        if (n_in != 29 || ws_size < WS_END) { fprintf(stderr, "kernel_launch: unexpected n_in %d / ws_size %zu (need %zu)\n", n_in, ws_size, (size_t)WS_END); grid = -1; return; }
        int dev = 0, cus = 0, per_cu = 0;
        hipGetDevice(&dev);
        hipDeviceGetAttribute(&cus, hipDeviceAttributeMultiprocessorCount, dev);
        if (hipFuncSetAttribute((const void*)fwd_megakernel, hipFuncAttributeMaxDynamicSharedMemorySize, LDS_BYTES) != hipSuccess) { fprintf(stderr, "kernel_launch: hipFuncSetAttribute failed\n"); grid = -1; return; }
        if (hipOccupancyMaxActiveBlocksPerMultiprocessor(&per_cu, (const void*)fwd_megakernel, NTHREADS, LDS_BYTES) != hipSuccess || per_cu < 1) { fprintf(stderr, "kernel_launch: occupancy query says %d blocks per CU\n", per_cu); per_cu = 1; }
        (void)hipGetLastError();
        grid = cus;
        if (grid != 256) fprintf(stderr, "kernel_launch: note: %d CUs (built for 256)\n", grid);
    }
    if (grid < 0) return;
    hipMemsetAsync((char*)d_ws, 0, WS_ZERO_BYTES, stream);
    Params p{};
    for (int i = 0; i < 29; ++i) p.in[i] = (const float*)d_in[i];
    p.out = (float*)d_out; p.ws = (unsigned char*)d_ws;
    void* args[] = {&p};
    hipError_t e = hipLaunchCooperativeKernel((const void*)fwd_megakernel, dim3(grid), dim3(NTHREADS), args, LDS_BYTES, stream);
    if (e != hipSuccess) fprintf(stderr, "kernel_launch: cooperative launch failed: %s (grid %d)\n", hipGetErrorString(e), grid);
}
```

```cpp
#include <hip/hip_runtime.h>
#include <hip/hip_cooperative_groups.h>
#include <cstdio>
#include <cstdint>
namespace cg = cooperative_groups;

#define LAS __attribute__((address_space(3)))
typedef unsigned short bf16_t;
typedef short bf16x8 __attribute__((ext_vector_type(8)));
typedef float f32x4 __attribute__((ext_vector_type(4)));
typedef float f32x16 __attribute__((ext_vector_type(16)));
typedef unsigned u32x4 __attribute__((ext_vector_type(4)));
typedef unsigned u32x2 __attribute__((ext_vector_type(2)));
typedef float f32x2 __attribute__((ext_vector_type(2)));
typedef int i32x4 __attribute__((ext_vector_type(4)));
typedef int i32x8 __attribute__((ext_vector_type(8)));

constexpr int D = 1024, NPROMPT = 32768, NT = 33280, INW = 4352, NEXP = 32;
constexpr float ALPHA = 1.41421356237f, LN_EPS = 1e-5f;
constexpr int NWAVES = 8, NTHREADS = 512;
constexpr int LDS_BYTES = 147456;
constexpr int LDS_BLK = 131072;
constexpr int LDS_IDX = 131072 + 256;
constexpr int MAXU = 24;
constexpr size_t OKP = 34078720, OVP = 34340864, OCP = 34603008, OKS = 34619392, OVS = 34881536, OCS = 35143680;
constexpr size_t MiB = 1u << 20;
constexpr size_t WS_CNT = 0;
constexpr size_t WS_BAR = 16384;
constexpr size_t WS_MOD = 65536;
constexpr size_t WS_MODP = 192 * MiB;
constexpr size_t WS_ZERO_BYTES = 1 * MiB;
constexpr size_t WS_BIAS = 1 * MiB;
constexpr size_t WS_SLOT = 2 * MiB;
constexpr size_t WS_TOK = 3 * MiB;
constexpr size_t WS_GATE = 8 * MiB;
constexpr size_t WS_WIN = 16 * MiB;
constexpr size_t WS_WIN8 = 180 * MiB;
constexpr size_t WS_WOA = 34 * MiB;
constexpr size_t WS_WOB = 36 * MiB;
constexpr size_t WS_WO = 38 * MiB;
constexpr size_t WS_WGU = 48 * MiB;
constexpr size_t WS_WDN = 304 * MiB;
constexpr size_t WS_H = 432 * MiB;
constexpr size_t WS_H8 = 1600 * MiB;
constexpr size_t WS_Z = 498 * MiB;
constexpr size_t WS_YA = 776 * MiB;
constexpr size_t WS_YB = 810 * MiB;
constexpr size_t WS_T1 = 844 * MiB;
constexpr size_t WS_V16 = 910 * MiB;
constexpr size_t WS_XB = 1200 * MiB;
constexpr size_t WS_MIX = 976 * MiB;
constexpr size_t WS_ACT = 1042 * MiB;
constexpr size_t WS_YS = 1320 * MiB;
constexpr size_t WS_ZG8 = 1460 * MiB;
constexpr size_t WS_END = 1634 * MiB;

struct Params { const float* in[29]; float* out; unsigned char* ws; };

__device__ __forceinline__ unsigned cvt_pk_bf16(float lo, float hi) { unsigned r; asm volatile("v_cvt_pk_bf16_f32 %0, %1, %2" : "=v"(r) : "v"(lo), "v"(hi)); return r; }
__device__ __forceinline__ unsigned pk4_fp8(float a, float b, float c, float d) { unsigned w = 0u; w = __builtin_amdgcn_cvt_pk_fp8_f32(a, b, w, false); w = __builtin_amdgcn_cvt_pk_fp8_f32(c, d, w, true); return w; }
__device__ __forceinline__ void unpk8_fp8(const u32x2 w, float (&o)[8]) { const f32x2 a = __builtin_amdgcn_cvt_pk_f32_fp8(w.x, false), b = __builtin_amdgcn_cvt_pk_f32_fp8(w.x, true), c = __builtin_amdgcn_cvt_pk_f32_fp8(w.y, false), d = __builtin_amdgcn_cvt_pk_f32_fp8(w.y, true);
    o[0] = a.x; o[1] = a.y; o[2] = b.x; o[3] = b.y; o[4] = c.x; o[5] = c.y; o[6] = d.x; o[7] = d.y; }
__device__ __forceinline__ float bf_lo(unsigned w) { return __uint_as_float(w << 16); }
__device__ __forceinline__ float bf_hi(unsigned w) { return __uint_as_float(w & 0xffff0000u); }
__device__ __forceinline__ float sigmoidf_(float x) { return __builtin_amdgcn_rcpf(1.0f + __expf(-x)); }
__device__ __forceinline__ float wave_sum(float v) {
#define WS_DPP_ADD(ctrl) v += __int_as_float(__builtin_amdgcn_update_dpp(0, __float_as_int(v), (ctrl), 0xf, 0xf, true))
    WS_DPP_ADD(0xB1);
    WS_DPP_ADD(0x4E);
    WS_DPP_ADD(0x141);
    WS_DPP_ADD(0x140);
#undef WS_DPP_ADD
    const int b = __float_as_int(v);
    const float r0 = __int_as_float(__builtin_amdgcn_readlane(b, 0)), r1 = __int_as_float(__builtin_amdgcn_readlane(b, 16)), r2 = __int_as_float(__builtin_amdgcn_readlane(b, 32)), r3 = __int_as_float(__builtin_amdgcn_readlane(b, 48));
    return (r0 + r1) + (r2 + r3);
}
__device__ __forceinline__ int batch_of(int row) { return row < NPROMPT ? (row >> 12) : 8 + ((row - NPROMPT) >> 6); }

namespace pg8 {
constexpr int BM = 256, BK = 64, HALF = 128, HTB = HALF * BK * 2, NXCD = 8, WGM = 8;
__device__ __forceinline__ int lds_byte(int r, int c) { const int st = (r >> 4) * 2 + (c >> 5), rr = r & 15, cc = c & 31, ob = rr * 64 + cc * 2; return st * 1024 + (ob ^ (((ob >> 9) & 1) << 5)); }
__device__ __forceinline__ void stage_rc(int b, int& R, int& C) { const int st = b / 1024, sb = b % 1024, swz = sb ^ (((sb >> 9) & 1) << 5); R = (st >> 1) * 16 + swz / 64; C = (st & 1) * 32 + (swz % 64) / 2; }
__device__ __forceinline__ int perm32(int rho) { const int n = rho >> 4, i = rho & 15; return 8 * (i >> 2) + 4 * n + (i & 3); }

struct Unit { int pm, pn, e; const char* b; };

struct SchedDense {
    int nM, nN, nwg, G, c, cbase, csplit, cskip; const char* Bt; size_t tstepB;
    __device__ __forceinline__ void init(int M, int N, int K, int G_, int c_, const void* Bt_, int cbase_ = 0, int csplit_ = 1 << 20, int cskip_ = 0) { nM = M / BM; nN = N / BM; nwg = nM * nN; G = G_; c = c_; Bt = (const char*)Bt_; tstepB = (size_t)BM * K * 2; cbase = cbase_; csplit = csplit_; cskip = cskip_; }
    __device__ __forceinline__ bool next(int i, Unit& u) const {
        const long L = (long)i * G + c; if (L >= nwg) return false;
        int wgid = (int)L; { const int q = nwg / NXCD, r = nwg % NXCD, xcd = wgid % NXCD, off = wgid / NXCD; wgid = (xcd < r ? xcd * (q + 1) : r * (q + 1) + (xcd - r) * q) + off; }
        const int nig = WGM * nN, gid = wgid / nig, fm = gid * WGM, gsz = (nM - fm) < WGM ? (nM - fm) : WGM;
        u.pm = fm + ((wgid % nig) % gsz); const int j = (wgid % nig) / gsz; u.pn = j < csplit ? j + cbase : j + cbase + cskip; u.e = 0; u.b = Bt + (size_t)u.pn * tstepB; return true;
    }
    __device__ __forceinline__ unsigned rowidx(int, const Unit& u, int r) const { return (unsigned)(u.pm * BM + r); }
};
template <bool GATHER> struct SchedMoE {
    const LAS int* blk; const LAS unsigned short* idx; int NB, RBX, NPN, NXs, perx, cx, cj; const char* Bt; size_t estep, tstepB;
    __device__ __forceinline__ void init(const LAS int* blk_, const LAS unsigned short* idx_, int NPN_, int K, int G, int c, const void* Bt_, size_t estep_) {
        blk = blk_; idx = idx_; NB = blk_[32]; NPN = NPN_; Bt = (const char*)Bt_; estep = estep_; tstepB = (size_t)BM * K * 2;
        if ((G & 7) == 0) { NXs = 8; perx = G >> 3; cx = c & 7; cj = c >> 3; } else { NXs = 1; perx = G; cx = 0; cj = c; }
        RBX = (NB + NXs - 1) / NXs;
    }
    __device__ __forceinline__ bool next(int i, Unit& u) const {
        const int j = i * perx + cj, rbl = j / NPN; if (rbl >= RBX) return false;
        const int rb = cx * RBX + rbl; if (rb >= NB) return false;
        int e = 0;
        for (int q = 1; q < 32; ++q) e = (blk[q] <= rb) ? q : e;
        u.pm = rb; u.pn = j - rbl * NPN; u.e = e; u.b = Bt + (size_t)e * estep + (size_t)u.pn * tstepB; return true;
    }
    __device__ __forceinline__ unsigned rowidx(int ui, const Unit& u, int r) const { if (GATHER) return (unsigned)idx[ui * 256 + r]; return (unsigned)(u.pm * BM + r); }
};

template <bool FP8, unsigned ASCALE, class Epi, class Sched>
__device__ __forceinline__ void gemm_phase(LAS unsigned char* lds, const char* Abase, const int K, const Sched& S, const Epi& E) {
    int tid_ = threadIdx.x; asm volatile("" : "+v"(tid_));
    const int tid = tid_, wid = __builtin_amdgcn_readfirstlane(tid >> 6), lane = tid & 63, wr = wid >> 2, wc = wid & 3, fr = lane & 15, fq = lane >> 4;
    int nt_ = K / BK; asm volatile("" : "+s"(nt_)); const int nt = nt_;
    unsigned voffB[2]; int RA[2], CA[2];
#pragma unroll
    for (int i = 0; i < 2; ++i) { int R, C; stage_rc(tid * 16 + i * 8192, R, C); const int Rb = Epi::PERM ? ((R & ~31) + perm32(R & 31)) : R;
        voffB[i] = (unsigned)(Rb * K + C) * 2u; RA[i] = R; CA[i] = C * 2; }
    const size_t kstep = (size_t)(BK * 2);
    const size_t hstep = (size_t)HALF * K * 2;
    const unsigned ldsw = (unsigned)wid * 1024u;
    const unsigned rowb = (unsigned)K * 2u;
    const int aoff = lds_byte(wr * 64 + fr, fq * 8), boff = lds_byte(wc * 32 + fr, fq * 8);
#define PG8_SA(b, h) (((b) * 2 + (h)) * HTB)
#define PG8_SB(b, h) ((4 + (b) * 2 + (h)) * HTB)
#define PG8_STAGE(bufoff, gbase, voff) do { _Pragma("unroll") for (int _i = 0; _i < 2; ++_i) \
        __builtin_amdgcn_global_load_lds((const unsigned*)((const char*)(gbase) + (voff)[_i]), (LAS unsigned*)(lds + (bufoff) + ldsw + _i * 8192), 16, 0, 0); } while (0)
#define PG8_LDA(dst, b, h) do { _Pragma("unroll") for (int m = 0; m < 4; ++m) _Pragma("unroll") for (int k = 0; k < 2; ++k) dst[m][k] = *(const LAS bf16x8*)(lds + PG8_SA(b, h) + aoff + m * 2048 + k * 1024); } while (0)
#define PG8_LDB(dst, b, h) do { _Pragma("unroll") for (int n = 0; n < 2; ++n) _Pragma("unroll") for (int k = 0; k < 2; ++k) dst[n][k] = *(const LAS bf16x8*)(lds + PG8_SB(b, h) + boff + n * 2048 + k * 1024); } while (0)
#define PG8_MMA(ai, bj, At, Bt) do { __builtin_amdgcn_s_setprio(1); _Pragma("unroll") for (int m = 0; m < 4; ++m) _Pragma("unroll") for (int n = 0; n < 2; ++n) { \
        if constexpr (FP8) { \
            const i32x8 wf_ = __builtin_shufflevector((i32x4)Bt[n][0], (i32x4)Bt[n][1], 0, 1, 2, 3, 4, 5, 6, 7), af_ = __builtin_shufflevector((i32x4)At[m][0], (i32x4)At[m][1], 0, 1, 2, 3, 4, 5, 6, 7); \
            acc[ai][bj][m][n] = __builtin_amdgcn_mfma_scale_f32_16x16x128_f8f6f4(wf_, af_, acc[ai][bj][m][n], 0, 0, 0, 0x79797979, 0, (int)ASCALE); \
        } else { _Pragma("unroll") for (int k = 0; k < 2; ++k) \
            acc[ai][bj][m][n] = __builtin_amdgcn_mfma_f32_16x16x32_bf16(Bt[n][k], At[m][k], acc[ai][bj][m][n], 0, 0, 0); } } \
        __builtin_amdgcn_s_setprio(0); } while (0)
#define PG8_WAIT_V(n) asm volatile("s_waitcnt vmcnt(" #n ")" ::: "memory")
#define PG8_WAIT_L(n) asm volatile("s_waitcnt lgkmcnt(" #n ")" ::: "memory")
#define PG8_BAR __builtin_amdgcn_s_barrier()
#define PG8_SCHED __builtin_amdgcn_sched_barrier(0)
#define PG8_LOADVA(ui_, u_) do { _Pragma("unroll") for (int _h = 0; _h < 2; ++_h) _Pragma("unroll") for (int _i = 0; _i < 2; ++_i) \
        vA[_h][_i] = S.rowidx((ui_), (u_), _h * HALF + RA[_i]) * rowb + (unsigned)CA[_i]; } while (0)
    Unit cur, nxt; int ui = 0;
    if (!S.next(0, cur)) return;
    f32x4 acc[2][2][4][2];
#pragma unroll
    for (int a = 0; a < 2; ++a)
#pragma unroll
        for (int b = 0; b < 2; ++b)
#pragma unroll
            for (int m = 0; m < 4; ++m)
#pragma unroll
                for (int n = 0; n < 2; ++n) acc[a][b][m][n] = (f32x4){0.f, 0.f, 0.f, 0.f};
    bf16x8 At[4][2], B0[2][2], B1[2][2];
    unsigned vA[2][2];
    PG8_LOADVA(0, cur);
    const char* cB = cur.b;
    PG8_STAGE(PG8_SB(0, 0), cB, voffB); PG8_STAGE(PG8_SB(0, 1), cB + hstep, voffB); PG8_STAGE(PG8_SA(0, 0), Abase, vA[0]); PG8_STAGE(PG8_SA(0, 1), Abase, vA[1]);
    if (wr == 1) PG8_BAR;
    PG8_WAIT_V(2); PG8_BAR;
    PG8_STAGE(PG8_SB(1, 0), cB + kstep, voffB); PG8_STAGE(PG8_SA(1, 0), Abase + kstep, vA[0]); PG8_STAGE(PG8_SB(1, 1), cB + hstep + kstep, voffB);
    PG8_WAIT_V(6); PG8_BAR;
    for (;;) {
        const bool has_next = S.next(ui + 1, nxt);
        const char* nB = has_next ? nxt.b : cB;
#pragma unroll 1
        for (int t = 0; t < nt; t += 2) {
            const bool last = (t == nt - 2);
            const char* a1 = Abase + (size_t)(t + 1) * kstep;
            const char* a2 = last ? Abase : Abase + (size_t)(t + 2) * kstep;
            const char* b2 = last ? nB : cB + (size_t)(t + 2) * kstep;
            const char* a3 = a2 + kstep; const char* b3 = b2 + kstep;
            PG8_LDB(B0, 0, 0); PG8_LDB(B1, 0, 1); PG8_SCHED; PG8_LDA(At, 0, 0); PG8_STAGE(PG8_SA(1, 1), a1, vA[1]);
            if (last && has_next) { PG8_LOADVA(ui + 1, nxt); }
            PG8_WAIT_V(8); PG8_WAIT_L(0); PG8_BAR; PG8_MMA(0, 0, At, B0); PG8_MMA(0, 1, At, B1); PG8_BAR; PG8_SCHED;
            PG8_LDA(At, 0, 1); PG8_STAGE(PG8_SB(0, 0), b2, voffB); PG8_STAGE(PG8_SB(0, 1), b2 + hstep, voffB); PG8_STAGE(PG8_SA(0, 0), a2, vA[0]);
            PG8_WAIT_V(8); PG8_WAIT_L(0); PG8_BAR; PG8_MMA(1, 0, At, B0); PG8_MMA(1, 1, At, B1); PG8_BAR; PG8_SCHED;
            PG8_LDB(B0, 1, 0); PG8_LDB(B1, 1, 1); PG8_SCHED; PG8_LDA(At, 1, 0); PG8_STAGE(PG8_SA(0, 1), a2, vA[1]);
            PG8_WAIT_V(8); PG8_WAIT_L(0); PG8_BAR; PG8_MMA(0, 0, At, B0); PG8_MMA(0, 1, At, B1); PG8_BAR; PG8_SCHED;
            PG8_LDA(At, 1, 1); PG8_STAGE(PG8_SB(1, 0), b3, voffB); PG8_STAGE(PG8_SB(1, 1), b3 + hstep, voffB); PG8_STAGE(PG8_SA(1, 0), a3, vA[0]);
            PG8_WAIT_V(8); PG8_WAIT_L(0); PG8_BAR; PG8_MMA(1, 0, At, B0); PG8_MMA(1, 1, At, B1); PG8_BAR; PG8_SCHED;
        }
        if (wr == 0) PG8_BAR;
        E(acc, cur, wr, wc, fr, fq);
        if (!has_next) break;
#pragma unroll
        for (int a = 0; a < 2; ++a)
#pragma unroll
            for (int b = 0; b < 2; ++b)
#pragma unroll
                for (int m = 0; m < 4; ++m)
#pragma unroll
                    for (int n = 0; n < 2; ++n) acc[a][b][m][n] = (f32x4){0.f, 0.f, 0.f, 0.f};
        cur = nxt; cB = nB; ++ui;
        if (wr == 1) PG8_BAR;
    }
    PG8_WAIT_V(0);
    PG8_BAR;
#undef PG8_SA
#undef PG8_SB
#undef PG8_STAGE
#undef PG8_LDA
#undef PG8_LDB
#undef PG8_MMA
#undef PG8_WAIT_V
#undef PG8_WAIT_L
#undef PG8_BAR
#undef PG8_SCHED
#undef PG8_LOADVA
}

typedef f32x4 Acc[2][2][4][2];

struct EpiZ {
    static constexpr bool PERM = true;
    bf16_t* Z; const float* bias; float* out; int l; unsigned char* ZG;
    __device__ __forceinline__ void operator()(const Acc& acc, const Unit& u, int wr, int wc, int fr, int fq) const {
        const int row0 = u.pm * 256 + wr * 64 + fr, col0 = u.pn * 256 + wc * 32 + 8 * fq;
        f32x4 bv[2][2];
#pragma unroll
        for (int bj = 0; bj < 2; ++bj)
#pragma unroll
            for (int n = 0; n < 2; ++n) bv[bj][n] = *(const f32x4*)(bias + col0 + bj * 128 + 4 * n);
#pragma unroll
        for (int ai = 0; ai < 2; ++ai)
#pragma unroll
            for (int m = 0; m < 4; ++m) {
                const int row = row0 + ai * 128 + m * 16;
                bf16_t* rowp = Z + (size_t)row * INW + col0;
                float* ko = nullptr; float* vo = nullptr;
                if (u.pn == 2) {
                    if (row < NPROMPT) { const int t = row & 4095; if (t >= 3968) { const size_t o = ((size_t)(l * 8 + (row >> 12)) * 128 + (t - 3968)) * 128 + wc * 32 + 8 * fq; ko = out + OKP + o; vo = out + OVP + o; } }
                    else { const int rr = row - NPROMPT; const size_t o = ((size_t)(l * 8 + (rr >> 6)) * 128 + 64 + (rr & 63)) * 128 + wc * 32 + 8 * fq; ko = out + OKS + o; vo = out + OVS + o; }
                }
#pragma unroll
                for (int bj = 0; bj < 2; ++bj) {
                    const f32x4 v0 = acc[ai][bj][m][0] + bv[bj][0], v1 = acc[ai][bj][m][1] + bv[bj][1];
                    if (u.pn >= 9) { u32x2 w8; w8.x = pk4_fp8(v0[0], v0[1], v0[2], v0[3]); w8.y = pk4_fp8(v1[0], v1[1], v1[2], v1[3]);
                        *(u32x2*)(ZG + (size_t)row * 2048 + (col0 - 2304) + bj * 128) = w8; }
                    else { u32x4 w; w.x = cvt_pk_bf16(v0[0], v0[1]); w.y = cvt_pk_bf16(v0[2], v0[3]); w.z = cvt_pk_bf16(v1[0], v1[1]); w.w = cvt_pk_bf16(v1[2], v1[3]);
                        *(u32x4*)(rowp + bj * 128) = w; }
                    float* o = bj == 0 ? ko : vo;
                    if (o) { *(f32x4*)o = v0; *(f32x4*)(o + 4) = v1; }
                }
                asm volatile("" ::: "memory");
            }
    }
};
struct EpiT1 {
    static constexpr bool PERM = true;
    unsigned char* T1; const unsigned char* ZG;
    __device__ __forceinline__ void operator()(const Acc& acc, const Unit& u, int wr, int wc, int fr, int fq) const {
        const int row0 = u.pm * 256 + wr * 64 + fr, col0 = u.pn * 256 + wc * 32 + 8 * fq;
        u32x2 g[2][4][2];
#pragma unroll
        for (int ai = 0; ai < 2; ++ai)
#pragma unroll
            for (int m = 0; m < 4; ++m)
#pragma unroll
                for (int bj = 0; bj < 2; ++bj) g[ai][m][bj] = *(const u32x2*)(ZG + (size_t)(row0 + ai * 128 + m * 16) * 2048 + col0 + bj * 128);
        asm volatile("" ::: "memory");
#pragma unroll
        for (int ai = 0; ai < 2; ++ai)
#pragma unroll
            for (int m = 0; m < 4; ++m) {
                const int row = row0 + ai * 128 + m * 16;
#pragma unroll
                for (int bj = 0; bj < 2; ++bj) {
                    float gg[8]; unpk8_fp8(g[ai][m][bj], gg);
                    f32x4 v0 = acc[ai][bj][m][0] * 16.0f, v1 = acc[ai][bj][m][1] * 16.0f;
#pragma unroll
                    for (int j = 0; j < 4; ++j) { v0[j] *= sigmoidf_(gg[j]); v1[j] *= sigmoidf_(gg[4 + j]); }
                    u32x2 w; w.x = pk4_fp8(v0[0], v0[1], v0[2], v0[3]); w.y = pk4_fp8(v1[0], v1[1], v1[2], v1[3]);
                    *(u32x2*)(T1 + (size_t)row * D + col0 + bj * 128) = w;
                }
            }
    }
};
struct EpiMix {
    static constexpr bool PERM = true;
    const unsigned char* T1; const unsigned char* ZG; unsigned char* MIX;
    __device__ __forceinline__ void operator()(const Acc& acc, const Unit& u, int wr, int wc, int fr, int fq) const {
        const int row0 = u.pm * 256 + wr * 64 + fr, col0 = u.pn * 256 + wc * 32 + 8 * fq;
        u32x2 g[2][4][2], t[2][4][2];
#pragma unroll
        for (int ai = 0; ai < 2; ++ai)
#pragma unroll
            for (int m = 0; m < 4; ++m)
#pragma unroll
                for (int bj = 0; bj < 2; ++bj) { const int row = row0 + ai * 128 + m * 16;
                    g[ai][m][bj] = *(const u32x2*)(ZG + (size_t)row * 2048 + 1024 + col0 + bj * 128);
                    t[ai][m][bj] = *(const u32x2*)(T1 + (size_t)row * D + col0 + bj * 128); }
        asm volatile("" ::: "memory");
#pragma unroll
        for (int ai = 0; ai < 2; ++ai)
#pragma unroll
            for (int m = 0; m < 4; ++m) {
                const int row = row0 + ai * 128 + m * 16;
#pragma unroll
                for (int bj = 0; bj < 2; ++bj) {
                    float gg[8], tt[8]; unpk8_fp8(g[ai][m][bj], gg); unpk8_fp8(t[ai][m][bj], tt);
                    const f32x4 a0 = acc[ai][bj][m][0], a1 = acc[ai][bj][m][1];
                    float v[8];
#pragma unroll
                    for (int j = 0; j < 4; ++j) { v[j] = tt[j] * 0.0625f + a0[j] * sigmoidf_(gg[j]); v[4 + j] = tt[4 + j] * 0.0625f + a1[j] * sigmoidf_(gg[4 + j]); }
                    u32x2 w; w.x = pk4_fp8(v[0], v[1], v[2], v[3]); w.y = pk4_fp8(v[4], v[5], v[6], v[7]);
                    *(u32x2*)(MIX + (size_t)row * D + col0 + bj * 128) = w;
                }
            }
    }
};
struct EpiX {
    static constexpr bool PERM = true;
    const bf16_t* X; bf16_t* V; const float* modl;
    __device__ __forceinline__ void operator()(const Acc& acc, const Unit& u, int wr, int wc, int fr, int fq) const {
        const int row0 = u.pm * 256 + wr * 64 + fr, col0 = u.pn * 256 + wc * 32 + 8 * fq;
        const bool uni = u.pm < 128;
        f32x4 g[2][2];
        if (uni) { const float* gp = modl + (size_t)(u.pm >> 4) * 6144 + 2048 + col0;
#pragma unroll
            for (int bj = 0; bj < 2; ++bj)
#pragma unroll
                for (int n = 0; n < 2; ++n) g[bj][n] = *(const f32x4*)(gp + bj * 128 + 4 * n) + 1.0f; }
#pragma unroll
        for (int ai = 0; ai < 2; ++ai)
#pragma unroll
        for (int mh = 0; mh < 2; ++mh) {
            u32x4 x[4][2];
#pragma unroll
            for (int m = 2 * mh; m < 2 * mh + 2; ++m)
#pragma unroll
                for (int bj = 0; bj < 2; ++bj) x[m][bj] = *(const u32x4*)(X + (size_t)(row0 + ai * 128 + m * 16) * D + col0 + bj * 128);
            asm volatile("" ::: "memory");
#pragma unroll
            for (int m = 2 * mh; m < 2 * mh + 2; ++m) {
                const int row = row0 + ai * 128 + m * 16;
                if (!uni) { const float* gp = modl + (size_t)batch_of(row) * 6144 + 2048 + col0;
#pragma unroll
                    for (int bj = 0; bj < 2; ++bj)
#pragma unroll
                        for (int n = 0; n < 2; ++n) g[bj][n] = *(const f32x4*)(gp + bj * 128 + 4 * n) + 1.0f; }
#pragma unroll
                for (int bj = 0; bj < 2; ++bj) {
                    const u32x4 xx = x[m][bj];
                    const f32x4 x0 = (f32x4){bf_lo(xx.x), bf_hi(xx.x), bf_lo(xx.y), bf_hi(xx.y)}, x1 = (f32x4){bf_lo(xx.z), bf_hi(xx.z), bf_lo(xx.w), bf_hi(xx.w)};
                    const f32x4 v0 = x0 * ALPHA + g[bj][0] * acc[ai][bj][m][0], v1 = x1 * ALPHA + g[bj][1] * acc[ai][bj][m][1];
                    u32x4 w; w.x = cvt_pk_bf16(v0[0], v0[1]); w.y = cvt_pk_bf16(v0[2], v0[3]); w.z = cvt_pk_bf16(v1[0], v1[1]); w.w = cvt_pk_bf16(v1[2], v1[3]);
                    *(u32x4*)(V + (size_t)row * D + col0 + bj * 128) = w;
                }
            }
            asm volatile("" ::: "memory");
        }
    }
};
struct EpiAct {
    static constexpr bool PERM = true;
    unsigned char* ACT; const float* bgu;
    __device__ __forceinline__ void operator()(const Acc& acc, const Unit& u, int wr, int wc, int fr, int fq) const {
        const int row0 = u.pm * 256 + wr * 64 + fr, c0 = u.pn * 128 + wc * 32 + 8 * fq;
        const float* bp = bgu + (size_t)u.e * 2048 + c0;
        f32x4 bg[2], bl[2];
#pragma unroll
        for (int n = 0; n < 2; ++n) { bg[n] = *(const f32x4*)(bp + 4 * n); bl[n] = *(const f32x4*)(bp + 1024 + 4 * n); }
#pragma unroll
        for (int ai = 0; ai < 2; ++ai)
#pragma unroll
            for (int m = 0; m < 4; ++m) {
                const int row = row0 + ai * 128 + m * 16;
                float a[8];
#pragma unroll
                for (int n = 0; n < 2; ++n)
#pragma unroll
                    for (int jp = 0; jp < 2; ++jp) {
                        f32x2 g = (f32x2){acc[ai][0][m][n][2 * jp], acc[ai][0][m][n][2 * jp + 1]} + (f32x2){bg[n][2 * jp], bg[n][2 * jp + 1]};
                        f32x2 li = (f32x2){acc[ai][1][m][n][2 * jp], acc[ai][1][m][n][2 * jp + 1]} + (f32x2){bl[n][2 * jp], bl[n][2 * jp + 1]};
                        g = __builtin_elementwise_min(g, (f32x2){7.0f, 7.0f});
                        li = __builtin_elementwise_min(__builtin_elementwise_max(li, (f32x2){-7.0f, -7.0f}), (f32x2){7.0f, 7.0f});
                        const f32x2 t = g * (-1.702f * 1.44269504089f);
                        f32x2 e; e.x = __builtin_amdgcn_exp2f(t.x); e.y = __builtin_amdgcn_exp2f(t.y);
                        const f32x2 dd = e + 1.0f;
                        f32x2 r; r.x = __builtin_amdgcn_rcpf(dd.x); r.y = __builtin_amdgcn_rcpf(dd.y);
                        const f32x2 av = (g * r) * (li + 1.0f);
                        a[n * 4 + 2 * jp] = av.x; a[n * 4 + 2 * jp + 1] = av.y;
                    }
                u32x2 w; w.x = pk4_fp8(a[0], a[1], a[2], a[3]); w.y = pk4_fp8(a[4], a[5], a[6], a[7]);
                *(u32x2*)(ACT + (size_t)row * D + c0) = w;
                asm volatile("" ::: "memory");
            }
    }
};
struct EpiYs {
    static constexpr bool PERM = true;
    unsigned char* YS; const float* bdn; const float* gate; const unsigned* cnt; const LAS int* blk;
    __device__ __forceinline__ void operator()(const Acc& acc, const Unit& u, int wr, int wc, int fr, int fq) const {
        const int r0 = wr * 64 + fr, col0 = u.pn * 256 + wc * 32 + 8 * fq;
        const int rank0 = (u.pm - blk[u.e]) * 256; const int ce = (int)cnt[u.e * 64];
        f32x4 bv[2][2];
#pragma unroll
        for (int bj = 0; bj < 2; ++bj)
#pragma unroll
            for (int n = 0; n < 2; ++n) bv[bj][n] = *(const f32x4*)(bdn + (size_t)u.e * D + col0 + bj * 128 + 4 * n);
        float gts[2][4];
#pragma unroll
        for (int ai = 0; ai < 2; ++ai)
#pragma unroll
            for (int m = 0; m < 4; ++m) { const int rank = rank0 + r0 + ai * 128 + m * 16; gts[ai][m] = rank < ce ? 16.0f * gate[(size_t)u.e * NT + rank] : 0.0f; }
        asm volatile("" ::: "memory");
#pragma unroll
        for (int ai = 0; ai < 2; ++ai)
#pragma unroll
            for (int m = 0; m < 4; ++m) {
                const int r = r0 + ai * 128 + m * 16;
                const float gt = gts[ai][m];
                unsigned char* rowp = YS + (size_t)(u.pm * 256 + r) * D + col0;
#pragma unroll
                for (int bj = 0; bj < 2; ++bj) {
                    const f32x4 v0 = (acc[ai][bj][m][0] + bv[bj][0]) * gt, v1 = (acc[ai][bj][m][1] + bv[bj][1]) * gt;
                    u32x2 w; w.x = pk4_fp8(v0[0], v0[1], v0[2], v0[3]); w.y = pk4_fp8(v1[0], v1[1], v1[2], v1[3]);
                    *(u32x2*)(rowp + bj * 128) = w;
                }
                asm volatile("" ::: "memory");
            }
    }
};
}


#define XB_TMO      128
#define XB_XCNT(j)  (256  + 64 * (j))
#define XB_XSUB(j)  (1280 + 64 * (j))
#define XB_XGEN(j)  (2304 + 64 * (j))
#define XB_TOP      3328
#define XB_TOPGEN   3392
#define XCD_BAR_WORDS 3456
#define XB_SPIN_CAP (1u << 21)
__device__ __forceinline__ unsigned xb_ld(unsigned* p)              { return __hip_atomic_load(p, __ATOMIC_RELAXED, __HIP_MEMORY_SCOPE_AGENT); }
__device__ __forceinline__ unsigned xb_add(unsigned* p, unsigned v) { return __hip_atomic_fetch_add(p, v, __ATOMIC_RELAXED, __HIP_MEMORY_SCOPE_AGENT); }
__device__ __forceinline__ unsigned xb_xcc_id() { return (unsigned)__builtin_amdgcn_s_getreg((3 << 11) | 20) & 0xFu; }
#define XB_SPIN(cond, bar) do { unsigned _sp = 0; while (cond) { __builtin_amdgcn_s_sleep(1); \
    if ((++_sp & 255u) == 0u) { if (xb_ld(&(bar)[XB_TMO])) break; if (_sp > XB_SPIN_CAP) { atomicAdd(&(bar)[XB_TMO], 1u); break; } } } } while (0)
struct XcdBarrier { unsigned* bar; unsigned x; volatile LAS unsigned* st; };
__device__ __forceinline__ XcdBarrier xcd_barrier_post(unsigned* bar, volatile LAS unsigned* st) {
    XcdBarrier b; b.bar = bar; b.x = xb_xcc_id(); b.st = st;
    if (threadIdx.x == 0) (void)xb_add(&bar[XB_XCNT(b.x)], 1u);
    return b;
}
__device__ __forceinline__ void xcd_barrier_complete(unsigned* bar, unsigned x, unsigned& nloc, unsigned& nx) {
    const unsigned G = gridDim.x * gridDim.y * gridDim.z;
    unsigned sum, cnt, mine, sp = 0u;
    for (;;) {
        sum = 0u; cnt = 0u; mine = 0u;
#pragma unroll
        for (unsigned j = 0; j < 16; ++j) { const unsigned c = xb_ld(&bar[XB_XCNT(j)]); sum += c; cnt += (c > 0u) ? 1u : 0u; mine = (j == x) ? c : mine; }
        if (sum == G) break;
        __builtin_amdgcn_s_sleep(1);
        if ((++sp & 255u) == 0u) { if (xb_ld(&bar[XB_TMO])) break; if (sp > XB_SPIN_CAP) { atomicAdd(&bar[XB_TMO], 1u); break; } }
    }
    nloc = mine > 0u ? mine : 1u; nx = cnt > 0u ? cnt : 1u;
}
__device__ __forceinline__ void xcd_barrier(const XcdBarrier& b) {
    asm volatile("s_waitcnt vmcnt(0)" ::: "memory");
    __syncthreads();
    if (threadIdx.x == 0) {
        unsigned* bar = b.bar;
        __builtin_amdgcn_s_waitcnt(0);
        unsigned nloc = b.st[0], nx = b.st[1];
        if (nloc == 0u) { xcd_barrier_complete(bar, b.x, nloc, nx); b.st[0] = nloc; b.st[1] = nx; }
        const unsigned old = xb_add(&bar[XB_XSUB(b.x)], 1u);
        const unsigned gen = old / nloc;
        if (old + 1u == (gen + 1u) * nloc) {
            __builtin_amdgcn_fence(__ATOMIC_RELEASE, "agent");
            asm volatile("s_waitcnt vmcnt(0)" ::: "memory");
            const unsigned og = xb_add(&bar[XB_TOP], 1u);
            const unsigned tg = og / nx;
            if (og + 1u == (tg + 1u) * nx) xb_add(&bar[XB_TOPGEN], 1u);
            else XB_SPIN(xb_ld(&bar[XB_TOPGEN]) == tg, bar);
            __builtin_amdgcn_fence(__ATOMIC_ACQUIRE, "agent");
            xb_add(&bar[XB_XGEN(b.x)], 1u);
            asm volatile("s_waitcnt vmcnt(0)" ::: "memory");
        } else {
            XB_SPIN(xb_ld(&bar[XB_XGEN(b.x)]) == gen, bar);
            __builtin_amdgcn_fence(__ATOMIC_ACQUIRE, "agent");
            asm volatile("s_waitcnt vmcnt(0)" ::: "memory");
        }
    }
    __syncthreads();
}

struct Ctx {
    LAS unsigned char* lds; int tid, lane, wave, G, bx;
    const float* const* in; float* out; unsigned char* ws;
};
#define LDS_WAIT() asm volatile("s_waitcnt lgkmcnt(0)" ::: "memory")

struct TDesc { const float* src; unsigned char* dst; int N, K, k0, n0, kind, f8; };
__device__ __forceinline__ void t64_load(const TDesc& d, float (&v)[64], int lane) {
    const float* src = d.src + (size_t)d.k0 * d.N + d.n0 + lane;
#pragma unroll
    for (int kk = 0; kk < 64; ++kk) v[kk] = src[(size_t)kk * d.N];
}
__device__ __forceinline__ void t64_finish(const TDesc& d, const float (&v)[64], LAS unsigned char* scr, int lane) {
    if (d.f8) {
        LAS unsigned char* wp = scr + lane * 80;
#pragma unroll
        for (int q = 0; q < 4; ++q) { u32x4 o;
            o.x = pk4_fp8(64.f * v[16 * q + 0], 64.f * v[16 * q + 1], 64.f * v[16 * q + 2], 64.f * v[16 * q + 3]);
            o.y = pk4_fp8(64.f * v[16 * q + 4], 64.f * v[16 * q + 5], 64.f * v[16 * q + 6], 64.f * v[16 * q + 7]);
            o.z = pk4_fp8(64.f * v[16 * q + 8], 64.f * v[16 * q + 9], 64.f * v[16 * q + 10], 64.f * v[16 * q + 11]);
            o.w = pk4_fp8(64.f * v[16 * q + 12], 64.f * v[16 * q + 13], 64.f * v[16 * q + 14], 64.f * v[16 * q + 15]);
            *(LAS u32x4*)(wp + q * 16) = o; }
        LDS_WAIT(); asm volatile("" ::: "memory");
        const int c = lane & 3;
#pragma unroll
        for (int j = 0; j < 4; ++j) { const int nl = (lane >> 2) + 16 * j; const u32x4 o = *(const LAS u32x4*)(scr + nl * 80 + c * 16);
            const int n = d.n0 + nl; int dr = n;
            if (d.kind == 1) { dr = (n < 1024) ? ((n >> 7) * 256 + (n & 127)) : (((n - 1024) >> 7) * 256 + 128 + (n & 127)); }
            *(u32x4*)(d.dst + (size_t)dr * d.K + d.k0 + c * 16) = o; }
    } else {
        LAS unsigned char* wp = scr + lane * 144;
#pragma unroll
        for (int q = 0; q < 8; ++q) { u32x4 o;
            o.x = cvt_pk_bf16(v[8 * q + 0], v[8 * q + 1]); o.y = cvt_pk_bf16(v[8 * q + 2], v[8 * q + 3]); o.z = cvt_pk_bf16(v[8 * q + 4], v[8 * q + 5]); o.w = cvt_pk_bf16(v[8 * q + 6], v[8 * q + 7]);
            *(LAS u32x4*)(wp + q * 16) = o; }
        LDS_WAIT(); asm volatile("" ::: "memory");
        const int c = lane & 7;
#pragma unroll
        for (int j = 0; j < 8; ++j) { const int nl = (lane >> 3) + 8 * j; const u32x4 o = *(const LAS u32x4*)(scr + nl * 144 + c * 16);
            *(u32x4*)(d.dst + ((size_t)(d.n0 + nl) * d.K + d.k0) * 2 + c * 16) = o; }
    }
    LDS_WAIT(); asm volatile("" ::: "memory");
}
__device__ __forceinline__ TDesc t64_decode(const float* const* in, unsigned char* ws, int it) {
    TDesc d; int r = it, item, nblk;
    if (r < 32768) { const int m = r >> 9; item = r & 511; d.src = in[23] + (size_t)m * 1024 * 2048; d.dst = ws + WS_WGU + (size_t)m * 2048 * 1024; d.N = 2048; d.K = 1024; d.kind = 1; d.f8 = 1; }
    else if ((r -= 32768) < 16384) { const int m = r >> 8; item = r & 255; d.src = in[25] + (size_t)m * 1024 * 1024; d.dst = ws + WS_WDN + (size_t)m * 1024 * 1024; d.N = 1024; d.K = 1024; d.kind = 0; d.f8 = 1; }
    else if ((r -= 16384) < 2176) { const int m = r / 1088; item = r % 1088; d.src = in[12] + (size_t)m * 1024 * INW; d.dst = ws + WS_WIN + (size_t)m * INW * 1024 * 2; d.N = INW; d.K = 1024; d.kind = 0; d.f8 = 0; }
    else if ((r -= 2176) < 2176) { const int m = r / 1088; item = r % 1088; d.src = in[12] + (size_t)m * 1024 * INW; d.dst = ws + WS_WIN8 + (size_t)m * INW * 1024; d.N = INW; d.K = 1024; d.kind = 0; d.f8 = 1; }
    else if ((r -= 2176) < 512) { const int m = r >> 8; item = r & 255; d.src = in[18] + (size_t)m * 1024 * 1024; d.dst = ws + WS_WO + (size_t)m * 1024 * 1024; d.N = 1024; d.K = 1024; d.kind = 0; d.f8 = 1; }
    else if ((r -= 512) < 256) { const int m = r >> 7; item = r & 127; d.src = in[16] + (size_t)m * 512 * 1024; d.dst = ws + WS_WOA + (size_t)m * 1024 * 512; d.N = 1024; d.K = 512; d.kind = 0; d.f8 = 1; }
    else { r -= 256; const int m = r >> 7; item = r & 127; d.src = in[17] + (size_t)m * 512 * 1024; d.dst = ws + WS_WOB + (size_t)m * 1024 * 512; d.N = 1024; d.K = 512; d.kind = 0; d.f8 = 1; }
    nblk = d.N >> 6; const int kb = item / nblk; d.k0 = kb * 64; d.n0 = (item - kb * nblk) * 64;
    return d;
}

__device__ __forceinline__ int rel_bucket(int rel) {
    const int n = rel < 0 ? -rel : rel;
    int v;
    if (n < 8) v = n;
    else { const float nf = (float)n; int large = 8 + (int)(logf(nf / 8.0f) / 2.7725887298583984f * 8.0f); v = large < 15 ? large : 15; }
    return (rel > 0 ? 16 : 0) + v;
}

__device__ __forceinline__ void phase0a(Ctx& F) {
    LAS float* scr = (LAS float*)(F.lds + F.wave * 16384);
    const int gw = F.bx * NWAVES + F.wave, NGW = F.G * NWAVES;
    unsigned char* ws = F.ws;
    {
        float* modp = (float*)(ws + WS_MODP);
        for (int it = gw; it < 2 * 96 * 8; it += NGW) {
            const int kc = it & 7, cgp = (it >> 3) % 96, l = it / (8 * 96), k0 = kc * 128, n0 = cgp * 64;
#pragma unroll 4
            for (int j = 0; j < 32; ++j) { const int idx = F.lane + 64 * j, r = idx >> 7, kk = idx & 127;
                const float c = r < 8 ? F.in[2][r * 1024 + k0 + kk] : F.in[3][(r - 8) * 1024 + k0 + kk];
                scr[kk * 16 + r] = c * sigmoidf_(c); }
            LDS_WAIT(); asm volatile("" ::: "memory");
            float a[16];
#pragma unroll
            for (int r = 0; r < 16; ++r) a[r] = 0.f;
            const float* wp = F.in[10] + ((size_t)l * 1024 + k0) * 6144 + n0 + F.lane;
#pragma unroll 16
            for (int kk = 0; kk < 128; ++kk) {
                const float w = wp[(size_t)kk * 6144];
                const LAS f32x4* sp = (const LAS f32x4*)(scr + kk * 16);
                const f32x4 s0 = sp[0], s1 = sp[1], s2 = sp[2], s3 = sp[3];
                a[0] += s0[0] * w; a[1] += s0[1] * w; a[2] += s0[2] * w; a[3] += s0[3] * w;
                a[4] += s1[0] * w; a[5] += s1[1] * w; a[6] += s1[2] * w; a[7] += s1[3] * w;
                a[8] += s2[0] * w; a[9] += s2[1] * w; a[10] += s2[2] * w; a[11] += s2[3] * w;
                a[12] += s3[0] * w; a[13] += s3[1] * w; a[14] += s3[2] * w; a[15] += s3[3] * w;
            }
            const float bb = (kc == 0) ? F.in[11][l * 6144 + n0 + F.lane] : 0.f;
#pragma unroll
            for (int r = 0; r < 16; ++r) modp[(size_t)kc * (2 * 16 * 6144) + ((size_t)(l * 16 + r)) * 6144 + n0 + F.lane] = a[r] + bb;
            LDS_WAIT(); asm volatile("" ::: "memory");
        }
    }
    if (F.bx == 0) {
        float* bt = (float*)(ws + WS_BIAS);
        for (int i = F.tid; i < 8 * 256; i += NTHREADS) { const int h = i >> 8, ri = i & 255; const int rel = ri - 191;
            bt[i] = (ri < 255) ? F.in[7][rel_bucket(rel) * 8 + h] : 0.f; }
    }
    for (int i = F.bx * NTHREADS + F.tid; i < 2 * 8 * 64 * 128; i += F.G * NTHREADS) {
        const int lb = i >> 13, rem = i & 8191;
        F.out[OKS + (size_t)lb * 16384 + rem] = F.in[4][(size_t)lb * 16384 + 8192 + rem];
        F.out[OVS + (size_t)lb * 16384 + rem] = F.in[5][(size_t)lb * 16384 + 8192 + rem];
    }
    LAS unsigned char* scrb = F.lds + F.wave * 16384;
    constexpr int NITEMS = 32768 + 16384 + 2176 + 2176 + 512 + 256 + 256;
    {
        float va[64], vb[64]; TDesc da, db;
        int it = gw;
        if (it < NITEMS) { da = t64_decode(F.in, ws, it); t64_load(da, va, F.lane); }
        while (it < NITEMS) {
            int itn = it + NGW;
            if (itn < NITEMS) { db = t64_decode(F.in, ws, itn); t64_load(db, vb, F.lane); }
            t64_finish(da, va, scrb, F.lane);
            it = itn; if (it >= NITEMS) break;
            itn = it + NGW;
            if (itn < NITEMS) { da = t64_decode(F.in, ws, itn); t64_load(da, va, F.lane); }
            t64_finish(db, vb, scrb, F.lane);
            it = itn;
        }
    }
}

__device__ __forceinline__ void ln_row(f32x4 (&v)[4], const float* g, const float* b, int lane) {
    float s = 0.f;
#pragma unroll
    for (int j = 0; j < 4; ++j) s += (v[j][0] + v[j][1]) + (v[j][2] + v[j][3]);
    const float mean = wave_sum(s) * (1.0f / D); float s2 = 0.f;
#pragma unroll
    for (int j = 0; j < 4; ++j) { v[j] = v[j] - mean; s2 += (v[j][0] * v[j][0] + v[j][1] * v[j][1]) + (v[j][2] * v[j][2] + v[j][3] * v[j][3]); }
    const float rstd = 1.0f / sqrtf(wave_sum(s2) * (1.0f / D) + LN_EPS);
#pragma unroll
    for (int j = 0; j < 4; ++j) { const f32x4 gg = *(const f32x4*)(g + 4 * lane + 256 * j), bb = *(const f32x4*)(b + 4 * lane + 256 * j); v[j] = v[j] * rstd * gg + bb; }
}
__device__ __forceinline__ void store_mod_row(const f32x4 (&v)[4], const float* sh, const float* sc, bf16_t* hrow, unsigned char* h8row, int lane) {
#pragma unroll
    for (int j = 0; j < 4; ++j) { const f32x4 a = *(const f32x4*)(sc + 4 * lane + 256 * j), b = *(const f32x4*)(sh + 4 * lane + 256 * j);
        const f32x4 h = v[j] * (a + 1.0f) + b; u32x2 w; w.x = cvt_pk_bf16(h[0], h[1]); w.y = cvt_pk_bf16(h[2], h[3]);
        *(u32x2*)(hrow + 4 * lane + 256 * j) = w;
        *(unsigned*)(h8row + 4 * lane + 256 * j) = pk4_fp8(h[0], h[1], h[2], h[3]); }
}

__device__ __forceinline__ void phase0b(Ctx& F) {
    const int gw = F.bx * NWAVES + F.wave, NGW = F.G * NWAVES;
    const float* mod = (const float*)(F.ws + WS_MOD);
    bf16_t* H = (bf16_t*)(F.ws + WS_H);
    for (int row = gw; row < NT; row += NGW) {
        const float* xr = row < NPROMPT ? F.in[0] + (size_t)row * D : F.in[1] + (size_t)(row - NPROMPT) * D;
        f32x4 v[4];
#pragma unroll
        for (int j = 0; j < 4; ++j) v[j] = *(const f32x4*)(xr + 4 * F.lane + 256 * j);
        ln_row(v, F.in[8], F.in[9], F.lane);
#pragma unroll
        for (int j = 0; j < 4; ++j) { u32x2 w; w.x = cvt_pk_bf16(v[j][0], v[j][1]); w.y = cvt_pk_bf16(v[j][2], v[j][3]); *(u32x2*)((bf16_t*)(F.ws + WS_XB) + (size_t)row * D + 4 * F.lane + 256 * j) = w; }
        const float* mb = mod + (size_t)batch_of(row) * 6144;
        store_mod_row(v, mb, mb + 1024, H + (size_t)row * D, F.ws + WS_H8 + (size_t)row * D, F.lane);
    }
}

__device__ __forceinline__ void phase_attn(Ctx& F, int l) {
    const bf16_t* Z = (const bf16_t*)(F.ws + WS_Z);
    unsigned char* YA = F.ws + WS_YA;
    unsigned char* YB = F.ws + WS_YB;
    const float* biasr = (const float*)(F.ws + WS_BIAS);
    LAS unsigned char* Ks = F.lds;
    LAS unsigned char* Vt = F.lds + 27648;
    LAS float* bt = (LAS float*)(F.lds + 53248);
    const int lane = F.lane, tid = F.tid;
    int bt_kv = -1;
    for (int au = F.bx; au < 1040; au += F.G) {
        const bool isS = au >= 1024;
        const int kv = au & 1;
        const int b = isS ? ((au - 1024) >> 1) : (au >> 7);
        const int n = isS ? 0 : ((au & 127) >> 1);
        __syncthreads();
        if (kv != bt_kv) { for (int i = tid; i < 1024; i += NTHREADS) bt[i] = biasr[(kv * 4 + (i >> 8)) * 256 + (i & 255)]; bt_kv = kv; }
#pragma unroll
        for (int jj = 0; jj < 3; ++jj) {
            const int p = tid + NTHREADS * jj, key = p >> 3, ds = p & 7;
            u32x4 kq = (u32x4){0u, 0u, 0u, 0u}, vq = (u32x4){0u, 0u, 0u, 0u};
            if (!isS) {
                const int t = n * 64 + key - 128;
                if (t >= 0) { const bf16_t* zr = Z + (size_t)(b * 4096 + t) * INW + kv * 64 + ds * 8; kq = *(const u32x4*)(zr + 512); vq = *(const u32x4*)(zr + 640); }
            } else if (key < 128) {
                const size_t o = ((size_t)((l * 8 + b) * 128 + key) * 2 + kv) * 64 + ds * 8;
                const f32x4 k0 = *(const f32x4*)(F.in[4] + o), k1 = *(const f32x4*)(F.in[4] + o + 4), v0 = *(const f32x4*)(F.in[5] + o), v1 = *(const f32x4*)(F.in[5] + o + 4);
                kq.x = cvt_pk_bf16(k0[0], k0[1]); kq.y = cvt_pk_bf16(k0[2], k0[3]); kq.z = cvt_pk_bf16(k1[0], k1[1]); kq.w = cvt_pk_bf16(k1[2], k1[3]);
                vq.x = cvt_pk_bf16(v0[0], v0[1]); vq.y = cvt_pk_bf16(v0[2], v0[3]); vq.z = cvt_pk_bf16(v1[0], v1[1]); vq.w = cvt_pk_bf16(v1[2], v1[3]);
            } else {
                const bf16_t* zr = Z + (size_t)(NPROMPT + b * 64 + key - 128) * INW + kv * 64 + ds * 8; kq = *(const u32x4*)(zr + 512); vq = *(const u32x4*)(zr + 640);
            }
            *(LAS u32x4*)(Ks + key * 144 + ds * 16) = kq;
            LAS unsigned short* vp = (LAS unsigned short*)Vt + (ds * 8) * 200 + key;
            vp[0 * 200] = (unsigned short)(vq.x & 0xffffu); vp[1 * 200] = (unsigned short)(vq.x >> 16);
            vp[2 * 200] = (unsigned short)(vq.y & 0xffffu); vp[3 * 200] = (unsigned short)(vq.y >> 16);
            vp[4 * 200] = (unsigned short)(vq.z & 0xffffu); vp[5 * 200] = (unsigned short)(vq.z >> 16);
            vp[6 * 200] = (unsigned short)(vq.w & 0xffffu); vp[7 * 200] = (unsigned short)(vq.w >> 16);
        }
        __syncthreads();
        const int g = F.wave >> 1, qi = (F.wave & 1) * 32 + (lane & 31), hh = lane >> 5, head = kv * 4 + g;
        const int qrow = isS ? NPROMPT + b * 64 + qi : b * 4096 + n * 64 + qi;
        bf16x8 Qf[4];
#pragma unroll
        for (int ks = 0; ks < 4; ++ks) Qf[ks] = *(const bf16x8*)(Z + (size_t)qrow * INW + head * 64 + ks * 16 + hh * 8);
        f32x16 S[6];
#pragma unroll
        for (int kb = 0; kb < 6; ++kb) {
#pragma unroll
            for (int j = 0; j < 16; ++j) S[kb][j] = 0.f;
#pragma unroll
            for (int ks = 0; ks < 4; ++ks) {
                const bf16x8 A = *(const LAS bf16x8*)(Ks + (kb * 32 + (lane & 31)) * 144 + (ks * 16 + hh * 8) * 2);
                S[kb] = __builtin_amdgcn_mfma_f32_32x32x16_bf16(A, Qf[ks], S[kb], 0, 0, 0);
            }
        }
        const float sinkv = F.in[14][l * 8 + head];
        float mx = sinkv;
        const int kmin = isS ? 0 : (128 - n * 64);
#pragma unroll
        for (int kb = 0; kb < 6; ++kb)
#pragma unroll
            for (int j = 0; j < 16; ++j) {
                const int key = kb * 32 + 8 * (j >> 2) + 4 * hh + (j & 3);
                float sv = S[kb][j] * 0.125f + bt[g * 256 + key - qi + 63];
                sv = key >= kmin ? sv : -1e30f;
                S[kb][j] = sv; mx = fmaxf(mx, sv);
            }
        mx = fmaxf(mx, __shfl_xor(mx, 32));
        float sum = 0.f;
#pragma unroll
        for (int kb = 0; kb < 6; ++kb)
#pragma unroll
            for (int j = 0; j < 16; ++j) { const float p = __expf(S[kb][j] - mx); S[kb][j] = p; sum += p; }
        sum += __shfl_xor(sum, 32);
        sum += __expf(sinkv - mx);
        const float inv = 1.0f / sum;
        f32x16 O[2];
#pragma unroll
        for (int db = 0; db < 2; ++db)
#pragma unroll
            for (int j = 0; j < 16; ++j) O[db][j] = 0.f;
#pragma unroll
        for (int kb = 0; kb < 6; ++kb)
#pragma unroll
            for (int s2 = 0; s2 < 2; ++s2) {
                union { bf16x8 v; unsigned u[4]; } P;
#pragma unroll
                for (int q = 0; q < 4; ++q) P.u[q] = cvt_pk_bf16(S[kb][8 * s2 + 2 * q], S[kb][8 * s2 + 2 * q + 1]);
#pragma unroll
                for (int db = 0; db < 2; ++db) {
                    const LAS unsigned char* vb = Vt + (db * 32 + (lane & 31)) * 400 + (kb * 32 + 16 * s2 + 4 * hh) * 2;
                    union { bf16x8 v; u32x2 h[2]; } Vf;
                    Vf.h[0] = *(const LAS u32x2*)vb; Vf.h[1] = *(const LAS u32x2*)(vb + 16);
                    O[db] = __builtin_amdgcn_mfma_f32_32x32x16_bf16(Vf.v, P.v, O[db], 0, 0, 0);
                }
            }
        unsigned char* orow = YA + (size_t)qrow * 512 + head * 64 + 4 * hh; const float inv8 = inv * 8.0f;
#pragma unroll
        for (int db = 0; db < 2; ++db)
#pragma unroll
            for (int jq = 0; jq < 4; ++jq) {
                *(unsigned*)(orow + db * 32 + 8 * jq) = pk4_fp8(O[db][4 * jq] * inv8, O[db][4 * jq + 1] * inv8, O[db][4 * jq + 2] * inv8, O[db][4 * jq + 3] * inv8);
            }
    }
    int nxtra = 1040 % F.G; if (1040 < F.G || 2 * nxtra > F.G) nxtra = 0;
    if (F.bx < nxtra) return;
    const int gw = (F.bx - nxtra) * NWAVES + F.wave, NGW = (F.G - nxtra) * NWAVES;
    const float* cw = F.in[15] + (size_t)l * 3 * 512 + 8 * lane;
    float w0[8], w1[8], w2[8];
#pragma unroll
    for (int e = 0; e < 8; ++e) { w0[e] = cw[e]; w1[e] = cw[512 + e]; w2[e] = cw[1024 + e]; }
    for (int row = gw; row < NT; row += NGW) {
        const bool isS = row >= NPROMPT; const int b = isS ? ((row - NPROMPT) >> 6) : (row >> 12), t = isS ? ((row - NPROMPT) & 63) : (row & 4095);
        const bf16_t* zr = Z + (size_t)row * INW + 8 * lane;
        const u32x4 cb = *(const u32x4*)(zr + 768);
        float u[3][8];
#pragma unroll
        for (int d = 0; d < 3; ++d) {
            if (t - d >= 0) {
                const bf16_t* zz = zr - (size_t)d * INW; const u32x4 cc = *(const u32x4*)(zz + 1280), cx = *(const u32x4*)(zz + 1792);
                u[d][0] = bf_lo(cc.x) * bf_lo(cx.x); u[d][1] = bf_hi(cc.x) * bf_hi(cx.x); u[d][2] = bf_lo(cc.y) * bf_lo(cx.y); u[d][3] = bf_hi(cc.y) * bf_hi(cx.y);
                u[d][4] = bf_lo(cc.z) * bf_lo(cx.z); u[d][5] = bf_hi(cc.z) * bf_hi(cx.z); u[d][6] = bf_lo(cc.w) * bf_lo(cx.w); u[d][7] = bf_hi(cc.w) * bf_hi(cx.w);
            } else if (isS) {
                const float* hp = F.in[6] + ((size_t)(l * 8 + b) * 2 + (2 + t - d)) * 512 + 8 * lane;
                const f32x4 h0 = *(const f32x4*)hp, h1 = *(const f32x4*)(hp + 4);
#pragma unroll
                for (int e = 0; e < 4; ++e) { u[d][e] = h0[e]; u[d][4 + e] = h1[e]; }
            } else {
#pragma unroll
                for (int e = 0; e < 8; ++e) u[d][e] = 0.f;
            }
        }
        const float cbf[8] = {bf_lo(cb.x), bf_hi(cb.x), bf_lo(cb.y), bf_hi(cb.y), bf_lo(cb.z), bf_hi(cb.z), bf_lo(cb.w), bf_hi(cb.w)};
        float y[8];
#pragma unroll
        for (int e = 0; e < 8; ++e) y[e] = cbf[e] * (w0[e] * u[2][e] + w1[e] * u[1][e] + w2[e] * u[0][e]);
        u32x2 w; w.x = pk4_fp8(y[0], y[1], y[2], y[3]); w.y = pk4_fp8(y[4], y[5], y[6], y[7]);
        *(u32x2*)(YB + (size_t)row * 512 + 8 * lane) = w;
        const int tl = isS ? 62 : 4094;
        if (t >= tl) {
            float* o = F.out + (isS ? OCS : OCP) + ((size_t)(l * 8 + b) * 2 + (t - tl)) * 512 + 8 * lane;
            *(f32x4*)o = (f32x4){u[0][0], u[0][1], u[0][2], u[0][3]}; *(f32x4*)(o + 4) = (f32x4){u[0][4], u[0][5], u[0][6], u[0][7]};
        }
    }
}

__device__ __forceinline__ void phase_ln_router(Ctx& F, int l) {
    bf16_t* XB = (bf16_t*)(F.ws + WS_XB); unsigned char* H8 = (unsigned char*)(F.ws + WS_H8); const bf16_t* V16 = (const bf16_t*)(F.ws + WS_V16);
    const float* mod = (const float*)(F.ws + WS_MOD) + (size_t)l * 16 * 6144;
    unsigned* cnt = (unsigned*)(F.ws + WS_CNT) + l * 2048;
    unsigned* tok = (unsigned*)(F.ws + WS_TOK); float* gate = (float*)(F.ws + WS_GATE); unsigned* slot = (unsigned*)(F.ws + WS_SLOT);
    const float* Wr = F.in[21] + (size_t)l * 1024 * 32;
    LAS float* hf = (LAS float*)F.lds;
    LAS unsigned* hist = (LAS unsigned*)(F.lds + 139264); LAS unsigned* hbase = hist + 32;
    const int lane = F.lane, w = F.wave;
    float breg[64];
    { const float* bp = Wr + (size_t)(128 * w) * 32 + lane;
#pragma unroll
      for (int s = 0; s < 64; ++s) breg[s] = bp[64 * s]; }
    for (int tidx = F.bx; tidx < 1024 + 256; tidx += F.G) {
        const int tile0 = tidx < 1024 ? tidx * 32 : NPROMPT + (tidx - 1024) * 2, nrows = tidx < 1024 ? 32 : 2;
        __syncthreads();
        if (F.tid < 32) hist[F.tid] = 0u;
        if (w * 4 < nrows) {
            u32x2 pv[4][4];
#pragma unroll
            for (int rr = 0; rr < 4; ++rr) { const int rl = w * 4 + rr, row = rl < nrows ? tile0 + rl : tile0;
#pragma unroll
                for (int j = 0; j < 4; ++j) pv[rr][j] = *(const u32x2*)(V16 + (size_t)row * D + 4 * lane + 256 * j); }
#pragma unroll
            for (int rr = 0; rr < 4; ++rr) {
                const int rl = w * 4 + rr, row = tile0 + rl;
                if (rl < nrows) {
                    f32x4 v[4];
#pragma unroll
                    for (int j = 0; j < 4; ++j) v[j] = (f32x4){bf_lo(pv[rr][j].x), bf_hi(pv[rr][j].x), bf_lo(pv[rr][j].y), bf_hi(pv[rr][j].y)};
                    ln_row(v, F.in[19] + l * D, F.in[20] + l * D, lane);
#pragma unroll
                    for (int j = 0; j < 4; ++j) { u32x2 wq; wq.x = cvt_pk_bf16(v[j][0], v[j][1]); wq.y = cvt_pk_bf16(v[j][2], v[j][3]); *(u32x2*)(XB + (size_t)row * D + 4 * lane + 256 * j) = wq; }
                    const float* mb = mod + (size_t)batch_of(row) * 6144;
#pragma unroll
                    for (int j = 0; j < 4; ++j) { const f32x4 a = *(const f32x4*)(mb + 4096 + 4 * lane + 256 * j), b = *(const f32x4*)(mb + 3072 + 4 * lane + 256 * j);
                        const f32x4 h = v[j] * (a + 1.0f) + b;
                        *(unsigned*)(H8 + (size_t)row * D + 4 * lane + 256 * j) = pk4_fp8(h[0], h[1], h[2], h[3]);
                        LAS float* hp = hf + rl * 1025 + lane + 64 * j;
                        hp[0] = h[0]; hp[256] = h[1]; hp[512] = h[2]; hp[768] = h[3]; }
                }
            }
        }
        __syncthreads();
        f32x16 acc;
#pragma unroll
        for (int j = 0; j < 16; ++j) acc[j] = 0.f;
        {
            const LAS float* ap = hf + (lane & 31) * 1025 + 32 * w;
            const int hh = lane >> 5;
#pragma unroll
            for (int s = 0; s < 64; ++s) { const int kk = 2 * s + hh; acc = __builtin_amdgcn_mfma_f32_32x32x2f32(ap[(kk & 3) * 256 + (kk >> 2)], breg[s], acc, 0, 0, 0); }
        }
        __syncthreads();
        LAS float* red = hf;
#pragma unroll
        for (int j = 0; j < 16; ++j) red[(w * 32 + 8 * (j >> 2) + 4 * (lane >> 5) + (j & 3)) * 33 + (lane & 31)] = acc[j];
        __syncthreads();
        int e_sel[4]; float g_sel[4]; unsigned loc[4];
#pragma unroll
        for (int rr = 0; rr < 4; ++rr) {
            const int tk = w * 4 + rr;
            float val = -INFINITY;
            if (lane < 32) { float sacc = F.in[22][l * 32 + lane];
#pragma unroll
                for (int ww = 0; ww < 8; ++ww) sacc += red[(ww * 32 + tk) * 33 + lane];
                val = sacc; }
            float tv[4]; int te[4];
            {
                const int vbits = __float_as_int(val); int rank = 0;
#pragma unroll
                for (int j = 0; j < 32; ++j) { const float vj = __int_as_float(__builtin_amdgcn_readlane(vbits, j)); rank += (vj > val || (vj == val && j < lane)) ? 1 : 0; }
#pragma unroll
                for (int it = 0; it < 4; ++it) { const unsigned long long mk = __ballot(rank == it); const int ln = mk ? (__ffsll((long long)mk) - 1) : 0;
                    te[it] = ln; tv[it] = __int_as_float(__builtin_amdgcn_readlane(vbits, ln)); }
            }
            const float e1 = __expf(tv[1] - tv[0]), e2 = __expf(tv[2] - tv[0]), e3 = __expf(tv[3] - tv[0]);
            const float rs = 1.0f / (1.0f + e1 + e2 + e3);
            e_sel[rr] = lane == 0 ? te[0] : lane == 1 ? te[1] : lane == 2 ? te[2] : te[3];
            g_sel[rr] = (lane == 0 ? 1.0f : lane == 1 ? e1 : lane == 2 ? e2 : e3) * rs;
            loc[rr] = 0u;
            if (lane < 4 && tk < nrows) loc[rr] = atomicAdd((unsigned*)&hist[e_sel[rr]], 1u);
        }
        __syncthreads();
        if (F.tid < 32) { const unsigned hcount = hist[F.tid]; hbase[F.tid] = hcount ? atomicAdd(cnt + F.tid * 64, hcount) : 0u; }
        __syncthreads();
        if (lane < 4) {
#pragma unroll
            for (int rr = 0; rr < 4; ++rr) {
                const int row = tile0 + w * 4 + rr, e = e_sel[rr] & 31; const unsigned rank = hbase[e] + loc[rr];
                if (w * 4 + rr < nrows) { tok[(size_t)e * NT + rank] = (unsigned)row; gate[(size_t)e * NT + rank] = g_sel[rr]; slot[(size_t)row * 4 + lane] = ((unsigned)e << 24) | rank; }
            }
        }
    }
}

__device__ __forceinline__ void build_blk(Ctx& F, int l) {
    LAS int* blk = (LAS int*)(F.lds + LDS_BLK);
    const unsigned* cnt = (const unsigned*)(F.ws + WS_CNT) + l * 2048;
    __syncthreads();
    if (F.tid == 0) { int s = 0; for (int e = 0; e < 32; ++e) { blk[e] = s; s += ((int)cnt[e * 64] + 255) >> 8; } blk[32] = s; }
    __syncthreads();
}

__device__ __forceinline__ void phase_combine(Ctx& F, int l) {
    const LAS int* blk = (const LAS int*)(F.lds + LDS_BLK);
    float* X = F.out; bf16_t* XB = (bf16_t*)(F.ws + WS_XB); bf16_t* H = (bf16_t*)(F.ws + WS_H); const unsigned char* YS = F.ws + WS_YS;
    const unsigned* slot = (const unsigned*)(F.ws + WS_SLOT);
    const float* mod = (const float*)(F.ws + WS_MOD);
    const int gw = F.bx * NWAVES + F.wave, NGW = F.G * NWAVES, lane = F.lane;
    for (int row = gw; row < NT; row += NGW) {
        f32x4 ff[4];
#pragma unroll
        for (int j = 0; j < 4; ++j) ff[j] = (f32x4){0.f, 0.f, 0.f, 0.f};
#pragma unroll
        for (int k = 0; k < 4; ++k) {
            const unsigned s = slot[(size_t)row * 4 + k]; const int e = (int)(s >> 24), rank = (int)(s & 0xffffffu);
            const unsigned char* yr = YS + ((size_t)blk[e] * 256 + rank) * D + 4 * lane;
#pragma unroll
            for (int j = 0; j < 4; ++j) { const unsigned wv = *(const unsigned*)(yr + 256 * j); const f32x2 lo = __builtin_amdgcn_cvt_pk_f32_fp8(wv, false), hi = __builtin_amdgcn_cvt_pk_f32_fp8(wv, true);
                ff[j][0] += lo.x; ff[j][1] += lo.y; ff[j][2] += hi.x; ff[j][3] += hi.y; }
        }
        const int bi = batch_of(row);
        const float* mb = mod + (size_t)(l * 16 + bi) * 6144;
        f32x4 v[4];
#pragma unroll
        for (int j = 0; j < 4; ++j) { const u32x2 xw = *(const u32x2*)(XB + (size_t)row * D + 4 * lane + 256 * j); const f32x4 x = (f32x4){bf_lo(xw.x), bf_hi(xw.x), bf_lo(xw.y), bf_hi(xw.y)}, g2 = *(const f32x4*)(mb + 5120 + 4 * lane + 256 * j);
            v[j] = x * ALPHA + (g2 + 1.0f) * (ff[j] * 0.0625f); }
        ln_row(v, F.in[27] + l * D, F.in[28] + l * D, lane);
#pragma unroll
        for (int j = 0; j < 4; ++j) { if (l == 0) { u32x2 w; w.x = cvt_pk_bf16(v[j][0], v[j][1]); w.y = cvt_pk_bf16(v[j][2], v[j][3]); *(u32x2*)(XB + (size_t)row * D + 4 * lane + 256 * j) = w; }
            else *(f32x4*)(X + (size_t)row * D + 4 * lane + 256 * j) = v[j]; }
        if (l == 0) { const float* mn = mod + (size_t)(16 + bi) * 6144; store_mod_row(v, mn, mn + 1024, H + (size_t)row * D, F.ws + WS_H8 + (size_t)row * D, lane); }
    }
}

#ifndef PH_MASK
#define PH_MASK 0xFFFF
#endif
#define PH(b) ((PH_MASK >> (b)) & 1)
#ifndef PROBE_MASK
#define PROBE_MASK 0
#endif
#define PB0(id) do { if ((PROBE_MASK >> (id)) & 1) pb_t0 = __builtin_amdgcn_s_memrealtime(); } while (0)
#define PB1(id) do { if ((PROBE_MASK >> (id)) & 1) pb_acc += __builtin_amdgcn_s_memrealtime() - pb_t0; } while (0)
#define RELOAD() do { int t_ = threadIdx.x; asm volatile("" : "+v"(t_)); F.tid = t_; F.lane = t_ & 63; F.wave = __builtin_amdgcn_readfirstlane(t_ >> 6); \
    unsigned z_; asm volatile("s_mov_b32 %0, 0" : "=s"(z_)); F.in = p.in; F.out = p.out + z_; F.ws = p.ws + z_; } while (0)
#define LAYER_BODY(l) do { \
          \
        PB0(2); RELOAD(); \
        if (PH(2)) { \
              \
            pg8::SchedDense S; S.init(NT, 7 * 256, D, F.G, F.bx, (const bf16_t*)(F.ws + WS_WIN) + (size_t)l * INW * D, 2); \
            pg8::EpiZ E{(bf16_t*)(F.ws + WS_Z), F.in[13] + l * INW, F.out, l, F.ws + WS_ZG8}; \
            pg8::gemm_phase<false, 0u>(F.lds, (const char*)(F.ws + WS_H), D, S, E); \
        } \
        RELOAD(); \
        if (PH(2)) { \
              \
            pg8::SchedDense S; S.init(NT, 10 * 256, 512, F.G, (F.G == 256) ? ((F.bx + 112) & 255) : F.bx, F.ws + WS_WIN8 + (size_t)l * INW * D, 0, 2, 7); \
            pg8::EpiZ E{(bf16_t*)(F.ws + WS_Z), F.in[13] + l * INW, F.out, l, F.ws + WS_ZG8}; \
            pg8::gemm_phase<true, 0x7f7f7f7fu>(F.lds, (const char*)(F.ws + WS_H8), 512, S, E); \
        } \
        xcd_barrier(xbar); PB1(2); PB0(3); \
        RELOAD(); \
        if (PH(3)) phase_attn(F, l); \
        xcd_barrier(xbar); PB1(3); PB0(4); \
          \
        RELOAD(); \
        if (PH(4)) { \
            pg8::SchedDense S; S.init(NT, D, 256, F.G, F.bx, F.ws + WS_WOA + (size_t)l * D * 512); \
            pg8::EpiT1 E{F.ws + WS_T1, F.ws + WS_ZG8}; \
            pg8::gemm_phase<true, 0x7c7c7c7cu>(F.lds, (const char*)(F.ws + WS_YA), 256, S, E); \
        } \
        RELOAD(); \
        if (PH(5)) { \
            pg8::SchedDense S; S.init(NT, D, 256, F.G, F.bx, F.ws + WS_WOB + (size_t)l * D * 512); \
            pg8::EpiMix E{F.ws + WS_T1, F.ws + WS_ZG8, F.ws + WS_MIX}; \
            pg8::gemm_phase<true, 0x7f7f7f7fu>(F.lds, (const char*)(F.ws + WS_YB), 256, S, E); \
        } \
        xcd_barrier(xbar); PB1(4); PB0(5); \
          \
        RELOAD(); \
        if (PH(6)) { \
            pg8::SchedDense S; S.init(NT, D, 512, F.G, F.bx, F.ws + WS_WO + (size_t)l * D * D); \
            pg8::EpiX E{(const bf16_t*)(F.ws + WS_XB), (bf16_t*)(F.ws + WS_V16), (const float*)(F.ws + WS_MOD) + (size_t)l * 16 * 6144}; \
            pg8::gemm_phase<true, 0x7f7f7f7fu>(F.lds, (const char*)(F.ws + WS_MIX), 512, S, E); \
        } \
        xcd_barrier(xbar); PB1(5); PB0(6); \
        RELOAD(); \
        if (PH(7)) phase_ln_router(F, l); \
        xcd_barrier(xbar); PB1(6); PB0(7); \
          \
        RELOAD(); \
        build_blk(F, l); \
        if (PH(8)) { \
            LAS int* blk = (LAS int*)(F.lds + LDS_BLK); \
            LAS unsigned short* idx = (LAS unsigned short*)(F.lds + LDS_IDX); \
            pg8::SchedMoE<true> S; S.init(blk, idx, 8, 512, F.G, F.bx, (const unsigned char*)(F.ws + WS_WGU) + (size_t)l * 32 * 2048 * D, (size_t)2048 * D); \
            const unsigned* cnt = (const unsigned*)(F.ws + WS_CNT) + l * 2048; const unsigned* tok = (const unsigned*)(F.ws + WS_TOK); \
            for (int i = 0; i < MAXU; ++i) { pg8::Unit u; if (!S.next(i, u)) break; \
                if (F.tid < 256) { int rank = (u.pm - blk[u.e]) * 256 + F.tid; const int ce = (int)cnt[u.e * 64]; rank = rank < ce ? rank : ce - 1; \
                    idx[i * 256 + F.tid] = (unsigned short)tok[(size_t)u.e * NT + rank]; } } \
            __syncthreads(); \
            pg8::EpiAct E{(unsigned char*)(F.ws + WS_ACT), F.in[24] + (size_t)l * 32 * 2048}; \
            pg8::gemm_phase<true, 0x7f7f7f7fu>(F.lds, (const char*)(F.ws + WS_H8), 512, S, E); \
        } \
        xcd_barrier(xbar); PB1(7); PB0(8); \
          \
        RELOAD(); \
        if (PH(9)) { \
            LAS int* blk = (LAS int*)(F.lds + LDS_BLK); \
            LAS unsigned short* idx = (LAS unsigned short*)(F.lds + LDS_IDX); \
            pg8::SchedMoE<false> S; S.init(blk, idx, 4, 512, F.G, F.bx, (const unsigned char*)(F.ws + WS_WDN) + (size_t)l * 32 * D * D, (size_t)D * D); \
            pg8::EpiYs E{F.ws + WS_YS, F.in[26] + (size_t)l * 32 * D, (const float*)(F.ws + WS_GATE), (const unsigned*)(F.ws + WS_CNT) + l * 2048, blk}; \
            pg8::gemm_phase<true, 0x7f7f7f7fu>(F.lds, (const char*)(F.ws + WS_ACT), 512, S, E); \
        } \
        xcd_barrier(xbar); PB1(8); PB0(9); \
        RELOAD(); \
        if (PH(10)) phase_combine(F, l); \
        if (l == 0) xcd_barrier(xbar); \
        PB1(9); \
 \
    } while (0)
__global__ void __launch_bounds__(NTHREADS, 2) fwd_megakernel(Params p) {
    extern __shared__ __attribute__((aligned(16))) unsigned char lds_raw[];
    cg::grid_group grid = cg::this_grid();
    Ctx F;
    F.lds = (LAS unsigned char*)lds_raw;
    F.G = gridDim.x; F.bx = blockIdx.x;
    volatile LAS unsigned* bst = (volatile LAS unsigned*)(F.lds + 147392);
    if (threadIdx.x < 2) bst[threadIdx.x] = 0u;
    __syncthreads();
    const XcdBarrier xbar = xcd_barrier_post((unsigned*)(p.ws + WS_BAR), bst);
    unsigned long long pb_t0 = 0, pb_acc = 0;
    PB0(0); RELOAD();
    if (PH(0)) phase0a(F);
    grid.sync();
    PB1(0); PB0(1); RELOAD();
    { const float* modp = (const float*)(F.ws + WS_MODP); float* mod = (float*)(F.ws + WS_MOD);
      for (int i = F.bx * NTHREADS + F.tid; i < 2 * 16 * 6144; i += F.G * NTHREADS) { float sm = 0.f;
#pragma unroll
          for (int kc = 0; kc < 8; ++kc) sm += modp[(size_t)kc * (2 * 16 * 6144) + i];
          mod[i] = sm; } }
    xcd_barrier(xbar);
    RELOAD();
    if (PH(1)) phase0b(F);
    xcd_barrier(xbar); PB1(1);

    LAYER_BODY(0);
    LAYER_BODY(1);
    if (PROBE_MASK != 0 && blockIdx.x == 0) { const unsigned long long te = __builtin_amdgcn_s_memrealtime(); while (__builtin_amdgcn_s_memrealtime() - te < pb_acc) __builtin_amdgcn_s_sleep(8); }
    (void)pb_t0; (void)pb_acc;
}

extern "C" void kernel_launch(void* const* d_in, const int* in_sizes, int n_in, void* d_out, int out_size, void* d_ws, size_t ws_size, hipStream_t stream) {
    static int grid = 0;
    if (grid == 0) {
        if (n_in != 29 || ws_size < WS_END) { fprintf(stderr, "kernel_launch: unexpected n_in %d / ws_size %zu (need %zu)\n", n_in, ws_size, (size_t)WS_END); grid = -1; return; }
        int dev = 0, cus = 0, per_cu = 0;
        hipGetDevice(&dev);
        hipDeviceGetAttribute(&cus, hipDeviceAttributeMultiprocessorCount, dev);
        if (hipFuncSetAttribute((const void*)fwd_megakernel, hipFuncAttributeMaxDynamicSharedMemorySize, LDS_BYTES) != hipSuccess) { fprintf(stderr, "kernel_launch: hipFuncSetAttribute failed\n"); grid = -1; return; }
        if (hipOccupancyMaxActiveBlocksPerMultiprocessor(&per_cu, (const void*)fwd_megakernel, NTHREADS, LDS_BYTES) != hipSuccess || per_cu < 1) { fprintf(stderr, "kernel_launch: occupancy query says %d blocks per CU\n", per_cu); per_cu = 1; }
        (void)hipGetLastError();
        grid = cus;
        if (grid != 256) fprintf(stderr, "kernel_launch: note: %d CUs (built for 256)\n", grid);
    }
    if (grid < 0) return;
    hipMemsetAsync((char*)d_ws, 0, WS_ZERO_BYTES, stream);
    Params p{};
    for (int i = 0; i < 29; ++i) p.in[i] = (const float*)d_in[i];
    p.out = (float*)d_out; p.ws = (unsigned char*)d_ws;
    void* args[] = {&p};
    hipError_t e = hipLaunchCooperativeKernel((const void*)fwd_megakernel, dim3(grid), dim3(NTHREADS), args, LDS_BYTES, stream);
    if (e != hipSuccess) fprintf(stderr, "kernel_launch: cooperative launch failed: %s (grid %d)\n", hipGetErrorString(e), grid);
}
```

```cpp
#include <hip/hip_runtime.h>
#include <hip/hip_cooperative_groups.h>
#include <cstdio>
#include <cstdint>
namespace cg = cooperative_groups;

#define LAS __attribute__((address_space(3)))
typedef unsigned short bf16_t;
typedef short bf16x8 __attribute__((ext_vector_type(8)));
typedef float f32x4 __attribute__((ext_vector_type(4)));
typedef float f32x16 __attribute__((ext_vector_type(16)));
typedef unsigned u32x4 __attribute__((ext_vector_type(4)));
typedef unsigned u32x2 __attribute__((ext_vector_type(2)));
typedef float f32x2 __attribute__((ext_vector_type(2)));
typedef int i32x4 __attribute__((ext_vector_type(4)));
typedef int i32x8 __attribute__((ext_vector_type(8)));

constexpr int D = 1024, NPROMPT = 32768, NT = 33280, INW = 4352, NEXP = 32;
constexpr float ALPHA = 1.41421356237f, LN_EPS = 1e-5f;
constexpr int NWAVES = 8, NTHREADS = 512;
constexpr int LDS_BYTES = 147456;
constexpr int LDS_BLK = 131072;
constexpr int LDS_IDX = 131072 + 256;
constexpr int MAXU = 20;
constexpr int LDS_BIASBUF = 141568;
constexpr int LDS_CNT = 145664;
constexpr size_t OKP = 34078720, OVP = 34340864, OCP = 34603008, OKS = 34619392, OVS = 34881536, OCS = 35143680;
constexpr size_t MiB = 1u << 20;
constexpr size_t WS_CNT = 0;
constexpr size_t WS_BAR = 16384;
constexpr size_t WS_MOD = 65536;
constexpr size_t WS_MODP = 192 * MiB;
constexpr size_t WS_ZERO_BYTES = 1 * MiB;
constexpr size_t WS_BIAS = 1 * MiB;
constexpr size_t WS_SLOT = 2 * MiB;
constexpr size_t WS_TOK = 3 * MiB;
constexpr size_t WS_GATE = 8 * MiB;
constexpr size_t WS_WIN = 16 * MiB;
constexpr size_t WS_WIN8 = 180 * MiB;
constexpr size_t WS_WOA = 34 * MiB;
constexpr size_t WS_WOB = 36 * MiB;
constexpr size_t WS_WO = 38 * MiB;
constexpr size_t WS_WGU = 48 * MiB;
constexpr size_t WS_WDN = 304 * MiB;
constexpr size_t WS_H = 432 * MiB;
constexpr size_t WS_H8 = 1600 * MiB;
constexpr size_t WS_Z = 498 * MiB;
constexpr size_t WS_YA = 776 * MiB;
constexpr size_t WS_YB = 810 * MiB;
constexpr size_t WS_T1 = 844 * MiB;
constexpr size_t WS_V16 = 910 * MiB;
constexpr size_t WS_XB = 1200 * MiB;
constexpr size_t WS_MIX = 976 * MiB;
constexpr size_t WS_ACT = 1042 * MiB;
constexpr size_t WS_YS = 1320 * MiB;
constexpr size_t WS_ZG8 = 1460 * MiB;
constexpr size_t WS_END = 1634 * MiB;

struct Params { const float* in[29]; float* out; unsigned char* ws; };

__device__ __forceinline__ unsigned cvt_pk_bf16(float lo, float hi) { unsigned r; asm volatile("v_cvt_pk_bf16_f32 %0, %1, %2" : "=v"(r) : "v"(lo), "v"(hi)); return r; }
__device__ __forceinline__ unsigned pk4_fp8(float a, float b, float c, float d) { unsigned w = 0u; w = __builtin_amdgcn_cvt_pk_fp8_f32(a, b, w, false); w = __builtin_amdgcn_cvt_pk_fp8_f32(c, d, w, true); return w; }
__device__ __forceinline__ void unpk8_fp8(const u32x2 w, float (&o)[8]) { const f32x2 a = __builtin_amdgcn_cvt_pk_f32_fp8(w.x, false), b = __builtin_amdgcn_cvt_pk_f32_fp8(w.x, true), c = __builtin_amdgcn_cvt_pk_f32_fp8(w.y, false), d = __builtin_amdgcn_cvt_pk_f32_fp8(w.y, true);
    o[0] = a.x; o[1] = a.y; o[2] = b.x; o[3] = b.y; o[4] = c.x; o[5] = c.y; o[6] = d.x; o[7] = d.y; }
__device__ __forceinline__ float bf_lo(unsigned w) { return __uint_as_float(w << 16); }
__device__ __forceinline__ float bf_hi(unsigned w) { return __uint_as_float(w & 0xffff0000u); }
__device__ __forceinline__ float sigmoidf_(float x) { return __builtin_amdgcn_rcpf(1.0f + __expf(-x)); }
__device__ __forceinline__ float wave_sum(float v) {
#define WS_DPP_ADD(ctrl) v += __int_as_float(__builtin_amdgcn_update_dpp(0, __float_as_int(v), (ctrl), 0xf, 0xf, true))
    WS_DPP_ADD(0xB1);
    WS_DPP_ADD(0x4E);
    WS_DPP_ADD(0x141);
    WS_DPP_ADD(0x140);
#undef WS_DPP_ADD
    const int b = __float_as_int(v);
    const float r0 = __int_as_float(__builtin_amdgcn_readlane(b, 0)), r1 = __int_as_float(__builtin_amdgcn_readlane(b, 16)), r2 = __int_as_float(__builtin_amdgcn_readlane(b, 32)), r3 = __int_as_float(__builtin_amdgcn_readlane(b, 48));
    return (r0 + r1) + (r2 + r3);
}
__device__ __forceinline__ int batch_of(int row) { return row < NPROMPT ? (row >> 12) : 8 + ((row - NPROMPT) >> 6); }

namespace pg8 {
constexpr int BM = 256, BK = 64, HALF = 128, HTB = HALF * BK * 2, NXCD = 8, WGM = 8;
__device__ __forceinline__ int lds_byte(int r, int c) { const int st = (r >> 4) * 2 + (c >> 5), rr = r & 15, cc = c & 31, ob = rr * 64 + cc * 2; return st * 1024 + (ob ^ (((ob >> 9) & 1) << 5)); }
__device__ __forceinline__ void stage_rc(int b, int& R, int& C) { const int st = b / 1024, sb = b % 1024, swz = sb ^ (((sb >> 9) & 1) << 5); R = (st >> 1) * 16 + swz / 64; C = (st & 1) * 32 + (swz % 64) / 2; }
__device__ __forceinline__ int perm32(int rho) { const int n = rho >> 4, i = rho & 15; return 8 * (i >> 2) + 4 * n + (i & 3); }

struct Unit { int pm, pn, e; const char* b; };

struct SchedDense {
    int nM, nN, nwg, G, c, cbase, csplit, cskip; const char* Bt; size_t tstepB;
    __device__ __forceinline__ void init(int M, int N, int K, int G_, int c_, const void* Bt_, int cbase_ = 0, int csplit_ = 1 << 20, int cskip_ = 0) { nM = M / BM; nN = N / BM; nwg = nM * nN; G = G_; c = c_; Bt = (const char*)Bt_; tstepB = (size_t)BM * K * 2; cbase = cbase_; csplit = csplit_; cskip = cskip_; }
    __device__ __forceinline__ bool next(int i, Unit& u) const {
        const long L = (long)i * G + c; if (L >= nwg) return false;
        int wgid = (int)L; { const int q = nwg / NXCD, r = nwg % NXCD, xcd = wgid % NXCD, off = wgid / NXCD; wgid = (xcd < r ? xcd * (q + 1) : r * (q + 1) + (xcd - r) * q) + off; }
        const int nig = WGM * nN, gid = wgid / nig, fm = gid * WGM, gsz = (nM - fm) < WGM ? (nM - fm) : WGM;
        u.pm = fm + ((wgid % nig) % gsz); const int j = (wgid % nig) / gsz; u.pn = j < csplit ? j + cbase : j + cbase + cskip; u.e = 0; u.b = Bt + (size_t)u.pn * tstepB; return true;
    }
    __device__ __forceinline__ unsigned rowidx(int, const Unit& u, int r) const { return (unsigned)(u.pm * BM + r); }
};
template <bool GATHER> struct SchedMoE {
    const LAS int* blk; const LAS unsigned short* idx; int NB, RBX, NPN, NXs, perx, cx, cj; const char* Bt; size_t estep, tstepB;
    __device__ __forceinline__ void init(const LAS int* blk_, const LAS unsigned short* idx_, int NPN_, int K, int G, int c, const void* Bt_, size_t estep_) {
        blk = blk_; idx = idx_; NB = blk_[32]; NPN = NPN_; Bt = (const char*)Bt_; estep = estep_; tstepB = (size_t)BM * K * 2;
        if ((G & 7) == 0) { NXs = 8; perx = G >> 3; cx = c & 7; cj = c >> 3; } else { NXs = 1; perx = G; cx = 0; cj = c; }
        RBX = (NB + NXs - 1) / NXs;
    }
    __device__ __forceinline__ bool next(int i, Unit& u) const {
        const int j = i * perx + cj, rbl = j / NPN; if (rbl >= RBX) return false;
        const int rb = cx * RBX + rbl; if (rb >= NB) return false;
        int e = 0;
        for (int q = 1; q < 32; ++q) e = (blk[q] <= rb) ? q : e;
        u.pm = rb; u.pn = j - rbl * NPN; u.e = e; u.b = Bt + (size_t)e * estep + (size_t)u.pn * tstepB; return true;
    }
    __device__ __forceinline__ unsigned rowidx(int ui, const Unit& u, int r) const { if (GATHER) return (unsigned)idx[ui * 256 + r]; return (unsigned)(u.pm * BM + r); }
};

template <bool FP8, unsigned ASCALE, class Epi, class Sched>
__device__ __forceinline__ void gemm_phase(LAS unsigned char* lds, const char* Abase, const int K, const Sched& S, const Epi& E) {
    int tid_ = threadIdx.x; asm volatile("" : "+v"(tid_));
    const int tid = tid_, wid = __builtin_amdgcn_readfirstlane(tid >> 6), lane = tid & 63, wr = wid >> 2, wc = wid & 3, fr = lane & 15, fq = lane >> 4;
    int nt_ = K / BK; asm volatile("" : "+s"(nt_)); const int nt = nt_;
    unsigned voffB[2]; int RA[2], CA[2];
#pragma unroll
    for (int i = 0; i < 2; ++i) { int R, C; stage_rc(tid * 16 + i * 8192, R, C); const int Rb = Epi::PERM ? ((R & ~31) + perm32(R & 31)) : R;
        voffB[i] = (unsigned)(Rb * K + C) * 2u; RA[i] = R; CA[i] = C * 2; }
    const size_t kstep = (size_t)(BK * 2);
    const size_t hstep = (size_t)HALF * K * 2;
    const unsigned ldsw = (unsigned)wid * 1024u;
    const unsigned rowb = (unsigned)K * 2u;
    const int aoff = lds_byte(wr * 64 + fr, fq * 8), boff = lds_byte(wc * 32 + fr, fq * 8);
#define PG8_SA(b, h) (((b) * 2 + (h)) * HTB)
#define PG8_SB(b, h) ((4 + (b) * 2 + (h)) * HTB)
#define PG8_STAGE(bufoff, gbase, voff) do { _Pragma("unroll") for (int _i = 0; _i < 2; ++_i) \
        __builtin_amdgcn_global_load_lds((const unsigned*)((const char*)(gbase) + (voff)[_i]), (LAS unsigned*)(lds + (bufoff) + ldsw + _i * 8192), 16, 0, 0); } while (0)
#define PG8_LDA(dst, b, h) do { _Pragma("unroll") for (int m = 0; m < 4; ++m) _Pragma("unroll") for (int k = 0; k < 2; ++k) dst[m][k] = *(const LAS bf16x8*)(lds + PG8_SA(b, h) + aoff + m * 2048 + k * 1024); } while (0)
#define PG8_LDB(dst, b, h) do { _Pragma("unroll") for (int n = 0; n < 2; ++n) _Pragma("unroll") for (int k = 0; k < 2; ++k) dst[n][k] = *(const LAS bf16x8*)(lds + PG8_SB(b, h) + boff + n * 2048 + k * 1024); } while (0)
#define PG8_MMA(ai, bj, At, Bt) do { __builtin_amdgcn_s_setprio(1); _Pragma("unroll") for (int m = 0; m < 4; ++m) _Pragma("unroll") for (int n = 0; n < 2; ++n) { \
        if constexpr (FP8) { \
            const i32x8 wf_ = __builtin_shufflevector((i32x4)Bt[n][0], (i32x4)Bt[n][1], 0, 1, 2, 3, 4, 5, 6, 7), af_ = __builtin_shufflevector((i32x4)At[m][0], (i32x4)At[m][1], 0, 1, 2, 3, 4, 5, 6, 7); \
            acc[ai][bj][m][n] = __builtin_amdgcn_mfma_scale_f32_16x16x128_f8f6f4(wf_, af_, acc[ai][bj][m][n], 0, 0, 0, 0x79797979, 0, (int)ASCALE); \
        } else { _Pragma("unroll") for (int k = 0; k < 2; ++k) \
            acc[ai][bj][m][n] = __builtin_amdgcn_mfma_f32_16x16x32_bf16(Bt[n][k], At[m][k], acc[ai][bj][m][n], 0, 0, 0); } } \
        __builtin_amdgcn_s_setprio(0); } while (0)
#define PG8_WAIT_V(n) asm volatile("s_waitcnt vmcnt(" #n ")" ::: "memory")
#define PG8_WAIT_L(n) asm volatile("s_waitcnt lgkmcnt(" #n ")" ::: "memory")
#define PG8_BAR __builtin_amdgcn_s_barrier()
#define PG8_SCHED __builtin_amdgcn_sched_barrier(0)
#define PG8_LOADVA(ui_, u_) do { _Pragma("unroll") for (int _h = 0; _h < 2; ++_h) _Pragma("unroll") for (int _i = 0; _i < 2; ++_i) \
        vA[_h][_i] = S.rowidx((ui_), (u_), _h * HALF + RA[_i]) * rowb + (unsigned)CA[_i]; } while (0)
    Unit cur, nxt; int ui = 0;
    if (!S.next(0, cur)) return;
    f32x4 acc[2][2][4][2];
#pragma unroll
    for (int a = 0; a < 2; ++a)
#pragma unroll
        for (int b = 0; b < 2; ++b)
#pragma unroll
            for (int m = 0; m < 4; ++m)
#pragma unroll
                for (int n = 0; n < 2; ++n) acc[a][b][m][n] = (f32x4){0.f, 0.f, 0.f, 0.f};
    bf16x8 At[4][2], B0[2][2], B1[2][2];
    unsigned vA[2][2];
    PG8_LOADVA(0, cur);
    const char* cB = cur.b;
    if (Epi::BIAS && tid < 64) __builtin_amdgcn_global_load_lds((const unsigned*)E.bias_ptr(cur, tid), (LAS unsigned*)(lds + LDS_BIASBUF), 16, 0, 0);
    if (Epi::EXTRA && tid < 64) __builtin_amdgcn_global_load_lds((const unsigned*)E.extra_ptr(cur, tid), (LAS unsigned*)(lds + LDS_BIASBUF + 1024), 16, 0, 0);
    PG8_STAGE(PG8_SB(0, 0), cB, voffB); PG8_STAGE(PG8_SB(0, 1), cB + hstep, voffB); PG8_STAGE(PG8_SA(0, 0), Abase, vA[0]); PG8_STAGE(PG8_SA(0, 1), Abase, vA[1]);
    if (wr == 1) PG8_BAR;
    PG8_WAIT_V(2); PG8_BAR;
    PG8_STAGE(PG8_SB(1, 0), cB + kstep, voffB); PG8_STAGE(PG8_SA(1, 0), Abase + kstep, vA[0]); PG8_STAGE(PG8_SB(1, 1), cB + hstep + kstep, voffB);
    PG8_WAIT_V(6); PG8_BAR;
    for (;;) {
        const bool has_next = S.next(ui + 1, nxt);
        const char* nB = has_next ? nxt.b : cB;
#pragma unroll 1
        for (int t = 0; t < nt; t += 2) {
            const bool last = (t == nt - 2);
            const char* a1 = Abase + (size_t)(t + 1) * kstep;
            const char* a2 = last ? Abase : Abase + (size_t)(t + 2) * kstep;
            const char* b2 = last ? nB : cB + (size_t)(t + 2) * kstep;
            const char* a3 = a2 + kstep; const char* b3 = b2 + kstep;
            PG8_LDB(B0, 0, 0); PG8_LDB(B1, 0, 1); PG8_SCHED; PG8_LDA(At, 0, 0); PG8_STAGE(PG8_SA(1, 1), a1, vA[1]);
            if (last && has_next) { PG8_LOADVA(ui + 1, nxt);
                if (Epi::BIAS && tid < 64) __builtin_amdgcn_global_load_lds((const unsigned*)E.bias_ptr(nxt, tid), (LAS unsigned*)(lds + LDS_BIASBUF + ((ui + 1) & 1) * 2048), 16, 0, 0);
                if (Epi::EXTRA && tid < 64) __builtin_amdgcn_global_load_lds((const unsigned*)E.extra_ptr(nxt, tid), (LAS unsigned*)(lds + LDS_BIASBUF + ((ui + 1) & 1) * 2048 + 1024), 16, 0, 0); }
            PG8_WAIT_V(8); PG8_WAIT_L(0); PG8_BAR; PG8_MMA(0, 0, At, B0); PG8_MMA(0, 1, At, B1); PG8_BAR; PG8_SCHED;
            PG8_LDA(At, 0, 1); PG8_STAGE(PG8_SB(0, 0), b2, voffB); PG8_STAGE(PG8_SB(0, 1), b2 + hstep, voffB); PG8_STAGE(PG8_SA(0, 0), a2, vA[0]);
            PG8_WAIT_V(8); PG8_WAIT_L(0); PG8_BAR; PG8_MMA(1, 0, At, B0); PG8_MMA(1, 1, At, B1); PG8_BAR; PG8_SCHED;
            PG8_LDB(B0, 1, 0); PG8_LDB(B1, 1, 1); PG8_SCHED; PG8_LDA(At, 1, 0); PG8_STAGE(PG8_SA(0, 1), a2, vA[1]);
            PG8_WAIT_V(8); PG8_WAIT_L(0); PG8_BAR; PG8_MMA(0, 0, At, B0); PG8_MMA(0, 1, At, B1); PG8_BAR; PG8_SCHED;
            PG8_LDA(At, 1, 1); PG8_STAGE(PG8_SB(1, 0), b3, voffB); PG8_STAGE(PG8_SB(1, 1), b3 + hstep, voffB); PG8_STAGE(PG8_SA(1, 0), a3, vA[0]);
            PG8_WAIT_V(8); PG8_WAIT_L(0); PG8_BAR; PG8_MMA(1, 0, At, B0); PG8_MMA(1, 1, At, B1); PG8_BAR; PG8_SCHED;
        }
        if (wr == 0) PG8_BAR;
        E(acc, cur, wr, wc, fr, fq, (const LAS float*)(lds + LDS_BIASBUF + (ui & 1) * 2048));
        if (!has_next) break;
#pragma unroll
        for (int a = 0; a < 2; ++a)
#pragma unroll
            for (int b = 0; b < 2; ++b)
#pragma unroll
                for (int m = 0; m < 4; ++m)
#pragma unroll
                    for (int n = 0; n < 2; ++n) acc[a][b][m][n] = (f32x4){0.f, 0.f, 0.f, 0.f};
        cur = nxt; cB = nB; ++ui;
        if (wr == 1) PG8_BAR;
    }
    PG8_WAIT_V(0);
    PG8_BAR;
#undef PG8_SA
#undef PG8_SB
#undef PG8_STAGE
#undef PG8_LDA
#undef PG8_LDB
#undef PG8_MMA
#undef PG8_WAIT_V
#undef PG8_WAIT_L
#undef PG8_BAR
#undef PG8_SCHED
#undef PG8_LOADVA
}

typedef f32x4 Acc[2][2][4][2];

struct EpiZ {
    static constexpr bool PERM = true, BIAS = true, EXTRA = false;
    __device__ __forceinline__ const float* extra_ptr(const Unit&, int) const { return nullptr; }
    __device__ __forceinline__ const float* bias_ptr(const Unit& u, int t) const { return bias + u.pn * 256 + 4 * t; }
    bf16_t* Z; const float* bias; float* out; int l; unsigned char* ZG;
    __device__ __forceinline__ void operator()(const Acc& acc, const Unit& u, int wr, int wc, int fr, int fq, const LAS float* lb) const {
        const int row0 = u.pm * 256 + wr * 64 + fr, col0 = u.pn * 256 + wc * 32 + 8 * fq;
        f32x4 bv[2][2];
#pragma unroll
        for (int bj = 0; bj < 2; ++bj)
#pragma unroll
            for (int n = 0; n < 2; ++n) bv[bj][n] = *(const LAS f32x4*)(lb + bj * 128 + wc * 32 + 8 * fq + 4 * n);
#pragma unroll
        for (int ai = 0; ai < 2; ++ai)
#pragma unroll
            for (int m = 0; m < 4; ++m) {
                const int row = row0 + ai * 128 + m * 16;
                bf16_t* rowp = Z + (size_t)row * INW + col0;
                float* ko = nullptr; float* vo = nullptr;
                if (u.pn == 2) {
                    if (row < NPROMPT) { const int t = row & 4095; if (t >= 3968) { const size_t o = ((size_t)(l * 8 + (row >> 12)) * 128 + (t - 3968)) * 128 + wc * 32 + 8 * fq; ko = out + OKP + o; vo = out + OVP + o; } }
                    else { const int rr = row - NPROMPT; const size_t o = ((size_t)(l * 8 + (rr >> 6)) * 128 + 64 + (rr & 63)) * 128 + wc * 32 + 8 * fq; ko = out + OKS + o; vo = out + OVS + o; }
                }
#pragma unroll
                for (int bj = 0; bj < 2; ++bj) {
                    const f32x4 v0 = acc[ai][bj][m][0] + bv[bj][0], v1 = acc[ai][bj][m][1] + bv[bj][1];
                    if (u.pn >= 9) { u32x2 w8; w8.x = pk4_fp8(v0[0], v0[1], v0[2], v0[3]); w8.y = pk4_fp8(v1[0], v1[1], v1[2], v1[3]);
                        *(u32x2*)(ZG + (size_t)row * 2048 + (col0 - 2304) + bj * 128) = w8; }
                    else { u32x4 w; w.x = cvt_pk_bf16(v0[0], v0[1]); w.y = cvt_pk_bf16(v0[2], v0[3]); w.z = cvt_pk_bf16(v1[0], v1[1]); w.w = cvt_pk_bf16(v1[2], v1[3]);
                        *(u32x4*)(rowp + bj * 128) = w; }
                    float* o = bj == 0 ? ko : vo;
                    if (o) { *(f32x4*)o = v0; *(f32x4*)(o + 4) = v1; }
                }
                asm volatile("" ::: "memory");
            }
    }
};
struct EpiT1 {
    static constexpr bool PERM = true, BIAS = false, EXTRA = false;
    __device__ __forceinline__ const float* extra_ptr(const Unit&, int) const { return nullptr; }
    __device__ __forceinline__ const float* bias_ptr(const Unit&, int) const { return nullptr; }
    unsigned char* T1; const unsigned char* ZG;
    __device__ __forceinline__ void operator()(const Acc& acc, const Unit& u, int wr, int wc, int fr, int fq, const LAS float* lb) const {
        const int row0 = u.pm * 256 + wr * 64 + fr, col0 = u.pn * 256 + wc * 32 + 8 * fq;
        u32x2 g[2][4][2];
#pragma unroll
        for (int ai = 0; ai < 2; ++ai)
#pragma unroll
            for (int m = 0; m < 4; ++m)
#pragma unroll
                for (int bj = 0; bj < 2; ++bj) g[ai][m][bj] = *(const u32x2*)(ZG + (size_t)(row0 + ai * 128 + m * 16) * 2048 + col0 + bj * 128);
        asm volatile("" ::: "memory");
#pragma unroll
        for (int ai = 0; ai < 2; ++ai)
#pragma unroll
            for (int m = 0; m < 4; ++m) {
                const int row = row0 + ai * 128 + m * 16;
#pragma unroll
                for (int bj = 0; bj < 2; ++bj) {
                    float gg[8]; unpk8_fp8(g[ai][m][bj], gg);
                    f32x4 v0 = acc[ai][bj][m][0] * 16.0f, v1 = acc[ai][bj][m][1] * 16.0f;
#pragma unroll
                    for (int j = 0; j < 4; ++j) { v0[j] *= sigmoidf_(gg[j]); v1[j] *= sigmoidf_(gg[4 + j]); }
                    u32x2 w; w.x = pk4_fp8(v0[0], v0[1], v0[2], v0[3]); w.y = pk4_fp8(v1[0], v1[1], v1[2], v1[3]);
                    *(u32x2*)(T1 + (size_t)row * D + col0 + bj * 128) = w;
                }
            }
    }
};
struct EpiMix {
    static constexpr bool PERM = true, BIAS = false, EXTRA = false;
    __device__ __forceinline__ const float* extra_ptr(const Unit&, int) const { return nullptr; }
    __device__ __forceinline__ const float* bias_ptr(const Unit&, int) const { return nullptr; }
    const unsigned char* T1; const unsigned char* ZG; unsigned char* MIX;
    __device__ __forceinline__ void operator()(const Acc& acc, const Unit& u, int wr, int wc, int fr, int fq, const LAS float* lb) const {
        const int row0 = u.pm * 256 + wr * 64 + fr, col0 = u.pn * 256 + wc * 32 + 8 * fq;
        u32x2 g[2][4][2], t[2][4][2];
#pragma unroll
        for (int ai = 0; ai < 2; ++ai)
#pragma unroll
            for (int m = 0; m < 4; ++m)
#pragma unroll
                for (int bj = 0; bj < 2; ++bj) { const int row = row0 + ai * 128 + m * 16;
                    g[ai][m][bj] = *(const u32x2*)(ZG + (size_t)row * 2048 + 1024 + col0 + bj * 128);
                    t[ai][m][bj] = *(const u32x2*)(T1 + (size_t)row * D + col0 + bj * 128); }
        asm volatile("" ::: "memory");
#pragma unroll
        for (int ai = 0; ai < 2; ++ai)
#pragma unroll
            for (int m = 0; m < 4; ++m) {
                const int row = row0 + ai * 128 + m * 16;
#pragma unroll
                for (int bj = 0; bj < 2; ++bj) {
                    float gg[8], tt[8]; unpk8_fp8(g[ai][m][bj], gg); unpk8_fp8(t[ai][m][bj], tt);
                    const f32x4 a0 = acc[ai][bj][m][0], a1 = acc[ai][bj][m][1];
                    float v[8];
#pragma unroll
                    for (int j = 0; j < 4; ++j) { v[j] = tt[j] * 0.0625f + a0[j] * sigmoidf_(gg[j]); v[4 + j] = tt[4 + j] * 0.0625f + a1[j] * sigmoidf_(gg[4 + j]); }
                    u32x2 w; w.x = pk4_fp8(v[0], v[1], v[2], v[3]); w.y = pk4_fp8(v[4], v[5], v[6], v[7]);
                    *(u32x2*)(MIX + (size_t)row * D + col0 + bj * 128) = w;
                }
            }
    }
};
struct EpiX {
    static constexpr bool PERM = true, BIAS = false, EXTRA = false;
    __device__ __forceinline__ const float* extra_ptr(const Unit&, int) const { return nullptr; }
    __device__ __forceinline__ const float* bias_ptr(const Unit&, int) const { return nullptr; }
    const bf16_t* X; bf16_t* V; const float* modl;
    __device__ __forceinline__ void operator()(const Acc& acc, const Unit& u, int wr, int wc, int fr, int fq, const LAS float* lb) const {
        const int row0 = u.pm * 256 + wr * 64 + fr, col0 = u.pn * 256 + wc * 32 + 8 * fq;
        const bool uni = u.pm < 128;
        f32x4 g[2][2];
        if (uni) { const float* gp = modl + (size_t)(u.pm >> 4) * 6144 + 2048 + col0;
#pragma unroll
            for (int bj = 0; bj < 2; ++bj)
#pragma unroll
                for (int n = 0; n < 2; ++n) g[bj][n] = *(const f32x4*)(gp + bj * 128 + 4 * n) + 1.0f; }
#pragma unroll
        for (int ai = 0; ai < 2; ++ai) {
            u32x4 x[4][2];
#pragma unroll
            for (int m = 0; m < 4; ++m)
#pragma unroll
                for (int bj = 0; bj < 2; ++bj) x[m][bj] = *(const u32x4*)(X + (size_t)(row0 + ai * 128 + m * 16) * D + col0 + bj * 128);
            asm volatile("" ::: "memory");
#pragma unroll
            for (int m = 0; m < 4; ++m) {
                const int row = row0 + ai * 128 + m * 16;
                if (!uni) { const float* gp = modl + (size_t)batch_of(row) * 6144 + 2048 + col0;
#pragma unroll
                    for (int bj = 0; bj < 2; ++bj)
#pragma unroll
                        for (int n = 0; n < 2; ++n) g[bj][n] = *(const f32x4*)(gp + bj * 128 + 4 * n) + 1.0f; }
#pragma unroll
                for (int bj = 0; bj < 2; ++bj) {
                    const u32x4 xx = x[m][bj];
                    const f32x4 x0 = (f32x4){bf_lo(xx.x), bf_hi(xx.x), bf_lo(xx.y), bf_hi(xx.y)}, x1 = (f32x4){bf_lo(xx.z), bf_hi(xx.z), bf_lo(xx.w), bf_hi(xx.w)};
                    const f32x4 v0 = x0 * ALPHA + g[bj][0] * acc[ai][bj][m][0], v1 = x1 * ALPHA + g[bj][1] * acc[ai][bj][m][1];
                    u32x4 w; w.x = cvt_pk_bf16(v0[0], v0[1]); w.y = cvt_pk_bf16(v0[2], v0[3]); w.z = cvt_pk_bf16(v1[0], v1[1]); w.w = cvt_pk_bf16(v1[2], v1[3]);
                    *(u32x4*)(V + (size_t)row * D + col0 + bj * 128) = w;
                }
            }
            asm volatile("" ::: "memory");
        }
    }
};
struct EpiAct {
    static constexpr bool PERM = true, BIAS = true, EXTRA = false;
    __device__ __forceinline__ const float* extra_ptr(const Unit&, int) const { return nullptr; }
    __device__ __forceinline__ const float* bias_ptr(const Unit& u, int t) const { return bgu + (size_t)u.e * 2048 + u.pn * 128 + (t < 32 ? 4 * t : 1024 + 4 * (t - 32)); }
    unsigned char* ACT; const float* bgu;
    __device__ __forceinline__ void operator()(const Acc& acc, const Unit& u, int wr, int wc, int fr, int fq, const LAS float* lb) const {
        const int row0 = u.pm * 256 + wr * 64 + fr, c0 = u.pn * 128 + wc * 32 + 8 * fq;
        f32x4 bg[2], bl[2];
#pragma unroll
        for (int n = 0; n < 2; ++n) { bg[n] = *(const LAS f32x4*)(lb + wc * 32 + 8 * fq + 4 * n); bl[n] = *(const LAS f32x4*)(lb + 128 + wc * 32 + 8 * fq + 4 * n); }
#pragma unroll
        for (int ai = 0; ai < 2; ++ai)
#pragma unroll
            for (int m = 0; m < 4; ++m) {
                const int row = row0 + ai * 128 + m * 16;
                float a[8];
#pragma unroll
                for (int n = 0; n < 2; ++n)
#pragma unroll
                    for (int jp = 0; jp < 2; ++jp) {
                        f32x2 g = (f32x2){acc[ai][0][m][n][2 * jp], acc[ai][0][m][n][2 * jp + 1]} + (f32x2){bg[n][2 * jp], bg[n][2 * jp + 1]};
                        f32x2 li = (f32x2){acc[ai][1][m][n][2 * jp], acc[ai][1][m][n][2 * jp + 1]} + (f32x2){bl[n][2 * jp], bl[n][2 * jp + 1]};
                        g = __builtin_elementwise_min(g, (f32x2){7.0f, 7.0f});
                        li = __builtin_elementwise_min(__builtin_elementwise_max(li, (f32x2){-7.0f, -7.0f}), (f32x2){7.0f, 7.0f});
                        const f32x2 t = g * (-1.702f * 1.44269504089f);
                        f32x2 e; e.x = __builtin_amdgcn_exp2f(t.x); e.y = __builtin_amdgcn_exp2f(t.y);
                        const f32x2 dd = e + 1.0f;
                        f32x2 r; r.x = __builtin_amdgcn_rcpf(dd.x); r.y = __builtin_amdgcn_rcpf(dd.y);
                        const f32x2 av = (g * r) * (li + 1.0f);
                        a[n * 4 + 2 * jp] = av.x; a[n * 4 + 2 * jp + 1] = av.y;
                    }
                u32x2 w; w.x = pk4_fp8(a[0], a[1], a[2], a[3]); w.y = pk4_fp8(a[4], a[5], a[6], a[7]);
                *(u32x2*)(ACT + (size_t)row * D + c0) = w;
                asm volatile("" ::: "memory");
            }
    }
};
struct EpiYs {
    static constexpr bool PERM = true, BIAS = true, EXTRA = true;
    __device__ __forceinline__ const float* extra_ptr(const Unit& u, int t) const { return gate + (size_t)u.e * NT + (u.pm - blk[u.e]) * 256 + 4 * t; }
    __device__ __forceinline__ const float* bias_ptr(const Unit& u, int t) const { return bdn + (size_t)u.e * D + u.pn * 256 + 4 * t; }
    unsigned char* YS; const float* bdn; const float* gate; const LAS int* cnt; const LAS int* blk;
    __device__ __forceinline__ void operator()(const Acc& acc, const Unit& u, int wr, int wc, int fr, int fq, const LAS float* lb) const {
        const int r0 = wr * 64 + fr, col0 = u.pn * 256 + wc * 32 + 8 * fq;
        const int rank0 = (u.pm - blk[u.e]) * 256; const int ce = cnt[u.e];
        f32x4 bv[2][2];
#pragma unroll
        for (int bj = 0; bj < 2; ++bj)
#pragma unroll
            for (int n = 0; n < 2; ++n) bv[bj][n] = *(const LAS f32x4*)(lb + bj * 128 + wc * 32 + 8 * fq + 4 * n);
        float gts[2][4];
#pragma unroll
        for (int ai = 0; ai < 2; ++ai)
#pragma unroll
            for (int m = 0; m < 4; ++m) { const int rank = rank0 + r0 + ai * 128 + m * 16; const float gv = lb[256 + r0 + ai * 128 + m * 16]; gts[ai][m] = rank < ce ? 16.0f * gv : 0.0f; }
        asm volatile("" ::: "memory");
#pragma unroll
        for (int ai = 0; ai < 2; ++ai)
#pragma unroll
            for (int m = 0; m < 4; ++m) {
                const int r = r0 + ai * 128 + m * 16;
                const float gt = gts[ai][m];
                unsigned char* rowp = YS + (size_t)(u.pm * 256 + r) * D + col0;
#pragma unroll
                for (int bj = 0; bj < 2; ++bj) {
                    const f32x4 v0 = (acc[ai][bj][m][0] + bv[bj][0]) * gt, v1 = (acc[ai][bj][m][1] + bv[bj][1]) * gt;
                    u32x2 w; w.x = pk4_fp8(v0[0], v0[1], v0[2], v0[3]); w.y = pk4_fp8(v1[0], v1[1], v1[2], v1[3]);
                    *(u32x2*)(rowp + bj * 128) = w;
                }
                asm volatile("" ::: "memory");
            }
    }
};
}


#define XB_TMO      128
#define XB_XCNT(j)  (256  + 64 * (j))
#define XB_XSUB(j)  (1280 + 64 * (j))
#define XB_XGEN(j)  (2304 + 64 * (j))
#define XB_TOP      3328
#define XB_TOPGEN   3392
#define XCD_BAR_WORDS 3456
#define XB_SPIN_CAP (1u << 21)
__device__ __forceinline__ unsigned xb_ld(unsigned* p)              { return __hip_atomic_load(p, __ATOMIC_RELAXED, __HIP_MEMORY_SCOPE_AGENT); }
__device__ __forceinline__ unsigned xb_add(unsigned* p, unsigned v) { return __hip_atomic_fetch_add(p, v, __ATOMIC_RELAXED, __HIP_MEMORY_SCOPE_AGENT); }
__device__ __forceinline__ unsigned xb_xcc_id() { return (unsigned)__builtin_amdgcn_s_getreg((3 << 11) | 20) & 0xFu; }
#define XB_SPIN(cond, bar) do { unsigned _sp = 0; while (cond) { __builtin_amdgcn_s_sleep(1); \
    if ((++_sp & 255u) == 0u) { if (xb_ld(&(bar)[XB_TMO])) break; if (_sp > XB_SPIN_CAP) { atomicAdd(&(bar)[XB_TMO], 1u); break; } } } } while (0)
struct XcdBarrier { unsigned* bar; unsigned x; volatile LAS unsigned* st; };
__device__ __forceinline__ XcdBarrier xcd_barrier_post(unsigned* bar, volatile LAS unsigned* st) {
    XcdBarrier b; b.bar = bar; b.x = xb_xcc_id(); b.st = st;
    if (threadIdx.x == 0) (void)xb_add(&bar[XB_XCNT(b.x)], 1u);
    return b;
}
__device__ __forceinline__ void xcd_barrier_complete(unsigned* bar, unsigned x, unsigned& nloc, unsigned& nx) {
    const unsigned G = gridDim.x * gridDim.y * gridDim.z;
    unsigned sum, cnt, mine, sp = 0u;
    for (;;) {
        sum = 0u; cnt = 0u; mine = 0u;
#pragma unroll
        for (unsigned j = 0; j < 16; ++j) { const unsigned c = xb_ld(&bar[XB_XCNT(j)]); sum += c; cnt += (c > 0u) ? 1u : 0u; mine = (j == x) ? c : mine; }
        if (sum == G) break;
        __builtin_amdgcn_s_sleep(1);
        if ((++sp & 255u) == 0u) { if (xb_ld(&bar[XB_TMO])) break; if (sp > XB_SPIN_CAP) { atomicAdd(&bar[XB_TMO], 1u); break; } }
    }
    nloc = mine > 0u ? mine : 1u; nx = cnt > 0u ? cnt : 1u;
}
__device__ __forceinline__ void xcd_barrier(const XcdBarrier& b) {
    asm volatile("s_waitcnt vmcnt(0)" ::: "memory");
    __syncthreads();
    if (threadIdx.x == 0) {
        unsigned* bar = b.bar;
        __builtin_amdgcn_s_waitcnt(0);
        unsigned nloc = b.st[0], nx = b.st[1];
        if (nloc == 0u) { xcd_barrier_complete(bar, b.x, nloc, nx); b.st[0] = nloc; b.st[1] = nx; }
        const unsigned old = xb_add(&bar[XB_XSUB(b.x)], 1u);
        const unsigned gen = old / nloc;
        if (old + 1u == (gen + 1u) * nloc) {
            __builtin_amdgcn_fence(__ATOMIC_RELEASE, "agent");
            asm volatile("s_waitcnt vmcnt(0)" ::: "memory");
            const unsigned og = xb_add(&bar[XB_TOP], 1u);
            const unsigned tg = og / nx;
            if (og + 1u == (tg + 1u) * nx) xb_add(&bar[XB_TOPGEN], 1u);
            else XB_SPIN(xb_ld(&bar[XB_TOPGEN]) == tg, bar);
            __builtin_amdgcn_fence(__ATOMIC_ACQUIRE, "agent");
            xb_add(&bar[XB_XGEN(b.x)], 1u);
            asm volatile("s_waitcnt vmcnt(0)" ::: "memory");
        } else {
            XB_SPIN(xb_ld(&bar[XB_XGEN(b.x)]) == gen, bar);
            __builtin_amdgcn_fence(__ATOMIC_ACQUIRE, "agent");
            asm volatile("s_waitcnt vmcnt(0)" ::: "memory");
        }
    }
    __syncthreads();
}

struct Ctx {
    LAS unsigned char* lds; int tid, lane, wave, G, bx;
    const float* const* in; float* out; unsigned char* ws;
};
#define LDS_WAIT() asm volatile("s_waitcnt lgkmcnt(0)" ::: "memory")

struct TDesc { const float* src; unsigned char* dst; int N, K, k0, n0, kind, f8; };
__device__ __forceinline__ void t64_load(const TDesc& d, float (&v)[64], int lane) {
    const float* src = d.src + (size_t)d.k0 * d.N + d.n0 + lane;
#pragma unroll
    for (int kk = 0; kk < 64; ++kk) v[kk] = src[(size_t)kk * d.N];
}
__device__ __forceinline__ void t64_finish(const TDesc& d, const float (&v)[64], LAS unsigned char* scr, int lane) {
    if (d.f8) {
        LAS unsigned char* wp = scr + lane * 80;
#pragma unroll
        for (int q = 0; q < 4; ++q) { u32x4 o;
            o.x = pk4_fp8(64.f * v[16 * q + 0], 64.f * v[16 * q + 1], 64.f * v[16 * q + 2], 64.f * v[16 * q + 3]);
            o.y = pk4_fp8(64.f * v[16 * q + 4], 64.f * v[16 * q + 5], 64.f * v[16 * q + 6], 64.f * v[16 * q + 7]);
            o.z = pk4_fp8(64.f * v[16 * q + 8], 64.f * v[16 * q + 9], 64.f * v[16 * q + 10], 64.f * v[16 * q + 11]);
            o.w = pk4_fp8(64.f * v[16 * q + 12], 64.f * v[16 * q + 13], 64.f * v[16 * q + 14], 64.f * v[16 * q + 15]);
            *(LAS u32x4*)(wp + q * 16) = o; }
        LDS_WAIT(); asm volatile("" ::: "memory");
        const int c = lane & 3;
#pragma unroll
        for (int j = 0; j < 4; ++j) { const int nl = (lane >> 2) + 16 * j; const u32x4 o = *(const LAS u32x4*)(scr + nl * 80 + c * 16);
            const int n = d.n0 + nl; int dr = n;
            if (d.kind == 1) { dr = (n < 1024) ? ((n >> 7) * 256 + (n & 127)) : (((n - 1024) >> 7) * 256 + 128 + (n & 127)); }
            *(u32x4*)(d.dst + (size_t)dr * d.K + d.k0 + c * 16) = o; }
    } else {
        LAS unsigned char* wp = scr + lane * 144;
#pragma unroll
        for (int q = 0; q < 8; ++q) { u32x4 o;
            o.x = cvt_pk_bf16(v[8 * q + 0], v[8 * q + 1]); o.y = cvt_pk_bf16(v[8 * q + 2], v[8 * q + 3]); o.z = cvt_pk_bf16(v[8 * q + 4], v[8 * q + 5]); o.w = cvt_pk_bf16(v[8 * q + 6], v[8 * q + 7]);
            *(LAS u32x4*)(wp + q * 16) = o; }
        LDS_WAIT(); asm volatile("" ::: "memory");
        const int c = lane & 7;
#pragma unroll
        for (int j = 0; j < 8; ++j) { const int nl = (lane >> 3) + 8 * j; const u32x4 o = *(const LAS u32x4*)(scr + nl * 144 + c * 16);
            *(u32x4*)(d.dst + ((size_t)(d.n0 + nl) * d.K + d.k0) * 2 + c * 16) = o; }
    }
    LDS_WAIT(); asm volatile("" ::: "memory");
}
__device__ __forceinline__ TDesc t64_decode(const float* const* in, unsigned char* ws, int it) {
    TDesc d; int r = it, item, nblk;
    if (r < 32768) { const int m = r >> 9; item = r & 511; d.src = in[23] + (size_t)m * 1024 * 2048; d.dst = ws + WS_WGU + (size_t)m * 2048 * 1024; d.N = 2048; d.K = 1024; d.kind = 1; d.f8 = 1; }
    else if ((r -= 32768) < 16384) { const int m = r >> 8; item = r & 255; d.src = in[25] + (size_t)m * 1024 * 1024; d.dst = ws + WS_WDN + (size_t)m * 1024 * 1024; d.N = 1024; d.K = 1024; d.kind = 0; d.f8 = 1; }
    else if ((r -= 16384) < 2176) { const int m = r / 1088; item = r % 1088; d.src = in[12] + (size_t)m * 1024 * INW; d.dst = ws + WS_WIN + (size_t)m * INW * 1024 * 2; d.N = INW; d.K = 1024; d.kind = 0; d.f8 = 0; }
    else if ((r -= 2176) < 2176) { const int m = r / 1088; item = r % 1088; d.src = in[12] + (size_t)m * 1024 * INW; d.dst = ws + WS_WIN8 + (size_t)m * INW * 1024; d.N = INW; d.K = 1024; d.kind = 0; d.f8 = 1; }
    else if ((r -= 2176) < 512) { const int m = r >> 8; item = r & 255; d.src = in[18] + (size_t)m * 1024 * 1024; d.dst = ws + WS_WO + (size_t)m * 1024 * 1024; d.N = 1024; d.K = 1024; d.kind = 0; d.f8 = 1; }
    else if ((r -= 512) < 256) { const int m = r >> 7; item = r & 127; d.src = in[16] + (size_t)m * 512 * 1024; d.dst = ws + WS_WOA + (size_t)m * 1024 * 512; d.N = 1024; d.K = 512; d.kind = 0; d.f8 = 1; }
    else { r -= 256; const int m = r >> 7; item = r & 127; d.src = in[17] + (size_t)m * 512 * 1024; d.dst = ws + WS_WOB + (size_t)m * 1024 * 512; d.N = 1024; d.K = 512; d.kind = 0; d.f8 = 1; }
    nblk = d.N >> 6; const int kb = item / nblk; d.k0 = kb * 64; d.n0 = (item - kb * nblk) * 64;
    return d;
}

__device__ __forceinline__ int rel_bucket(int rel) {
    const int n = rel < 0 ? -rel : rel;
    int v;
    if (n < 8) v = n;
    else { const float nf = (float)n; int large = 8 + (int)(logf(nf / 8.0f) / 2.7725887298583984f * 8.0f); v = large < 15 ? large : 15; }
    return (rel > 0 ? 16 : 0) + v;
}

__device__ __forceinline__ void phase0a(Ctx& F) {
    LAS float* scr = (LAS float*)(F.lds + F.wave * 16384);
    const int gw = F.bx * NWAVES + F.wave, NGW = F.G * NWAVES;
    unsigned char* ws = F.ws;
    {
        float* modp = (float*)(ws + WS_MODP);
        for (int it = gw; it < 2 * 96 * 8; it += NGW) {
            const int kc = it & 7, cgp = (it >> 3) % 96, l = it / (8 * 96), k0 = kc * 128, n0 = cgp * 64;
#pragma unroll 4
            for (int j = 0; j < 32; ++j) { const int idx = F.lane + 64 * j, r = idx >> 7, kk = idx & 127;
                const float c = r < 8 ? F.in[2][r * 1024 + k0 + kk] : F.in[3][(r - 8) * 1024 + k0 + kk];
                scr[kk * 16 + r] = c * sigmoidf_(c); }
            LDS_WAIT(); asm volatile("" ::: "memory");
            float a[16];
#pragma unroll
            for (int r = 0; r < 16; ++r) a[r] = 0.f;
            const float* wp = F.in[10] + ((size_t)l * 1024 + k0) * 6144 + n0 + F.lane;
#pragma unroll 16
            for (int kk = 0; kk < 128; ++kk) {
                const float w = wp[(size_t)kk * 6144];
                const LAS f32x4* sp = (const LAS f32x4*)(scr + kk * 16);
                const f32x4 s0 = sp[0], s1 = sp[1], s2 = sp[2], s3 = sp[3];
                a[0] += s0[0] * w; a[1] += s0[1] * w; a[2] += s0[2] * w; a[3] += s0[3] * w;
                a[4] += s1[0] * w; a[5] += s1[1] * w; a[6] += s1[2] * w; a[7] += s1[3] * w;
                a[8] += s2[0] * w; a[9] += s2[1] * w; a[10] += s2[2] * w; a[11] += s2[3] * w;
                a[12] += s3[0] * w; a[13] += s3[1] * w; a[14] += s3[2] * w; a[15] += s3[3] * w;
            }
            const float bb = (kc == 0) ? F.in[11][l * 6144 + n0 + F.lane] : 0.f;
#pragma unroll
            for (int r = 0; r < 16; ++r) modp[(size_t)kc * (2 * 16 * 6144) + ((size_t)(l * 16 + r)) * 6144 + n0 + F.lane] = a[r] + bb;
            LDS_WAIT(); asm volatile("" ::: "memory");
        }
    }
    if (F.bx == 0) {
        float* bt = (float*)(ws + WS_BIAS);
        for (int i = F.tid; i < 8 * 256; i += NTHREADS) { const int h = i >> 8, ri = i & 255; const int rel = ri - 191;
            bt[i] = (ri < 255) ? F.in[7][rel_bucket(rel) * 8 + h] : 0.f; }
    }
    for (int i = F.bx * NTHREADS + F.tid; i < 2 * 8 * 64 * 128; i += F.G * NTHREADS) {
        const int lb = i >> 13, rem = i & 8191;
        F.out[OKS + (size_t)lb * 16384 + rem] = F.in[4][(size_t)lb * 16384 + 8192 + rem];
        F.out[OVS + (size_t)lb * 16384 + rem] = F.in[5][(size_t)lb * 16384 + 8192 + rem];
    }
    LAS unsigned char* scrb = F.lds + F.wave * 16384;
    constexpr int NITEMS = 32768 + 16384 + 2176 + 2176 + 512 + 256 + 256;
    {
        float va[64], vb[64]; TDesc da, db;
        int it = gw;
        if (it < NITEMS) { da = t64_decode(F.in, ws, it); t64_load(da, va, F.lane); }
        while (it < NITEMS) {
            int itn = it + NGW;
            if (itn < NITEMS) { db = t64_decode(F.in, ws, itn); t64_load(db, vb, F.lane); }
            t64_finish(da, va, scrb, F.lane);
            it = itn; if (it >= NITEMS) break;
            itn = it + NGW;
            if (itn < NITEMS) { da = t64_decode(F.in, ws, itn); t64_load(da, va, F.lane); }
            t64_finish(db, vb, scrb, F.lane);
            it = itn;
        }
    }
}

__device__ __forceinline__ void ln_row(f32x4 (&v)[4], const float* g, const float* b, int lane) {
    float s = 0.f;
#pragma unroll
    for (int j = 0; j < 4; ++j) s += (v[j][0] + v[j][1]) + (v[j][2] + v[j][3]);
    const float mean = wave_sum(s) * (1.0f / D); float s2 = 0.f;
#pragma unroll
    for (int j = 0; j < 4; ++j) { v[j] = v[j] - mean; s2 += (v[j][0] * v[j][0] + v[j][1] * v[j][1]) + (v[j][2] * v[j][2] + v[j][3] * v[j][3]); }
    const float rstd = 1.0f / sqrtf(wave_sum(s2) * (1.0f / D) + LN_EPS);
#pragma unroll
    for (int j = 0; j < 4; ++j) { const f32x4 gg = *(const f32x4*)(g + 4 * lane + 256 * j), bb = *(const f32x4*)(b + 4 * lane + 256 * j); v[j] = v[j] * rstd * gg + bb; }
}
__device__ __forceinline__ void store_mod_row(const f32x4 (&v)[4], const float* sh, const float* sc, bf16_t* hrow, unsigned char* h8row, int lane) {
#pragma unroll
    for (int j = 0; j < 4; ++j) { const f32x4 a = *(const f32x4*)(sc + 4 * lane + 256 * j), b = *(const f32x4*)(sh + 4 * lane + 256 * j);
        const f32x4 h = v[j] * (a + 1.0f) + b; u32x2 w; w.x = cvt_pk_bf16(h[0], h[1]); w.y = cvt_pk_bf16(h[2], h[3]);
        *(u32x2*)(hrow + 4 * lane + 256 * j) = w;
        *(unsigned*)(h8row + 4 * lane + 256 * j) = pk4_fp8(h[0], h[1], h[2], h[3]); }
}

__device__ __forceinline__ void phase0b(Ctx& F) {
    const int gw = F.bx * NWAVES + F.wave, NGW = F.G * NWAVES;
    const float* mod = (const float*)(F.ws + WS_MOD);
    bf16_t* H = (bf16_t*)(F.ws + WS_H);
    for (int row = gw; row < NT; row += NGW) {
        const float* xr = row < NPROMPT ? F.in[0] + (size_t)row * D : F.in[1] + (size_t)(row - NPROMPT) * D;
        f32x4 v[4];
#pragma unroll
        for (int j = 0; j < 4; ++j) v[j] = *(const f32x4*)(xr + 4 * F.lane + 256 * j);
        ln_row(v, F.in[8], F.in[9], F.lane);
#pragma unroll
        for (int j = 0; j < 4; ++j) { u32x2 w; w.x = cvt_pk_bf16(v[j][0], v[j][1]); w.y = cvt_pk_bf16(v[j][2], v[j][3]); *(u32x2*)((bf16_t*)(F.ws + WS_XB) + (size_t)row * D + 4 * F.lane + 256 * j) = w; }
        const float* mb = mod + (size_t)batch_of(row) * 6144;
        store_mod_row(v, mb, mb + 1024, H + (size_t)row * D, F.ws + WS_H8 + (size_t)row * D, F.lane);
    }
}

__device__ __forceinline__ void phase_attn(Ctx& F, int l) {
    const bf16_t* Z = (const bf16_t*)(F.ws + WS_Z);
    unsigned char* YA = F.ws + WS_YA;
    unsigned char* YB = F.ws + WS_YB;
    const float* biasr = (const float*)(F.ws + WS_BIAS);
    LAS unsigned char* Ks = F.lds;
    LAS unsigned char* Vt = F.lds + 27648;
    LAS float* bt = (LAS float*)(F.lds + 53248);
    const int lane = F.lane, tid = F.tid;
    int bt_kv = -1;
    for (int au = F.bx; au < 1040; au += F.G) {
        const bool isS = au >= 1024;
        const int kv = au & 1;
        const int b = isS ? ((au - 1024) >> 1) : (au >> 7);
        const int n = isS ? 0 : ((au & 127) >> 1);
        __syncthreads();
        if (kv != bt_kv) { for (int i = tid; i < 1024; i += NTHREADS) bt[i] = biasr[(kv * 4 + (i >> 8)) * 256 + (i & 255)]; bt_kv = kv; }
#pragma unroll
        for (int jj = 0; jj < 3; ++jj) {
            const int p = tid + NTHREADS * jj, key = p >> 3, ds = p & 7;
            u32x4 kq = (u32x4){0u, 0u, 0u, 0u}, vq = (u32x4){0u, 0u, 0u, 0u};
            if (!isS) {
                const int t = n * 64 + key - 128;
                if (t >= 0) { const bf16_t* zr = Z + (size_t)(b * 4096 + t) * INW + kv * 64 + ds * 8; kq = *(const u32x4*)(zr + 512); vq = *(const u32x4*)(zr + 640); }
            } else if (key < 128) {
                const size_t o = ((size_t)((l * 8 + b) * 128 + key) * 2 + kv) * 64 + ds * 8;
                const f32x4 k0 = *(const f32x4*)(F.in[4] + o), k1 = *(const f32x4*)(F.in[4] + o + 4), v0 = *(const f32x4*)(F.in[5] + o), v1 = *(const f32x4*)(F.in[5] + o + 4);
                kq.x = cvt_pk_bf16(k0[0], k0[1]); kq.y = cvt_pk_bf16(k0[2], k0[3]); kq.z = cvt_pk_bf16(k1[0], k1[1]); kq.w = cvt_pk_bf16(k1[2], k1[3]);
                vq.x = cvt_pk_bf16(v0[0], v0[1]); vq.y = cvt_pk_bf16(v0[2], v0[3]); vq.z = cvt_pk_bf16(v1[0], v1[1]); vq.w = cvt_pk_bf16(v1[2], v1[3]);
            } else {
                const bf16_t* zr = Z + (size_t)(NPROMPT + b * 64 + key - 128) * INW + kv * 64 + ds * 8; kq = *(const u32x4*)(zr + 512); vq = *(const u32x4*)(zr + 640);
            }
            *(LAS u32x4*)(Ks + key * 144 + ds * 16) = kq;
            LAS unsigned short* vp = (LAS unsigned short*)Vt + (ds * 8) * 200 + key;
            vp[0 * 200] = (unsigned short)(vq.x & 0xffffu); vp[1 * 200] = (unsigned short)(vq.x >> 16);
            vp[2 * 200] = (unsigned short)(vq.y & 0xffffu); vp[3 * 200] = (unsigned short)(vq.y >> 16);
            vp[4 * 200] = (unsigned short)(vq.z & 0xffffu); vp[5 * 200] = (unsigned short)(vq.z >> 16);
            vp[6 * 200] = (unsigned short)(vq.w & 0xffffu); vp[7 * 200] = (unsigned short)(vq.w >> 16);
        }
        __syncthreads();
        const int g = F.wave >> 1, qi = (F.wave & 1) * 32 + (lane & 31), hh = lane >> 5, head = kv * 4 + g;
        const int qrow = isS ? NPROMPT + b * 64 + qi : b * 4096 + n * 64 + qi;
        bf16x8 Qf[4];
#pragma unroll
        for (int ks = 0; ks < 4; ++ks) Qf[ks] = *(const bf16x8*)(Z + (size_t)qrow * INW + head * 64 + ks * 16 + hh * 8);
        f32x16 S[6];
#pragma unroll
        for (int kb = 0; kb < 6; ++kb) {
#pragma unroll
            for (int j = 0; j < 16; ++j) S[kb][j] = 0.f;
#pragma unroll
            for (int ks = 0; ks < 4; ++ks) {
                const bf16x8 A = *(const LAS bf16x8*)(Ks + (kb * 32 + (lane & 31)) * 144 + (ks * 16 + hh * 8) * 2);
                S[kb] = __builtin_amdgcn_mfma_f32_32x32x16_bf16(A, Qf[ks], S[kb], 0, 0, 0);
            }
        }
        const float sinkv = F.in[14][l * 8 + head];
        float mx = sinkv;
        const int kmin = isS ? 0 : (128 - n * 64);
#pragma unroll
        for (int kb = 0; kb < 6; ++kb)
#pragma unroll
            for (int j = 0; j < 16; ++j) {
                const int key = kb * 32 + 8 * (j >> 2) + 4 * hh + (j & 3);
                float sv = S[kb][j] * 0.125f + bt[g * 256 + key - qi + 63];
                sv = key >= kmin ? sv : -1e30f;
                S[kb][j] = sv; mx = fmaxf(mx, sv);
            }
        mx = fmaxf(mx, __shfl_xor(mx, 32));
        float sum = 0.f;
#pragma unroll
        for (int kb = 0; kb < 6; ++kb)
#pragma unroll
            for (int j = 0; j < 16; ++j) { const float p = __expf(S[kb][j] - mx); S[kb][j] = p; sum += p; }
        sum += __shfl_xor(sum, 32);
        sum += __expf(sinkv - mx);
        const float inv = 1.0f / sum;
        f32x16 O[2];
#pragma unroll
        for (int db = 0; db < 2; ++db)
#pragma unroll
            for (int j = 0; j < 16; ++j) O[db][j] = 0.f;
#pragma unroll
        for (int kb = 0; kb < 6; ++kb)
#pragma unroll
            for (int s2 = 0; s2 < 2; ++s2) {
                union { bf16x8 v; unsigned u[4]; } P;
#pragma unroll
                for (int q = 0; q < 4; ++q) P.u[q] = cvt_pk_bf16(S[kb][8 * s2 + 2 * q], S[kb][8 * s2 + 2 * q + 1]);
#pragma unroll
                for (int db = 0; db < 2; ++db) {
                    const LAS unsigned char* vb = Vt + (db * 32 + (lane & 31)) * 400 + (kb * 32 + 16 * s2 + 4 * hh) * 2;
                    union { bf16x8 v; u32x2 h[2]; } Vf;
                    Vf.h[0] = *(const LAS u32x2*)vb; Vf.h[1] = *(const LAS u32x2*)(vb + 16);
                    O[db] = __builtin_amdgcn_mfma_f32_32x32x16_bf16(Vf.v, P.v, O[db], 0, 0, 0);
                }
            }
        unsigned char* orow = YA + (size_t)qrow * 512 + head * 64 + 4 * hh; const float inv8 = inv * 8.0f;
#pragma unroll
        for (int db = 0; db < 2; ++db)
#pragma unroll
            for (int jq = 0; jq < 4; ++jq) {
                *(unsigned*)(orow + db * 32 + 8 * jq) = pk4_fp8(O[db][4 * jq] * inv8, O[db][4 * jq + 1] * inv8, O[db][4 * jq + 2] * inv8, O[db][4 * jq + 3] * inv8);
            }
    }
    int nxtra = 1040 % F.G; if (1040 < F.G || 2 * nxtra > F.G) nxtra = 0;
    if (F.bx < nxtra) return;
    const int gw = (F.bx - nxtra) * NWAVES + F.wave, NGW = (F.G - nxtra) * NWAVES;
    const float* cw = F.in[15] + (size_t)l * 3 * 512 + 8 * lane;
    float w0[8], w1[8], w2[8];
#pragma unroll
    for (int e = 0; e < 8; ++e) { w0[e] = cw[e]; w1[e] = cw[512 + e]; w2[e] = cw[1024 + e]; }
    for (int row = gw; row < NT; row += NGW) {
        const bool isS = row >= NPROMPT; const int b = isS ? ((row - NPROMPT) >> 6) : (row >> 12), t = isS ? ((row - NPROMPT) & 63) : (row & 4095);
        const bf16_t* zr = Z + (size_t)row * INW + 8 * lane;
        const u32x4 cb = *(const u32x4*)(zr + 768);
        float u[3][8];
#pragma unroll
        for (int d = 0; d < 3; ++d) {
            if (t - d >= 0) {
                const bf16_t* zz = zr - (size_t)d * INW; const u32x4 cc = *(const u32x4*)(zz + 1280), cx = *(const u32x4*)(zz + 1792);
                u[d][0] = bf_lo(cc.x) * bf_lo(cx.x); u[d][1] = bf_hi(cc.x) * bf_hi(cx.x); u[d][2] = bf_lo(cc.y) * bf_lo(cx.y); u[d][3] = bf_hi(cc.y) * bf_hi(cx.y);
                u[d][4] = bf_lo(cc.z) * bf_lo(cx.z); u[d][5] = bf_hi(cc.z) * bf_hi(cx.z); u[d][6] = bf_lo(cc.w) * bf_lo(cx.w); u[d][7] = bf_hi(cc.w) * bf_hi(cx.w);
            } else if (isS) {
                const float* hp = F.in[6] + ((size_t)(l * 8 + b) * 2 + (2 + t - d)) * 512 + 8 * lane;
                const f32x4 h0 = *(const f32x4*)hp, h1 = *(const f32x4*)(hp + 4);
#pragma unroll
                for (int e = 0; e < 4; ++e) { u[d][e] = h0[e]; u[d][4 + e] = h1[e]; }
            } else {
#pragma unroll
                for (int e = 0; e < 8; ++e) u[d][e] = 0.f;
            }
        }
        const float cbf[8] = {bf_lo(cb.x), bf_hi(cb.x), bf_lo(cb.y), bf_hi(cb.y), bf_lo(cb.z), bf_hi(cb.z), bf_lo(cb.w), bf_hi(cb.w)};
        float y[8];
#pragma unroll
        for (int e = 0; e < 8; ++e) y[e] = cbf[e] * (w0[e] * u[2][e] + w1[e] * u[1][e] + w2[e] * u[0][e]);
        u32x2 w; w.x = pk4_fp8(y[0], y[1], y[2], y[3]); w.y = pk4_fp8(y[4], y[5], y[6], y[7]);
        *(u32x2*)(YB + (size_t)row * 512 + 8 * lane) = w;
        const int tl = isS ? 62 : 4094;
        if (t >= tl) {
            float* o = F.out + (isS ? OCS : OCP) + ((size_t)(l * 8 + b) * 2 + (t - tl)) * 512 + 8 * lane;
            *(f32x4*)o = (f32x4){u[0][0], u[0][1], u[0][2], u[0][3]}; *(f32x4*)(o + 4) = (f32x4){u[0][4], u[0][5], u[0][6], u[0][7]};
        }
    }
}

__device__ __forceinline__ void phase_ln_router(Ctx& F, int l) {
    bf16_t* XB = (bf16_t*)(F.ws + WS_XB); unsigned char* H8 = (unsigned char*)(F.ws + WS_H8); const bf16_t* V16 = (const bf16_t*)(F.ws + WS_V16);
    const float* mod = (const float*)(F.ws + WS_MOD) + (size_t)l * 16 * 6144;
    unsigned* cnt = (unsigned*)(F.ws + WS_CNT) + l * 2048;
    unsigned* tok = (unsigned*)(F.ws + WS_TOK); float* gate = (float*)(F.ws + WS_GATE); unsigned* slot = (unsigned*)(F.ws + WS_SLOT);
    const float* Wr = F.in[21] + (size_t)l * 1024 * 32;
    LAS float* hf = (LAS float*)F.lds;
    LAS unsigned* hist = (LAS unsigned*)(F.lds + 139264); LAS unsigned* hbase = hist + 32;
    const int lane = F.lane, w = F.wave;
    float breg[64];
    { const float* bp = Wr + (size_t)(128 * w) * 32 + lane;
#pragma unroll
      for (int s = 0; s < 64; ++s) breg[s] = bp[64 * s]; }
    for (int tidx = F.bx; tidx < 1024 + 256; tidx += F.G) {
        const int tile0 = tidx < 1024 ? tidx * 32 : NPROMPT + (tidx - 1024) * 2, nrows = tidx < 1024 ? 32 : 2;
        __syncthreads();
        if (F.tid < 32) hist[F.tid] = 0u;
        if (w * 4 < nrows) {
            u32x2 pv[4][4];
#pragma unroll
            for (int rr = 0; rr < 4; ++rr) { const int rl = w * 4 + rr, row = rl < nrows ? tile0 + rl : tile0;
#pragma unroll
                for (int j = 0; j < 4; ++j) pv[rr][j] = *(const u32x2*)(V16 + (size_t)row * D + 4 * lane + 256 * j); }
#pragma unroll
            for (int rr = 0; rr < 4; ++rr) {
                const int rl = w * 4 + rr, row = tile0 + rl;
                if (rl < nrows) {
                    f32x4 v[4];
#pragma unroll
                    for (int j = 0; j < 4; ++j) v[j] = (f32x4){bf_lo(pv[rr][j].x), bf_hi(pv[rr][j].x), bf_lo(pv[rr][j].y), bf_hi(pv[rr][j].y)};
                    ln_row(v, F.in[19] + l * D, F.in[20] + l * D, lane);
#pragma unroll
                    for (int j = 0; j < 4; ++j) { u32x2 wq; wq.x = cvt_pk_bf16(v[j][0], v[j][1]); wq.y = cvt_pk_bf16(v[j][2], v[j][3]); *(u32x2*)(XB + (size_t)row * D + 4 * lane + 256 * j) = wq; }
                    const float* mb = mod + (size_t)batch_of(row) * 6144;
#pragma unroll
                    for (int j = 0; j < 4; ++j) { const f32x4 a = *(const f32x4*)(mb + 4096 + 4 * lane + 256 * j), b = *(const f32x4*)(mb + 3072 + 4 * lane + 256 * j);
                        const f32x4 h = v[j] * (a + 1.0f) + b;
                        *(unsigned*)(H8 + (size_t)row * D + 4 * lane + 256 * j) = pk4_fp8(h[0], h[1], h[2], h[3]);
                        LAS float* hp = hf + rl * 1025 + lane + 64 * j;
                        hp[0] = h[0]; hp[256] = h[1]; hp[512] = h[2]; hp[768] = h[3]; }
                }
            }
        }
        __syncthreads();
        f32x16 acc;
#pragma unroll
        for (int j = 0; j < 16; ++j) acc[j] = 0.f;
        {
            const LAS float* ap = hf + (lane & 31) * 1025 + 32 * w;
            const int hh = lane >> 5;
#pragma unroll
            for (int s = 0; s < 64; ++s) { const int kk = 2 * s + hh; acc = __builtin_amdgcn_mfma_f32_32x32x2f32(ap[(kk & 3) * 256 + (kk >> 2)], breg[s], acc, 0, 0, 0); }
        }
        __syncthreads();
        LAS float* red = hf;
#pragma unroll
        for (int j = 0; j < 16; ++j) red[(w * 32 + 8 * (j >> 2) + 4 * (lane >> 5) + (j & 3)) * 33 + (lane & 31)] = acc[j];
        __syncthreads();
        int e_sel[4]; float g_sel[4]; unsigned loc[4];
#pragma unroll
        for (int rr = 0; rr < 4; ++rr) {
            const int tk = w * 4 + rr;
            float val = -INFINITY;
            if (lane < 32) { float sacc = F.in[22][l * 32 + lane];
#pragma unroll
                for (int ww = 0; ww < 8; ++ww) sacc += red[(ww * 32 + tk) * 33 + lane];
                val = sacc; }
            float tv[4]; int te[4];
            {
                const int vbits = __float_as_int(val); int rank = 0;
#pragma unroll
                for (int j = 0; j < 32; ++j) { const float vj = __int_as_float(__builtin_amdgcn_readlane(vbits, j)); rank += (vj > val || (vj == val && j < lane)) ? 1 : 0; }
#pragma unroll
                for (int it = 0; it < 4; ++it) { const unsigned long long mk = __ballot(rank == it); const int ln = mk ? (__ffsll((long long)mk) - 1) : 0;
                    te[it] = ln; tv[it] = __int_as_float(__builtin_amdgcn_readlane(vbits, ln)); }
            }
            const float e1 = __expf(tv[1] - tv[0]), e2 = __expf(tv[2] - tv[0]), e3 = __expf(tv[3] - tv[0]);
            const float rs = 1.0f / (1.0f + e1 + e2 + e3);
            e_sel[rr] = lane == 0 ? te[0] : lane == 1 ? te[1] : lane == 2 ? te[2] : te[3];
            g_sel[rr] = (lane == 0 ? 1.0f : lane == 1 ? e1 : lane == 2 ? e2 : e3) * rs;
            loc[rr] = 0u;
            if (lane < 4 && tk < nrows) loc[rr] = atomicAdd((unsigned*)&hist[e_sel[rr]], 1u);
        }
        __syncthreads();
        if (F.tid < 32) { const unsigned hcount = hist[F.tid]; hbase[F.tid] = hcount ? atomicAdd(cnt + F.tid * 64, hcount) : 0u; }
        __syncthreads();
        if (lane < 4) {
#pragma unroll
            for (int rr = 0; rr < 4; ++rr) {
                const int row = tile0 + w * 4 + rr, e = e_sel[rr] & 31; const unsigned rank = hbase[e] + loc[rr];
                if (w * 4 + rr < nrows) { tok[(size_t)e * NT + rank] = (unsigned)row; gate[(size_t)e * NT + rank] = g_sel[rr]; slot[(size_t)row * 4 + lane] = ((unsigned)e << 24) | rank; }
            }
        }
    }
}

__device__ __forceinline__ void build_blk(Ctx& F, int l) {
    LAS int* blk = (LAS int*)(F.lds + LDS_BLK);
    const unsigned* cnt = (const unsigned*)(F.ws + WS_CNT) + l * 2048;
    __syncthreads();
    if (F.tid == 0) { LAS int* cl = (LAS int*)(F.lds + LDS_CNT); int s = 0; for (int e = 0; e < 32; ++e) { const int ce = (int)cnt[e * 64]; cl[e] = ce; blk[e] = s; s += (ce + 255) >> 8; } blk[32] = s; }
    __syncthreads();
}

__device__ __forceinline__ void phase_combine(Ctx& F, int l) {
    const LAS int* blk = (const LAS int*)(F.lds + LDS_BLK);
    float* X = F.out; bf16_t* XB = (bf16_t*)(F.ws + WS_XB); bf16_t* H = (bf16_t*)(F.ws + WS_H); const unsigned char* YS = F.ws + WS_YS;
    const unsigned* slot = (const unsigned*)(F.ws + WS_SLOT);
    const float* mod = (const float*)(F.ws + WS_MOD);
    const int gw = F.bx * NWAVES + F.wave, NGW = F.G * NWAVES, lane = F.lane;
    for (int row = gw; row < NT; row += NGW) {
        f32x4 ff[4];
#pragma unroll
        for (int j = 0; j < 4; ++j) ff[j] = (f32x4){0.f, 0.f, 0.f, 0.f};
#pragma unroll
        for (int k = 0; k < 4; ++k) {
            const unsigned s = slot[(size_t)row * 4 + k]; const int e = (int)(s >> 24), rank = (int)(s & 0xffffffu);
            const unsigned char* yr = YS + ((size_t)blk[e] * 256 + rank) * D + 4 * lane;
#pragma unroll
            for (int j = 0; j < 4; ++j) { const unsigned wv = *(const unsigned*)(yr + 256 * j); const f32x2 lo = __builtin_amdgcn_cvt_pk_f32_fp8(wv, false), hi = __builtin_amdgcn_cvt_pk_f32_fp8(wv, true);
                ff[j][0] += lo.x; ff[j][1] += lo.y; ff[j][2] += hi.x; ff[j][3] += hi.y; }
        }
        const int bi = batch_of(row);
        const float* mb = mod + (size_t)(l * 16 + bi) * 6144;
        f32x4 v[4];
#pragma unroll
        for (int j = 0; j < 4; ++j) { const u32x2 xw = *(const u32x2*)(XB + (size_t)row * D + 4 * lane + 256 * j); const f32x4 x = (f32x4){bf_lo(xw.x), bf_hi(xw.x), bf_lo(xw.y), bf_hi(xw.y)}, g2 = *(const f32x4*)(mb + 5120 + 4 * lane + 256 * j);
            v[j] = x * ALPHA + (g2 + 1.0f) * (ff[j] * 0.0625f); }
        ln_row(v, F.in[27] + l * D, F.in[28] + l * D, lane);
#pragma unroll
        for (int j = 0; j < 4; ++j) { if (l == 0) { u32x2 w; w.x = cvt_pk_bf16(v[j][0], v[j][1]); w.y = cvt_pk_bf16(v[j][2], v[j][3]); *(u32x2*)(XB + (size_t)row * D + 4 * lane + 256 * j) = w; }
            else *(f32x4*)(X + (size_t)row * D + 4 * lane + 256 * j) = v[j]; }
        if (l == 0) { const float* mn = mod + (size_t)(16 + bi) * 6144; store_mod_row(v, mn, mn + 1024, H + (size_t)row * D, F.ws + WS_H8 + (size_t)row * D, lane); }
    }
}

#ifndef PH_MASK
#define PH_MASK 0xFFFF
#endif
#define PH(b) ((PH_MASK >> (b)) & 1)
#ifndef PROBE_MASK
#define PROBE_MASK 0
#endif
#define PB0(id) do { if ((PROBE_MASK >> (id)) & 1) pb_t0 = __builtin_amdgcn_s_memrealtime(); } while (0)
#define PB1(id) do { if ((PROBE_MASK >> (id)) & 1) pb_acc += __builtin_amdgcn_s_memrealtime() - pb_t0; } while (0)
#define RELOAD() do { int t_ = threadIdx.x; asm volatile("" : "+v"(t_)); F.tid = t_; F.lane = t_ & 63; F.wave = __builtin_amdgcn_readfirstlane(t_ >> 6); \
    unsigned z_; asm volatile("s_mov_b32 %0, 0" : "=s"(z_)); F.in = p.in; F.out = p.out + z_; F.ws = p.ws + z_; } while (0)
#define LAYER_BODY(l) do { \
          \
        PB0(2); RELOAD(); \
        if (PH(2)) { \
              \
            pg8::SchedDense S; S.init(NT, 7 * 256, D, F.G, F.bx, (const bf16_t*)(F.ws + WS_WIN) + (size_t)l * INW * D, 2); \
            pg8::EpiZ E{(bf16_t*)(F.ws + WS_Z), F.in[13] + l * INW, F.out, l, F.ws + WS_ZG8}; \
            pg8::gemm_phase<false, 0u>(F.lds, (const char*)(F.ws + WS_H), D, S, E); \
        } \
        RELOAD(); \
        if (PH(2)) { \
              \
            pg8::SchedDense S; S.init(NT, 10 * 256, 512, F.G, (F.G == 256) ? ((F.bx + 112) & 255) : F.bx, F.ws + WS_WIN8 + (size_t)l * INW * D, 0, 2, 7); \
            pg8::EpiZ E{(bf16_t*)(F.ws + WS_Z), F.in[13] + l * INW, F.out, l, F.ws + WS_ZG8}; \
            pg8::gemm_phase<true, 0x7f7f7f7fu>(F.lds, (const char*)(F.ws + WS_H8), 512, S, E); \
        } \
        xcd_barrier(xbar); PB1(2); PB0(3); \
        RELOAD(); \
        if (PH(3)) phase_attn(F, l); \
        xcd_barrier(xbar); PB1(3); PB0(4); \
          \
        RELOAD(); \
        if (PH(4)) { \
            pg8::SchedDense S; S.init(NT, D, 256, F.G, F.bx, F.ws + WS_WOA + (size_t)l * D * 512); \
            pg8::EpiT1 E{F.ws + WS_T1, F.ws + WS_ZG8}; \
            pg8::gemm_phase<true, 0x7c7c7c7cu>(F.lds, (const char*)(F.ws + WS_YA), 256, S, E); \
        } \
        RELOAD(); \
        if (PH(5)) { \
            pg8::SchedDense S; S.init(NT, D, 256, F.G, F.bx, F.ws + WS_WOB + (size_t)l * D * 512); \
            pg8::EpiMix E{F.ws + WS_T1, F.ws + WS_ZG8, F.ws + WS_MIX}; \
            pg8::gemm_phase<true, 0x7f7f7f7fu>(F.lds, (const char*)(F.ws + WS_YB), 256, S, E); \
        } \
        xcd_barrier(xbar); PB1(4); PB0(5); \
          \
        RELOAD(); \
        if (PH(6)) { \
            pg8::SchedDense S; S.init(NT, D, 512, F.G, F.bx, F.ws + WS_WO + (size_t)l * D * D); \
            pg8::EpiX E{(const bf16_t*)(F.ws + WS_XB), (bf16_t*)(F.ws + WS_V16), (const float*)(F.ws + WS_MOD) + (size_t)l * 16 * 6144}; \
            pg8::gemm_phase<true, 0x7f7f7f7fu>(F.lds, (const char*)(F.ws + WS_MIX), 512, S, E); \
        } \
        xcd_barrier(xbar); PB1(5); PB0(6); \
        RELOAD(); \
        if (PH(7)) phase_ln_router(F, l); \
        xcd_barrier(xbar); PB1(6); PB0(7); \
          \
        RELOAD(); \
        build_blk(F, l); \
        if (PH(8)) { \
            LAS int* blk = (LAS int*)(F.lds + LDS_BLK); \
            LAS unsigned short* idx = (LAS unsigned short*)(F.lds + LDS_IDX); \
            pg8::SchedMoE<true> S; S.init(blk, idx, 8, 512, F.G, F.bx, (const unsigned char*)(F.ws + WS_WGU) + (size_t)l * 32 * 2048 * D, (size_t)2048 * D); \
            const unsigned* cnt = (const unsigned*)(F.ws + WS_CNT) + l * 2048; const unsigned* tok = (const unsigned*)(F.ws + WS_TOK); \
            for (int i = 0; i < MAXU; ++i) { pg8::Unit u; if (!S.next(i, u)) break; \
                if (F.tid < 256) { int rank = (u.pm - blk[u.e]) * 256 + F.tid; const int ce = (int)cnt[u.e * 64]; rank = rank < ce ? rank : ce - 1; \
                    idx[i * 256 + F.tid] = (unsigned short)tok[(size_t)u.e * NT + rank]; } } \
            __syncthreads(); \
            pg8::EpiAct E{(unsigned char*)(F.ws + WS_ACT), F.in[24] + (size_t)l * 32 * 2048}; \
            pg8::gemm_phase<true, 0x7f7f7f7fu>(F.lds, (const char*)(F.ws + WS_H8), 512, S, E); \
        } \
        xcd_barrier(xbar); PB1(7); PB0(8); \
          \
        RELOAD(); \
        if (PH(9)) { \
            LAS int* blk = (LAS int*)(F.lds + LDS_BLK); \
            LAS unsigned short* idx = (LAS unsigned short*)(F.lds + LDS_IDX); \
            pg8::SchedMoE<false> S; S.init(blk, idx, 4, 512, F.G, F.bx, (const unsigned char*)(F.ws + WS_WDN) + (size_t)l * 32 * D * D, (size_t)D * D); \
            pg8::EpiYs E{F.ws + WS_YS, F.in[26] + (size_t)l * 32 * D, (const float*)(F.ws + WS_GATE), (const LAS int*)(F.lds + LDS_CNT), blk}; \
            pg8::gemm_phase<true, 0x7f7f7f7fu>(F.lds, (const char*)(F.ws + WS_ACT), 512, S, E); \
        } \
        xcd_barrier(xbar); PB1(8); PB0(9); \
        RELOAD(); \
        if (PH(10)) phase_combine(F, l); \
        if (l == 0) xcd_barrier(xbar); \
        PB1(9); \
 \
    } while (0)
__global__ void __launch_bounds__(NTHREADS, 2) fwd_megakernel(Params p) {
    extern __shared__ __attribute__((aligned(16))) unsigned char lds_raw[];
    cg::grid_group grid = cg::this_grid();
    Ctx F;
    F.lds = (LAS unsigned char*)lds_raw;
    F.G = gridDim.x; F.bx = blockIdx.x;
    volatile LAS unsigned* bst = (volatile LAS unsigned*)(F.lds + 147392);
    if (threadIdx.x < 2) bst[threadIdx.x] = 0u;
    __syncthreads();
    const XcdBarrier xbar = xcd_barrier_post((unsigned*)(p.ws + WS_BAR), bst);
    unsigned long long pb_t0 = 0, pb_acc = 0;
    PB0(0); RELOAD();
    if (PH(0)) phase0a(F);
    grid.sync();
    PB1(0); PB0(1); RELOAD();
    { const float* modp = (const float*)(F.ws + WS_MODP); float* mod = (float*)(F.ws + WS_MOD);
      for (int i = F.bx * NTHREADS + F.tid; i < 2 * 16 * 6144; i += F.G * NTHREADS) { float sm = 0.f;
#pragma unroll
          for (int kc = 0; kc < 8; ++kc) sm += modp[(size_t)kc * (2 * 16 * 6144) + i];
          mod[i] = sm; } }
    xcd_barrier(xbar);
    RELOAD();
    if (PH(1)) phase0b(F);
    xcd_barrier(xbar); PB1(1);

    LAYER_BODY(0);
    LAYER_BODY(1);
    if (PROBE_MASK != 0 && blockIdx.x == 0) { const unsigned long long te = __builtin_amdgcn_s_memrealtime(); while (__builtin_amdgcn_s_memrealtime() - te < pb_acc) __builtin_amdgcn_s_sleep(8); }
    (void)pb_t0; (void)pb_acc;
}

extern "C" void kernel_launch(void* const* d_in, const int* in_sizes, int n_in, void* d_out, int out_size, void* d_ws, size_t ws_size, hipStream_t stream) {
    static int grid = 0;
    if (grid == 0) {
        if (n_in != 29 || ws_size < WS_END) { fprintf(stderr, "kernel_launch: unexpected n_in %d / ws_size %zu (need %zu)\n", n_in, ws_size, (size_t)WS_END); grid = -1; return; }
        int dev = 0, cus = 0, per_cu = 0;
        hipGetDevice(&dev);
        hipDeviceGetAttribute(&cus, hipDeviceAttributeMultiprocessorCount, dev);
        if (hipFuncSetAttribute((const void*)fwd_megakernel, hipFuncAttributeMaxDynamicSharedMemorySize, LDS_BYTES) != hipSuccess) { fprintf(stderr, "kernel_launch: hipFuncSetAttribute failed\n"); grid = -1; return; }
        if (hipOccupancyMaxActiveBlocksPerMultiprocessor(&per_cu, (const void*)fwd_megakernel, NTHREADS, LDS_BYTES) != hipSuccess || per_cu < 1) { fprintf(stderr, "kernel_launch: occupancy query says %d blocks per CU\n", per_cu); per_cu = 1; }
        (void)hipGetLastError();
        grid = cus;
        if (grid != 256) fprintf(stderr, "kernel_launch: note: %d CUs (built for 256)\n", grid);
    }
    if (grid < 0) return;
    hipMemsetAsync((char*)d_ws, 0, WS_ZERO_BYTES, stream);
    Params p{};
    for (int i = 0; i < 29; ++i) p.in[i] = (const float*)d_in[i];
    p.out = (float*)d_out; p.ws = (unsigned char*)d_ws;
    void* args[] = {&p};
    hipError_t e = hipLaunchCooperativeKernel((const void*)fwd_megakernel, dim3(grid), dim3(NTHREADS), args, LDS_BYTES, stream);
    if (e != hipSuccess) fprintf(stderr, "kernel_launch: cooperative launch failed: %s (grid %d)\n", hipGetErrorString(e), grid);
}
```

```cpp
#include <hip/hip_runtime.h>
#include <hip/hip_cooperative_groups.h>
#include <cstdio>
#include <cstdint>
namespace cg = cooperative_groups;

#define LAS __attribute__((address_space(3)))
typedef unsigned short bf16_t;
typedef short bf16x8 __attribute__((ext_vector_type(8)));
typedef float f32x4 __attribute__((ext_vector_type(4)));
typedef float f32x16 __attribute__((ext_vector_type(16)));
typedef unsigned u32x4 __attribute__((ext_vector_type(4)));
typedef unsigned u32x2 __attribute__((ext_vector_type(2)));
typedef float f32x2 __attribute__((ext_vector_type(2)));
typedef int i32x4 __attribute__((ext_vector_type(4)));
typedef int i32x8 __attribute__((ext_vector_type(8)));

constexpr int D = 1024, NPROMPT = 32768, NT = 33280, INW = 4352, NEXP = 32;
constexpr float ALPHA = 1.41421356237f, LN_EPS = 1e-5f;
constexpr int NWAVES = 8, NTHREADS = 512;
constexpr int LDS_BYTES = 147456;
constexpr int LDS_BLK = 131072;
constexpr int LDS_IDX = 131072 + 256;
constexpr int MAXU = 20;
constexpr int LDS_BIASBUF = 141568;
constexpr int LDS_CNT = 145664;
constexpr size_t OKP = 34078720, OVP = 34340864, OCP = 34603008, OKS = 34619392, OVS = 34881536, OCS = 35143680;
constexpr size_t MiB = 1u << 20;
constexpr size_t WS_CNT = 0;
constexpr size_t WS_BAR = 16384;
constexpr size_t WS_MOD = 65536;
constexpr size_t WS_MODP = 192 * MiB;
constexpr size_t WS_ZERO_BYTES = 1 * MiB;
constexpr size_t WS_BIAS = 1 * MiB;
constexpr size_t WS_SLOT = 2 * MiB;
constexpr size_t WS_TOK = 3 * MiB;
constexpr size_t WS_GATE = 8 * MiB;
constexpr size_t WS_WIN = 16 * MiB;
constexpr size_t WS_WIN8 = 180 * MiB;
constexpr size_t WS_WOA = 34 * MiB;
constexpr size_t WS_WOB = 36 * MiB;
constexpr size_t WS_WO = 38 * MiB;
constexpr size_t WS_WGU = 48 * MiB;
constexpr size_t WS_WDN = 304 * MiB;
constexpr size_t WS_H = 432 * MiB;
constexpr size_t WS_H8 = 1600 * MiB;
constexpr size_t WS_Z = 498 * MiB;
constexpr size_t WS_YA = 776 * MiB;
constexpr size_t WS_YB = 810 * MiB;
constexpr size_t WS_T1 = 844 * MiB;
constexpr size_t WS_V16 = 910 * MiB;
constexpr size_t WS_XB = 1200 * MiB;
constexpr size_t WS_MIX = 976 * MiB;
constexpr size_t WS_ACT = 1042 * MiB;
constexpr size_t WS_YS = 1320 * MiB;
constexpr size_t WS_ZG8 = 1460 * MiB;
constexpr size_t WS_END = 1634 * MiB;

struct Params { const float* in[29]; float* out; unsigned char* ws; };

__device__ __forceinline__ unsigned cvt_pk_bf16(float lo, float hi) { unsigned r; asm volatile("v_cvt_pk_bf16_f32 %0, %1, %2" : "=v"(r) : "v"(lo), "v"(hi)); return r; }
__device__ __forceinline__ unsigned pk4_fp8(float a, float b, float c, float d) { unsigned w = 0u; w = __builtin_amdgcn_cvt_pk_fp8_f32(a, b, w, false); w = __builtin_amdgcn_cvt_pk_fp8_f32(c, d, w, true); return w; }
__device__ __forceinline__ void unpk8_fp8(const u32x2 w, float (&o)[8]) { const f32x2 a = __builtin_amdgcn_cvt_pk_f32_fp8(w.x, false), b = __builtin_amdgcn_cvt_pk_f32_fp8(w.x, true), c = __builtin_amdgcn_cvt_pk_f32_fp8(w.y, false), d = __builtin_amdgcn_cvt_pk_f32_fp8(w.y, true);
    o[0] = a.x; o[1] = a.y; o[2] = b.x; o[3] = b.y; o[4] = c.x; o[5] = c.y; o[6] = d.x; o[7] = d.y; }
__device__ __forceinline__ float bf_lo(unsigned w) { return __uint_as_float(w << 16); }
__device__ __forceinline__ float bf_hi(unsigned w) { return __uint_as_float(w & 0xffff0000u); }
__device__ __forceinline__ float sigmoidf_(float x) { return __builtin_amdgcn_rcpf(1.0f + __expf(-x)); }
__device__ __forceinline__ float wave_sum(float v) {
#define WS_DPP_ADD(ctrl) v += __int_as_float(__builtin_amdgcn_update_dpp(0, __float_as_int(v), (ctrl), 0xf, 0xf, true))
    WS_DPP_ADD(0xB1);
    WS_DPP_ADD(0x4E);
    WS_DPP_ADD(0x141);
    WS_DPP_ADD(0x140);
#undef WS_DPP_ADD
    const int b = __float_as_int(v);
    const float r0 = __int_as_float(__builtin_amdgcn_readlane(b, 0)), r1 = __int_as_float(__builtin_amdgcn_readlane(b, 16)), r2 = __int_as_float(__builtin_amdgcn_readlane(b, 32)), r3 = __int_as_float(__builtin_amdgcn_readlane(b, 48));
    return (r0 + r1) + (r2 + r3);
}
__device__ __forceinline__ int batch_of(int row) { return row < NPROMPT ? (row >> 12) : 8 + ((row - NPROMPT) >> 6); }

namespace pg8 {
constexpr int BM = 256, BK = 64, HALF = 128, HTB = HALF * BK * 2, NXCD = 8, WGM = 8;
__device__ __forceinline__ int lds_byte(int r, int c) { const int st = (r >> 4) * 2 + (c >> 5), rr = r & 15, cc = c & 31, ob = rr * 64 + cc * 2; return st * 1024 + (ob ^ (((ob >> 9) & 1) << 5)); }
__device__ __forceinline__ void stage_rc(int b, int& R, int& C) { const int st = b / 1024, sb = b % 1024, swz = sb ^ (((sb >> 9) & 1) << 5); R = (st >> 1) * 16 + swz / 64; C = (st & 1) * 32 + (swz % 64) / 2; }
__device__ __forceinline__ int perm32(int rho) { const int n = rho >> 4, i = rho & 15; return 8 * (i >> 2) + 4 * n + (i & 3); }

struct Unit { int pm, pn, e; const char* b; };

struct SchedDense {
    int nM, nN, nwg, G, c, cbase, csplit, cskip; const char* Bt; size_t tstepB;
    __device__ __forceinline__ void init(int M, int N, int K, int G_, int c_, const void* Bt_, int cbase_ = 0, int csplit_ = 1 << 20, int cskip_ = 0) { nM = M / BM; nN = N / BM; nwg = nM * nN; G = G_; c = c_; Bt = (const char*)Bt_; tstepB = (size_t)BM * K * 2; cbase = cbase_; csplit = csplit_; cskip = cskip_; }
    __device__ __forceinline__ bool next(int i, Unit& u) const {
        const long L = (long)i * G + c; if (L >= nwg) return false;
        int wgid = (int)L; { const int q = nwg / NXCD, r = nwg % NXCD, xcd = wgid % NXCD, off = wgid / NXCD; wgid = (xcd < r ? xcd * (q + 1) : r * (q + 1) + (xcd - r) * q) + off; }
        const int nig = WGM * nN, gid = wgid / nig, fm = gid * WGM, gsz = (nM - fm) < WGM ? (nM - fm) : WGM;
        u.pm = fm + ((wgid % nig) % gsz); const int j = (wgid % nig) / gsz; u.pn = j < csplit ? j + cbase : j + cbase + cskip; u.e = 0; u.b = Bt + (size_t)u.pn * tstepB; return true;
    }
    __device__ __forceinline__ unsigned rowidx(int, const Unit& u, int r) const { return (unsigned)(u.pm * BM + r); }
};
template <bool GATHER> struct SchedMoE {
    const LAS int* blk; const LAS unsigned short* idx; int NB, RBX, NPN, NXs, perx, cx, cj; const char* Bt; size_t estep, tstepB;
    __device__ __forceinline__ void init(const LAS int* blk_, const LAS unsigned short* idx_, int NPN_, int K, int G, int c, const void* Bt_, size_t estep_) {
        blk = blk_; idx = idx_; NB = blk_[32]; NPN = NPN_; Bt = (const char*)Bt_; estep = estep_; tstepB = (size_t)BM * K * 2;
        if ((G & 7) == 0) { NXs = 8; perx = G >> 3; cx = c & 7; cj = c >> 3; } else { NXs = 1; perx = G; cx = 0; cj = c; }
        RBX = (NB + NXs - 1) / NXs;
    }
    __device__ __forceinline__ bool next(int i, Unit& u) const {
        const int j = i * perx + cj, rbl = j / NPN; if (rbl >= RBX) return false;
        const int rb = cx * RBX + rbl; if (rb >= NB) return false;
        int e = 0;
        for (int q = 1; q < 32; ++q) e = (blk[q] <= rb) ? q : e;
        u.pm = rb; u.pn = j - rbl * NPN; u.e = e; u.b = Bt + (size_t)e * estep + (size_t)u.pn * tstepB; return true;
    }
    __device__ __forceinline__ unsigned rowidx(int ui, const Unit& u, int r) const { if (GATHER) return (unsigned)idx[ui * 256 + r]; return (unsigned)(u.pm * BM + r); }
};

template <bool FP8, unsigned ASCALE, class Epi, class Sched>
__device__ __forceinline__ void gemm_phase(LAS unsigned char* lds, const char* Abase, const int K, const Sched& S, const Epi& E) {
    int tid_ = threadIdx.x; asm volatile("" : "+v"(tid_));
    const int tid = tid_, wid = __builtin_amdgcn_readfirstlane(tid >> 6), lane = tid & 63, wr = wid >> 2, wc = wid & 3, fr = lane & 15, fq = lane >> 4;
    int nt_ = K / BK; asm volatile("" : "+s"(nt_)); const int nt = nt_;
    unsigned voffB[2]; int RA[2], CA[2];
#pragma unroll
    for (int i = 0; i < 2; ++i) { int R, C; stage_rc(tid * 16 + i * 8192, R, C); const int Rb = Epi::PERM ? ((R & ~31) + perm32(R & 31)) : R;
        voffB[i] = (unsigned)(Rb * K + C) * 2u; RA[i] = R; CA[i] = C * 2; }
    const size_t kstep = (size_t)(BK * 2);
    const size_t hstep = (size_t)HALF * K * 2;
    const unsigned ldsw = (unsigned)wid * 1024u;
    const unsigned rowb = (unsigned)K * 2u;
    const int aoff = lds_byte(wr * 64 + fr, fq * 8), boff = lds_byte(wc * 32 + fr, fq * 8);
#define PG8_SA(b, h) (((b) * 2 + (h)) * HTB)
#define PG8_SB(b, h) ((4 + (b) * 2 + (h)) * HTB)
#define PG8_STAGE(bufoff, gbase, voff) do { _Pragma("unroll") for (int _i = 0; _i < 2; ++_i) \
        __builtin_amdgcn_global_load_lds((const unsigned*)((const char*)(gbase) + (voff)[_i]), (LAS unsigned*)(lds + (bufoff) + ldsw + _i * 8192), 16, 0, 0); } while (0)
#define PG8_LDA(dst, b, h) do { _Pragma("unroll") for (int m = 0; m < 4; ++m) _Pragma("unroll") for (int k = 0; k < 2; ++k) dst[m][k] = *(const LAS bf16x8*)(lds + PG8_SA(b, h) + aoff + m * 2048 + k * 1024); } while (0)
#define PG8_LDB(dst, b, h) do { _Pragma("unroll") for (int n = 0; n < 2; ++n) _Pragma("unroll") for (int k = 0; k < 2; ++k) dst[n][k] = *(const LAS bf16x8*)(lds + PG8_SB(b, h) + boff + n * 2048 + k * 1024); } while (0)
#define PG8_MMA(ai, bj, At, Bt) do { __builtin_amdgcn_s_setprio(1); _Pragma("unroll") for (int m = 0; m < 4; ++m) _Pragma("unroll") for (int n = 0; n < 2; ++n) { \
        if constexpr (FP8) { \
            const i32x8 wf_ = __builtin_shufflevector((i32x4)Bt[n][0], (i32x4)Bt[n][1], 0, 1, 2, 3, 4, 5, 6, 7), af_ = __builtin_shufflevector((i32x4)At[m][0], (i32x4)At[m][1], 0, 1, 2, 3, 4, 5, 6, 7); \
            acc[ai][bj][m][n] = __builtin_amdgcn_mfma_scale_f32_16x16x128_f8f6f4(wf_, af_, acc[ai][bj][m][n], 0, 0, 0, 0x79797979, 0, (int)ASCALE); \
        } else { _Pragma("unroll") for (int k = 0; k < 2; ++k) \
            acc[ai][bj][m][n] = __builtin_amdgcn_mfma_f32_16x16x32_bf16(Bt[n][k], At[m][k], acc[ai][bj][m][n], 0, 0, 0); } } \
        __builtin_amdgcn_s_setprio(0); } while (0)
#define PG8_WAIT_V(n) asm volatile("s_waitcnt vmcnt(" #n ")" ::: "memory")
#define PG8_WAIT_L(n) asm volatile("s_waitcnt lgkmcnt(" #n ")" ::: "memory")
#define PG8_BAR __builtin_amdgcn_s_barrier()
#define PG8_SCHED __builtin_amdgcn_sched_barrier(0)
#define PG8_LOADVA(ui_, u_) do { _Pragma("unroll") for (int _h = 0; _h < 2; ++_h) _Pragma("unroll") for (int _i = 0; _i < 2; ++_i) \
        vA[_h][_i] = S.rowidx((ui_), (u_), _h * HALF + RA[_i]) * rowb + (unsigned)CA[_i]; } while (0)
    Unit cur, nxt; int ui = 0;
    if (!S.next(0, cur)) return;
    f32x4 acc[2][2][4][2];
#pragma unroll
    for (int a = 0; a < 2; ++a)
#pragma unroll
        for (int b = 0; b < 2; ++b)
#pragma unroll
            for (int m = 0; m < 4; ++m)
#pragma unroll
                for (int n = 0; n < 2; ++n) acc[a][b][m][n] = (f32x4){0.f, 0.f, 0.f, 0.f};
    bf16x8 At[4][2], B0[2][2], B1[2][2];
    unsigned vA[2][2];
    PG8_LOADVA(0, cur);
    const char* cB = cur.b;
    if (Epi::BIAS && tid < 64) __builtin_amdgcn_global_load_lds((const unsigned*)E.bias_ptr(cur, tid), (LAS unsigned*)(lds + LDS_BIASBUF), 16, 0, 0);
    if (Epi::EXTRA && tid < 64) __builtin_amdgcn_global_load_lds((const unsigned*)E.extra_ptr(cur, tid), (LAS unsigned*)(lds + LDS_BIASBUF + 1024), 16, 0, 0);
    PG8_STAGE(PG8_SB(0, 0), cB, voffB); PG8_STAGE(PG8_SB(0, 1), cB + hstep, voffB); PG8_STAGE(PG8_SA(0, 0), Abase, vA[0]); PG8_STAGE(PG8_SA(0, 1), Abase, vA[1]);
    if (wr == 1) PG8_BAR;
    PG8_WAIT_V(2); PG8_BAR;
    PG8_STAGE(PG8_SB(1, 0), cB + kstep, voffB); PG8_STAGE(PG8_SA(1, 0), Abase + kstep, vA[0]); PG8_STAGE(PG8_SB(1, 1), cB + hstep + kstep, voffB);
    PG8_WAIT_V(6); PG8_BAR;
    for (;;) {
        const bool has_next = S.next(ui + 1, nxt);
        const char* nB = has_next ? nxt.b : cB;
#pragma unroll 1
        for (int t = 0; t < nt; t += 2) {
            const bool last = (t == nt - 2);
            const char* a1 = Abase + (size_t)(t + 1) * kstep;
            const char* a2 = last ? Abase : Abase + (size_t)(t + 2) * kstep;
            const char* b2 = last ? nB : cB + (size_t)(t + 2) * kstep;
            const char* a3 = a2 + kstep; const char* b3 = b2 + kstep;
            PG8_LDB(B0, 0, 0); PG8_LDB(B1, 0, 1); PG8_SCHED; PG8_LDA(At, 0, 0); PG8_STAGE(PG8_SA(1, 1), a1, vA[1]);
            if (last && has_next) { PG8_LOADVA(ui + 1, nxt);
                if (Epi::BIAS && tid < 64) __builtin_amdgcn_global_load_lds((const unsigned*)E.bias_ptr(nxt, tid), (LAS unsigned*)(lds + LDS_BIASBUF + ((ui + 1) & 1) * 2048), 16, 0, 0);
                if (Epi::EXTRA && tid < 64) __builtin_amdgcn_global_load_lds((const unsigned*)E.extra_ptr(nxt, tid), (LAS unsigned*)(lds + LDS_BIASBUF + ((ui + 1) & 1) * 2048 + 1024), 16, 0, 0); }
            PG8_WAIT_V(8); PG8_WAIT_L(0); PG8_BAR; PG8_MMA(0, 0, At, B0); PG8_MMA(0, 1, At, B1); PG8_BAR; PG8_SCHED;
            PG8_LDA(At, 0, 1); PG8_STAGE(PG8_SB(0, 0), b2, voffB); PG8_STAGE(PG8_SB(0, 1), b2 + hstep, voffB); PG8_STAGE(PG8_SA(0, 0), a2, vA[0]);
            PG8_WAIT_V(8); PG8_WAIT_L(0); PG8_BAR; PG8_MMA(1, 0, At, B0); PG8_MMA(1, 1, At, B1); PG8_BAR; PG8_SCHED;
            PG8_LDB(B0, 1, 0); PG8_LDB(B1, 1, 1); PG8_SCHED; PG8_LDA(At, 1, 0); PG8_STAGE(PG8_SA(0, 1), a2, vA[1]);
            PG8_WAIT_V(8); PG8_WAIT_L(0); PG8_BAR; PG8_MMA(0, 0, At, B0); PG8_MMA(0, 1, At, B1); PG8_BAR; PG8_SCHED;
            PG8_LDA(At, 1, 1); PG8_STAGE(PG8_SB(1, 0), b3, voffB); PG8_STAGE(PG8_SB(1, 1), b3 + hstep, voffB); PG8_STAGE(PG8_SA(1, 0), a3, vA[0]);
            PG8_WAIT_V(8); PG8_WAIT_L(0); PG8_BAR; PG8_MMA(1, 0, At, B0); PG8_MMA(1, 1, At, B1); PG8_BAR; PG8_SCHED;
        }
        if (wr == 0) PG8_BAR;
        E(acc, cur, wr, wc, fr, fq, (const LAS float*)(lds + LDS_BIASBUF + (ui & 1) * 2048));
        if (!has_next) break;
#pragma unroll
        for (int a = 0; a < 2; ++a)
#pragma unroll
            for (int b = 0; b < 2; ++b)
#pragma unroll
                for (int m = 0; m < 4; ++m)
#pragma unroll
                    for (int n = 0; n < 2; ++n) acc[a][b][m][n] = (f32x4){0.f, 0.f, 0.f, 0.f};
        cur = nxt; cB = nB; ++ui;
        if (wr == 1) PG8_BAR;
    }
    PG8_WAIT_V(0);
    PG8_BAR;
#undef PG8_SA
#undef PG8_SB
#undef PG8_STAGE
#undef PG8_LDA
#undef PG8_LDB
#undef PG8_MMA
#undef PG8_WAIT_V
#undef PG8_WAIT_L
#undef PG8_BAR
#undef PG8_SCHED
#undef PG8_LOADVA
}

typedef f32x4 Acc[2][2][4][2];

struct EpiZ {
    static constexpr bool PERM = true, BIAS = true, EXTRA = false;
    __device__ __forceinline__ const float* extra_ptr(const Unit&, int) const { return nullptr; }
    __device__ __forceinline__ const float* bias_ptr(const Unit& u, int t) const { return bias + u.pn * 256 + 4 * t; }
    bf16_t* Z; const float* bias; float* out; int l; unsigned char* ZG;
    __device__ __forceinline__ void operator()(const Acc& acc, const Unit& u, int wr, int wc, int fr, int fq, const LAS float* lb) const {
        const int row0 = u.pm * 256 + wr * 64 + fr, col0 = u.pn * 256 + wc * 32 + 8 * fq;
        f32x4 bv[2][2];
#pragma unroll
        for (int bj = 0; bj < 2; ++bj)
#pragma unroll
            for (int n = 0; n < 2; ++n) bv[bj][n] = *(const LAS f32x4*)(lb + bj * 128 + wc * 32 + 8 * fq + 4 * n);
#pragma unroll
        for (int ai = 0; ai < 2; ++ai)
#pragma unroll
            for (int m = 0; m < 4; ++m) {
                const int row = row0 + ai * 128 + m * 16;
                bf16_t* rowp = Z + (size_t)row * INW + col0;
                float* ko = nullptr; float* vo = nullptr;
                if (u.pn == 2) {
                    if (row < NPROMPT) { const int t = row & 4095; if (t >= 3968) { const size_t o = ((size_t)(l * 8 + (row >> 12)) * 128 + (t - 3968)) * 128 + wc * 32 + 8 * fq; ko = out + OKP + o; vo = out + OVP + o; } }
                    else { const int rr = row - NPROMPT; const size_t o = ((size_t)(l * 8 + (rr >> 6)) * 128 + 64 + (rr & 63)) * 128 + wc * 32 + 8 * fq; ko = out + OKS + o; vo = out + OVS + o; }
                }
#pragma unroll
                for (int bj = 0; bj < 2; ++bj) {
                    const f32x4 v0 = acc[ai][bj][m][0] + bv[bj][0], v1 = acc[ai][bj][m][1] + bv[bj][1];
                    if (u.pn >= 9) { u32x2 w8; w8.x = pk4_fp8(v0[0], v0[1], v0[2], v0[3]); w8.y = pk4_fp8(v1[0], v1[1], v1[2], v1[3]);
                        *(u32x2*)(ZG + (size_t)row * 2048 + (col0 - 2304) + bj * 128) = w8; }
                    else { u32x4 w; w.x = cvt_pk_bf16(v0[0], v0[1]); w.y = cvt_pk_bf16(v0[2], v0[3]); w.z = cvt_pk_bf16(v1[0], v1[1]); w.w = cvt_pk_bf16(v1[2], v1[3]);
                        *(u32x4*)(rowp + bj * 128) = w; }
                    float* o = bj == 0 ? ko : vo;
                    if (o) { *(f32x4*)o = v0; *(f32x4*)(o + 4) = v1; }
                }
                asm volatile("" ::: "memory");
            }
    }
};
struct EpiT1 {
    static constexpr bool PERM = true, BIAS = false, EXTRA = false;
    __device__ __forceinline__ const float* extra_ptr(const Unit&, int) const { return nullptr; }
    __device__ __forceinline__ const float* bias_ptr(const Unit&, int) const { return nullptr; }
    unsigned char* T1; const unsigned char* ZG;
    __device__ __forceinline__ void operator()(const Acc& acc, const Unit& u, int wr, int wc, int fr, int fq, const LAS float* lb) const {
        const int row0 = u.pm * 256 + wr * 64 + fr, col0 = u.pn * 256 + wc * 32 + 8 * fq;
        u32x2 g[2][4][2];
#pragma unroll
        for (int ai = 0; ai < 2; ++ai)
#pragma unroll
            for (int m = 0; m < 4; ++m)
#pragma unroll
                for (int bj = 0; bj < 2; ++bj) g[ai][m][bj] = *(const u32x2*)(ZG + (size_t)(row0 + ai * 128 + m * 16) * 2048 + col0 + bj * 128);
        asm volatile("" ::: "memory");
#pragma unroll
        for (int ai = 0; ai < 2; ++ai)
#pragma unroll
            for (int m = 0; m < 4; ++m) {
                const int row = row0 + ai * 128 + m * 16;
#pragma unroll
                for (int bj = 0; bj < 2; ++bj) {
                    float gg[8]; unpk8_fp8(g[ai][m][bj], gg);
                    f32x4 v0 = acc[ai][bj][m][0] * 16.0f, v1 = acc[ai][bj][m][1] * 16.0f;
#pragma unroll
                    for (int j = 0; j < 4; ++j) { v0[j] *= sigmoidf_(gg[j]); v1[j] *= sigmoidf_(gg[4 + j]); }
                    u32x2 w; w.x = pk4_fp8(v0[0], v0[1], v0[2], v0[3]); w.y = pk4_fp8(v1[0], v1[1], v1[2], v1[3]);
                    *(u32x2*)(T1 + (size_t)row * D + col0 + bj * 128) = w;
                }
            }
    }
};
struct EpiMix {
    static constexpr bool PERM = true, BIAS = false, EXTRA = false;
    __device__ __forceinline__ const float* extra_ptr(const Unit&, int) const { return nullptr; }
    __device__ __forceinline__ const float* bias_ptr(const Unit&, int) const { return nullptr; }
    const unsigned char* T1; const unsigned char* ZG; unsigned char* MIX;
    __device__ __forceinline__ void operator()(const Acc& acc, const Unit& u, int wr, int wc, int fr, int fq, const LAS float* lb) const {
        const int row0 = u.pm * 256 + wr * 64 + fr, col0 = u.pn * 256 + wc * 32 + 8 * fq;
        u32x2 g[2][4][2], t[2][4][2];
#pragma unroll
        for (int ai = 0; ai < 2; ++ai)
#pragma unroll
            for (int m = 0; m < 4; ++m)
#pragma unroll
                for (int bj = 0; bj < 2; ++bj) { const int row = row0 + ai * 128 + m * 16;
                    g[ai][m][bj] = *(const u32x2*)(ZG + (size_t)row * 2048 + 1024 + col0 + bj * 128);
                    t[ai][m][bj] = *(const u32x2*)(T1 + (size_t)row * D + col0 + bj * 128); }
        asm volatile("" ::: "memory");
#pragma unroll
        for (int ai = 0; ai < 2; ++ai)
#pragma unroll
            for (int m = 0; m < 4; ++m) {
                const int row = row0 + ai * 128 + m * 16;
#pragma unroll
                for (int bj = 0; bj < 2; ++bj) {
                    float gg[8], tt[8]; unpk8_fp8(g[ai][m][bj], gg); unpk8_fp8(t[ai][m][bj], tt);
                    const f32x4 a0 = acc[ai][bj][m][0], a1 = acc[ai][bj][m][1];
                    float v[8];
#pragma unroll
                    for (int j = 0; j < 4; ++j) { v[j] = tt[j] * 0.0625f + a0[j] * sigmoidf_(gg[j]); v[4 + j] = tt[4 + j] * 0.0625f + a1[j] * sigmoidf_(gg[4 + j]); }
                    u32x2 w; w.x = pk4_fp8(v[0], v[1], v[2], v[3]); w.y = pk4_fp8(v[4], v[5], v[6], v[7]);
                    *(u32x2*)(MIX + (size_t)row * D + col0 + bj * 128) = w;
                }
            }
    }
};
struct EpiX {
    static constexpr bool PERM = true, BIAS = false, EXTRA = false;
    __device__ __forceinline__ const float* extra_ptr(const Unit&, int) const { return nullptr; }
    __device__ __forceinline__ const float* bias_ptr(const Unit&, int) const { return nullptr; }
    const bf16_t* X; bf16_t* V; const float* modl;
    __device__ __forceinline__ void operator()(const Acc& acc, const Unit& u, int wr, int wc, int fr, int fq, const LAS float* lb) const {
        const int row0 = u.pm * 256 + wr * 64 + fr, col0 = u.pn * 256 + wc * 32 + 8 * fq;
        const bool uni = u.pm < 128;
        f32x4 g[2][2];
        if (uni) { const float* gp = modl + (size_t)(u.pm >> 4) * 6144 + 2048 + col0;
#pragma unroll
            for (int bj = 0; bj < 2; ++bj)
#pragma unroll
                for (int n = 0; n < 2; ++n) g[bj][n] = *(const f32x4*)(gp + bj * 128 + 4 * n) + 1.0f; }
#pragma unroll
        for (int ai = 0; ai < 2; ++ai) {
            u32x4 x[4][2];
#pragma unroll
            for (int m = 0; m < 4; ++m)
#pragma unroll
                for (int bj = 0; bj < 2; ++bj) x[m][bj] = *(const u32x4*)(X + (size_t)(row0 + ai * 128 + m * 16) * D + col0 + bj * 128);
            asm volatile("" ::: "memory");
#pragma unroll
            for (int m = 0; m < 4; ++m) {
                const int row = row0 + ai * 128 + m * 16;
                if (!uni) { const float* gp = modl + (size_t)batch_of(row) * 6144 + 2048 + col0;
#pragma unroll
                    for (int bj = 0; bj < 2; ++bj)
#pragma unroll
                        for (int n = 0; n < 2; ++n) g[bj][n] = *(const f32x4*)(gp + bj * 128 + 4 * n) + 1.0f; }
#pragma unroll
                for (int bj = 0; bj < 2; ++bj) {
                    const u32x4 xx = x[m][bj];
                    const f32x4 x0 = (f32x4){bf_lo(xx.x), bf_hi(xx.x), bf_lo(xx.y), bf_hi(xx.y)}, x1 = (f32x4){bf_lo(xx.z), bf_hi(xx.z), bf_lo(xx.w), bf_hi(xx.w)};
                    const f32x4 v0 = x0 * ALPHA + g[bj][0] * acc[ai][bj][m][0], v1 = x1 * ALPHA + g[bj][1] * acc[ai][bj][m][1];
                    u32x4 w; w.x = cvt_pk_bf16(v0[0], v0[1]); w.y = cvt_pk_bf16(v0[2], v0[3]); w.z = cvt_pk_bf16(v1[0], v1[1]); w.w = cvt_pk_bf16(v1[2], v1[3]);
                    *(u32x4*)(V + (size_t)row * D + col0 + bj * 128) = w;
                }
            }
            asm volatile("" ::: "memory");
        }
    }
};
struct EpiAct {
    static constexpr bool PERM = true, BIAS = true, EXTRA = false;
    __device__ __forceinline__ const float* extra_ptr(const Unit&, int) const { return nullptr; }
    __device__ __forceinline__ const float* bias_ptr(const Unit& u, int t) const { return bgu + (size_t)u.e * 2048 + u.pn * 128 + (t < 32 ? 4 * t : 1024 + 4 * (t - 32)); }
    unsigned char* ACT; const float* bgu;
    __device__ __forceinline__ void operator()(const Acc& acc, const Unit& u, int wr, int wc, int fr, int fq, const LAS float* lb) const {
        const int row0 = u.pm * 256 + wr * 64 + fr, c0 = u.pn * 128 + wc * 32 + 8 * fq;
        f32x4 bg[2], bl[2];
#pragma unroll
        for (int n = 0; n < 2; ++n) { bg[n] = *(const LAS f32x4*)(lb + wc * 32 + 8 * fq + 4 * n); bl[n] = *(const LAS f32x4*)(lb + 128 + wc * 32 + 8 * fq + 4 * n); }
#pragma unroll
        for (int ai = 0; ai < 2; ++ai)
#pragma unroll
            for (int m = 0; m < 4; ++m) {
                const int row = row0 + ai * 128 + m * 16;
                float a[8];
#pragma unroll
                for (int n = 0; n < 2; ++n)
#pragma unroll
                    for (int jp = 0; jp < 2; ++jp) {
                        f32x2 g = (f32x2){acc[ai][0][m][n][2 * jp], acc[ai][0][m][n][2 * jp + 1]} + (f32x2){bg[n][2 * jp], bg[n][2 * jp + 1]};
                        f32x2 li = (f32x2){acc[ai][1][m][n][2 * jp], acc[ai][1][m][n][2 * jp + 1]} + (f32x2){bl[n][2 * jp], bl[n][2 * jp + 1]};
                        g = __builtin_elementwise_min(g, (f32x2){7.0f, 7.0f});
                        li = __builtin_elementwise_min(__builtin_elementwise_max(li, (f32x2){-7.0f, -7.0f}), (f32x2){7.0f, 7.0f});
                        const f32x2 t = g * (-1.702f * 1.44269504089f);
                        f32x2 e; e.x = __builtin_amdgcn_exp2f(t.x); e.y = __builtin_amdgcn_exp2f(t.y);
                        const f32x2 dd = e + 1.0f;
                        f32x2 r; r.x = __builtin_amdgcn_rcpf(dd.x); r.y = __builtin_amdgcn_rcpf(dd.y);
                        const f32x2 av = (g * r) * (li + 1.0f);
                        a[n * 4 + 2 * jp] = av.x; a[n * 4 + 2 * jp + 1] = av.y;
                    }
                u32x2 w; w.x = pk4_fp8(a[0], a[1], a[2], a[3]); w.y = pk4_fp8(a[4], a[5], a[6], a[7]);
                *(u32x2*)(ACT + (size_t)row * D + c0) = w;
                asm volatile("" ::: "memory");
            }
    }
};
struct EpiYs {
    static constexpr bool PERM = true, BIAS = true, EXTRA = true;
    __device__ __forceinline__ const float* extra_ptr(const Unit& u, int t) const { return gate + (size_t)u.e * NT + (u.pm - blk[u.e]) * 256 + 4 * t; }
    __device__ __forceinline__ const float* bias_ptr(const Unit& u, int t) const { return bdn + (size_t)u.e * D + u.pn * 256 + 4 * t; }
    unsigned char* YS; const float* bdn; const float* gate; const LAS int* cnt; const LAS int* blk;
    __device__ __forceinline__ void operator()(const Acc& acc, const Unit& u, int wr, int wc, int fr, int fq, const LAS float* lb) const {
        const int r0 = wr * 64 + fr, col0 = u.pn * 256 + wc * 32 + 8 * fq;
        const int rank0 = (u.pm - blk[u.e]) * 256; const int ce = cnt[u.e];
        f32x4 bv[2][2];
#pragma unroll
        for (int bj = 0; bj < 2; ++bj)
#pragma unroll
            for (int n = 0; n < 2; ++n) bv[bj][n] = *(const LAS f32x4*)(lb + bj * 128 + wc * 32 + 8 * fq + 4 * n);
        float gts[2][4];
#pragma unroll
        for (int ai = 0; ai < 2; ++ai)
#pragma unroll
            for (int m = 0; m < 4; ++m) { const int rank = rank0 + r0 + ai * 128 + m * 16; const float gv = lb[256 + r0 + ai * 128 + m * 16]; gts[ai][m] = rank < ce ? 16.0f * gv : 0.0f; }
        asm volatile("" ::: "memory");
#pragma unroll
        for (int ai = 0; ai < 2; ++ai)
#pragma unroll
            for (int m = 0; m < 4; ++m) {
                const int r = r0 + ai * 128 + m * 16;
                const float gt = gts[ai][m];
                unsigned char* rowp = YS + (size_t)(u.pm * 256 + r) * D + col0;
#pragma unroll
                for (int bj = 0; bj < 2; ++bj) {
                    const f32x4 v0 = (acc[ai][bj][m][0] + bv[bj][0]) * gt, v1 = (acc[ai][bj][m][1] + bv[bj][1]) * gt;
                    u32x2 w; w.x = pk4_fp8(v0[0], v0[1], v0[2], v0[3]); w.y = pk4_fp8(v1[0], v1[1], v1[2], v1[3]);
                    *(u32x2*)(rowp + bj * 128) = w;
                }
                asm volatile("" ::: "memory");
            }
    }
};
}


#define XB_TMO      128
#define XB_XCNT(j)  (256  + 64 * (j))
#define XB_XSUB(j)  (1280 + 64 * (j))
#define XB_XGEN(j)  (2304 + 64 * (j))
#define XB_TOP      3328
#define XB_TOPGEN   3392
#define XCD_BAR_WORDS 3456
#define XB_SPIN_CAP (1u << 21)
__device__ __forceinline__ unsigned xb_ld(unsigned* p)              { return __hip_atomic_load(p, __ATOMIC_RELAXED, __HIP_MEMORY_SCOPE_AGENT); }
__device__ __forceinline__ unsigned xb_add(unsigned* p, unsigned v) { return __hip_atomic_fetch_add(p, v, __ATOMIC_RELAXED, __HIP_MEMORY_SCOPE_AGENT); }
__device__ __forceinline__ unsigned xb_xcc_id() { return (unsigned)__builtin_amdgcn_s_getreg((3 << 11) | 20) & 0xFu; }
#define XB_SPIN(cond, bar) do { unsigned _sp = 0; while (cond) { __builtin_amdgcn_s_sleep(1); \
    if ((++_sp & 255u) == 0u) { if (xb_ld(&(bar)[XB_TMO])) break; if (_sp > XB_SPIN_CAP) { atomicAdd(&(bar)[XB_TMO], 1u); break; } } } } while (0)
struct XcdBarrier { unsigned* bar; unsigned x; volatile LAS unsigned* st; };
__device__ __forceinline__ XcdBarrier xcd_barrier_post(unsigned* bar, volatile LAS unsigned* st) {
    XcdBarrier b; b.bar = bar; b.x = xb_xcc_id(); b.st = st;
    if (threadIdx.x == 0) (void)xb_add(&bar[XB_XCNT(b.x)], 1u);
    return b;
}
__device__ __forceinline__ void xcd_barrier_complete(unsigned* bar, unsigned x, unsigned& nloc, unsigned& nx) {
    const unsigned G = gridDim.x * gridDim.y * gridDim.z;
    unsigned sum, cnt, mine, sp = 0u;
    for (;;) {
        sum = 0u; cnt = 0u; mine = 0u;
#pragma unroll
        for (unsigned j = 0; j < 16; ++j) { const unsigned c = xb_ld(&bar[XB_XCNT(j)]); sum += c; cnt += (c > 0u) ? 1u : 0u; mine = (j == x) ? c : mine; }
        if (sum == G) break;
        __builtin_amdgcn_s_sleep(1);
        if ((++sp & 255u) == 0u) { if (xb_ld(&bar[XB_TMO])) break; if (sp > XB_SPIN_CAP) { atomicAdd(&bar[XB_TMO], 1u); break; } }
    }
    nloc = mine > 0u ? mine : 1u; nx = cnt > 0u ? cnt : 1u;
}
__device__ __forceinline__ void xcd_barrier(const XcdBarrier& b) {
    asm volatile("s_waitcnt vmcnt(0)" ::: "memory");
    __syncthreads();
    if (threadIdx.x == 0) {
        unsigned* bar = b.bar;
        __builtin_amdgcn_s_waitcnt(0);
        unsigned nloc = b.st[0], nx = b.st[1];
        if (nloc == 0u) { xcd_barrier_complete(bar, b.x, nloc, nx); b.st[0] = nloc; b.st[1] = nx; }
        const unsigned old = xb_add(&bar[XB_XSUB(b.x)], 1u);
        const unsigned gen = old / nloc;
        if (old + 1u == (gen + 1u) * nloc) {
            __builtin_amdgcn_fence(__ATOMIC_RELEASE, "agent");
            asm volatile("s_waitcnt vmcnt(0)" ::: "memory");
            const unsigned og = xb_add(&bar[XB_TOP], 1u);
            const unsigned tg = og / nx;
            if (og + 1u == (tg + 1u) * nx) xb_add(&bar[XB_TOPGEN], 1u);
            else XB_SPIN(xb_ld(&bar[XB_TOPGEN]) == tg, bar);
            __builtin_amdgcn_fence(__ATOMIC_ACQUIRE, "agent");
            xb_add(&bar[XB_XGEN(b.x)], 1u);
            asm volatile("s_waitcnt vmcnt(0)" ::: "memory");
        } else {
            XB_SPIN(xb_ld(&bar[XB_XGEN(b.x)]) == gen, bar);
            __builtin_amdgcn_fence(__ATOMIC_ACQUIRE, "agent");
            asm volatile("s_waitcnt vmcnt(0)" ::: "memory");
        }
    }
    __syncthreads();
}

struct Ctx {
    LAS unsigned char* lds; int tid, lane, wave, G, bx;
    const float* const* in; float* out; unsigned char* ws;
};
#define LDS_WAIT() asm volatile("s_waitcnt lgkmcnt(0)" ::: "memory")

struct TDesc { const float* src; unsigned char* dst; int N, K, k0, n0, kind, f8; };
__device__ __forceinline__ void t64_load(const TDesc& d, float (&v)[64], int lane) {
    const float* src = d.src + (size_t)d.k0 * d.N + d.n0 + lane;
#pragma unroll
    for (int kk = 0; kk < 64; ++kk) v[kk] = src[(size_t)kk * d.N];
}
__device__ __forceinline__ void t64_finish(const TDesc& d, const float (&v)[64], LAS unsigned char* scr, int lane) {
    if (d.f8) {
        LAS unsigned char* wp = scr + lane * 80;
#pragma unroll
        for (int q = 0; q < 4; ++q) { u32x4 o;
            o.x = pk4_fp8(64.f * v[16 * q + 0], 64.f * v[16 * q + 1], 64.f * v[16 * q + 2], 64.f * v[16 * q + 3]);
            o.y = pk4_fp8(64.f * v[16 * q + 4], 64.f * v[16 * q + 5], 64.f * v[16 * q + 6], 64.f * v[16 * q + 7]);
            o.z = pk4_fp8(64.f * v[16 * q + 8], 64.f * v[16 * q + 9], 64.f * v[16 * q + 10], 64.f * v[16 * q + 11]);
            o.w = pk4_fp8(64.f * v[16 * q + 12], 64.f * v[16 * q + 13], 64.f * v[16 * q + 14], 64.f * v[16 * q + 15]);
            *(LAS u32x4*)(wp + q * 16) = o; }
        LDS_WAIT(); asm volatile("" ::: "memory");
        const int c = lane & 3;
#pragma unroll
        for (int j = 0; j < 4; ++j) { const int nl = (lane >> 2) + 16 * j; const u32x4 o = *(const LAS u32x4*)(scr + nl * 80 + c * 16);
            const int n = d.n0 + nl; int dr = n;
            if (d.kind == 1) { dr = (n < 1024) ? ((n >> 7) * 256 + (n & 127)) : (((n - 1024) >> 7) * 256 + 128 + (n & 127)); }
            *(u32x4*)(d.dst + (size_t)dr * d.K + d.k0 + c * 16) = o; }
    } else {
        LAS unsigned char* wp = scr + lane * 144;
#pragma unroll
        for (int q = 0; q < 8; ++q) { u32x4 o;
            o.x = cvt_pk_bf16(v[8 * q + 0], v[8 * q + 1]); o.y = cvt_pk_bf16(v[8 * q + 2], v[8 * q + 3]); o.z = cvt_pk_bf16(v[8 * q + 4], v[8 * q + 5]); o.w = cvt_pk_bf16(v[8 * q + 6], v[8 * q + 7]);
            *(LAS u32x4*)(wp + q * 16) = o; }
        LDS_WAIT(); asm volatile("" ::: "memory");
        const int c = lane & 7;
#pragma unroll
        for (int j = 0; j < 8; ++j) { const int nl = (lane >> 3) + 8 * j; const u32x4 o = *(const LAS u32x4*)(scr + nl * 144 + c * 16);
            *(u32x4*)(d.dst + ((size_t)(d.n0 + nl) * d.K + d.k0) * 2 + c * 16) = o; }
    }
    LDS_WAIT(); asm volatile("" ::: "memory");
}
__device__ __forceinline__ TDesc t64_decode(const float* const* in, unsigned char* ws, int it) {
    TDesc d; int r = it, item, nblk;
    if (r < 32768) { const int m = r >> 9; item = r & 511; d.src = in[23] + (size_t)m * 1024 * 2048; d.dst = ws + WS_WGU + (size_t)m * 2048 * 1024; d.N = 2048; d.K = 1024; d.kind = 1; d.f8 = 1; }
    else if ((r -= 32768) < 16384) { const int m = r >> 8; item = r & 255; d.src = in[25] + (size_t)m * 1024 * 1024; d.dst = ws + WS_WDN + (size_t)m * 1024 * 1024; d.N = 1024; d.K = 1024; d.kind = 0; d.f8 = 1; }
    else if ((r -= 16384) < 2176) { const int m = r / 1088; item = r % 1088; d.src = in[12] + (size_t)m * 1024 * INW; d.dst = ws + WS_WIN + (size_t)m * INW * 1024 * 2; d.N = INW; d.K = 1024; d.kind = 0; d.f8 = 0; }
    else if ((r -= 2176) < 2176) { const int m = r / 1088; item = r % 1088; d.src = in[12] + (size_t)m * 1024 * INW; d.dst = ws + WS_WIN8 + (size_t)m * INW * 1024; d.N = INW; d.K = 1024; d.kind = 0; d.f8 = 1; }
    else if ((r -= 2176) < 512) { const int m = r >> 8; item = r & 255; d.src = in[18] + (size_t)m * 1024 * 1024; d.dst = ws + WS_WO + (size_t)m * 1024 * 1024; d.N = 1024; d.K = 1024; d.kind = 0; d.f8 = 1; }
    else if ((r -= 512) < 256) { const int m = r >> 7; item = r & 127; d.src = in[16] + (size_t)m * 512 * 1024; d.dst = ws + WS_WOA + (size_t)m * 1024 * 512; d.N = 1024; d.K = 512; d.kind = 0; d.f8 = 1; }
    else { r -= 256; const int m = r >> 7; item = r & 127; d.src = in[17] + (size_t)m * 512 * 1024; d.dst = ws + WS_WOB + (size_t)m * 1024 * 512; d.N = 1024; d.K = 512; d.kind = 0; d.f8 = 1; }
    nblk = d.N >> 6; const int kb = item / nblk; d.k0 = kb * 64; d.n0 = (item - kb * nblk) * 64;
    return d;
}

__device__ __forceinline__ int rel_bucket(int rel) {
    const int n = rel < 0 ? -rel : rel;
    int v;
    if (n < 8) v = n;
    else { const float nf = (float)n; int large = 8 + (int)(logf(nf / 8.0f) / 2.7725887298583984f * 8.0f); v = large < 15 ? large : 15; }
    return (rel > 0 ? 16 : 0) + v;
}

__device__ __forceinline__ void phase0a(Ctx& F) {
    LAS float* scr = (LAS float*)(F.lds + F.wave * 16384);
    const int gw = F.bx * NWAVES + F.wave, NGW = F.G * NWAVES;
    unsigned char* ws = F.ws;
    {
        float* modp = (float*)(ws + WS_MODP);
        for (int it = gw; it < 2 * 96 * 8; it += NGW) {
            const int kc = it & 7, cgp = (it >> 3) % 96, l = it / (8 * 96), k0 = kc * 128, n0 = cgp * 64;
#pragma unroll 4
            for (int j = 0; j < 32; ++j) { const int idx = F.lane + 64 * j, r = idx >> 7, kk = idx & 127;
                const float c = r < 8 ? F.in[2][r * 1024 + k0 + kk] : F.in[3][(r - 8) * 1024 + k0 + kk];
                scr[kk * 16 + r] = c * sigmoidf_(c); }
            LDS_WAIT(); asm volatile("" ::: "memory");
            float a[16];
#pragma unroll
            for (int r = 0; r < 16; ++r) a[r] = 0.f;
            const float* wp = F.in[10] + ((size_t)l * 1024 + k0) * 6144 + n0 + F.lane;
#pragma unroll 16
            for (int kk = 0; kk < 128; ++kk) {
                const float w = wp[(size_t)kk * 6144];
                const LAS f32x4* sp = (const LAS f32x4*)(scr + kk * 16);
                const f32x4 s0 = sp[0], s1 = sp[1], s2 = sp[2], s3 = sp[3];
                a[0] += s0[0] * w; a[1] += s0[1] * w; a[2] += s0[2] * w; a[3] += s0[3] * w;
                a[4] += s1[0] * w; a[5] += s1[1] * w; a[6] += s1[2] * w; a[7] += s1[3] * w;
                a[8] += s2[0] * w; a[9] += s2[1] * w; a[10] += s2[2] * w; a[11] += s2[3] * w;
                a[12] += s3[0] * w; a[13] += s3[1] * w; a[14] += s3[2] * w; a[15] += s3[3] * w;
            }
            const float bb = (kc == 0) ? F.in[11][l * 6144 + n0 + F.lane] : 0.f;
#pragma unroll
            for (int r = 0; r < 16; ++r) modp[(size_t)kc * (2 * 16 * 6144) + ((size_t)(l * 16 + r)) * 6144 + n0 + F.lane] = a[r] + bb;
            LDS_WAIT(); asm volatile("" ::: "memory");
        }
    }
    if (F.bx == 0) {
        float* bt = (float*)(ws + WS_BIAS);
        for (int i = F.tid; i < 8 * 256; i += NTHREADS) { const int h = i >> 8, ri = i & 255; const int rel = ri - 191;
            bt[i] = (ri < 255) ? F.in[7][rel_bucket(rel) * 8 + h] : 0.f; }
    }
    for (int i = F.bx * NTHREADS + F.tid; i < 2 * 8 * 64 * 128; i += F.G * NTHREADS) {
        const int lb = i >> 13, rem = i & 8191;
        F.out[OKS + (size_t)lb * 16384 + rem] = F.in[4][(size_t)lb * 16384 + 8192 + rem];
        F.out[OVS + (size_t)lb * 16384 + rem] = F.in[5][(size_t)lb * 16384 + 8192 + rem];
    }
    LAS unsigned char* scrb = F.lds + F.wave * 16384;
    constexpr int NITEMS = 32768 + 16384 + 2176 + 2176 + 512 + 256 + 256;
    {
        float va[64], vb[64]; TDesc da, db;
        int it = gw;
        if (it < NITEMS) { da = t64_decode(F.in, ws, it); t64_load(da, va, F.lane); }
        while (it < NITEMS) {
            int itn = it + NGW;
            if (itn < NITEMS) { db = t64_decode(F.in, ws, itn); t64_load(db, vb, F.lane); }
            t64_finish(da, va, scrb, F.lane);
            it = itn; if (it >= NITEMS) break;
            itn = it + NGW;
            if (itn < NITEMS) { da = t64_decode(F.in, ws, itn); t64_load(da, va, F.lane); }
            t64_finish(db, vb, scrb, F.lane);
            it = itn;
        }
    }
}

__device__ __forceinline__ void ln_row(f32x4 (&v)[4], const float* g, const float* b, int lane) {
    float s = 0.f;
#pragma unroll
    for (int j = 0; j < 4; ++j) s += (v[j][0] + v[j][1]) + (v[j][2] + v[j][3]);
    const float mean = wave_sum(s) * (1.0f / D); float s2 = 0.f;
#pragma unroll
    for (int j = 0; j < 4; ++j) { v[j] = v[j] - mean; s2 += (v[j][0] * v[j][0] + v[j][1] * v[j][1]) + (v[j][2] * v[j][2] + v[j][3] * v[j][3]); }
    const float rstd = 1.0f / sqrtf(wave_sum(s2) * (1.0f / D) + LN_EPS);
#pragma unroll
    for (int j = 0; j < 4; ++j) { const f32x4 gg = *(const f32x4*)(g + 4 * lane + 256 * j), bb = *(const f32x4*)(b + 4 * lane + 256 * j); v[j] = v[j] * rstd * gg + bb; }
}
__device__ __forceinline__ void store_mod_row(const f32x4 (&v)[4], const float* sh, const float* sc, bf16_t* hrow, unsigned char* h8row, int lane) {
#pragma unroll
    for (int j = 0; j < 4; ++j) { const f32x4 a = *(const f32x4*)(sc + 4 * lane + 256 * j), b = *(const f32x4*)(sh + 4 * lane + 256 * j);
        const f32x4 h = v[j] * (a + 1.0f) + b; u32x2 w; w.x = cvt_pk_bf16(h[0], h[1]); w.y = cvt_pk_bf16(h[2], h[3]);
        *(u32x2*)(hrow + 4 * lane + 256 * j) = w;
        *(unsigned*)(h8row + 4 * lane + 256 * j) = pk4_fp8(h[0], h[1], h[2], h[3]); }
}

__device__ __forceinline__ void phase0b(Ctx& F) {
    const int gw = F.bx * NWAVES + F.wave, NGW = F.G * NWAVES;
    const float* mod = (const float*)(F.ws + WS_MOD);
    bf16_t* H = (bf16_t*)(F.ws + WS_H);
    for (int row = gw; row < NT; row += NGW) {
        const float* xr = row < NPROMPT ? F.in[0] + (size_t)row * D : F.in[1] + (size_t)(row - NPROMPT) * D;
        f32x4 v[4];
#pragma unroll
        for (int j = 0; j < 4; ++j) v[j] = *(const f32x4*)(xr + 4 * F.lane + 256 * j);
        ln_row(v, F.in[8], F.in[9], F.lane);
#pragma unroll
        for (int j = 0; j < 4; ++j) { u32x2 w; w.x = cvt_pk_bf16(v[j][0], v[j][1]); w.y = cvt_pk_bf16(v[j][2], v[j][3]); *(u32x2*)((bf16_t*)(F.ws + WS_XB) + (size_t)row * D + 4 * F.lane + 256 * j) = w; }
        const float* mb = mod + (size_t)batch_of(row) * 6144;
        store_mod_row(v, mb, mb + 1024, H + (size_t)row * D, F.ws + WS_H8 + (size_t)row * D, F.lane);
    }
}

__device__ __forceinline__ void phase_attn(Ctx& F, int l) {
    const bf16_t* Z = (const bf16_t*)(F.ws + WS_Z);
    unsigned char* YA = F.ws + WS_YA;
    unsigned char* YB = F.ws + WS_YB;
    const float* biasr = (const float*)(F.ws + WS_BIAS);
    LAS unsigned char* Ks = F.lds;
    LAS unsigned char* Vt = F.lds + 27648;
    LAS float* bt = (LAS float*)(F.lds + 53248);
    const int lane = F.lane, tid = F.tid;
    int bt_kv = -1;
    for (int au = F.bx; au < 1040; au += F.G) {
        const bool isS = au >= 1024;
        const int kv = au & 1;
        const int b = isS ? ((au - 1024) >> 1) : (au >> 7);
        const int n = isS ? 0 : ((au & 127) >> 1);
        __syncthreads();
        if (kv != bt_kv) { for (int i = tid; i < 1024; i += NTHREADS) bt[i] = biasr[(kv * 4 + (i >> 8)) * 256 + (i & 255)]; bt_kv = kv; }
#pragma unroll
        for (int jj = 0; jj < 3; ++jj) {
            const int p = tid + NTHREADS * jj, key = p >> 3, ds = p & 7;
            u32x4 kq = (u32x4){0u, 0u, 0u, 0u}, vq = (u32x4){0u, 0u, 0u, 0u};
            if (!isS) {
                const int t = n * 64 + key - 128;
                if (t >= 0) { const bf16_t* zr = Z + (size_t)(b * 4096 + t) * INW + kv * 64 + ds * 8; kq = *(const u32x4*)(zr + 512); vq = *(const u32x4*)(zr + 640); }
            } else if (key < 128) {
                const size_t o = ((size_t)((l * 8 + b) * 128 + key) * 2 + kv) * 64 + ds * 8;
                const f32x4 k0 = *(const f32x4*)(F.in[4] + o), k1 = *(const f32x4*)(F.in[4] + o + 4), v0 = *(const f32x4*)(F.in[5] + o), v1 = *(const f32x4*)(F.in[5] + o + 4);
                kq.x = cvt_pk_bf16(k0[0], k0[1]); kq.y = cvt_pk_bf16(k0[2], k0[3]); kq.z = cvt_pk_bf16(k1[0], k1[1]); kq.w = cvt_pk_bf16(k1[2], k1[3]);
                vq.x = cvt_pk_bf16(v0[0], v0[1]); vq.y = cvt_pk_bf16(v0[2], v0[3]); vq.z = cvt_pk_bf16(v1[0], v1[1]); vq.w = cvt_pk_bf16(v1[2], v1[3]);
            } else {
                const bf16_t* zr = Z + (size_t)(NPROMPT + b * 64 + key - 128) * INW + kv * 64 + ds * 8; kq = *(const u32x4*)(zr + 512); vq = *(const u32x4*)(zr + 640);
            }
            *(LAS u32x4*)(Ks + key * 144 + ds * 16) = kq;
            LAS unsigned short* vp = (LAS unsigned short*)Vt + (ds * 8) * 200 + key;
            vp[0 * 200] = (unsigned short)(vq.x & 0xffffu); vp[1 * 200] = (unsigned short)(vq.x >> 16);
            vp[2 * 200] = (unsigned short)(vq.y & 0xffffu); vp[3 * 200] = (unsigned short)(vq.y >> 16);
            vp[4 * 200] = (unsigned short)(vq.z & 0xffffu); vp[5 * 200] = (unsigned short)(vq.z >> 16);
            vp[6 * 200] = (unsigned short)(vq.w & 0xffffu); vp[7 * 200] = (unsigned short)(vq.w >> 16);
        }
        __syncthreads();
        const int g = F.wave >> 1, qi = (F.wave & 1) * 32 + (lane & 31), hh = lane >> 5, head = kv * 4 + g;
        const int qrow = isS ? NPROMPT + b * 64 + qi : b * 4096 + n * 64 + qi;
        bf16x8 Qf[4];
#pragma unroll
        for (int ks = 0; ks < 4; ++ks) Qf[ks] = *(const bf16x8*)(Z + (size_t)qrow * INW + head * 64 + ks * 16 + hh * 8);
        f32x16 S[6];
#pragma unroll
        for (int kb = 0; kb < 6; ++kb) {
#pragma unroll
            for (int j = 0; j < 16; ++j) S[kb][j] = 0.f;
#pragma unroll
            for (int ks = 0; ks < 4; ++ks) {
                const bf16x8 A = *(const LAS bf16x8*)(Ks + (kb * 32 + (lane & 31)) * 144 + (ks * 16 + hh * 8) * 2);
                S[kb] = __builtin_amdgcn_mfma_f32_32x32x16_bf16(A, Qf[ks], S[kb], 0, 0, 0);
            }
        }
        const float sinkv = F.in[14][l * 8 + head];
        float mx = sinkv;
        const int kmin = isS ? 0 : (128 - n * 64);
#pragma unroll
        for (int kb = 0; kb < 6; ++kb)
#pragma unroll
            for (int j = 0; j < 16; ++j) {
                const int key = kb * 32 + 8 * (j >> 2) + 4 * hh + (j & 3);
                float sv = S[kb][j] * 0.125f + bt[g * 256 + key - qi + 63];
                sv = key >= kmin ? sv : -1e30f;
                S[kb][j] = sv; mx = fmaxf(mx, sv);
            }
        mx = fmaxf(mx, __shfl_xor(mx, 32));
        float sum = 0.f;
#pragma unroll
        for (int kb = 0; kb < 6; ++kb)
#pragma unroll
            for (int j = 0; j < 16; ++j) { const float p = __expf(S[kb][j] - mx); S[kb][j] = p; sum += p; }
        sum += __shfl_xor(sum, 32);
        sum += __expf(sinkv - mx);
        const float inv = 1.0f / sum;
        f32x16 O[2];
#pragma unroll
        for (int db = 0; db < 2; ++db)
#pragma unroll
            for (int j = 0; j < 16; ++j) O[db][j] = 0.f;
#pragma unroll
        for (int kb = 0; kb < 6; ++kb)
#pragma unroll
            for (int s2 = 0; s2 < 2; ++s2) {
                union { bf16x8 v; unsigned u[4]; } P;
#pragma unroll
                for (int q = 0; q < 4; ++q) P.u[q] = cvt_pk_bf16(S[kb][8 * s2 + 2 * q], S[kb][8 * s2 + 2 * q + 1]);
#pragma unroll
                for (int db = 0; db < 2; ++db) {
                    const LAS unsigned char* vb = Vt + (db * 32 + (lane & 31)) * 400 + (kb * 32 + 16 * s2 + 4 * hh) * 2;
                    union { bf16x8 v; u32x2 h[2]; } Vf;
                    Vf.h[0] = *(const LAS u32x2*)vb; Vf.h[1] = *(const LAS u32x2*)(vb + 16);
                    O[db] = __builtin_amdgcn_mfma_f32_32x32x16_bf16(Vf.v, P.v, O[db], 0, 0, 0);
                }
            }
        unsigned char* orow = YA + (size_t)qrow * 512 + head * 64 + 4 * hh; const float inv8 = inv * 8.0f;
#pragma unroll
        for (int db = 0; db < 2; ++db)
#pragma unroll
            for (int jq = 0; jq < 4; ++jq) {
                *(unsigned*)(orow + db * 32 + 8 * jq) = pk4_fp8(O[db][4 * jq] * inv8, O[db][4 * jq + 1] * inv8, O[db][4 * jq + 2] * inv8, O[db][4 * jq + 3] * inv8);
            }
    }
    int nxtra = 1040 % F.G; if (1040 < F.G || 2 * nxtra > F.G) nxtra = 0;
    if (F.bx < nxtra) return;
    const int gw = (F.bx - nxtra) * NWAVES + F.wave, NGW = (F.G - nxtra) * NWAVES;
    const float* cw = F.in[15] + (size_t)l * 3 * 512 + 8 * lane;
    float w0[8], w1[8], w2[8];
#pragma unroll
    for (int e = 0; e < 8; ++e) { w0[e] = cw[e]; w1[e] = cw[512 + e]; w2[e] = cw[1024 + e]; }
    for (int row = gw; row < NT; row += NGW) {
        const bool isS = row >= NPROMPT; const int b = isS ? ((row - NPROMPT) >> 6) : (row >> 12), t = isS ? ((row - NPROMPT) & 63) : (row & 4095);
        const bf16_t* zr = Z + (size_t)row * INW + 8 * lane;
        const u32x4 cb = *(const u32x4*)(zr + 768);
        float u[3][8];
#pragma unroll
        for (int d = 0; d < 3; ++d) {
            if (t - d >= 0) {
                const bf16_t* zz = zr - (size_t)d * INW; const u32x4 cc = *(const u32x4*)(zz + 1280), cx = *(const u32x4*)(zz + 1792);
                u[d][0] = bf_lo(cc.x) * bf_lo(cx.x); u[d][1] = bf_hi(cc.x) * bf_hi(cx.x); u[d][2] = bf_lo(cc.y) * bf_lo(cx.y); u[d][3] = bf_hi(cc.y) * bf_hi(cx.y);
                u[d][4] = bf_lo(cc.z) * bf_lo(cx.z); u[d][5] = bf_hi(cc.z) * bf_hi(cx.z); u[d][6] = bf_lo(cc.w) * bf_lo(cx.w); u[d][7] = bf_hi(cc.w) * bf_hi(cx.w);
            } else if (isS) {
                const float* hp = F.in[6] + ((size_t)(l * 8 + b) * 2 + (2 + t - d)) * 512 + 8 * lane;
                const f32x4 h0 = *(const f32x4*)hp, h1 = *(const f32x4*)(hp + 4);
#pragma unroll
                for (int e = 0; e < 4; ++e) { u[d][e] = h0[e]; u[d][4 + e] = h1[e]; }
            } else {
#pragma unroll
                for (int e = 0; e < 8; ++e) u[d][e] = 0.f;
            }
        }
        const float cbf[8] = {bf_lo(cb.x), bf_hi(cb.x), bf_lo(cb.y), bf_hi(cb.y), bf_lo(cb.z), bf_hi(cb.z), bf_lo(cb.w), bf_hi(cb.w)};
        float y[8];
#pragma unroll
        for (int e = 0; e < 8; ++e) y[e] = cbf[e] * (w0[e] * u[2][e] + w1[e] * u[1][e] + w2[e] * u[0][e]);
        u32x2 w; w.x = pk4_fp8(y[0], y[1], y[2], y[3]); w.y = pk4_fp8(y[4], y[5], y[6], y[7]);
        *(u32x2*)(YB + (size_t)row * 512 + 8 * lane) = w;
        const int tl = isS ? 62 : 4094;
        if (t >= tl) {
            float* o = F.out + (isS ? OCS : OCP) + ((size_t)(l * 8 + b) * 2 + (t - tl)) * 512 + 8 * lane;
            *(f32x4*)o = (f32x4){u[0][0], u[0][1], u[0][2], u[0][3]}; *(f32x4*)(o + 4) = (f32x4){u[0][4], u[0][5], u[0][6], u[0][7]};
        }
    }
}

__device__ __forceinline__ void phase_ln_router(Ctx& F, int l) {
    bf16_t* XB = (bf16_t*)(F.ws + WS_XB); unsigned char* H8 = (unsigned char*)(F.ws + WS_H8); const bf16_t* V16 = (const bf16_t*)(F.ws + WS_V16);
    const float* mod = (const float*)(F.ws + WS_MOD) + (size_t)l * 16 * 6144;
    unsigned* cnt = (unsigned*)(F.ws + WS_CNT) + l * 2048;
    unsigned* tok = (unsigned*)(F.ws + WS_TOK); float* gate = (float*)(F.ws + WS_GATE); unsigned* slot = (unsigned*)(F.ws + WS_SLOT);
    const float* Wr = F.in[21] + (size_t)l * 1024 * 32;
    LAS float* hf = (LAS float*)F.lds;
    LAS unsigned* hist = (LAS unsigned*)(F.lds + 146432); LAS unsigned* hbase = hist + 32;
    LAS u32x4* rec = (LAS u32x4*)(F.lds + 131328);
    int nrec_tiles = 0;
    __syncthreads();
    if (F.tid < 32) hist[F.tid] = 0u;
    const int lane = F.lane, w = F.wave;
    float breg[64];
    { const float* bp = Wr + (size_t)(128 * w) * 32 + lane;
#pragma unroll
      for (int s = 0; s < 64; ++s) breg[s] = bp[64 * s]; }
    for (int tidx = F.bx; tidx < 1024 + 256; tidx += F.G) {
        const int tile0 = tidx < 1024 ? tidx * 32 : NPROMPT + (tidx - 1024) * 2, nrows = tidx < 1024 ? 32 : 2;
        __syncthreads();
        if (w * 4 < nrows) {
            u32x2 pv[4][4];
#pragma unroll
            for (int rr = 0; rr < 4; ++rr) { const int rl = w * 4 + rr, row = rl < nrows ? tile0 + rl : tile0;
#pragma unroll
                for (int j = 0; j < 4; ++j) pv[rr][j] = *(const u32x2*)(V16 + (size_t)row * D + 4 * lane + 256 * j); }
#pragma unroll
            for (int rr = 0; rr < 4; ++rr) {
                const int rl = w * 4 + rr, row = tile0 + rl;
                if (rl < nrows) {
                    f32x4 v[4];
#pragma unroll
                    for (int j = 0; j < 4; ++j) v[j] = (f32x4){bf_lo(pv[rr][j].x), bf_hi(pv[rr][j].x), bf_lo(pv[rr][j].y), bf_hi(pv[rr][j].y)};
                    ln_row(v, F.in[19] + l * D, F.in[20] + l * D, lane);
#pragma unroll
                    for (int j = 0; j < 4; ++j) { u32x2 wq; wq.x = cvt_pk_bf16(v[j][0], v[j][1]); wq.y = cvt_pk_bf16(v[j][2], v[j][3]); *(u32x2*)(XB + (size_t)row * D + 4 * lane + 256 * j) = wq; }
                    const float* mb = mod + (size_t)batch_of(row) * 6144;
#pragma unroll
                    for (int j = 0; j < 4; ++j) { const f32x4 a = *(const f32x4*)(mb + 4096 + 4 * lane + 256 * j), b = *(const f32x4*)(mb + 3072 + 4 * lane + 256 * j);
                        const f32x4 h = v[j] * (a + 1.0f) + b;
                        *(unsigned*)(H8 + (size_t)row * D + 4 * lane + 256 * j) = pk4_fp8(h[0], h[1], h[2], h[3]);
                        LAS float* hp = hf + rl * 1025 + lane + 64 * j;
                        hp[0] = h[0]; hp[256] = h[1]; hp[512] = h[2]; hp[768] = h[3]; }
                }
            }
        }
        __syncthreads();
        f32x16 acc;
#pragma unroll
        for (int j = 0; j < 16; ++j) acc[j] = 0.f;
        {
            const LAS float* ap = hf + (lane & 31) * 1025 + 32 * w;
            const int hh = lane >> 5;
#pragma unroll
            for (int s = 0; s < 64; ++s) { const int kk = 2 * s + hh; acc = __builtin_amdgcn_mfma_f32_32x32x2f32(ap[(kk & 3) * 256 + (kk >> 2)], breg[s], acc, 0, 0, 0); }
        }
        __syncthreads();
        LAS float* red = hf;
#pragma unroll
        for (int j = 0; j < 16; ++j) red[(w * 32 + 8 * (j >> 2) + 4 * (lane >> 5) + (j & 3)) * 33 + (lane & 31)] = acc[j];
        __syncthreads();
        int e_sel[4]; float g_sel[4]; unsigned loc[4];
#pragma unroll
        for (int rr = 0; rr < 4; ++rr) {
            const int tk = w * 4 + rr;
            float val = -INFINITY;
            if (lane < 32) { float sacc = F.in[22][l * 32 + lane];
#pragma unroll
                for (int ww = 0; ww < 8; ++ww) sacc += red[(ww * 32 + tk) * 33 + lane];
                val = sacc; }
            float tv[4]; int te[4];
            {
                const int vbits = __float_as_int(val); int rank = 0;
#pragma unroll
                for (int j = 0; j < 32; ++j) { const float vj = __int_as_float(__builtin_amdgcn_readlane(vbits, j)); rank += (vj > val || (vj == val && j < lane)) ? 1 : 0; }
#pragma unroll
                for (int it = 0; it < 4; ++it) { const unsigned long long mk = __ballot(rank == it); const int ln = mk ? (__ffsll((long long)mk) - 1) : 0;
                    te[it] = ln; tv[it] = __int_as_float(__builtin_amdgcn_readlane(vbits, ln)); }
            }
            const float e1 = __expf(tv[1] - tv[0]), e2 = __expf(tv[2] - tv[0]), e3 = __expf(tv[3] - tv[0]);
            const float rs = 1.0f / (1.0f + e1 + e2 + e3);
            e_sel[rr] = lane == 0 ? te[0] : lane == 1 ? te[1] : lane == 2 ? te[2] : te[3];
            g_sel[rr] = (lane == 0 ? 1.0f : lane == 1 ? e1 : lane == 2 ? e2 : e3) * rs;
            loc[rr] = 0u;
            if (lane < 4 && tk < nrows) loc[rr] = atomicAdd((unsigned*)&hist[e_sel[rr]], 1u);
        }
        if (lane < 4) {
#pragma unroll
            for (int rr = 0; rr < 4; ++rr) {
                const int rl = w * 4 + rr;
                u32x4 rc; rc.x = (rl < nrows) ? (unsigned)(tile0 + rl) : 0xffffffffu; rc.y = (unsigned)(e_sel[rr] & 31); rc.z = loc[rr]; rc.w = __float_as_uint(g_sel[rr]);
                rec[(nrec_tiles * 32 + rl) * 4 + lane] = rc;
            }
        }
        ++nrec_tiles;
    }
    __syncthreads();
    if (F.tid < 32) { const unsigned hcount = hist[F.tid]; hbase[F.tid] = hcount ? atomicAdd(cnt + F.tid * 64, hcount) : 0u; }
    __syncthreads();
    for (int i = F.tid; i < nrec_tiles * 128; i += NTHREADS) {
        const u32x4 rc = rec[i];
        if (rc.x != 0xffffffffu) { const unsigned e = rc.y, rank = hbase[e] + rc.z;
            tok[(size_t)e * NT + rank] = rc.x; gate[(size_t)e * NT + rank] = __uint_as_float(rc.w); slot[(size_t)rc.x * 4 + (i & 3)] = (e << 24) | rank; }
    }
}

__device__ __forceinline__ void build_blk(Ctx& F, int l) {
    LAS int* blk = (LAS int*)(F.lds + LDS_BLK);
    const unsigned* cnt = (const unsigned*)(F.ws + WS_CNT) + l * 2048;
    __syncthreads();
    if (F.tid == 0) { LAS int* cl = (LAS int*)(F.lds + LDS_CNT); int s = 0; for (int e = 0; e < 32; ++e) { const int ce = (int)cnt[e * 64]; cl[e] = ce; blk[e] = s; s += (ce + 255) >> 8; } blk[32] = s; }
    __syncthreads();
}

__device__ __forceinline__ void phase_combine(Ctx& F, int l) {
    const LAS int* blk = (const LAS int*)(F.lds + LDS_BLK);
    float* X = F.out; bf16_t* XB = (bf16_t*)(F.ws + WS_XB); bf16_t* H = (bf16_t*)(F.ws + WS_H); const unsigned char* YS = F.ws + WS_YS;
    const unsigned* slot = (const unsigned*)(F.ws + WS_SLOT);
    const float* mod = (const float*)(F.ws + WS_MOD);
    const int gw = F.bx * NWAVES + F.wave, NGW = F.G * NWAVES, lane = F.lane;
    for (int row = gw; row < NT; row += NGW) {
        f32x4 ff[4];
#pragma unroll
        for (int j = 0; j < 4; ++j) ff[j] = (f32x4){0.f, 0.f, 0.f, 0.f};
#pragma unroll
        for (int k = 0; k < 4; ++k) {
            const unsigned s = slot[(size_t)row * 4 + k]; const int e = (int)(s >> 24), rank = (int)(s & 0xffffffu);
            const unsigned char* yr = YS + ((size_t)blk[e] * 256 + rank) * D + 4 * lane;
#pragma unroll
            for (int j = 0; j < 4; ++j) { const unsigned wv = *(const unsigned*)(yr + 256 * j); const f32x2 lo = __builtin_amdgcn_cvt_pk_f32_fp8(wv, false), hi = __builtin_amdgcn_cvt_pk_f32_fp8(wv, true);
                ff[j][0] += lo.x; ff[j][1] += lo.y; ff[j][2] += hi.x; ff[j][3] += hi.y; }
        }
        const int bi = batch_of(row);
        const float* mb = mod + (size_t)(l * 16 + bi) * 6144;
        f32x4 v[4];
#pragma unroll
        for (int j = 0; j < 4; ++j) { const u32x2 xw = *(const u32x2*)(XB + (size_t)row * D + 4 * lane + 256 * j); const f32x4 x = (f32x4){bf_lo(xw.x), bf_hi(xw.x), bf_lo(xw.y), bf_hi(xw.y)}, g2 = *(const f32x4*)(mb + 5120 + 4 * lane + 256 * j);
            v[j] = x * ALPHA + (g2 + 1.0f) * (ff[j] * 0.0625f); }
        ln_row(v, F.in[27] + l * D, F.in[28] + l * D, lane);
#pragma unroll
        for (int j = 0; j < 4; ++j) { if (l == 0) { u32x2 w; w.x = cvt_pk_bf16(v[j][0], v[j][1]); w.y = cvt_pk_bf16(v[j][2], v[j][3]); *(u32x2*)(XB + (size_t)row * D + 4 * lane + 256 * j) = w; }
            else *(f32x4*)(X + (size_t)row * D + 4 * lane + 256 * j) = v[j]; }
        if (l == 0) { const float* mn = mod + (size_t)(16 + bi) * 6144; store_mod_row(v, mn, mn + 1024, H + (size_t)row * D, F.ws + WS_H8 + (size_t)row * D, lane); }
    }
}

#ifndef PH_MASK
#define PH_MASK 0xFFFF
#endif
#define PH(b) ((PH_MASK >> (b)) & 1)
#ifndef PROBE_MASK
#define PROBE_MASK 0
#endif
#define PB0(id) do { if ((PROBE_MASK >> (id)) & 1) pb_t0 = __builtin_amdgcn_s_memrealtime(); } while (0)
#define PB1(id) do { if ((PROBE_MASK >> (id)) & 1) pb_acc += __builtin_amdgcn_s_memrealtime() - pb_t0; } while (0)
#define RELOAD() do { int t_ = threadIdx.x; asm volatile("" : "+v"(t_)); F.tid = t_; F.lane = t_ & 63; F.wave = __builtin_amdgcn_readfirstlane(t_ >> 6); \
    unsigned z_; asm volatile("s_mov_b32 %0, 0" : "=s"(z_)); F.in = p.in; F.out = p.out + z_; F.ws = p.ws + z_; } while (0)
#define LAYER_BODY(l) do { \
          \
        PB0(2); RELOAD(); \
        if (PH(2)) { \
              \
            pg8::SchedDense S; S.init(NT, 7 * 256, D, F.G, F.bx, (const bf16_t*)(F.ws + WS_WIN) + (size_t)l * INW * D, 2); \
            pg8::EpiZ E{(bf16_t*)(F.ws + WS_Z), F.in[13] + l * INW, F.out, l, F.ws + WS_ZG8}; \
            pg8::gemm_phase<false, 0u>(F.lds, (const char*)(F.ws + WS_H), D, S, E); \
        } \
        RELOAD(); \
        if (PH(2)) { \
              \
            pg8::SchedDense S; S.init(NT, 10 * 256, 512, F.G, (F.G == 256) ? ((F.bx + 112) & 255) : F.bx, F.ws + WS_WIN8 + (size_t)l * INW * D, 0, 2, 7); \
            pg8::EpiZ E{(bf16_t*)(F.ws + WS_Z), F.in[13] + l * INW, F.out, l, F.ws + WS_ZG8}; \
            pg8::gemm_phase<true, 0x7f7f7f7fu>(F.lds, (const char*)(F.ws + WS_H8), 512, S, E); \
        } \
        xcd_barrier(xbar); PB1(2); PB0(3); \
        RELOAD(); \
        if (PH(3)) phase_attn(F, l); \
        xcd_barrier(xbar); PB1(3); PB0(4); \
          \
        RELOAD(); \
        if (PH(4)) { \
            pg8::SchedDense S; S.init(NT, D, 256, F.G, F.bx, F.ws + WS_WOA + (size_t)l * D * 512); \
            pg8::EpiT1 E{F.ws + WS_T1, F.ws + WS_ZG8}; \
            pg8::gemm_phase<true, 0x7c7c7c7cu>(F.lds, (const char*)(F.ws + WS_YA), 256, S, E); \
        } \
        RELOAD(); \
        if (PH(5)) { \
            pg8::SchedDense S; S.init(NT, D, 256, F.G, F.bx, F.ws + WS_WOB + (size_t)l * D * 512); \
            pg8::EpiMix E{F.ws + WS_T1, F.ws + WS_ZG8, F.ws + WS_MIX}; \
            pg8::gemm_phase<true, 0x7f7f7f7fu>(F.lds, (const char*)(F.ws + WS_YB), 256, S, E); \
        } \
        xcd_barrier(xbar); PB1(4); PB0(5); \
          \
        RELOAD(); \
        if (PH(6)) { \
            pg8::SchedDense S; S.init(NT, D, 512, F.G, F.bx, F.ws + WS_WO + (size_t)l * D * D); \
            pg8::EpiX E{(const bf16_t*)(F.ws + WS_XB), (bf16_t*)(F.ws + WS_V16), (const float*)(F.ws + WS_MOD) + (size_t)l * 16 * 6144}; \
            pg8::gemm_phase<true, 0x7f7f7f7fu>(F.lds, (const char*)(F.ws + WS_MIX), 512, S, E); \
        } \
        xcd_barrier(xbar); PB1(5); PB0(6); \
        RELOAD(); \
        if (PH(7)) phase_ln_router(F, l); \
        xcd_barrier(xbar); PB1(6); PB0(7); \
          \
        RELOAD(); \
        build_blk(F, l); \
        if (PH(8)) { \
            LAS int* blk = (LAS int*)(F.lds + LDS_BLK); \
            LAS unsigned short* idx = (LAS unsigned short*)(F.lds + LDS_IDX); \
            pg8::SchedMoE<true> S; S.init(blk, idx, 8, 512, F.G, F.bx, (const unsigned char*)(F.ws + WS_WGU) + (size_t)l * 32 * 2048 * D, (size_t)2048 * D); \
            const unsigned* cnt = (const unsigned*)(F.ws + WS_CNT) + l * 2048; const unsigned* tok = (const unsigned*)(F.ws + WS_TOK); \
            for (int i = 0; i < MAXU; ++i) { pg8::Unit u; if (!S.next(i, u)) break; \
                if (F.tid < 256) { int rank = (u.pm - blk[u.e]) * 256 + F.tid; const int ce = (int)cnt[u.e * 64]; rank = rank < ce ? rank : ce - 1; \
                    idx[i * 256 + F.tid] = (unsigned short)tok[(size_t)u.e * NT + rank]; } } \
            __syncthreads(); \
            pg8::EpiAct E{(unsigned char*)(F.ws + WS_ACT), F.in[24] + (size_t)l * 32 * 2048}; \
            pg8::gemm_phase<true, 0x7f7f7f7fu>(F.lds, (const char*)(F.ws + WS_H8), 512, S, E); \
        } \
        xcd_barrier(xbar); PB1(7); PB0(8); \
          \
        RELOAD(); \
        if (PH(9)) { \
            LAS int* blk = (LAS int*)(F.lds + LDS_BLK); \
            LAS unsigned short* idx = (LAS unsigned short*)(F.lds + LDS_IDX); \
            pg8::SchedMoE<false> S; S.init(blk, idx, 4, 512, F.G, F.bx, (const unsigned char*)(F.ws + WS_WDN) + (size_t)l * 32 * D * D, (size_t)D * D); \
            pg8::EpiYs E{F.ws + WS_YS, F.in[26] + (size_t)l * 32 * D, (const float*)(F.ws + WS_GATE), (const LAS int*)(F.lds + LDS_CNT), blk}; \
            pg8::gemm_phase<true, 0x7f7f7f7fu>(F.lds, (const char*)(F.ws + WS_ACT), 512, S, E); \
        } \
        xcd_barrier(xbar); PB1(8); PB0(9); \
        RELOAD(); \
        if (PH(10)) phase_combine(F, l); \
        if (l == 0) xcd_barrier(xbar); \
        PB1(9); \
 \
    } while (0)
__global__ void __launch_bounds__(NTHREADS, 2) fwd_megakernel(Params p) {
    extern __shared__ __attribute__((aligned(16))) unsigned char lds_raw[];
    cg::grid_group grid = cg::this_grid();
    Ctx F;
    F.lds = (LAS unsigned char*)lds_raw;
    F.G = gridDim.x; F.bx = blockIdx.x;
    volatile LAS unsigned* bst = (volatile LAS unsigned*)(F.lds + 147392);
    if (threadIdx.x < 2) bst[threadIdx.x] = 0u;
    __syncthreads();
    const XcdBarrier xbar = xcd_barrier_post((unsigned*)(p.ws + WS_BAR), bst);
    unsigned long long pb_t0 = 0, pb_acc = 0;
    PB0(0); RELOAD();
    if (PH(0)) phase0a(F);
    grid.sync();
    PB1(0); PB0(1); RELOAD();
    { const float* modp = (const float*)(F.ws + WS_MODP); float* mod = (float*)(F.ws + WS_MOD);
      for (int i = F.bx * NTHREADS + F.tid; i < 2 * 16 * 6144; i += F.G * NTHREADS) { float sm = 0.f;
#pragma unroll
          for (int kc = 0; kc < 8; ++kc) sm += modp[(size_t)kc * (2 * 16 * 6144) + i];
          mod[i] = sm; } }
    xcd_barrier(xbar);
    RELOAD();
    if (PH(1)) phase0b(F);
    xcd_barrier(xbar); PB1(1);

    LAYER_BODY(0);
    LAYER_BODY(1);
    if (PROBE_MASK != 0 && blockIdx.x == 0) { const unsigned long long te = __builtin_amdgcn_s_memrealtime(); while (__builtin_amdgcn_s_memrealtime() - te < pb_acc) __builtin_amdgcn_s_sleep(8); }
    (void)pb_t0; (void)pb_acc;
}

extern "C" void kernel_launch(void* const* d_in, const int* in_sizes, int n_in, void* d_out, int out_size, void* d_ws, size_t ws_size, hipStream_t stream) {
    static int grid = 0;
    if (grid == 0) {
        if (n_in != 29 || ws_size < WS_END) { fprintf(stderr, "kernel_launch: unexpected n_in %d / ws_size %zu (need %zu)\n", n_in, ws_size, (size_t)WS_END); grid = -1; return; }
        int dev = 0, cus = 0, per_cu = 0;
        hipGetDevice(&dev);
        hipDeviceGetAttribute(&cus, hipDeviceAttributeMultiprocessorCount, dev);
        if (hipFuncSetAttribute((const void*)fwd_megakernel, hipFuncAttributeMaxDynamicSharedMemorySize, LDS_BYTES) != hipSuccess) { fprintf(stderr, "kernel_launch: hipFuncSetAttribute failed\n"); grid = -1; return; }
        if (hipOccupancyMaxActiveBlocksPerMultiprocessor(&per_cu, (const void*)fwd_megakernel, NTHREADS, LDS_BYTES) != hipSuccess || per_cu < 1) { fprintf(stderr, "kernel_launch: occupancy query says %d blocks per CU\n", per_cu); per_cu = 1; }
        (void)hipGetLastError();
        grid = cus;
        if (grid != 256) fprintf(stderr, "kernel_launch: note: %d CUs (built for 256)\n", grid);
    }
    if (grid < 0) return;
    hipMemsetAsync((char*)d_ws, 0, WS_ZERO_BYTES, stream);
    Params p{};
    for (int i = 0; i < 29; ++i) p.in[i] = (const float*)d_in[i];
    p.out = (float*)d_out; p.ws = (unsigned char*)d_ws;
    void* args[] = {&p};
    hipError_t e = hipLaunchCooperativeKernel((const void*)fwd_megakernel, dim3(grid), dim3(NTHREADS), args, LDS_BYTES, stream);
    if (e != hipSuccess) fprintf(stderr, "kernel_launch: cooperative launch failed: %s (grid %d)\n", hipGetErrorString(e), grid);
}
```

```cpp
#include <hip/hip_runtime.h>
#include <hip/hip_cooperative_groups.h>
#include <cstdio>
#include <cstdint>
namespace cg = cooperative_groups;

#define LAS __attribute__((address_space(3)))
typedef unsigned short bf16_t;
typedef short bf16x8 __attribute__((ext_vector_type(8)));
typedef float f32x4 __attribute__((ext_vector_type(4)));
typedef float f32x16 __attribute__((ext_vector_type(16)));
typedef unsigned u32x4 __attribute__((ext_vector_type(4)));
typedef unsigned u32x2 __attribute__((ext_vector_type(2)));
typedef float f32x2 __attribute__((ext_vector_type(2)));
typedef int i32x4 __attribute__((ext_vector_type(4)));
typedef int i32x8 __attribute__((ext_vector_type(8)));

constexpr int D = 1024, NPROMPT = 32768, NT = 33280, INW = 4352, NEXP = 32;
constexpr float ALPHA = 1.41421356237f, LN_EPS = 1e-5f;
constexpr int NWAVES = 8, NTHREADS = 512;
constexpr int LDS_BYTES = 147456;
constexpr int LDS_BLK = 131072;
constexpr int LDS_IDX = 131072 + 256;
constexpr int MAXU = 20;
constexpr int LDS_BIASBUF = 141568;
constexpr int LDS_CNT = 145664;
constexpr size_t OKP = 34078720, OVP = 34340864, OCP = 34603008, OKS = 34619392, OVS = 34881536, OCS = 35143680;
constexpr size_t MiB = 1u << 20;
constexpr size_t WS_CNT = 0;
constexpr size_t WS_BAR = 16384;
constexpr size_t WS_MOD = 65536;
constexpr size_t WS_MODP = 192 * MiB;
constexpr size_t WS_ZERO_BYTES = 1 * MiB;
constexpr size_t WS_BIAS = 1 * MiB;
constexpr size_t WS_SLOT = 2 * MiB;
constexpr size_t WS_TOK = 3 * MiB;
constexpr size_t WS_GATE = 8 * MiB;
constexpr size_t WS_WIN = 16 * MiB;
constexpr size_t WS_WIN8 = 180 * MiB;
constexpr size_t WS_WOA = 34 * MiB;
constexpr size_t WS_WOB = 36 * MiB;
constexpr size_t WS_WO = 38 * MiB;
constexpr size_t WS_WGU = 48 * MiB;
constexpr size_t WS_WDN = 304 * MiB;
constexpr size_t WS_H = 432 * MiB;
constexpr size_t WS_H8 = 1600 * MiB;
constexpr size_t WS_Z = 498 * MiB;
constexpr size_t WS_YA = 776 * MiB;
constexpr size_t WS_YB = 810 * MiB;
constexpr size_t WS_T1 = 844 * MiB;
constexpr size_t WS_V16 = 910 * MiB;
constexpr size_t WS_XB = 1200 * MiB;
constexpr size_t WS_MIX = 976 * MiB;
constexpr size_t WS_ACT = 1042 * MiB;
constexpr size_t WS_YS = 1320 * MiB;
constexpr size_t WS_ZG8 = 1460 * MiB;
constexpr size_t WS_END = 1634 * MiB;

struct Params { const float* in[29]; float* out; unsigned char* ws; };

__device__ __forceinline__ unsigned cvt_pk_bf16(float lo, float hi) { unsigned r; asm volatile("v_cvt_pk_bf16_f32 %0, %1, %2" : "=v"(r) : "v"(lo), "v"(hi)); return r; }
__device__ __forceinline__ unsigned pk4_fp8(float a, float b, float c, float d) { unsigned w = 0u; w = __builtin_amdgcn_cvt_pk_fp8_f32(a, b, w, false); w = __builtin_amdgcn_cvt_pk_fp8_f32(c, d, w, true); return w; }
__device__ __forceinline__ void unpk8_fp8(const u32x2 w, float (&o)[8]) { const f32x2 a = __builtin_amdgcn_cvt_pk_f32_fp8(w.x, false), b = __builtin_amdgcn_cvt_pk_f32_fp8(w.x, true), c = __builtin_amdgcn_cvt_pk_f32_fp8(w.y, false), d = __builtin_amdgcn_cvt_pk_f32_fp8(w.y, true);
    o[0] = a.x; o[1] = a.y; o[2] = b.x; o[3] = b.y; o[4] = c.x; o[5] = c.y; o[6] = d.x; o[7] = d.y; }
__device__ __forceinline__ void store_pair16(unsigned char* pa, unsigned char* pb, int fq, u32x2 wa, u32x2 wb) {
    const auto rx = __builtin_amdgcn_permlane16_swap(wa.x, wb.x, false, false);
    const auto ry = __builtin_amdgcn_permlane16_swap(wa.y, wb.y, false, false);
    u32x4 o; o.x = rx[0]; o.y = ry[0]; o.z = rx[1]; o.w = ry[1];
    *(u32x4*)((fq & 1) ? pb - 8 : pa) = o;
}
__device__ __forceinline__ float bf_lo(unsigned w) { return __uint_as_float(w << 16); }
__device__ __forceinline__ float bf_hi(unsigned w) { return __uint_as_float(w & 0xffff0000u); }
__device__ __forceinline__ float sigmoidf_(float x) { return __builtin_amdgcn_rcpf(1.0f + __expf(-x)); }
__device__ __forceinline__ float wave_sum(float v) {
#define WS_DPP_ADD(ctrl) v += __int_as_float(__builtin_amdgcn_update_dpp(0, __float_as_int(v), (ctrl), 0xf, 0xf, true))
    WS_DPP_ADD(0xB1);
    WS_DPP_ADD(0x4E);
    WS_DPP_ADD(0x141);
    WS_DPP_ADD(0x140);
#undef WS_DPP_ADD
    const int b = __float_as_int(v);
    const float r0 = __int_as_float(__builtin_amdgcn_readlane(b, 0)), r1 = __int_as_float(__builtin_amdgcn_readlane(b, 16)), r2 = __int_as_float(__builtin_amdgcn_readlane(b, 32)), r3 = __int_as_float(__builtin_amdgcn_readlane(b, 48));
    return (r0 + r1) + (r2 + r3);
}
__device__ __forceinline__ int batch_of(int row) { return row < NPROMPT ? (row >> 12) : 8 + ((row - NPROMPT) >> 6); }

namespace pg8 {
constexpr int BM = 256, BK = 64, HALF = 128, HTB = HALF * BK * 2, NXCD = 8, WGM = 8;
__device__ __forceinline__ int lds_byte(int r, int c) { const int st = (r >> 4) * 2 + (c >> 5), rr = r & 15, cc = c & 31, ob = rr * 64 + cc * 2; return st * 1024 + (ob ^ (((ob >> 9) & 1) << 5)); }
__device__ __forceinline__ void stage_rc(int b, int& R, int& C) { const int st = b / 1024, sb = b % 1024, swz = sb ^ (((sb >> 9) & 1) << 5); R = (st >> 1) * 16 + swz / 64; C = (st & 1) * 32 + (swz % 64) / 2; }
__device__ __forceinline__ int perm32(int rho) { const int n = rho >> 4, i = rho & 15; return 8 * (i >> 2) + 4 * n + (i & 3); }

struct Unit { int pm, pn, e; const char* b; };

struct SchedDense {
    int nM, nN, nwg, G, c, cbase, csplit, cskip; const char* Bt; size_t tstepB;
    __device__ __forceinline__ void init(int M, int N, int K, int G_, int c_, const void* Bt_, int cbase_ = 0, int csplit_ = 1 << 20, int cskip_ = 0) { nM = M / BM; nN = N / BM; nwg = nM * nN; G = G_; c = c_; Bt = (const char*)Bt_; tstepB = (size_t)BM * K * 2; cbase = cbase_; csplit = csplit_; cskip = cskip_; }
    __device__ __forceinline__ bool next(int i, Unit& u) const {
        const long L = (long)i * G + c; if (L >= nwg) return false;
        int wgid = (int)L; { const int q = nwg / NXCD, r = nwg % NXCD, xcd = wgid % NXCD, off = wgid / NXCD; wgid = (xcd < r ? xcd * (q + 1) : r * (q + 1) + (xcd - r) * q) + off; }
        const int nig = WGM * nN, gid = wgid / nig, fm = gid * WGM, gsz = (nM - fm) < WGM ? (nM - fm) : WGM;
        u.pm = fm + ((wgid % nig) % gsz); const int j = (wgid % nig) / gsz; u.pn = j < csplit ? j + cbase : j + cbase + cskip; u.e = 0; u.b = Bt + (size_t)u.pn * tstepB; return true;
    }
    __device__ __forceinline__ unsigned rowidx(int, const Unit& u, int r) const { return (unsigned)(u.pm * BM + r); }
};
template <bool GATHER> struct SchedMoE {
    const LAS int* blk; const LAS unsigned short* idx; int NB, RBX, NPN, NXs, perx, cx, cj; const char* Bt; size_t estep, tstepB;
    __device__ __forceinline__ void init(const LAS int* blk_, const LAS unsigned short* idx_, int NPN_, int K, int G, int c, const void* Bt_, size_t estep_) {
        blk = blk_; idx = idx_; NB = blk_[32]; NPN = NPN_; Bt = (const char*)Bt_; estep = estep_; tstepB = (size_t)BM * K * 2;
        if ((G & 7) == 0) { NXs = 8; perx = G >> 3; cx = c & 7; cj = c >> 3; } else { NXs = 1; perx = G; cx = 0; cj = c; }
        RBX = (NB + NXs - 1) / NXs;
    }
    __device__ __forceinline__ bool next(int i, Unit& u) const {
        const int j = i * perx + cj, rbl = j / NPN; if (rbl >= RBX) return false;
        const int rb = cx * RBX + rbl; if (rb >= NB) return false;
        int e = 0;
        for (int q = 1; q < 32; ++q) e = (blk[q] <= rb) ? q : e;
        u.pm = rb; u.pn = j - rbl * NPN; u.e = e; u.b = Bt + (size_t)e * estep + (size_t)u.pn * tstepB; return true;
    }
    __device__ __forceinline__ unsigned rowidx(int ui, const Unit& u, int r) const { if (GATHER) return (unsigned)idx[ui * 256 + r]; return (unsigned)(u.pm * BM + r); }
};

template <bool FP8, unsigned ASCALE, class Epi, class Sched>
__device__ __forceinline__ void gemm_phase(LAS unsigned char* lds, const char* Abase, const int K, const Sched& S, const Epi& E) {
    int tid_ = threadIdx.x; asm volatile("" : "+v"(tid_));
    const int tid = tid_, wid = __builtin_amdgcn_readfirstlane(tid >> 6), lane = tid & 63, wr = wid >> 2, wc = wid & 3, fr = lane & 15, fq = lane >> 4;
    int nt_ = K / BK; asm volatile("" : "+s"(nt_)); const int nt = nt_;
    unsigned voffB[2]; int RA[2], CA[2];
#pragma unroll
    for (int i = 0; i < 2; ++i) { int R, C; stage_rc(tid * 16 + i * 8192, R, C); const int Rb = Epi::PERM ? ((R & ~31) + perm32(R & 31)) : R;
        voffB[i] = (unsigned)(Rb * K + C) * 2u; RA[i] = R; CA[i] = C * 2; }
    const size_t kstep = (size_t)(BK * 2);
    const size_t hstep = (size_t)HALF * K * 2;
    const unsigned ldsw = (unsigned)wid * 1024u;
    const unsigned rowb = (unsigned)K * 2u;
    const int aoff = lds_byte(wr * 64 + fr, fq * 8), boff = lds_byte(wc * 32 + fr, fq * 8);
#define PG8_SA(b, h) (((b) * 2 + (h)) * HTB)
#define PG8_SB(b, h) ((4 + (b) * 2 + (h)) * HTB)
#define PG8_STAGE(bufoff, gbase, voff) do { _Pragma("unroll") for (int _i = 0; _i < 2; ++_i) \
        __builtin_amdgcn_global_load_lds((const unsigned*)((const char*)(gbase) + (voff)[_i]), (LAS unsigned*)(lds + (bufoff) + ldsw + _i * 8192), 16, 0, 0); } while (0)
#define PG8_LDA(dst, b, h) do { _Pragma("unroll") for (int m = 0; m < 4; ++m) _Pragma("unroll") for (int k = 0; k < 2; ++k) dst[m][k] = *(const LAS bf16x8*)(lds + PG8_SA(b, h) + aoff + m * 2048 + k * 1024); } while (0)
#define PG8_LDB(dst, b, h) do { _Pragma("unroll") for (int n = 0; n < 2; ++n) _Pragma("unroll") for (int k = 0; k < 2; ++k) dst[n][k] = *(const LAS bf16x8*)(lds + PG8_SB(b, h) + boff + n * 2048 + k * 1024); } while (0)
#define PG8_MMA(ai, bj, At, Bt) do { __builtin_amdgcn_s_setprio(1); _Pragma("unroll") for (int m = 0; m < 4; ++m) _Pragma("unroll") for (int n = 0; n < 2; ++n) { \
        if constexpr (FP8) { \
            const i32x8 wf_ = __builtin_shufflevector((i32x4)Bt[n][0], (i32x4)Bt[n][1], 0, 1, 2, 3, 4, 5, 6, 7), af_ = __builtin_shufflevector((i32x4)At[m][0], (i32x4)At[m][1], 0, 1, 2, 3, 4, 5, 6, 7); \
            acc[ai][bj][m][n] = __builtin_amdgcn_mfma_scale_f32_16x16x128_f8f6f4(wf_, af_, acc[ai][bj][m][n], 0, 0, 0, 0x79797979, 0, (int)ASCALE); \
        } else { _Pragma("unroll") for (int k = 0; k < 2; ++k) \
            acc[ai][bj][m][n] = __builtin_amdgcn_mfma_f32_16x16x32_bf16(Bt[n][k], At[m][k], acc[ai][bj][m][n], 0, 0, 0); } } \
        __builtin_amdgcn_s_setprio(0); } while (0)
#define PG8_WAIT_V(n) asm volatile("s_waitcnt vmcnt(" #n ")" ::: "memory")
#define PG8_WAIT_L(n) asm volatile("s_waitcnt lgkmcnt(" #n ")" ::: "memory")
#define PG8_BAR __builtin_amdgcn_s_barrier()
#define PG8_SCHED __builtin_amdgcn_sched_barrier(0)
#define PG8_LOADVA(ui_, u_) do { _Pragma("unroll") for (int _h = 0; _h < 2; ++_h) _Pragma("unroll") for (int _i = 0; _i < 2; ++_i) \
        vA[_h][_i] = S.rowidx((ui_), (u_), _h * HALF + RA[_i]) * rowb + (unsigned)CA[_i]; } while (0)
    Unit cur, nxt; int ui = 0;
    if (!S.next(0, cur)) return;
    f32x4 acc[2][2][4][2];
#pragma unroll
    for (int a = 0; a < 2; ++a)
#pragma unroll
        for (int b = 0; b < 2; ++b)
#pragma unroll
            for (int m = 0; m < 4; ++m)
#pragma unroll
                for (int n = 0; n < 2; ++n) acc[a][b][m][n] = (f32x4){0.f, 0.f, 0.f, 0.f};
    bf16x8 At[4][2], B0[2][2], B1[2][2];
    unsigned vA[2][2];
    PG8_LOADVA(0, cur);
    const char* cB = cur.b;
    if (Epi::BIAS && tid < 64) __builtin_amdgcn_global_load_lds((const unsigned*)E.bias_ptr(cur, tid), (LAS unsigned*)(lds + LDS_BIASBUF), 16, 0, 0);
    if (Epi::EXTRA && tid < 64) __builtin_amdgcn_global_load_lds((const unsigned*)E.extra_ptr(cur, tid), (LAS unsigned*)(lds + LDS_BIASBUF + 1024), 16, 0, 0);
    PG8_STAGE(PG8_SB(0, 0), cB, voffB); PG8_STAGE(PG8_SB(0, 1), cB + hstep, voffB); PG8_STAGE(PG8_SA(0, 0), Abase, vA[0]); PG8_STAGE(PG8_SA(0, 1), Abase, vA[1]);
    if (wr == 1) PG8_BAR;
    PG8_WAIT_V(2); PG8_BAR;
    PG8_STAGE(PG8_SB(1, 0), cB + kstep, voffB); PG8_STAGE(PG8_SA(1, 0), Abase + kstep, vA[0]); PG8_STAGE(PG8_SB(1, 1), cB + hstep + kstep, voffB);
    PG8_WAIT_V(6); PG8_BAR;
    for (;;) {
        const bool has_next = S.next(ui + 1, nxt);
        const char* nB = has_next ? nxt.b : cB;
#pragma unroll 1
        for (int t = 0; t < nt; t += 2) {
            const bool last = (t == nt - 2);
            const char* a1 = Abase + (size_t)(t + 1) * kstep;
            const char* a2 = last ? Abase : Abase + (size_t)(t + 2) * kstep;
            const char* b2 = last ? nB : cB + (size_t)(t + 2) * kstep;
            const char* a3 = a2 + kstep; const char* b3 = b2 + kstep;
            PG8_LDB(B0, 0, 0); PG8_LDB(B1, 0, 1); PG8_SCHED; PG8_LDA(At, 0, 0); PG8_STAGE(PG8_SA(1, 1), a1, vA[1]);
            if (last && has_next) { PG8_LOADVA(ui + 1, nxt);
                if (Epi::BIAS && tid < 64) __builtin_amdgcn_global_load_lds((const unsigned*)E.bias_ptr(nxt, tid), (LAS unsigned*)(lds + LDS_BIASBUF + ((ui + 1) & 1) * 2048), 16, 0, 0);
                if (Epi::EXTRA && tid < 64) __builtin_amdgcn_global_load_lds((const unsigned*)E.extra_ptr(nxt, tid), (LAS unsigned*)(lds + LDS_BIASBUF + ((ui + 1) & 1) * 2048 + 1024), 16, 0, 0); }
            PG8_WAIT_V(8); PG8_WAIT_L(0); PG8_BAR; PG8_MMA(0, 0, At, B0); PG8_MMA(0, 1, At, B1); PG8_BAR; PG8_SCHED;
            PG8_LDA(At, 0, 1); PG8_STAGE(PG8_SB(0, 0), b2, voffB); PG8_STAGE(PG8_SB(0, 1), b2 + hstep, voffB); PG8_STAGE(PG8_SA(0, 0), a2, vA[0]);
            PG8_WAIT_V(8); PG8_WAIT_L(0); PG8_BAR; PG8_MMA(1, 0, At, B0); PG8_MMA(1, 1, At, B1); PG8_BAR; PG8_SCHED;
            PG8_LDB(B0, 1, 0); PG8_LDB(B1, 1, 1); PG8_SCHED; PG8_LDA(At, 1, 0); PG8_STAGE(PG8_SA(0, 1), a2, vA[1]);
            PG8_WAIT_V(8); PG8_WAIT_L(0); PG8_BAR; PG8_MMA(0, 0, At, B0); PG8_MMA(0, 1, At, B1); PG8_BAR; PG8_SCHED;
            PG8_LDA(At, 1, 1); PG8_STAGE(PG8_SB(1, 0), b3, voffB); PG8_STAGE(PG8_SB(1, 1), b3 + hstep, voffB); PG8_STAGE(PG8_SA(1, 0), a3, vA[0]);
            PG8_WAIT_V(8); PG8_WAIT_L(0); PG8_BAR; PG8_MMA(1, 0, At, B0); PG8_MMA(1, 1, At, B1); PG8_BAR; PG8_SCHED;
        }
        if (wr == 0) PG8_BAR;
        E(acc, cur, wr, wc, fr, fq, (const LAS float*)(lds + LDS_BIASBUF + (ui & 1) * 2048));
        if (!has_next) break;
#pragma unroll
        for (int a = 0; a < 2; ++a)
#pragma unroll
            for (int b = 0; b < 2; ++b)
#pragma unroll
                for (int m = 0; m < 4; ++m)
#pragma unroll
                    for (int n = 0; n < 2; ++n) acc[a][b][m][n] = (f32x4){0.f, 0.f, 0.f, 0.f};
        cur = nxt; cB = nB; ++ui;
        if (wr == 1) PG8_BAR;
    }
    PG8_WAIT_V(0);
    PG8_BAR;
#undef PG8_SA
#undef PG8_SB
#undef PG8_STAGE
#undef PG8_LDA
#undef PG8_LDB
#undef PG8_MMA
#undef PG8_WAIT_V
#undef PG8_WAIT_L
#undef PG8_BAR
#undef PG8_SCHED
#undef PG8_LOADVA
}

typedef f32x4 Acc[2][2][4][2];

struct EpiZ {
    static constexpr bool PERM = true, BIAS = true, EXTRA = false;
    __device__ __forceinline__ const float* extra_ptr(const Unit&, int) const { return nullptr; }
    __device__ __forceinline__ const float* bias_ptr(const Unit& u, int t) const { return bias + u.pn * 256 + 4 * t; }
    bf16_t* Z; const float* bias; float* out; int l; unsigned char* ZG;
    __device__ __forceinline__ void operator()(const Acc& acc, const Unit& u, int wr, int wc, int fr, int fq, const LAS float* lb) const {
        const int row0 = u.pm * 256 + wr * 64 + fr, col0 = u.pn * 256 + wc * 32 + 8 * fq;
        f32x4 bv[2][2];
#pragma unroll
        for (int bj = 0; bj < 2; ++bj)
#pragma unroll
            for (int n = 0; n < 2; ++n) bv[bj][n] = *(const LAS f32x4*)(lb + bj * 128 + wc * 32 + 8 * fq + 4 * n);
#pragma unroll
        for (int ai = 0; ai < 2; ++ai)
#pragma unroll
            for (int m = 0; m < 4; ++m) {
                const int row = row0 + ai * 128 + m * 16;
                bf16_t* rowp = Z + (size_t)row * INW + col0;
                float* ko = nullptr; float* vo = nullptr;
                if (u.pn == 2) {
                    if (row < NPROMPT) { const int t = row & 4095; if (t >= 3968) { const size_t o = ((size_t)(l * 8 + (row >> 12)) * 128 + (t - 3968)) * 128 + wc * 32 + 8 * fq; ko = out + OKP + o; vo = out + OVP + o; } }
                    else { const int rr = row - NPROMPT; const size_t o = ((size_t)(l * 8 + (rr >> 6)) * 128 + 64 + (rr & 63)) * 128 + wc * 32 + 8 * fq; ko = out + OKS + o; vo = out + OVS + o; }
                }
#pragma unroll
                for (int bj = 0; bj < 2; ++bj) {
                    const f32x4 v0 = acc[ai][bj][m][0] + bv[bj][0], v1 = acc[ai][bj][m][1] + bv[bj][1];
                    if (u.pn >= 9) { u32x2 w8; w8.x = pk4_fp8(v0[0], v0[1], v0[2], v0[3]); w8.y = pk4_fp8(v1[0], v1[1], v1[2], v1[3]);
                        *(u32x2*)(ZG + (size_t)row * 2048 + (col0 - 2304) + bj * 128) = w8; }
                    else { u32x4 w; w.x = cvt_pk_bf16(v0[0], v0[1]); w.y = cvt_pk_bf16(v0[2], v0[3]); w.z = cvt_pk_bf16(v1[0], v1[1]); w.w = cvt_pk_bf16(v1[2], v1[3]);
                        *(u32x4*)(rowp + bj * 128) = w; }
                    float* o = bj == 0 ? ko : vo;
                    if (o) { *(f32x4*)o = v0; *(f32x4*)(o + 4) = v1; }
                }
                asm volatile("" ::: "memory");
            }
    }
};
struct EpiT1 {
    static constexpr bool PERM = true, BIAS = false, EXTRA = false;
    __device__ __forceinline__ const float* extra_ptr(const Unit&, int) const { return nullptr; }
    __device__ __forceinline__ const float* bias_ptr(const Unit&, int) const { return nullptr; }
    unsigned char* T1; const unsigned char* ZG;
    __device__ __forceinline__ void operator()(const Acc& acc, const Unit& u, int wr, int wc, int fr, int fq, const LAS float* lb) const {
        const int row0 = u.pm * 256 + wr * 64 + fr, col0 = u.pn * 256 + wc * 32 + 8 * fq;
        u32x2 g[2][4][2];
#pragma unroll
        for (int ai = 0; ai < 2; ++ai)
#pragma unroll
            for (int m = 0; m < 4; ++m)
#pragma unroll
                for (int bj = 0; bj < 2; ++bj) g[ai][m][bj] = *(const u32x2*)(ZG + (size_t)(row0 + ai * 128 + m * 16) * 2048 + col0 + bj * 128);
        asm volatile("" ::: "memory");
        u32x2 wprev[2];
#pragma unroll
        for (int ai = 0; ai < 2; ++ai)
#pragma unroll
            for (int m = 0; m < 4; ++m) {
                const int row = row0 + ai * 128 + m * 16;
#pragma unroll
                for (int bj = 0; bj < 2; ++bj) {
                    float gg[8]; unpk8_fp8(g[ai][m][bj], gg);
                    f32x4 v0 = acc[ai][bj][m][0] * 16.0f, v1 = acc[ai][bj][m][1] * 16.0f;
#pragma unroll
                    for (int j = 0; j < 4; ++j) { v0[j] *= sigmoidf_(gg[j]); v1[j] *= sigmoidf_(gg[4 + j]); }
                    u32x2 w; w.x = pk4_fp8(v0[0], v0[1], v0[2], v0[3]); w.y = pk4_fp8(v1[0], v1[1], v1[2], v1[3]);
                    if ((m & 1) == 0) wprev[bj] = w;
                    else store_pair16(T1 + (size_t)(row - 16) * D + col0 + bj * 128, T1 + (size_t)row * D + col0 + bj * 128, fq, wprev[bj], w);
                }
            }
    }
};
struct EpiMix {
    static constexpr bool PERM = true, BIAS = false, EXTRA = false;
    __device__ __forceinline__ const float* extra_ptr(const Unit&, int) const { return nullptr; }
    __device__ __forceinline__ const float* bias_ptr(const Unit&, int) const { return nullptr; }
    const unsigned char* T1; const unsigned char* ZG; unsigned char* MIX;
    __device__ __forceinline__ void operator()(const Acc& acc, const Unit& u, int wr, int wc, int fr, int fq, const LAS float* lb) const {
        const int row0 = u.pm * 256 + wr * 64 + fr, col0 = u.pn * 256 + wc * 32 + 8 * fq;
        u32x2 g[2][4][2], t[2][4][2];
#pragma unroll
        for (int ai = 0; ai < 2; ++ai)
#pragma unroll
            for (int m = 0; m < 4; ++m)
#pragma unroll
                for (int bj = 0; bj < 2; ++bj) { const int row = row0 + ai * 128 + m * 16;
                    g[ai][m][bj] = *(const u32x2*)(ZG + (size_t)row * 2048 + 1024 + col0 + bj * 128);
                    t[ai][m][bj] = *(const u32x2*)(T1 + (size_t)row * D + col0 + bj * 128); }
        asm volatile("" ::: "memory");
        u32x2 wprev[2];
#pragma unroll
        for (int ai = 0; ai < 2; ++ai)
#pragma unroll
            for (int m = 0; m < 4; ++m) {
                const int row = row0 + ai * 128 + m * 16;
#pragma unroll
                for (int bj = 0; bj < 2; ++bj) {
                    float gg[8], tt[8]; unpk8_fp8(g[ai][m][bj], gg); unpk8_fp8(t[ai][m][bj], tt);
                    const f32x4 a0 = acc[ai][bj][m][0], a1 = acc[ai][bj][m][1];
                    float v[8];
#pragma unroll
                    for (int j = 0; j < 4; ++j) { v[j] = tt[j] * 0.0625f + a0[j] * sigmoidf_(gg[j]); v[4 + j] = tt[4 + j] * 0.0625f + a1[j] * sigmoidf_(gg[4 + j]); }
                    u32x2 w; w.x = pk4_fp8(v[0], v[1], v[2], v[3]); w.y = pk4_fp8(v[4], v[5], v[6], v[7]);
                    if ((m & 1) == 0) wprev[bj] = w;
                    else store_pair16(MIX + (size_t)(row - 16) * D + col0 + bj * 128, MIX + (size_t)row * D + col0 + bj * 128, fq, wprev[bj], w);
                }
            }
    }
};
struct EpiX {
    static constexpr bool PERM = true, BIAS = false, EXTRA = false;
    __device__ __forceinline__ const float* extra_ptr(const Unit&, int) const { return nullptr; }
    __device__ __forceinline__ const float* bias_ptr(const Unit&, int) const { return nullptr; }
    const bf16_t* X; bf16_t* V; const float* modl;
    __device__ __forceinline__ void operator()(const Acc& acc, const Unit& u, int wr, int wc, int fr, int fq, const LAS float* lb) const {
        const int row0 = u.pm * 256 + wr * 64 + fr, col0 = u.pn * 256 + wc * 32 + 8 * fq;
        const bool uni = u.pm < 128;
        f32x4 g[2][2];
        if (uni) { const float* gp = modl + (size_t)(u.pm >> 4) * 6144 + 2048 + col0;
#pragma unroll
            for (int bj = 0; bj < 2; ++bj)
#pragma unroll
                for (int n = 0; n < 2; ++n) g[bj][n] = *(const f32x4*)(gp + bj * 128 + 4 * n) + 1.0f; }
#pragma unroll
        for (int ai = 0; ai < 2; ++ai) {
            u32x4 x[4][2];
#pragma unroll
            for (int m = 0; m < 4; ++m)
#pragma unroll
                for (int bj = 0; bj < 2; ++bj) x[m][bj] = *(const u32x4*)(X + (size_t)(row0 + ai * 128 + m * 16) * D + col0 + bj * 128);
            asm volatile("" ::: "memory");
#pragma unroll
            for (int m = 0; m < 4; ++m) {
                const int row = row0 + ai * 128 + m * 16;
                if (!uni) { const float* gp = modl + (size_t)batch_of(row) * 6144 + 2048 + col0;
#pragma unroll
                    for (int bj = 0; bj < 2; ++bj)
#pragma unroll
                        for (int n = 0; n < 2; ++n) g[bj][n] = *(const f32x4*)(gp + bj * 128 + 4 * n) + 1.0f; }
#pragma unroll
                for (int bj = 0; bj < 2; ++bj) {
                    const u32x4 xx = x[m][bj];
                    const f32x4 x0 = (f32x4){bf_lo(xx.x), bf_hi(xx.x), bf_lo(xx.y), bf_hi(xx.y)}, x1 = (f32x4){bf_lo(xx.z), bf_hi(xx.z), bf_lo(xx.w), bf_hi(xx.w)};
                    const f32x4 v0 = x0 * ALPHA + g[bj][0] * acc[ai][bj][m][0], v1 = x1 * ALPHA + g[bj][1] * acc[ai][bj][m][1];
                    u32x4 w; w.x = cvt_pk_bf16(v0[0], v0[1]); w.y = cvt_pk_bf16(v0[2], v0[3]); w.z = cvt_pk_bf16(v1[0], v1[1]); w.w = cvt_pk_bf16(v1[2], v1[3]);
                    *(u32x4*)(V + (size_t)row * D + col0 + bj * 128) = w;
                }
            }
            asm volatile("" ::: "memory");
        }
    }
};
struct EpiAct {
    static constexpr bool PERM = true, BIAS = true, EXTRA = false;
    __device__ __forceinline__ const float* extra_ptr(const Unit&, int) const { return nullptr; }
    __device__ __forceinline__ const float* bias_ptr(const Unit& u, int t) const { return bgu + (size_t)u.e * 2048 + u.pn * 128 + (t < 32 ? 4 * t : 1024 + 4 * (t - 32)); }
    unsigned char* ACT; const float* bgu;
    __device__ __forceinline__ void operator()(const Acc& acc, const Unit& u, int wr, int wc, int fr, int fq, const LAS float* lb) const {
        const int row0 = u.pm * 256 + wr * 64 + fr, c0 = u.pn * 128 + wc * 32 + 8 * fq;
        u32x2 wprev;
        f32x4 bg[2], bl[2];
#pragma unroll
        for (int n = 0; n < 2; ++n) { bg[n] = *(const LAS f32x4*)(lb + wc * 32 + 8 * fq + 4 * n); bl[n] = *(const LAS f32x4*)(lb + 128 + wc * 32 + 8 * fq + 4 * n); }
#pragma unroll
        for (int ai = 0; ai < 2; ++ai)
#pragma unroll
            for (int m = 0; m < 4; ++m) {
                const int row = row0 + ai * 128 + m * 16;
                float a[8];
#pragma unroll
                for (int n = 0; n < 2; ++n)
#pragma unroll
                    for (int jp = 0; jp < 2; ++jp) {
                        f32x2 g = (f32x2){acc[ai][0][m][n][2 * jp], acc[ai][0][m][n][2 * jp + 1]} + (f32x2){bg[n][2 * jp], bg[n][2 * jp + 1]};
                        f32x2 li = (f32x2){acc[ai][1][m][n][2 * jp], acc[ai][1][m][n][2 * jp + 1]} + (f32x2){bl[n][2 * jp], bl[n][2 * jp + 1]};
                        g = __builtin_elementwise_min(g, (f32x2){7.0f, 7.0f});
                        li = __builtin_elementwise_min(__builtin_elementwise_max(li, (f32x2){-7.0f, -7.0f}), (f32x2){7.0f, 7.0f});
                        const f32x2 t = g * (-1.702f * 1.44269504089f);
                        f32x2 e; e.x = __builtin_amdgcn_exp2f(t.x); e.y = __builtin_amdgcn_exp2f(t.y);
                        const f32x2 dd = e + 1.0f;
                        f32x2 r; r.x = __builtin_amdgcn_rcpf(dd.x); r.y = __builtin_amdgcn_rcpf(dd.y);
                        const f32x2 av = (g * r) * (li + 1.0f);
                        a[n * 4 + 2 * jp] = av.x; a[n * 4 + 2 * jp + 1] = av.y;
                    }
                u32x2 w; w.x = pk4_fp8(a[0], a[1], a[2], a[3]); w.y = pk4_fp8(a[4], a[5], a[6], a[7]);
                if ((m & 1) == 0) wprev = w;
                else store_pair16(ACT + (size_t)(row - 16) * D + c0, ACT + (size_t)row * D + c0, fq, wprev, w);
                asm volatile("" ::: "memory");
            }
    }
};
struct EpiYs {
    static constexpr bool PERM = true, BIAS = true, EXTRA = true;
    __device__ __forceinline__ const float* extra_ptr(const Unit& u, int t) const { return gate + (size_t)u.e * NT + (u.pm - blk[u.e]) * 256 + 4 * t; }
    __device__ __forceinline__ const float* bias_ptr(const Unit& u, int t) const { return bdn + (size_t)u.e * D + u.pn * 256 + 4 * t; }
    unsigned char* YS; const float* bdn; const float* gate; const LAS int* cnt; const LAS int* blk;
    __device__ __forceinline__ void operator()(const Acc& acc, const Unit& u, int wr, int wc, int fr, int fq, const LAS float* lb) const {
        const int r0 = wr * 64 + fr, col0 = u.pn * 256 + wc * 32 + 8 * fq;
        const int rank0 = (u.pm - blk[u.e]) * 256; const int ce = cnt[u.e];
        f32x4 bv[2][2];
#pragma unroll
        for (int bj = 0; bj < 2; ++bj)
#pragma unroll
            for (int n = 0; n < 2; ++n) bv[bj][n] = *(const LAS f32x4*)(lb + bj * 128 + wc * 32 + 8 * fq + 4 * n);
        float gts[2][4];
#pragma unroll
        for (int ai = 0; ai < 2; ++ai)
#pragma unroll
            for (int m = 0; m < 4; ++m) { const int rank = rank0 + r0 + ai * 128 + m * 16; const float gv = lb[256 + r0 + ai * 128 + m * 16]; gts[ai][m] = rank < ce ? 16.0f * gv : 0.0f; }
        asm volatile("" ::: "memory");
        u32x2 wprev[2];
#pragma unroll
        for (int ai = 0; ai < 2; ++ai)
#pragma unroll
            for (int m = 0; m < 4; ++m) {
                const int r = r0 + ai * 128 + m * 16;
                const float gt = gts[ai][m];
                unsigned char* rowp = YS + (size_t)(u.pm * 256 + r) * D + col0;
#pragma unroll
                for (int bj = 0; bj < 2; ++bj) {
                    const f32x4 v0 = (acc[ai][bj][m][0] + bv[bj][0]) * gt, v1 = (acc[ai][bj][m][1] + bv[bj][1]) * gt;
                    u32x2 w; w.x = pk4_fp8(v0[0], v0[1], v0[2], v0[3]); w.y = pk4_fp8(v1[0], v1[1], v1[2], v1[3]);
                    if ((m & 1) == 0) wprev[bj] = w;
                    else store_pair16(rowp - (size_t)16 * D + bj * 128, rowp + bj * 128, fq, wprev[bj], w);
                }
                asm volatile("" ::: "memory");
            }
    }
};
}


#define XB_TMO      128
#define XB_XCNT(j)  (256  + 64 * (j))
#define XB_XSUB(j)  (1280 + 64 * (j))
#define XB_XGEN(j)  (2304 + 64 * (j))
#define XB_TOP      3328
#define XB_TOPGEN   3392
#define XCD_BAR_WORDS 3456
#define XB_SPIN_CAP (1u << 21)
__device__ __forceinline__ unsigned xb_ld(unsigned* p)              { return __hip_atomic_load(p, __ATOMIC_RELAXED, __HIP_MEMORY_SCOPE_AGENT); }
__device__ __forceinline__ unsigned xb_add(unsigned* p, unsigned v) { return __hip_atomic_fetch_add(p, v, __ATOMIC_RELAXED, __HIP_MEMORY_SCOPE_AGENT); }
__device__ __forceinline__ unsigned xb_xcc_id() { return (unsigned)__builtin_amdgcn_s_getreg((3 << 11) | 20) & 0xFu; }
#define XB_SPIN(cond, bar) do { unsigned _sp = 0; while (cond) { __builtin_amdgcn_s_sleep(1); \
    if ((++_sp & 255u) == 0u) { if (xb_ld(&(bar)[XB_TMO])) break; if (_sp > XB_SPIN_CAP) { atomicAdd(&(bar)[XB_TMO], 1u); break; } } } } while (0)
struct XcdBarrier { unsigned* bar; unsigned x; volatile LAS unsigned* st; };
__device__ __forceinline__ XcdBarrier xcd_barrier_post(unsigned* bar, volatile LAS unsigned* st) {
    XcdBarrier b; b.bar = bar; b.x = xb_xcc_id(); b.st = st;
    if (threadIdx.x == 0) (void)xb_add(&bar[XB_XCNT(b.x)], 1u);
    return b;
}
__device__ __forceinline__ void xcd_barrier_complete(unsigned* bar, unsigned x, unsigned& nloc, unsigned& nx) {
    const unsigned G = gridDim.x * gridDim.y * gridDim.z;
    unsigned sum, cnt, mine, sp = 0u;
    for (;;) {
        sum = 0u; cnt = 0u; mine = 0u;
#pragma unroll
        for (unsigned j = 0; j < 16; ++j) { const unsigned c = xb_ld(&bar[XB_XCNT(j)]); sum += c; cnt += (c > 0u) ? 1u : 0u; mine = (j == x) ? c : mine; }
        if (sum == G) break;
        __builtin_amdgcn_s_sleep(1);
        if ((++sp & 255u) == 0u) { if (xb_ld(&bar[XB_TMO])) break; if (sp > XB_SPIN_CAP) { atomicAdd(&bar[XB_TMO], 1u); break; } }
    }
    nloc = mine > 0u ? mine : 1u; nx = cnt > 0u ? cnt : 1u;
}
__device__ __forceinline__ void xcd_barrier(const XcdBarrier& b) {
    asm volatile("s_waitcnt vmcnt(0)" ::: "memory");
    __syncthreads();
    if (threadIdx.x == 0) {
        unsigned* bar = b.bar;
        __builtin_amdgcn_s_waitcnt(0);
        unsigned nloc = b.st[0], nx = b.st[1];
        if (nloc == 0u) { xcd_barrier_complete(bar, b.x, nloc, nx); b.st[0] = nloc; b.st[1] = nx; }
        const unsigned old = xb_add(&bar[XB_XSUB(b.x)], 1u);
        const unsigned gen = old / nloc;
        if (old + 1u == (gen + 1u) * nloc) {
            __builtin_amdgcn_fence(__ATOMIC_RELEASE, "agent");
            asm volatile("s_waitcnt vmcnt(0)" ::: "memory");
            const unsigned og = xb_add(&bar[XB_TOP], 1u);
            const unsigned tg = og / nx;
            if (og + 1u == (tg + 1u) * nx) xb_add(&bar[XB_TOPGEN], 1u);
            else XB_SPIN(xb_ld(&bar[XB_TOPGEN]) == tg, bar);
            __builtin_amdgcn_fence(__ATOMIC_ACQUIRE, "agent");
            xb_add(&bar[XB_XGEN(b.x)], 1u);
            asm volatile("s_waitcnt vmcnt(0)" ::: "memory");
        } else {
            XB_SPIN(xb_ld(&bar[XB_XGEN(b.x)]) == gen, bar);
            __builtin_amdgcn_fence(__ATOMIC_ACQUIRE, "agent");
            asm volatile("s_waitcnt vmcnt(0)" ::: "memory");
        }
    }
    __syncthreads();
}

struct Ctx {
    LAS unsigned char* lds; int tid, lane, wave, G, bx;
    const float* const* in; float* out; unsigned char* ws;
};
#define LDS_WAIT() asm volatile("s_waitcnt lgkmcnt(0)" ::: "memory")

struct TDesc { const float* src; unsigned char* dst; int N, K, k0, n0, kind, f8; };
__device__ __forceinline__ void t64_load(const TDesc& d, float (&v)[64], int lane) {
    const float* src = d.src + (size_t)d.k0 * d.N + d.n0 + lane;
#pragma unroll
    for (int kk = 0; kk < 64; ++kk) v[kk] = src[(size_t)kk * d.N];
}
__device__ __forceinline__ void t64_finish(const TDesc& d, const float (&v)[64], LAS unsigned char* scr, int lane) {
    if (d.f8) {
        LAS unsigned char* wp = scr + lane * 80;
#pragma unroll
        for (int q = 0; q < 4; ++q) { u32x4 o;
            o.x = pk4_fp8(64.f * v[16 * q + 0], 64.f * v[16 * q + 1], 64.f * v[16 * q + 2], 64.f * v[16 * q + 3]);
            o.y = pk4_fp8(64.f * v[16 * q + 4], 64.f * v[16 * q + 5], 64.f * v[16 * q + 6], 64.f * v[16 * q + 7]);
            o.z = pk4_fp8(64.f * v[16 * q + 8], 64.f * v[16 * q + 9], 64.f * v[16 * q + 10], 64.f * v[16 * q + 11]);
            o.w = pk4_fp8(64.f * v[16 * q + 12], 64.f * v[16 * q + 13], 64.f * v[16 * q + 14], 64.f * v[16 * q + 15]);
            *(LAS u32x4*)(wp + q * 16) = o; }
        LDS_WAIT(); asm volatile("" ::: "memory");
        const int c = lane & 3;
#pragma unroll
        for (int j = 0; j < 4; ++j) { const int nl = (lane >> 2) + 16 * j; const u32x4 o = *(const LAS u32x4*)(scr + nl * 80 + c * 16);
            const int n = d.n0 + nl; int dr = n;
            if (d.kind == 1) { dr = (n < 1024) ? ((n >> 7) * 256 + (n & 127)) : (((n - 1024) >> 7) * 256 + 128 + (n & 127)); }
            *(u32x4*)(d.dst + (size_t)dr * d.K + d.k0 + c * 16) = o; }
    } else {
        LAS unsigned char* wp = scr + lane * 144;
#pragma unroll
        for (int q = 0; q < 8; ++q) { u32x4 o;
            o.x = cvt_pk_bf16(v[8 * q + 0], v[8 * q + 1]); o.y = cvt_pk_bf16(v[8 * q + 2], v[8 * q + 3]); o.z = cvt_pk_bf16(v[8 * q + 4], v[8 * q + 5]); o.w = cvt_pk_bf16(v[8 * q + 6], v[8 * q + 7]);
            *(LAS u32x4*)(wp + q * 16) = o; }
        LDS_WAIT(); asm volatile("" ::: "memory");
        const int c = lane & 7;
#pragma unroll
        for (int j = 0; j < 8; ++j) { const int nl = (lane >> 3) + 8 * j; const u32x4 o = *(const LAS u32x4*)(scr + nl * 144 + c * 16);
            *(u32x4*)(d.dst + ((size_t)(d.n0 + nl) * d.K + d.k0) * 2 + c * 16) = o; }
    }
    LDS_WAIT(); asm volatile("" ::: "memory");
}
__device__ __forceinline__ TDesc t64_decode(const float* const* in, unsigned char* ws, int it) {
    TDesc d; int r = it, item, nblk;
    if (r < 32768) { const int m = r >> 9; item = r & 511; d.src = in[23] + (size_t)m * 1024 * 2048; d.dst = ws + WS_WGU + (size_t)m * 2048 * 1024; d.N = 2048; d.K = 1024; d.kind = 1; d.f8 = 1; }
    else if ((r -= 32768) < 16384) { const int m = r >> 8; item = r & 255; d.src = in[25] + (size_t)m * 1024 * 1024; d.dst = ws + WS_WDN + (size_t)m * 1024 * 1024; d.N = 1024; d.K = 1024; d.kind = 0; d.f8 = 1; }
    else if ((r -= 16384) < 2176) { const int m = r / 1088; item = r % 1088; d.src = in[12] + (size_t)m * 1024 * INW; d.dst = ws + WS_WIN + (size_t)m * INW * 1024 * 2; d.N = INW; d.K = 1024; d.kind = 0; d.f8 = 0; }
    else if ((r -= 2176) < 2176) { const int m = r / 1088; item = r % 1088; d.src = in[12] + (size_t)m * 1024 * INW; d.dst = ws + WS_WIN8 + (size_t)m * INW * 1024; d.N = INW; d.K = 1024; d.kind = 0; d.f8 = 1; }
    else if ((r -= 2176) < 512) { const int m = r >> 8; item = r & 255; d.src = in[18] + (size_t)m * 1024 * 1024; d.dst = ws + WS_WO + (size_t)m * 1024 * 1024; d.N = 1024; d.K = 1024; d.kind = 0; d.f8 = 1; }
    else if ((r -= 512) < 256) { const int m = r >> 7; item = r & 127; d.src = in[16] + (size_t)m * 512 * 1024; d.dst = ws + WS_WOA + (size_t)m * 1024 * 512; d.N = 1024; d.K = 512; d.kind = 0; d.f8 = 1; }
    else { r -= 256; const int m = r >> 7; item = r & 127; d.src = in[17] + (size_t)m * 512 * 1024; d.dst = ws + WS_WOB + (size_t)m * 1024 * 512; d.N = 1024; d.K = 512; d.kind = 0; d.f8 = 1; }
    nblk = d.N >> 6; const int kb = item / nblk; d.k0 = kb * 64; d.n0 = (item - kb * nblk) * 64;
    return d;
}

__device__ __forceinline__ int rel_bucket(int rel) {
    const int n = rel < 0 ? -rel : rel;
    int v;
    if (n < 8) v = n;
    else { const float nf = (float)n; int large = 8 + (int)(logf(nf / 8.0f) / 2.7725887298583984f * 8.0f); v = large < 15 ? large : 15; }
    return (rel > 0 ? 16 : 0) + v;
}

__device__ __forceinline__ void phase0a(Ctx& F) {
    LAS float* scr = (LAS float*)(F.lds + F.wave * 16384);
    const int gw = F.bx * NWAVES + F.wave, NGW = F.G * NWAVES;
    unsigned char* ws = F.ws;
    {
        float* modp = (float*)(ws + WS_MODP);
        for (int it = gw; it < 2 * 96 * 8; it += NGW) {
            const int kc = it & 7, cgp = (it >> 3) % 96, l = it / (8 * 96), k0 = kc * 128, n0 = cgp * 64;
#pragma unroll 4
            for (int j = 0; j < 32; ++j) { const int idx = F.lane + 64 * j, r = idx >> 7, kk = idx & 127;
                const float c = r < 8 ? F.in[2][r * 1024 + k0 + kk] : F.in[3][(r - 8) * 1024 + k0 + kk];
                scr[kk * 16 + r] = c * sigmoidf_(c); }
            LDS_WAIT(); asm volatile("" ::: "memory");
            float a[16];
#pragma unroll
            for (int r = 0; r < 16; ++r) a[r] = 0.f;
            const float* wp = F.in[10] + ((size_t)l * 1024 + k0) * 6144 + n0 + F.lane;
#pragma unroll 16
            for (int kk = 0; kk < 128; ++kk) {
                const float w = wp[(size_t)kk * 6144];
                const LAS f32x4* sp = (const LAS f32x4*)(scr + kk * 16);
                const f32x4 s0 = sp[0], s1 = sp[1], s2 = sp[2], s3 = sp[3];
                a[0] += s0[0] * w; a[1] += s0[1] * w; a[2] += s0[2] * w; a[3] += s0[3] * w;
                a[4] += s1[0] * w; a[5] += s1[1] * w; a[6] += s1[2] * w; a[7] += s1[3] * w;
                a[8] += s2[0] * w; a[9] += s2[1] * w; a[10] += s2[2] * w; a[11] += s2[3] * w;
                a[12] += s3[0] * w; a[13] += s3[1] * w; a[14] += s3[2] * w; a[15] += s3[3] * w;
            }
            const float bb = (kc == 0) ? F.in[11][l * 6144 + n0 + F.lane] : 0.f;
#pragma unroll
            for (int r = 0; r < 16; ++r) modp[(size_t)kc * (2 * 16 * 6144) + ((size_t)(l * 16 + r)) * 6144 + n0 + F.lane] = a[r] + bb;
            LDS_WAIT(); asm volatile("" ::: "memory");
        }
    }
    if (F.bx == 0) {
        float* bt = (float*)(ws + WS_BIAS);
        for (int i = F.tid; i < 8 * 256; i += NTHREADS) { const int h = i >> 8, ri = i & 255; const int rel = ri - 191;
            bt[i] = (ri < 255) ? F.in[7][rel_bucket(rel) * 8 + h] : 0.f; }
    }
    for (int i = F.bx * NTHREADS + F.tid; i < 2 * 8 * 64 * 128; i += F.G * NTHREADS) {
        const int lb = i >> 13, rem = i & 8191;
        F.out[OKS + (size_t)lb * 16384 + rem] = F.in[4][(size_t)lb * 16384 + 8192 + rem];
        F.out[OVS + (size_t)lb * 16384 + rem] = F.in[5][(size_t)lb * 16384 + 8192 + rem];
    }
    LAS unsigned char* scrb = F.lds + F.wave * 16384;
    constexpr int NITEMS = 32768 + 16384 + 2176 + 2176 + 512 + 256 + 256;
    {
        float va[64], vb[64]; TDesc da, db;
        int it = gw;
        if (it < NITEMS) { da = t64_decode(F.in, ws, it); t64_load(da, va, F.lane); }
        while (it < NITEMS) {
            int itn = it + NGW;
            if (itn < NITEMS) { db = t64_decode(F.in, ws, itn); t64_load(db, vb, F.lane); }
            t64_finish(da, va, scrb, F.lane);
            it = itn; if (it >= NITEMS) break;
            itn = it + NGW;
            if (itn < NITEMS) { da = t64_decode(F.in, ws, itn); t64_load(da, va, F.lane); }
            t64_finish(db, vb, scrb, F.lane);
            it = itn;
        }
    }
}

__device__ __forceinline__ void ln_row(f32x4 (&v)[4], const float* g, const float* b, int lane) {
    float s = 0.f;
#pragma unroll
    for (int j = 0; j < 4; ++j) s += (v[j][0] + v[j][1]) + (v[j][2] + v[j][3]);
    const float mean = wave_sum(s) * (1.0f / D); float s2 = 0.f;
#pragma unroll
    for (int j = 0; j < 4; ++j) { v[j] = v[j] - mean; s2 += (v[j][0] * v[j][0] + v[j][1] * v[j][1]) + (v[j][2] * v[j][2] + v[j][3] * v[j][3]); }
    const float rstd = 1.0f / sqrtf(wave_sum(s2) * (1.0f / D) + LN_EPS);
#pragma unroll
    for (int j = 0; j < 4; ++j) { const f32x4 gg = *(const f32x4*)(g + 4 * lane + 256 * j), bb = *(const f32x4*)(b + 4 * lane + 256 * j); v[j] = v[j] * rstd * gg + bb; }
}
__device__ __forceinline__ void store_mod_row(const f32x4 (&v)[4], const float* sh, const float* sc, bf16_t* hrow, unsigned char* h8row, int lane) {
#pragma unroll
    for (int j = 0; j < 4; ++j) { const f32x4 a = *(const f32x4*)(sc + 4 * lane + 256 * j), b = *(const f32x4*)(sh + 4 * lane + 256 * j);
        const f32x4 h = v[j] * (a + 1.0f) + b; u32x2 w; w.x = cvt_pk_bf16(h[0], h[1]); w.y = cvt_pk_bf16(h[2], h[3]);
        *(u32x2*)(hrow + 4 * lane + 256 * j) = w;
        *(unsigned*)(h8row + 4 * lane + 256 * j) = pk4_fp8(h[0], h[1], h[2], h[3]); }
}

__device__ __forceinline__ void phase0b(Ctx& F) {
    const int gw = F.bx * NWAVES + F.wave, NGW = F.G * NWAVES;
    const float* mod = (const float*)(F.ws + WS_MOD);
    bf16_t* H = (bf16_t*)(F.ws + WS_H);
    for (int row = gw; row < NT; row += NGW) {
        const float* xr = row < NPROMPT ? F.in[0] + (size_t)row * D : F.in[1] + (size_t)(row - NPROMPT) * D;
        f32x4 v[4];
#pragma unroll
        for (int j = 0; j < 4; ++j) v[j] = *(const f32x4*)(xr + 4 * F.lane + 256 * j);
        ln_row(v, F.in[8], F.in[9], F.lane);
#pragma unroll
        for (int j = 0; j < 4; ++j) { u32x2 w; w.x = cvt_pk_bf16(v[j][0], v[j][1]); w.y = cvt_pk_bf16(v[j][2], v[j][3]); *(u32x2*)((bf16_t*)(F.ws + WS_XB) + (size_t)row * D + 4 * F.lane + 256 * j) = w; }
        const float* mb = mod + (size_t)batch_of(row) * 6144;
        store_mod_row(v, mb, mb + 1024, H + (size_t)row * D, F.ws + WS_H8 + (size_t)row * D, F.lane);
    }
}

__device__ __forceinline__ void phase_attn(Ctx& F, int l) {
    const bf16_t* Z = (const bf16_t*)(F.ws + WS_Z);
    unsigned char* YA = F.ws + WS_YA;
    unsigned char* YB = F.ws + WS_YB;
    const float* biasr = (const float*)(F.ws + WS_BIAS);
    LAS unsigned char* Ks = F.lds;
    LAS unsigned char* Vt = F.lds + 27648;
    LAS float* bt = (LAS float*)(F.lds + 53248);
    const int lane = F.lane, tid = F.tid;
    int bt_kv = -1;
    for (int au = F.bx; au < 1040; au += F.G) {
        const bool isS = au >= 1024;
        const int kv = au & 1;
        const int b = isS ? ((au - 1024) >> 1) : (au >> 7);
        const int n = isS ? 0 : ((au & 127) >> 1);
        __syncthreads();
        if (kv != bt_kv) { for (int i = tid; i < 1024; i += NTHREADS) bt[i] = biasr[(kv * 4 + (i >> 8)) * 256 + (i & 255)]; bt_kv = kv; }
#pragma unroll
        for (int jj = 0; jj < 3; ++jj) {
            const int p = tid + NTHREADS * jj, key = p >> 3, ds = p & 7;
            u32x4 kq = (u32x4){0u, 0u, 0u, 0u}, vq = (u32x4){0u, 0u, 0u, 0u};
            if (!isS) {
                const int t = n * 64 + key - 128;
                if (t >= 0) { const bf16_t* zr = Z + (size_t)(b * 4096 + t) * INW + kv * 64 + ds * 8; kq = *(const u32x4*)(zr + 512); vq = *(const u32x4*)(zr + 640); }
            } else if (key < 128) {
                const size_t o = ((size_t)((l * 8 + b) * 128 + key) * 2 + kv) * 64 + ds * 8;
                const f32x4 k0 = *(const f32x4*)(F.in[4] + o), k1 = *(const f32x4*)(F.in[4] + o + 4), v0 = *(const f32x4*)(F.in[5] + o), v1 = *(const f32x4*)(F.in[5] + o + 4);
                kq.x = cvt_pk_bf16(k0[0], k0[1]); kq.y = cvt_pk_bf16(k0[2], k0[3]); kq.z = cvt_pk_bf16(k1[0], k1[1]); kq.w = cvt_pk_bf16(k1[2], k1[3]);
                vq.x = cvt_pk_bf16(v0[0], v0[1]); vq.y = cvt_pk_bf16(v0[2], v0[3]); vq.z = cvt_pk_bf16(v1[0], v1[1]); vq.w = cvt_pk_bf16(v1[2], v1[3]);
            } else {
                const bf16_t* zr = Z + (size_t)(NPROMPT + b * 64 + key - 128) * INW + kv * 64 + ds * 8; kq = *(const u32x4*)(zr + 512); vq = *(const u32x4*)(zr + 640);
            }
            *(LAS u32x4*)(Ks + key * 144 + ds * 16) = kq;
            LAS unsigned short* vp = (LAS unsigned short*)Vt + (ds * 8) * 200 + key;
            vp[0 * 200] = (unsigned short)(vq.x & 0xffffu); vp[1 * 200] = (unsigned short)(vq.x >> 16);
            vp[2 * 200] = (unsigned short)(vq.y & 0xffffu); vp[3 * 200] = (unsigned short)(vq.y >> 16);
            vp[4 * 200] = (unsigned short)(vq.z & 0xffffu); vp[5 * 200] = (unsigned short)(vq.z >> 16);
            vp[6 * 200] = (unsigned short)(vq.w & 0xffffu); vp[7 * 200] = (unsigned short)(vq.w >> 16);
        }
        __syncthreads();
        const int g = F.wave >> 1, qi = (F.wave & 1) * 32 + (lane & 31), hh = lane >> 5, head = kv * 4 + g;
        const int qrow = isS ? NPROMPT + b * 64 + qi : b * 4096 + n * 64 + qi;
        bf16x8 Qf[4];
#pragma unroll
        for (int ks = 0; ks < 4; ++ks) Qf[ks] = *(const bf16x8*)(Z + (size_t)qrow * INW + head * 64 + ks * 16 + hh * 8);
        f32x16 S[6];
#pragma unroll
        for (int kb = 0; kb < 6; ++kb) {
#pragma unroll
            for (int j = 0; j < 16; ++j) S[kb][j] = 0.f;
#pragma unroll
            for (int ks = 0; ks < 4; ++ks) {
                const bf16x8 A = *(const LAS bf16x8*)(Ks + (kb * 32 + (lane & 31)) * 144 + (ks * 16 + hh * 8) * 2);
                S[kb] = __builtin_amdgcn_mfma_f32_32x32x16_bf16(A, Qf[ks], S[kb], 0, 0, 0);
            }
        }
        const float sinkv = F.in[14][l * 8 + head];
        float mx = sinkv;
        const int kmin = isS ? 0 : (128 - n * 64);
#pragma unroll
        for (int kb = 0; kb < 6; ++kb)
#pragma unroll
            for (int j = 0; j < 16; ++j) {
                const int key = kb * 32 + 8 * (j >> 2) + 4 * hh + (j & 3);
                float sv = S[kb][j] * 0.125f + bt[g * 256 + key - qi + 63];
                sv = key >= kmin ? sv : -1e30f;
                S[kb][j] = sv; mx = fmaxf(mx, sv);
            }
        mx = fmaxf(mx, __shfl_xor(mx, 32));
        float sum = 0.f;
#pragma unroll
        for (int kb = 0; kb < 6; ++kb)
#pragma unroll
            for (int j = 0; j < 16; ++j) { const float p = __expf(S[kb][j] - mx); S[kb][j] = p; sum += p; }
        sum += __shfl_xor(sum, 32);
        sum += __expf(sinkv - mx);
        const float inv = 1.0f / sum;
        f32x16 O[2];
#pragma unroll
        for (int db = 0; db < 2; ++db)
#pragma unroll
            for (int j = 0; j < 16; ++j) O[db][j] = 0.f;
#pragma unroll
        for (int kb = 0; kb < 6; ++kb)
#pragma unroll
            for (int s2 = 0; s2 < 2; ++s2) {
                union { bf16x8 v; unsigned u[4]; } P;
#pragma unroll
                for (int q = 0; q < 4; ++q) P.u[q] = cvt_pk_bf16(S[kb][8 * s2 + 2 * q], S[kb][8 * s2 + 2 * q + 1]);
#pragma unroll
                for (int db = 0; db < 2; ++db) {
                    const LAS unsigned char* vb = Vt + (db * 32 + (lane & 31)) * 400 + (kb * 32 + 16 * s2 + 4 * hh) * 2;
                    union { bf16x8 v; u32x2 h[2]; } Vf;
                    Vf.h[0] = *(const LAS u32x2*)vb; Vf.h[1] = *(const LAS u32x2*)(vb + 16);
                    O[db] = __builtin_amdgcn_mfma_f32_32x32x16_bf16(Vf.v, P.v, O[db], 0, 0, 0);
                }
            }
        unsigned char* orow = YA + (size_t)qrow * 512 + head * 64 + 4 * hh; const float inv8 = inv * 8.0f;
#pragma unroll
        for (int db = 0; db < 2; ++db)
#pragma unroll
            for (int jq = 0; jq < 4; ++jq) {
                *(unsigned*)(orow + db * 32 + 8 * jq) = pk4_fp8(O[db][4 * jq] * inv8, O[db][4 * jq + 1] * inv8, O[db][4 * jq + 2] * inv8, O[db][4 * jq + 3] * inv8);
            }
    }
    int nxtra = 1040 % F.G; if (1040 < F.G || 2 * nxtra > F.G) nxtra = 0;
    if (F.bx < nxtra) return;
    const int gw = (F.bx - nxtra) * NWAVES + F.wave, NGW = (F.G - nxtra) * NWAVES;
    const float* cw = F.in[15] + (size_t)l * 3 * 512 + 8 * lane;
    float w0[8], w1[8], w2[8];
#pragma unroll
    for (int e = 0; e < 8; ++e) { w0[e] = cw[e]; w1[e] = cw[512 + e]; w2[e] = cw[1024 + e]; }
    for (int row = gw; row < NT; row += NGW) {
        const bool isS = row >= NPROMPT; const int b = isS ? ((row - NPROMPT) >> 6) : (row >> 12), t = isS ? ((row - NPROMPT) & 63) : (row & 4095);
        const bf16_t* zr = Z + (size_t)row * INW + 8 * lane;
        const u32x4 cb = *(const u32x4*)(zr + 768);
        float u[3][8];
#pragma unroll
        for (int d = 0; d < 3; ++d) {
            if (t - d >= 0) {
                const bf16_t* zz = zr - (size_t)d * INW; const u32x4 cc = *(const u32x4*)(zz + 1280), cx = *(const u32x4*)(zz + 1792);
                u[d][0] = bf_lo(cc.x) * bf_lo(cx.x); u[d][1] = bf_hi(cc.x) * bf_hi(cx.x); u[d][2] = bf_lo(cc.y) * bf_lo(cx.y); u[d][3] = bf_hi(cc.y) * bf_hi(cx.y);
                u[d][4] = bf_lo(cc.z) * bf_lo(cx.z); u[d][5] = bf_hi(cc.z) * bf_hi(cx.z); u[d][6] = bf_lo(cc.w) * bf_lo(cx.w); u[d][7] = bf_hi(cc.w) * bf_hi(cx.w);
            } else if (isS) {
                const float* hp = F.in[6] + ((size_t)(l * 8 + b) * 2 + (2 + t - d)) * 512 + 8 * lane;
                const f32x4 h0 = *(const f32x4*)hp, h1 = *(const f32x4*)(hp + 4);
#pragma unroll
                for (int e = 0; e < 4; ++e) { u[d][e] = h0[e]; u[d][4 + e] = h1[e]; }
            } else {
#pragma unroll
                for (int e = 0; e < 8; ++e) u[d][e] = 0.f;
            }
        }
        const float cbf[8] = {bf_lo(cb.x), bf_hi(cb.x), bf_lo(cb.y), bf_hi(cb.y), bf_lo(cb.z), bf_hi(cb.z), bf_lo(cb.w), bf_hi(cb.w)};
        float y[8];
#pragma unroll
        for (int e = 0; e < 8; ++e) y[e] = cbf[e] * (w0[e] * u[2][e] + w1[e] * u[1][e] + w2[e] * u[0][e]);
        u32x2 w; w.x = pk4_fp8(y[0], y[1], y[2], y[3]); w.y = pk4_fp8(y[4], y[5], y[6], y[7]);
        *(u32x2*)(YB + (size_t)row * 512 + 8 * lane) = w;
        const int tl = isS ? 62 : 4094;
        if (t >= tl) {
            float* o = F.out + (isS ? OCS : OCP) + ((size_t)(l * 8 + b) * 2 + (t - tl)) * 512 + 8 * lane;
            *(f32x4*)o = (f32x4){u[0][0], u[0][1], u[0][2], u[0][3]}; *(f32x4*)(o + 4) = (f32x4){u[0][4], u[0][5], u[0][6], u[0][7]};
        }
    }
}

__device__ __forceinline__ void phase_ln_router(Ctx& F, int l) {
    bf16_t* XB = (bf16_t*)(F.ws + WS_XB); unsigned char* H8 = (unsigned char*)(F.ws + WS_H8); const bf16_t* V16 = (const bf16_t*)(F.ws + WS_V16);
    const float* mod = (const float*)(F.ws + WS_MOD) + (size_t)l * 16 * 6144;
    unsigned* cnt = (unsigned*)(F.ws + WS_CNT) + l * 2048;
    unsigned* tok = (unsigned*)(F.ws + WS_TOK); float* gate = (float*)(F.ws + WS_GATE); unsigned* slot = (unsigned*)(F.ws + WS_SLOT);
    const float* Wr = F.in[21] + (size_t)l * 1024 * 32;
    LAS float* hf = (LAS float*)F.lds;
    LAS unsigned* hist = (LAS unsigned*)(F.lds + 146432); LAS unsigned* hbase = hist + 32;
    LAS u32x4* rec = (LAS u32x4*)(F.lds + 131328);
    int nrec_tiles = 0;
    __syncthreads();
    if (F.tid < 32) hist[F.tid] = 0u;
    const int lane = F.lane, w = F.wave;
    float breg[64];
    { const float* bp = Wr + (size_t)(128 * w) * 32 + lane;
#pragma unroll
      for (int s = 0; s < 64; ++s) breg[s] = bp[64 * s]; }
    for (int tidx = F.bx; tidx < 1024 + 256; tidx += F.G) {
        const int tile0 = tidx < 1024 ? tidx * 32 : NPROMPT + (tidx - 1024) * 2, nrows = tidx < 1024 ? 32 : 2;
        __syncthreads();
        if (w * 4 < nrows) {
            u32x2 pv[4][4];
#pragma unroll
            for (int rr = 0; rr < 4; ++rr) { const int rl = w * 4 + rr, row = rl < nrows ? tile0 + rl : tile0;
#pragma unroll
                for (int j = 0; j < 4; ++j) pv[rr][j] = *(const u32x2*)(V16 + (size_t)row * D + 4 * lane + 256 * j); }
#pragma unroll
            for (int rr = 0; rr < 4; ++rr) {
                const int rl = w * 4 + rr, row = tile0 + rl;
                if (rl < nrows) {
                    f32x4 v[4];
#pragma unroll
                    for (int j = 0; j < 4; ++j) v[j] = (f32x4){bf_lo(pv[rr][j].x), bf_hi(pv[rr][j].x), bf_lo(pv[rr][j].y), bf_hi(pv[rr][j].y)};
                    ln_row(v, F.in[19] + l * D, F.in[20] + l * D, lane);
#pragma unroll
                    for (int j = 0; j < 4; ++j) { u32x2 wq; wq.x = cvt_pk_bf16(v[j][0], v[j][1]); wq.y = cvt_pk_bf16(v[j][2], v[j][3]); *(u32x2*)(XB + (size_t)row * D + 4 * lane + 256 * j) = wq; }
                    const float* mb = mod + (size_t)batch_of(row) * 6144;
#pragma unroll
                    for (int j = 0; j < 4; ++j) { const f32x4 a = *(const f32x4*)(mb + 4096 + 4 * lane + 256 * j), b = *(const f32x4*)(mb + 3072 + 4 * lane + 256 * j);
                        const f32x4 h = v[j] * (a + 1.0f) + b;
                        *(unsigned*)(H8 + (size_t)row * D + 4 * lane + 256 * j) = pk4_fp8(h[0], h[1], h[2], h[3]);
                        LAS float* hp = hf + rl * 1025 + lane + 64 * j;
                        hp[0] = h[0]; hp[256] = h[1]; hp[512] = h[2]; hp[768] = h[3]; }
                }
            }
        }
        __syncthreads();
        f32x16 acc;
#pragma unroll
        for (int j = 0; j < 16; ++j) acc[j] = 0.f;
        {
            const LAS float* ap = hf + (lane & 31) * 1025 + 32 * w;
            const int hh = lane >> 5;
#pragma unroll
            for (int s = 0; s < 64; ++s) { const int kk = 2 * s + hh; acc = __builtin_amdgcn_mfma_f32_32x32x2f32(ap[(kk & 3) * 256 + (kk >> 2)], breg[s], acc, 0, 0, 0); }
        }
        __syncthreads();
        LAS float* red = hf;
#pragma unroll
        for (int j = 0; j < 16; ++j) red[(w * 32 + 8 * (j >> 2) + 4 * (lane >> 5) + (j & 3)) * 33 + (lane & 31)] = acc[j];
        __syncthreads();
        int e_sel[4]; float g_sel[4]; unsigned loc[4];
#pragma unroll
        for (int rr = 0; rr < 4; ++rr) {
            const int tk = w * 4 + rr;
            float val = -INFINITY;
            if (lane < 32) { float sacc = F.in[22][l * 32 + lane];
#pragma unroll
                for (int ww = 0; ww < 8; ++ww) sacc += red[(ww * 32 + tk) * 33 + lane];
                val = sacc; }
            float tv[4]; int te[4];
            {
                const int vbits = __float_as_int(val); int rank = 0;
#pragma unroll
                for (int j = 0; j < 32; ++j) { const float vj = __int_as_float(__builtin_amdgcn_readlane(vbits, j)); rank += (vj > val || (vj == val && j < lane)) ? 1 : 0; }
#pragma unroll
                for (int it = 0; it < 4; ++it) { const unsigned long long mk = __ballot(rank == it); const int ln = mk ? (__ffsll((long long)mk) - 1) : 0;
                    te[it] = ln; tv[it] = __int_as_float(__builtin_amdgcn_readlane(vbits, ln)); }
            }
            const float e1 = __expf(tv[1] - tv[0]), e2 = __expf(tv[2] - tv[0]), e3 = __expf(tv[3] - tv[0]);
            const float rs = 1.0f / (1.0f + e1 + e2 + e3);
            e_sel[rr] = lane == 0 ? te[0] : lane == 1 ? te[1] : lane == 2 ? te[2] : te[3];
            g_sel[rr] = (lane == 0 ? 1.0f : lane == 1 ? e1 : lane == 2 ? e2 : e3) * rs;
            loc[rr] = 0u;
            if (lane < 4 && tk < nrows) loc[rr] = atomicAdd((unsigned*)&hist[e_sel[rr]], 1u);
        }
        if (lane < 4) {
#pragma unroll
            for (int rr = 0; rr < 4; ++rr) {
                const int rl = w * 4 + rr;
                u32x4 rc; rc.x = (rl < nrows) ? (unsigned)(tile0 + rl) : 0xffffffffu; rc.y = (unsigned)(e_sel[rr] & 31); rc.z = loc[rr]; rc.w = __float_as_uint(g_sel[rr]);
                rec[(nrec_tiles * 32 + rl) * 4 + lane] = rc;
            }
        }
        ++nrec_tiles;
    }
    __syncthreads();
    if (F.tid < 32) { const unsigned hcount = hist[F.tid]; hbase[F.tid] = hcount ? atomicAdd(cnt + F.tid * 64, hcount) : 0u; }
    __syncthreads();
    for (int i = F.tid; i < nrec_tiles * 128; i += NTHREADS) {
        const u32x4 rc = rec[i];
        if (rc.x != 0xffffffffu) { const unsigned e = rc.y, rank = hbase[e] + rc.z;
            tok[(size_t)e * NT + rank] = rc.x; gate[(size_t)e * NT + rank] = __uint_as_float(rc.w); slot[(size_t)rc.x * 4 + (i & 3)] = (e << 24) | rank; }
    }
}

__device__ __forceinline__ void build_blk(Ctx& F, int l) {
    LAS int* blk = (LAS int*)(F.lds + LDS_BLK);
    const unsigned* cnt = (const unsigned*)(F.ws + WS_CNT) + l * 2048;
    __syncthreads();
    if (F.tid == 0) { LAS int* cl = (LAS int*)(F.lds + LDS_CNT); int s = 0; for (int e = 0; e < 32; ++e) { const int ce = (int)cnt[e * 64]; cl[e] = ce; blk[e] = s; s += (ce + 255) >> 8; } blk[32] = s; }
    __syncthreads();
}

__device__ __forceinline__ void phase_combine(Ctx& F, int l) {
    const LAS int* blk = (const LAS int*)(F.lds + LDS_BLK);
    float* X = F.out; bf16_t* XB = (bf16_t*)(F.ws + WS_XB); bf16_t* H = (bf16_t*)(F.ws + WS_H); const unsigned char* YS = F.ws + WS_YS;
    const unsigned* slot = (const unsigned*)(F.ws + WS_SLOT);
    const float* mod = (const float*)(F.ws + WS_MOD);
    const int gw = F.bx * NWAVES + F.wave, NGW = F.G * NWAVES, lane = F.lane;
    for (int row = gw; row < NT; row += NGW) {
        f32x4 ff[4];
#pragma unroll
        for (int j = 0; j < 4; ++j) ff[j] = (f32x4){0.f, 0.f, 0.f, 0.f};
#pragma unroll
        for (int k = 0; k < 4; ++k) {
            const unsigned s = slot[(size_t)row * 4 + k]; const int e = (int)(s >> 24), rank = (int)(s & 0xffffffu);
            const unsigned char* yr = YS + ((size_t)blk[e] * 256 + rank) * D + 4 * lane;
#pragma unroll
            for (int j = 0; j < 4; ++j) { const unsigned wv = *(const unsigned*)(yr + 256 * j); const f32x2 lo = __builtin_amdgcn_cvt_pk_f32_fp8(wv, false), hi = __builtin_amdgcn_cvt_pk_f32_fp8(wv, true);
                ff[j][0] += lo.x; ff[j][1] += lo.y; ff[j][2] += hi.x; ff[j][3] += hi.y; }
        }
        const int bi = batch_of(row);
        const float* mb = mod + (size_t)(l * 16 + bi) * 6144;
        f32x4 v[4];
#pragma unroll
        for (int j = 0; j < 4; ++j) { const u32x2 xw = *(const u32x2*)(XB + (size_t)row * D + 4 * lane + 256 * j); const f32x4 x = (f32x4){bf_lo(xw.x), bf_hi(xw.x), bf_lo(xw.y), bf_hi(xw.y)}, g2 = *(const f32x4*)(mb + 5120 + 4 * lane + 256 * j);
            v[j] = x * ALPHA + (g2 + 1.0f) * (ff[j] * 0.0625f); }
        ln_row(v, F.in[27] + l * D, F.in[28] + l * D, lane);
#pragma unroll
        for (int j = 0; j < 4; ++j) { if (l == 0) { u32x2 w; w.x = cvt_pk_bf16(v[j][0], v[j][1]); w.y = cvt_pk_bf16(v[j][2], v[j][3]); *(u32x2*)(XB + (size_t)row * D + 4 * lane + 256 * j) = w; }
            else *(f32x4*)(X + (size_t)row * D + 4 * lane + 256 * j) = v[j]; }
        if (l == 0) { const float* mn = mod + (size_t)(16 + bi) * 6144; store_mod_row(v, mn, mn + 1024, H + (size_t)row * D, F.ws + WS_H8 + (size_t)row * D, lane); }
    }
}

#ifndef PH_MASK
#define PH_MASK 0xFFFF
#endif
#define PH(b) ((PH_MASK >> (b)) & 1)
#ifndef PROBE_MASK
#define PROBE_MASK 0
#endif
#define PB0(id) do { if ((PROBE_MASK >> (id)) & 1) pb_t0 = __builtin_amdgcn_s_memrealtime(); } while (0)
#define PB1(id) do { if ((PROBE_MASK >> (id)) & 1) pb_acc += __builtin_amdgcn_s_memrealtime() - pb_t0; } while (0)
#define RELOAD() do { int t_ = threadIdx.x; asm volatile("" : "+v"(t_)); F.tid = t_; F.lane = t_ & 63; F.wave = __builtin_amdgcn_readfirstlane(t_ >> 6); \
    unsigned z_; asm volatile("s_mov_b32 %0, 0" : "=s"(z_)); F.in = p.in; F.out = p.out + z_; F.ws = p.ws + z_; } while (0)
#define LAYER_BODY(l) do { \
          \
        PB0(2); RELOAD(); \
        if (PH(2)) { \
              \
            pg8::SchedDense S; S.init(NT, 7 * 256, D, F.G, F.bx, (const bf16_t*)(F.ws + WS_WIN) + (size_t)l * INW * D, 2); \
            pg8::EpiZ E{(bf16_t*)(F.ws + WS_Z), F.in[13] + l * INW, F.out, l, F.ws + WS_ZG8}; \
            pg8::gemm_phase<false, 0u>(F.lds, (const char*)(F.ws + WS_H), D, S, E); \
        } \
        RELOAD(); \
        if (PH(2)) { \
              \
            pg8::SchedDense S; S.init(NT, 10 * 256, 512, F.G, (F.G == 256) ? ((F.bx + 112) & 255) : F.bx, F.ws + WS_WIN8 + (size_t)l * INW * D, 0, 2, 7); \
            pg8::EpiZ E{(bf16_t*)(F.ws + WS_Z), F.in[13] + l * INW, F.out, l, F.ws + WS_ZG8}; \
            pg8::gemm_phase<true, 0x7f7f7f7fu>(F.lds, (const char*)(F.ws + WS_H8), 512, S, E); \
        } \
        xcd_barrier(xbar); PB1(2); PB0(3); \
        RELOAD(); \
        if (PH(3)) phase_attn(F, l); \
        xcd_barrier(xbar); PB1(3); PB0(4); \
          \
        RELOAD(); \
        if (PH(4)) { \
            pg8::SchedDense S; S.init(NT, D, 256, F.G, F.bx, F.ws + WS_WOA + (size_t)l * D * 512); \
            pg8::EpiT1 E{F.ws + WS_T1, F.ws + WS_ZG8}; \
            pg8::gemm_phase<true, 0x7c7c7c7cu>(F.lds, (const char*)(F.ws + WS_YA), 256, S, E); \
        } \
        RELOAD(); \
        if (PH(5)) { \
            pg8::SchedDense S; S.init(NT, D, 256, F.G, F.bx, F.ws + WS_WOB + (size_t)l * D * 512); \
            pg8::EpiMix E{F.ws + WS_T1, F.ws + WS_ZG8, F.ws + WS_MIX}; \
            pg8::gemm_phase<true, 0x7f7f7f7fu>(F.lds, (const char*)(F.ws + WS_YB), 256, S, E); \
        } \
        xcd_barrier(xbar); PB1(4); PB0(5); \
          \
        RELOAD(); \
        if (PH(6)) { \
            pg8::SchedDense S; S.init(NT, D, 512, F.G, F.bx, F.ws + WS_WO + (size_t)l * D * D); \
            pg8::EpiX E{(const bf16_t*)(F.ws + WS_XB), (bf16_t*)(F.ws + WS_V16), (const float*)(F.ws + WS_MOD) + (size_t)l * 16 * 6144}; \
            pg8::gemm_phase<true, 0x7f7f7f7fu>(F.lds, (const char*)(F.ws + WS_MIX), 512, S, E); \
        } \
        xcd_barrier(xbar); PB1(5); PB0(6); \
        RELOAD(); \
        if (PH(7)) phase_ln_router(F, l); \
        xcd_barrier(xbar); PB1(6); PB0(7); \
          \
        RELOAD(); \
        build_blk(F, l); \
        if (PH(8)) { \
            LAS int* blk = (LAS int*)(F.lds + LDS_BLK); \
            LAS unsigned short* idx = (LAS unsigned short*)(F.lds + LDS_IDX); \
            pg8::SchedMoE<true> S; S.init(blk, idx, 8, 512, F.G, F.bx, (const unsigned char*)(F.ws + WS_WGU) + (size_t)l * 32 * 2048 * D, (size_t)2048 * D); \
            const unsigned* cnt = (const unsigned*)(F.ws + WS_CNT) + l * 2048; const unsigned* tok = (const unsigned*)(F.ws + WS_TOK); \
            for (int i = 0; i < MAXU; ++i) { pg8::Unit u; if (!S.next(i, u)) break; \
                if (F.tid < 256) { int rank = (u.pm - blk[u.e]) * 256 + F.tid; const int ce = (int)cnt[u.e * 64]; rank = rank < ce ? rank : ce - 1; \
                    idx[i * 256 + F.tid] = (unsigned short)tok[(size_t)u.e * NT + rank]; } } \
            __syncthreads(); \
            pg8::EpiAct E{(unsigned char*)(F.ws + WS_ACT), F.in[24] + (size_t)l * 32 * 2048}; \
            pg8::gemm_phase<true, 0x7f7f7f7fu>(F.lds, (const char*)(F.ws + WS_H8), 512, S, E); \
        } \
        xcd_barrier(xbar); PB1(7); PB0(8); \
          \
        RELOAD(); \
        if (PH(9)) { \
            LAS int* blk = (LAS int*)(F.lds + LDS_BLK); \
            LAS unsigned short* idx = (LAS unsigned short*)(F.lds + LDS_IDX); \
            pg8::SchedMoE<false> S; S.init(blk, idx, 4, 512, F.G, F.bx, (const unsigned char*)(F.ws + WS_WDN) + (size_t)l * 32 * D * D, (size_t)D * D); \
            pg8::EpiYs E{F.ws + WS_YS, F.in[26] + (size_t)l * 32 * D, (const float*)(F.ws + WS_GATE), (const LAS int*)(F.lds + LDS_CNT), blk}; \
            pg8::gemm_phase<true, 0x7f7f7f7fu>(F.lds, (const char*)(F.ws + WS_ACT), 512, S, E); \
        } \
        xcd_barrier(xbar); PB1(8); PB0(9); \
        RELOAD(); \
        if (PH(10)) phase_combine(F, l); \
        if (l == 0) xcd_barrier(xbar); \
        PB1(9); \
 \
    } while (0)
__global__ void __launch_bounds__(NTHREADS, 2) fwd_megakernel(Params p) {
    extern __shared__ __attribute__((aligned(16))) unsigned char lds_raw[];
    cg::grid_group grid = cg::this_grid();
    Ctx F;
    F.lds = (LAS unsigned char*)lds_raw;
    F.G = gridDim.x; F.bx = blockIdx.x;
    volatile LAS unsigned* bst = (volatile LAS unsigned*)(F.lds + 147392);
    if (threadIdx.x < 2) bst[threadIdx.x] = 0u;
    __syncthreads();
    const XcdBarrier xbar = xcd_barrier_post((unsigned*)(p.ws + WS_BAR), bst);
    unsigned long long pb_t0 = 0, pb_acc = 0;
    PB0(0); RELOAD();
    if (PH(0)) phase0a(F);
    grid.sync();
    PB1(0); PB0(1); RELOAD();
    { const float* modp = (const float*)(F.ws + WS_MODP); float* mod = (float*)(F.ws + WS_MOD);
      for (int i = F.bx * NTHREADS + F.tid; i < 2 * 16 * 6144; i += F.G * NTHREADS) { float sm = 0.f;
#pragma unroll
          for (int kc = 0; kc < 8; ++kc) sm += modp[(size_t)kc * (2 * 16 * 6144) + i];
          mod[i] = sm; } }
    xcd_barrier(xbar);
    RELOAD();
    if (PH(1)) phase0b(F);
    xcd_barrier(xbar); PB1(1);

    LAYER_BODY(0);
    LAYER_BODY(1);
    if (PROBE_MASK != 0 && blockIdx.x == 0) { const unsigned long long te = __builtin_amdgcn_s_memrealtime(); while (__builtin_amdgcn_s_memrealtime() - te < pb_acc) __builtin_amdgcn_s_sleep(8); }
    (void)pb_t0; (void)pb_acc;
}

extern "C" void kernel_launch(void* const* d_in, const int* in_sizes, int n_in, void* d_out, int out_size, void* d_ws, size_t ws_size, hipStream_t stream) {
    static int grid = 0;
    if (grid == 0) {
        if (n_in != 29 || ws_size < WS_END) { fprintf(stderr, "kernel_launch: unexpected n_in %d / ws_size %zu (need %zu)\n", n_in, ws_size, (size_t)WS_END); grid = -1; return; }
        int dev = 0, cus = 0, per_cu = 0;
        hipGetDevice(&dev);
        hipDeviceGetAttribute(&cus, hipDeviceAttributeMultiprocessorCount, dev);
        if (hipFuncSetAttribute((const void*)fwd_megakernel, hipFuncAttributeMaxDynamicSharedMemorySize, LDS_BYTES) != hipSuccess) { fprintf(stderr, "kernel_launch: hipFuncSetAttribute failed\n"); grid = -1; return; }
        if (hipOccupancyMaxActiveBlocksPerMultiprocessor(&per_cu, (const void*)fwd_megakernel, NTHREADS, LDS_BYTES) != hipSuccess || per_cu < 1) { fprintf(stderr, "kernel_launch: occupancy query says %d blocks per CU\n", per_cu); per_cu = 1; }
        (void)hipGetLastError();
        grid = cus;
        if (grid != 256) fprintf(stderr, "kernel_launch: note: %d CUs (built for 256)\n", grid);
    }
    if (grid < 0) return;
    hipMemsetAsync((char*)d_ws, 0, WS_ZERO_BYTES, stream);
    Params p{};
    for (int i = 0; i < 29; ++i) p.in[i] = (const float*)d_in[i];
    p.out = (float*)d_out; p.ws = (unsigned char*)d_ws;
    void* args[] = {&p};
    hipError_t e = hipLaunchCooperativeKernel((const void*)fwd_megakernel, dim3(grid), dim3(NTHREADS), args, LDS_BYTES, stream);
    if (e != hipSuccess) fprintf(stderr, "kernel_launch: cooperative launch failed: %s (grid %d)\n", hipGetErrorString(e), grid);
}
```

```cpp
#include <hip/hip_runtime.h>
#include <hip/hip_cooperative_groups.h>
#include <cstdio>
#include <cstdint>
namespace cg = cooperative_groups;

#define LAS __attribute__((address_space(3)))
typedef unsigned short bf16_t;
typedef short bf16x8 __attribute__((ext_vector_type(8)));
typedef float f32x4 __attribute__((ext_vector_type(4)));
typedef float f32x16 __attribute__((ext_vector_type(16)));
typedef unsigned u32x4 __attribute__((ext_vector_type(4)));
typedef unsigned u32x2 __attribute__((ext_vector_type(2)));
typedef float f32x2 __attribute__((ext_vector_type(2)));
typedef int i32x4 __attribute__((ext_vector_type(4)));
typedef int i32x8 __attribute__((ext_vector_type(8)));

constexpr int D = 1024, NPROMPT = 32768, NT = 33280, INW = 4352, NEXP = 32;
constexpr float ALPHA = 1.41421356237f, LN_EPS = 1e-5f;
constexpr int NWAVES = 8, NTHREADS = 512;
constexpr int LDS_BYTES = 147456;
constexpr int LDS_BLK = 131072;
constexpr int LDS_IDX = 131072 + 256;
constexpr int MAXU = 20;
constexpr int LDS_BIASBUF = 141568;
constexpr int LDS_CNT = 145664;
constexpr size_t OKP = 34078720, OVP = 34340864, OCP = 34603008, OKS = 34619392, OVS = 34881536, OCS = 35143680;
constexpr size_t MiB = 1u << 20;
constexpr size_t WS_CNT = 0;
constexpr size_t WS_BAR = 16384;
constexpr size_t WS_MOD = 65536;
constexpr size_t WS_MODP = 192 * MiB;
constexpr size_t WS_ZERO_BYTES = 1 * MiB;
constexpr size_t WS_BIAS = 1 * MiB;
constexpr size_t WS_SLOT = 2 * MiB;
constexpr size_t WS_TOK = 3 * MiB;
constexpr size_t WS_GATE = 8 * MiB;
constexpr size_t WS_WIN = 16 * MiB;
constexpr size_t WS_WIN8 = 180 * MiB;
constexpr size_t WS_WOA = 34 * MiB;
constexpr size_t WS_WOB = 36 * MiB;
constexpr size_t WS_WO = 38 * MiB;
constexpr size_t WS_WGU = 48 * MiB;
constexpr size_t WS_WDN = 304 * MiB;
constexpr size_t WS_H = 432 * MiB;
constexpr size_t WS_H8 = 1600 * MiB;
constexpr size_t WS_Z = 498 * MiB;
constexpr size_t WS_YA = 776 * MiB;
constexpr size_t WS_YB = 810 * MiB;
constexpr size_t WS_T1 = 844 * MiB;
constexpr size_t WS_V16 = 910 * MiB;
constexpr size_t WS_XB = 1200 * MiB;
constexpr size_t WS_MIX = 976 * MiB;
constexpr size_t WS_ACT = 1042 * MiB;
constexpr size_t WS_YS = 1320 * MiB;
constexpr size_t WS_ZG8 = 1460 * MiB;
constexpr size_t WS_END = 1634 * MiB;

struct Params { const float* in[29]; float* out; unsigned char* ws; };

__device__ __forceinline__ unsigned cvt_pk_bf16(float lo, float hi) { unsigned r; asm volatile("v_cvt_pk_bf16_f32 %0, %1, %2" : "=v"(r) : "v"(lo), "v"(hi)); return r; }
__device__ __forceinline__ unsigned pk4_fp8(float a, float b, float c, float d) { unsigned w = 0u; w = __builtin_amdgcn_cvt_pk_fp8_f32(a, b, w, false); w = __builtin_amdgcn_cvt_pk_fp8_f32(c, d, w, true); return w; }
__device__ __forceinline__ void unpk8_fp8(const u32x2 w, float (&o)[8]) { const f32x2 a = __builtin_amdgcn_cvt_pk_f32_fp8(w.x, false), b = __builtin_amdgcn_cvt_pk_f32_fp8(w.x, true), c = __builtin_amdgcn_cvt_pk_f32_fp8(w.y, false), d = __builtin_amdgcn_cvt_pk_f32_fp8(w.y, true);
    o[0] = a.x; o[1] = a.y; o[2] = b.x; o[3] = b.y; o[4] = c.x; o[5] = c.y; o[6] = d.x; o[7] = d.y; }
__device__ __forceinline__ void store_pair16(unsigned char* pa, unsigned char* pb, int fq, u32x2 wa, u32x2 wb) {
    const auto rx = __builtin_amdgcn_permlane16_swap(wa.x, wb.x, false, false);
    const auto ry = __builtin_amdgcn_permlane16_swap(wa.y, wb.y, false, false);
    u32x4 o; o.x = rx[0]; o.y = ry[0]; o.z = rx[1]; o.w = ry[1];
    *(u32x4*)((fq & 1) ? pb - 8 : pa) = o;
}
__device__ __forceinline__ void load_pair16(const unsigned char* pa, const unsigned char* pb, int fq, u32x2& wa, u32x2& wb) {
    const u32x4 x = *(const u32x4*)((fq & 1) ? pb - 8 : pa);
    const auto rx = __builtin_amdgcn_permlane16_swap(x.x, x.z, false, false);
    const auto ry = __builtin_amdgcn_permlane16_swap(x.y, x.w, false, false);
    wa.x = rx[0]; wa.y = ry[0]; wb.x = rx[1]; wb.y = ry[1];
}
__device__ __forceinline__ float bf_lo(unsigned w) { return __uint_as_float(w << 16); }
__device__ __forceinline__ float bf_hi(unsigned w) { return __uint_as_float(w & 0xffff0000u); }
__device__ __forceinline__ float sigmoidf_(float x) { return __builtin_amdgcn_rcpf(1.0f + __expf(-x)); }
__device__ __forceinline__ float wave_sum(float v) {
#define WS_DPP_ADD(ctrl) v += __int_as_float(__builtin_amdgcn_update_dpp(0, __float_as_int(v), (ctrl), 0xf, 0xf, true))
    WS_DPP_ADD(0xB1);
    WS_DPP_ADD(0x4E);
    WS_DPP_ADD(0x141);
    WS_DPP_ADD(0x140);
#undef WS_DPP_ADD
    const int b = __float_as_int(v);
    const float r0 = __int_as_float(__builtin_amdgcn_readlane(b, 0)), r1 = __int_as_float(__builtin_amdgcn_readlane(b, 16)), r2 = __int_as_float(__builtin_amdgcn_readlane(b, 32)), r3 = __int_as_float(__builtin_amdgcn_readlane(b, 48));
    return (r0 + r1) + (r2 + r3);
}
__device__ __forceinline__ int batch_of(int row) { return row < NPROMPT ? (row >> 12) : 8 + ((row - NPROMPT) >> 6); }

namespace pg8 {
constexpr int BM = 256, BK = 64, HALF = 128, HTB = HALF * BK * 2, NXCD = 8, WGM = 8;
__device__ __forceinline__ int lds_byte(int r, int c) { const int st = (r >> 4) * 2 + (c >> 5), rr = r & 15, cc = c & 31, ob = rr * 64 + cc * 2; return st * 1024 + (ob ^ (((ob >> 9) & 1) << 5)); }
__device__ __forceinline__ void stage_rc(int b, int& R, int& C) { const int st = b / 1024, sb = b % 1024, swz = sb ^ (((sb >> 9) & 1) << 5); R = (st >> 1) * 16 + swz / 64; C = (st & 1) * 32 + (swz % 64) / 2; }
__device__ __forceinline__ int perm32(int rho) { const int n = rho >> 4, i = rho & 15; return 8 * (i >> 2) + 4 * n + (i & 3); }

struct Unit { int pm, pn, e; const char* b; };

struct SchedDense {
    int nM, nN, nwg, G, c, cbase, csplit, cskip; const char* Bt; size_t tstepB;
    __device__ __forceinline__ void init(int M, int N, int K, int G_, int c_, const void* Bt_, int cbase_ = 0, int csplit_ = 1 << 20, int cskip_ = 0) { nM = M / BM; nN = N / BM; nwg = nM * nN; G = G_; c = c_; Bt = (const char*)Bt_; tstepB = (size_t)BM * K * 2; cbase = cbase_; csplit = csplit_; cskip = cskip_; }
    __device__ __forceinline__ bool next(int i, Unit& u) const {
        const long L = (long)i * G + c; if (L >= nwg) return false;
        int wgid = (int)L; { const int q = nwg / NXCD, r = nwg % NXCD, xcd = wgid % NXCD, off = wgid / NXCD; wgid = (xcd < r ? xcd * (q + 1) : r * (q + 1) + (xcd - r) * q) + off; }
        const int nig = WGM * nN, gid = wgid / nig, fm = gid * WGM, gsz = (nM - fm) < WGM ? (nM - fm) : WGM;
        u.pm = fm + ((wgid % nig) % gsz); const int j = (wgid % nig) / gsz; u.pn = j < csplit ? j + cbase : j + cbase + cskip; u.e = 0; u.b = Bt + (size_t)u.pn * tstepB; return true;
    }
    __device__ __forceinline__ unsigned rowidx(int, const Unit& u, int r) const { return (unsigned)(u.pm * BM + r); }
};
template <bool GATHER> struct SchedMoE {
    const LAS int* blk; const LAS unsigned short* idx; int NB, RBX, NPN, NXs, perx, cx, cj; const char* Bt; size_t estep, tstepB;
    __device__ __forceinline__ void init(const LAS int* blk_, const LAS unsigned short* idx_, int NPN_, int K, int G, int c, const void* Bt_, size_t estep_) {
        blk = blk_; idx = idx_; NB = blk_[32]; NPN = NPN_; Bt = (const char*)Bt_; estep = estep_; tstepB = (size_t)BM * K * 2;
        if ((G & 7) == 0) { NXs = 8; perx = G >> 3; cx = c & 7; cj = c >> 3; } else { NXs = 1; perx = G; cx = 0; cj = c; }
        RBX = (NB + NXs - 1) / NXs;
    }
    __device__ __forceinline__ bool next(int i, Unit& u) const {
        const int j = i * perx + cj, rbl = j / NPN; if (rbl >= RBX) return false;
        const int rb = cx * RBX + rbl; if (rb >= NB) return false;
        int e = 0;
        for (int q = 1; q < 32; ++q) e = (blk[q] <= rb) ? q : e;
        u.pm = rb; u.pn = j - rbl * NPN; u.e = e; u.b = Bt + (size_t)e * estep + (size_t)u.pn * tstepB; return true;
    }
    __device__ __forceinline__ unsigned rowidx(int ui, const Unit& u, int r) const { if (GATHER) return (unsigned)idx[ui * 256 + r]; return (unsigned)(u.pm * BM + r); }
};

template <bool FP8, unsigned ASCALE, class Epi, class Sched>
__device__ __forceinline__ void gemm_phase(LAS unsigned char* lds, const char* Abase, const int K, const Sched& S, const Epi& E) {
    int tid_ = threadIdx.x; asm volatile("" : "+v"(tid_));
    const int tid = tid_, wid = __builtin_amdgcn_readfirstlane(tid >> 6), lane = tid & 63, wr = wid >> 2, wc = wid & 3, fr = lane & 15, fq = lane >> 4;
    int nt_ = K / BK; asm volatile("" : "+s"(nt_)); const int nt = nt_;
    unsigned voffB[2]; int RA[2], CA[2];
#pragma unroll
    for (int i = 0; i < 2; ++i) { int R, C; stage_rc(tid * 16 + i * 8192, R, C); const int Rb = Epi::PERM ? ((R & ~31) + perm32(R & 31)) : R;
        voffB[i] = (unsigned)(Rb * K + C) * 2u; RA[i] = R; CA[i] = C * 2; }
    const size_t kstep = (size_t)(BK * 2);
    const size_t hstep = (size_t)HALF * K * 2;
    const unsigned ldsw = (unsigned)wid * 1024u;
    const unsigned rowb = (unsigned)K * 2u;
    const int aoff = lds_byte(wr * 64 + fr, fq * 8), boff = lds_byte(wc * 32 + fr, fq * 8);
#define PG8_SA(b, h) (((b) * 2 + (h)) * HTB)
#define PG8_SB(b, h) ((4 + (b) * 2 + (h)) * HTB)
#define PG8_STAGE(bufoff, gbase, voff) do { _Pragma("unroll") for (int _i = 0; _i < 2; ++_i) \
        __builtin_amdgcn_global_load_lds((const unsigned*)((const char*)(gbase) + (voff)[_i]), (LAS unsigned*)(lds + (bufoff) + ldsw + _i * 8192), 16, 0, 0); } while (0)
#define PG8_LDA(dst, b, h) do { _Pragma("unroll") for (int m = 0; m < 4; ++m) _Pragma("unroll") for (int k = 0; k < 2; ++k) dst[m][k] = *(const LAS bf16x8*)(lds + PG8_SA(b, h) + aoff + m * 2048 + k * 1024); } while (0)
#define PG8_LDB(dst, b, h) do { _Pragma("unroll") for (int n = 0; n < 2; ++n) _Pragma("unroll") for (int k = 0; k < 2; ++k) dst[n][k] = *(const LAS bf16x8*)(lds + PG8_SB(b, h) + boff + n * 2048 + k * 1024); } while (0)
#define PG8_MMA(ai, bj, At, Bt) do { __builtin_amdgcn_s_setprio(1); _Pragma("unroll") for (int m = 0; m < 4; ++m) _Pragma("unroll") for (int n = 0; n < 2; ++n) { \
        if constexpr (FP8) { \
            const i32x8 wf_ = __builtin_shufflevector((i32x4)Bt[n][0], (i32x4)Bt[n][1], 0, 1, 2, 3, 4, 5, 6, 7), af_ = __builtin_shufflevector((i32x4)At[m][0], (i32x4)At[m][1], 0, 1, 2, 3, 4, 5, 6, 7); \
            acc[ai][bj][m][n] = __builtin_amdgcn_mfma_scale_f32_16x16x128_f8f6f4(wf_, af_, acc[ai][bj][m][n], 0, 0, 0, 0x79797979, 0, (int)ASCALE); \
        } else { _Pragma("unroll") for (int k = 0; k < 2; ++k) \
            acc[ai][bj][m][n] = __builtin_amdgcn_mfma_f32_16x16x32_bf16(Bt[n][k], At[m][k], acc[ai][bj][m][n], 0, 0, 0); } } \
        __builtin_amdgcn_s_setprio(0); } while (0)
#define PG8_WAIT_V(n) asm volatile("s_waitcnt vmcnt(" #n ")" ::: "memory")
#define PG8_WAIT_L(n) asm volatile("s_waitcnt lgkmcnt(" #n ")" ::: "memory")
#define PG8_BAR __builtin_amdgcn_s_barrier()
#define PG8_SCHED __builtin_amdgcn_sched_barrier(0)
#define PG8_LOADVA(ui_, u_) do { _Pragma("unroll") for (int _h = 0; _h < 2; ++_h) _Pragma("unroll") for (int _i = 0; _i < 2; ++_i) \
        vA[_h][_i] = S.rowidx((ui_), (u_), _h * HALF + RA[_i]) * rowb + (unsigned)CA[_i]; } while (0)
    Unit cur, nxt; int ui = 0;
    if (!S.next(0, cur)) return;
    f32x4 acc[2][2][4][2];
#pragma unroll
    for (int a = 0; a < 2; ++a)
#pragma unroll
        for (int b = 0; b < 2; ++b)
#pragma unroll
            for (int m = 0; m < 4; ++m)
#pragma unroll
                for (int n = 0; n < 2; ++n) acc[a][b][m][n] = (f32x4){0.f, 0.f, 0.f, 0.f};
    bf16x8 At[4][2], B0[2][2], B1[2][2];
    unsigned vA[2][2];
    PG8_LOADVA(0, cur);
    const char* cB = cur.b;
    if (Epi::BIAS && tid < 64) __builtin_amdgcn_global_load_lds((const unsigned*)E.bias_ptr(cur, tid), (LAS unsigned*)(lds + LDS_BIASBUF), 16, 0, 0);
    if (Epi::EXTRA && tid < 64) __builtin_amdgcn_global_load_lds((const unsigned*)E.extra_ptr(cur, tid), (LAS unsigned*)(lds + LDS_BIASBUF + 1024), 16, 0, 0);
    PG8_STAGE(PG8_SB(0, 0), cB, voffB); PG8_STAGE(PG8_SB(0, 1), cB + hstep, voffB); PG8_STAGE(PG8_SA(0, 0), Abase, vA[0]); PG8_STAGE(PG8_SA(0, 1), Abase, vA[1]);
    if (wr == 1) PG8_BAR;
    PG8_WAIT_V(2); PG8_BAR;
    PG8_STAGE(PG8_SB(1, 0), cB + kstep, voffB); PG8_STAGE(PG8_SA(1, 0), Abase + kstep, vA[0]); PG8_STAGE(PG8_SB(1, 1), cB + hstep + kstep, voffB);
    PG8_WAIT_V(6); PG8_BAR;
    for (;;) {
        const bool has_next = S.next(ui + 1, nxt);
        const char* nB = has_next ? nxt.b : cB;
#pragma unroll 1
        for (int t = 0; t < nt; t += 2) {
            const bool last = (t == nt - 2);
            const char* a1 = Abase + (size_t)(t + 1) * kstep;
            const char* a2 = last ? Abase : Abase + (size_t)(t + 2) * kstep;
            const char* b2 = last ? nB : cB + (size_t)(t + 2) * kstep;
            const char* a3 = a2 + kstep; const char* b3 = b2 + kstep;
            PG8_LDB(B0, 0, 0); PG8_LDB(B1, 0, 1); PG8_SCHED; PG8_LDA(At, 0, 0); PG8_STAGE(PG8_SA(1, 1), a1, vA[1]);
            if (last && has_next) { PG8_LOADVA(ui + 1, nxt);
                if (Epi::BIAS && tid < 64) __builtin_amdgcn_global_load_lds((const unsigned*)E.bias_ptr(nxt, tid), (LAS unsigned*)(lds + LDS_BIASBUF + ((ui + 1) & 1) * 2048), 16, 0, 0);
                if (Epi::EXTRA && tid < 64) __builtin_amdgcn_global_load_lds((const unsigned*)E.extra_ptr(nxt, tid), (LAS unsigned*)(lds + LDS_BIASBUF + ((ui + 1) & 1) * 2048 + 1024), 16, 0, 0); }
            PG8_WAIT_V(8); PG8_WAIT_L(0); PG8_BAR; PG8_MMA(0, 0, At, B0); PG8_MMA(0, 1, At, B1); PG8_BAR; PG8_SCHED;
            PG8_LDA(At, 0, 1); PG8_STAGE(PG8_SB(0, 0), b2, voffB); PG8_STAGE(PG8_SB(0, 1), b2 + hstep, voffB); PG8_STAGE(PG8_SA(0, 0), a2, vA[0]);
            PG8_WAIT_V(8); PG8_WAIT_L(0); PG8_BAR; PG8_MMA(1, 0, At, B0); PG8_MMA(1, 1, At, B1); PG8_BAR; PG8_SCHED;
            PG8_LDB(B0, 1, 0); PG8_LDB(B1, 1, 1); PG8_SCHED; PG8_LDA(At, 1, 0); PG8_STAGE(PG8_SA(0, 1), a2, vA[1]);
            PG8_WAIT_V(8); PG8_WAIT_L(0); PG8_BAR; PG8_MMA(0, 0, At, B0); PG8_MMA(0, 1, At, B1); PG8_BAR; PG8_SCHED;
            PG8_LDA(At, 1, 1); PG8_STAGE(PG8_SB(1, 0), b3, voffB); PG8_STAGE(PG8_SB(1, 1), b3 + hstep, voffB); PG8_STAGE(PG8_SA(1, 0), a3, vA[0]);
            PG8_WAIT_V(8); PG8_WAIT_L(0); PG8_BAR; PG8_MMA(1, 0, At, B0); PG8_MMA(1, 1, At, B1); PG8_BAR; PG8_SCHED;
        }
        if (wr == 0) PG8_BAR;
        E(acc, cur, wr, wc, fr, fq, (const LAS float*)(lds + LDS_BIASBUF + (ui & 1) * 2048));
        if (!has_next) break;
#pragma unroll
        for (int a = 0; a < 2; ++a)
#pragma unroll
            for (int b = 0; b < 2; ++b)
#pragma unroll
                for (int m = 0; m < 4; ++m)
#pragma unroll
                    for (int n = 0; n < 2; ++n) acc[a][b][m][n] = (f32x4){0.f, 0.f, 0.f, 0.f};
        cur = nxt; cB = nB; ++ui;
        if (wr == 1) PG8_BAR;
    }
    PG8_WAIT_V(0);
    PG8_BAR;
#undef PG8_SA
#undef PG8_SB
#undef PG8_STAGE
#undef PG8_LDA
#undef PG8_LDB
#undef PG8_MMA
#undef PG8_WAIT_V
#undef PG8_WAIT_L
#undef PG8_BAR
#undef PG8_SCHED
#undef PG8_LOADVA
}

typedef f32x4 Acc[2][2][4][2];

struct EpiZ {
    static constexpr bool PERM = true, BIAS = true, EXTRA = false;
    __device__ __forceinline__ const float* extra_ptr(const Unit&, int) const { return nullptr; }
    __device__ __forceinline__ const float* bias_ptr(const Unit& u, int t) const { return bias + u.pn * 256 + 4 * t; }
    bf16_t* Z; const float* bias; float* out; int l; unsigned char* ZG;
    __device__ __forceinline__ void operator()(const Acc& acc, const Unit& u, int wr, int wc, int fr, int fq, const LAS float* lb) const {
        const int row0 = u.pm * 256 + wr * 64 + fr, col0 = u.pn * 256 + wc * 32 + 8 * fq;
        u32x2 wprev[2];
        f32x4 bv[2][2];
#pragma unroll
        for (int bj = 0; bj < 2; ++bj)
#pragma unroll
            for (int n = 0; n < 2; ++n) bv[bj][n] = *(const LAS f32x4*)(lb + bj * 128 + wc * 32 + 8 * fq + 4 * n);
#pragma unroll
        for (int ai = 0; ai < 2; ++ai)
#pragma unroll
            for (int m = 0; m < 4; ++m) {
                const int row = row0 + ai * 128 + m * 16;
                bf16_t* rowp = Z + (size_t)row * INW + col0;
                float* ko = nullptr; float* vo = nullptr;
                if (u.pn == 2) {
                    if (row < NPROMPT) { const int t = row & 4095; if (t >= 3968) { const size_t o = ((size_t)(l * 8 + (row >> 12)) * 128 + (t - 3968)) * 128 + wc * 32 + 8 * fq; ko = out + OKP + o; vo = out + OVP + o; } }
                    else { const int rr = row - NPROMPT; const size_t o = ((size_t)(l * 8 + (rr >> 6)) * 128 + 64 + (rr & 63)) * 128 + wc * 32 + 8 * fq; ko = out + OKS + o; vo = out + OVS + o; }
                }
#pragma unroll
                for (int bj = 0; bj < 2; ++bj) {
                    const f32x4 v0 = acc[ai][bj][m][0] + bv[bj][0], v1 = acc[ai][bj][m][1] + bv[bj][1];
                    if (u.pn >= 9) { u32x2 w8; w8.x = pk4_fp8(v0[0], v0[1], v0[2], v0[3]); w8.y = pk4_fp8(v1[0], v1[1], v1[2], v1[3]);
                        unsigned char* pz = ZG + (size_t)row * 2048 + (col0 - 2304) + bj * 128;
                        if ((m & 1) == 0) wprev[bj] = w8; else store_pair16(pz - (size_t)16 * 2048, pz, fq, wprev[bj], w8); }
                    else { u32x4 w; w.x = cvt_pk_bf16(v0[0], v0[1]); w.y = cvt_pk_bf16(v0[2], v0[3]); w.z = cvt_pk_bf16(v1[0], v1[1]); w.w = cvt_pk_bf16(v1[2], v1[3]);
                        *(u32x4*)(rowp + bj * 128) = w; }
                    float* o = bj == 0 ? ko : vo;
                    if (o) { *(f32x4*)o = v0; *(f32x4*)(o + 4) = v1; }
                }
                asm volatile("" ::: "memory");
            }
    }
};
struct EpiT1 {
    static constexpr bool PERM = true, BIAS = false, EXTRA = false;
    __device__ __forceinline__ const float* extra_ptr(const Unit&, int) const { return nullptr; }
    __device__ __forceinline__ const float* bias_ptr(const Unit&, int) const { return nullptr; }
    unsigned char* T1; const unsigned char* ZG;
    __device__ __forceinline__ void operator()(const Acc& acc, const Unit& u, int wr, int wc, int fr, int fq, const LAS float* lb) const {
        const int row0 = u.pm * 256 + wr * 64 + fr, col0 = u.pn * 256 + wc * 32 + 8 * fq;
        u32x2 g[2][4][2];
#pragma unroll
        for (int ai = 0; ai < 2; ++ai)
#pragma unroll
            for (int m = 0; m < 4; m += 2)
#pragma unroll
                for (int bj = 0; bj < 2; ++bj) { const unsigned char* pa = ZG + (size_t)(row0 + ai * 128 + m * 16) * 2048 + col0 + bj * 128;
                    load_pair16(pa, pa + (size_t)16 * 2048, fq, g[ai][m][bj], g[ai][m + 1][bj]); }
        asm volatile("" ::: "memory");
        u32x2 wprev[2];
#pragma unroll
        for (int ai = 0; ai < 2; ++ai)
#pragma unroll
            for (int m = 0; m < 4; ++m) {
                const int row = row0 + ai * 128 + m * 16;
#pragma unroll
                for (int bj = 0; bj < 2; ++bj) {
                    float gg[8]; unpk8_fp8(g[ai][m][bj], gg);
                    f32x4 v0 = acc[ai][bj][m][0] * 16.0f, v1 = acc[ai][bj][m][1] * 16.0f;
#pragma unroll
                    for (int j = 0; j < 4; ++j) { v0[j] *= sigmoidf_(gg[j]); v1[j] *= sigmoidf_(gg[4 + j]); }
                    u32x2 w; w.x = pk4_fp8(v0[0], v0[1], v0[2], v0[3]); w.y = pk4_fp8(v1[0], v1[1], v1[2], v1[3]);
                    if ((m & 1) == 0) wprev[bj] = w;
                    else store_pair16(T1 + (size_t)(row - 16) * D + col0 + bj * 128, T1 + (size_t)row * D + col0 + bj * 128, fq, wprev[bj], w);
                }
            }
    }
};
struct EpiMix {
    static constexpr bool PERM = true, BIAS = false, EXTRA = false;
    __device__ __forceinline__ const float* extra_ptr(const Unit&, int) const { return nullptr; }
    __device__ __forceinline__ const float* bias_ptr(const Unit&, int) const { return nullptr; }
    const unsigned char* T1; const unsigned char* ZG; unsigned char* MIX;
    __device__ __forceinline__ void operator()(const Acc& acc, const Unit& u, int wr, int wc, int fr, int fq, const LAS float* lb) const {
        const int row0 = u.pm * 256 + wr * 64 + fr, col0 = u.pn * 256 + wc * 32 + 8 * fq;
        u32x2 g[2][4][2], t[2][4][2];
#pragma unroll
        for (int ai = 0; ai < 2; ++ai)
#pragma unroll
            for (int m = 0; m < 4; ++m)
#pragma unroll
                for (int bj = 0; bj < 2; ++bj) { if (m & 1) continue; const int row = row0 + ai * 128 + m * 16;
                    const unsigned char* pg = ZG + (size_t)row * 2048 + 1024 + col0 + bj * 128; const unsigned char* pt = T1 + (size_t)row * D + col0 + bj * 128;
                    load_pair16(pg, pg + (size_t)16 * 2048, fq, g[ai][m][bj], g[ai][m | 1][bj]);
                    load_pair16(pt, pt + (size_t)16 * D, fq, t[ai][m][bj], t[ai][m | 1][bj]); }
        asm volatile("" ::: "memory");
        u32x2 wprev[2];
#pragma unroll
        for (int ai = 0; ai < 2; ++ai)
#pragma unroll
            for (int m = 0; m < 4; ++m) {
                const int row = row0 + ai * 128 + m * 16;
#pragma unroll
                for (int bj = 0; bj < 2; ++bj) {
                    float gg[8], tt[8]; unpk8_fp8(g[ai][m][bj], gg); unpk8_fp8(t[ai][m][bj], tt);
                    const f32x4 a0 = acc[ai][bj][m][0], a1 = acc[ai][bj][m][1];
                    float v[8];
#pragma unroll
                    for (int j = 0; j < 4; ++j) { v[j] = tt[j] * 0.0625f + a0[j] * sigmoidf_(gg[j]); v[4 + j] = tt[4 + j] * 0.0625f + a1[j] * sigmoidf_(gg[4 + j]); }
                    u32x2 w; w.x = pk4_fp8(v[0], v[1], v[2], v[3]); w.y = pk4_fp8(v[4], v[5], v[6], v[7]);
                    if ((m & 1) == 0) wprev[bj] = w;
                    else store_pair16(MIX + (size_t)(row - 16) * D + col0 + bj * 128, MIX + (size_t)row * D + col0 + bj * 128, fq, wprev[bj], w);
                }
            }
    }
};
struct EpiX {
    static constexpr bool PERM = true, BIAS = false, EXTRA = false;
    __device__ __forceinline__ const float* extra_ptr(const Unit&, int) const { return nullptr; }
    __device__ __forceinline__ const float* bias_ptr(const Unit&, int) const { return nullptr; }
    const bf16_t* X; bf16_t* V; const float* modl;
    __device__ __forceinline__ void operator()(const Acc& acc, const Unit& u, int wr, int wc, int fr, int fq, const LAS float* lb) const {
        const int row0 = u.pm * 256 + wr * 64 + fr, col0 = u.pn * 256 + wc * 32 + 8 * fq;
        const bool uni = u.pm < 128;
        f32x4 g[2][2];
        if (uni) { const float* gp = modl + (size_t)(u.pm >> 4) * 6144 + 2048 + col0;
#pragma unroll
            for (int bj = 0; bj < 2; ++bj)
#pragma unroll
                for (int n = 0; n < 2; ++n) g[bj][n] = *(const f32x4*)(gp + bj * 128 + 4 * n) + 1.0f; }
#pragma unroll
        for (int ai = 0; ai < 2; ++ai) {
            u32x4 x[4][2];
#pragma unroll
            for (int m = 0; m < 4; ++m)
#pragma unroll
                for (int bj = 0; bj < 2; ++bj) x[m][bj] = *(const u32x4*)(X + (size_t)(row0 + ai * 128 + m * 16) * D + col0 + bj * 128);
            asm volatile("" ::: "memory");
#pragma unroll
            for (int m = 0; m < 4; ++m) {
                const int row = row0 + ai * 128 + m * 16;
                if (!uni) { const float* gp = modl + (size_t)batch_of(row) * 6144 + 2048 + col0;
#pragma unroll
                    for (int bj = 0; bj < 2; ++bj)
#pragma unroll
                        for (int n = 0; n < 2; ++n) g[bj][n] = *(const f32x4*)(gp + bj * 128 + 4 * n) + 1.0f; }
#pragma unroll
                for (int bj = 0; bj < 2; ++bj) {
                    const u32x4 xx = x[m][bj];
                    const f32x4 x0 = (f32x4){bf_lo(xx.x), bf_hi(xx.x), bf_lo(xx.y), bf_hi(xx.y)}, x1 = (f32x4){bf_lo(xx.z), bf_hi(xx.z), bf_lo(xx.w), bf_hi(xx.w)};
                    const f32x4 v0 = x0 * ALPHA + g[bj][0] * acc[ai][bj][m][0], v1 = x1 * ALPHA + g[bj][1] * acc[ai][bj][m][1];
                    u32x4 w; w.x = cvt_pk_bf16(v0[0], v0[1]); w.y = cvt_pk_bf16(v0[2], v0[3]); w.z = cvt_pk_bf16(v1[0], v1[1]); w.w = cvt_pk_bf16(v1[2], v1[3]);
                    *(u32x4*)(V + (size_t)row * D + col0 + bj * 128) = w;
                }
            }
            asm volatile("" ::: "memory");
        }
    }
};
struct EpiAct {
    static constexpr bool PERM = true, BIAS = true, EXTRA = false;
    __device__ __forceinline__ const float* extra_ptr(const Unit&, int) const { return nullptr; }
    __device__ __forceinline__ const float* bias_ptr(const Unit& u, int t) const { return bgu + (size_t)u.e * 2048 + u.pn * 128 + (t < 32 ? 4 * t : 1024 + 4 * (t - 32)); }
    unsigned char* ACT; const float* bgu;
    __device__ __forceinline__ void operator()(const Acc& acc, const Unit& u, int wr, int wc, int fr, int fq, const LAS float* lb) const {
        const int row0 = u.pm * 256 + wr * 64 + fr, c0 = u.pn * 128 + wc * 32 + 8 * fq;
        u32x2 wprev;
        f32x4 bg[2], bl[2];
#pragma unroll
        for (int n = 0; n < 2; ++n) { bg[n] = *(const LAS f32x4*)(lb + wc * 32 + 8 * fq + 4 * n); bl[n] = *(const LAS f32x4*)(lb + 128 + wc * 32 + 8 * fq + 4 * n); }
#pragma unroll
        for (int ai = 0; ai < 2; ++ai)
#pragma unroll
            for (int m = 0; m < 4; ++m) {
                const int row = row0 + ai * 128 + m * 16;
                float a[8];
#pragma unroll
                for (int n = 0; n < 2; ++n)
#pragma unroll
                    for (int jp = 0; jp < 2; ++jp) {
                        f32x2 g = (f32x2){acc[ai][0][m][n][2 * jp], acc[ai][0][m][n][2 * jp + 1]} + (f32x2){bg[n][2 * jp], bg[n][2 * jp + 1]};
                        f32x2 li = (f32x2){acc[ai][1][m][n][2 * jp], acc[ai][1][m][n][2 * jp + 1]} + (f32x2){bl[n][2 * jp], bl[n][2 * jp + 1]};
                        g = __builtin_elementwise_min(g, (f32x2){7.0f, 7.0f});
                        li = __builtin_elementwise_min(__builtin_elementwise_max(li, (f32x2){-7.0f, -7.0f}), (f32x2){7.0f, 7.0f});
                        const f32x2 t = g * (-1.702f * 1.44269504089f);
                        f32x2 e; e.x = __builtin_amdgcn_exp2f(t.x); e.y = __builtin_amdgcn_exp2f(t.y);
                        const f32x2 dd = e + 1.0f;
                        f32x2 r; r.x = __builtin_amdgcn_rcpf(dd.x); r.y = __builtin_amdgcn_rcpf(dd.y);
                        const f32x2 av = (g * r) * (li + 1.0f);
                        a[n * 4 + 2 * jp] = av.x; a[n * 4 + 2 * jp + 1] = av.y;
                    }
                u32x2 w; w.x = pk4_fp8(a[0], a[1], a[2], a[3]); w.y = pk4_fp8(a[4], a[5], a[6], a[7]);
                if ((m & 1) == 0) wprev = w;
                else store_pair16(ACT + (size_t)(row - 16) * D + c0, ACT + (size_t)row * D + c0, fq, wprev, w);
                asm volatile("" ::: "memory");
            }
    }
};
struct EpiYs {
    static constexpr bool PERM = true, BIAS = true, EXTRA = true;
    __device__ __forceinline__ const float* extra_ptr(const Unit& u, int t) const { return gate + (size_t)u.e * NT + (u.pm - blk[u.e]) * 256 + 4 * t; }
    __device__ __forceinline__ const float* bias_ptr(const Unit& u, int t) const { return bdn + (size_t)u.e * D + u.pn * 256 + 4 * t; }
    unsigned char* YS; const float* bdn; const float* gate; const LAS int* cnt; const LAS int* blk;
    __device__ __forceinline__ void operator()(const Acc& acc, const Unit& u, int wr, int wc, int fr, int fq, const LAS float* lb) const {
        const int r0 = wr * 64 + fr, col0 = u.pn * 256 + wc * 32 + 8 * fq;
        const int rank0 = (u.pm - blk[u.e]) * 256; const int ce = cnt[u.e];
        f32x4 bv[2][2];
#pragma unroll
        for (int bj = 0; bj < 2; ++bj)
#pragma unroll
            for (int n = 0; n < 2; ++n) bv[bj][n] = *(const LAS f32x4*)(lb + bj * 128 + wc * 32 + 8 * fq + 4 * n);
        float gts[2][4];
#pragma unroll
        for (int ai = 0; ai < 2; ++ai)
#pragma unroll
            for (int m = 0; m < 4; ++m) { const int rank = rank0 + r0 + ai * 128 + m * 16; const float gv = lb[256 + r0 + ai * 128 + m * 16]; gts[ai][m] = rank < ce ? 16.0f * gv : 0.0f; }
        asm volatile("" ::: "memory");
        u32x2 wprev[2];
#pragma unroll
        for (int ai = 0; ai < 2; ++ai)
#pragma unroll
            for (int m = 0; m < 4; ++m) {
                const int r = r0 + ai * 128 + m * 16;
                const float gt = gts[ai][m];
                unsigned char* rowp = YS + (size_t)(u.pm * 256 + r) * D + col0;
#pragma unroll
                for (int bj = 0; bj < 2; ++bj) {
                    const f32x4 v0 = (acc[ai][bj][m][0] + bv[bj][0]) * gt, v1 = (acc[ai][bj][m][1] + bv[bj][1]) * gt;
                    u32x2 w; w.x = pk4_fp8(v0[0], v0[1], v0[2], v0[3]); w.y = pk4_fp8(v1[0], v1[1], v1[2], v1[3]);
                    if ((m & 1) == 0) wprev[bj] = w;
                    else store_pair16(rowp - (size_t)16 * D + bj * 128, rowp + bj * 128, fq, wprev[bj], w);
                }
                asm volatile("" ::: "memory");
            }
    }
};
}


#define XB_TMO      128
#define XB_XCNT(j)  (256  + 64 * (j))
#define XB_XSUB(j)  (1280 + 64 * (j))
#define XB_XGEN(j)  (2304 + 64 * (j))
#define XB_TOP      3328
#define XB_TOPGEN   3392
#define XCD_BAR_WORDS 3456
#define XB_SPIN_CAP (1u << 21)
__device__ __forceinline__ unsigned xb_ld(unsigned* p)              { return __hip_atomic_load(p, __ATOMIC_RELAXED, __HIP_MEMORY_SCOPE_AGENT); }
__device__ __forceinline__ unsigned xb_add(unsigned* p, unsigned v) { return __hip_atomic_fetch_add(p, v, __ATOMIC_RELAXED, __HIP_MEMORY_SCOPE_AGENT); }
__device__ __forceinline__ unsigned xb_xcc_id() { return (unsigned)__builtin_amdgcn_s_getreg((3 << 11) | 20) & 0xFu; }
#define XB_SPIN(cond, bar) do { unsigned _sp = 0; while (cond) { __builtin_amdgcn_s_sleep(1); \
    if ((++_sp & 255u) == 0u) { if (xb_ld(&(bar)[XB_TMO])) break; if (_sp > XB_SPIN_CAP) { atomicAdd(&(bar)[XB_TMO], 1u); break; } } } } while (0)
struct XcdBarrier { unsigned* bar; unsigned x; volatile LAS unsigned* st; };
__device__ __forceinline__ XcdBarrier xcd_barrier_post(unsigned* bar, volatile LAS unsigned* st) {
    XcdBarrier b; b.bar = bar; b.x = xb_xcc_id(); b.st = st;
    if (threadIdx.x == 0) (void)xb_add(&bar[XB_XCNT(b.x)], 1u);
    return b;
}
__device__ __forceinline__ void xcd_barrier_complete(unsigned* bar, unsigned x, unsigned& nloc, unsigned& nx) {
    const unsigned G = gridDim.x * gridDim.y * gridDim.z;
    unsigned sum, cnt, mine, sp = 0u;
    for (;;) {
        sum = 0u; cnt = 0u; mine = 0u;
#pragma unroll
        for (unsigned j = 0; j < 16; ++j) { const unsigned c = xb_ld(&bar[XB_XCNT(j)]); sum += c; cnt += (c > 0u) ? 1u : 0u; mine = (j == x) ? c : mine; }
        if (sum == G) break;
        __builtin_amdgcn_s_sleep(1);
        if ((++sp & 255u) == 0u) { if (xb_ld(&bar[XB_TMO])) break; if (sp > XB_SPIN_CAP) { atomicAdd(&bar[XB_TMO], 1u); break; } }
    }
    nloc = mine > 0u ? mine : 1u; nx = cnt > 0u ? cnt : 1u;
}
__device__ __forceinline__ void xcd_barrier(const XcdBarrier& b) {
    asm volatile("s_waitcnt vmcnt(0)" ::: "memory");
    __syncthreads();
    if (threadIdx.x == 0) {
        unsigned* bar = b.bar;
        __builtin_amdgcn_s_waitcnt(0);
        unsigned nloc = b.st[0], nx = b.st[1];
        if (nloc == 0u) { xcd_barrier_complete(bar, b.x, nloc, nx); b.st[0] = nloc; b.st[1] = nx; }
        const unsigned old = xb_add(&bar[XB_XSUB(b.x)], 1u);
        const unsigned gen = old / nloc;
        if (old + 1u == (gen + 1u) * nloc) {
            __builtin_amdgcn_fence(__ATOMIC_RELEASE, "agent");
            asm volatile("s_waitcnt vmcnt(0)" ::: "memory");
            const unsigned og = xb_add(&bar[XB_TOP], 1u);
            const unsigned tg = og / nx;
            if (og + 1u == (tg + 1u) * nx) xb_add(&bar[XB_TOPGEN], 1u);
            else XB_SPIN(xb_ld(&bar[XB_TOPGEN]) == tg, bar);
            __builtin_amdgcn_fence(__ATOMIC_ACQUIRE, "agent");
            xb_add(&bar[XB_XGEN(b.x)], 1u);
            asm volatile("s_waitcnt vmcnt(0)" ::: "memory");
        } else {
            XB_SPIN(xb_ld(&bar[XB_XGEN(b.x)]) == gen, bar);
            __builtin_amdgcn_fence(__ATOMIC_ACQUIRE, "agent");
            asm volatile("s_waitcnt vmcnt(0)" ::: "memory");
        }
    }
    __syncthreads();
}

struct Ctx {
    LAS unsigned char* lds; int tid, lane, wave, G, bx;
    const float* const* in; float* out; unsigned char* ws;
};
#define LDS_WAIT() asm volatile("s_waitcnt lgkmcnt(0)" ::: "memory")

struct TDesc { const float* src; unsigned char* dst; int N, K, k0, n0, kind, f8; };
__device__ __forceinline__ void t64_load(const TDesc& d, float (&v)[64], int lane) {
    const float* src = d.src + (size_t)d.k0 * d.N + d.n0 + lane;
#pragma unroll
    for (int kk = 0; kk < 64; ++kk) v[kk] = src[(size_t)kk * d.N];
}
__device__ __forceinline__ void t64_finish(const TDesc& d, const float (&v)[64], LAS unsigned char* scr, int lane) {
    if (d.f8) {
        LAS unsigned char* wp = scr + lane * 80;
#pragma unroll
        for (int q = 0; q < 4; ++q) { u32x4 o;
            o.x = pk4_fp8(64.f * v[16 * q + 0], 64.f * v[16 * q + 1], 64.f * v[16 * q + 2], 64.f * v[16 * q + 3]);
            o.y = pk4_fp8(64.f * v[16 * q + 4], 64.f * v[16 * q + 5], 64.f * v[16 * q + 6], 64.f * v[16 * q + 7]);
            o.z = pk4_fp8(64.f * v[16 * q + 8], 64.f * v[16 * q + 9], 64.f * v[16 * q + 10], 64.f * v[16 * q + 11]);
            o.w = pk4_fp8(64.f * v[16 * q + 12], 64.f * v[16 * q + 13], 64.f * v[16 * q + 14], 64.f * v[16 * q + 15]);
            *(LAS u32x4*)(wp + q * 16) = o; }
        LDS_WAIT(); asm volatile("" ::: "memory");
        const int c = lane & 3;
#pragma unroll
        for (int j = 0; j < 4; ++j) { const int nl = (lane >> 2) + 16 * j; const u32x4 o = *(const LAS u32x4*)(scr + nl * 80 + c * 16);
            const int n = d.n0 + nl; int dr = n;
            if (d.kind == 1) { dr = (n < 1024) ? ((n >> 7) * 256 + (n & 127)) : (((n - 1024) >> 7) * 256 + 128 + (n & 127)); }
            *(u32x4*)(d.dst + (size_t)dr * d.K + d.k0 + c * 16) = o; }
    } else {
        LAS unsigned char* wp = scr + lane * 144;
#pragma unroll
        for (int q = 0; q < 8; ++q) { u32x4 o;
            o.x = cvt_pk_bf16(v[8 * q + 0], v[8 * q + 1]); o.y = cvt_pk_bf16(v[8 * q + 2], v[8 * q + 3]); o.z = cvt_pk_bf16(v[8 * q + 4], v[8 * q + 5]); o.w = cvt_pk_bf16(v[8 * q + 6], v[8 * q + 7]);
            *(LAS u32x4*)(wp + q * 16) = o; }
        LDS_WAIT(); asm volatile("" ::: "memory");
        const int c = lane & 7;
#pragma unroll
        for (int j = 0; j < 8; ++j) { const int nl = (lane >> 3) + 8 * j; const u32x4 o = *(const LAS u32x4*)(scr + nl * 144 + c * 16);
            *(u32x4*)(d.dst + ((size_t)(d.n0 + nl) * d.K + d.k0) * 2 + c * 16) = o; }
    }
    LDS_WAIT(); asm volatile("" ::: "memory");
}
__device__ __forceinline__ TDesc t64_decode(const float* const* in, unsigned char* ws, int it) {
    TDesc d; int r = it, item, nblk;
    if (r < 32768) { const int m = r >> 9; item = r & 511; d.src = in[23] + (size_t)m * 1024 * 2048; d.dst = ws + WS_WGU + (size_t)m * 2048 * 1024; d.N = 2048; d.K = 1024; d.kind = 1; d.f8 = 1; }
    else if ((r -= 32768) < 16384) { const int m = r >> 8; item = r & 255; d.src = in[25] + (size_t)m * 1024 * 1024; d.dst = ws + WS_WDN + (size_t)m * 1024 * 1024; d.N = 1024; d.K = 1024; d.kind = 0; d.f8 = 1; }
    else if ((r -= 16384) < 2176) { const int m = r / 1088; item = r % 1088; d.src = in[12] + (size_t)m * 1024 * INW; d.dst = ws + WS_WIN + (size_t)m * INW * 1024 * 2; d.N = INW; d.K = 1024; d.kind = 0; d.f8 = 0; }
    else if ((r -= 2176) < 2176) { const int m = r / 1088; item = r % 1088; d.src = in[12] + (size_t)m * 1024 * INW; d.dst = ws + WS_WIN8 + (size_t)m * INW * 1024; d.N = INW; d.K = 1024; d.kind = 0; d.f8 = 1; }
    else if ((r -= 2176) < 512) { const int m = r >> 8; item = r & 255; d.src = in[18] + (size_t)m * 1024 * 1024; d.dst = ws + WS_WO + (size_t)m * 1024 * 1024; d.N = 1024; d.K = 1024; d.kind = 0; d.f8 = 1; }
    else if ((r -= 512) < 256) { const int m = r >> 7; item = r & 127; d.src = in[16] + (size_t)m * 512 * 1024; d.dst = ws + WS_WOA + (size_t)m * 1024 * 512; d.N = 1024; d.K = 512; d.kind = 0; d.f8 = 1; }
    else { r -= 256; const int m = r >> 7; item = r & 127; d.src = in[17] + (size_t)m * 512 * 1024; d.dst = ws + WS_WOB + (size_t)m * 1024 * 512; d.N = 1024; d.K = 512; d.kind = 0; d.f8 = 1; }
    nblk = d.N >> 6; const int kb = item / nblk; d.k0 = kb * 64; d.n0 = (item - kb * nblk) * 64;
    return d;
}

__device__ __forceinline__ int rel_bucket(int rel) {
    const int n = rel < 0 ? -rel : rel;
    int v;
    if (n < 8) v = n;
    else { const float nf = (float)n; int large = 8 + (int)(logf(nf / 8.0f) / 2.7725887298583984f * 8.0f); v = large < 15 ? large : 15; }
    return (rel > 0 ? 16 : 0) + v;
}

__device__ __forceinline__ void phase0a(Ctx& F) {
    LAS float* scr = (LAS float*)(F.lds + F.wave * 16384);
    const int gw = F.bx * NWAVES + F.wave, NGW = F.G * NWAVES;
    unsigned char* ws = F.ws;
    {
        float* modp = (float*)(ws + WS_MODP);
        for (int it = gw; it < 2 * 96 * 8; it += NGW) {
            const int kc = it & 7, cgp = (it >> 3) % 96, l = it / (8 * 96), k0 = kc * 128, n0 = cgp * 64;
#pragma unroll 4
            for (int j = 0; j < 32; ++j) { const int idx = F.lane + 64 * j, r = idx >> 7, kk = idx & 127;
                const float c = r < 8 ? F.in[2][r * 1024 + k0 + kk] : F.in[3][(r - 8) * 1024 + k0 + kk];
                scr[kk * 16 + r] = c * sigmoidf_(c); }
            LDS_WAIT(); asm volatile("" ::: "memory");
            float a[16];
#pragma unroll
            for (int r = 0; r < 16; ++r) a[r] = 0.f;
            const float* wp = F.in[10] + ((size_t)l * 1024 + k0) * 6144 + n0 + F.lane;
#pragma unroll 16
            for (int kk = 0; kk < 128; ++kk) {
                const float w = wp[(size_t)kk * 6144];
                const LAS f32x4* sp = (const LAS f32x4*)(scr + kk * 16);
                const f32x4 s0 = sp[0], s1 = sp[1], s2 = sp[2], s3 = sp[3];
                a[0] += s0[0] * w; a[1] += s0[1] * w; a[2] += s0[2] * w; a[3] += s0[3] * w;
                a[4] += s1[0] * w; a[5] += s1[1] * w; a[6] += s1[2] * w; a[7] += s1[3] * w;
                a[8] += s2[0] * w; a[9] += s2[1] * w; a[10] += s2[2] * w; a[11] += s2[3] * w;
                a[12] += s3[0] * w; a[13] += s3[1] * w; a[14] += s3[2] * w; a[15] += s3[3] * w;
            }
            const float bb = (kc == 0) ? F.in[11][l * 6144 + n0 + F.lane] : 0.f;
#pragma unroll
            for (int r = 0; r < 16; ++r) modp[(size_t)kc * (2 * 16 * 6144) + ((size_t)(l * 16 + r)) * 6144 + n0 + F.lane] = a[r] + bb;
            LDS_WAIT(); asm volatile("" ::: "memory");
        }
    }
    if (F.bx == 0) {
        float* bt = (float*)(ws + WS_BIAS);
        for (int i = F.tid; i < 8 * 256; i += NTHREADS) { const int h = i >> 8, ri = i & 255; const int rel = ri - 191;
            bt[i] = (ri < 255) ? F.in[7][rel_bucket(rel) * 8 + h] : 0.f; }
    }
    for (int i = F.bx * NTHREADS + F.tid; i < 2 * 8 * 64 * 128; i += F.G * NTHREADS) {
        const int lb = i >> 13, rem = i & 8191;
        F.out[OKS + (size_t)lb * 16384 + rem] = F.in[4][(size_t)lb * 16384 + 8192 + rem];
        F.out[OVS + (size_t)lb * 16384 + rem] = F.in[5][(size_t)lb * 16384 + 8192 + rem];
    }
    LAS unsigned char* scrb = F.lds + F.wave * 16384;
    constexpr int NITEMS = 32768 + 16384 + 2176 + 2176 + 512 + 256 + 256;
    {
        float va[64], vb[64]; TDesc da, db;
        int it = gw;
        if (it < NITEMS) { da = t64_decode(F.in, ws, it); t64_load(da, va, F.lane); }
        while (it < NITEMS) {
            int itn = it + NGW;
            if (itn < NITEMS) { db = t64_decode(F.in, ws, itn); t64_load(db, vb, F.lane); }
            t64_finish(da, va, scrb, F.lane);
            it = itn; if (it >= NITEMS) break;
            itn = it + NGW;
            if (itn < NITEMS) { da = t64_decode(F.in, ws, itn); t64_load(da, va, F.lane); }
            t64_finish(db, vb, scrb, F.lane);
            it = itn;
        }
    }
}

__device__ __forceinline__ void ln_row(f32x4 (&v)[4], const float* g, const float* b, int lane) {
    float s = 0.f;
#pragma unroll
    for (int j = 0; j < 4; ++j) s += (v[j][0] + v[j][1]) + (v[j][2] + v[j][3]);
    const float mean = wave_sum(s) * (1.0f / D); float s2 = 0.f;
#pragma unroll
    for (int j = 0; j < 4; ++j) { v[j] = v[j] - mean; s2 += (v[j][0] * v[j][0] + v[j][1] * v[j][1]) + (v[j][2] * v[j][2] + v[j][3] * v[j][3]); }
    const float rstd = 1.0f / sqrtf(wave_sum(s2) * (1.0f / D) + LN_EPS);
#pragma unroll
    for (int j = 0; j < 4; ++j) { const f32x4 gg = *(const f32x4*)(g + 4 * lane + 256 * j), bb = *(const f32x4*)(b + 4 * lane + 256 * j); v[j] = v[j] * rstd * gg + bb; }
}
__device__ __forceinline__ void store_mod_row(const f32x4 (&v)[4], const float* sh, const float* sc, bf16_t* hrow, unsigned char* h8row, int lane) {
#pragma unroll
    for (int j = 0; j < 4; ++j) { const f32x4 a = *(const f32x4*)(sc + 4 * lane + 256 * j), b = *(const f32x4*)(sh + 4 * lane + 256 * j);
        const f32x4 h = v[j] * (a + 1.0f) + b; u32x2 w; w.x = cvt_pk_bf16(h[0], h[1]); w.y = cvt_pk_bf16(h[2], h[3]);
        *(u32x2*)(hrow + 4 * lane + 256 * j) = w;
        *(unsigned*)(h8row + 4 * lane + 256 * j) = pk4_fp8(h[0], h[1], h[2], h[3]); }
}

__device__ __forceinline__ void phase0b(Ctx& F) {
    const int gw = F.bx * NWAVES + F.wave, NGW = F.G * NWAVES;
    const float* mod = (const float*)(F.ws + WS_MOD);
    bf16_t* H = (bf16_t*)(F.ws + WS_H);
    for (int row = gw; row < NT; row += NGW) {
        const float* xr = row < NPROMPT ? F.in[0] + (size_t)row * D : F.in[1] + (size_t)(row - NPROMPT) * D;
        f32x4 v[4];
#pragma unroll
        for (int j = 0; j < 4; ++j) v[j] = *(const f32x4*)(xr + 4 * F.lane + 256 * j);
        ln_row(v, F.in[8], F.in[9], F.lane);
#pragma unroll
        for (int j = 0; j < 4; ++j) { u32x2 w; w.x = cvt_pk_bf16(v[j][0], v[j][1]); w.y = cvt_pk_bf16(v[j][2], v[j][3]); *(u32x2*)((bf16_t*)(F.ws + WS_XB) + (size_t)row * D + 4 * F.lane + 256 * j) = w; }
        const float* mb = mod + (size_t)batch_of(row) * 6144;
        store_mod_row(v, mb, mb + 1024, H + (size_t)row * D, F.ws + WS_H8 + (size_t)row * D, F.lane);
    }
}

__device__ __forceinline__ void phase_attn(Ctx& F, int l) {
    const bf16_t* Z = (const bf16_t*)(F.ws + WS_Z);
    unsigned char* YA = F.ws + WS_YA;
    unsigned char* YB = F.ws + WS_YB;
    const float* biasr = (const float*)(F.ws + WS_BIAS);
    LAS unsigned char* Ks = F.lds;
    LAS unsigned char* Vt = F.lds + 27648;
    LAS float* bt = (LAS float*)(F.lds + 53248);
    const int lane = F.lane, tid = F.tid;
    int bt_kv = -1;
    for (int au = F.bx; au < 1040; au += F.G) {
        const bool isS = au >= 1024;
        const int kv = au & 1;
        const int b = isS ? ((au - 1024) >> 1) : (au >> 7);
        const int n = isS ? 0 : ((au & 127) >> 1);
        __syncthreads();
        if (kv != bt_kv) { for (int i = tid; i < 1024; i += NTHREADS) bt[i] = biasr[(kv * 4 + (i >> 8)) * 256 + (i & 255)]; bt_kv = kv; }
#pragma unroll
        for (int jj = 0; jj < 3; ++jj) {
            const int p = tid + NTHREADS * jj, key = p >> 3, ds = p & 7;
            u32x4 kq = (u32x4){0u, 0u, 0u, 0u}, vq = (u32x4){0u, 0u, 0u, 0u};
            if (!isS) {
                const int t = n * 64 + key - 128;
                if (t >= 0) { const bf16_t* zr = Z + (size_t)(b * 4096 + t) * INW + kv * 64 + ds * 8; kq = *(const u32x4*)(zr + 512); vq = *(const u32x4*)(zr + 640); }
            } else if (key < 128) {
                const size_t o = ((size_t)((l * 8 + b) * 128 + key) * 2 + kv) * 64 + ds * 8;
                const f32x4 k0 = *(const f32x4*)(F.in[4] + o), k1 = *(const f32x4*)(F.in[4] + o + 4), v0 = *(const f32x4*)(F.in[5] + o), v1 = *(const f32x4*)(F.in[5] + o + 4);
                kq.x = cvt_pk_bf16(k0[0], k0[1]); kq.y = cvt_pk_bf16(k0[2], k0[3]); kq.z = cvt_pk_bf16(k1[0], k1[1]); kq.w = cvt_pk_bf16(k1[2], k1[3]);
                vq.x = cvt_pk_bf16(v0[0], v0[1]); vq.y = cvt_pk_bf16(v0[2], v0[3]); vq.z = cvt_pk_bf16(v1[0], v1[1]); vq.w = cvt_pk_bf16(v1[2], v1[3]);
            } else {
                const bf16_t* zr = Z + (size_t)(NPROMPT + b * 64 + key - 128) * INW + kv * 64 + ds * 8; kq = *(const u32x4*)(zr + 512); vq = *(const u32x4*)(zr + 640);
            }
            *(LAS u32x4*)(Ks + key * 144 + ds * 16) = kq;
            LAS unsigned short* vp = (LAS unsigned short*)Vt + (ds * 8) * 200 + key;
            vp[0 * 200] = (unsigned short)(vq.x & 0xffffu); vp[1 * 200] = (unsigned short)(vq.x >> 16);
            vp[2 * 200] = (unsigned short)(vq.y & 0xffffu); vp[3 * 200] = (unsigned short)(vq.y >> 16);
            vp[4 * 200] = (unsigned short)(vq.z & 0xffffu); vp[5 * 200] = (unsigned short)(vq.z >> 16);
            vp[6 * 200] = (unsigned short)(vq.w & 0xffffu); vp[7 * 200] = (unsigned short)(vq.w >> 16);
        }
        __syncthreads();
        const int g = F.wave >> 1, qi = (F.wave & 1) * 32 + (lane & 31), hh = lane >> 5, head = kv * 4 + g;
        const int qrow = isS ? NPROMPT + b * 64 + qi : b * 4096 + n * 64 + qi;
        bf16x8 Qf[4];
#pragma unroll
        for (int ks = 0; ks < 4; ++ks) Qf[ks] = *(const bf16x8*)(Z + (size_t)qrow * INW + head * 64 + ks * 16 + hh * 8);
        f32x16 S[6];
#pragma unroll
        for (int kb = 0; kb < 6; ++kb) {
#pragma unroll
            for (int j = 0; j < 16; ++j) S[kb][j] = 0.f;
#pragma unroll
            for (int ks = 0; ks < 4; ++ks) {
                const bf16x8 A = *(const LAS bf16x8*)(Ks + (kb * 32 + (lane & 31)) * 144 + (ks * 16 + hh * 8) * 2);
                S[kb] = __builtin_amdgcn_mfma_f32_32x32x16_bf16(A, Qf[ks], S[kb], 0, 0, 0);
            }
        }
        const float sinkv = F.in[14][l * 8 + head];
        float mx = sinkv;
        const int kmin = isS ? 0 : (128 - n * 64);
#pragma unroll
        for (int kb = 0; kb < 6; ++kb)
#pragma unroll
            for (int j = 0; j < 16; ++j) {
                const int key = kb * 32 + 8 * (j >> 2) + 4 * hh + (j & 3);
                float sv = S[kb][j] * 0.125f + bt[g * 256 + key - qi + 63];
                sv = key >= kmin ? sv : -1e30f;
                S[kb][j] = sv; mx = fmaxf(mx, sv);
            }
        mx = fmaxf(mx, __shfl_xor(mx, 32));
        float sum = 0.f;
#pragma unroll
        for (int kb = 0; kb < 6; ++kb)
#pragma unroll
            for (int j = 0; j < 16; ++j) { const float p = __expf(S[kb][j] - mx); S[kb][j] = p; sum += p; }
        sum += __shfl_xor(sum, 32);
        sum += __expf(sinkv - mx);
        const float inv = 1.0f / sum;
        f32x16 O[2];
#pragma unroll
        for (int db = 0; db < 2; ++db)
#pragma unroll
            for (int j = 0; j < 16; ++j) O[db][j] = 0.f;
#pragma unroll
        for (int kb = 0; kb < 6; ++kb)
#pragma unroll
            for (int s2 = 0; s2 < 2; ++s2) {
                union { bf16x8 v; unsigned u[4]; } P;
#pragma unroll
                for (int q = 0; q < 4; ++q) P.u[q] = cvt_pk_bf16(S[kb][8 * s2 + 2 * q], S[kb][8 * s2 + 2 * q + 1]);
#pragma unroll
                for (int db = 0; db < 2; ++db) {
                    const LAS unsigned char* vb = Vt + (db * 32 + (lane & 31)) * 400 + (kb * 32 + 16 * s2 + 4 * hh) * 2;
                    union { bf16x8 v; u32x2 h[2]; } Vf;
                    Vf.h[0] = *(const LAS u32x2*)vb; Vf.h[1] = *(const LAS u32x2*)(vb + 16);
                    O[db] = __builtin_amdgcn_mfma_f32_32x32x16_bf16(Vf.v, P.v, O[db], 0, 0, 0);
                }
            }
        unsigned char* orow = YA + (size_t)qrow * 512 + head * 64 + 4 * hh; const float inv8 = inv * 8.0f;
#pragma unroll
        for (int db = 0; db < 2; ++db)
#pragma unroll
            for (int jq = 0; jq < 4; ++jq) {
                *(unsigned*)(orow + db * 32 + 8 * jq) = pk4_fp8(O[db][4 * jq] * inv8, O[db][4 * jq + 1] * inv8, O[db][4 * jq + 2] * inv8, O[db][4 * jq + 3] * inv8);
            }
    }
    int nxtra = 1040 % F.G; if (1040 < F.G || 2 * nxtra > F.G) nxtra = 0;
    if (F.bx < nxtra) return;
    const int gw = (F.bx - nxtra) * NWAVES + F.wave, NGW = (F.G - nxtra) * NWAVES;
    const float* cw = F.in[15] + (size_t)l * 3 * 512 + 8 * lane;
    float w0[8], w1[8], w2[8];
#pragma unroll
    for (int e = 0; e < 8; ++e) { w0[e] = cw[e]; w1[e] = cw[512 + e]; w2[e] = cw[1024 + e]; }
    for (int row = gw; row < NT; row += NGW) {
        const bool isS = row >= NPROMPT; const int b = isS ? ((row - NPROMPT) >> 6) : (row >> 12), t = isS ? ((row - NPROMPT) & 63) : (row & 4095);
        const bf16_t* zr = Z + (size_t)row * INW + 8 * lane;
        const u32x4 cb = *(const u32x4*)(zr + 768);
        float u[3][8];
#pragma unroll
        for (int d = 0; d < 3; ++d) {
            if (t - d >= 0) {
                const bf16_t* zz = zr - (size_t)d * INW; const u32x4 cc = *(const u32x4*)(zz + 1280), cx = *(const u32x4*)(zz + 1792);
                u[d][0] = bf_lo(cc.x) * bf_lo(cx.x); u[d][1] = bf_hi(cc.x) * bf_hi(cx.x); u[d][2] = bf_lo(cc.y) * bf_lo(cx.y); u[d][3] = bf_hi(cc.y) * bf_hi(cx.y);
                u[d][4] = bf_lo(cc.z) * bf_lo(cx.z); u[d][5] = bf_hi(cc.z) * bf_hi(cx.z); u[d][6] = bf_lo(cc.w) * bf_lo(cx.w); u[d][7] = bf_hi(cc.w) * bf_hi(cx.w);
            } else if (isS) {
                const float* hp = F.in[6] + ((size_t)(l * 8 + b) * 2 + (2 + t - d)) * 512 + 8 * lane;
                const f32x4 h0 = *(const f32x4*)hp, h1 = *(const f32x4*)(hp + 4);
#pragma unroll
                for (int e = 0; e < 4; ++e) { u[d][e] = h0[e]; u[d][4 + e] = h1[e]; }
            } else {
#pragma unroll
                for (int e = 0; e < 8; ++e) u[d][e] = 0.f;
            }
        }
        const float cbf[8] = {bf_lo(cb.x), bf_hi(cb.x), bf_lo(cb.y), bf_hi(cb.y), bf_lo(cb.z), bf_hi(cb.z), bf_lo(cb.w), bf_hi(cb.w)};
        float y[8];
#pragma unroll
        for (int e = 0; e < 8; ++e) y[e] = cbf[e] * (w0[e] * u[2][e] + w1[e] * u[1][e] + w2[e] * u[0][e]);
        u32x2 w; w.x = pk4_fp8(y[0], y[1], y[2], y[3]); w.y = pk4_fp8(y[4], y[5], y[6], y[7]);
        *(u32x2*)(YB + (size_t)row * 512 + 8 * lane) = w;
        const int tl = isS ? 62 : 4094;
        if (t >= tl) {
            float* o = F.out + (isS ? OCS : OCP) + ((size_t)(l * 8 + b) * 2 + (t - tl)) * 512 + 8 * lane;
            *(f32x4*)o = (f32x4){u[0][0], u[0][1], u[0][2], u[0][3]}; *(f32x4*)(o + 4) = (f32x4){u[0][4], u[0][5], u[0][6], u[0][7]};
        }
    }
}

__device__ __forceinline__ void phase_ln_router(Ctx& F, int l) {
    bf16_t* XB = (bf16_t*)(F.ws + WS_XB); unsigned char* H8 = (unsigned char*)(F.ws + WS_H8); const bf16_t* V16 = (const bf16_t*)(F.ws + WS_V16);
    const float* mod = (const float*)(F.ws + WS_MOD) + (size_t)l * 16 * 6144;
    unsigned* cnt = (unsigned*)(F.ws + WS_CNT) + l * 2048;
    unsigned* tok = (unsigned*)(F.ws + WS_TOK); float* gate = (float*)(F.ws + WS_GATE); unsigned* slot = (unsigned*)(F.ws + WS_SLOT);
    const float* Wr = F.in[21] + (size_t)l * 1024 * 32;
    LAS float* hf = (LAS float*)F.lds;
    LAS unsigned* hist = (LAS unsigned*)(F.lds + 146432); LAS unsigned* hbase = hist + 32;
    LAS u32x4* rec = (LAS u32x4*)(F.lds + 131328);
    int nrec_tiles = 0;
    __syncthreads();
    if (F.tid < 32) hist[F.tid] = 0u;
    const int lane = F.lane, w = F.wave;
    float breg[64];
    { const float* bp = Wr + (size_t)(128 * w) * 32 + lane;
#pragma unroll
      for (int s = 0; s < 64; ++s) breg[s] = bp[64 * s]; }
    for (int tidx = F.bx; tidx < 1024 + 256; tidx += F.G) {
        const int tile0 = tidx < 1024 ? tidx * 32 : NPROMPT + (tidx - 1024) * 2, nrows = tidx < 1024 ? 32 : 2;
        __syncthreads();
        if (w * 4 < nrows) {
            u32x2 pv[4][4];
#pragma unroll
            for (int rr = 0; rr < 4; ++rr) { const int rl = w * 4 + rr, row = rl < nrows ? tile0 + rl : tile0;
#pragma unroll
                for (int j = 0; j < 4; ++j) pv[rr][j] = *(const u32x2*)(V16 + (size_t)row * D + 4 * lane + 256 * j); }
#pragma unroll
            for (int rr = 0; rr < 4; ++rr) {
                const int rl = w * 4 + rr, row = tile0 + rl;
                if (rl < nrows) {
                    f32x4 v[4];
#pragma unroll
                    for (int j = 0; j < 4; ++j) v[j] = (f32x4){bf_lo(pv[rr][j].x), bf_hi(pv[rr][j].x), bf_lo(pv[rr][j].y), bf_hi(pv[rr][j].y)};
                    ln_row(v, F.in[19] + l * D, F.in[20] + l * D, lane);
#pragma unroll
                    for (int j = 0; j < 4; ++j) { u32x2 wq; wq.x = cvt_pk_bf16(v[j][0], v[j][1]); wq.y = cvt_pk_bf16(v[j][2], v[j][3]); *(u32x2*)(XB + (size_t)row * D + 4 * lane + 256 * j) = wq; }
                    const float* mb = mod + (size_t)batch_of(row) * 6144;
#pragma unroll
                    for (int j = 0; j < 4; ++j) { const f32x4 a = *(const f32x4*)(mb + 4096 + 4 * lane + 256 * j), b = *(const f32x4*)(mb + 3072 + 4 * lane + 256 * j);
                        const f32x4 h = v[j] * (a + 1.0f) + b;
                        *(unsigned*)(H8 + (size_t)row * D + 4 * lane + 256 * j) = pk4_fp8(h[0], h[1], h[2], h[3]);
                        LAS float* hp = hf + rl * 1025 + lane + 64 * j;
                        hp[0] = h[0]; hp[256] = h[1]; hp[512] = h[2]; hp[768] = h[3]; }
                }
            }
        }
        __syncthreads();
        f32x16 acc;
#pragma unroll
        for (int j = 0; j < 16; ++j) acc[j] = 0.f;
        {
            const LAS float* ap = hf + (lane & 31) * 1025 + 32 * w;
            const int hh = lane >> 5;
#pragma unroll
            for (int s = 0; s < 64; ++s) { const int kk = 2 * s + hh; acc = __builtin_amdgcn_mfma_f32_32x32x2f32(ap[(kk & 3) * 256 + (kk >> 2)], breg[s], acc, 0, 0, 0); }
        }
        __syncthreads();
        LAS float* red = hf;
#pragma unroll
        for (int j = 0; j < 16; ++j) red[(w * 32 + 8 * (j >> 2) + 4 * (lane >> 5) + (j & 3)) * 33 + (lane & 31)] = acc[j];
        __syncthreads();
        int e_sel[4]; float g_sel[4]; unsigned loc[4];
#pragma unroll
        for (int rr = 0; rr < 4; ++rr) {
            const int tk = w * 4 + rr;
            float val = -INFINITY;
            if (lane < 32) { float sacc = F.in[22][l * 32 + lane];
#pragma unroll
                for (int ww = 0; ww < 8; ++ww) sacc += red[(ww * 32 + tk) * 33 + lane];
                val = sacc; }
            float tv[4]; int te[4];
            {
                const int vbits = __float_as_int(val); int rank = 0;
#pragma unroll
                for (int j = 0; j < 32; ++j) { const float vj = __int_as_float(__builtin_amdgcn_readlane(vbits, j)); rank += (vj > val || (vj == val && j < lane)) ? 1 : 0; }
#pragma unroll
                for (int it = 0; it < 4; ++it) { const unsigned long long mk = __ballot(rank == it); const int ln = mk ? (__ffsll((long long)mk) - 1) : 0;
                    te[it] = ln; tv[it] = __int_as_float(__builtin_amdgcn_readlane(vbits, ln)); }
            }
            const float e1 = __expf(tv[1] - tv[0]), e2 = __expf(tv[2] - tv[0]), e3 = __expf(tv[3] - tv[0]);
            const float rs = 1.0f / (1.0f + e1 + e2 + e3);
            e_sel[rr] = lane == 0 ? te[0] : lane == 1 ? te[1] : lane == 2 ? te[2] : te[3];
            g_sel[rr] = (lane == 0 ? 1.0f : lane == 1 ? e1 : lane == 2 ? e2 : e3) * rs;
            loc[rr] = 0u;
            if (lane < 4 && tk < nrows) loc[rr] = atomicAdd((unsigned*)&hist[e_sel[rr]], 1u);
        }
        if (lane < 4) {
#pragma unroll
            for (int rr = 0; rr < 4; ++rr) {
                const int rl = w * 4 + rr;
                u32x4 rc; rc.x = (rl < nrows) ? (unsigned)(tile0 + rl) : 0xffffffffu; rc.y = (unsigned)(e_sel[rr] & 31); rc.z = loc[rr]; rc.w = __float_as_uint(g_sel[rr]);
                rec[(nrec_tiles * 32 + rl) * 4 + lane] = rc;
            }
        }
        ++nrec_tiles;
    }
    __syncthreads();
    if (F.tid < 32) { const unsigned hcount = hist[F.tid]; hbase[F.tid] = hcount ? atomicAdd(cnt + F.tid * 64, hcount) : 0u; }
    __syncthreads();
    for (int i = F.tid; i < nrec_tiles * 128; i += NTHREADS) {
        const u32x4 rc = rec[i];
        if (rc.x != 0xffffffffu) { const unsigned e = rc.y, rank = hbase[e] + rc.z;
            tok[(size_t)e * NT + rank] = rc.x; gate[(size_t)e * NT + rank] = __uint_as_float(rc.w); slot[(size_t)rc.x * 4 + (i & 3)] = (e << 24) | rank; }
    }
}

__device__ __forceinline__ void build_blk(Ctx& F, int l) {
    LAS int* blk = (LAS int*)(F.lds + LDS_BLK);
    const unsigned* cnt = (const unsigned*)(F.ws + WS_CNT) + l * 2048;
    __syncthreads();
    if (F.tid == 0) { LAS int* cl = (LAS int*)(F.lds + LDS_CNT); int s = 0; for (int e = 0; e < 32; ++e) { const int ce = (int)cnt[e * 64]; cl[e] = ce; blk[e] = s; s += (ce + 255) >> 8; } blk[32] = s; }
    __syncthreads();
}

__device__ __forceinline__ void phase_combine(Ctx& F, int l) {
    const LAS int* blk = (const LAS int*)(F.lds + LDS_BLK);
    float* X = F.out; bf16_t* XB = (bf16_t*)(F.ws + WS_XB); bf16_t* H = (bf16_t*)(F.ws + WS_H); const unsigned char* YS = F.ws + WS_YS;
    const unsigned* slot = (const unsigned*)(F.ws + WS_SLOT);
    const float* mod = (const float*)(F.ws + WS_MOD);
    const int gw = F.bx * NWAVES + F.wave, NGW = F.G * NWAVES, lane = F.lane;
    for (int row = gw; row < NT; row += NGW) {
        f32x4 ff[4];
#pragma unroll
        for (int j = 0; j < 4; ++j) ff[j] = (f32x4){0.f, 0.f, 0.f, 0.f};
#pragma unroll
        for (int k = 0; k < 4; ++k) {
            const unsigned s = slot[(size_t)row * 4 + k]; const int e = (int)(s >> 24), rank = (int)(s & 0xffffffu);
            const unsigned char* yr = YS + ((size_t)blk[e] * 256 + rank) * D + 4 * lane;
#pragma unroll
            for (int j = 0; j < 4; ++j) { const unsigned wv = *(const unsigned*)(yr + 256 * j); const f32x2 lo = __builtin_amdgcn_cvt_pk_f32_fp8(wv, false), hi = __builtin_amdgcn_cvt_pk_f32_fp8(wv, true);
                ff[j][0] += lo.x; ff[j][1] += lo.y; ff[j][2] += hi.x; ff[j][3] += hi.y; }
        }
        const int bi = batch_of(row);
        const float* mb = mod + (size_t)(l * 16 + bi) * 6144;
        f32x4 v[4];
#pragma unroll
        for (int j = 0; j < 4; ++j) { const u32x2 xw = *(const u32x2*)(XB + (size_t)row * D + 4 * lane + 256 * j); const f32x4 x = (f32x4){bf_lo(xw.x), bf_hi(xw.x), bf_lo(xw.y), bf_hi(xw.y)}, g2 = *(const f32x4*)(mb + 5120 + 4 * lane + 256 * j);
            v[j] = x * ALPHA + (g2 + 1.0f) * (ff[j] * 0.0625f); }
        ln_row(v, F.in[27] + l * D, F.in[28] + l * D, lane);
#pragma unroll
        for (int j = 0; j < 4; ++j) { if (l == 0) { u32x2 w; w.x = cvt_pk_bf16(v[j][0], v[j][1]); w.y = cvt_pk_bf16(v[j][2], v[j][3]); *(u32x2*)(XB + (size_t)row * D + 4 * lane + 256 * j) = w; }
            else *(f32x4*)(X + (size_t)row * D + 4 * lane + 256 * j) = v[j]; }
        if (l == 0) { const float* mn = mod + (size_t)(16 + bi) * 6144; store_mod_row(v, mn, mn + 1024, H + (size_t)row * D, F.ws + WS_H8 + (size_t)row * D, lane); }
    }
}

#ifndef PH_MASK
#define PH_MASK 0xFFFF
#endif
#define PH(b) ((PH_MASK >> (b)) & 1)
#ifndef PROBE_MASK
#define PROBE_MASK 0
#endif
#define PB0(id) do { if ((PROBE_MASK >> (id)) & 1) pb_t0 = __builtin_amdgcn_s_memrealtime(); } while (0)
#define PB1(id) do { if ((PROBE_MASK >> (id)) & 1) pb_acc += __builtin_amdgcn_s_memrealtime() - pb_t0; } while (0)
#define RELOAD() do { int t_ = threadIdx.x; asm volatile("" : "+v"(t_)); F.tid = t_; F.lane = t_ & 63; F.wave = __builtin_amdgcn_readfirstlane(t_ >> 6); \
    unsigned z_; asm volatile("s_mov_b32 %0, 0" : "=s"(z_)); F.in = p.in; F.out = p.out + z_; F.ws = p.ws + z_; } while (0)
#define LAYER_BODY(l) do { \
          \
        PB0(2); RELOAD(); \
        if (PH(2)) { \
              \
            pg8::SchedDense S; S.init(NT, 7 * 256, D, F.G, F.bx, (const bf16_t*)(F.ws + WS_WIN) + (size_t)l * INW * D, 2); \
            pg8::EpiZ E{(bf16_t*)(F.ws + WS_Z), F.in[13] + l * INW, F.out, l, F.ws + WS_ZG8}; \
            pg8::gemm_phase<false, 0u>(F.lds, (const char*)(F.ws + WS_H), D, S, E); \
        } \
        RELOAD(); \
        if (PH(2)) { \
              \
            pg8::SchedDense S; S.init(NT, 10 * 256, 512, F.G, (F.G == 256) ? ((F.bx + 112) & 255) : F.bx, F.ws + WS_WIN8 + (size_t)l * INW * D, 0, 2, 7); \
            pg8::EpiZ E{(bf16_t*)(F.ws + WS_Z), F.in[13] + l * INW, F.out, l, F.ws + WS_ZG8}; \
            pg8::gemm_phase<true, 0x7f7f7f7fu>(F.lds, (const char*)(F.ws + WS_H8), 512, S, E); \
        } \
        xcd_barrier(xbar); PB1(2); PB0(3); \
        RELOAD(); \
        if (PH(3)) phase_attn(F, l); \
        xcd_barrier(xbar); PB1(3); PB0(4); \
          \
        RELOAD(); \
        if (PH(4)) { \
            pg8::SchedDense S; S.init(NT, D, 256, F.G, F.bx, F.ws + WS_WOA + (size_t)l * D * 512); \
            pg8::EpiT1 E{F.ws + WS_T1, F.ws + WS_ZG8}; \
            pg8::gemm_phase<true, 0x7c7c7c7cu>(F.lds, (const char*)(F.ws + WS_YA), 256, S, E); \
        } \
        RELOAD(); \
        if (PH(5)) { \
            pg8::SchedDense S; S.init(NT, D, 256, F.G, F.bx, F.ws + WS_WOB + (size_t)l * D * 512); \
            pg8::EpiMix E{F.ws + WS_T1, F.ws + WS_ZG8, F.ws + WS_MIX}; \
            pg8::gemm_phase<true, 0x7f7f7f7fu>(F.lds, (const char*)(F.ws + WS_YB), 256, S, E); \
        } \
        xcd_barrier(xbar); PB1(4); PB0(5); \
          \
        RELOAD(); \
        if (PH(6)) { \
            pg8::SchedDense S; S.init(NT, D, 512, F.G, F.bx, F.ws + WS_WO + (size_t)l * D * D); \
            pg8::EpiX E{(const bf16_t*)(F.ws + WS_XB), (bf16_t*)(F.ws + WS_V16), (const float*)(F.ws + WS_MOD) + (size_t)l * 16 * 6144}; \
            pg8::gemm_phase<true, 0x7f7f7f7fu>(F.lds, (const char*)(F.ws + WS_MIX), 512, S, E); \
        } \
        xcd_barrier(xbar); PB1(5); PB0(6); \
        RELOAD(); \
        if (PH(7)) phase_ln_router(F, l); \
        xcd_barrier(xbar); PB1(6); PB0(7); \
          \
        RELOAD(); \
        build_blk(F, l); \
        if (PH(8)) { \
            LAS int* blk = (LAS int*)(F.lds + LDS_BLK); \
            LAS unsigned short* idx = (LAS unsigned short*)(F.lds + LDS_IDX); \
            pg8::SchedMoE<true> S; S.init(blk, idx, 8, 512, F.G, F.bx, (const unsigned char*)(F.ws + WS_WGU) + (size_t)l * 32 * 2048 * D, (size_t)2048 * D); \
            const unsigned* cnt = (const unsigned*)(F.ws + WS_CNT) + l * 2048; const unsigned* tok = (const unsigned*)(F.ws + WS_TOK); \
            for (int i = 0; i < MAXU; ++i) { pg8::Unit u; if (!S.next(i, u)) break; \
                if (F.tid < 256) { int rank = (u.pm - blk[u.e]) * 256 + F.tid; const int ce = (int)cnt[u.e * 64]; rank = rank < ce ? rank : ce - 1; \
                    idx[i * 256 + F.tid] = (unsigned short)tok[(size_t)u.e * NT + rank]; } } \
            __syncthreads(); \
            pg8::EpiAct E{(unsigned char*)(F.ws + WS_ACT), F.in[24] + (size_t)l * 32 * 2048}; \
            pg8::gemm_phase<true, 0x7f7f7f7fu>(F.lds, (const char*)(F.ws + WS_H8), 512, S, E); \
        } \
        xcd_barrier(xbar); PB1(7); PB0(8); \
          \
        RELOAD(); \
        if (PH(9)) { \
            LAS int* blk = (LAS int*)(F.lds + LDS_BLK); \
            LAS unsigned short* idx = (LAS unsigned short*)(F.lds + LDS_IDX); \
            pg8::SchedMoE<false> S; S.init(blk, idx, 4, 512, F.G, F.bx, (const unsigned char*)(F.ws + WS_WDN) + (size_t)l * 32 * D * D, (size_t)D * D); \
            pg8::EpiYs E{F.ws + WS_YS, F.in[26] + (size_t)l * 32 * D, (const float*)(F.ws + WS_GATE), (const LAS int*)(F.lds + LDS_CNT), blk}; \
            pg8::gemm_phase<true, 0x7f7f7f7fu>(F.lds, (const char*)(F.ws + WS_ACT), 512, S, E); \
        } \
        xcd_barrier(xbar); PB1(8); PB0(9); \
        RELOAD(); \
        if (PH(10)) phase_combine(F, l); \
        if (l == 0) xcd_barrier(xbar); \
        PB1(9); \
 \
    } while (0)
__global__ void __launch_bounds__(NTHREADS, 2) fwd_megakernel(Params p) {
    extern __shared__ __attribute__((aligned(16))) unsigned char lds_raw[];
    cg::grid_group grid = cg::this_grid();
    Ctx F;
    F.lds = (LAS unsigned char*)lds_raw;
    F.G = gridDim.x; F.bx = blockIdx.x;
    volatile LAS unsigned* bst = (volatile LAS unsigned*)(F.lds + 147392);
    if (threadIdx.x < 2) bst[threadIdx.x] = 0u;
    __syncthreads();
    const XcdBarrier xbar = xcd_barrier_post((unsigned*)(p.ws + WS_BAR), bst);
    unsigned long long pb_t0 = 0, pb_acc = 0;
    PB0(0); RELOAD();
    if (PH(0)) phase0a(F);
    grid.sync();
    PB1(0); PB0(1); RELOAD();
    { const float* modp = (const float*)(F.ws + WS_MODP); float* mod = (float*)(F.ws + WS_MOD);
      for (int i = F.bx * NTHREADS + F.tid; i < 2 * 16 * 6144; i += F.G * NTHREADS) { float sm = 0.f;
#pragma unroll
          for (int kc = 0; kc < 8; ++kc) sm += modp[(size_t)kc * (2 * 16 * 6144) + i];
          mod[i] = sm; } }
    xcd_barrier(xbar);
    RELOAD();
    if (PH(1)) phase0b(F);
    xcd_barrier(xbar); PB1(1);

    LAYER_BODY(0);
    LAYER_BODY(1);
    if (PROBE_MASK != 0 && blockIdx.x == 0) { const unsigned long long te = __builtin_amdgcn_s_memrealtime(); while (__builtin_amdgcn_s_memrealtime() - te < pb_acc) __builtin_amdgcn_s_sleep(8); }
    (void)pb_t0; (void)pb_acc;
}

extern "C" void kernel_launch(void* const* d_in, const int* in_sizes, int n_in, void* d_out, int out_size, void* d_ws, size_t ws_size, hipStream_t stream) {
    static int grid = 0;
    if (grid == 0) {
        if (n_in != 29 || ws_size < WS_END) { fprintf(stderr, "kernel_launch: unexpected n_in %d / ws_size %zu (need %zu)\n", n_in, ws_size, (size_t)WS_END); grid = -1; return; }
        int dev = 0, cus = 0, per_cu = 0;
        hipGetDevice(&dev);
        hipDeviceGetAttribute(&cus, hipDeviceAttributeMultiprocessorCount, dev);
        if (hipFuncSetAttribute((const void*)fwd_megakernel, hipFuncAttributeMaxDynamicSharedMemorySize, LDS_BYTES) != hipSuccess) { fprintf(stderr, "kernel_launch: hipFuncSetAttribute failed\n"); grid = -1; return; }
        if (hipOccupancyMaxActiveBlocksPerMultiprocessor(&per_cu, (const void*)fwd_megakernel, NTHREADS, LDS_BYTES) != hipSuccess || per_cu < 1) { fprintf(stderr, "kernel_launch: occupancy query says %d blocks per CU\n", per_cu); per_cu = 1; }
        (void)hipGetLastError();
        grid = cus;
        if (grid != 256) fprintf(stderr, "kernel_launch: note: %d CUs (built for 256)\n", grid);
    }
    if (grid < 0) return;
    hipMemsetAsync((char*)d_ws, 0, WS_ZERO_BYTES, stream);
    Params p{};
    for (int i = 0; i < 29; ++i) p.in[i] = (const float*)d_in[i];
    p.out = (float*)d_out; p.ws = (unsigned char*)d_ws;
    void* args[] = {&p};
    hipError_t e = hipLaunchCooperativeKernel((const void*)fwd_megakernel, dim3(grid), dim3(NTHREADS), args, LDS_BYTES, stream);
    if (e != hipSuccess) fprintf(stderr, "kernel_launch: cooperative launch failed: %s (grid %d)\n", hipGetErrorString(e), grid);
}
```

```cpp
#include <hip/hip_runtime.h>
#include <hip/hip_cooperative_groups.h>
#include <cstdio>
#include <cstdint>
namespace cg = cooperative_groups;

#define LAS __attribute__((address_space(3)))
typedef unsigned short bf16_t;
typedef short bf16x8 __attribute__((ext_vector_type(8)));
typedef float f32x4 __attribute__((ext_vector_type(4)));
typedef float f32x16 __attribute__((ext_vector_type(16)));
typedef unsigned u32x4 __attribute__((ext_vector_type(4)));
typedef unsigned u32x2 __attribute__((ext_vector_type(2)));
typedef float f32x2 __attribute__((ext_vector_type(2)));
typedef int i32x4 __attribute__((ext_vector_type(4)));
typedef int i32x8 __attribute__((ext_vector_type(8)));

constexpr int D = 1024, NPROMPT = 32768, NT = 33280, INW = 4352, NEXP = 32;
constexpr float ALPHA = 1.41421356237f, LN_EPS = 1e-5f;
constexpr int NWAVES = 8, NTHREADS = 512;
constexpr int LDS_BYTES = 147456;
constexpr int LDS_BLK = 131072;
constexpr int LDS_IDX = 131072 + 256;
constexpr int MAXU = 20;
constexpr int LDS_BIASBUF = 141568;
constexpr int LDS_CNT = 145664;
constexpr size_t OKP = 34078720, OVP = 34340864, OCP = 34603008, OKS = 34619392, OVS = 34881536, OCS = 35143680;
constexpr size_t MiB = 1u << 20;
constexpr size_t WS_CNT = 0;
constexpr size_t WS_BAR = 16384;
constexpr size_t WS_MOD = 65536;
constexpr size_t WS_MODP = 192 * MiB;
constexpr size_t WS_ZERO_BYTES = 1 * MiB;
constexpr size_t WS_BIAS = 1 * MiB;
constexpr size_t WS_SLOT = 2 * MiB;
constexpr size_t WS_TOK = 3 * MiB;
constexpr size_t WS_GATE = 8 * MiB;
constexpr size_t WS_WIN = 16 * MiB;
constexpr size_t WS_WIN8 = 180 * MiB;
constexpr size_t WS_WOA = 34 * MiB;
constexpr size_t WS_WOB = 36 * MiB;
constexpr size_t WS_WO = 38 * MiB;
constexpr size_t WS_WGU = 48 * MiB;
constexpr size_t WS_WDN = 304 * MiB;
constexpr size_t WS_H = 432 * MiB;
constexpr size_t WS_H8 = 1600 * MiB;
constexpr size_t WS_Z = 498 * MiB;
constexpr size_t WS_YA = 776 * MiB;
constexpr size_t WS_YB = 810 * MiB;
constexpr size_t WS_T1 = 844 * MiB;
constexpr size_t WS_V16 = 910 * MiB;
constexpr size_t WS_XB = 1200 * MiB;
constexpr size_t WS_MIX = 976 * MiB;
constexpr size_t WS_ACT = 1042 * MiB;
constexpr size_t WS_YS = 1320 * MiB;
constexpr size_t WS_ZG8 = 1460 * MiB;
constexpr size_t WS_END = 1634 * MiB;

struct Params { const float* in[29]; float* out; unsigned char* ws; };

__device__ __forceinline__ unsigned cvt_pk_bf16(float lo, float hi) { unsigned r; asm volatile("v_cvt_pk_bf16_f32 %0, %1, %2" : "=v"(r) : "v"(lo), "v"(hi)); return r; }
__device__ __forceinline__ unsigned pk4_fp8(float a, float b, float c, float d) { unsigned w = 0u; w = __builtin_amdgcn_cvt_pk_fp8_f32(a, b, w, false); w = __builtin_amdgcn_cvt_pk_fp8_f32(c, d, w, true); return w; }
__device__ __forceinline__ void unpk8_fp8(const u32x2 w, float (&o)[8]) { const f32x2 a = __builtin_amdgcn_cvt_pk_f32_fp8(w.x, false), b = __builtin_amdgcn_cvt_pk_f32_fp8(w.x, true), c = __builtin_amdgcn_cvt_pk_f32_fp8(w.y, false), d = __builtin_amdgcn_cvt_pk_f32_fp8(w.y, true);
    o[0] = a.x; o[1] = a.y; o[2] = b.x; o[3] = b.y; o[4] = c.x; o[5] = c.y; o[6] = d.x; o[7] = d.y; }
__device__ __forceinline__ void store_pair16(unsigned char* pa, unsigned char* pb, int fq, u32x2 wa, u32x2 wb) {
    const auto rx = __builtin_amdgcn_permlane16_swap(wa.x, wb.x, false, false);
    const auto ry = __builtin_amdgcn_permlane16_swap(wa.y, wb.y, false, false);
    u32x4 o; o.x = rx[0]; o.y = ry[0]; o.z = rx[1]; o.w = ry[1];
    *(u32x4*)((fq & 1) ? pb - 8 : pa) = o;
}
__device__ __forceinline__ void load_pair16(const unsigned char* pa, const unsigned char* pb, int fq, u32x2& wa, u32x2& wb) {
    const u32x4 x = *(const u32x4*)((fq & 1) ? pb - 8 : pa);
    const auto rx = __builtin_amdgcn_permlane16_swap(x.x, x.z, false, false);
    const auto ry = __builtin_amdgcn_permlane16_swap(x.y, x.w, false, false);
    wa.x = rx[0]; wa.y = ry[0]; wb.x = rx[1]; wb.y = ry[1];
}
__device__ __forceinline__ float bf_lo(unsigned w) { return __uint_as_float(w << 16); }
__device__ __forceinline__ float bf_hi(unsigned w) { return __uint_as_float(w & 0xffff0000u); }
__device__ __forceinline__ float sigmoidf_(float x) { return __builtin_amdgcn_rcpf(1.0f + __expf(-x)); }
__device__ __forceinline__ f32x2 sigmoid2(f32x2 x) {
    const f32x2 t = x * (-1.44269504089f);
    f32x2 e; e.x = __builtin_amdgcn_exp2f(t.x); e.y = __builtin_amdgcn_exp2f(t.y);
    const f32x2 d = e + 1.0f;
    f32x2 r; r.x = __builtin_amdgcn_rcpf(d.x); r.y = __builtin_amdgcn_rcpf(d.y);
    return r;
}
__device__ __forceinline__ float wave_sum(float v) {
#define WS_DPP_ADD(ctrl) v += __int_as_float(__builtin_amdgcn_update_dpp(0, __float_as_int(v), (ctrl), 0xf, 0xf, true))
    WS_DPP_ADD(0xB1);
    WS_DPP_ADD(0x4E);
    WS_DPP_ADD(0x141);
    WS_DPP_ADD(0x140);
#undef WS_DPP_ADD
    const int b = __float_as_int(v);
    const float r0 = __int_as_float(__builtin_amdgcn_readlane(b, 0)), r1 = __int_as_float(__builtin_amdgcn_readlane(b, 16)), r2 = __int_as_float(__builtin_amdgcn_readlane(b, 32)), r3 = __int_as_float(__builtin_amdgcn_readlane(b, 48));
    return (r0 + r1) + (r2 + r3);
}
__device__ __forceinline__ int batch_of(int row) { return row < NPROMPT ? (row >> 12) : 8 + ((row - NPROMPT) >> 6); }

namespace pg8 {
constexpr int BM = 256, BK = 64, HALF = 128, HTB = HALF * BK * 2, NXCD = 8, WGM = 8;
__device__ __forceinline__ int lds_byte(int r, int c) { const int st = (r >> 4) * 2 + (c >> 5), rr = r & 15, cc = c & 31, ob = rr * 64 + cc * 2; return st * 1024 + (ob ^ (((ob >> 9) & 1) << 5)); }
__device__ __forceinline__ void stage_rc(int b, int& R, int& C) { const int st = b / 1024, sb = b % 1024, swz = sb ^ (((sb >> 9) & 1) << 5); R = (st >> 1) * 16 + swz / 64; C = (st & 1) * 32 + (swz % 64) / 2; }
__device__ __forceinline__ int perm32(int rho) { const int n = rho >> 4, i = rho & 15; return 8 * (i >> 2) + 4 * n + (i & 3); }

struct Unit { int pm, pn, e; const char* b; };

struct SchedDense {
    int nM, nN, nwg, G, c, cbase, csplit, cskip; const char* Bt; size_t tstepB;
    __device__ __forceinline__ void init(int M, int N, int K, int G_, int c_, const void* Bt_, int cbase_ = 0, int csplit_ = 1 << 20, int cskip_ = 0) { nM = M / BM; nN = N / BM; nwg = nM * nN; G = G_; c = c_; Bt = (const char*)Bt_; tstepB = (size_t)BM * K * 2; cbase = cbase_; csplit = csplit_; cskip = cskip_; }
    __device__ __forceinline__ bool next(int i, Unit& u) const {
        const long L = (long)i * G + c; if (L >= nwg) return false;
        int wgid = (int)L; { const int q = nwg / NXCD, r = nwg % NXCD, xcd = wgid % NXCD, off = wgid / NXCD; wgid = (xcd < r ? xcd * (q + 1) : r * (q + 1) + (xcd - r) * q) + off; }
        const int nig = WGM * nN, gid = wgid / nig, fm = gid * WGM, gsz = (nM - fm) < WGM ? (nM - fm) : WGM;
        u.pm = fm + ((wgid % nig) % gsz); const int j = (wgid % nig) / gsz; u.pn = j < csplit ? j + cbase : j + cbase + cskip; u.e = 0; u.b = Bt + (size_t)u.pn * tstepB; return true;
    }
    __device__ __forceinline__ unsigned rowidx(int, const Unit& u, int r) const { return (unsigned)(u.pm * BM + r); }
};
template <bool GATHER> struct SchedMoE {
    const LAS int* blk; const LAS unsigned short* idx; int NB, RBX, NPN, NXs, perx, cx, cj; const char* Bt; size_t estep, tstepB;
    __device__ __forceinline__ void init(const LAS int* blk_, const LAS unsigned short* idx_, int NPN_, int K, int G, int c, const void* Bt_, size_t estep_) {
        blk = blk_; idx = idx_; NB = blk_[32]; NPN = NPN_; Bt = (const char*)Bt_; estep = estep_; tstepB = (size_t)BM * K * 2;
        if ((G & 7) == 0) { NXs = 8; perx = G >> 3; cx = c & 7; cj = c >> 3; } else { NXs = 1; perx = G; cx = 0; cj = c; }
        RBX = (NB + NXs - 1) / NXs;
    }
    __device__ __forceinline__ bool next(int i, Unit& u) const {
        const int j = i * perx + cj, rbl = j / NPN; if (rbl >= RBX) return false;
        const int rb = cx * RBX + rbl; if (rb >= NB) return false;
        int e = 0;
        for (int q = 1; q < 32; ++q) e = (blk[q] <= rb) ? q : e;
        u.pm = rb; u.pn = j - rbl * NPN; u.e = e; u.b = Bt + (size_t)e * estep + (size_t)u.pn * tstepB; return true;
    }
    __device__ __forceinline__ unsigned rowidx(int ui, const Unit& u, int r) const { if (GATHER) return (unsigned)idx[ui * 256 + r]; return (unsigned)(u.pm * BM + r); }
};

template <bool FP8, unsigned ASCALE, class Epi, class Sched>
__device__ __forceinline__ void gemm_phase(LAS unsigned char* lds, const char* Abase, const int K, const Sched& S, const Epi& E) {
    int tid_ = threadIdx.x; asm volatile("" : "+v"(tid_));
    const int tid = tid_, wid = __builtin_amdgcn_readfirstlane(tid >> 6), lane = tid & 63, wr = wid >> 2, wc = wid & 3, fr = lane & 15, fq = lane >> 4;
    int nt_ = K / BK; asm volatile("" : "+s"(nt_)); const int nt = nt_;
    unsigned voffB[2]; int RA[2], CA[2];
#pragma unroll
    for (int i = 0; i < 2; ++i) { int R, C; stage_rc(tid * 16 + i * 8192, R, C); const int Rb = Epi::PERM ? ((R & ~31) + perm32(R & 31)) : R;
        voffB[i] = (unsigned)(Rb * K + C) * 2u; RA[i] = R; CA[i] = C * 2; }
    const size_t kstep = (size_t)(BK * 2);
    const size_t hstep = (size_t)HALF * K * 2;
    const unsigned ldsw = (unsigned)wid * 1024u;
    const unsigned rowb = (unsigned)K * 2u;
    const int aoff = lds_byte(wr * 64 + fr, fq * 8), boff = lds_byte(wc * 32 + fr, fq * 8);
#define PG8_SA(b, h) (((b) * 2 + (h)) * HTB)
#define PG8_SB(b, h) ((4 + (b) * 2 + (h)) * HTB)
#define PG8_STAGE(bufoff, gbase, voff) do { _Pragma("unroll") for (int _i = 0; _i < 2; ++_i) \
        __builtin_amdgcn_global_load_lds((const unsigned*)((const char*)(gbase) + (voff)[_i]), (LAS unsigned*)(lds + (bufoff) + ldsw + _i * 8192), 16, 0, 0); } while (0)
#define PG8_LDA(dst, b, h) do { _Pragma("unroll") for (int m = 0; m < 4; ++m) _Pragma("unroll") for (int k = 0; k < 2; ++k) dst[m][k] = *(const LAS bf16x8*)(lds + PG8_SA(b, h) + aoff + m * 2048 + k * 1024); } while (0)
#define PG8_LDB(dst, b, h) do { _Pragma("unroll") for (int n = 0; n < 2; ++n) _Pragma("unroll") for (int k = 0; k < 2; ++k) dst[n][k] = *(const LAS bf16x8*)(lds + PG8_SB(b, h) + boff + n * 2048 + k * 1024); } while (0)
#define PG8_MMA(ai, bj, At, Bt) do { __builtin_amdgcn_s_setprio(1); _Pragma("unroll") for (int m = 0; m < 4; ++m) _Pragma("unroll") for (int n = 0; n < 2; ++n) { \
        if constexpr (FP8) { \
            const i32x8 wf_ = __builtin_shufflevector((i32x4)Bt[n][0], (i32x4)Bt[n][1], 0, 1, 2, 3, 4, 5, 6, 7), af_ = __builtin_shufflevector((i32x4)At[m][0], (i32x4)At[m][1], 0, 1, 2, 3, 4, 5, 6, 7); \
            acc[ai][bj][m][n] = __builtin_amdgcn_mfma_scale_f32_16x16x128_f8f6f4(wf_, af_, acc[ai][bj][m][n], 0, 0, 0, 0x79797979, 0, (int)ASCALE); \
        } else { _Pragma("unroll") for (int k = 0; k < 2; ++k) \
            acc[ai][bj][m][n] = __builtin_amdgcn_mfma_f32_16x16x32_bf16(Bt[n][k], At[m][k], acc[ai][bj][m][n], 0, 0, 0); } } \
        __builtin_amdgcn_s_setprio(0); } while (0)
#define PG8_WAIT_V(n) asm volatile("s_waitcnt vmcnt(" #n ")" ::: "memory")
#define PG8_WAIT_L(n) asm volatile("s_waitcnt lgkmcnt(" #n ")" ::: "memory")
#define PG8_BAR __builtin_amdgcn_s_barrier()
#define PG8_SCHED __builtin_amdgcn_sched_barrier(0)
#define PG8_LOADVA(ui_, u_) do { _Pragma("unroll") for (int _h = 0; _h < 2; ++_h) _Pragma("unroll") for (int _i = 0; _i < 2; ++_i) \
        vA[_h][_i] = S.rowidx((ui_), (u_), _h * HALF + RA[_i]) * rowb + (unsigned)CA[_i]; } while (0)
    Unit cur, nxt; int ui = 0;
    if (!S.next(0, cur)) return;
    f32x4 acc[2][2][4][2];
#pragma unroll
    for (int a = 0; a < 2; ++a)
#pragma unroll
        for (int b = 0; b < 2; ++b)
#pragma unroll
            for (int m = 0; m < 4; ++m)
#pragma unroll
                for (int n = 0; n < 2; ++n) acc[a][b][m][n] = (f32x4){0.f, 0.f, 0.f, 0.f};
    bf16x8 At[4][2], B0[2][2], B1[2][2];
    unsigned vA[2][2];
    PG8_LOADVA(0, cur);
    const char* cB = cur.b;
    if (Epi::BIAS && tid < 64) __builtin_amdgcn_global_load_lds((const unsigned*)E.bias_ptr(cur, tid), (LAS unsigned*)(lds + LDS_BIASBUF), 16, 0, 0);
    if (Epi::EXTRA && tid < 64) __builtin_amdgcn_global_load_lds((const unsigned*)E.extra_ptr(cur, tid), (LAS unsigned*)(lds + LDS_BIASBUF + 1024), 16, 0, 0);
    PG8_STAGE(PG8_SB(0, 0), cB, voffB); PG8_STAGE(PG8_SB(0, 1), cB + hstep, voffB); PG8_STAGE(PG8_SA(0, 0), Abase, vA[0]); PG8_STAGE(PG8_SA(0, 1), Abase, vA[1]);
    if (wr == 1) PG8_BAR;
    PG8_WAIT_V(2); PG8_BAR;
    PG8_STAGE(PG8_SB(1, 0), cB + kstep, voffB); PG8_STAGE(PG8_SA(1, 0), Abase + kstep, vA[0]); PG8_STAGE(PG8_SB(1, 1), cB + hstep + kstep, voffB);
    PG8_WAIT_V(6); PG8_BAR;
    for (;;) {
        const bool has_next = S.next(ui + 1, nxt);
        const char* nB = has_next ? nxt.b : cB;
#pragma unroll 1
        for (int t = 0; t < nt; t += 2) {
            const bool last = (t == nt - 2);
            const char* a1 = Abase + (size_t)(t + 1) * kstep;
            const char* a2 = last ? Abase : Abase + (size_t)(t + 2) * kstep;
            const char* b2 = last ? nB : cB + (size_t)(t + 2) * kstep;
            const char* a3 = a2 + kstep; const char* b3 = b2 + kstep;
            PG8_LDB(B0, 0, 0); PG8_LDB(B1, 0, 1); PG8_SCHED; PG8_LDA(At, 0, 0); PG8_STAGE(PG8_SA(1, 1), a1, vA[1]);
            if (last && has_next) { PG8_LOADVA(ui + 1, nxt);
                if (Epi::BIAS && tid < 64) __builtin_amdgcn_global_load_lds((const unsigned*)E.bias_ptr(nxt, tid), (LAS unsigned*)(lds + LDS_BIASBUF + ((ui + 1) & 1) * 2048), 16, 0, 0);
                if (Epi::EXTRA && tid < 64) __builtin_amdgcn_global_load_lds((const unsigned*)E.extra_ptr(nxt, tid), (LAS unsigned*)(lds + LDS_BIASBUF + ((ui + 1) & 1) * 2048 + 1024), 16, 0, 0); }
            PG8_WAIT_V(8); PG8_WAIT_L(0); PG8_BAR; PG8_MMA(0, 0, At, B0); PG8_MMA(0, 1, At, B1); PG8_BAR; PG8_SCHED;
            PG8_LDA(At, 0, 1); PG8_STAGE(PG8_SB(0, 0), b2, voffB); PG8_STAGE(PG8_SB(0, 1), b2 + hstep, voffB); PG8_STAGE(PG8_SA(0, 0), a2, vA[0]);
            PG8_WAIT_V(8); PG8_WAIT_L(0); PG8_BAR; PG8_MMA(1, 0, At, B0); PG8_MMA(1, 1, At, B1); PG8_BAR; PG8_SCHED;
            PG8_LDB(B0, 1, 0); PG8_LDB(B1, 1, 1); PG8_SCHED; PG8_LDA(At, 1, 0); PG8_STAGE(PG8_SA(0, 1), a2, vA[1]);
            PG8_WAIT_V(8); PG8_WAIT_L(0); PG8_BAR; PG8_MMA(0, 0, At, B0); PG8_MMA(0, 1, At, B1); PG8_BAR; PG8_SCHED;
            PG8_LDA(At, 1, 1); PG8_STAGE(PG8_SB(1, 0), b3, voffB); PG8_STAGE(PG8_SB(1, 1), b3 + hstep, voffB); PG8_STAGE(PG8_SA(1, 0), a3, vA[0]);
            PG8_WAIT_V(8); PG8_WAIT_L(0); PG8_BAR; PG8_MMA(1, 0, At, B0); PG8_MMA(1, 1, At, B1); PG8_BAR; PG8_SCHED;
        }
        if (wr == 0) PG8_BAR;
        E(acc, cur, wr, wc, fr, fq, (const LAS float*)(lds + LDS_BIASBUF + (ui & 1) * 2048));
        if (!has_next) break;
#pragma unroll
        for (int a = 0; a < 2; ++a)
#pragma unroll
            for (int b = 0; b < 2; ++b)
#pragma unroll
                for (int m = 0; m < 4; ++m)
#pragma unroll
                    for (int n = 0; n < 2; ++n) acc[a][b][m][n] = (f32x4){0.f, 0.f, 0.f, 0.f};
        cur = nxt; cB = nB; ++ui;
        if (wr == 1) PG8_BAR;
    }
    PG8_WAIT_V(0);
    PG8_BAR;
#undef PG8_SA
#undef PG8_SB
#undef PG8_STAGE
#undef PG8_LDA
#undef PG8_LDB
#undef PG8_MMA
#undef PG8_WAIT_V
#undef PG8_WAIT_L
#undef PG8_BAR
#undef PG8_SCHED
#undef PG8_LOADVA
}

typedef f32x4 Acc[2][2][4][2];

struct EpiZ {
    static constexpr bool PERM = true, BIAS = true, EXTRA = false;
    __device__ __forceinline__ const float* extra_ptr(const Unit&, int) const { return nullptr; }
    __device__ __forceinline__ const float* bias_ptr(const Unit& u, int t) const { return bias + u.pn * 256 + 4 * t; }
    bf16_t* Z; const float* bias; float* out; int l; unsigned char* ZG;
    __device__ __forceinline__ void operator()(const Acc& acc, const Unit& u, int wr, int wc, int fr, int fq, const LAS float* lb) const {
        const int row0 = u.pm * 256 + wr * 64 + fr, col0 = u.pn * 256 + wc * 32 + 8 * fq;
        u32x2 wprev[2];
        f32x4 bv[2][2];
#pragma unroll
        for (int bj = 0; bj < 2; ++bj)
#pragma unroll
            for (int n = 0; n < 2; ++n) bv[bj][n] = *(const LAS f32x4*)(lb + bj * 128 + wc * 32 + 8 * fq + 4 * n);
#pragma unroll
        for (int ai = 0; ai < 2; ++ai)
#pragma unroll
            for (int m = 0; m < 4; ++m) {
                const int row = row0 + ai * 128 + m * 16;
                bf16_t* rowp = Z + (size_t)row * INW + col0;
                float* ko = nullptr; float* vo = nullptr;
                if (u.pn == 2) {
                    if (row < NPROMPT) { const int t = row & 4095; if (t >= 3968) { const size_t o = ((size_t)(l * 8 + (row >> 12)) * 128 + (t - 3968)) * 128 + wc * 32 + 8 * fq; ko = out + OKP + o; vo = out + OVP + o; } }
                    else { const int rr = row - NPROMPT; const size_t o = ((size_t)(l * 8 + (rr >> 6)) * 128 + 64 + (rr & 63)) * 128 + wc * 32 + 8 * fq; ko = out + OKS + o; vo = out + OVS + o; }
                }
#pragma unroll
                for (int bj = 0; bj < 2; ++bj) {
                    const f32x4 v0 = acc[ai][bj][m][0] + bv[bj][0], v1 = acc[ai][bj][m][1] + bv[bj][1];
                    if (u.pn >= 9) { u32x2 w8; w8.x = pk4_fp8(v0[0], v0[1], v0[2], v0[3]); w8.y = pk4_fp8(v1[0], v1[1], v1[2], v1[3]);
                        unsigned char* pz = ZG + (size_t)row * 2048 + (col0 - 2304) + bj * 128;
                        if ((m & 1) == 0) wprev[bj] = w8; else store_pair16(pz - (size_t)16 * 2048, pz, fq, wprev[bj], w8); }
                    else { u32x4 w; w.x = cvt_pk_bf16(v0[0], v0[1]); w.y = cvt_pk_bf16(v0[2], v0[3]); w.z = cvt_pk_bf16(v1[0], v1[1]); w.w = cvt_pk_bf16(v1[2], v1[3]);
                        *(u32x4*)(rowp + bj * 128) = w; }
                    float* o = bj == 0 ? ko : vo;
                    if (o) { *(f32x4*)o = v0; *(f32x4*)(o + 4) = v1; }
                }
                asm volatile("" ::: "memory");
            }
    }
};
struct EpiT1 {
    static constexpr bool PERM = true, BIAS = false, EXTRA = false;
    __device__ __forceinline__ const float* extra_ptr(const Unit&, int) const { return nullptr; }
    __device__ __forceinline__ const float* bias_ptr(const Unit&, int) const { return nullptr; }
    unsigned char* T1; const unsigned char* ZG;
    __device__ __forceinline__ void operator()(const Acc& acc, const Unit& u, int wr, int wc, int fr, int fq, const LAS float* lb) const {
        const int row0 = u.pm * 256 + wr * 64 + fr, col0 = u.pn * 256 + wc * 32 + 8 * fq;
        u32x2 g[2][4][2];
#pragma unroll
        for (int ai = 0; ai < 2; ++ai)
#pragma unroll
            for (int m = 0; m < 4; m += 2)
#pragma unroll
                for (int bj = 0; bj < 2; ++bj) { const unsigned char* pa = ZG + (size_t)(row0 + ai * 128 + m * 16) * 2048 + col0 + bj * 128;
                    load_pair16(pa, pa + (size_t)16 * 2048, fq, g[ai][m][bj], g[ai][m + 1][bj]); }
        asm volatile("" ::: "memory");
        u32x2 wprev[2];
#pragma unroll
        for (int ai = 0; ai < 2; ++ai)
#pragma unroll
            for (int m = 0; m < 4; ++m) {
                const int row = row0 + ai * 128 + m * 16;
#pragma unroll
                for (int bj = 0; bj < 2; ++bj) {
                    const u32x2 gw = g[ai][m][bj];
                    const f32x2 s0 = sigmoid2(__builtin_amdgcn_cvt_pk_f32_fp8(gw.x, false)), s1 = sigmoid2(__builtin_amdgcn_cvt_pk_f32_fp8(gw.x, true)),
                                s2 = sigmoid2(__builtin_amdgcn_cvt_pk_f32_fp8(gw.y, false)), s3 = sigmoid2(__builtin_amdgcn_cvt_pk_f32_fp8(gw.y, true));
                    const f32x4 a0 = acc[ai][bj][m][0], a1 = acc[ai][bj][m][1];
                    const f32x2 p0 = ((f32x2){a0[0], a0[1]} * 16.0f) * s0, p1 = ((f32x2){a0[2], a0[3]} * 16.0f) * s1, p2 = ((f32x2){a1[0], a1[1]} * 16.0f) * s2, p3 = ((f32x2){a1[2], a1[3]} * 16.0f) * s3;
                    u32x2 w; w.x = pk4_fp8(p0.x, p0.y, p1.x, p1.y); w.y = pk4_fp8(p2.x, p2.y, p3.x, p3.y);
                    if ((m & 1) == 0) wprev[bj] = w;
                    else store_pair16(T1 + (size_t)(row - 16) * D + col0 + bj * 128, T1 + (size_t)row * D + col0 + bj * 128, fq, wprev[bj], w);
                }
            }
    }
};
struct EpiMix {
    static constexpr bool PERM = true, BIAS = false, EXTRA = false;
    __device__ __forceinline__ const float* extra_ptr(const Unit&, int) const { return nullptr; }
    __device__ __forceinline__ const float* bias_ptr(const Unit&, int) const { return nullptr; }
    const unsigned char* T1; const unsigned char* ZG; unsigned char* MIX;
    __device__ __forceinline__ void operator()(const Acc& acc, const Unit& u, int wr, int wc, int fr, int fq, const LAS float* lb) const {
        const int row0 = u.pm * 256 + wr * 64 + fr, col0 = u.pn * 256 + wc * 32 + 8 * fq;
        u32x2 g[2][4][2], t[2][4][2];
#pragma unroll
        for (int ai = 0; ai < 2; ++ai)
#pragma unroll
            for (int m = 0; m < 4; ++m)
#pragma unroll
                for (int bj = 0; bj < 2; ++bj) { if (m & 1) continue; const int row = row0 + ai * 128 + m * 16;
                    const unsigned char* pg = ZG + (size_t)row * 2048 + 1024 + col0 + bj * 128; const unsigned char* pt = T1 + (size_t)row * D + col0 + bj * 128;
                    load_pair16(pg, pg + (size_t)16 * 2048, fq, g[ai][m][bj], g[ai][m | 1][bj]);
                    load_pair16(pt, pt + (size_t)16 * D, fq, t[ai][m][bj], t[ai][m | 1][bj]); }
        asm volatile("" ::: "memory");
        u32x2 wprev[2];
#pragma unroll
        for (int ai = 0; ai < 2; ++ai)
#pragma unroll
            for (int m = 0; m < 4; ++m) {
                const int row = row0 + ai * 128 + m * 16;
#pragma unroll
                for (int bj = 0; bj < 2; ++bj) {
                    const u32x2 gw = g[ai][m][bj], tw = t[ai][m][bj];
                    const f32x2 s0 = sigmoid2(__builtin_amdgcn_cvt_pk_f32_fp8(gw.x, false)), s1 = sigmoid2(__builtin_amdgcn_cvt_pk_f32_fp8(gw.x, true)),
                                s2 = sigmoid2(__builtin_amdgcn_cvt_pk_f32_fp8(gw.y, false)), s3 = sigmoid2(__builtin_amdgcn_cvt_pk_f32_fp8(gw.y, true));
                    const f32x2 t0 = __builtin_amdgcn_cvt_pk_f32_fp8(tw.x, false), t1 = __builtin_amdgcn_cvt_pk_f32_fp8(tw.x, true), t2 = __builtin_amdgcn_cvt_pk_f32_fp8(tw.y, false), t3 = __builtin_amdgcn_cvt_pk_f32_fp8(tw.y, true);
                    const f32x4 a0 = acc[ai][bj][m][0], a1 = acc[ai][bj][m][1];
                    const f32x2 p0 = t0 * 0.0625f + (f32x2){a0[0], a0[1]} * s0, p1 = t1 * 0.0625f + (f32x2){a0[2], a0[3]} * s1, p2 = t2 * 0.0625f + (f32x2){a1[0], a1[1]} * s2, p3 = t3 * 0.0625f + (f32x2){a1[2], a1[3]} * s3;
                    u32x2 w; w.x = pk4_fp8(p0.x, p0.y, p1.x, p1.y); w.y = pk4_fp8(p2.x, p2.y, p3.x, p3.y);
                    if ((m & 1) == 0) wprev[bj] = w;
                    else store_pair16(MIX + (size_t)(row - 16) * D + col0 + bj * 128, MIX + (size_t)row * D + col0 + bj * 128, fq, wprev[bj], w);
                }
            }
    }
};
struct EpiX {
    static constexpr bool PERM = true, BIAS = false, EXTRA = false;
    __device__ __forceinline__ const float* extra_ptr(const Unit&, int) const { return nullptr; }
    __device__ __forceinline__ const float* bias_ptr(const Unit&, int) const { return nullptr; }
    const bf16_t* X; bf16_t* V; const float* modl;
    __device__ __forceinline__ void operator()(const Acc& acc, const Unit& u, int wr, int wc, int fr, int fq, const LAS float* lb) const {
        const int row0 = u.pm * 256 + wr * 64 + fr, col0 = u.pn * 256 + wc * 32 + 8 * fq;
        const bool uni = u.pm < 128;
        f32x4 g[2][2];
        if (uni) { const float* gp = modl + (size_t)(u.pm >> 4) * 6144 + 2048 + col0;
#pragma unroll
            for (int bj = 0; bj < 2; ++bj)
#pragma unroll
                for (int n = 0; n < 2; ++n) g[bj][n] = *(const f32x4*)(gp + bj * 128 + 4 * n) + 1.0f; }
#pragma unroll
        for (int ai = 0; ai < 2; ++ai) {
            u32x4 x[4][2];
#pragma unroll
            for (int m = 0; m < 4; ++m)
#pragma unroll
                for (int bj = 0; bj < 2; ++bj) x[m][bj] = *(const u32x4*)(X + (size_t)(row0 + ai * 128 + m * 16) * D + col0 + bj * 128);
            asm volatile("" ::: "memory");
#pragma unroll
            for (int m = 0; m < 4; ++m) {
                const int row = row0 + ai * 128 + m * 16;
                if (!uni) { const float* gp = modl + (size_t)batch_of(row) * 6144 + 2048 + col0;
#pragma unroll
                    for (int bj = 0; bj < 2; ++bj)
#pragma unroll
                        for (int n = 0; n < 2; ++n) g[bj][n] = *(const f32x4*)(gp + bj * 128 + 4 * n) + 1.0f; }
#pragma unroll
                for (int bj = 0; bj < 2; ++bj) {
                    const u32x4 xx = x[m][bj];
                    const f32x4 x0 = (f32x4){bf_lo(xx.x), bf_hi(xx.x), bf_lo(xx.y), bf_hi(xx.y)}, x1 = (f32x4){bf_lo(xx.z), bf_hi(xx.z), bf_lo(xx.w), bf_hi(xx.w)};
                    const f32x4 v0 = x0 * ALPHA + g[bj][0] * acc[ai][bj][m][0], v1 = x1 * ALPHA + g[bj][1] * acc[ai][bj][m][1];
                    u32x4 w; w.x = cvt_pk_bf16(v0[0], v0[1]); w.y = cvt_pk_bf16(v0[2], v0[3]); w.z = cvt_pk_bf16(v1[0], v1[1]); w.w = cvt_pk_bf16(v1[2], v1[3]);
                    *(u32x4*)(V + (size_t)row * D + col0 + bj * 128) = w;
                }
            }
            asm volatile("" ::: "memory");
        }
    }
};
struct EpiAct {
    static constexpr bool PERM = true, BIAS = true, EXTRA = false;
    __device__ __forceinline__ const float* extra_ptr(const Unit&, int) const { return nullptr; }
    __device__ __forceinline__ const float* bias_ptr(const Unit& u, int t) const { return bgu + (size_t)u.e * 2048 + u.pn * 128 + (t < 32 ? 4 * t : 1024 + 4 * (t - 32)); }
    unsigned char* ACT; const float* bgu;
    __device__ __forceinline__ void operator()(const Acc& acc, const Unit& u, int wr, int wc, int fr, int fq, const LAS float* lb) const {
        const int row0 = u.pm * 256 + wr * 64 + fr, c0 = u.pn * 128 + wc * 32 + 8 * fq;
        u32x2 wprev;
        f32x4 bg[2], bl[2];
#pragma unroll
        for (int n = 0; n < 2; ++n) { bg[n] = *(const LAS f32x4*)(lb + wc * 32 + 8 * fq + 4 * n); bl[n] = *(const LAS f32x4*)(lb + 128 + wc * 32 + 8 * fq + 4 * n); }
#pragma unroll
        for (int ai = 0; ai < 2; ++ai)
#pragma unroll
            for (int m = 0; m < 4; ++m) {
                const int row = row0 + ai * 128 + m * 16;
                float a[8];
#pragma unroll
                for (int n = 0; n < 2; ++n)
#pragma unroll
                    for (int jp = 0; jp < 2; ++jp) {
                        f32x2 g = (f32x2){acc[ai][0][m][n][2 * jp], acc[ai][0][m][n][2 * jp + 1]} + (f32x2){bg[n][2 * jp], bg[n][2 * jp + 1]};
                        f32x2 li = (f32x2){acc[ai][1][m][n][2 * jp], acc[ai][1][m][n][2 * jp + 1]} + (f32x2){bl[n][2 * jp], bl[n][2 * jp + 1]};
                        g = __builtin_elementwise_min(g, (f32x2){7.0f, 7.0f});
                        li = __builtin_elementwise_min(__builtin_elementwise_max(li, (f32x2){-7.0f, -7.0f}), (f32x2){7.0f, 7.0f});
                        const f32x2 t = g * (-1.702f * 1.44269504089f);
                        f32x2 e; e.x = __builtin_amdgcn_exp2f(t.x); e.y = __builtin_amdgcn_exp2f(t.y);
                        const f32x2 dd = e + 1.0f;
                        f32x2 r; r.x = __builtin_amdgcn_rcpf(dd.x); r.y = __builtin_amdgcn_rcpf(dd.y);
                        const f32x2 av = (g * r) * (li + 1.0f);
                        a[n * 4 + 2 * jp] = av.x; a[n * 4 + 2 * jp + 1] = av.y;
                    }
                u32x2 w; w.x = pk4_fp8(a[0], a[1], a[2], a[3]); w.y = pk4_fp8(a[4], a[5], a[6], a[7]);
                if ((m & 1) == 0) wprev = w;
                else store_pair16(ACT + (size_t)(row - 16) * D + c0, ACT + (size_t)row * D + c0, fq, wprev, w);
                asm volatile("" ::: "memory");
            }
    }
};
struct EpiYs {
    static constexpr bool PERM = true, BIAS = true, EXTRA = true;
    __device__ __forceinline__ const float* extra_ptr(const Unit& u, int t) const { return gate + (size_t)u.e * NT + (u.pm - blk[u.e]) * 256 + 4 * t; }
    __device__ __forceinline__ const float* bias_ptr(const Unit& u, int t) const { return bdn + (size_t)u.e * D + u.pn * 256 + 4 * t; }
    unsigned char* YS; const float* bdn; const float* gate; const LAS int* cnt; const LAS int* blk;
    __device__ __forceinline__ void operator()(const Acc& acc, const Unit& u, int wr, int wc, int fr, int fq, const LAS float* lb) const {
        const int r0 = wr * 64 + fr, col0 = u.pn * 256 + wc * 32 + 8 * fq;
        const int rank0 = (u.pm - blk[u.e]) * 256; const int ce = cnt[u.e];
        f32x4 bv[2][2];
#pragma unroll
        for (int bj = 0; bj < 2; ++bj)
#pragma unroll
            for (int n = 0; n < 2; ++n) bv[bj][n] = *(const LAS f32x4*)(lb + bj * 128 + wc * 32 + 8 * fq + 4 * n);
        float gts[2][4];
#pragma unroll
        for (int ai = 0; ai < 2; ++ai)
#pragma unroll
            for (int m = 0; m < 4; ++m) { const int rank = rank0 + r0 + ai * 128 + m * 16; const float gv = lb[256 + r0 + ai * 128 + m * 16]; gts[ai][m] = rank < ce ? 16.0f * gv : 0.0f; }
        asm volatile("" ::: "memory");
        u32x2 wprev[2];
#pragma unroll
        for (int ai = 0; ai < 2; ++ai)
#pragma unroll
            for (int m = 0; m < 4; ++m) {
                const int r = r0 + ai * 128 + m * 16;
                const float gt = gts[ai][m];
                unsigned char* rowp = YS + (size_t)(u.pm * 256 + r) * D + col0;
#pragma unroll
                for (int bj = 0; bj < 2; ++bj) {
                    const f32x4 v0 = (acc[ai][bj][m][0] + bv[bj][0]) * gt, v1 = (acc[ai][bj][m][1] + bv[bj][1]) * gt;
                    u32x2 w; w.x = pk4_fp8(v0[0], v0[1], v0[2], v0[3]); w.y = pk4_fp8(v1[0], v1[1], v1[2], v1[3]);
                    if ((m & 1) == 0) wprev[bj] = w;
                    else store_pair16(rowp - (size_t)16 * D + bj * 128, rowp + bj * 128, fq, wprev[bj], w);
                }
                asm volatile("" ::: "memory");
            }
    }
};
}


#define XB_TMO      128
#define XB_XCNT(j)  (256  + 64 * (j))
#define XB_XSUB(j)  (1280 + 64 * (j))
#define XB_XGEN(j)  (2304 + 64 * (j))
#define XB_TOP      3328
#define XB_TOPGEN   3392
#define XCD_BAR_WORDS 3456
#define XB_SPIN_CAP (1u << 21)
__device__ __forceinline__ unsigned xb_ld(unsigned* p)              { return __hip_atomic_load(p, __ATOMIC_RELAXED, __HIP_MEMORY_SCOPE_AGENT); }
__device__ __forceinline__ unsigned xb_add(unsigned* p, unsigned v) { return __hip_atomic_fetch_add(p, v, __ATOMIC_RELAXED, __HIP_MEMORY_SCOPE_AGENT); }
__device__ __forceinline__ unsigned xb_xcc_id() { return (unsigned)__builtin_amdgcn_s_getreg((3 << 11) | 20) & 0xFu; }
#define XB_SPIN(cond, bar) do { unsigned _sp = 0; while (cond) { __builtin_amdgcn_s_sleep(1); \
    if ((++_sp & 255u) == 0u) { if (xb_ld(&(bar)[XB_TMO])) break; if (_sp > XB_SPIN_CAP) { atomicAdd(&(bar)[XB_TMO], 1u); break; } } } } while (0)
struct XcdBarrier { unsigned* bar; unsigned x; volatile LAS unsigned* st; };
__device__ __forceinline__ XcdBarrier xcd_barrier_post(unsigned* bar, volatile LAS unsigned* st) {
    XcdBarrier b; b.bar = bar; b.x = xb_xcc_id(); b.st = st;
    if (threadIdx.x == 0) (void)xb_add(&bar[XB_XCNT(b.x)], 1u);
    return b;
}
__device__ __forceinline__ void xcd_barrier_complete(unsigned* bar, unsigned x, unsigned& nloc, unsigned& nx) {
    const unsigned G = gridDim.x * gridDim.y * gridDim.z;
    unsigned sum, cnt, mine, sp = 0u;
    for (;;) {
        sum = 0u; cnt = 0u; mine = 0u;
#pragma unroll
        for (unsigned j = 0; j < 16; ++j) { const unsigned c = xb_ld(&bar[XB_XCNT(j)]); sum += c; cnt += (c > 0u) ? 1u : 0u; mine = (j == x) ? c : mine; }
        if (sum == G) break;
        __builtin_amdgcn_s_sleep(1);
        if ((++sp & 255u) == 0u) { if (xb_ld(&bar[XB_TMO])) break; if (sp > XB_SPIN_CAP) { atomicAdd(&bar[XB_TMO], 1u); break; } }
    }
    nloc = mine > 0u ? mine : 1u; nx = cnt > 0u ? cnt : 1u;
}
__device__ __forceinline__ void xcd_barrier(const XcdBarrier& b) {
    asm volatile("s_waitcnt vmcnt(0)" ::: "memory");
    __syncthreads();
    if (threadIdx.x == 0) {
        unsigned* bar = b.bar;
        __builtin_amdgcn_s_waitcnt(0);
        unsigned nloc = b.st[0], nx = b.st[1];
        if (nloc == 0u) { xcd_barrier_complete(bar, b.x, nloc, nx); b.st[0] = nloc; b.st[1] = nx; }
        const unsigned old = xb_add(&bar[XB_XSUB(b.x)], 1u);
        const unsigned gen = old / nloc;
        if (old + 1u == (gen + 1u) * nloc) {
            __builtin_amdgcn_fence(__ATOMIC_RELEASE, "agent");
            asm volatile("s_waitcnt vmcnt(0)" ::: "memory");
            const unsigned og = xb_add(&bar[XB_TOP], 1u);
            const unsigned tg = og / nx;
            if (og + 1u == (tg + 1u) * nx) xb_add(&bar[XB_TOPGEN], 1u);
            else XB_SPIN(xb_ld(&bar[XB_TOPGEN]) == tg, bar);
            __builtin_amdgcn_fence(__ATOMIC_ACQUIRE, "agent");
            xb_add(&bar[XB_XGEN(b.x)], 1u);
            asm volatile("s_waitcnt vmcnt(0)" ::: "memory");
        } else {
            XB_SPIN(xb_ld(&bar[XB_XGEN(b.x)]) == gen, bar);
            __builtin_amdgcn_fence(__ATOMIC_ACQUIRE, "agent");
            asm volatile("s_waitcnt vmcnt(0)" ::: "memory");
        }
    }
    __syncthreads();
}

struct Ctx {
    LAS unsigned char* lds; int tid, lane, wave, G, bx;
    const float* const* in; float* out; unsigned char* ws;
};
#define LDS_WAIT() asm volatile("s_waitcnt lgkmcnt(0)" ::: "memory")

struct TDesc { const float* src; unsigned char* dst; int N, K, k0, n0, kind, f8; };
__device__ __forceinline__ void t64_load(const TDesc& d, float (&v)[64], int lane) {
    const float* src = d.src + (size_t)d.k0 * d.N + d.n0 + lane;
#pragma unroll
    for (int kk = 0; kk < 64; ++kk) v[kk] = src[(size_t)kk * d.N];
}
__device__ __forceinline__ void t64_finish(const TDesc& d, const float (&v)[64], LAS unsigned char* scr, int lane) {
    if (d.f8) {
        LAS unsigned char* wp = scr + lane * 80;
#pragma unroll
        for (int q = 0; q < 4; ++q) { u32x4 o;
            o.x = pk4_fp8(64.f * v[16 * q + 0], 64.f * v[16 * q + 1], 64.f * v[16 * q + 2], 64.f * v[16 * q + 3]);
            o.y = pk4_fp8(64.f * v[16 * q + 4], 64.f * v[16 * q + 5], 64.f * v[16 * q + 6], 64.f * v[16 * q + 7]);
            o.z = pk4_fp8(64.f * v[16 * q + 8], 64.f * v[16 * q + 9], 64.f * v[16 * q + 10], 64.f * v[16 * q + 11]);
            o.w = pk4_fp8(64.f * v[16 * q + 12], 64.f * v[16 * q + 13], 64.f * v[16 * q + 14], 64.f * v[16 * q + 15]);
            *(LAS u32x4*)(wp + q * 16) = o; }
        LDS_WAIT(); asm volatile("" ::: "memory");
        const int c = lane & 3;
#pragma unroll
        for (int j = 0; j < 4; ++j) { const int nl = (lane >> 2) + 16 * j; const u32x4 o = *(const LAS u32x4*)(scr + nl * 80 + c * 16);
            const int n = d.n0 + nl; int dr = n;
            if (d.kind == 1) { dr = (n < 1024) ? ((n >> 7) * 256 + (n & 127)) : (((n - 1024) >> 7) * 256 + 128 + (n & 127)); }
            *(u32x4*)(d.dst + (size_t)dr * d.K + d.k0 + c * 16) = o; }
    } else {
        LAS unsigned char* wp = scr + lane * 144;
#pragma unroll
        for (int q = 0; q < 8; ++q) { u32x4 o;
            o.x = cvt_pk_bf16(v[8 * q + 0], v[8 * q + 1]); o.y = cvt_pk_bf16(v[8 * q + 2], v[8 * q + 3]); o.z = cvt_pk_bf16(v[8 * q + 4], v[8 * q + 5]); o.w = cvt_pk_bf16(v[8 * q + 6], v[8 * q + 7]);
            *(LAS u32x4*)(wp + q * 16) = o; }
        LDS_WAIT(); asm volatile("" ::: "memory");
        const int c = lane & 7;
#pragma unroll
        for (int j = 0; j < 8; ++j) { const int nl = (lane >> 3) + 8 * j; const u32x4 o = *(const LAS u32x4*)(scr + nl * 144 + c * 16);
            *(u32x4*)(d.dst + ((size_t)(d.n0 + nl) * d.K + d.k0) * 2 + c * 16) = o; }
    }
    LDS_WAIT(); asm volatile("" ::: "memory");
}
__device__ __forceinline__ TDesc t64_decode(const float* const* in, unsigned char* ws, int it) {
    TDesc d; int r = it, item, nblk;
    if (r < 32768) { const int m = r >> 9; item = r & 511; d.src = in[23] + (size_t)m * 1024 * 2048; d.dst = ws + WS_WGU + (size_t)m * 2048 * 1024; d.N = 2048; d.K = 1024; d.kind = 1; d.f8 = 1; }
    else if ((r -= 32768) < 16384) { const int m = r >> 8; item = r & 255; d.src = in[25] + (size_t)m * 1024 * 1024; d.dst = ws + WS_WDN + (size_t)m * 1024 * 1024; d.N = 1024; d.K = 1024; d.kind = 0; d.f8 = 1; }
    else if ((r -= 16384) < 2176) { const int m = r / 1088; item = r % 1088; d.src = in[12] + (size_t)m * 1024 * INW; d.dst = ws + WS_WIN + (size_t)m * INW * 1024 * 2; d.N = INW; d.K = 1024; d.kind = 0; d.f8 = 0; }
    else if ((r -= 2176) < 2176) { const int m = r / 1088; item = r % 1088; d.src = in[12] + (size_t)m * 1024 * INW; d.dst = ws + WS_WIN8 + (size_t)m * INW * 1024; d.N = INW; d.K = 1024; d.kind = 0; d.f8 = 1; }
    else if ((r -= 2176) < 512) { const int m = r >> 8; item = r & 255; d.src = in[18] + (size_t)m * 1024 * 1024; d.dst = ws + WS_WO + (size_t)m * 1024 * 1024; d.N = 1024; d.K = 1024; d.kind = 0; d.f8 = 1; }
    else if ((r -= 512) < 256) { const int m = r >> 7; item = r & 127; d.src = in[16] + (size_t)m * 512 * 1024; d.dst = ws + WS_WOA + (size_t)m * 1024 * 512; d.N = 1024; d.K = 512; d.kind = 0; d.f8 = 1; }
    else { r -= 256; const int m = r >> 7; item = r & 127; d.src = in[17] + (size_t)m * 512 * 1024; d.dst = ws + WS_WOB + (size_t)m * 1024 * 512; d.N = 1024; d.K = 512; d.kind = 0; d.f8 = 1; }
    nblk = d.N >> 6; const int kb = item / nblk; d.k0 = kb * 64; d.n0 = (item - kb * nblk) * 64;
    return d;
}

__device__ __forceinline__ int rel_bucket(int rel) {
    const int n = rel < 0 ? -rel : rel;
    int v;
    if (n < 8) v = n;
    else { const float nf = (float)n; int large = 8 + (int)(logf(nf / 8.0f) / 2.7725887298583984f * 8.0f); v = large < 15 ? large : 15; }
    return (rel > 0 ? 16 : 0) + v;
}

__device__ __forceinline__ void phase0a(Ctx& F) {
    LAS float* scr = (LAS float*)(F.lds + F.wave * 16384);
    const int gw = F.bx * NWAVES + F.wave, NGW = F.G * NWAVES;
    unsigned char* ws = F.ws;
    {
        float* modp = (float*)(ws + WS_MODP);
        for (int it = gw; it < 2 * 96 * 8; it += NGW) {
            const int kc = it & 7, cgp = (it >> 3) % 96, l = it / (8 * 96), k0 = kc * 128, n0 = cgp * 64;
#pragma unroll 4
            for (int j = 0; j < 32; ++j) { const int idx = F.lane + 64 * j, r = idx >> 7, kk = idx & 127;
                const float c = r < 8 ? F.in[2][r * 1024 + k0 + kk] : F.in[3][(r - 8) * 1024 + k0 + kk];
                scr[kk * 16 + r] = c * sigmoidf_(c); }
            LDS_WAIT(); asm volatile("" ::: "memory");
            float a[16];
#pragma unroll
            for (int r = 0; r < 16; ++r) a[r] = 0.f;
            const float* wp = F.in[10] + ((size_t)l * 1024 + k0) * 6144 + n0 + F.lane;
#pragma unroll 16
            for (int kk = 0; kk < 128; ++kk) {
                const float w = wp[(size_t)kk * 6144];
                const LAS f32x4* sp = (const LAS f32x4*)(scr + kk * 16);
                const f32x4 s0 = sp[0], s1 = sp[1], s2 = sp[2], s3 = sp[3];
                a[0] += s0[0] * w; a[1] += s0[1] * w; a[2] += s0[2] * w; a[3] += s0[3] * w;
                a[4] += s1[0] * w; a[5] += s1[1] * w; a[6] += s1[2] * w; a[7] += s1[3] * w;
                a[8] += s2[0] * w; a[9] += s2[1] * w; a[10] += s2[2] * w; a[11] += s2[3] * w;
                a[12] += s3[0] * w; a[13] += s3[1] * w; a[14] += s3[2] * w; a[15] += s3[3] * w;
            }
            const float bb = (kc == 0) ? F.in[11][l * 6144 + n0 + F.lane] : 0.f;
#pragma unroll
            for (int r = 0; r < 16; ++r) modp[(size_t)kc * (2 * 16 * 6144) + ((size_t)(l * 16 + r)) * 6144 + n0 + F.lane] = a[r] + bb;
            LDS_WAIT(); asm volatile("" ::: "memory");
        }
    }
    if (F.bx == 0) {
        float* bt = (float*)(ws + WS_BIAS);
        for (int i = F.tid; i < 8 * 256; i += NTHREADS) { const int h = i >> 8, ri = i & 255; const int rel = ri - 191;
            bt[i] = (ri < 255) ? F.in[7][rel_bucket(rel) * 8 + h] : 0.f; }
    }
    for (int i = F.bx * NTHREADS + F.tid; i < 2 * 8 * 64 * 128; i += F.G * NTHREADS) {
        const int lb = i >> 13, rem = i & 8191;
        F.out[OKS + (size_t)lb * 16384 + rem] = F.in[4][(size_t)lb * 16384 + 8192 + rem];
        F.out[OVS + (size_t)lb * 16384 + rem] = F.in[5][(size_t)lb * 16384 + 8192 + rem];
    }
    LAS unsigned char* scrb = F.lds + F.wave * 16384;
    constexpr int NITEMS = 32768 + 16384 + 2176 + 2176 + 512 + 256 + 256;
    {
        float va[64], vb[64]; TDesc da, db;
        int it = gw;
        if (it < NITEMS) { da = t64_decode(F.in, ws, it); t64_load(da, va, F.lane); }
        while (it < NITEMS) {
            int itn = it + NGW;
            if (itn < NITEMS) { db = t64_decode(F.in, ws, itn); t64_load(db, vb, F.lane); }
            t64_finish(da, va, scrb, F.lane);
            it = itn; if (it >= NITEMS) break;
            itn = it + NGW;
            if (itn < NITEMS) { da = t64_decode(F.in, ws, itn); t64_load(da, va, F.lane); }
            t64_finish(db, vb, scrb, F.lane);
            it = itn;
        }
    }
}

__device__ __forceinline__ void ln_row(f32x4 (&v)[4], const float* g, const float* b, int lane) {
    float s = 0.f;
#pragma unroll
    for (int j = 0; j < 4; ++j) s += (v[j][0] + v[j][1]) + (v[j][2] + v[j][3]);
    const float mean = wave_sum(s) * (1.0f / D); float s2 = 0.f;
#pragma unroll
    for (int j = 0; j < 4; ++j) { v[j] = v[j] - mean; s2 += (v[j][0] * v[j][0] + v[j][1] * v[j][1]) + (v[j][2] * v[j][2] + v[j][3] * v[j][3]); }
    const float rstd = 1.0f / sqrtf(wave_sum(s2) * (1.0f / D) + LN_EPS);
#pragma unroll
    for (int j = 0; j < 4; ++j) { const f32x4 gg = *(const f32x4*)(g + 4 * lane + 256 * j), bb = *(const f32x4*)(b + 4 * lane + 256 * j); v[j] = v[j] * rstd * gg + bb; }
}
__device__ __forceinline__ void store_mod_row(const f32x4 (&v)[4], const float* sh, const float* sc, bf16_t* hrow, unsigned char* h8row, int lane) {
#pragma unroll
    for (int j = 0; j < 4; ++j) { const f32x4 a = *(const f32x4*)(sc + 4 * lane + 256 * j), b = *(const f32x4*)(sh + 4 * lane + 256 * j);
        const f32x4 h = v[j] * (a + 1.0f) + b; u32x2 w; w.x = cvt_pk_bf16(h[0], h[1]); w.y = cvt_pk_bf16(h[2], h[3]);
        *(u32x2*)(hrow + 4 * lane + 256 * j) = w;
        *(unsigned*)(h8row + 4 * lane + 256 * j) = pk4_fp8(h[0], h[1], h[2], h[3]); }
}

__device__ __forceinline__ void phase0b(Ctx& F) {
    const int gw = F.bx * NWAVES + F.wave, NGW = F.G * NWAVES;
    const float* mod = (const float*)(F.ws + WS_MOD);
    bf16_t* H = (bf16_t*)(F.ws + WS_H);
    for (int row = gw; row < NT; row += NGW) {
        const float* xr = row < NPROMPT ? F.in[0] + (size_t)row * D : F.in[1] + (size_t)(row - NPROMPT) * D;
        f32x4 v[4];
#pragma unroll
        for (int j = 0; j < 4; ++j) v[j] = *(const f32x4*)(xr + 4 * F.lane + 256 * j);
        ln_row(v, F.in[8], F.in[9], F.lane);
#pragma unroll
        for (int j = 0; j < 4; ++j) { u32x2 w; w.x = cvt_pk_bf16(v[j][0], v[j][1]); w.y = cvt_pk_bf16(v[j][2], v[j][3]); *(u32x2*)((bf16_t*)(F.ws + WS_XB) + (size_t)row * D + 4 * F.lane + 256 * j) = w; }
        const float* mb = mod + (size_t)batch_of(row) * 6144;
        store_mod_row(v, mb, mb + 1024, H + (size_t)row * D, F.ws + WS_H8 + (size_t)row * D, F.lane);
    }
}

__device__ __forceinline__ void phase_attn(Ctx& F, int l) {
    const bf16_t* Z = (const bf16_t*)(F.ws + WS_Z);
    unsigned char* YA = F.ws + WS_YA;
    unsigned char* YB = F.ws + WS_YB;
    const float* biasr = (const float*)(F.ws + WS_BIAS);
    LAS unsigned char* Ks = F.lds;
    LAS unsigned char* Vt = F.lds + 27648;
    LAS float* bt = (LAS float*)(F.lds + 53248);
    const int lane = F.lane, tid = F.tid;
    int bt_kv = -1;
    for (int au = F.bx; au < 1040; au += F.G) {
        const bool isS = au >= 1024;
        const int kv = au & 1;
        const int b = isS ? ((au - 1024) >> 1) : (au >> 7);
        const int n = isS ? 0 : ((au & 127) >> 1);
        __syncthreads();
        if (kv != bt_kv) { for (int i = tid; i < 1024; i += NTHREADS) bt[i] = biasr[(kv * 4 + (i >> 8)) * 256 + (i & 255)]; bt_kv = kv; }
#pragma unroll
        for (int jj = 0; jj < 3; ++jj) {
            const int p = tid + NTHREADS * jj, key = p >> 3, ds = p & 7;
            u32x4 kq = (u32x4){0u, 0u, 0u, 0u}, vq = (u32x4){0u, 0u, 0u, 0u};
            if (!isS) {
                const int t = n * 64 + key - 128;
                if (t >= 0) { const bf16_t* zr = Z + (size_t)(b * 4096 + t) * INW + kv * 64 + ds * 8; kq = *(const u32x4*)(zr + 512); vq = *(const u32x4*)(zr + 640); }
            } else if (key < 128) {
                const size_t o = ((size_t)((l * 8 + b) * 128 + key) * 2 + kv) * 64 + ds * 8;
                const f32x4 k0 = *(const f32x4*)(F.in[4] + o), k1 = *(const f32x4*)(F.in[4] + o + 4), v0 = *(const f32x4*)(F.in[5] + o), v1 = *(const f32x4*)(F.in[5] + o + 4);
                kq.x = cvt_pk_bf16(k0[0], k0[1]); kq.y = cvt_pk_bf16(k0[2], k0[3]); kq.z = cvt_pk_bf16(k1[0], k1[1]); kq.w = cvt_pk_bf16(k1[2], k1[3]);
                vq.x = cvt_pk_bf16(v0[0], v0[1]); vq.y = cvt_pk_bf16(v0[2], v0[3]); vq.z = cvt_pk_bf16(v1[0], v1[1]); vq.w = cvt_pk_bf16(v1[2], v1[3]);
            } else {
                const bf16_t* zr = Z + (size_t)(NPROMPT + b * 64 + key - 128) * INW + kv * 64 + ds * 8; kq = *(const u32x4*)(zr + 512); vq = *(const u32x4*)(zr + 640);
            }
            *(LAS u32x4*)(Ks + key * 144 + ds * 16) = kq;
            LAS unsigned short* vp = (LAS unsigned short*)Vt + (ds * 8) * 200 + key;
            vp[0 * 200] = (unsigned short)(vq.x & 0xffffu); vp[1 * 200] = (unsigned short)(vq.x >> 16);
            vp[2 * 200] = (unsigned short)(vq.y & 0xffffu); vp[3 * 200] = (unsigned short)(vq.y >> 16);
            vp[4 * 200] = (unsigned short)(vq.z & 0xffffu); vp[5 * 200] = (unsigned short)(vq.z >> 16);
            vp[6 * 200] = (unsigned short)(vq.w & 0xffffu); vp[7 * 200] = (unsigned short)(vq.w >> 16);
        }
        __syncthreads();
        const int g = F.wave >> 1, qi = (F.wave & 1) * 32 + (lane & 31), hh = lane >> 5, head = kv * 4 + g;
        const int qrow = isS ? NPROMPT + b * 64 + qi : b * 4096 + n * 64 + qi;
        bf16x8 Qf[4];
#pragma unroll
        for (int ks = 0; ks < 4; ++ks) Qf[ks] = *(const bf16x8*)(Z + (size_t)qrow * INW + head * 64 + ks * 16 + hh * 8);
        f32x16 S[6];
#pragma unroll
        for (int kb = 0; kb < 6; ++kb) {
#pragma unroll
            for (int j = 0; j < 16; ++j) S[kb][j] = 0.f;
#pragma unroll
            for (int ks = 0; ks < 4; ++ks) {
                const bf16x8 A = *(const LAS bf16x8*)(Ks + (kb * 32 + (lane & 31)) * 144 + (ks * 16 + hh * 8) * 2);
                S[kb] = __builtin_amdgcn_mfma_f32_32x32x16_bf16(A, Qf[ks], S[kb], 0, 0, 0);
            }
        }
        const float sinkv = F.in[14][l * 8 + head];
        float mx = sinkv;
        const int kmin = isS ? 0 : (128 - n * 64);
#pragma unroll
        for (int kb = 0; kb < 6; ++kb)
#pragma unroll
            for (int j = 0; j < 16; ++j) {
                const int key = kb * 32 + 8 * (j >> 2) + 4 * hh + (j & 3);
                float sv = S[kb][j] * 0.125f + bt[g * 256 + key - qi + 63];
                sv = key >= kmin ? sv : -1e30f;
                S[kb][j] = sv; mx = fmaxf(mx, sv);
            }
        mx = fmaxf(mx, __shfl_xor(mx, 32));
        float sum = 0.f;
#pragma unroll
        for (int kb = 0; kb < 6; ++kb)
#pragma unroll
            for (int j = 0; j < 16; ++j) { const float p = __expf(S[kb][j] - mx); S[kb][j] = p; sum += p; }
        sum += __shfl_xor(sum, 32);
        sum += __expf(sinkv - mx);
        const float inv = 1.0f / sum;
        f32x16 O[2];
#pragma unroll
        for (int db = 0; db < 2; ++db)
#pragma unroll
            for (int j = 0; j < 16; ++j) O[db][j] = 0.f;
#pragma unroll
        for (int kb = 0; kb < 6; ++kb)
#pragma unroll
            for (int s2 = 0; s2 < 2; ++s2) {
                union { bf16x8 v; unsigned u[4]; } P;
#pragma unroll
                for (int q = 0; q < 4; ++q) P.u[q] = cvt_pk_bf16(S[kb][8 * s2 + 2 * q], S[kb][8 * s2 + 2 * q + 1]);
#pragma unroll
                for (int db = 0; db < 2; ++db) {
                    const LAS unsigned char* vb = Vt + (db * 32 + (lane & 31)) * 400 + (kb * 32 + 16 * s2 + 4 * hh) * 2;
                    union { bf16x8 v; u32x2 h[2]; } Vf;
                    Vf.h[0] = *(const LAS u32x2*)vb; Vf.h[1] = *(const LAS u32x2*)(vb + 16);
                    O[db] = __builtin_amdgcn_mfma_f32_32x32x16_bf16(Vf.v, P.v, O[db], 0, 0, 0);
                }
            }
        unsigned char* orow = YA + (size_t)qrow * 512 + head * 64 + 4 * hh; const float inv8 = inv * 8.0f;
#pragma unroll
        for (int db = 0; db < 2; ++db)
#pragma unroll
            for (int jq = 0; jq < 4; ++jq) {
                *(unsigned*)(orow + db * 32 + 8 * jq) = pk4_fp8(O[db][4 * jq] * inv8, O[db][4 * jq + 1] * inv8, O[db][4 * jq + 2] * inv8, O[db][4 * jq + 3] * inv8);
            }
    }
    int nxtra = 1040 % F.G; if (1040 < F.G || 2 * nxtra > F.G) nxtra = 0;
    if (F.bx < nxtra) return;
    const int gw = (F.bx - nxtra) * NWAVES + F.wave, NGW = (F.G - nxtra) * NWAVES;
    const float* cw = F.in[15] + (size_t)l * 3 * 512 + 8 * lane;
    float w0[8], w1[8], w2[8];
#pragma unroll
    for (int e = 0; e < 8; ++e) { w0[e] = cw[e]; w1[e] = cw[512 + e]; w2[e] = cw[1024 + e]; }
    for (int row = gw; row < NT; row += NGW) {
        const bool isS = row >= NPROMPT; const int b = isS ? ((row - NPROMPT) >> 6) : (row >> 12), t = isS ? ((row - NPROMPT) & 63) : (row & 4095);
        const bf16_t* zr = Z + (size_t)row * INW + 8 * lane;
        const u32x4 cb = *(const u32x4*)(zr + 768);
        float u[3][8];
#pragma unroll
        for (int d = 0; d < 3; ++d) {
            if (t - d >= 0) {
                const bf16_t* zz = zr - (size_t)d * INW; const u32x4 cc = *(const u32x4*)(zz + 1280), cx = *(const u32x4*)(zz + 1792);
                u[d][0] = bf_lo(cc.x) * bf_lo(cx.x); u[d][1] = bf_hi(cc.x) * bf_hi(cx.x); u[d][2] = bf_lo(cc.y) * bf_lo(cx.y); u[d][3] = bf_hi(cc.y) * bf_hi(cx.y);
                u[d][4] = bf_lo(cc.z) * bf_lo(cx.z); u[d][5] = bf_hi(cc.z) * bf_hi(cx.z); u[d][6] = bf_lo(cc.w) * bf_lo(cx.w); u[d][7] = bf_hi(cc.w) * bf_hi(cx.w);
            } else if (isS) {
                const float* hp = F.in[6] + ((size_t)(l * 8 + b) * 2 + (2 + t - d)) * 512 + 8 * lane;
                const f32x4 h0 = *(const f32x4*)hp, h1 = *(const f32x4*)(hp + 4);
#pragma unroll
                for (int e = 0; e < 4; ++e) { u[d][e] = h0[e]; u[d][4 + e] = h1[e]; }
            } else {
#pragma unroll
                for (int e = 0; e < 8; ++e) u[d][e] = 0.f;
            }
        }
        const float cbf[8] = {bf_lo(cb.x), bf_hi(cb.x), bf_lo(cb.y), bf_hi(cb.y), bf_lo(cb.z), bf_hi(cb.z), bf_lo(cb.w), bf_hi(cb.w)};
        float y[8];
#pragma unroll
        for (int e = 0; e < 8; ++e) y[e] = cbf[e] * (w0[e] * u[2][e] + w1[e] * u[1][e] + w2[e] * u[0][e]);
        u32x2 w; w.x = pk4_fp8(y[0], y[1], y[2], y[3]); w.y = pk4_fp8(y[4], y[5], y[6], y[7]);
        *(u32x2*)(YB + (size_t)row * 512 + 8 * lane) = w;
        const int tl = isS ? 62 : 4094;
        if (t >= tl) {
            float* o = F.out + (isS ? OCS : OCP) + ((size_t)(l * 8 + b) * 2 + (t - tl)) * 512 + 8 * lane;
            *(f32x4*)o = (f32x4){u[0][0], u[0][1], u[0][2], u[0][3]}; *(f32x4*)(o + 4) = (f32x4){u[0][4], u[0][5], u[0][6], u[0][7]};
        }
    }
}

__device__ __forceinline__ void phase_ln_router(Ctx& F, int l) {
    bf16_t* XB = (bf16_t*)(F.ws + WS_XB); unsigned char* H8 = (unsigned char*)(F.ws + WS_H8); const bf16_t* V16 = (const bf16_t*)(F.ws + WS_V16);
    const float* mod = (const float*)(F.ws + WS_MOD) + (size_t)l * 16 * 6144;
    unsigned* cnt = (unsigned*)(F.ws + WS_CNT) + l * 2048;
    unsigned* tok = (unsigned*)(F.ws + WS_TOK); float* gate = (float*)(F.ws + WS_GATE); unsigned* slot = (unsigned*)(F.ws + WS_SLOT);
    const float* Wr = F.in[21] + (size_t)l * 1024 * 32;
    LAS float* hf = (LAS float*)F.lds;
    LAS unsigned* hist = (LAS unsigned*)(F.lds + 146432); LAS unsigned* hbase = hist + 32;
    LAS u32x4* rec = (LAS u32x4*)(F.lds + 131328);
    int nrec_tiles = 0;
    __syncthreads();
    if (F.tid < 32) hist[F.tid] = 0u;
    const int lane = F.lane, w = F.wave;
    float breg[64];
    { const float* bp = Wr + (size_t)(128 * w) * 32 + lane;
#pragma unroll
      for (int s = 0; s < 64; ++s) breg[s] = bp[64 * s]; }
    for (int tidx = F.bx; tidx < 1024 + 256; tidx += F.G) {
        const int tile0 = tidx < 1024 ? tidx * 32 : NPROMPT + (tidx - 1024) * 2, nrows = tidx < 1024 ? 32 : 2;
        __syncthreads();
        if (w * 4 < nrows) {
            u32x2 pv[4][4];
#pragma unroll
            for (int rr = 0; rr < 4; ++rr) { const int rl = w * 4 + rr, row = rl < nrows ? tile0 + rl : tile0;
#pragma unroll
                for (int j = 0; j < 4; ++j) pv[rr][j] = *(const u32x2*)(V16 + (size_t)row * D + 4 * lane + 256 * j); }
#pragma unroll
            for (int rr = 0; rr < 4; ++rr) {
                const int rl = w * 4 + rr, row = tile0 + rl;
                if (rl < nrows) {
                    f32x4 v[4];
#pragma unroll
                    for (int j = 0; j < 4; ++j) v[j] = (f32x4){bf_lo(pv[rr][j].x), bf_hi(pv[rr][j].x), bf_lo(pv[rr][j].y), bf_hi(pv[rr][j].y)};
                    ln_row(v, F.in[19] + l * D, F.in[20] + l * D, lane);
#pragma unroll
                    for (int j = 0; j < 4; ++j) { u32x2 wq; wq.x = cvt_pk_bf16(v[j][0], v[j][1]); wq.y = cvt_pk_bf16(v[j][2], v[j][3]); *(u32x2*)(XB + (size_t)row * D + 4 * lane + 256 * j) = wq; }
                    const float* mb = mod + (size_t)batch_of(row) * 6144;
#pragma unroll
                    for (int j = 0; j < 4; ++j) { const f32x4 a = *(const f32x4*)(mb + 4096 + 4 * lane + 256 * j), b = *(const f32x4*)(mb + 3072 + 4 * lane + 256 * j);
                        const f32x4 h = v[j] * (a + 1.0f) + b;
                        *(unsigned*)(H8 + (size_t)row * D + 4 * lane + 256 * j) = pk4_fp8(h[0], h[1], h[2], h[3]);
                        LAS float* hp = hf + rl * 1025 + lane + 64 * j;
                        hp[0] = h[0]; hp[256] = h[1]; hp[512] = h[2]; hp[768] = h[3]; }
                }
            }
        }
        __syncthreads();
        f32x16 acc;
#pragma unroll
        for (int j = 0; j < 16; ++j) acc[j] = 0.f;
        {
            const LAS float* ap = hf + (lane & 31) * 1025 + 32 * w;
            const int hh = lane >> 5;
#pragma unroll
            for (int s = 0; s < 64; ++s) { const int kk = 2 * s + hh; acc = __builtin_amdgcn_mfma_f32_32x32x2f32(ap[(kk & 3) * 256 + (kk >> 2)], breg[s], acc, 0, 0, 0); }
        }
        __syncthreads();
        LAS float* red = hf;
#pragma unroll
        for (int j = 0; j < 16; ++j) red[(w * 32 + 8 * (j >> 2) + 4 * (lane >> 5) + (j & 3)) * 33 + (lane & 31)] = acc[j];
        __syncthreads();
        int e_sel[4]; float g_sel[4]; unsigned loc[4];
#pragma unroll
        for (int rr = 0; rr < 4; ++rr) {
            const int tk = w * 4 + rr;
            float val = -INFINITY;
            if (lane < 32) { float sacc = F.in[22][l * 32 + lane];
#pragma unroll
                for (int ww = 0; ww < 8; ++ww) sacc += red[(ww * 32 + tk) * 33 + lane];
                val = sacc; }
            float tv[4]; int te[4];
            {
                const int vbits = __float_as_int(val); int rank = 0;
#pragma unroll
                for (int j = 0; j < 32; ++j) { const float vj = __int_as_float(__builtin_amdgcn_readlane(vbits, j)); rank += (vj > val || (vj == val && j < lane)) ? 1 : 0; }
#pragma unroll
                for (int it = 0; it < 4; ++it) { const unsigned long long mk = __ballot(rank == it); const int ln = mk ? (__ffsll((long long)mk) - 1) : 0;
                    te[it] = ln; tv[it] = __int_as_float(__builtin_amdgcn_readlane(vbits, ln)); }
            }
            const float e1 = __expf(tv[1] - tv[0]), e2 = __expf(tv[2] - tv[0]), e3 = __expf(tv[3] - tv[0]);
            const float rs = 1.0f / (1.0f + e1 + e2 + e3);
            e_sel[rr] = lane == 0 ? te[0] : lane == 1 ? te[1] : lane == 2 ? te[2] : te[3];
            g_sel[rr] = (lane == 0 ? 1.0f : lane == 1 ? e1 : lane == 2 ? e2 : e3) * rs;
            loc[rr] = 0u;
            if (lane < 4 && tk < nrows) loc[rr] = atomicAdd((unsigned*)&hist[e_sel[rr]], 1u);
        }
        if (lane < 4) {
#pragma unroll
            for (int rr = 0; rr < 4; ++rr) {
                const int rl = w * 4 + rr;
                u32x4 rc; rc.x = (rl < nrows) ? (unsigned)(tile0 + rl) : 0xffffffffu; rc.y = (unsigned)(e_sel[rr] & 31); rc.z = loc[rr]; rc.w = __float_as_uint(g_sel[rr]);
                rec[(nrec_tiles * 32 + rl) * 4 + lane] = rc;
            }
        }
        ++nrec_tiles;
    }
    __syncthreads();
    if (F.tid < 32) { const unsigned hcount = hist[F.tid]; hbase[F.tid] = hcount ? atomicAdd(cnt + F.tid * 64, hcount) : 0u; }
    __syncthreads();
    for (int i = F.tid; i < nrec_tiles * 128; i += NTHREADS) {
        const u32x4 rc = rec[i];
        if (rc.x != 0xffffffffu) { const unsigned e = rc.y, rank = hbase[e] + rc.z;
            tok[(size_t)e * NT + rank] = rc.x; gate[(size_t)e * NT + rank] = __uint_as_float(rc.w); slot[(size_t)rc.x * 4 + (i & 3)] = (e << 24) | rank; }
    }
}

__device__ __forceinline__ void build_blk(Ctx& F, int l) {
    LAS int* blk = (LAS int*)(F.lds + LDS_BLK);
    const unsigned* cnt = (const unsigned*)(F.ws + WS_CNT) + l * 2048;
    __syncthreads();
    if (F.tid == 0) { LAS int* cl = (LAS int*)(F.lds + LDS_CNT); int s = 0; for (int e = 0; e < 32; ++e) { const int ce = (int)cnt[e * 64]; cl[e] = ce; blk[e] = s; s += (ce + 255) >> 8; } blk[32] = s; }
    __syncthreads();
}

__device__ __forceinline__ void phase_combine(Ctx& F, int l) {
    const LAS int* blk = (const LAS int*)(F.lds + LDS_BLK);
    float* X = F.out; bf16_t* XB = (bf16_t*)(F.ws + WS_XB); bf16_t* H = (bf16_t*)(F.ws + WS_H); const unsigned char* YS = F.ws + WS_YS;
    const unsigned* slot = (const unsigned*)(F.ws + WS_SLOT);
    const float* mod = (const float*)(F.ws + WS_MOD);
    const int gw = F.bx * NWAVES + F.wave, NGW = F.G * NWAVES, lane = F.lane;
    for (int row = gw; row < NT; row += NGW) {
        f32x4 ff[4];
#pragma unroll
        for (int j = 0; j < 4; ++j) ff[j] = (f32x4){0.f, 0.f, 0.f, 0.f};
#pragma unroll
        for (int k = 0; k < 4; ++k) {
            const unsigned s = slot[(size_t)row * 4 + k]; const int e = (int)(s >> 24), rank = (int)(s & 0xffffffu);
            const unsigned char* yr = YS + ((size_t)blk[e] * 256 + rank) * D + 4 * lane;
#pragma unroll
            for (int j = 0; j < 4; ++j) { const unsigned wv = *(const unsigned*)(yr + 256 * j); const f32x2 lo = __builtin_amdgcn_cvt_pk_f32_fp8(wv, false), hi = __builtin_amdgcn_cvt_pk_f32_fp8(wv, true);
                ff[j][0] += lo.x; ff[j][1] += lo.y; ff[j][2] += hi.x; ff[j][3] += hi.y; }
        }
        const int bi = batch_of(row);
        const float* mb = mod + (size_t)(l * 16 + bi) * 6144;
        f32x4 v[4];
#pragma unroll
        for (int j = 0; j < 4; ++j) { const u32x2 xw = *(const u32x2*)(XB + (size_t)row * D + 4 * lane + 256 * j); const f32x4 x = (f32x4){bf_lo(xw.x), bf_hi(xw.x), bf_lo(xw.y), bf_hi(xw.y)}, g2 = *(const f32x4*)(mb + 5120 + 4 * lane + 256 * j);
            v[j] = x * ALPHA + (g2 + 1.0f) * (ff[j] * 0.0625f); }
        ln_row(v, F.in[27] + l * D, F.in[28] + l * D, lane);
#pragma unroll
        for (int j = 0; j < 4; ++j) { if (l == 0) { u32x2 w; w.x = cvt_pk_bf16(v[j][0], v[j][1]); w.y = cvt_pk_bf16(v[j][2], v[j][3]); *(u32x2*)(XB + (size_t)row * D + 4 * lane + 256 * j) = w; }
            else *(f32x4*)(X + (size_t)row * D + 4 * lane + 256 * j) = v[j]; }
        if (l == 0) { const float* mn = mod + (size_t)(16 + bi) * 6144; store_mod_row(v, mn, mn + 1024, H + (size_t)row * D, F.ws + WS_H8 + (size_t)row * D, lane); }
    }
}

#ifndef PH_MASK
#define PH_MASK 0xFFFF
#endif
#define PH(b) ((PH_MASK >> (b)) & 1)
#ifndef PROBE_MASK
#define PROBE_MASK 0
#endif
#define PB0(id) do { if ((PROBE_MASK >> (id)) & 1) pb_t0 = __builtin_amdgcn_s_memrealtime(); } while (0)
#define PB1(id) do { if ((PROBE_MASK >> (id)) & 1) pb_acc += __builtin_amdgcn_s_memrealtime() - pb_t0; } while (0)
#define RELOAD() do { int t_ = threadIdx.x; asm volatile("" : "+v"(t_)); F.tid = t_; F.lane = t_ & 63; F.wave = __builtin_amdgcn_readfirstlane(t_ >> 6); \
    unsigned z_; asm volatile("s_mov_b32 %0, 0" : "=s"(z_)); F.in = p.in; F.out = p.out + z_; F.ws = p.ws + z_; } while (0)
#define LAYER_BODY(l) do { \
          \
        PB0(2); RELOAD(); \
        if (PH(2)) { \
              \
            pg8::SchedDense S; S.init(NT, 7 * 256, D, F.G, F.bx, (const bf16_t*)(F.ws + WS_WIN) + (size_t)l * INW * D, 2); \
            pg8::EpiZ E{(bf16_t*)(F.ws + WS_Z), F.in[13] + l * INW, F.out, l, F.ws + WS_ZG8}; \
            pg8::gemm_phase<false, 0u>(F.lds, (const char*)(F.ws + WS_H), D, S, E); \
        } \
        RELOAD(); \
        if (PH(2)) { \
              \
            pg8::SchedDense S; S.init(NT, 10 * 256, 512, F.G, (F.G == 256) ? ((F.bx + 112) & 255) : F.bx, F.ws + WS_WIN8 + (size_t)l * INW * D, 0, 2, 7); \
            pg8::EpiZ E{(bf16_t*)(F.ws + WS_Z), F.in[13] + l * INW, F.out, l, F.ws + WS_ZG8}; \
            pg8::gemm_phase<true, 0x7f7f7f7fu>(F.lds, (const char*)(F.ws + WS_H8), 512, S, E); \
        } \
        xcd_barrier(xbar); PB1(2); PB0(3); \
        RELOAD(); \
        if (PH(3)) phase_attn(F, l); \
        xcd_barrier(xbar); PB1(3); PB0(4); \
          \
        RELOAD(); \
        if (PH(4)) { \
            pg8::SchedDense S; S.init(NT, D, 256, F.G, F.bx, F.ws + WS_WOA + (size_t)l * D * 512); \
            pg8::EpiT1 E{F.ws + WS_T1, F.ws + WS_ZG8}; \
            pg8::gemm_phase<true, 0x7c7c7c7cu>(F.lds, (const char*)(F.ws + WS_YA), 256, S, E); \
        } \
        RELOAD(); \
        if (PH(5)) { \
            pg8::SchedDense S; S.init(NT, D, 256, F.G, F.bx, F.ws + WS_WOB + (size_t)l * D * 512); \
            pg8::EpiMix E{F.ws + WS_T1, F.ws + WS_ZG8, F.ws + WS_MIX}; \
            pg8::gemm_phase<true, 0x7f7f7f7fu>(F.lds, (const char*)(F.ws + WS_YB), 256, S, E); \
        } \
        xcd_barrier(xbar); PB1(4); PB0(5); \
          \
        RELOAD(); \
        if (PH(6)) { \
            pg8::SchedDense S; S.init(NT, D, 512, F.G, F.bx, F.ws + WS_WO + (size_t)l * D * D); \
            pg8::EpiX E{(const bf16_t*)(F.ws + WS_XB), (bf16_t*)(F.ws + WS_V16), (const float*)(F.ws + WS_MOD) + (size_t)l * 16 * 6144}; \
            pg8::gemm_phase<true, 0x7f7f7f7fu>(F.lds, (const char*)(F.ws + WS_MIX), 512, S, E); \
        } \
        xcd_barrier(xbar); PB1(5); PB0(6); \
        RELOAD(); \
        if (PH(7)) phase_ln_router(F, l); \
        xcd_barrier(xbar); PB1(6); PB0(7); \
          \
        RELOAD(); \
        build_blk(F, l); \
        if (PH(8)) { \
            LAS int* blk = (LAS int*)(F.lds + LDS_BLK); \
            LAS unsigned short* idx = (LAS unsigned short*)(F.lds + LDS_IDX); \
            pg8::SchedMoE<true> S; S.init(blk, idx, 8, 512, F.G, F.bx, (const unsigned char*)(F.ws + WS_WGU) + (size_t)l * 32 * 2048 * D, (size_t)2048 * D); \
            const unsigned* cnt = (const unsigned*)(F.ws + WS_CNT) + l * 2048; const unsigned* tok = (const unsigned*)(F.ws + WS_TOK); \
            for (int i = 0; i < MAXU; ++i) { pg8::Unit u; if (!S.next(i, u)) break; \
                if (F.tid < 256) { int rank = (u.pm - blk[u.e]) * 256 + F.tid; const int ce = (int)cnt[u.e * 64]; rank = rank < ce ? rank : ce - 1; \
                    idx[i * 256 + F.tid] = (unsigned short)tok[(size_t)u.e * NT + rank]; } } \
            __syncthreads(); \
            pg8::EpiAct E{(unsigned char*)(F.ws + WS_ACT), F.in[24] + (size_t)l * 32 * 2048}; \
            pg8::gemm_phase<true, 0x7f7f7f7fu>(F.lds, (const char*)(F.ws + WS_H8), 512, S, E); \
        } \
        xcd_barrier(xbar); PB1(7); PB0(8); \
          \
        RELOAD(); \
        if (PH(9)) { \
            LAS int* blk = (LAS int*)(F.lds + LDS_BLK); \
            LAS unsigned short* idx = (LAS unsigned short*)(F.lds + LDS_IDX); \
            pg8::SchedMoE<false> S; S.init(blk, idx, 4, 512, F.G, F.bx, (const unsigned char*)(F.ws + WS_WDN) + (size_t)l * 32 * D * D, (size_t)D * D); \
            pg8::EpiYs E{F.ws + WS_YS, F.in[26] + (size_t)l * 32 * D, (const float*)(F.ws + WS_GATE), (const LAS int*)(F.lds + LDS_CNT), blk}; \
            pg8::gemm_phase<true, 0x7f7f7f7fu>(F.lds, (const char*)(F.ws + WS_ACT), 512, S, E); \
        } \
        xcd_barrier(xbar); PB1(8); PB0(9); \
        RELOAD(); \
        if (PH(10)) phase_combine(F, l); \
        if (l == 0) xcd_barrier(xbar); \
        PB1(9); \
 \
    } while (0)
__global__ void __launch_bounds__(NTHREADS, 2) fwd_megakernel(Params p) {
    extern __shared__ __attribute__((aligned(16))) unsigned char lds_raw[];
    cg::grid_group grid = cg::this_grid();
    Ctx F;
    F.lds = (LAS unsigned char*)lds_raw;
    F.G = gridDim.x; F.bx = blockIdx.x;
    volatile LAS unsigned* bst = (volatile LAS unsigned*)(F.lds + 147392);
    if (threadIdx.x < 2) bst[threadIdx.x] = 0u;
    __syncthreads();
    const XcdBarrier xbar = xcd_barrier_post((unsigned*)(p.ws + WS_BAR), bst);
    unsigned long long pb_t0 = 0, pb_acc = 0;
    PB0(0); RELOAD();
    if (PH(0)) phase0a(F);
    grid.sync();
    PB1(0); PB0(1); RELOAD();
    { const float* modp = (const float*)(F.ws + WS_MODP); float* mod = (float*)(F.ws + WS_MOD);
      for (int i = F.bx * NTHREADS + F.tid; i < 2 * 16 * 6144; i += F.G * NTHREADS) { float sm = 0.f;
#pragma unroll
          for (int kc = 0; kc < 8; ++kc) sm += modp[(size_t)kc * (2 * 16 * 6144) + i];
          mod[i] = sm; } }
    xcd_barrier(xbar);
    RELOAD();
    if (PH(1)) phase0b(F);
    xcd_barrier(xbar); PB1(1);

    LAYER_BODY(0);
    LAYER_BODY(1);
    if (PROBE_MASK != 0 && blockIdx.x == 0) { const unsigned long long te = __builtin_amdgcn_s_memrealtime(); while (__builtin_amdgcn_s_memrealtime() - te < pb_acc) __builtin_amdgcn_s_sleep(8); }
    (void)pb_t0; (void)pb_acc;
}

extern "C" void kernel_launch(void* const* d_in, const int* in_sizes, int n_in, void* d_out, int out_size, void* d_ws, size_t ws_size, hipStream_t stream) {
    static int grid = 0;
    if (grid == 0) {
        if (n_in != 29 || ws_size < WS_END) { fprintf(stderr, "kernel_launch: unexpected n_in %d / ws_size %zu (need %zu)\n", n_in, ws_size, (size_t)WS_END); grid = -1; return; }
        int dev = 0, cus = 0, per_cu = 0;
        hipGetDevice(&dev);
        hipDeviceGetAttribute(&cus, hipDeviceAttributeMultiprocessorCount, dev);
        if (hipFuncSetAttribute((const void*)fwd_megakernel, hipFuncAttributeMaxDynamicSharedMemorySize, LDS_BYTES) != hipSuccess) { fprintf(stderr, "kernel_launch: hipFuncSetAttribute failed\n"); grid = -1; return; }
        if (hipOccupancyMaxActiveBlocksPerMultiprocessor(&per_cu, (const void*)fwd_megakernel, NTHREADS, LDS_BYTES) != hipSuccess || per_cu < 1) { fprintf(stderr, "kernel_launch: occupancy query says %d blocks per CU\n", per_cu); per_cu = 1; }
        (void)hipGetLastError();
        grid = cus;
        if (grid != 256) fprintf(stderr, "kernel_launch: note: %d CUs (built for 256)\n", grid);
    }
    if (grid < 0) return;
    hipMemsetAsync((char*)d_ws, 0, WS_ZERO_BYTES, stream);
    Params p{};
    for (int i = 0; i < 29; ++i) p.in[i] = (const float*)d_in[i];
    p.out = (float*)d_out; p.ws = (unsigned char*)d_ws;
    void* args[] = {&p};
    hipError_t e = hipLaunchCooperativeKernel((const void*)fwd_megakernel, dim3(grid), dim3(NTHREADS), args, LDS_BYTES, stream);
    if (e != hipSuccess) fprintf(stderr, "kernel_launch: cooperative launch failed: %s (grid %d)\n", hipGetErrorString(e), grid);
}
```

```cpp
#include <hip/hip_runtime.h>
#include <hip/hip_cooperative_groups.h>
#include <cstdio>
#include <cstdint>
namespace cg = cooperative_groups;

#define LAS __attribute__((address_space(3)))
typedef unsigned short bf16_t;
typedef short bf16x8 __attribute__((ext_vector_type(8)));
typedef float f32x4 __attribute__((ext_vector_type(4)));
typedef float f32x16 __attribute__((ext_vector_type(16)));
typedef unsigned u32x4 __attribute__((ext_vector_type(4)));
typedef unsigned u32x2 __attribute__((ext_vector_type(2)));
typedef float f32x2 __attribute__((ext_vector_type(2)));
typedef int i32x4 __attribute__((ext_vector_type(4)));
typedef int i32x8 __attribute__((ext_vector_type(8)));

constexpr int D = 1024, NPROMPT = 32768, NT = 33280, INW = 4352, NEXP = 32;
constexpr float ALPHA = 1.41421356237f, LN_EPS = 1e-5f;
constexpr int NWAVES = 8, NTHREADS = 512;
constexpr int LDS_BYTES = 147456;
constexpr int LDS_BLK = 131072;
constexpr int LDS_IDX = 131072 + 256;
constexpr int MAXU = 20;
constexpr int LDS_BIASBUF = 141568;
constexpr int LDS_CNT = 145664;
constexpr size_t OKP = 34078720, OVP = 34340864, OCP = 34603008, OKS = 34619392, OVS = 34881536, OCS = 35143680;
constexpr size_t MiB = 1u << 20;
constexpr size_t WS_CNT = 0;
constexpr size_t WS_BAR = 16384;
constexpr size_t WS_MOD = 65536;
constexpr size_t WS_MODP = 192 * MiB;
constexpr size_t WS_ZERO_BYTES = 1 * MiB;
constexpr size_t WS_BIAS = 1 * MiB;
constexpr size_t WS_SLOT = 2 * MiB;
constexpr size_t WS_TOK = 3 * MiB;
constexpr size_t WS_GATE = 8 * MiB;
constexpr size_t WS_WIN = 16 * MiB;
constexpr size_t WS_WIN8 = 180 * MiB;
constexpr size_t WS_WOA = 34 * MiB;
constexpr size_t WS_WOB = 36 * MiB;
constexpr size_t WS_WO = 38 * MiB;
constexpr size_t WS_WGU = 48 * MiB;
constexpr size_t WS_WDN = 304 * MiB;
constexpr size_t WS_H = 432 * MiB;
constexpr size_t WS_H8 = 1600 * MiB;
constexpr size_t WS_Z = 498 * MiB;
constexpr size_t WS_YA = 776 * MiB;
constexpr size_t WS_YB = 810 * MiB;
constexpr size_t WS_T1 = 844 * MiB;
constexpr size_t WS_V16 = 910 * MiB;
constexpr size_t WS_XB = 1200 * MiB;
constexpr size_t WS_MIX = 976 * MiB;
constexpr size_t WS_ACT = 1042 * MiB;
constexpr size_t WS_YS = 1320 * MiB;
constexpr size_t WS_ZG8 = 1460 * MiB;
constexpr size_t WS_END = 1634 * MiB;

struct Params { const float* in[29]; float* out; unsigned char* ws; };

__device__ __forceinline__ unsigned cvt_pk_bf16(float lo, float hi) { unsigned r; asm volatile("v_cvt_pk_bf16_f32 %0, %1, %2" : "=v"(r) : "v"(lo), "v"(hi)); return r; }
__device__ __forceinline__ unsigned pk4_fp8(float a, float b, float c, float d) { unsigned w = 0u; w = __builtin_amdgcn_cvt_pk_fp8_f32(a, b, w, false); w = __builtin_amdgcn_cvt_pk_fp8_f32(c, d, w, true); return w; }
__device__ __forceinline__ void unpk8_fp8(const u32x2 w, float (&o)[8]) { const f32x2 a = __builtin_amdgcn_cvt_pk_f32_fp8(w.x, false), b = __builtin_amdgcn_cvt_pk_f32_fp8(w.x, true), c = __builtin_amdgcn_cvt_pk_f32_fp8(w.y, false), d = __builtin_amdgcn_cvt_pk_f32_fp8(w.y, true);
    o[0] = a.x; o[1] = a.y; o[2] = b.x; o[3] = b.y; o[4] = c.x; o[5] = c.y; o[6] = d.x; o[7] = d.y; }
__device__ __forceinline__ void store_pair16(unsigned char* pa, unsigned char* pb, int fq, u32x2 wa, u32x2 wb) {
    const auto rx = __builtin_amdgcn_permlane16_swap(wa.x, wb.x, false, false);
    const auto ry = __builtin_amdgcn_permlane16_swap(wa.y, wb.y, false, false);
    u32x4 o; o.x = rx[0]; o.y = ry[0]; o.z = rx[1]; o.w = ry[1];
    *(u32x4*)((fq & 1) ? pb - 8 : pa) = o;
}
__device__ __forceinline__ void load_pair16(const unsigned char* pa, const unsigned char* pb, int fq, u32x2& wa, u32x2& wb) {
    const u32x4 x = *(const u32x4*)((fq & 1) ? pb - 8 : pa);
    const auto rx = __builtin_amdgcn_permlane16_swap(x.x, x.z, false, false);
    const auto ry = __builtin_amdgcn_permlane16_swap(x.y, x.w, false, false);
    wa.x = rx[0]; wa.y = ry[0]; wb.x = rx[1]; wb.y = ry[1];
}
__device__ __forceinline__ float bf_lo(unsigned w) { return __uint_as_float(w << 16); }
__device__ __forceinline__ float bf_hi(unsigned w) { return __uint_as_float(w & 0xffff0000u); }
__device__ __forceinline__ float sigmoidf_(float x) { return __builtin_amdgcn_rcpf(1.0f + __expf(-x)); }
__device__ __forceinline__ f32x2 sigmoid2(f32x2 x) {
    const f32x2 t = x * (-1.44269504089f);
    f32x2 e; e.x = __builtin_amdgcn_exp2f(t.x); e.y = __builtin_amdgcn_exp2f(t.y);
    const f32x2 d = e + 1.0f;
    f32x2 r; r.x = __builtin_amdgcn_rcpf(d.x); r.y = __builtin_amdgcn_rcpf(d.y);
    return r;
}
__device__ __forceinline__ float wave_sum(float v) {
#define WS_DPP_ADD(ctrl) v += __int_as_float(__builtin_amdgcn_update_dpp(0, __float_as_int(v), (ctrl), 0xf, 0xf, true))
    WS_DPP_ADD(0xB1);
    WS_DPP_ADD(0x4E);
    WS_DPP_ADD(0x141);
    WS_DPP_ADD(0x140);
#undef WS_DPP_ADD
    const int b = __float_as_int(v);
    const float r0 = __int_as_float(__builtin_amdgcn_readlane(b, 0)), r1 = __int_as_float(__builtin_amdgcn_readlane(b, 16)), r2 = __int_as_float(__builtin_amdgcn_readlane(b, 32)), r3 = __int_as_float(__builtin_amdgcn_readlane(b, 48));
    return (r0 + r1) + (r2 + r3);
}
__device__ __forceinline__ int batch_of(int row) { return row < NPROMPT ? (row >> 12) : 8 + ((row - NPROMPT) >> 6); }

namespace pg8 {
constexpr int BM = 256, BK = 64, HALF = 128, HTB = HALF * BK * 2, NXCD = 8, WGM = 8;
__device__ __forceinline__ int lds_byte(int r, int c) { const int st = (r >> 4) * 2 + (c >> 5), rr = r & 15, cc = c & 31, ob = rr * 64 + cc * 2; return st * 1024 + (ob ^ (((ob >> 9) & 1) << 5)); }
__device__ __forceinline__ void stage_rc(int b, int& R, int& C) { const int st = b / 1024, sb = b % 1024, swz = sb ^ (((sb >> 9) & 1) << 5); R = (st >> 1) * 16 + swz / 64; C = (st & 1) * 32 + (swz % 64) / 2; }
__device__ __forceinline__ int perm32(int rho) { const int n = rho >> 4, i = rho & 15; return 8 * (i >> 2) + 4 * n + (i & 3); }

struct Unit { int pm, pn, e; const char* b; };

struct SchedDense {
    int nM, nN, nwg, G, c, cbase, csplit, cskip; const char* Bt; size_t tstepB;
    __device__ __forceinline__ void init(int M, int N, int K, int G_, int c_, const void* Bt_, int cbase_ = 0, int csplit_ = 1 << 20, int cskip_ = 0) { nM = M / BM; nN = N / BM; nwg = nM * nN; G = G_; c = c_; Bt = (const char*)Bt_; tstepB = (size_t)BM * K * 2; cbase = cbase_; csplit = csplit_; cskip = cskip_; }
    __device__ __forceinline__ bool next(int i, Unit& u) const {
        const long L = (long)i * G + c; if (L >= nwg) return false;
        int wgid = (int)L; { const int q = nwg / NXCD, r = nwg % NXCD, xcd = wgid % NXCD, off = wgid / NXCD; wgid = (xcd < r ? xcd * (q + 1) : r * (q + 1) + (xcd - r) * q) + off; }
        const int nig = WGM * nN, gid = wgid / nig, fm = gid * WGM, gsz = (nM - fm) < WGM ? (nM - fm) : WGM;
        u.pm = fm + ((wgid % nig) % gsz); const int j = (wgid % nig) / gsz; u.pn = j < csplit ? j + cbase : j + cbase + cskip; u.e = 0; u.b = Bt + (size_t)u.pn * tstepB; return true;
    }
    __device__ __forceinline__ unsigned rowidx(int, const Unit& u, int r) const { return (unsigned)(u.pm * BM + r); }
};
template <bool GATHER> struct SchedMoE {
    const LAS int* blk; const LAS unsigned short* idx; int NB, RBX, NPN, NXs, perx, cx, cj; const char* Bt; size_t estep, tstepB;
    __device__ __forceinline__ void init(const LAS int* blk_, const LAS unsigned short* idx_, int NPN_, int K, int G, int c, const void* Bt_, size_t estep_) {
        blk = blk_; idx = idx_; NB = blk_[32]; NPN = NPN_; Bt = (const char*)Bt_; estep = estep_; tstepB = (size_t)BM * K * 2;
        if ((G & 7) == 0) { NXs = 8; perx = G >> 3; cx = c & 7; cj = c >> 3; } else { NXs = 1; perx = G; cx = 0; cj = c; }
        RBX = (NB + NXs - 1) / NXs;
    }
    __device__ __forceinline__ bool next(int i, Unit& u) const {
        const int j = i * perx + cj, rbl = j / NPN; if (rbl >= RBX) return false;
        const int rb = cx * RBX + rbl; if (rb >= NB) return false;
        int e = 0;
        for (int q = 1; q < 32; ++q) e = (blk[q] <= rb) ? q : e;
        u.pm = rb; u.pn = j - rbl * NPN; u.e = e; u.b = Bt + (size_t)e * estep + (size_t)u.pn * tstepB; return true;
    }
    __device__ __forceinline__ unsigned rowidx(int ui, const Unit& u, int r) const { if (GATHER) return (unsigned)idx[ui * 256 + r]; return (unsigned)(u.pm * BM + r); }
};

template <bool FP8, unsigned ASCALE, class Epi, class Sched>
__device__ __forceinline__ void gemm_phase(LAS unsigned char* lds, const char* Abase, const int K, const Sched& S, const Epi& E) {
    int tid_ = threadIdx.x; asm volatile("" : "+v"(tid_));
    const int tid = tid_, wid = __builtin_amdgcn_readfirstlane(tid >> 6), lane = tid & 63, wr = wid >> 2, wc = wid & 3, fr = lane & 15, fq = lane >> 4;
    int nt_ = K / BK; asm volatile("" : "+s"(nt_)); const int nt = nt_;
    unsigned voffB[2]; int RA[2], CA[2];
#pragma unroll
    for (int i = 0; i < 2; ++i) { int R, C; stage_rc(tid * 16 + i * 8192, R, C); const int Rb = Epi::PERM ? ((R & ~31) + perm32(R & 31)) : R;
        voffB[i] = (unsigned)(Rb * K + C) * 2u; RA[i] = R; CA[i] = C * 2; }
    const size_t kstep = (size_t)(BK * 2);
    const size_t hstep = (size_t)HALF * K * 2;
    const unsigned ldsw = (unsigned)wid * 1024u;
    const unsigned rowb = (unsigned)K * 2u;
    const int aoff = lds_byte(wr * 64 + fr, fq * 8), boff = lds_byte(wc * 32 + fr, fq * 8);
#define PG8_SA(b, h) (((b) * 2 + (h)) * HTB)
#define PG8_SB(b, h) ((4 + (b) * 2 + (h)) * HTB)
#define PG8_STAGE(bufoff, gbase, voff) do { _Pragma("unroll") for (int _i = 0; _i < 2; ++_i) \
        __builtin_amdgcn_global_load_lds((const unsigned*)((const char*)(gbase) + (voff)[_i]), (LAS unsigned*)(lds + (bufoff) + ldsw + _i * 8192), 16, 0, 0); } while (0)
#define PG8_LDA(dst, b, h) do { _Pragma("unroll") for (int m = 0; m < 4; ++m) _Pragma("unroll") for (int k = 0; k < 2; ++k) dst[m][k] = *(const LAS bf16x8*)(lds + PG8_SA(b, h) + aoff + m * 2048 + k * 1024); } while (0)
#define PG8_LDB(dst, b, h) do { _Pragma("unroll") for (int n = 0; n < 2; ++n) _Pragma("unroll") for (int k = 0; k < 2; ++k) dst[n][k] = *(const LAS bf16x8*)(lds + PG8_SB(b, h) + boff + n * 2048 + k * 1024); } while (0)
#define PG8_MMA(ai, bj, At, Bt) do { __builtin_amdgcn_s_setprio(1); _Pragma("unroll") for (int m = 0; m < 4; ++m) _Pragma("unroll") for (int n = 0; n < 2; ++n) { \
        if constexpr (FP8) { \
            const i32x8 wf_ = __builtin_shufflevector((i32x4)Bt[n][0], (i32x4)Bt[n][1], 0, 1, 2, 3, 4, 5, 6, 7), af_ = __builtin_shufflevector((i32x4)At[m][0], (i32x4)At[m][1], 0, 1, 2, 3, 4, 5, 6, 7); \
            acc[ai][bj][m][n] = __builtin_amdgcn_mfma_scale_f32_16x16x128_f8f6f4(wf_, af_, acc[ai][bj][m][n], 0, 0, 0, 0x79797979, 0, (int)ASCALE); \
        } else { _Pragma("unroll") for (int k = 0; k < 2; ++k) \
            acc[ai][bj][m][n] = __builtin_amdgcn_mfma_f32_16x16x32_bf16(Bt[n][k], At[m][k], acc[ai][bj][m][n], 0, 0, 0); } } \
        __builtin_amdgcn_s_setprio(0); } while (0)
#define PG8_WAIT_V(n) asm volatile("s_waitcnt vmcnt(" #n ")" ::: "memory")
#define PG8_WAIT_L(n) asm volatile("s_waitcnt lgkmcnt(" #n ")" ::: "memory")
#define PG8_BAR __builtin_amdgcn_s_barrier()
#define PG8_SCHED __builtin_amdgcn_sched_barrier(0)
#define PG8_LOADVA(ui_, u_) do { _Pragma("unroll") for (int _h = 0; _h < 2; ++_h) _Pragma("unroll") for (int _i = 0; _i < 2; ++_i) \
        vA[_h][_i] = S.rowidx((ui_), (u_), _h * HALF + RA[_i]) * rowb + (unsigned)CA[_i]; } while (0)
    Unit cur, nxt; int ui = 0;
    if (!S.next(0, cur)) return;
    f32x4 acc[2][2][4][2];
#pragma unroll
    for (int a = 0; a < 2; ++a)
#pragma unroll
        for (int b = 0; b < 2; ++b)
#pragma unroll
            for (int m = 0; m < 4; ++m)
#pragma unroll
                for (int n = 0; n < 2; ++n) acc[a][b][m][n] = (f32x4){0.f, 0.f, 0.f, 0.f};
    bf16x8 At[4][2], B0[2][2], B1[2][2];
    unsigned vA[2][2];
    PG8_LOADVA(0, cur);
    const char* cB = cur.b;
    if (Epi::BIAS && tid < 64) __builtin_amdgcn_global_load_lds((const unsigned*)E.bias_ptr(cur, tid), (LAS unsigned*)(lds + LDS_BIASBUF), 16, 0, 0);
    if (Epi::EXTRA && tid < 64) __builtin_amdgcn_global_load_lds((const unsigned*)E.extra_ptr(cur, tid), (LAS unsigned*)(lds + LDS_BIASBUF + 1024), 16, 0, 0);
    PG8_STAGE(PG8_SB(0, 0), cB, voffB); PG8_STAGE(PG8_SB(0, 1), cB + hstep, voffB); PG8_STAGE(PG8_SA(0, 0), Abase, vA[0]); PG8_STAGE(PG8_SA(0, 1), Abase, vA[1]);
    if (wr == 1) PG8_BAR;
    PG8_WAIT_V(2); PG8_BAR;
    PG8_STAGE(PG8_SB(1, 0), cB + kstep, voffB); PG8_STAGE(PG8_SA(1, 0), Abase + kstep, vA[0]); PG8_STAGE(PG8_SB(1, 1), cB + hstep + kstep, voffB);
    PG8_WAIT_V(6); PG8_BAR;
    for (;;) {
        const bool has_next = S.next(ui + 1, nxt);
        const char* nB = has_next ? nxt.b : cB;
#pragma unroll 1
        for (int t = 0; t < nt; t += 2) {
            const bool last = (t == nt - 2);
            const char* a1 = Abase + (size_t)(t + 1) * kstep;
            const char* a2 = last ? Abase : Abase + (size_t)(t + 2) * kstep;
            const char* b2 = last ? nB : cB + (size_t)(t + 2) * kstep;
            const char* a3 = a2 + kstep; const char* b3 = b2 + kstep;
            PG8_LDB(B0, 0, 0); PG8_LDB(B1, 0, 1); PG8_SCHED; PG8_LDA(At, 0, 0); PG8_STAGE(PG8_SA(1, 1), a1, vA[1]);
            if (last && has_next) { PG8_LOADVA(ui + 1, nxt);
                if (Epi::BIAS && tid < 64) __builtin_amdgcn_global_load_lds((const unsigned*)E.bias_ptr(nxt, tid), (LAS unsigned*)(lds + LDS_BIASBUF + ((ui + 1) & 1) * 2048), 16, 0, 0);
                if (Epi::EXTRA && tid < 64) __builtin_amdgcn_global_load_lds((const unsigned*)E.extra_ptr(nxt, tid), (LAS unsigned*)(lds + LDS_BIASBUF + ((ui + 1) & 1) * 2048 + 1024), 16, 0, 0); }
            PG8_WAIT_V(8); PG8_WAIT_L(0); PG8_BAR; PG8_MMA(0, 0, At, B0); PG8_MMA(0, 1, At, B1); PG8_BAR; PG8_SCHED;
            PG8_LDA(At, 0, 1); PG8_STAGE(PG8_SB(0, 0), b2, voffB); PG8_STAGE(PG8_SB(0, 1), b2 + hstep, voffB); PG8_STAGE(PG8_SA(0, 0), a2, vA[0]);
            PG8_WAIT_V(8); PG8_WAIT_L(0); PG8_BAR; PG8_MMA(1, 0, At, B0); PG8_MMA(1, 1, At, B1); PG8_BAR; PG8_SCHED;
            PG8_LDB(B0, 1, 0); PG8_LDB(B1, 1, 1); PG8_SCHED; PG8_LDA(At, 1, 0); PG8_STAGE(PG8_SA(0, 1), a2, vA[1]);
            PG8_WAIT_V(8); PG8_WAIT_L(0); PG8_BAR; PG8_MMA(0, 0, At, B0); PG8_MMA(0, 1, At, B1); PG8_BAR; PG8_SCHED;
            PG8_LDA(At, 1, 1); PG8_STAGE(PG8_SB(1, 0), b3, voffB); PG8_STAGE(PG8_SB(1, 1), b3 + hstep, voffB); PG8_STAGE(PG8_SA(1, 0), a3, vA[0]);
            PG8_WAIT_V(8); PG8_WAIT_L(0); PG8_BAR; PG8_MMA(1, 0, At, B0); PG8_MMA(1, 1, At, B1); PG8_BAR; PG8_SCHED;
        }
        if (wr == 0) PG8_BAR;
        E(acc, cur, wr, wc, fr, fq, (const LAS float*)(lds + LDS_BIASBUF + (ui & 1) * 2048));
        if (!has_next) break;
#pragma unroll
        for (int a = 0; a < 2; ++a)
#pragma unroll
            for (int b = 0; b < 2; ++b)
#pragma unroll
                for (int m = 0; m < 4; ++m)
#pragma unroll
                    for (int n = 0; n < 2; ++n) acc[a][b][m][n] = (f32x4){0.f, 0.f, 0.f, 0.f};
        cur = nxt; cB = nB; ++ui;
        if (wr == 1) PG8_BAR;
    }
    PG8_WAIT_V(0);
    PG8_BAR;
#undef PG8_SA
#undef PG8_SB
#undef PG8_STAGE
#undef PG8_LDA
#undef PG8_LDB
#undef PG8_MMA
#undef PG8_WAIT_V
#undef PG8_WAIT_L
#undef PG8_BAR
#undef PG8_SCHED
#undef PG8_LOADVA
}

typedef f32x4 Acc[2][2][4][2];

struct EpiZ {
    static constexpr bool PERM = true, BIAS = true, EXTRA = false;
    __device__ __forceinline__ const float* extra_ptr(const Unit&, int) const { return nullptr; }
    __device__ __forceinline__ const float* bias_ptr(const Unit& u, int t) const { return bias + u.pn * 256 + 4 * t; }
    bf16_t* Z; const float* bias; float* out; int l; unsigned char* ZG;
    __device__ __forceinline__ void operator()(const Acc& acc, const Unit& u, int wr, int wc, int fr, int fq, const LAS float* lb) const {
        const int row0 = u.pm * 256 + wr * 64 + fr, col0 = u.pn * 256 + wc * 32 + 8 * fq;
        u32x2 wprev[2];
        f32x4 bv[2][2];
#pragma unroll
        for (int bj = 0; bj < 2; ++bj)
#pragma unroll
            for (int n = 0; n < 2; ++n) bv[bj][n] = *(const LAS f32x4*)(lb + bj * 128 + wc * 32 + 8 * fq + 4 * n);
#pragma unroll
        for (int ai = 0; ai < 2; ++ai)
#pragma unroll
            for (int m = 0; m < 4; ++m) {
                const int row = row0 + ai * 128 + m * 16;
                bf16_t* rowp = Z + (size_t)row * INW + col0;
                float* ko = nullptr; float* vo = nullptr;
                if (u.pn == 2) {
                    if (row < NPROMPT) { const int t = row & 4095; if (t >= 3968) { const size_t o = ((size_t)(l * 8 + (row >> 12)) * 128 + (t - 3968)) * 128 + wc * 32 + 8 * fq; ko = out + OKP + o; vo = out + OVP + o; } }
                    else { const int rr = row - NPROMPT; const size_t o = ((size_t)(l * 8 + (rr >> 6)) * 128 + 64 + (rr & 63)) * 128 + wc * 32 + 8 * fq; ko = out + OKS + o; vo = out + OVS + o; }
                }
#pragma unroll
                for (int bj = 0; bj < 2; ++bj) {
                    const f32x4 v0 = acc[ai][bj][m][0] + bv[bj][0], v1 = acc[ai][bj][m][1] + bv[bj][1];
                    if (u.pn >= 9) { u32x2 w8; w8.x = pk4_fp8(v0[0], v0[1], v0[2], v0[3]); w8.y = pk4_fp8(v1[0], v1[1], v1[2], v1[3]);
                        unsigned char* pz = ZG + (size_t)row * 2048 + (col0 - 2304) + bj * 128;
                        if ((m & 1) == 0) wprev[bj] = w8; else store_pair16(pz - (size_t)16 * 2048, pz, fq, wprev[bj], w8); }
                    else { u32x4 w; w.x = cvt_pk_bf16(v0[0], v0[1]); w.y = cvt_pk_bf16(v0[2], v0[3]); w.z = cvt_pk_bf16(v1[0], v1[1]); w.w = cvt_pk_bf16(v1[2], v1[3]);
                        *(u32x4*)(rowp + bj * 128) = w; }
                    float* o = bj == 0 ? ko : vo;
                    if (o) { *(f32x4*)o = v0; *(f32x4*)(o + 4) = v1; }
                }
                asm volatile("" ::: "memory");
            }
    }
};
struct EpiT1 {
    static constexpr bool PERM = true, BIAS = false, EXTRA = false;
    __device__ __forceinline__ const float* extra_ptr(const Unit&, int) const { return nullptr; }
    __device__ __forceinline__ const float* bias_ptr(const Unit&, int) const { return nullptr; }
    unsigned char* T1; const unsigned char* ZG;
    __device__ __forceinline__ void operator()(const Acc& acc, const Unit& u, int wr, int wc, int fr, int fq, const LAS float* lb) const {
        const int row0 = u.pm * 256 + wr * 64 + fr, col0 = u.pn * 256 + wc * 32 + 8 * fq;
        u32x2 g[2][4][2];
#pragma unroll
        for (int ai = 0; ai < 2; ++ai)
#pragma unroll
            for (int m = 0; m < 4; m += 2)
#pragma unroll
                for (int bj = 0; bj < 2; ++bj) { const unsigned char* pa = ZG + (size_t)(row0 + ai * 128 + m * 16) * 2048 + col0 + bj * 128;
                    load_pair16(pa, pa + (size_t)16 * 2048, fq, g[ai][m][bj], g[ai][m + 1][bj]); }
        asm volatile("" ::: "memory");
        u32x2 wprev[2];
#pragma unroll
        for (int ai = 0; ai < 2; ++ai)
#pragma unroll
            for (int m = 0; m < 4; ++m) {
                const int row = row0 + ai * 128 + m * 16;
#pragma unroll
                for (int bj = 0; bj < 2; ++bj) {
                    const u32x2 gw = g[ai][m][bj];
                    const f32x2 s0 = sigmoid2(__builtin_amdgcn_cvt_pk_f32_fp8(gw.x, false)), s1 = sigmoid2(__builtin_amdgcn_cvt_pk_f32_fp8(gw.x, true)),
                                s2 = sigmoid2(__builtin_amdgcn_cvt_pk_f32_fp8(gw.y, false)), s3 = sigmoid2(__builtin_amdgcn_cvt_pk_f32_fp8(gw.y, true));
                    const f32x4 a0 = acc[ai][bj][m][0], a1 = acc[ai][bj][m][1];
                    const f32x2 p0 = ((f32x2){a0[0], a0[1]} * 16.0f) * s0, p1 = ((f32x2){a0[2], a0[3]} * 16.0f) * s1, p2 = ((f32x2){a1[0], a1[1]} * 16.0f) * s2, p3 = ((f32x2){a1[2], a1[3]} * 16.0f) * s3;
                    u32x2 w; w.x = pk4_fp8(p0.x, p0.y, p1.x, p1.y); w.y = pk4_fp8(p2.x, p2.y, p3.x, p3.y);
                    if ((m & 1) == 0) wprev[bj] = w;
                    else store_pair16(T1 + (size_t)(row - 16) * D + col0 + bj * 128, T1 + (size_t)row * D + col0 + bj * 128, fq, wprev[bj], w);
                }
            }
    }
};
struct EpiMix {
    static constexpr bool PERM = true, BIAS = false, EXTRA = false;
    __device__ __forceinline__ const float* extra_ptr(const Unit&, int) const { return nullptr; }
    __device__ __forceinline__ const float* bias_ptr(const Unit&, int) const { return nullptr; }
    const unsigned char* T1; const unsigned char* ZG; unsigned char* MIX;
    __device__ __forceinline__ void operator()(const Acc& acc, const Unit& u, int wr, int wc, int fr, int fq, const LAS float* lb) const {
        const int row0 = u.pm * 256 + wr * 64 + fr, col0 = u.pn * 256 + wc * 32 + 8 * fq;
        u32x2 g[2][4][2], t[2][4][2];
#pragma unroll
        for (int ai = 0; ai < 2; ++ai)
#pragma unroll
            for (int m = 0; m < 4; ++m)
#pragma unroll
                for (int bj = 0; bj < 2; ++bj) { if (m & 1) continue; const int row = row0 + ai * 128 + m * 16;
                    const unsigned char* pg = ZG + (size_t)row * 2048 + 1024 + col0 + bj * 128; const unsigned char* pt = T1 + (size_t)row * D + col0 + bj * 128;
                    load_pair16(pg, pg + (size_t)16 * 2048, fq, g[ai][m][bj], g[ai][m | 1][bj]);
                    load_pair16(pt, pt + (size_t)16 * D, fq, t[ai][m][bj], t[ai][m | 1][bj]); }
        asm volatile("" ::: "memory");
        u32x2 wprev[2];
#pragma unroll
        for (int ai = 0; ai < 2; ++ai)
#pragma unroll
            for (int m = 0; m < 4; ++m) {
                const int row = row0 + ai * 128 + m * 16;
#pragma unroll
                for (int bj = 0; bj < 2; ++bj) {
                    const u32x2 gw = g[ai][m][bj], tw = t[ai][m][bj];
                    const f32x2 s0 = sigmoid2(__builtin_amdgcn_cvt_pk_f32_fp8(gw.x, false)), s1 = sigmoid2(__builtin_amdgcn_cvt_pk_f32_fp8(gw.x, true)),
                                s2 = sigmoid2(__builtin_amdgcn_cvt_pk_f32_fp8(gw.y, false)), s3 = sigmoid2(__builtin_amdgcn_cvt_pk_f32_fp8(gw.y, true));
                    const f32x2 t0 = __builtin_amdgcn_cvt_pk_f32_fp8(tw.x, false), t1 = __builtin_amdgcn_cvt_pk_f32_fp8(tw.x, true), t2 = __builtin_amdgcn_cvt_pk_f32_fp8(tw.y, false), t3 = __builtin_amdgcn_cvt_pk_f32_fp8(tw.y, true);
                    const f32x4 a0 = acc[ai][bj][m][0], a1 = acc[ai][bj][m][1];
                    const f32x2 p0 = t0 * 0.0625f + (f32x2){a0[0], a0[1]} * s0, p1 = t1 * 0.0625f + (f32x2){a0[2], a0[3]} * s1, p2 = t2 * 0.0625f + (f32x2){a1[0], a1[1]} * s2, p3 = t3 * 0.0625f + (f32x2){a1[2], a1[3]} * s3;
                    u32x2 w; w.x = pk4_fp8(p0.x, p0.y, p1.x, p1.y); w.y = pk4_fp8(p2.x, p2.y, p3.x, p3.y);
                    if ((m & 1) == 0) wprev[bj] = w;
                    else store_pair16(MIX + (size_t)(row - 16) * D + col0 + bj * 128, MIX + (size_t)row * D + col0 + bj * 128, fq, wprev[bj], w);
                }
            }
    }
};
struct EpiX {
    static constexpr bool PERM = true, BIAS = false, EXTRA = false;
    __device__ __forceinline__ const float* extra_ptr(const Unit&, int) const { return nullptr; }
    __device__ __forceinline__ const float* bias_ptr(const Unit&, int) const { return nullptr; }
    const bf16_t* X; bf16_t* V; const float* modl;
    __device__ __forceinline__ void operator()(const Acc& acc, const Unit& u, int wr, int wc, int fr, int fq, const LAS float* lb) const {
        const int row0 = u.pm * 256 + wr * 64 + fr, col0 = u.pn * 256 + wc * 32 + 8 * fq;
        const bool uni = u.pm < 128;
        f32x4 g[2][2];
        if (uni) { const float* gp = modl + (size_t)(u.pm >> 4) * 6144 + 2048 + col0;
#pragma unroll
            for (int bj = 0; bj < 2; ++bj)
#pragma unroll
                for (int n = 0; n < 2; ++n) g[bj][n] = *(const f32x4*)(gp + bj * 128 + 4 * n) + 1.0f; }
#pragma unroll
        for (int ai = 0; ai < 2; ++ai) {
            u32x4 x[4][2];
#pragma unroll
            for (int m = 0; m < 4; ++m)
#pragma unroll
                for (int bj = 0; bj < 2; ++bj) x[m][bj] = *(const u32x4*)(X + (size_t)(row0 + ai * 128 + m * 16) * D + col0 + bj * 128);
            asm volatile("" ::: "memory");
#pragma unroll
            for (int m = 0; m < 4; ++m) {
                const int row = row0 + ai * 128 + m * 16;
                if (!uni) { const float* gp = modl + (size_t)batch_of(row) * 6144 + 2048 + col0;
#pragma unroll
                    for (int bj = 0; bj < 2; ++bj)
#pragma unroll
                        for (int n = 0; n < 2; ++n) g[bj][n] = *(const f32x4*)(gp + bj * 128 + 4 * n) + 1.0f; }
#pragma unroll
                for (int bj = 0; bj < 2; ++bj) {
                    const u32x4 xx = x[m][bj];
                    const f32x4 x0 = (f32x4){bf_lo(xx.x), bf_hi(xx.x), bf_lo(xx.y), bf_hi(xx.y)}, x1 = (f32x4){bf_lo(xx.z), bf_hi(xx.z), bf_lo(xx.w), bf_hi(xx.w)};
                    const f32x4 v0 = x0 * ALPHA + g[bj][0] * acc[ai][bj][m][0], v1 = x1 * ALPHA + g[bj][1] * acc[ai][bj][m][1];
                    u32x4 w; w.x = cvt_pk_bf16(v0[0], v0[1]); w.y = cvt_pk_bf16(v0[2], v0[3]); w.z = cvt_pk_bf16(v1[0], v1[1]); w.w = cvt_pk_bf16(v1[2], v1[3]);
                    *(u32x4*)(V + (size_t)row * D + col0 + bj * 128) = w;
                }
            }
            asm volatile("" ::: "memory");
        }
    }
};
struct EpiAct {
    static constexpr bool PERM = true, BIAS = true, EXTRA = false;
    __device__ __forceinline__ const float* extra_ptr(const Unit&, int) const { return nullptr; }
    __device__ __forceinline__ const float* bias_ptr(const Unit& u, int t) const { return bgu + (size_t)u.e * 2048 + u.pn * 128 + (t < 32 ? 4 * t : 1024 + 4 * (t - 32)); }
    unsigned char* ACT; const float* bgu;
    __device__ __forceinline__ void operator()(const Acc& acc, const Unit& u, int wr, int wc, int fr, int fq, const LAS float* lb) const {
        const int row0 = u.pm * 256 + wr * 64 + fr, c0 = u.pn * 128 + wc * 32 + 8 * fq;
        u32x2 wprev;
        f32x4 bg[2], bl[2];
#pragma unroll
        for (int n = 0; n < 2; ++n) { bg[n] = *(const LAS f32x4*)(lb + wc * 32 + 8 * fq + 4 * n); bl[n] = *(const LAS f32x4*)(lb + 128 + wc * 32 + 8 * fq + 4 * n); }
#pragma unroll
        for (int ai = 0; ai < 2; ++ai)
#pragma unroll
            for (int m = 0; m < 4; ++m) {
                const int row = row0 + ai * 128 + m * 16;
                float a[8];
#pragma unroll
                for (int n = 0; n < 2; ++n)
#pragma unroll
                    for (int jp = 0; jp < 2; ++jp) {
                        f32x2 g = (f32x2){acc[ai][0][m][n][2 * jp], acc[ai][0][m][n][2 * jp + 1]} + (f32x2){bg[n][2 * jp], bg[n][2 * jp + 1]};
                        f32x2 li = (f32x2){acc[ai][1][m][n][2 * jp], acc[ai][1][m][n][2 * jp + 1]} + (f32x2){bl[n][2 * jp], bl[n][2 * jp + 1]};
                        g = __builtin_elementwise_min(g, (f32x2){7.0f, 7.0f});
                        li = __builtin_elementwise_min(__builtin_elementwise_max(li, (f32x2){-7.0f, -7.0f}), (f32x2){7.0f, 7.0f});
                        const f32x2 t = g * (-1.702f * 1.44269504089f);
                        f32x2 e; e.x = __builtin_amdgcn_exp2f(t.x); e.y = __builtin_amdgcn_exp2f(t.y);
                        const f32x2 dd = e + 1.0f;
                        f32x2 r; r.x = __builtin_amdgcn_rcpf(dd.x); r.y = __builtin_amdgcn_rcpf(dd.y);
                        const f32x2 av = (g * r) * (li + 1.0f);
                        a[n * 4 + 2 * jp] = av.x; a[n * 4 + 2 * jp + 1] = av.y;
                    }
                u32x2 w; w.x = pk4_fp8(a[0], a[1], a[2], a[3]); w.y = pk4_fp8(a[4], a[5], a[6], a[7]);
                if ((m & 1) == 0) wprev = w;
                else store_pair16(ACT + (size_t)(row - 16) * D + c0, ACT + (size_t)row * D + c0, fq, wprev, w);
                asm volatile("" ::: "memory");
            }
    }
};
struct EpiYs {
    static constexpr bool PERM = true, BIAS = true, EXTRA = true;
    __device__ __forceinline__ const float* extra_ptr(const Unit& u, int t) const { return gate + (size_t)u.e * NT + (u.pm - blk[u.e]) * 256 + 4 * t; }
    __device__ __forceinline__ const float* bias_ptr(const Unit& u, int t) const { return bdn + (size_t)u.e * D + u.pn * 256 + 4 * t; }
    unsigned char* YS; const float* bdn; const float* gate; const LAS int* cnt; const LAS int* blk;
    __device__ __forceinline__ void operator()(const Acc& acc, const Unit& u, int wr, int wc, int fr, int fq, const LAS float* lb) const {
        const int r0 = wr * 64 + fr, col0 = u.pn * 256 + wc * 32 + 8 * fq;
        const int rank0 = (u.pm - blk[u.e]) * 256; const int ce = cnt[u.e];
        f32x4 bv[2][2];
#pragma unroll
        for (int bj = 0; bj < 2; ++bj)
#pragma unroll
            for (int n = 0; n < 2; ++n) bv[bj][n] = *(const LAS f32x4*)(lb + bj * 128 + wc * 32 + 8 * fq + 4 * n);
        float gts[2][4];
#pragma unroll
        for (int ai = 0; ai < 2; ++ai)
#pragma unroll
            for (int m = 0; m < 4; ++m) { const int rank = rank0 + r0 + ai * 128 + m * 16; const float gv = lb[256 + r0 + ai * 128 + m * 16]; gts[ai][m] = rank < ce ? 16.0f * gv : 0.0f; }
        asm volatile("" ::: "memory");
        u32x2 wprev[2];
#pragma unroll
        for (int ai = 0; ai < 2; ++ai)
#pragma unroll
            for (int m = 0; m < 4; ++m) {
                const int r = r0 + ai * 128 + m * 16;
                const float gt = gts[ai][m];
                unsigned char* rowp = YS + (size_t)(u.pm * 256 + r) * D + col0;
#pragma unroll
                for (int bj = 0; bj < 2; ++bj) {
                    const f32x4 v0 = (acc[ai][bj][m][0] + bv[bj][0]) * gt, v1 = (acc[ai][bj][m][1] + bv[bj][1]) * gt;
                    u32x2 w; w.x = pk4_fp8(v0[0], v0[1], v0[2], v0[3]); w.y = pk4_fp8(v1[0], v1[1], v1[2], v1[3]);
                    if ((m & 1) == 0) wprev[bj] = w;
                    else store_pair16(rowp - (size_t)16 * D + bj * 128, rowp + bj * 128, fq, wprev[bj], w);
                }
                asm volatile("" ::: "memory");
            }
    }
};
}


#define XB_TMO      128
#define XB_XCNT(j)  (256  + 64 * (j))
#define XB_XSUB(j)  (1280 + 64 * (j))
#define XB_XGEN(j)  (2304 + 64 * (j))
#define XB_TOP      3328
#define XB_TOPGEN   3392
#define XCD_BAR_WORDS 3456
#define XB_SPIN_CAP (1u << 21)
__device__ __forceinline__ unsigned xb_ld(unsigned* p)              { return __hip_atomic_load(p, __ATOMIC_RELAXED, __HIP_MEMORY_SCOPE_AGENT); }
__device__ __forceinline__ unsigned xb_add(unsigned* p, unsigned v) { return __hip_atomic_fetch_add(p, v, __ATOMIC_RELAXED, __HIP_MEMORY_SCOPE_AGENT); }
__device__ __forceinline__ unsigned xb_xcc_id() { return (unsigned)__builtin_amdgcn_s_getreg((3 << 11) | 20) & 0xFu; }
#define XB_SPIN(cond, bar) do { unsigned _sp = 0; while (cond) { __builtin_amdgcn_s_sleep(1); \
    if ((++_sp & 255u) == 0u) { if (xb_ld(&(bar)[XB_TMO])) break; if (_sp > XB_SPIN_CAP) { atomicAdd(&(bar)[XB_TMO], 1u); break; } } } } while (0)
struct XcdBarrier { unsigned* bar; unsigned x; volatile LAS unsigned* st; };
__device__ __forceinline__ XcdBarrier xcd_barrier_post(unsigned* bar, volatile LAS unsigned* st) {
    XcdBarrier b; b.bar = bar; b.x = xb_xcc_id(); b.st = st;
    if (threadIdx.x == 0) (void)xb_add(&bar[XB_XCNT(b.x)], 1u);
    return b;
}
__device__ __forceinline__ void xcd_barrier_complete(unsigned* bar, unsigned x, unsigned& nloc, unsigned& nx) {
    const unsigned G = gridDim.x * gridDim.y * gridDim.z;
    unsigned sum, cnt, mine, sp = 0u;
    for (;;) {
        sum = 0u; cnt = 0u; mine = 0u;
#pragma unroll
        for (unsigned j = 0; j < 16; ++j) { const unsigned c = xb_ld(&bar[XB_XCNT(j)]); sum += c; cnt += (c > 0u) ? 1u : 0u; mine = (j == x) ? c : mine; }
        if (sum == G) break;
        __builtin_amdgcn_s_sleep(1);
        if ((++sp & 255u) == 0u) { if (xb_ld(&bar[XB_TMO])) break; if (sp > XB_SPIN_CAP) { atomicAdd(&bar[XB_TMO], 1u); break; } }
    }
    nloc = mine > 0u ? mine : 1u; nx = cnt > 0u ? cnt : 1u;
}
__device__ __forceinline__ void xcd_barrier(const XcdBarrier& b) {
    asm volatile("s_waitcnt vmcnt(0)" ::: "memory");
    __syncthreads();
    if (threadIdx.x == 0) {
        unsigned* bar = b.bar;
        __builtin_amdgcn_s_waitcnt(0);
        unsigned nloc = b.st[0], nx = b.st[1];
        if (nloc == 0u) { xcd_barrier_complete(bar, b.x, nloc, nx); b.st[0] = nloc; b.st[1] = nx; }
        const unsigned old = xb_add(&bar[XB_XSUB(b.x)], 1u);
        const unsigned gen = old / nloc;
        if (old + 1u == (gen + 1u) * nloc) {
            __builtin_amdgcn_fence(__ATOMIC_RELEASE, "agent");
            asm volatile("s_waitcnt vmcnt(0)" ::: "memory");
            const unsigned og = xb_add(&bar[XB_TOP], 1u);
            const unsigned tg = og / nx;
            if (og + 1u == (tg + 1u) * nx) xb_add(&bar[XB_TOPGEN], 1u);
            else XB_SPIN(xb_ld(&bar[XB_TOPGEN]) == tg, bar);
            __builtin_amdgcn_fence(__ATOMIC_ACQUIRE, "agent");
            xb_add(&bar[XB_XGEN(b.x)], 1u);
            asm volatile("s_waitcnt vmcnt(0)" ::: "memory");
        } else {
            XB_SPIN(xb_ld(&bar[XB_XGEN(b.x)]) == gen, bar);
            __builtin_amdgcn_fence(__ATOMIC_ACQUIRE, "agent");
            asm volatile("s_waitcnt vmcnt(0)" ::: "memory");
        }
    }
    __syncthreads();
}

struct Ctx {
    LAS unsigned char* lds; int tid, lane, wave, G, bx;
    const float* const* in; float* out; unsigned char* ws;
};
#define LDS_WAIT() asm volatile("s_waitcnt lgkmcnt(0)" ::: "memory")

struct TDesc { const float* src; unsigned char* dst; int N, K, k0, n0, kind, f8; };
__device__ __forceinline__ void t64_load(const TDesc& d, float (&v)[64], int lane) {
    const float* src = d.src + (size_t)d.k0 * d.N + d.n0 + lane;
#pragma unroll
    for (int kk = 0; kk < 64; ++kk) v[kk] = src[(size_t)kk * d.N];
}
__device__ __forceinline__ void t64_finish(const TDesc& d, const float (&v)[64], LAS unsigned char* scr, int lane) {
    if (d.f8) {
        LAS unsigned char* wp = scr + lane * 80;
#pragma unroll
        for (int q = 0; q < 4; ++q) { u32x4 o;
            o.x = pk4_fp8(64.f * v[16 * q + 0], 64.f * v[16 * q + 1], 64.f * v[16 * q + 2], 64.f * v[16 * q + 3]);
            o.y = pk4_fp8(64.f * v[16 * q + 4], 64.f * v[16 * q + 5], 64.f * v[16 * q + 6], 64.f * v[16 * q + 7]);
            o.z = pk4_fp8(64.f * v[16 * q + 8], 64.f * v[16 * q + 9], 64.f * v[16 * q + 10], 64.f * v[16 * q + 11]);
            o.w = pk4_fp8(64.f * v[16 * q + 12], 64.f * v[16 * q + 13], 64.f * v[16 * q + 14], 64.f * v[16 * q + 15]);
            *(LAS u32x4*)(wp + q * 16) = o; }
        LDS_WAIT(); asm volatile("" ::: "memory");
        const int c = lane & 3;
#pragma unroll
        for (int j = 0; j < 4; ++j) { const int nl = (lane >> 2) + 16 * j; const u32x4 o = *(const LAS u32x4*)(scr + nl * 80 + c * 16);
            const int n = d.n0 + nl; int dr = n;
            if (d.kind == 1) { dr = (n < 1024) ? ((n >> 7) * 256 + (n & 127)) : (((n - 1024) >> 7) * 256 + 128 + (n & 127)); }
            *(u32x4*)(d.dst + (size_t)dr * d.K + d.k0 + c * 16) = o; }
    } else {
        LAS unsigned char* wp = scr + lane * 144;
#pragma unroll
        for (int q = 0; q < 8; ++q) { u32x4 o;
            o.x = cvt_pk_bf16(v[8 * q + 0], v[8 * q + 1]); o.y = cvt_pk_bf16(v[8 * q + 2], v[8 * q + 3]); o.z = cvt_pk_bf16(v[8 * q + 4], v[8 * q + 5]); o.w = cvt_pk_bf16(v[8 * q + 6], v[8 * q + 7]);
            *(LAS u32x4*)(wp + q * 16) = o; }
        LDS_WAIT(); asm volatile("" ::: "memory");
        const int c = lane & 7;
#pragma unroll
        for (int j = 0; j < 8; ++j) { const int nl = (lane >> 3) + 8 * j; const u32x4 o = *(const LAS u32x4*)(scr + nl * 144 + c * 16);
            *(u32x4*)(d.dst + ((size_t)(d.n0 + nl) * d.K + d.k0) * 2 + c * 16) = o; }
    }
    LDS_WAIT(); asm volatile("" ::: "memory");
}
__device__ __forceinline__ TDesc t64_decode(const float* const* in, unsigned char* ws, int it) {
    TDesc d; int r = it, item, nblk;
    if (r < 32768) { const int m = r >> 9; item = r & 511; d.src = in[23] + (size_t)m * 1024 * 2048; d.dst = ws + WS_WGU + (size_t)m * 2048 * 1024; d.N = 2048; d.K = 1024; d.kind = 1; d.f8 = 1; }
    else if ((r -= 32768) < 16384) { const int m = r >> 8; item = r & 255; d.src = in[25] + (size_t)m * 1024 * 1024; d.dst = ws + WS_WDN + (size_t)m * 1024 * 1024; d.N = 1024; d.K = 1024; d.kind = 0; d.f8 = 1; }
    else if ((r -= 16384) < 2176) { const int m = r / 1088; item = r % 1088; d.src = in[12] + (size_t)m * 1024 * INW; d.dst = ws + WS_WIN + (size_t)m * INW * 1024 * 2; d.N = INW; d.K = 1024; d.kind = 0; d.f8 = 0; }
    else if ((r -= 2176) < 2176) { const int m = r / 1088; item = r % 1088; d.src = in[12] + (size_t)m * 1024 * INW; d.dst = ws + WS_WIN8 + (size_t)m * INW * 1024; d.N = INW; d.K = 1024; d.kind = 0; d.f8 = 1; }
    else if ((r -= 2176) < 512) { const int m = r >> 8; item = r & 255; d.src = in[18] + (size_t)m * 1024 * 1024; d.dst = ws + WS_WO + (size_t)m * 1024 * 1024; d.N = 1024; d.K = 1024; d.kind = 0; d.f8 = 1; }
    else if ((r -= 512) < 256) { const int m = r >> 7; item = r & 127; d.src = in[16] + (size_t)m * 512 * 1024; d.dst = ws + WS_WOA + (size_t)m * 1024 * 512; d.N = 1024; d.K = 512; d.kind = 0; d.f8 = 1; }
    else { r -= 256; const int m = r >> 7; item = r & 127; d.src = in[17] + (size_t)m * 512 * 1024; d.dst = ws + WS_WOB + (size_t)m * 1024 * 512; d.N = 1024; d.K = 512; d.kind = 0; d.f8 = 1; }
    nblk = d.N >> 6; const int kb = item / nblk; d.k0 = kb * 64; d.n0 = (item - kb * nblk) * 64;
    return d;
}

__device__ __forceinline__ int rel_bucket(int rel) {
    const int n = rel < 0 ? -rel : rel;
    int v;
    if (n < 8) v = n;
    else { const float nf = (float)n; int large = 8 + (int)(logf(nf / 8.0f) / 2.7725887298583984f * 8.0f); v = large < 15 ? large : 15; }
    return (rel > 0 ? 16 : 0) + v;
}

__device__ __forceinline__ void phase0a(Ctx& F) {
    LAS float* scr = (LAS float*)(F.lds + F.wave * 16384);
    const int gw = F.bx * NWAVES + F.wave, NGW = F.G * NWAVES;
    unsigned char* ws = F.ws;
    {
        float* modp = (float*)(ws + WS_MODP);
        for (int it = gw; it < 2 * 96 * 8; it += NGW) {
            const int kc = it & 7, cgp = (it >> 3) % 96, l = it / (8 * 96), k0 = kc * 128, n0 = cgp * 64;
#pragma unroll 4
            for (int j = 0; j < 32; ++j) { const int idx = F.lane + 64 * j, r = idx >> 7, kk = idx & 127;
                const float c = r < 8 ? F.in[2][r * 1024 + k0 + kk] : F.in[3][(r - 8) * 1024 + k0 + kk];
                scr[kk * 16 + r] = c * sigmoidf_(c); }
            LDS_WAIT(); asm volatile("" ::: "memory");
            float a[16];
#pragma unroll
            for (int r = 0; r < 16; ++r) a[r] = 0.f;
            const float* wp = F.in[10] + ((size_t)l * 1024 + k0) * 6144 + n0 + F.lane;
#pragma unroll 16
            for (int kk = 0; kk < 128; ++kk) {
                const float w = wp[(size_t)kk * 6144];
                const LAS f32x4* sp = (const LAS f32x4*)(scr + kk * 16);
                const f32x4 s0 = sp[0], s1 = sp[1], s2 = sp[2], s3 = sp[3];
                a[0] += s0[0] * w; a[1] += s0[1] * w; a[2] += s0[2] * w; a[3] += s0[3] * w;
                a[4] += s1[0] * w; a[5] += s1[1] * w; a[6] += s1[2] * w; a[7] += s1[3] * w;
                a[8] += s2[0] * w; a[9] += s2[1] * w; a[10] += s2[2] * w; a[11] += s2[3] * w;
                a[12] += s3[0] * w; a[13] += s3[1] * w; a[14] += s3[2] * w; a[15] += s3[3] * w;
            }
            const float bb = (kc == 0) ? F.in[11][l * 6144 + n0 + F.lane] : 0.f;
#pragma unroll
            for (int r = 0; r < 16; ++r) modp[(size_t)kc * (2 * 16 * 6144) + ((size_t)(l * 16 + r)) * 6144 + n0 + F.lane] = a[r] + bb;
            LDS_WAIT(); asm volatile("" ::: "memory");
        }
    }
    if (F.bx == 0) {
        float* bt = (float*)(ws + WS_BIAS);
        for (int i = F.tid; i < 8 * 256; i += NTHREADS) { const int h = i >> 8, ri = i & 255; const int rel = ri - 191;
            bt[i] = (ri < 255) ? F.in[7][rel_bucket(rel) * 8 + h] : 0.f; }
    }
    for (int i = F.bx * NTHREADS + F.tid; i < 2 * 8 * 64 * 128; i += F.G * NTHREADS) {
        const int lb = i >> 13, rem = i & 8191;
        F.out[OKS + (size_t)lb * 16384 + rem] = F.in[4][(size_t)lb * 16384 + 8192 + rem];
        F.out[OVS + (size_t)lb * 16384 + rem] = F.in[5][(size_t)lb * 16384 + 8192 + rem];
    }
    LAS unsigned char* scrb = F.lds + F.wave * 16384;
    constexpr int NITEMS = 32768 + 16384 + 2176 + 2176 + 512 + 256 + 256;
    {
        float va[64], vb[64]; TDesc da, db;
        int it = gw;
        if (it < NITEMS) { da = t64_decode(F.in, ws, it); t64_load(da, va, F.lane); }
        while (it < NITEMS) {
            int itn = it + NGW;
            if (itn < NITEMS) { db = t64_decode(F.in, ws, itn); t64_load(db, vb, F.lane); }
            t64_finish(da, va, scrb, F.lane);
            it = itn; if (it >= NITEMS) break;
            itn = it + NGW;
            if (itn < NITEMS) { da = t64_decode(F.in, ws, itn); t64_load(da, va, F.lane); }
            t64_finish(db, vb, scrb, F.lane);
            it = itn;
        }
    }
}

__device__ __forceinline__ void ln_row(f32x4 (&v)[4], const float* g, const float* b, int lane) {
    float s = 0.f;
#pragma unroll
    for (int j = 0; j < 4; ++j) s += (v[j][0] + v[j][1]) + (v[j][2] + v[j][3]);
    const float mean = wave_sum(s) * (1.0f / D); float s2 = 0.f;
#pragma unroll
    for (int j = 0; j < 4; ++j) { v[j] = v[j] - mean; s2 += (v[j][0] * v[j][0] + v[j][1] * v[j][1]) + (v[j][2] * v[j][2] + v[j][3] * v[j][3]); }
    const float rstd = 1.0f / sqrtf(wave_sum(s2) * (1.0f / D) + LN_EPS);
#pragma unroll
    for (int j = 0; j < 4; ++j) { const f32x4 gg = *(const f32x4*)(g + 4 * lane + 256 * j), bb = *(const f32x4*)(b + 4 * lane + 256 * j); v[j] = v[j] * rstd * gg + bb; }
}
__device__ __forceinline__ void store_mod_row(const f32x4 (&v)[4], const float* sh, const float* sc, bf16_t* hrow, unsigned char* h8row, int lane) {
#pragma unroll
    for (int j = 0; j < 4; ++j) { const f32x4 a = *(const f32x4*)(sc + 4 * lane + 256 * j), b = *(const f32x4*)(sh + 4 * lane + 256 * j);
        const f32x4 h = v[j] * (a + 1.0f) + b; u32x2 w; w.x = cvt_pk_bf16(h[0], h[1]); w.y = cvt_pk_bf16(h[2], h[3]);
        *(u32x2*)(hrow + 4 * lane + 256 * j) = w;
        *(unsigned*)(h8row + 4 * lane + 256 * j) = pk4_fp8(h[0], h[1], h[2], h[3]); }
}

__device__ __forceinline__ void phase0b(Ctx& F) {
    const int gw = F.bx * NWAVES + F.wave, NGW = F.G * NWAVES;
    const float* mod = (const float*)(F.ws + WS_MOD);
    bf16_t* H = (bf16_t*)(F.ws + WS_H);
    for (int row = gw; row < NT; row += NGW) {
        const float* xr = row < NPROMPT ? F.in[0] + (size_t)row * D : F.in[1] + (size_t)(row - NPROMPT) * D;
        f32x4 v[4];
#pragma unroll
        for (int j = 0; j < 4; ++j) v[j] = *(const f32x4*)(xr + 4 * F.lane + 256 * j);
        ln_row(v, F.in[8], F.in[9], F.lane);
#pragma unroll
        for (int j = 0; j < 4; ++j) { u32x2 w; w.x = cvt_pk_bf16(v[j][0], v[j][1]); w.y = cvt_pk_bf16(v[j][2], v[j][3]); *(u32x2*)((bf16_t*)(F.ws + WS_XB) + (size_t)row * D + 4 * F.lane + 256 * j) = w; }
        const float* mb = mod + (size_t)batch_of(row) * 6144;
        store_mod_row(v, mb, mb + 1024, H + (size_t)row * D, F.ws + WS_H8 + (size_t)row * D, F.lane);
    }
}

__device__ __forceinline__ void phase_attn(Ctx& F, int l) {
    const bf16_t* Z = (const bf16_t*)(F.ws + WS_Z);
    unsigned char* YA = F.ws + WS_YA;
    unsigned char* YB = F.ws + WS_YB;
    const float* biasr = (const float*)(F.ws + WS_BIAS);
    LAS unsigned char* Ks = F.lds;
    LAS unsigned char* Vt = F.lds + 27648;
    LAS float* bt = (LAS float*)(F.lds + 53248);
    const int lane = F.lane, tid = F.tid;
    int bt_kv = -1;
    for (int au = F.bx; au < 1040; au += F.G) {
        const bool isS = au >= 1024;
        const int kv = au & 1;
        const int b = isS ? ((au - 1024) >> 1) : (au >> 7);
        const int n = isS ? 0 : ((au & 127) >> 1);
        __syncthreads();
        if (kv != bt_kv) { for (int i = tid; i < 1024; i += NTHREADS) bt[i] = biasr[(kv * 4 + (i >> 8)) * 256 + (i & 255)]; bt_kv = kv; }
#pragma unroll
        for (int jj = 0; jj < 3; ++jj) {
            const int p = tid + NTHREADS * jj, key = p >> 3, ds = p & 7;
            u32x4 kq = (u32x4){0u, 0u, 0u, 0u}, vq = (u32x4){0u, 0u, 0u, 0u};
            if (!isS) {
                const int t = n * 64 + key - 128;
                if (t >= 0) { const bf16_t* zr = Z + (size_t)(b * 4096 + t) * INW + kv * 64 + ds * 8; kq = *(const u32x4*)(zr + 512); vq = *(const u32x4*)(zr + 640); }
            } else if (key < 128) {
                const size_t o = ((size_t)((l * 8 + b) * 128 + key) * 2 + kv) * 64 + ds * 8;
                const f32x4 k0 = *(const f32x4*)(F.in[4] + o), k1 = *(const f32x4*)(F.in[4] + o + 4), v0 = *(const f32x4*)(F.in[5] + o), v1 = *(const f32x4*)(F.in[5] + o + 4);
                kq.x = cvt_pk_bf16(k0[0], k0[1]); kq.y = cvt_pk_bf16(k0[2], k0[3]); kq.z = cvt_pk_bf16(k1[0], k1[1]); kq.w = cvt_pk_bf16(k1[2], k1[3]);
                vq.x = cvt_pk_bf16(v0[0], v0[1]); vq.y = cvt_pk_bf16(v0[2], v0[3]); vq.z = cvt_pk_bf16(v1[0], v1[1]); vq.w = cvt_pk_bf16(v1[2], v1[3]);
            } else {
                const bf16_t* zr = Z + (size_t)(NPROMPT + b * 64 + key - 128) * INW + kv * 64 + ds * 8; kq = *(const u32x4*)(zr + 512); vq = *(const u32x4*)(zr + 640);
            }
            *(LAS u32x4*)(Ks + key * 144 + ds * 16) = kq;
            LAS unsigned short* vp = (LAS unsigned short*)Vt + (ds * 8) * 200 + key;
            vp[0 * 200] = (unsigned short)(vq.x & 0xffffu); vp[1 * 200] = (unsigned short)(vq.x >> 16);
            vp[2 * 200] = (unsigned short)(vq.y & 0xffffu); vp[3 * 200] = (unsigned short)(vq.y >> 16);
            vp[4 * 200] = (unsigned short)(vq.z & 0xffffu); vp[5 * 200] = (unsigned short)(vq.z >> 16);
            vp[6 * 200] = (unsigned short)(vq.w & 0xffffu); vp[7 * 200] = (unsigned short)(vq.w >> 16);
        }
        __syncthreads();
        const int g = F.wave >> 1, qi = (F.wave & 1) * 32 + (lane & 31), hh = lane >> 5, head = kv * 4 + g;
        const int qrow = isS ? NPROMPT + b * 64 + qi : b * 4096 + n * 64 + qi;
        bf16x8 Qf[4];
#pragma unroll
        for (int ks = 0; ks < 4; ++ks) Qf[ks] = *(const bf16x8*)(Z + (size_t)qrow * INW + head * 64 + ks * 16 + hh * 8);
        f32x16 S[6];
#pragma unroll
        for (int kb = 0; kb < 6; ++kb) {
#pragma unroll
            for (int j = 0; j < 16; ++j) S[kb][j] = 0.f;
#pragma unroll
            for (int ks = 0; ks < 4; ++ks) {
                const bf16x8 A = *(const LAS bf16x8*)(Ks + (kb * 32 + (lane & 31)) * 144 + (ks * 16 + hh * 8) * 2);
                S[kb] = __builtin_amdgcn_mfma_f32_32x32x16_bf16(A, Qf[ks], S[kb], 0, 0, 0);
            }
        }
        const float sinkv = F.in[14][l * 8 + head];
        float mx = sinkv;
        const int kmin = isS ? 0 : (128 - n * 64);
#pragma unroll
        for (int kb = 0; kb < 6; ++kb)
#pragma unroll
            for (int j = 0; j < 16; ++j) {
                const int key = kb * 32 + 8 * (j >> 2) + 4 * hh + (j & 3);
                float sv = S[kb][j] * 0.125f + bt[g * 256 + key - qi + 63];
                sv = key >= kmin ? sv : -1e30f;
                S[kb][j] = sv; mx = fmaxf(mx, sv);
            }
        mx = fmaxf(mx, __shfl_xor(mx, 32));
        float sum = 0.f;
#pragma unroll
        for (int kb = 0; kb < 6; ++kb)
#pragma unroll
            for (int j = 0; j < 16; ++j) { const float p = __expf(S[kb][j] - mx); S[kb][j] = p; sum += p; }
        sum += __shfl_xor(sum, 32);
        sum += __expf(sinkv - mx);
        const float inv = 1.0f / sum;
        f32x16 O[2];
#pragma unroll
        for (int db = 0; db < 2; ++db)
#pragma unroll
            for (int j = 0; j < 16; ++j) O[db][j] = 0.f;
#pragma unroll
        for (int kb = 0; kb < 6; ++kb)
#pragma unroll
            for (int s2 = 0; s2 < 2; ++s2) {
                union { bf16x8 v; unsigned u[4]; } P;
#pragma unroll
                for (int q = 0; q < 4; ++q) P.u[q] = cvt_pk_bf16(S[kb][8 * s2 + 2 * q], S[kb][8 * s2 + 2 * q + 1]);
#pragma unroll
                for (int db = 0; db < 2; ++db) {
                    const LAS unsigned char* vb = Vt + (db * 32 + (lane & 31)) * 400 + (kb * 32 + 16 * s2 + 4 * hh) * 2;
                    union { bf16x8 v; u32x2 h[2]; } Vf;
                    Vf.h[0] = *(const LAS u32x2*)vb; Vf.h[1] = *(const LAS u32x2*)(vb + 16);
                    O[db] = __builtin_amdgcn_mfma_f32_32x32x16_bf16(Vf.v, P.v, O[db], 0, 0, 0);
                }
            }
        unsigned char* orow = YA + (size_t)qrow * 512 + head * 64 + 4 * hh; const float inv8 = inv * 8.0f;
#pragma unroll
        for (int db = 0; db < 2; ++db)
#pragma unroll
            for (int jq = 0; jq < 4; ++jq) {
                *(unsigned*)(orow + db * 32 + 8 * jq) = pk4_fp8(O[db][4 * jq] * inv8, O[db][4 * jq + 1] * inv8, O[db][4 * jq + 2] * inv8, O[db][4 * jq + 3] * inv8);
            }
    }
    int nxtra = 1040 % F.G; if (1040 < F.G || 2 * nxtra > F.G) nxtra = 0;
    if (F.bx < nxtra) return;
    const int gw = (F.bx - nxtra) * NWAVES + F.wave, NGW = (F.G - nxtra) * NWAVES;
    const float* cw = F.in[15] + (size_t)l * 3 * 512 + 8 * lane;
    float w0[8], w1[8], w2[8];
#pragma unroll
    for (int e = 0; e < 8; ++e) { w0[e] = cw[e]; w1[e] = cw[512 + e]; w2[e] = cw[1024 + e]; }
    for (int row = gw; row < NT; row += NGW) {
        const bool isS = row >= NPROMPT; const int b = isS ? ((row - NPROMPT) >> 6) : (row >> 12), t = isS ? ((row - NPROMPT) & 63) : (row & 4095);
        const bf16_t* zr = Z + (size_t)row * INW + 8 * lane;
        const u32x4 cb = *(const u32x4*)(zr + 768);
        float u[3][8];
#pragma unroll
        for (int d = 0; d < 3; ++d) {
            if (t - d >= 0) {
                const bf16_t* zz = zr - (size_t)d * INW; const u32x4 cc = *(const u32x4*)(zz + 1280), cx = *(const u32x4*)(zz + 1792);
                u[d][0] = bf_lo(cc.x) * bf_lo(cx.x); u[d][1] = bf_hi(cc.x) * bf_hi(cx.x); u[d][2] = bf_lo(cc.y) * bf_lo(cx.y); u[d][3] = bf_hi(cc.y) * bf_hi(cx.y);
                u[d][4] = bf_lo(cc.z) * bf_lo(cx.z); u[d][5] = bf_hi(cc.z) * bf_hi(cx.z); u[d][6] = bf_lo(cc.w) * bf_lo(cx.w); u[d][7] = bf_hi(cc.w) * bf_hi(cx.w);
            } else if (isS) {
                const float* hp = F.in[6] + ((size_t)(l * 8 + b) * 2 + (2 + t - d)) * 512 + 8 * lane;
                const f32x4 h0 = *(const f32x4*)hp, h1 = *(const f32x4*)(hp + 4);
#pragma unroll
                for (int e = 0; e < 4; ++e) { u[d][e] = h0[e]; u[d][4 + e] = h1[e]; }
            } else {
#pragma unroll
                for (int e = 0; e < 8; ++e) u[d][e] = 0.f;
            }
        }
        const float cbf[8] = {bf_lo(cb.x), bf_hi(cb.x), bf_lo(cb.y), bf_hi(cb.y), bf_lo(cb.z), bf_hi(cb.z), bf_lo(cb.w), bf_hi(cb.w)};
        float y[8];
#pragma unroll
        for (int e = 0; e < 8; ++e) y[e] = cbf[e] * (w0[e] * u[2][e] + w1[e] * u[1][e] + w2[e] * u[0][e]);
        u32x2 w; w.x = pk4_fp8(y[0], y[1], y[2], y[3]); w.y = pk4_fp8(y[4], y[5], y[6], y[7]);
        *(u32x2*)(YB + (size_t)row * 512 + 8 * lane) = w;
        const int tl = isS ? 62 : 4094;
        if (t >= tl) {
            float* o = F.out + (isS ? OCS : OCP) + ((size_t)(l * 8 + b) * 2 + (t - tl)) * 512 + 8 * lane;
            *(f32x4*)o = (f32x4){u[0][0], u[0][1], u[0][2], u[0][3]}; *(f32x4*)(o + 4) = (f32x4){u[0][4], u[0][5], u[0][6], u[0][7]};
        }
    }
}

__device__ __forceinline__ void phase_ln_router(Ctx& F, int l) {
    bf16_t* XB = (bf16_t*)(F.ws + WS_XB); unsigned char* H8 = (unsigned char*)(F.ws + WS_H8); const bf16_t* V16 = (const bf16_t*)(F.ws + WS_V16);
    const float* mod = (const float*)(F.ws + WS_MOD) + (size_t)l * 16 * 6144;
    unsigned* cnt = (unsigned*)(F.ws + WS_CNT) + l * 2048;
    unsigned* tok = (unsigned*)(F.ws + WS_TOK); float* gate = (float*)(F.ws + WS_GATE); unsigned* slot = (unsigned*)(F.ws + WS_SLOT);
    const float* Wr = F.in[21] + (size_t)l * 1024 * 32;
    LAS float* hf = (LAS float*)F.lds;
    LAS unsigned char* Hh = F.lds;
    LAS unsigned char* Hl = F.lds + 66048;
    LAS unsigned* hist = (LAS unsigned*)(F.lds + 146432); LAS unsigned* hbase = hist + 32;
    LAS u32x4* rec = (LAS u32x4*)(F.lds + 132096);
    int nrec_tiles = 0;
    __syncthreads();
    if (F.tid < 32) hist[F.tid] = 0u;
    const int lane = F.lane, w = F.wave;
    bf16x8 bh[8], bl[8];
    {
#pragma unroll
        for (int ks = 0; ks < 8; ++ks) {
            const float* bp = Wr + (size_t)(128 * w + 16 * ks + 8 * (lane >> 5)) * 32 + (lane & 31);
            float wv[8];
#pragma unroll
            for (int j = 0; j < 8; ++j) wv[j] = bp[32 * j];
            union { bf16x8 v; unsigned u[4]; } ph, pl;
#pragma unroll
            for (int q = 0; q < 4; ++q) { const unsigned hw = cvt_pk_bf16(wv[2 * q], wv[2 * q + 1]); ph.u[q] = hw; pl.u[q] = cvt_pk_bf16(wv[2 * q] - bf_lo(hw), wv[2 * q + 1] - bf_hi(hw)); }
            bh[ks] = ph.v; bl[ks] = pl.v;
        }
    }
    for (int tidx = F.bx; tidx < 1024 + 256; tidx += F.G) {
        const int tile0 = tidx < 1024 ? tidx * 32 : NPROMPT + (tidx - 1024) * 2, nrows = tidx < 1024 ? 32 : 2;
        __syncthreads();
        if (w * 4 < nrows) {
            u32x2 pv[4][4];
#pragma unroll
            for (int rr = 0; rr < 4; ++rr) { const int rl = w * 4 + rr, row = rl < nrows ? tile0 + rl : tile0;
#pragma unroll
                for (int j = 0; j < 4; ++j) pv[rr][j] = *(const u32x2*)(V16 + (size_t)row * D + 4 * lane + 256 * j); }
#pragma unroll
            for (int rr = 0; rr < 4; ++rr) {
                const int rl = w * 4 + rr, row = tile0 + rl;
                if (rl < nrows) {
                    f32x4 v[4];
#pragma unroll
                    for (int j = 0; j < 4; ++j) v[j] = (f32x4){bf_lo(pv[rr][j].x), bf_hi(pv[rr][j].x), bf_lo(pv[rr][j].y), bf_hi(pv[rr][j].y)};
                    ln_row(v, F.in[19] + l * D, F.in[20] + l * D, lane);
#pragma unroll
                    for (int j = 0; j < 4; ++j) { u32x2 wq; wq.x = cvt_pk_bf16(v[j][0], v[j][1]); wq.y = cvt_pk_bf16(v[j][2], v[j][3]); *(u32x2*)(XB + (size_t)row * D + 4 * lane + 256 * j) = wq; }
                    const float* mb = mod + (size_t)batch_of(row) * 6144;
#pragma unroll
                    for (int j = 0; j < 4; ++j) { const f32x4 a = *(const f32x4*)(mb + 4096 + 4 * lane + 256 * j), b = *(const f32x4*)(mb + 3072 + 4 * lane + 256 * j);
                        const f32x4 h = v[j] * (a + 1.0f) + b;
                        *(unsigned*)(H8 + (size_t)row * D + 4 * lane + 256 * j) = pk4_fp8(h[0], h[1], h[2], h[3]);
                        u32x2 hw; hw.x = cvt_pk_bf16(h[0], h[1]); hw.y = cvt_pk_bf16(h[2], h[3]);
                        u32x2 lw; lw.x = cvt_pk_bf16(h[0] - bf_lo(hw.x), h[1] - bf_hi(hw.x)); lw.y = cvt_pk_bf16(h[2] - bf_lo(hw.y), h[3] - bf_hi(hw.y));
                        *(LAS u32x2*)(Hh + rl * 2064 + (4 * lane + 256 * j) * 2) = hw; *(LAS u32x2*)(Hl + rl * 2064 + (4 * lane + 256 * j) * 2) = lw; }
                }
            }
        }
        __syncthreads();
        f32x16 acc;
#pragma unroll
        for (int j = 0; j < 16; ++j) acc[j] = 0.f;
        {
            const int aoffb = (lane & 31) * 2064 + (128 * w + 8 * (lane >> 5)) * 2;
#pragma unroll
            for (int ks = 0; ks < 8; ++ks) {
                const bf16x8 ah = *(const LAS bf16x8*)(Hh + aoffb + ks * 32), al = *(const LAS bf16x8*)(Hl + aoffb + ks * 32);
                acc = __builtin_amdgcn_mfma_f32_32x32x16_bf16(ah, bh[ks], acc, 0, 0, 0);
                acc = __builtin_amdgcn_mfma_f32_32x32x16_bf16(ah, bl[ks], acc, 0, 0, 0);
                acc = __builtin_amdgcn_mfma_f32_32x32x16_bf16(al, bh[ks], acc, 0, 0, 0);
            }
        }
        __syncthreads();
        LAS float* red = hf;
#pragma unroll
        for (int j = 0; j < 16; ++j) red[(w * 32 + 8 * (j >> 2) + 4 * (lane >> 5) + (j & 3)) * 33 + (lane & 31)] = acc[j];
        __syncthreads();
        int e_sel[4]; float g_sel[4]; unsigned loc[4];
#pragma unroll
        for (int rr = 0; rr < 4; ++rr) {
            const int tk = w * 4 + rr;
            float val = -INFINITY;
            if (lane < 32) { float sacc = F.in[22][l * 32 + lane];
#pragma unroll
                for (int ww = 0; ww < 8; ++ww) sacc += red[(ww * 32 + tk) * 33 + lane];
                val = sacc; }
            float tv[4]; int te[4];
            {
                const int vbits = __float_as_int(val); int rank = 0;
#pragma unroll
                for (int j = 0; j < 32; ++j) { const float vj = __int_as_float(__builtin_amdgcn_readlane(vbits, j)); rank += (vj > val || (vj == val && j < lane)) ? 1 : 0; }
#pragma unroll
                for (int it = 0; it < 4; ++it) { const unsigned long long mk = __ballot(rank == it); const int ln = mk ? (__ffsll((long long)mk) - 1) : 0;
                    te[it] = ln; tv[it] = __int_as_float(__builtin_amdgcn_readlane(vbits, ln)); }
            }
            const float e1 = __expf(tv[1] - tv[0]), e2 = __expf(tv[2] - tv[0]), e3 = __expf(tv[3] - tv[0]);
            const float rs = 1.0f / (1.0f + e1 + e2 + e3);
            e_sel[rr] = lane == 0 ? te[0] : lane == 1 ? te[1] : lane == 2 ? te[2] : te[3];
            g_sel[rr] = (lane == 0 ? 1.0f : lane == 1 ? e1 : lane == 2 ? e2 : e3) * rs;
            loc[rr] = 0u;
            if (lane < 4 && tk < nrows) loc[rr] = atomicAdd((unsigned*)&hist[e_sel[rr]], 1u);
        }
        if (lane < 4) {
#pragma unroll
            for (int rr = 0; rr < 4; ++rr) {
                const int rl = w * 4 + rr;
                u32x4 rc; rc.x = (rl < nrows) ? (unsigned)(tile0 + rl) : 0xffffffffu; rc.y = (unsigned)(e_sel[rr] & 31); rc.z = loc[rr]; rc.w = __float_as_uint(g_sel[rr]);
                rec[(nrec_tiles * 32 + rl) * 4 + lane] = rc;
            }
        }
        ++nrec_tiles;
    }
    __syncthreads();
    if (F.tid < 32) { const unsigned hcount = hist[F.tid]; hbase[F.tid] = hcount ? atomicAdd(cnt + F.tid * 64, hcount) : 0u; }
    __syncthreads();
    for (int i = F.tid; i < nrec_tiles * 128; i += NTHREADS) {
        const u32x4 rc = rec[i];
        if (rc.x != 0xffffffffu) { const unsigned e = rc.y, rank = hbase[e] + rc.z;
            tok[(size_t)e * NT + rank] = rc.x; gate[(size_t)e * NT + rank] = __uint_as_float(rc.w); slot[(size_t)rc.x * 4 + (i & 3)] = (e << 24) | rank; }
    }
}

__device__ __forceinline__ void build_blk(Ctx& F, int l) {
    LAS int* blk = (LAS int*)(F.lds + LDS_BLK);
    const unsigned* cnt = (const unsigned*)(F.ws + WS_CNT) + l * 2048;
    __syncthreads();
    if (F.tid == 0) { LAS int* cl = (LAS int*)(F.lds + LDS_CNT); int s = 0; for (int e = 0; e < 32; ++e) { const int ce = (int)cnt[e * 64]; cl[e] = ce; blk[e] = s; s += (ce + 255) >> 8; } blk[32] = s; }
    __syncthreads();
}

__device__ __forceinline__ void phase_combine(Ctx& F, int l) {
    const LAS int* blk = (const LAS int*)(F.lds + LDS_BLK);
    float* X = F.out; bf16_t* XB = (bf16_t*)(F.ws + WS_XB); bf16_t* H = (bf16_t*)(F.ws + WS_H); const unsigned char* YS = F.ws + WS_YS;
    const unsigned* slot = (const unsigned*)(F.ws + WS_SLOT);
    const float* mod = (const float*)(F.ws + WS_MOD);
    const int gw = F.bx * NWAVES + F.wave, NGW = F.G * NWAVES, lane = F.lane;
    for (int row = gw; row < NT; row += NGW) {
        f32x4 ff[4];
#pragma unroll
        for (int j = 0; j < 4; ++j) ff[j] = (f32x4){0.f, 0.f, 0.f, 0.f};
#pragma unroll
        for (int k = 0; k < 4; ++k) {
            const unsigned s = slot[(size_t)row * 4 + k]; const int e = (int)(s >> 24), rank = (int)(s & 0xffffffu);
            const unsigned char* yr = YS + ((size_t)blk[e] * 256 + rank) * D + 4 * lane;
#pragma unroll
            for (int j = 0; j < 4; ++j) { const unsigned wv = *(const unsigned*)(yr + 256 * j); const f32x2 lo = __builtin_amdgcn_cvt_pk_f32_fp8(wv, false), hi = __builtin_amdgcn_cvt_pk_f32_fp8(wv, true);
                ff[j][0] += lo.x; ff[j][1] += lo.y; ff[j][2] += hi.x; ff[j][3] += hi.y; }
        }
        const int bi = batch_of(row);
        const float* mb = mod + (size_t)(l * 16 + bi) * 6144;
        f32x4 v[4];
#pragma unroll
        for (int j = 0; j < 4; ++j) { const u32x2 xw = *(const u32x2*)(XB + (size_t)row * D + 4 * lane + 256 * j); const f32x4 x = (f32x4){bf_lo(xw.x), bf_hi(xw.x), bf_lo(xw.y), bf_hi(xw.y)}, g2 = *(const f32x4*)(mb + 5120 + 4 * lane + 256 * j);
            v[j] = x * ALPHA + (g2 + 1.0f) * (ff[j] * 0.0625f); }
        ln_row(v, F.in[27] + l * D, F.in[28] + l * D, lane);
#pragma unroll
        for (int j = 0; j < 4; ++j) { if (l == 0) { u32x2 w; w.x = cvt_pk_bf16(v[j][0], v[j][1]); w.y = cvt_pk_bf16(v[j][2], v[j][3]); *(u32x2*)(XB + (size_t)row * D + 4 * lane + 256 * j) = w; }
            else *(f32x4*)(X + (size_t)row * D + 4 * lane + 256 * j) = v[j]; }
        if (l == 0) { const float* mn = mod + (size_t)(16 + bi) * 6144; store_mod_row(v, mn, mn + 1024, H + (size_t)row * D, F.ws + WS_H8 + (size_t)row * D, lane); }
    }
}

#ifndef PH_MASK
#define PH_MASK 0xFFFF
#endif
#define PH(b) ((PH_MASK >> (b)) & 1)
#ifndef PROBE_MASK
#define PROBE_MASK 0
#endif
#define PB0(id) do { if ((PROBE_MASK >> (id)) & 1) pb_t0 = __builtin_amdgcn_s_memrealtime(); } while (0)
#define PB1(id) do { if ((PROBE_MASK >> (id)) & 1) pb_acc += __builtin_amdgcn_s_memrealtime() - pb_t0; } while (0)
#define RELOAD() do { int t_ = threadIdx.x; asm volatile("" : "+v"(t_)); F.tid = t_; F.lane = t_ & 63; F.wave = __builtin_amdgcn_readfirstlane(t_ >> 6); \
    unsigned z_; asm volatile("s_mov_b32 %0, 0" : "=s"(z_)); F.in = p.in; F.out = p.out + z_; F.ws = p.ws + z_; } while (0)
#define LAYER_BODY(l) do { \
          \
        PB0(2); RELOAD(); \
        if (PH(2)) { \
              \
            pg8::SchedDense S; S.init(NT, 7 * 256, D, F.G, F.bx, (const bf16_t*)(F.ws + WS_WIN) + (size_t)l * INW * D, 2); \
            pg8::EpiZ E{(bf16_t*)(F.ws + WS_Z), F.in[13] + l * INW, F.out, l, F.ws + WS_ZG8}; \
            pg8::gemm_phase<false, 0u>(F.lds, (const char*)(F.ws + WS_H), D, S, E); \
        } \
        RELOAD(); \
        if (PH(2)) { \
              \
            pg8::SchedDense S; S.init(NT, 10 * 256, 512, F.G, (F.G == 256) ? ((F.bx + 112) & 255) : F.bx, F.ws + WS_WIN8 + (size_t)l * INW * D, 0, 2, 7); \
            pg8::EpiZ E{(bf16_t*)(F.ws + WS_Z), F.in[13] + l * INW, F.out, l, F.ws + WS_ZG8}; \
            pg8::gemm_phase<true, 0x7f7f7f7fu>(F.lds, (const char*)(F.ws + WS_H8), 512, S, E); \
        } \
        xcd_barrier(xbar); PB1(2); PB0(3); \
        RELOAD(); \
        if (PH(3)) phase_attn(F, l); \
        xcd_barrier(xbar); PB1(3); PB0(4); \
          \
        RELOAD(); \
        if (PH(4)) { \
            pg8::SchedDense S; S.init(NT, D, 256, F.G, F.bx, F.ws + WS_WOA + (size_t)l * D * 512); \
            pg8::EpiT1 E{F.ws + WS_T1, F.ws + WS_ZG8}; \
            pg8::gemm_phase<true, 0x7c7c7c7cu>(F.lds, (const char*)(F.ws + WS_YA), 256, S, E); \
        } \
        RELOAD(); \
        if (PH(5)) { \
            pg8::SchedDense S; S.init(NT, D, 256, F.G, F.bx, F.ws + WS_WOB + (size_t)l * D * 512); \
            pg8::EpiMix E{F.ws + WS_T1, F.ws + WS_ZG8, F.ws + WS_MIX}; \
            pg8::gemm_phase<true, 0x7f7f7f7fu>(F.lds, (const char*)(F.ws + WS_YB), 256, S, E); \
        } \
        xcd_barrier(xbar); PB1(4); PB0(5); \
          \
        RELOAD(); \
        if (PH(6)) { \
            pg8::SchedDense S; S.init(NT, D, 512, F.G, F.bx, F.ws + WS_WO + (size_t)l * D * D); \
            pg8::EpiX E{(const bf16_t*)(F.ws + WS_XB), (bf16_t*)(F.ws + WS_V16), (const float*)(F.ws + WS_MOD) + (size_t)l * 16 * 6144}; \
            pg8::gemm_phase<true, 0x7f7f7f7fu>(F.lds, (const char*)(F.ws + WS_MIX), 512, S, E); \
        } \
        xcd_barrier(xbar); PB1(5); PB0(6); \
        RELOAD(); \
        if (PH(7)) phase_ln_router(F, l); \
        xcd_barrier(xbar); PB1(6); PB0(7); \
          \
        RELOAD(); \
        build_blk(F, l); \
        if (PH(8)) { \
            LAS int* blk = (LAS int*)(F.lds + LDS_BLK); \
            LAS unsigned short* idx = (LAS unsigned short*)(F.lds + LDS_IDX); \
            pg8::SchedMoE<true> S; S.init(blk, idx, 8, 512, F.G, F.bx, (const unsigned char*)(F.ws + WS_WGU) + (size_t)l * 32 * 2048 * D, (size_t)2048 * D); \
            const unsigned* cnt = (const unsigned*)(F.ws + WS_CNT) + l * 2048; const unsigned* tok = (const unsigned*)(F.ws + WS_TOK); \
            for (int i = 0; i < MAXU; ++i) { pg8::Unit u; if (!S.next(i, u)) break; \
                if (F.tid < 256) { int rank = (u.pm - blk[u.e]) * 256 + F.tid; const int ce = (int)cnt[u.e * 64]; rank = rank < ce ? rank : ce - 1; \
                    idx[i * 256 + F.tid] = (unsigned short)tok[(size_t)u.e * NT + rank]; } } \
            __syncthreads(); \
            pg8::EpiAct E{(unsigned char*)(F.ws + WS_ACT), F.in[24] + (size_t)l * 32 * 2048}; \
            pg8::gemm_phase<true, 0x7f7f7f7fu>(F.lds, (const char*)(F.ws + WS_H8), 512, S, E); \
        } \
        xcd_barrier(xbar); PB1(7); PB0(8); \
          \
        RELOAD(); \
        if (PH(9)) { \
            LAS int* blk = (LAS int*)(F.lds + LDS_BLK); \
            LAS unsigned short* idx = (LAS unsigned short*)(F.lds + LDS_IDX); \
            pg8::SchedMoE<false> S; S.init(blk, idx, 4, 512, F.G, F.bx, (const unsigned char*)(F.ws + WS_WDN) + (size_t)l * 32 * D * D, (size_t)D * D); \
            pg8::EpiYs E{F.ws + WS_YS, F.in[26] + (size_t)l * 32 * D, (const float*)(F.ws + WS_GATE), (const LAS int*)(F.lds + LDS_CNT), blk}; \
            pg8::gemm_phase<true, 0x7f7f7f7fu>(F.lds, (const char*)(F.ws + WS_ACT), 512, S, E); \
        } \
        xcd_barrier(xbar); PB1(8); PB0(9); \
        RELOAD(); \
        if (PH(10)) phase_combine(F, l); \
        if (l == 0) xcd_barrier(xbar); \
        PB1(9); \
 \
    } while (0)
__global__ void __launch_bounds__(NTHREADS, 2) fwd_megakernel(Params p) {
    extern __shared__ __attribute__((aligned(16))) unsigned char lds_raw[];
    cg::grid_group grid = cg::this_grid();
    Ctx F;
    F.lds = (LAS unsigned char*)lds_raw;
    F.G = gridDim.x; F.bx = blockIdx.x;
    volatile LAS unsigned* bst = (volatile LAS unsigned*)(F.lds + 147392);
    if (threadIdx.x < 2) bst[threadIdx.x] = 0u;
    __syncthreads();
    const XcdBarrier xbar = xcd_barrier_post((unsigned*)(p.ws + WS_BAR), bst);
    unsigned long long pb_t0 = 0, pb_acc = 0;
    PB0(0); RELOAD();
    if (PH(0)) phase0a(F);
    grid.sync();
    PB1(0); PB0(1); RELOAD();
    { const float* modp = (const float*)(F.ws + WS_MODP); float* mod = (float*)(F.ws + WS_MOD);
      for (int i = F.bx * NTHREADS + F.tid; i < 2 * 16 * 6144; i += F.G * NTHREADS) { float sm = 0.f;
#pragma unroll
          for (int kc = 0; kc < 8; ++kc) sm += modp[(size_t)kc * (2 * 16 * 6144) + i];
          mod[i] = sm; } }
    xcd_barrier(xbar);
    RELOAD();
    if (PH(1)) phase0b(F);
    xcd_barrier(xbar); PB1(1);

    LAYER_BODY(0);
    LAYER_BODY(1);
    if (PROBE_MASK != 0 && blockIdx.x == 0) { const unsigned long long te = __builtin_amdgcn_s_memrealtime(); while (__builtin_amdgcn_s_memrealtime() - te < pb_acc) __builtin_amdgcn_s_sleep(8); }
    (void)pb_t0; (void)pb_acc;
}

extern "C" void kernel_launch(void* const* d_in, const int* in_sizes, int n_in, void* d_out, int out_size, void* d_ws, size_t ws_size, hipStream_t stream) {
    static int grid = 0;
    if (grid == 0) {
        if (n_in != 29 || ws_size < WS_END) { fprintf(stderr, "kernel_launch: unexpected n_in %d / ws_size %zu (need %zu)\n", n_in, ws_size, (size_t)WS_END); grid = -1; return; }
        int dev = 0, cus = 0, per_cu = 0;
        hipGetDevice(&dev);
        hipDeviceGetAttribute(&cus, hipDeviceAttributeMultiprocessorCount, dev);
        if (hipFuncSetAttribute((const void*)fwd_megakernel, hipFuncAttributeMaxDynamicSharedMemorySize, LDS_BYTES) != hipSuccess) { fprintf(stderr, "kernel_launch: hipFuncSetAttribute failed\n"); grid = -1; return; }
        if (hipOccupancyMaxActiveBlocksPerMultiprocessor(&per_cu, (const void*)fwd_megakernel, NTHREADS, LDS_BYTES) != hipSuccess || per_cu < 1) { fprintf(stderr, "kernel_launch: occupancy query says %d blocks per CU\n", per_cu); per_cu = 1; }
        (void)hipGetLastError();
        grid = cus;
        if (grid != 256) fprintf(stderr, "kernel_launch: note: %d CUs (built for 256)\n", grid);
    }
    if (grid < 0) return;
    hipMemsetAsync((char*)d_ws, 0, WS_ZERO_BYTES, stream);
    Params p{};
    for (int i = 0; i < 29; ++i) p.in[i] = (const float*)d_in[i];
    p.out = (float*)d_out; p.ws = (unsigned char*)d_ws;
    void* args[] = {&p};
    hipError_t e = hipLaunchCooperativeKernel((const void*)fwd_megakernel, dim3(grid), dim3(NTHREADS), args, LDS_BYTES, stream);
    if (e != hipSuccess) fprintf(stderr, "kernel_launch: cooperative launch failed: %s (grid %d)\n", hipGetErrorString(e), grid);
}
```

```cpp
#include <hip/hip_runtime.h>
#include <hip/hip_cooperative_groups.h>
#include <cstdio>
#include <cstdint>
namespace cg = cooperative_groups;

#define LAS __attribute__((address_space(3)))
typedef unsigned short bf16_t;
typedef short bf16x8 __attribute__((ext_vector_type(8)));
typedef float f32x4 __attribute__((ext_vector_type(4)));
typedef float f32x16 __attribute__((ext_vector_type(16)));
typedef unsigned u32x4 __attribute__((ext_vector_type(4)));
typedef unsigned u32x2 __attribute__((ext_vector_type(2)));
typedef float f32x2 __attribute__((ext_vector_type(2)));
typedef int i32x4 __attribute__((ext_vector_type(4)));
typedef int i32x8 __attribute__((ext_vector_type(8)));

constexpr int D = 1024, NPROMPT = 32768, NT = 33280, INW = 4352, NEXP = 32;
constexpr float ALPHA = 1.41421356237f, LN_EPS = 1e-5f;
constexpr int NWAVES = 8, NTHREADS = 512;
constexpr int LDS_BYTES = 147456;
constexpr int LDS_BLK = 131072;
constexpr int LDS_IDX = 131072 + 256;
constexpr int MAXU = 20;
constexpr int LDS_BIASBUF = 141568;
constexpr int LDS_CNT = 145664;
constexpr size_t OKP = 34078720, OVP = 34340864, OCP = 34603008, OKS = 34619392, OVS = 34881536, OCS = 35143680;
constexpr size_t MiB = 1u << 20;
constexpr size_t WS_CNT = 0;
constexpr size_t WS_BAR = 16384;
constexpr size_t WS_MOD = 65536;
constexpr size_t WS_MODP = 192 * MiB;
constexpr size_t WS_ZERO_BYTES = 1 * MiB;
constexpr size_t WS_BIAS = 1 * MiB;
constexpr size_t WS_SLOT = 2 * MiB;
constexpr size_t WS_TOK = 3 * MiB;
constexpr size_t WS_GATE = 8 * MiB;
constexpr size_t WS_WIN = 16 * MiB;
constexpr size_t WS_WIN8 = 180 * MiB;
constexpr size_t WS_WOA = 34 * MiB;
constexpr size_t WS_WOB = 36 * MiB;
constexpr size_t WS_WO = 38 * MiB;
constexpr size_t WS_WGU = 48 * MiB;
constexpr size_t WS_WDN = 304 * MiB;
constexpr size_t WS_H = 432 * MiB;
constexpr size_t WS_H8 = 1600 * MiB;
constexpr size_t WS_Z = 498 * MiB;
constexpr size_t WS_YA = 776 * MiB;
constexpr size_t WS_YB = 810 * MiB;
constexpr size_t WS_T1 = 844 * MiB;
constexpr size_t WS_V16 = 910 * MiB;
constexpr size_t WS_XB = 1200 * MiB;
constexpr size_t WS_MIX = 976 * MiB;
constexpr size_t WS_ACT = 1042 * MiB;
constexpr size_t WS_YS = 1320 * MiB;
constexpr size_t WS_ZG8 = 1460 * MiB;
constexpr size_t WS_END = 1634 * MiB;

struct Params { const float* in[29]; float* out; unsigned char* ws; };

__device__ __forceinline__ unsigned cvt_pk_bf16(float lo, float hi) { unsigned r; asm volatile("v_cvt_pk_bf16_f32 %0, %1, %2" : "=v"(r) : "v"(lo), "v"(hi)); return r; }
__device__ __forceinline__ unsigned pk4_fp8(float a, float b, float c, float d) { unsigned w = 0u; w = __builtin_amdgcn_cvt_pk_fp8_f32(a, b, w, false); w = __builtin_amdgcn_cvt_pk_fp8_f32(c, d, w, true); return w; }
__device__ __forceinline__ void unpk8_fp8(const u32x2 w, float (&o)[8]) { const f32x2 a = __builtin_amdgcn_cvt_pk_f32_fp8(w.x, false), b = __builtin_amdgcn_cvt_pk_f32_fp8(w.x, true), c = __builtin_amdgcn_cvt_pk_f32_fp8(w.y, false), d = __builtin_amdgcn_cvt_pk_f32_fp8(w.y, true);
    o[0] = a.x; o[1] = a.y; o[2] = b.x; o[3] = b.y; o[4] = c.x; o[5] = c.y; o[6] = d.x; o[7] = d.y; }
__device__ __forceinline__ void store_pair16(unsigned char* pa, unsigned char* pb, int fq, u32x2 wa, u32x2 wb) {
    const auto rx = __builtin_amdgcn_permlane16_swap(wa.x, wb.x, false, false);
    const auto ry = __builtin_amdgcn_permlane16_swap(wa.y, wb.y, false, false);
    u32x4 o; o.x = rx[0]; o.y = ry[0]; o.z = rx[1]; o.w = ry[1];
    *(u32x4*)((fq & 1) ? pb - 8 : pa) = o;
}
__device__ __forceinline__ void load_pair16(const unsigned char* pa, const unsigned char* pb, int fq, u32x2& wa, u32x2& wb) {
    const u32x4 x = *(const u32x4*)((fq & 1) ? pb - 8 : pa);
    const auto rx = __builtin_amdgcn_permlane16_swap(x.x, x.z, false, false);
    const auto ry = __builtin_amdgcn_permlane16_swap(x.y, x.w, false, false);
    wa.x = rx[0]; wa.y = ry[0]; wb.x = rx[1]; wb.y = ry[1];
}
__device__ __forceinline__ float bf_lo(unsigned w) { return __uint_as_float(w << 16); }
__device__ __forceinline__ float bf_hi(unsigned w) { return __uint_as_float(w & 0xffff0000u); }
__device__ __forceinline__ float sigmoidf_(float x) { return __builtin_amdgcn_rcpf(1.0f + __expf(-x)); }
__device__ __forceinline__ f32x2 sigmoid2(f32x2 x) {
    const f32x2 t = x * (-1.44269504089f);
    f32x2 e; e.x = __builtin_amdgcn_exp2f(t.x); e.y = __builtin_amdgcn_exp2f(t.y);
    const f32x2 d = e + 1.0f;
    f32x2 r; r.x = __builtin_amdgcn_rcpf(d.x); r.y = __builtin_amdgcn_rcpf(d.y);
    return r;
}
__device__ __forceinline__ float wave_sum(float v) {
#define WS_DPP_ADD(ctrl) v += __int_as_float(__builtin_amdgcn_update_dpp(0, __float_as_int(v), (ctrl), 0xf, 0xf, true))
    WS_DPP_ADD(0xB1);
    WS_DPP_ADD(0x4E);
    WS_DPP_ADD(0x141);
    WS_DPP_ADD(0x140);
#undef WS_DPP_ADD
    const int b = __float_as_int(v);
    const float r0 = __int_as_float(__builtin_amdgcn_readlane(b, 0)), r1 = __int_as_float(__builtin_amdgcn_readlane(b, 16)), r2 = __int_as_float(__builtin_amdgcn_readlane(b, 32)), r3 = __int_as_float(__builtin_amdgcn_readlane(b, 48));
    return (r0 + r1) + (r2 + r3);
}
__device__ __forceinline__ int batch_of(int row) { return row < NPROMPT ? (row >> 12) : 8 + ((row - NPROMPT) >> 6); }

namespace pg8 {
constexpr int BM = 256, BK = 64, HALF = 128, HTB = HALF * BK * 2, NXCD = 8, WGM = 8;
__device__ __forceinline__ int lds_byte(int r, int c) { const int st = (r >> 4) * 2 + (c >> 5), rr = r & 15, cc = c & 31, ob = rr * 64 + cc * 2; return st * 1024 + (ob ^ (((ob >> 9) & 1) << 5)); }
__device__ __forceinline__ void stage_rc(int b, int& R, int& C) { const int st = b / 1024, sb = b % 1024, swz = sb ^ (((sb >> 9) & 1) << 5); R = (st >> 1) * 16 + swz / 64; C = (st & 1) * 32 + (swz % 64) / 2; }
__device__ __forceinline__ int perm32(int rho) { const int n = rho >> 4, i = rho & 15; return 8 * (i >> 2) + 4 * n + (i & 3); }

struct Unit { int pm, pn, e; const char* b; };

struct SchedDense {
    int nM, nN, nwg, G, c, cbase, csplit, cskip; const char* Bt; size_t tstepB;
    __device__ __forceinline__ void init(int M, int N, int K, int G_, int c_, const void* Bt_, int cbase_ = 0, int csplit_ = 1 << 20, int cskip_ = 0) { nM = M / BM; nN = N / BM; nwg = nM * nN; G = G_; c = c_; Bt = (const char*)Bt_; tstepB = (size_t)BM * K * 2; cbase = cbase_; csplit = csplit_; cskip = cskip_; }
    __device__ __forceinline__ bool next(int i, Unit& u) const {
        const long L = (long)i * G + c; if (L >= nwg) return false;
        int wgid = (int)L; { const int q = nwg / NXCD, r = nwg % NXCD, xcd = wgid % NXCD, off = wgid / NXCD; wgid = (xcd < r ? xcd * (q + 1) : r * (q + 1) + (xcd - r) * q) + off; }
        const int nig = WGM * nN, gid = wgid / nig, fm = gid * WGM, gsz = (nM - fm) < WGM ? (nM - fm) : WGM;
        u.pm = fm + ((wgid % nig) % gsz); const int j = (wgid % nig) / gsz; u.pn = j < csplit ? j + cbase : j + cbase + cskip; u.e = 0; u.b = Bt + (size_t)u.pn * tstepB; return true;
    }
    __device__ __forceinline__ unsigned rowidx(int, const Unit& u, int r) const { return (unsigned)(u.pm * BM + r); }
};
template <bool GATHER> struct SchedMoE {
    const LAS int* blk; const LAS unsigned short* idx; int NB, RBX, NPN, NXs, perx, cx, cj; const char* Bt; size_t estep, tstepB;
    __device__ __forceinline__ void init(const LAS int* blk_, const LAS unsigned short* idx_, int NPN_, int K, int G, int c, const void* Bt_, size_t estep_) {
        blk = blk_; idx = idx_; NB = blk_[32]; NPN = NPN_; Bt = (const char*)Bt_; estep = estep_; tstepB = (size_t)BM * K * 2;
        if ((G & 7) == 0) { NXs = 8; perx = G >> 3; cx = c & 7; cj = c >> 3; } else { NXs = 1; perx = G; cx = 0; cj = c; }
        RBX = (NB + NXs - 1) / NXs;
    }
    __device__ __forceinline__ bool next(int i, Unit& u) const {
        const int j = i * perx + cj, rbl = j / NPN; if (rbl >= RBX) return false;
        const int rb = cx * RBX + rbl; if (rb >= NB) return false;
        int e = 0;
        for (int q = 1; q < 32; ++q) e = (blk[q] <= rb) ? q : e;
        u.pm = rb; u.pn = j - rbl * NPN; u.e = e; u.b = Bt + (size_t)e * estep + (size_t)u.pn * tstepB; return true;
    }
    __device__ __forceinline__ unsigned rowidx(int ui, const Unit& u, int r) const { if (GATHER) return (unsigned)idx[ui * 256 + r]; return (unsigned)(u.pm * BM + r); }
};

template <bool FP8, unsigned ASCALE, class Epi, class Sched>
__device__ __forceinline__ void gemm_phase(LAS unsigned char* lds, const char* Abase, const int K, const Sched& S, const Epi& E) {
    int tid_ = threadIdx.x; asm volatile("" : "+v"(tid_));
    const int tid = tid_, wid = __builtin_amdgcn_readfirstlane(tid >> 6), lane = tid & 63, wr = wid >> 2, wc = wid & 3, fr = lane & 15, fq = lane >> 4;
    int nt_ = K / BK; asm volatile("" : "+s"(nt_)); const int nt = nt_;
    unsigned voffB[2]; int RA[2], CA[2];
#pragma unroll
    for (int i = 0; i < 2; ++i) { int R, C; stage_rc(tid * 16 + i * 8192, R, C); const int Rb = Epi::PERM ? ((R & ~31) + perm32(R & 31)) : R;
        voffB[i] = (unsigned)(Rb * K + C) * 2u; RA[i] = R; CA[i] = C * 2; }
    const size_t kstep = (size_t)(BK * 2);
    const size_t hstep = (size_t)HALF * K * 2;
    const unsigned ldsw = (unsigned)wid * 1024u;
    const unsigned rowb = (unsigned)K * 2u;
    const int aoff = lds_byte(wr * 64 + fr, fq * 8), boff = lds_byte(wc * 32 + fr, fq * 8);
#define PG8_SA(b, h) (((b) * 2 + (h)) * HTB)
#define PG8_SB(b, h) ((4 + (b) * 2 + (h)) * HTB)
#define PG8_STAGE(bufoff, gbase, voff) do { _Pragma("unroll") for (int _i = 0; _i < 2; ++_i) \
        __builtin_amdgcn_global_load_lds((const unsigned*)((const char*)(gbase) + (voff)[_i]), (LAS unsigned*)(lds + (bufoff) + ldsw + _i * 8192), 16, 0, 0); } while (0)
#define PG8_LDA(dst, b, h) do { _Pragma("unroll") for (int m = 0; m < 4; ++m) _Pragma("unroll") for (int k = 0; k < 2; ++k) dst[m][k] = *(const LAS bf16x8*)(lds + PG8_SA(b, h) + aoff + m * 2048 + k * 1024); } while (0)
#define PG8_LDB(dst, b, h) do { _Pragma("unroll") for (int n = 0; n < 2; ++n) _Pragma("unroll") for (int k = 0; k < 2; ++k) dst[n][k] = *(const LAS bf16x8*)(lds + PG8_SB(b, h) + boff + n * 2048 + k * 1024); } while (0)
#define PG8_MMA(ai, bj, At, Bt) do { __builtin_amdgcn_s_setprio(1); _Pragma("unroll") for (int m = 0; m < 4; ++m) _Pragma("unroll") for (int n = 0; n < 2; ++n) { \
        if constexpr (FP8) { \
            const i32x8 wf_ = __builtin_shufflevector((i32x4)Bt[n][0], (i32x4)Bt[n][1], 0, 1, 2, 3, 4, 5, 6, 7), af_ = __builtin_shufflevector((i32x4)At[m][0], (i32x4)At[m][1], 0, 1, 2, 3, 4, 5, 6, 7); \
            acc[ai][bj][m][n] = __builtin_amdgcn_mfma_scale_f32_16x16x128_f8f6f4(wf_, af_, acc[ai][bj][m][n], 0, 0, 0, 0x79797979, 0, (int)ASCALE); \
        } else { _Pragma("unroll") for (int k = 0; k < 2; ++k) \
            acc[ai][bj][m][n] = __builtin_amdgcn_mfma_f32_16x16x32_bf16(Bt[n][k], At[m][k], acc[ai][bj][m][n], 0, 0, 0); } } \
        __builtin_amdgcn_s_setprio(0); } while (0)
#define PG8_WAIT_V(n) asm volatile("s_waitcnt vmcnt(" #n ")" ::: "memory")
#define PG8_WAIT_L(n) asm volatile("s_waitcnt lgkmcnt(" #n ")" ::: "memory")
#define PG8_BAR __builtin_amdgcn_s_barrier()
#define PG8_SCHED __builtin_amdgcn_sched_barrier(0)
#define PG8_LOADVA(ui_, u_) do { _Pragma("unroll") for (int _h = 0; _h < 2; ++_h) _Pragma("unroll") for (int _i = 0; _i < 2; ++_i) \
        vA[_h][_i] = S.rowidx((ui_), (u_), _h * HALF + RA[_i]) * rowb + (unsigned)CA[_i]; } while (0)
    Unit cur, nxt; int ui = 0;
    if (!S.next(0, cur)) return;
    f32x4 acc[2][2][4][2];
#pragma unroll
    for (int a = 0; a < 2; ++a)
#pragma unroll
        for (int b = 0; b < 2; ++b)
#pragma unroll
            for (int m = 0; m < 4; ++m)
#pragma unroll
                for (int n = 0; n < 2; ++n) acc[a][b][m][n] = (f32x4){0.f, 0.f, 0.f, 0.f};
    bf16x8 At[4][2], B0[2][2], B1[2][2];
    unsigned vA[2][2];
    PG8_LOADVA(0, cur);
    const char* cB = cur.b;
    if (Epi::BIAS && tid < 64) __builtin_amdgcn_global_load_lds((const unsigned*)E.bias_ptr(cur, tid), (LAS unsigned*)(lds + LDS_BIASBUF), 16, 0, 0);
    if (Epi::EXTRA && tid < 64) __builtin_amdgcn_global_load_lds((const unsigned*)E.extra_ptr(cur, tid), (LAS unsigned*)(lds + LDS_BIASBUF + 1024), 16, 0, 0);
    PG8_STAGE(PG8_SB(0, 0), cB, voffB); PG8_STAGE(PG8_SB(0, 1), cB + hstep, voffB); PG8_STAGE(PG8_SA(0, 0), Abase, vA[0]); PG8_STAGE(PG8_SA(0, 1), Abase, vA[1]);
    if (wr == 1) PG8_BAR;
    PG8_WAIT_V(2); PG8_BAR;
    PG8_STAGE(PG8_SB(1, 0), cB + kstep, voffB); PG8_STAGE(PG8_SA(1, 0), Abase + kstep, vA[0]); PG8_STAGE(PG8_SB(1, 1), cB + hstep + kstep, voffB);
    PG8_WAIT_V(6); PG8_BAR;
    for (;;) {
        const bool has_next = S.next(ui + 1, nxt);
        const char* nB = has_next ? nxt.b : cB;
#pragma unroll 1
        for (int t = 0; t < nt; t += 2) {
            const bool last = (t == nt - 2);
            const char* a1 = Abase + (size_t)(t + 1) * kstep;
            const char* a2 = last ? Abase : Abase + (size_t)(t + 2) * kstep;
            const char* b2 = last ? nB : cB + (size_t)(t + 2) * kstep;
            const char* a3 = a2 + kstep; const char* b3 = b2 + kstep;
            PG8_LDB(B0, 0, 0); PG8_LDB(B1, 0, 1); PG8_SCHED; PG8_LDA(At, 0, 0); PG8_STAGE(PG8_SA(1, 1), a1, vA[1]);
            if (last && has_next) { PG8_LOADVA(ui + 1, nxt);
                if (Epi::BIAS && tid < 64) __builtin_amdgcn_global_load_lds((const unsigned*)E.bias_ptr(nxt, tid), (LAS unsigned*)(lds + LDS_BIASBUF + ((ui + 1) & 1) * 2048), 16, 0, 0);
                if (Epi::EXTRA && tid < 64) __builtin_amdgcn_global_load_lds((const unsigned*)E.extra_ptr(nxt, tid), (LAS unsigned*)(lds + LDS_BIASBUF + ((ui + 1) & 1) * 2048 + 1024), 16, 0, 0); }
            PG8_WAIT_V(8); PG8_WAIT_L(0); PG8_BAR; PG8_MMA(0, 0, At, B0); PG8_MMA(0, 1, At, B1); PG8_BAR; PG8_SCHED;
            PG8_LDA(At, 0, 1); PG8_STAGE(PG8_SB(0, 0), b2, voffB); PG8_STAGE(PG8_SB(0, 1), b2 + hstep, voffB); PG8_STAGE(PG8_SA(0, 0), a2, vA[0]);
            PG8_WAIT_V(8); PG8_WAIT_L(0); PG8_BAR; PG8_MMA(1, 0, At, B0); PG8_MMA(1, 1, At, B1); PG8_BAR; PG8_SCHED;
            PG8_LDB(B0, 1, 0); PG8_LDB(B1, 1, 1); PG8_SCHED; PG8_LDA(At, 1, 0); PG8_STAGE(PG8_SA(0, 1), a2, vA[1]);
            PG8_WAIT_V(8); PG8_WAIT_L(0); PG8_BAR; PG8_MMA(0, 0, At, B0); PG8_MMA(0, 1, At, B1); PG8_BAR; PG8_SCHED;
            PG8_LDA(At, 1, 1); PG8_STAGE(PG8_SB(1, 0), b3, voffB); PG8_STAGE(PG8_SB(1, 1), b3 + hstep, voffB); PG8_STAGE(PG8_SA(1, 0), a3, vA[0]);
            PG8_WAIT_V(8); PG8_WAIT_L(0); PG8_BAR; PG8_MMA(1, 0, At, B0); PG8_MMA(1, 1, At, B1); PG8_BAR; PG8_SCHED;
        }
        if (wr == 0) PG8_BAR;
        E(acc, cur, wr, wc, fr, fq, (const LAS float*)(lds + LDS_BIASBUF + (ui & 1) * 2048));
        if (!has_next) break;
#pragma unroll
        for (int a = 0; a < 2; ++a)
#pragma unroll
            for (int b = 0; b < 2; ++b)
#pragma unroll
                for (int m = 0; m < 4; ++m)
#pragma unroll
                    for (int n = 0; n < 2; ++n) acc[a][b][m][n] = (f32x4){0.f, 0.f, 0.f, 0.f};
        cur = nxt; cB = nB; ++ui;
        if (wr == 1) PG8_BAR;
    }
    PG8_WAIT_V(0);
    PG8_BAR;
#undef PG8_SA
#undef PG8_SB
#undef PG8_STAGE
#undef PG8_LDA
#undef PG8_LDB
#undef PG8_MMA
#undef PG8_WAIT_V
#undef PG8_WAIT_L
#undef PG8_BAR
#undef PG8_SCHED
#undef PG8_LOADVA
}

typedef f32x4 Acc[2][2][4][2];

struct EpiZ {
    static constexpr bool PERM = true, BIAS = true, EXTRA = false;
    __device__ __forceinline__ const float* extra_ptr(const Unit&, int) const { return nullptr; }
    __device__ __forceinline__ const float* bias_ptr(const Unit& u, int t) const { return bias + u.pn * 256 + 4 * t; }
    bf16_t* Z; const float* bias; float* out; int l; unsigned char* ZG;
    __device__ __forceinline__ void operator()(const Acc& acc, const Unit& u, int wr, int wc, int fr, int fq, const LAS float* lb) const {
        const int row0 = u.pm * 256 + wr * 64 + fr, col0 = u.pn * 256 + wc * 32 + 8 * fq;
        u32x2 wprev[2];
        f32x4 bv[2][2];
#pragma unroll
        for (int bj = 0; bj < 2; ++bj)
#pragma unroll
            for (int n = 0; n < 2; ++n) bv[bj][n] = *(const LAS f32x4*)(lb + bj * 128 + wc * 32 + 8 * fq + 4 * n);
#pragma unroll
        for (int ai = 0; ai < 2; ++ai)
#pragma unroll
            for (int m = 0; m < 4; ++m) {
                const int row = row0 + ai * 128 + m * 16;
                bf16_t* rowp = Z + (size_t)row * INW + col0;
                float* ko = nullptr; float* vo = nullptr;
                if (u.pn == 2) {
                    if (row < NPROMPT) { const int t = row & 4095; if (t >= 3968) { const size_t o = ((size_t)(l * 8 + (row >> 12)) * 128 + (t - 3968)) * 128 + wc * 32 + 8 * fq; ko = out + OKP + o; vo = out + OVP + o; } }
                    else { const int rr = row - NPROMPT; const size_t o = ((size_t)(l * 8 + (rr >> 6)) * 128 + 64 + (rr & 63)) * 128 + wc * 32 + 8 * fq; ko = out + OKS + o; vo = out + OVS + o; }
                }
#pragma unroll
                for (int bj = 0; bj < 2; ++bj) {
                    const f32x4 v0 = acc[ai][bj][m][0] + bv[bj][0], v1 = acc[ai][bj][m][1] + bv[bj][1];
                    if (u.pn >= 9) { u32x2 w8; w8.x = pk4_fp8(v0[0], v0[1], v0[2], v0[3]); w8.y = pk4_fp8(v1[0], v1[1], v1[2], v1[3]);
                        unsigned char* pz = ZG + (size_t)row * 2048 + (col0 - 2304) + bj * 128;
                        if ((m & 1) == 0) wprev[bj] = w8; else store_pair16(pz - (size_t)16 * 2048, pz, fq, wprev[bj], w8); }
                    else { u32x4 w; w.x = cvt_pk_bf16(v0[0], v0[1]); w.y = cvt_pk_bf16(v0[2], v0[3]); w.z = cvt_pk_bf16(v1[0], v1[1]); w.w = cvt_pk_bf16(v1[2], v1[3]);
                        *(u32x4*)(rowp + bj * 128) = w; }
                    float* o = bj == 0 ? ko : vo;
                    if (o) { *(f32x4*)o = v0; *(f32x4*)(o + 4) = v1; }
                }
                asm volatile("" ::: "memory");
            }
    }
};
struct EpiT1 {
    static constexpr bool PERM = true, BIAS = false, EXTRA = false;
    __device__ __forceinline__ const float* extra_ptr(const Unit&, int) const { return nullptr; }
    __device__ __forceinline__ const float* bias_ptr(const Unit&, int) const { return nullptr; }
    unsigned char* T1; const unsigned char* ZG;
    __device__ __forceinline__ void operator()(const Acc& acc, const Unit& u, int wr, int wc, int fr, int fq, const LAS float* lb) const {
        const int row0 = u.pm * 256 + wr * 64 + fr, col0 = u.pn * 256 + wc * 32 + 8 * fq;
        u32x2 g[2][4][2];
#pragma unroll
        for (int ai = 0; ai < 2; ++ai)
#pragma unroll
            for (int m = 0; m < 4; m += 2)
#pragma unroll
                for (int bj = 0; bj < 2; ++bj) { const unsigned char* pa = ZG + (size_t)(row0 + ai * 128 + m * 16) * 2048 + col0 + bj * 128;
                    load_pair16(pa, pa + (size_t)16 * 2048, fq, g[ai][m][bj], g[ai][m + 1][bj]); }
        asm volatile("" ::: "memory");
        u32x2 wprev[2];
#pragma unroll
        for (int ai = 0; ai < 2; ++ai)
#pragma unroll
            for (int m = 0; m < 4; ++m) {
                const int row = row0 + ai * 128 + m * 16;
#pragma unroll
                for (int bj = 0; bj < 2; ++bj) {
                    const u32x2 gw = g[ai][m][bj];
                    const f32x2 s0 = sigmoid2(__builtin_amdgcn_cvt_pk_f32_fp8(gw.x, false)), s1 = sigmoid2(__builtin_amdgcn_cvt_pk_f32_fp8(gw.x, true)),
                                s2 = sigmoid2(__builtin_amdgcn_cvt_pk_f32_fp8(gw.y, false)), s3 = sigmoid2(__builtin_amdgcn_cvt_pk_f32_fp8(gw.y, true));
                    const f32x4 a0 = acc[ai][bj][m][0], a1 = acc[ai][bj][m][1];
                    const f32x2 p0 = ((f32x2){a0[0], a0[1]} * 16.0f) * s0, p1 = ((f32x2){a0[2], a0[3]} * 16.0f) * s1, p2 = ((f32x2){a1[0], a1[1]} * 16.0f) * s2, p3 = ((f32x2){a1[2], a1[3]} * 16.0f) * s3;
                    u32x2 w; w.x = pk4_fp8(p0.x, p0.y, p1.x, p1.y); w.y = pk4_fp8(p2.x, p2.y, p3.x, p3.y);
                    if ((m & 1) == 0) wprev[bj] = w;
                    else store_pair16(T1 + (size_t)(row - 16) * D + col0 + bj * 128, T1 + (size_t)row * D + col0 + bj * 128, fq, wprev[bj], w);
                }
            }
    }
};
struct EpiMix {
    static constexpr bool PERM = true, BIAS = false, EXTRA = false;
    __device__ __forceinline__ const float* extra_ptr(const Unit&, int) const { return nullptr; }
    __device__ __forceinline__ const float* bias_ptr(const Unit&, int) const { return nullptr; }
    const unsigned char* T1; const unsigned char* ZG; unsigned char* MIX;
    __device__ __forceinline__ void operator()(const Acc& acc, const Unit& u, int wr, int wc, int fr, int fq, const LAS float* lb) const {
        const int row0 = u.pm * 256 + wr * 64 + fr, col0 = u.pn * 256 + wc * 32 + 8 * fq;
        u32x2 g[2][4][2], t[2][4][2];
#pragma unroll
        for (int ai = 0; ai < 2; ++ai)
#pragma unroll
            for (int m = 0; m < 4; ++m)
#pragma unroll
                for (int bj = 0; bj < 2; ++bj) { if (m & 1) continue; const int row = row0 + ai * 128 + m * 16;
                    const unsigned char* pg = ZG + (size_t)row * 2048 + 1024 + col0 + bj * 128; const unsigned char* pt = T1 + (size_t)row * D + col0 + bj * 128;
                    load_pair16(pg, pg + (size_t)16 * 2048, fq, g[ai][m][bj], g[ai][m | 1][bj]);
                    load_pair16(pt, pt + (size_t)16 * D, fq, t[ai][m][bj], t[ai][m | 1][bj]); }
        asm volatile("" ::: "memory");
        u32x2 wprev[2];
#pragma unroll
        for (int ai = 0; ai < 2; ++ai)
#pragma unroll
            for (int m = 0; m < 4; ++m) {
                const int row = row0 + ai * 128 + m * 16;
#pragma unroll
                for (int bj = 0; bj < 2; ++bj) {
                    const u32x2 gw = g[ai][m][bj], tw = t[ai][m][bj];
                    const f32x2 s0 = sigmoid2(__builtin_amdgcn_cvt_pk_f32_fp8(gw.x, false)), s1 = sigmoid2(__builtin_amdgcn_cvt_pk_f32_fp8(gw.x, true)),
                                s2 = sigmoid2(__builtin_amdgcn_cvt_pk_f32_fp8(gw.y, false)), s3 = sigmoid2(__builtin_amdgcn_cvt_pk_f32_fp8(gw.y, true));
                    const f32x2 t0 = __builtin_amdgcn_cvt_pk_f32_fp8(tw.x, false), t1 = __builtin_amdgcn_cvt_pk_f32_fp8(tw.x, true), t2 = __builtin_amdgcn_cvt_pk_f32_fp8(tw.y, false), t3 = __builtin_amdgcn_cvt_pk_f32_fp8(tw.y, true);
                    const f32x4 a0 = acc[ai][bj][m][0], a1 = acc[ai][bj][m][1];
                    const f32x2 p0 = t0 * 0.0625f + (f32x2){a0[0], a0[1]} * s0, p1 = t1 * 0.0625f + (f32x2){a0[2], a0[3]} * s1, p2 = t2 * 0.0625f + (f32x2){a1[0], a1[1]} * s2, p3 = t3 * 0.0625f + (f32x2){a1[2], a1[3]} * s3;
                    u32x2 w; w.x = pk4_fp8(p0.x, p0.y, p1.x, p1.y); w.y = pk4_fp8(p2.x, p2.y, p3.x, p3.y);
                    if ((m & 1) == 0) wprev[bj] = w;
                    else store_pair16(MIX + (size_t)(row - 16) * D + col0 + bj * 128, MIX + (size_t)row * D + col0 + bj * 128, fq, wprev[bj], w);
                }
            }
    }
};
struct EpiX {
    static constexpr bool PERM = true, BIAS = false, EXTRA = false;
    __device__ __forceinline__ const float* extra_ptr(const Unit&, int) const { return nullptr; }
    __device__ __forceinline__ const float* bias_ptr(const Unit&, int) const { return nullptr; }
    const bf16_t* X; bf16_t* V; const float* modl;
    __device__ __forceinline__ void operator()(const Acc& acc, const Unit& u, int wr, int wc, int fr, int fq, const LAS float* lb) const {
        const int row0 = u.pm * 256 + wr * 64 + fr, col0 = u.pn * 256 + wc * 32 + 8 * fq;
        const bool uni = u.pm < 128;
        f32x4 g[2][2];
        if (uni) { const float* gp = modl + (size_t)(u.pm >> 4) * 6144 + 2048 + col0;
#pragma unroll
            for (int bj = 0; bj < 2; ++bj)
#pragma unroll
                for (int n = 0; n < 2; ++n) g[bj][n] = *(const f32x4*)(gp + bj * 128 + 4 * n) + 1.0f; }
#pragma unroll
        for (int ai = 0; ai < 2; ++ai) {
            u32x4 x[4][2];
#pragma unroll
            for (int m = 0; m < 4; ++m)
#pragma unroll
                for (int bj = 0; bj < 2; ++bj) x[m][bj] = *(const u32x4*)(X + (size_t)(row0 + ai * 128 + m * 16) * D + col0 + bj * 128);
            asm volatile("" ::: "memory");
#pragma unroll
            for (int m = 0; m < 4; ++m) {
                const int row = row0 + ai * 128 + m * 16;
                if (!uni) { const float* gp = modl + (size_t)batch_of(row) * 6144 + 2048 + col0;
#pragma unroll
                    for (int bj = 0; bj < 2; ++bj)
#pragma unroll
                        for (int n = 0; n < 2; ++n) g[bj][n] = *(const f32x4*)(gp + bj * 128 + 4 * n) + 1.0f; }
#pragma unroll
                for (int bj = 0; bj < 2; ++bj) {
                    const u32x4 xx = x[m][bj];
                    const f32x4 x0 = (f32x4){bf_lo(xx.x), bf_hi(xx.x), bf_lo(xx.y), bf_hi(xx.y)}, x1 = (f32x4){bf_lo(xx.z), bf_hi(xx.z), bf_lo(xx.w), bf_hi(xx.w)};
                    const f32x4 v0 = x0 * ALPHA + g[bj][0] * acc[ai][bj][m][0], v1 = x1 * ALPHA + g[bj][1] * acc[ai][bj][m][1];
                    u32x4 w; w.x = cvt_pk_bf16(v0[0], v0[1]); w.y = cvt_pk_bf16(v0[2], v0[3]); w.z = cvt_pk_bf16(v1[0], v1[1]); w.w = cvt_pk_bf16(v1[2], v1[3]);
                    *(u32x4*)(V + (size_t)row * D + col0 + bj * 128) = w;
                }
            }
            asm volatile("" ::: "memory");
        }
    }
};
struct EpiAct {
    static constexpr bool PERM = true, BIAS = true, EXTRA = false;
    __device__ __forceinline__ const float* extra_ptr(const Unit&, int) const { return nullptr; }
    __device__ __forceinline__ const float* bias_ptr(const Unit& u, int t) const { return bgu + (size_t)u.e * 2048 + u.pn * 128 + (t < 32 ? 4 * t : 1024 + 4 * (t - 32)); }
    unsigned char* ACT; const float* bgu;
    __device__ __forceinline__ void operator()(const Acc& acc, const Unit& u, int wr, int wc, int fr, int fq, const LAS float* lb) const {
        const int row0 = u.pm * 256 + wr * 64 + fr, c0 = u.pn * 128 + wc * 32 + 8 * fq;
        u32x2 wprev;
        f32x4 bg[2], bl[2];
#pragma unroll
        for (int n = 0; n < 2; ++n) { bg[n] = *(const LAS f32x4*)(lb + wc * 32 + 8 * fq + 4 * n); bl[n] = *(const LAS f32x4*)(lb + 128 + wc * 32 + 8 * fq + 4 * n); }
#pragma unroll
        for (int ai = 0; ai < 2; ++ai)
#pragma unroll
            for (int m = 0; m < 4; ++m) {
                const int row = row0 + ai * 128 + m * 16;
                float a[8];
#pragma unroll
                for (int n = 0; n < 2; ++n)
#pragma unroll
                    for (int jp = 0; jp < 2; ++jp) {
                        f32x2 g = (f32x2){acc[ai][0][m][n][2 * jp], acc[ai][0][m][n][2 * jp + 1]} + (f32x2){bg[n][2 * jp], bg[n][2 * jp + 1]};
                        f32x2 li = (f32x2){acc[ai][1][m][n][2 * jp], acc[ai][1][m][n][2 * jp + 1]} + (f32x2){bl[n][2 * jp], bl[n][2 * jp + 1]};
                        g = __builtin_elementwise_min(g, (f32x2){7.0f, 7.0f});
                        li = __builtin_elementwise_min(__builtin_elementwise_max(li, (f32x2){-7.0f, -7.0f}), (f32x2){7.0f, 7.0f});
                        const f32x2 t = g * (-1.702f * 1.44269504089f);
                        f32x2 e; e.x = __builtin_amdgcn_exp2f(t.x); e.y = __builtin_amdgcn_exp2f(t.y);
                        const f32x2 dd = e + 1.0f;
                        f32x2 r; r.x = __builtin_amdgcn_rcpf(dd.x); r.y = __builtin_amdgcn_rcpf(dd.y);
                        const f32x2 av = (g * r) * (li + 1.0f);
                        a[n * 4 + 2 * jp] = av.x; a[n * 4 + 2 * jp + 1] = av.y;
                    }
                u32x2 w; w.x = pk4_fp8(a[0], a[1], a[2], a[3]); w.y = pk4_fp8(a[4], a[5], a[6], a[7]);
                if ((m & 1) == 0) wprev = w;
                else store_pair16(ACT + (size_t)(row - 16) * D + c0, ACT + (size_t)row * D + c0, fq, wprev, w);
                asm volatile("" ::: "memory");
            }
    }
};
struct EpiYs {
    static constexpr bool PERM = true, BIAS = true, EXTRA = true;
    __device__ __forceinline__ const float* extra_ptr(const Unit& u, int t) const { return gate + (size_t)u.e * NT + (u.pm - blk[u.e]) * 256 + 4 * t; }
    __device__ __forceinline__ const float* bias_ptr(const Unit& u, int t) const { return bdn + (size_t)u.e * D + u.pn * 256 + 4 * t; }
    unsigned char* YS; const float* bdn; const float* gate; const LAS int* cnt; const LAS int* blk;
    __device__ __forceinline__ void operator()(const Acc& acc, const Unit& u, int wr, int wc, int fr, int fq, const LAS float* lb) const {
        const int r0 = wr * 64 + fr, col0 = u.pn * 256 + wc * 32 + 8 * fq;
        const int rank0 = (u.pm - blk[u.e]) * 256; const int ce = cnt[u.e];
        f32x4 bv[2][2];
#pragma unroll
        for (int bj = 0; bj < 2; ++bj)
#pragma unroll
            for (int n = 0; n < 2; ++n) bv[bj][n] = *(const LAS f32x4*)(lb + bj * 128 + wc * 32 + 8 * fq + 4 * n);
        float gts[2][4];
#pragma unroll
        for (int ai = 0; ai < 2; ++ai)
#pragma unroll
            for (int m = 0; m < 4; ++m) { const int rank = rank0 + r0 + ai * 128 + m * 16; const float gv = lb[256 + r0 + ai * 128 + m * 16]; gts[ai][m] = rank < ce ? 16.0f * gv : 0.0f; }
        asm volatile("" ::: "memory");
        u32x2 wprev[2];
#pragma unroll
        for (int ai = 0; ai < 2; ++ai)
#pragma unroll
            for (int m = 0; m < 4; ++m) {
                const int r = r0 + ai * 128 + m * 16;
                const float gt = gts[ai][m];
                unsigned char* rowp = YS + (size_t)(u.pm * 256 + r) * D + col0;
#pragma unroll
                for (int bj = 0; bj < 2; ++bj) {
                    const f32x4 v0 = (acc[ai][bj][m][0] + bv[bj][0]) * gt, v1 = (acc[ai][bj][m][1] + bv[bj][1]) * gt;
                    u32x2 w; w.x = pk4_fp8(v0[0], v0[1], v0[2], v0[3]); w.y = pk4_fp8(v1[0], v1[1], v1[2], v1[3]);
                    if ((m & 1) == 0) wprev[bj] = w;
                    else store_pair16(rowp - (size_t)16 * D + bj * 128, rowp + bj * 128, fq, wprev[bj], w);
                }
                asm volatile("" ::: "memory");
            }
    }
};
}


#define XB_TMO      128
#define XB_XCNT(j)  (256  + 64 * (j))
#define XB_XSUB(j)  (1280 + 64 * (j))
#define XB_XGEN(j)  (2304 + 64 * (j))
#define XB_TOP      3328
#define XB_TOPGEN   3392
#define XCD_BAR_WORDS 3456
#define XB_SPIN_CAP (1u << 21)
__device__ __forceinline__ unsigned xb_ld(unsigned* p)              { return __hip_atomic_load(p, __ATOMIC_RELAXED, __HIP_MEMORY_SCOPE_AGENT); }
__device__ __forceinline__ unsigned xb_add(unsigned* p, unsigned v) { return __hip_atomic_fetch_add(p, v, __ATOMIC_RELAXED, __HIP_MEMORY_SCOPE_AGENT); }
__device__ __forceinline__ unsigned xb_xcc_id() { return (unsigned)__builtin_amdgcn_s_getreg((3 << 11) | 20) & 0xFu; }
#define XB_SPIN(cond, bar) do { unsigned _sp = 0; while (cond) { __builtin_amdgcn_s_sleep(1); \
    if ((++_sp & 255u) == 0u) { if (xb_ld(&(bar)[XB_TMO])) break; if (_sp > XB_SPIN_CAP) { atomicAdd(&(bar)[XB_TMO], 1u); break; } } } } while (0)
struct XcdBarrier { unsigned* bar; unsigned x; volatile LAS unsigned* st; };
__device__ __forceinline__ XcdBarrier xcd_barrier_post(unsigned* bar, volatile LAS unsigned* st) {
    XcdBarrier b; b.bar = bar; b.x = xb_xcc_id(); b.st = st;
    if (threadIdx.x == 0) (void)xb_add(&bar[XB_XCNT(b.x)], 1u);
    return b;
}
__device__ __forceinline__ void xcd_barrier_complete(unsigned* bar, unsigned x, unsigned& nloc, unsigned& nx) {
    const unsigned G = gridDim.x * gridDim.y * gridDim.z;
    unsigned sum, cnt, mine, sp = 0u;
    for (;;) {
        sum = 0u; cnt = 0u; mine = 0u;
#pragma unroll
        for (unsigned j = 0; j < 16; ++j) { const unsigned c = xb_ld(&bar[XB_XCNT(j)]); sum += c; cnt += (c > 0u) ? 1u : 0u; mine = (j == x) ? c : mine; }
        if (sum == G) break;
        __builtin_amdgcn_s_sleep(1);
        if ((++sp & 255u) == 0u) { if (xb_ld(&bar[XB_TMO])) break; if (sp > XB_SPIN_CAP) { atomicAdd(&bar[XB_TMO], 1u); break; } }
    }
    nloc = mine > 0u ? mine : 1u; nx = cnt > 0u ? cnt : 1u;
}
__device__ __forceinline__ void xcd_barrier(const XcdBarrier& b) {
    asm volatile("s_waitcnt vmcnt(0)" ::: "memory");
    __syncthreads();
    if (threadIdx.x == 0) {
        unsigned* bar = b.bar;
        __builtin_amdgcn_s_waitcnt(0);
        unsigned nloc = b.st[0], nx = b.st[1];
        if (nloc == 0u) { xcd_barrier_complete(bar, b.x, nloc, nx); b.st[0] = nloc; b.st[1] = nx; }
        const unsigned old = xb_add(&bar[XB_XSUB(b.x)], 1u);
        const unsigned gen = old / nloc;
        if (old + 1u == (gen + 1u) * nloc) {
            __builtin_amdgcn_fence(__ATOMIC_RELEASE, "agent");
            asm volatile("s_waitcnt vmcnt(0)" ::: "memory");
            const unsigned og = xb_add(&bar[XB_TOP], 1u);
            const unsigned tg = og / nx;
            if (og + 1u == (tg + 1u) * nx) xb_add(&bar[XB_TOPGEN], 1u);
            else XB_SPIN(xb_ld(&bar[XB_TOPGEN]) == tg, bar);
            __builtin_amdgcn_fence(__ATOMIC_ACQUIRE, "agent");
            xb_add(&bar[XB_XGEN(b.x)], 1u);
            asm volatile("s_waitcnt vmcnt(0)" ::: "memory");
        } else {
            XB_SPIN(xb_ld(&bar[XB_XGEN(b.x)]) == gen, bar);
            __builtin_amdgcn_fence(__ATOMIC_ACQUIRE, "agent");
            asm volatile("s_waitcnt vmcnt(0)" ::: "memory");
        }
    }
    __syncthreads();
}

struct Ctx {
    LAS unsigned char* lds; int tid, lane, wave, G, bx;
    const float* const* in; float* out; unsigned char* ws;
};
#define LDS_WAIT() asm volatile("s_waitcnt lgkmcnt(0)" ::: "memory")

struct TDesc { const float* src; unsigned char* dst; int N, K, k0, n0, kind, f8; };
__device__ __forceinline__ void t64_load(const TDesc& d, float (&v)[64], int lane) {
    const float* src = d.src + (size_t)d.k0 * d.N + d.n0 + lane;
#pragma unroll
    for (int kk = 0; kk < 64; ++kk) v[kk] = src[(size_t)kk * d.N];
}
__device__ __forceinline__ void t64_finish(const TDesc& d, const float (&v)[64], LAS unsigned char* scr, int lane) {
    if (d.f8) {
        LAS unsigned char* wp = scr + lane * 80;
#pragma unroll
        for (int q = 0; q < 4; ++q) { u32x4 o;
            o.x = pk4_fp8(64.f * v[16 * q + 0], 64.f * v[16 * q + 1], 64.f * v[16 * q + 2], 64.f * v[16 * q + 3]);
            o.y = pk4_fp8(64.f * v[16 * q + 4], 64.f * v[16 * q + 5], 64.f * v[16 * q + 6], 64.f * v[16 * q + 7]);
            o.z = pk4_fp8(64.f * v[16 * q + 8], 64.f * v[16 * q + 9], 64.f * v[16 * q + 10], 64.f * v[16 * q + 11]);
            o.w = pk4_fp8(64.f * v[16 * q + 12], 64.f * v[16 * q + 13], 64.f * v[16 * q + 14], 64.f * v[16 * q + 15]);
            *(LAS u32x4*)(wp + q * 16) = o; }
        LDS_WAIT(); asm volatile("" ::: "memory");
        const int c = lane & 3;
#pragma unroll
        for (int j = 0; j < 4; ++j) { const int nl = (lane >> 2) + 16 * j; const u32x4 o = *(const LAS u32x4*)(scr + nl * 80 + c * 16);
            const int n = d.n0 + nl; int dr = n;
            if (d.kind == 1) { dr = (n < 1024) ? ((n >> 7) * 256 + (n & 127)) : (((n - 1024) >> 7) * 256 + 128 + (n & 127)); }
            *(u32x4*)(d.dst + (size_t)dr * d.K + d.k0 + c * 16) = o; }
    } else {
        LAS unsigned char* wp = scr + lane * 144;
#pragma unroll
        for (int q = 0; q < 8; ++q) { u32x4 o;
            o.x = cvt_pk_bf16(v[8 * q + 0], v[8 * q + 1]); o.y = cvt_pk_bf16(v[8 * q + 2], v[8 * q + 3]); o.z = cvt_pk_bf16(v[8 * q + 4], v[8 * q + 5]); o.w = cvt_pk_bf16(v[8 * q + 6], v[8 * q + 7]);
            *(LAS u32x4*)(wp + q * 16) = o; }
        LDS_WAIT(); asm volatile("" ::: "memory");
        const int c = lane & 7;
#pragma unroll
        for (int j = 0; j < 8; ++j) { const int nl = (lane >> 3) + 8 * j; const u32x4 o = *(const LAS u32x4*)(scr + nl * 144 + c * 16);
            *(u32x4*)(d.dst + ((size_t)(d.n0 + nl) * d.K + d.k0) * 2 + c * 16) = o; }
    }
    LDS_WAIT(); asm volatile("" ::: "memory");
}
__device__ __forceinline__ TDesc t64_decode(const float* const* in, unsigned char* ws, int it) {
    TDesc d; int r = it, item, nblk;
    if (r < 32768) { const int m = r >> 9; item = r & 511; d.src = in[23] + (size_t)m * 1024 * 2048; d.dst = ws + WS_WGU + (size_t)m * 2048 * 1024; d.N = 2048; d.K = 1024; d.kind = 1; d.f8 = 1; }
    else if ((r -= 32768) < 16384) { const int m = r >> 8; item = r & 255; d.src = in[25] + (size_t)m * 1024 * 1024; d.dst = ws + WS_WDN + (size_t)m * 1024 * 1024; d.N = 1024; d.K = 1024; d.kind = 0; d.f8 = 1; }
    else if ((r -= 16384) < 2176) { const int m = r / 1088; item = r % 1088; d.src = in[12] + (size_t)m * 1024 * INW; d.dst = ws + WS_WIN + (size_t)m * INW * 1024 * 2; d.N = INW; d.K = 1024; d.kind = 0; d.f8 = 0; }
    else if ((r -= 2176) < 2176) { const int m = r / 1088; item = r % 1088; d.src = in[12] + (size_t)m * 1024 * INW; d.dst = ws + WS_WIN8 + (size_t)m * INW * 1024; d.N = INW; d.K = 1024; d.kind = 0; d.f8 = 1; }
    else if ((r -= 2176) < 512) { const int m = r >> 8; item = r & 255; d.src = in[18] + (size_t)m * 1024 * 1024; d.dst = ws + WS_WO + (size_t)m * 1024 * 1024; d.N = 1024; d.K = 1024; d.kind = 0; d.f8 = 1; }
    else if ((r -= 512) < 256) { const int m = r >> 7; item = r & 127; d.src = in[16] + (size_t)m * 512 * 1024; d.dst = ws + WS_WOA + (size_t)m * 1024 * 512; d.N = 1024; d.K = 512; d.kind = 0; d.f8 = 1; }
    else { r -= 256; const int m = r >> 7; item = r & 127; d.src = in[17] + (size_t)m * 512 * 1024; d.dst = ws + WS_WOB + (size_t)m * 1024 * 512; d.N = 1024; d.K = 512; d.kind = 0; d.f8 = 1; }
    nblk = d.N >> 6; const int kb = item / nblk; d.k0 = kb * 64; d.n0 = (item - kb * nblk) * 64;
    return d;
}

__device__ __forceinline__ int rel_bucket(int rel) {
    const int n = rel < 0 ? -rel : rel;
    int v;
    if (n < 8) v = n;
    else { const float nf = (float)n; int large = 8 + (int)(logf(nf / 8.0f) / 2.7725887298583984f * 8.0f); v = large < 15 ? large : 15; }
    return (rel > 0 ? 16 : 0) + v;
}

__device__ __forceinline__ void phase0a(Ctx& F) {
    LAS float* scr = (LAS float*)(F.lds + F.wave * 16384);
    const int gw = F.bx * NWAVES + F.wave, NGW = F.G * NWAVES;
    unsigned char* ws = F.ws;
    {
        float* modp = (float*)(ws + WS_MODP);
        for (int it = gw; it < 2 * 96 * 8; it += NGW) {
            const int kc = it & 7, cgp = (it >> 3) % 96, l = it / (8 * 96), k0 = kc * 128, n0 = cgp * 64;
#pragma unroll 4
            for (int j = 0; j < 32; ++j) { const int idx = F.lane + 64 * j, r = idx >> 7, kk = idx & 127;
                const float c = r < 8 ? F.in[2][r * 1024 + k0 + kk] : F.in[3][(r - 8) * 1024 + k0 + kk];
                scr[kk * 16 + r] = c * sigmoidf_(c); }
            LDS_WAIT(); asm volatile("" ::: "memory");
            float a[16];
#pragma unroll
            for (int r = 0; r < 16; ++r) a[r] = 0.f;
            const float* wp = F.in[10] + ((size_t)l * 1024 + k0) * 6144 + n0 + F.lane;
#pragma unroll 16
            for (int kk = 0; kk < 128; ++kk) {
                const float w = wp[(size_t)kk * 6144];
                const LAS f32x4* sp = (const LAS f32x4*)(scr + kk * 16);
                const f32x4 s0 = sp[0], s1 = sp[1], s2 = sp[2], s3 = sp[3];
                a[0] += s0[0] * w; a[1] += s0[1] * w; a[2] += s0[2] * w; a[3] += s0[3] * w;
                a[4] += s1[0] * w; a[5] += s1[1] * w; a[6] += s1[2] * w; a[7] += s1[3] * w;
                a[8] += s2[0] * w; a[9] += s2[1] * w; a[10] += s2[2] * w; a[11] += s2[3] * w;
                a[12] += s3[0] * w; a[13] += s3[1] * w; a[14] += s3[2] * w; a[15] += s3[3] * w;
            }
            const float bb = (kc == 0) ? F.in[11][l * 6144 + n0 + F.lane] : 0.f;
#pragma unroll
            for (int r = 0; r < 16; ++r) modp[(size_t)kc * (2 * 16 * 6144) + ((size_t)(l * 16 + r)) * 6144 + n0 + F.lane] = a[r] + bb;
            LDS_WAIT(); asm volatile("" ::: "memory");
        }
    }
    if (F.bx == 0) {
        float* bt = (float*)(ws + WS_BIAS);
        for (int i = F.tid; i < 8 * 256; i += NTHREADS) { const int h = i >> 8, ri = i & 255; const int rel = ri - 191;
            bt[i] = (ri < 255) ? F.in[7][rel_bucket(rel) * 8 + h] : 0.f; }
    }
    for (int i = F.bx * NTHREADS + F.tid; i < 2 * 8 * 64 * 128; i += F.G * NTHREADS) {
        const int lb = i >> 13, rem = i & 8191;
        F.out[OKS + (size_t)lb * 16384 + rem] = F.in[4][(size_t)lb * 16384 + 8192 + rem];
        F.out[OVS + (size_t)lb * 16384 + rem] = F.in[5][(size_t)lb * 16384 + 8192 + rem];
    }
    LAS unsigned char* scrb = F.lds + F.wave * 16384;
    constexpr int NITEMS = 32768 + 16384 + 2176 + 2176 + 512 + 256 + 256;
    {
        float va[64], vb[64]; TDesc da, db;
        int it = gw;
        if (it < NITEMS) { da = t64_decode(F.in, ws, it); t64_load(da, va, F.lane); }
        while (it < NITEMS) {
            int itn = it + NGW;
            if (itn < NITEMS) { db = t64_decode(F.in, ws, itn); t64_load(db, vb, F.lane); }
            t64_finish(da, va, scrb, F.lane);
            it = itn; if (it >= NITEMS) break;
            itn = it + NGW;
            if (itn < NITEMS) { da = t64_decode(F.in, ws, itn); t64_load(da, va, F.lane); }
            t64_finish(db, vb, scrb, F.lane);
            it = itn;
        }
    }
}

__device__ __forceinline__ void ln_row(f32x4 (&v)[4], const float* g, const float* b, int lane) {
    float s = 0.f;
#pragma unroll
    for (int j = 0; j < 4; ++j) s += (v[j][0] + v[j][1]) + (v[j][2] + v[j][3]);
    const float mean = wave_sum(s) * (1.0f / D); float s2 = 0.f;
#pragma unroll
    for (int j = 0; j < 4; ++j) { v[j] = v[j] - mean; s2 += (v[j][0] * v[j][0] + v[j][1] * v[j][1]) + (v[j][2] * v[j][2] + v[j][3] * v[j][3]); }
    const float rstd = 1.0f / sqrtf(wave_sum(s2) * (1.0f / D) + LN_EPS);
#pragma unroll
    for (int j = 0; j < 4; ++j) { const f32x4 gg = *(const f32x4*)(g + 4 * lane + 256 * j), bb = *(const f32x4*)(b + 4 * lane + 256 * j); v[j] = v[j] * rstd * gg + bb; }
}
__device__ __forceinline__ void store_mod_row(const f32x4 (&v)[4], const float* sh, const float* sc, bf16_t* hrow, unsigned char* h8row, int lane) {
#pragma unroll
    for (int j = 0; j < 4; ++j) { const f32x4 a = *(const f32x4*)(sc + 4 * lane + 256 * j), b = *(const f32x4*)(sh + 4 * lane + 256 * j);
        const f32x4 h = v[j] * (a + 1.0f) + b; u32x2 w; w.x = cvt_pk_bf16(h[0], h[1]); w.y = cvt_pk_bf16(h[2], h[3]);
        *(u32x2*)(hrow + 4 * lane + 256 * j) = w;
        *(unsigned*)(h8row + 4 * lane + 256 * j) = pk4_fp8(h[0], h[1], h[2], h[3]); }
}

__device__ __forceinline__ void phase0b(Ctx& F) {
    const int gw = F.bx * NWAVES + F.wave, NGW = F.G * NWAVES;
    const float* mod = (const float*)(F.ws + WS_MOD);
    bf16_t* H = (bf16_t*)(F.ws + WS_H);
    for (int row = gw; row < NT; row += NGW) {
        const float* xr = row < NPROMPT ? F.in[0] + (size_t)row * D : F.in[1] + (size_t)(row - NPROMPT) * D;
        f32x4 v[4];
#pragma unroll
        for (int j = 0; j < 4; ++j) v[j] = *(const f32x4*)(xr + 4 * F.lane + 256 * j);
        ln_row(v, F.in[8], F.in[9], F.lane);
#pragma unroll
        for (int j = 0; j < 4; ++j) { u32x2 w; w.x = cvt_pk_bf16(v[j][0], v[j][1]); w.y = cvt_pk_bf16(v[j][2], v[j][3]); *(u32x2*)((bf16_t*)(F.ws + WS_XB) + (size_t)row * D + 4 * F.lane + 256 * j) = w; }
        const float* mb = mod + (size_t)batch_of(row) * 6144;
        store_mod_row(v, mb, mb + 1024, H + (size_t)row * D, F.ws + WS_H8 + (size_t)row * D, F.lane);
    }
}

__device__ __forceinline__ void phase_attn(Ctx& F, int l) {
    const bf16_t* Z = (const bf16_t*)(F.ws + WS_Z);
    unsigned char* YA = F.ws + WS_YA;
    unsigned char* YB = F.ws + WS_YB;
    const float* biasr = (const float*)(F.ws + WS_BIAS);
    LAS unsigned char* Ks = F.lds;
    LAS unsigned char* Vt = F.lds + 27648;
    LAS float* bt = (LAS float*)(F.lds + 53248);
    const int lane = F.lane, tid = F.tid;
    int bt_kv = -1;
    for (int au = F.bx; au < 1040; au += F.G) {
        const bool isS = au >= 1024;
        const int kv = au & 1;
        const int b = isS ? ((au - 1024) >> 1) : (au >> 7);
        const int n = isS ? 0 : ((au & 127) >> 1);
        __syncthreads();
        if (kv != bt_kv) { for (int i = tid; i < 1024; i += NTHREADS) bt[i] = biasr[(kv * 4 + (i >> 8)) * 256 + (i & 255)]; bt_kv = kv; }
#pragma unroll
        for (int jj = 0; jj < 3; ++jj) {
            const int p = tid + NTHREADS * jj, key = p >> 3, ds = p & 7;
            u32x4 kq = (u32x4){0u, 0u, 0u, 0u}, vq = (u32x4){0u, 0u, 0u, 0u};
            if (!isS) {
                const int t = n * 64 + key - 128;
                if (t >= 0) { const bf16_t* zr = Z + (size_t)(b * 4096 + t) * INW + kv * 64 + ds * 8; kq = *(const u32x4*)(zr + 512); vq = *(const u32x4*)(zr + 640); }
            } else if (key < 128) {
                const size_t o = ((size_t)((l * 8 + b) * 128 + key) * 2 + kv) * 64 + ds * 8;
                const f32x4 k0 = *(const f32x4*)(F.in[4] + o), k1 = *(const f32x4*)(F.in[4] + o + 4), v0 = *(const f32x4*)(F.in[5] + o), v1 = *(const f32x4*)(F.in[5] + o + 4);
                kq.x = cvt_pk_bf16(k0[0], k0[1]); kq.y = cvt_pk_bf16(k0[2], k0[3]); kq.z = cvt_pk_bf16(k1[0], k1[1]); kq.w = cvt_pk_bf16(k1[2], k1[3]);
                vq.x = cvt_pk_bf16(v0[0], v0[1]); vq.y = cvt_pk_bf16(v0[2], v0[3]); vq.z = cvt_pk_bf16(v1[0], v1[1]); vq.w = cvt_pk_bf16(v1[2], v1[3]);
            } else {
                const bf16_t* zr = Z + (size_t)(NPROMPT + b * 64 + key - 128) * INW + kv * 64 + ds * 8; kq = *(const u32x4*)(zr + 512); vq = *(const u32x4*)(zr + 640);
            }
            *(LAS u32x4*)(Ks + key * 144 + ds * 16) = kq;
            LAS unsigned short* vp = (LAS unsigned short*)Vt + (ds * 8) * 200 + key;
            vp[0 * 200] = (unsigned short)(vq.x & 0xffffu); vp[1 * 200] = (unsigned short)(vq.x >> 16);
            vp[2 * 200] = (unsigned short)(vq.y & 0xffffu); vp[3 * 200] = (unsigned short)(vq.y >> 16);
            vp[4 * 200] = (unsigned short)(vq.z & 0xffffu); vp[5 * 200] = (unsigned short)(vq.z >> 16);
            vp[6 * 200] = (unsigned short)(vq.w & 0xffffu); vp[7 * 200] = (unsigned short)(vq.w >> 16);
        }
        __syncthreads();
        const int g = F.wave >> 1, qi = (F.wave & 1) * 32 + (lane & 31), hh = lane >> 5, head = kv * 4 + g;
        const int qrow = isS ? NPROMPT + b * 64 + qi : b * 4096 + n * 64 + qi;
        bf16x8 Qf[4];
#pragma unroll
        for (int ks = 0; ks < 4; ++ks) Qf[ks] = *(const bf16x8*)(Z + (size_t)qrow * INW + head * 64 + ks * 16 + hh * 8);
        f32x16 S[6];
#pragma unroll
        for (int kb = 0; kb < 6; ++kb) {
#pragma unroll
            for (int j = 0; j < 16; ++j) S[kb][j] = 0.f;
#pragma unroll
            for (int ks = 0; ks < 4; ++ks) {
                const bf16x8 A = *(const LAS bf16x8*)(Ks + (kb * 32 + (lane & 31)) * 144 + (ks * 16 + hh * 8) * 2);
                S[kb] = __builtin_amdgcn_mfma_f32_32x32x16_bf16(A, Qf[ks], S[kb], 0, 0, 0);
            }
        }
        const float sinkv = F.in[14][l * 8 + head];
        float mx = sinkv;
        const int kmin = isS ? 0 : (128 - n * 64);
#pragma unroll
        for (int kb = 0; kb < 6; ++kb)
#pragma unroll
            for (int j = 0; j < 16; ++j) {
                const int key = kb * 32 + 8 * (j >> 2) + 4 * hh + (j & 3);
                float sv = S[kb][j] * 0.125f + bt[g * 256 + key - qi + 63];
                sv = key >= kmin ? sv : -1e30f;
                S[kb][j] = sv; mx = fmaxf(mx, sv);
            }
        mx = fmaxf(mx, __shfl_xor(mx, 32));
        float sum = 0.f;
#pragma unroll
        for (int kb = 0; kb < 6; ++kb)
#pragma unroll
            for (int j = 0; j < 16; ++j) { const float p = __expf(S[kb][j] - mx); S[kb][j] = p; sum += p; }
        sum += __shfl_xor(sum, 32);
        sum += __expf(sinkv - mx);
        const float inv = 1.0f / sum;
        f32x16 O[2];
#pragma unroll
        for (int db = 0; db < 2; ++db)
#pragma unroll
            for (int j = 0; j < 16; ++j) O[db][j] = 0.f;
#pragma unroll
        for (int kb = 0; kb < 6; ++kb)
#pragma unroll
            for (int s2 = 0; s2 < 2; ++s2) {
                union { bf16x8 v; unsigned u[4]; } P;
#pragma unroll
                for (int q = 0; q < 4; ++q) P.u[q] = cvt_pk_bf16(S[kb][8 * s2 + 2 * q], S[kb][8 * s2 + 2 * q + 1]);
#pragma unroll
                for (int db = 0; db < 2; ++db) {
                    const LAS unsigned char* vb = Vt + (db * 32 + (lane & 31)) * 400 + (kb * 32 + 16 * s2 + 4 * hh) * 2;
                    union { bf16x8 v; u32x2 h[2]; } Vf;
                    Vf.h[0] = *(const LAS u32x2*)vb; Vf.h[1] = *(const LAS u32x2*)(vb + 16);
                    O[db] = __builtin_amdgcn_mfma_f32_32x32x16_bf16(Vf.v, P.v, O[db], 0, 0, 0);
                }
            }
        unsigned char* orow = YA + (size_t)qrow * 512 + head * 64 + 4 * hh; const float inv8 = inv * 8.0f;
#pragma unroll
        for (int db = 0; db < 2; ++db)
#pragma unroll
            for (int jq = 0; jq < 4; ++jq) {
                *(unsigned*)(orow + db * 32 + 8 * jq) = pk4_fp8(O[db][4 * jq] * inv8, O[db][4 * jq + 1] * inv8, O[db][4 * jq + 2] * inv8, O[db][4 * jq + 3] * inv8);
            }
    }
    int nxtra = 1040 % F.G; if (1040 < F.G || 2 * nxtra > F.G) nxtra = 0;
    if (F.bx < nxtra) return;
    const int gw = (F.bx - nxtra) * NWAVES + F.wave, NGW = (F.G - nxtra) * NWAVES;
    const float* cw = F.in[15] + (size_t)l * 3 * 512 + 8 * lane;
    float w0[8], w1[8], w2[8];
#pragma unroll
    for (int e = 0; e < 8; ++e) { w0[e] = cw[e]; w1[e] = cw[512 + e]; w2[e] = cw[1024 + e]; }
    for (int row = gw; row < NT; row += NGW) {
        const bool isS = row >= NPROMPT; const int b = isS ? ((row - NPROMPT) >> 6) : (row >> 12), t = isS ? ((row - NPROMPT) & 63) : (row & 4095);
        const bf16_t* zr = Z + (size_t)row * INW + 8 * lane;
        const u32x4 cb = *(const u32x4*)(zr + 768);
        float u[3][8];
#pragma unroll
        for (int d = 0; d < 3; ++d) {
            if (t - d >= 0) {
                const bf16_t* zz = zr - (size_t)d * INW; const u32x4 cc = *(const u32x4*)(zz + 1280), cx = *(const u32x4*)(zz + 1792);
                u[d][0] = bf_lo(cc.x) * bf_lo(cx.x); u[d][1] = bf_hi(cc.x) * bf_hi(cx.x); u[d][2] = bf_lo(cc.y) * bf_lo(cx.y); u[d][3] = bf_hi(cc.y) * bf_hi(cx.y);
                u[d][4] = bf_lo(cc.z) * bf_lo(cx.z); u[d][5] = bf_hi(cc.z) * bf_hi(cx.z); u[d][6] = bf_lo(cc.w) * bf_lo(cx.w); u[d][7] = bf_hi(cc.w) * bf_hi(cx.w);
            } else if (isS) {
                const float* hp = F.in[6] + ((size_t)(l * 8 + b) * 2 + (2 + t - d)) * 512 + 8 * lane;
                const f32x4 h0 = *(const f32x4*)hp, h1 = *(const f32x4*)(hp + 4);
#pragma unroll
                for (int e = 0; e < 4; ++e) { u[d][e] = h0[e]; u[d][4 + e] = h1[e]; }
            } else {
#pragma unroll
                for (int e = 0; e < 8; ++e) u[d][e] = 0.f;
            }
        }
        const float cbf[8] = {bf_lo(cb.x), bf_hi(cb.x), bf_lo(cb.y), bf_hi(cb.y), bf_lo(cb.z), bf_hi(cb.z), bf_lo(cb.w), bf_hi(cb.w)};
        float y[8];
#pragma unroll
        for (int e = 0; e < 8; ++e) y[e] = cbf[e] * (w0[e] * u[2][e] + w1[e] * u[1][e] + w2[e] * u[0][e]);
        u32x2 w; w.x = pk4_fp8(y[0], y[1], y[2], y[3]); w.y = pk4_fp8(y[4], y[5], y[6], y[7]);
        *(u32x2*)(YB + (size_t)row * 512 + 8 * lane) = w;
        const int tl = isS ? 62 : 4094;
        if (t >= tl) {
            float* o = F.out + (isS ? OCS : OCP) + ((size_t)(l * 8 + b) * 2 + (t - tl)) * 512 + 8 * lane;
            *(f32x4*)o = (f32x4){u[0][0], u[0][1], u[0][2], u[0][3]}; *(f32x4*)(o + 4) = (f32x4){u[0][4], u[0][5], u[0][6], u[0][7]};
        }
    }
}

__device__ __forceinline__ void phase_ln_router(Ctx& F, int l) {
    bf16_t* XB = (bf16_t*)(F.ws + WS_XB); unsigned char* H8 = (unsigned char*)(F.ws + WS_H8); const bf16_t* V16 = (const bf16_t*)(F.ws + WS_V16);
    const float* mod = (const float*)(F.ws + WS_MOD) + (size_t)l * 16 * 6144;
    unsigned* cnt = (unsigned*)(F.ws + WS_CNT) + l * 2048;
    unsigned* tok = (unsigned*)(F.ws + WS_TOK); float* gate = (float*)(F.ws + WS_GATE); unsigned* slot = (unsigned*)(F.ws + WS_SLOT);
    const float* Wr = F.in[21] + (size_t)l * 1024 * 32;
    LAS float* hf = (LAS float*)F.lds;
    LAS unsigned char* Hh = F.lds;
    LAS unsigned char* Hl = F.lds + 66048;
    LAS unsigned* hist = (LAS unsigned*)(F.lds + 146432); LAS unsigned* hbase = hist + 32;
    LAS u32x4* rec = (LAS u32x4*)(F.lds + 132096);
    int nrec_tiles = 0;
    __syncthreads();
    if (F.tid < 32) hist[F.tid] = 0u;
    const int lane = F.lane, w = F.wave;
    bf16x8 bh[8], bl[8];
    {
#pragma unroll
        for (int ks = 0; ks < 8; ++ks) {
            const float* bp = Wr + (size_t)(128 * w + 16 * ks + 8 * (lane >> 5)) * 32 + (lane & 31);
            float wv[8];
#pragma unroll
            for (int j = 0; j < 8; ++j) wv[j] = bp[32 * j];
            union { bf16x8 v; unsigned u[4]; } ph, pl;
#pragma unroll
            for (int q = 0; q < 4; ++q) { const unsigned hw = cvt_pk_bf16(wv[2 * q], wv[2 * q + 1]); ph.u[q] = hw; pl.u[q] = cvt_pk_bf16(wv[2 * q] - bf_lo(hw), wv[2 * q + 1] - bf_hi(hw)); }
            bh[ks] = ph.v; bl[ks] = pl.v;
        }
    }
    for (int tidx = F.bx; tidx < 1024 + 256; tidx += F.G) {
        const int tile0 = tidx < 1024 ? tidx * 32 : NPROMPT + (tidx - 1024) * 2, nrows = tidx < 1024 ? 32 : 2;
        __syncthreads();
        if (w * 4 < nrows) {
            u32x2 pv[4][4];
#pragma unroll
            for (int rr = 0; rr < 4; ++rr) { const int rl = w * 4 + rr, row = rl < nrows ? tile0 + rl : tile0;
#pragma unroll
                for (int j = 0; j < 4; ++j) pv[rr][j] = *(const u32x2*)(V16 + (size_t)row * D + 4 * lane + 256 * j); }
#pragma unroll
            for (int rr = 0; rr < 4; ++rr) {
                const int rl = w * 4 + rr, row = tile0 + rl;
                if (rl < nrows) {
                    f32x4 v[4];
#pragma unroll
                    for (int j = 0; j < 4; ++j) v[j] = (f32x4){bf_lo(pv[rr][j].x), bf_hi(pv[rr][j].x), bf_lo(pv[rr][j].y), bf_hi(pv[rr][j].y)};
                    ln_row(v, F.in[19] + l * D, F.in[20] + l * D, lane);
#pragma unroll
                    for (int j = 0; j < 4; ++j) { u32x2 wq; wq.x = cvt_pk_bf16(v[j][0], v[j][1]); wq.y = cvt_pk_bf16(v[j][2], v[j][3]); *(u32x2*)(XB + (size_t)row * D + 4 * lane + 256 * j) = wq; }
                    const float* mb = mod + (size_t)batch_of(row) * 6144;
#pragma unroll
                    for (int j = 0; j < 4; ++j) { const f32x4 a = *(const f32x4*)(mb + 4096 + 4 * lane + 256 * j), b = *(const f32x4*)(mb + 3072 + 4 * lane + 256 * j);
                        const f32x4 h = v[j] * (a + 1.0f) + b;
                        *(unsigned*)(H8 + (size_t)row * D + 4 * lane + 256 * j) = pk4_fp8(h[0], h[1], h[2], h[3]);
                        u32x2 hw; hw.x = cvt_pk_bf16(h[0], h[1]); hw.y = cvt_pk_bf16(h[2], h[3]);
                        u32x2 lw; lw.x = cvt_pk_bf16(h[0] - bf_lo(hw.x), h[1] - bf_hi(hw.x)); lw.y = cvt_pk_bf16(h[2] - bf_lo(hw.y), h[3] - bf_hi(hw.y));
                        *(LAS u32x2*)(Hh + rl * 2064 + (4 * lane + 256 * j) * 2) = hw; *(LAS u32x2*)(Hl + rl * 2064 + (4 * lane + 256 * j) * 2) = lw; }
                }
            }
        }
        __syncthreads();
        f32x16 acc;
#pragma unroll
        for (int j = 0; j < 16; ++j) acc[j] = 0.f;
        {
            const int aoffb = (lane & 31) * 2064 + (128 * w + 8 * (lane >> 5)) * 2;
#pragma unroll
            for (int ks = 0; ks < 8; ++ks) {
                const bf16x8 ah = *(const LAS bf16x8*)(Hh + aoffb + ks * 32), al = *(const LAS bf16x8*)(Hl + aoffb + ks * 32);
                acc = __builtin_amdgcn_mfma_f32_32x32x16_bf16(ah, bh[ks], acc, 0, 0, 0);
                acc = __builtin_amdgcn_mfma_f32_32x32x16_bf16(ah, bl[ks], acc, 0, 0, 0);
                acc = __builtin_amdgcn_mfma_f32_32x32x16_bf16(al, bh[ks], acc, 0, 0, 0);
            }
        }
        __syncthreads();
        LAS float* red = hf;
#pragma unroll
        for (int j = 0; j < 16; ++j) red[(w * 32 + 8 * (j >> 2) + 4 * (lane >> 5) + (j & 3)) * 33 + (lane & 31)] = acc[j];
        __syncthreads();
        int e_sel[4]; float g_sel[4]; unsigned loc[4];
#pragma unroll
        for (int rr = 0; rr < 4; ++rr) {
            const int tk = w * 4 + rr;
            float val = -INFINITY;
            if (lane < 32) { float sacc = F.in[22][l * 32 + lane];
#pragma unroll
                for (int ww = 0; ww < 8; ++ww) sacc += red[(ww * 32 + tk) * 33 + lane];
                val = sacc; }
            float tv[4]; int te[4];
            {
                const int vbits = __float_as_int(val); int rank = 0;
#pragma unroll
                for (int j = 0; j < 32; ++j) { const float vj = __int_as_float(__builtin_amdgcn_readlane(vbits, j)); rank += (vj > val || (vj == val && j < lane)) ? 1 : 0; }
#pragma unroll
                for (int it = 0; it < 4; ++it) { const unsigned long long mk = __ballot(rank == it); const int ln = mk ? (__ffsll((long long)mk) - 1) : 0;
                    te[it] = ln; tv[it] = __int_as_float(__builtin_amdgcn_readlane(vbits, ln)); }
            }
            const float e1 = __expf(tv[1] - tv[0]), e2 = __expf(tv[2] - tv[0]), e3 = __expf(tv[3] - tv[0]);
            const float rs = 1.0f / (1.0f + e1 + e2 + e3);
            e_sel[rr] = lane == 0 ? te[0] : lane == 1 ? te[1] : lane == 2 ? te[2] : te[3];
            g_sel[rr] = (lane == 0 ? 1.0f : lane == 1 ? e1 : lane == 2 ? e2 : e3) * rs;
            loc[rr] = 0u;
            if (lane < 4 && tk < nrows) loc[rr] = atomicAdd((unsigned*)&hist[e_sel[rr]], 1u);
        }
        if (lane < 4) {
#pragma unroll
            for (int rr = 0; rr < 4; ++rr) {
                const int rl = w * 4 + rr;
                u32x4 rc; rc.x = (rl < nrows) ? (unsigned)(tile0 + rl) : 0xffffffffu; rc.y = (unsigned)(e_sel[rr] & 31); rc.z = loc[rr]; rc.w = __float_as_uint(g_sel[rr]);
                rec[(nrec_tiles * 32 + rl) * 4 + lane] = rc;
            }
        }
        ++nrec_tiles;
    }
    __syncthreads();
    if (F.tid < 32) { const unsigned hcount = hist[F.tid]; hbase[F.tid] = hcount ? atomicAdd(cnt + F.tid * 64, hcount) : 0u; }
    __syncthreads();
    for (int i = F.tid; i < nrec_tiles * 128; i += NTHREADS) {
        const u32x4 rc = rec[i];
        if (rc.x != 0xffffffffu) { const unsigned e = rc.y, rank = hbase[e] + rc.z;
            tok[(size_t)e * NT + rank] = rc.x; gate[(size_t)e * NT + rank] = __uint_as_float(rc.w); slot[(size_t)rc.x * 4 + (i & 3)] = (e << 24) | rank; }
    }
}

__device__ __forceinline__ void build_blk(Ctx& F, int l) {
    LAS int* blk = (LAS int*)(F.lds + LDS_BLK);
    const unsigned* cnt = (const unsigned*)(F.ws + WS_CNT) + l * 2048;
    __syncthreads();
    if (F.tid == 0) { LAS int* cl = (LAS int*)(F.lds + LDS_CNT); int s = 0; for (int e = 0; e < 32; ++e) { const int ce = (int)cnt[e * 64]; cl[e] = ce; blk[e] = s; s += (ce + 255) >> 8; } blk[32] = s; }
    __syncthreads();
}

__device__ __forceinline__ void phase_combine(Ctx& F, int l) {
    const LAS int* blk = (const LAS int*)(F.lds + LDS_BLK);
    float* X = F.out; bf16_t* XB = (bf16_t*)(F.ws + WS_XB); bf16_t* H = (bf16_t*)(F.ws + WS_H); const unsigned char* YS = F.ws + WS_YS;
    const unsigned* slot = (const unsigned*)(F.ws + WS_SLOT);
    const float* mod = (const float*)(F.ws + WS_MOD);
    const int gw = F.bx * NWAVES + F.wave, NGW = F.G * NWAVES, lane = F.lane;
    for (int row = gw; row < NT; row += NGW) {
        f32x4 ff[4];
#pragma unroll
        for (int j = 0; j < 4; ++j) ff[j] = (f32x4){0.f, 0.f, 0.f, 0.f};
#pragma unroll
        for (int k = 0; k < 4; ++k) {
            const unsigned s = slot[(size_t)row * 4 + k]; const int e = (int)(s >> 24), rank = (int)(s & 0xffffffu);
            const unsigned char* yr = YS + ((size_t)blk[e] * 256 + rank) * D + 4 * lane;
#pragma unroll
            for (int j = 0; j < 4; ++j) { const unsigned wv = *(const unsigned*)(yr + 256 * j); const f32x2 lo = __builtin_amdgcn_cvt_pk_f32_fp8(wv, false), hi = __builtin_amdgcn_cvt_pk_f32_fp8(wv, true);
                ff[j][0] += lo.x; ff[j][1] += lo.y; ff[j][2] += hi.x; ff[j][3] += hi.y; }
        }
        const int bi = batch_of(row);
        const float* mb = mod + (size_t)(l * 16 + bi) * 6144;
        f32x4 v[4];
#pragma unroll
        for (int j = 0; j < 4; ++j) { const u32x2 xw = *(const u32x2*)(XB + (size_t)row * D + 4 * lane + 256 * j); const f32x4 x = (f32x4){bf_lo(xw.x), bf_hi(xw.x), bf_lo(xw.y), bf_hi(xw.y)}, g2 = *(const f32x4*)(mb + 5120 + 4 * lane + 256 * j);
            v[j] = x * ALPHA + (g2 + 1.0f) * (ff[j] * 0.0625f); }
        ln_row(v, F.in[27] + l * D, F.in[28] + l * D, lane);
#pragma unroll
        for (int j = 0; j < 4; ++j) { if (l == 0) { u32x2 w; w.x = cvt_pk_bf16(v[j][0], v[j][1]); w.y = cvt_pk_bf16(v[j][2], v[j][3]); *(u32x2*)(XB + (size_t)row * D + 4 * lane + 256 * j) = w; }
            else *(f32x4*)(X + (size_t)row * D + 4 * lane + 256 * j) = v[j]; }
        if (l == 0) { const float* mn = mod + (size_t)(16 + bi) * 6144; store_mod_row(v, mn, mn + 1024, H + (size_t)row * D, F.ws + WS_H8 + (size_t)row * D, lane); }
    }
}

#ifndef PH_MASK
#define PH_MASK 0xFFFF
#endif
#define PH(b) ((PH_MASK >> (b)) & 1)
#ifndef PROBE_MASK
#define PROBE_MASK 0
#endif
#define PB0(id) do { if ((PROBE_MASK >> (id)) & 1) pb_t0 = __builtin_amdgcn_s_memrealtime(); } while (0)
#define PB1(id) do { if ((PROBE_MASK >> (id)) & 1) pb_acc += __builtin_amdgcn_s_memrealtime() - pb_t0; } while (0)
#define RELOAD() do { int t_ = threadIdx.x; asm volatile("" : "+v"(t_)); F.tid = t_; F.lane = t_ & 63; F.wave = __builtin_amdgcn_readfirstlane(t_ >> 6); \
    unsigned z_; asm volatile("s_mov_b32 %0, 0" : "=s"(z_)); F.in = p.in; F.out = p.out + z_; F.ws = p.ws + z_; } while (0)
#define LAYER_BODY(l) do { \
          \
        PB0(2); RELOAD(); \
        if (PH(2)) { \
              \
            pg8::SchedDense S; S.init(NT, 7 * 256, D, F.G, F.bx, (const bf16_t*)(F.ws + WS_WIN) + (size_t)l * INW * D, 2); \
            pg8::EpiZ E{(bf16_t*)(F.ws + WS_Z), F.in[13] + l * INW, F.out, l, F.ws + WS_ZG8}; \
            pg8::gemm_phase<false, 0u>(F.lds, (const char*)(F.ws + WS_H), D, S, E); \
        } \
        RELOAD(); \
        if (PH(2)) { \
              \
            pg8::SchedDense S; S.init(NT, 10 * 256, 512, F.G, (F.G == 256) ? ((F.bx + 112) & 255) : F.bx, F.ws + WS_WIN8 + (size_t)l * INW * D, 0, 2, 7); \
            pg8::EpiZ E{(bf16_t*)(F.ws + WS_Z), F.in[13] + l * INW, F.out, l, F.ws + WS_ZG8}; \
            pg8::gemm_phase<true, 0x7f7f7f7fu>(F.lds, (const char*)(F.ws + WS_H8), 512, S, E); \
        } \
        xcd_barrier(xbar); PB1(2); PB0(3); \
        RELOAD(); \
        if (PH(3)) phase_attn(F, l); \
        xcd_barrier(xbar); PB1(3); PB0(4); \
          \
        RELOAD(); \
        if (PH(4)) { \
            pg8::SchedDense S; S.init(NT, D, 256, F.G, F.bx, F.ws + WS_WOA + (size_t)l * D * 512); \
            pg8::EpiT1 E{F.ws + WS_T1, F.ws + WS_ZG8}; \
            pg8::gemm_phase<true, 0x7c7c7c7cu>(F.lds, (const char*)(F.ws + WS_YA), 256, S, E); \
        } \
        RELOAD(); \
        if (PH(5)) { \
            pg8::SchedDense S; S.init(NT, D, 256, F.G, F.bx, F.ws + WS_WOB + (size_t)l * D * 512); \
            pg8::EpiMix E{F.ws + WS_T1, F.ws + WS_ZG8, F.ws + WS_MIX}; \
            pg8::gemm_phase<true, 0x7f7f7f7fu>(F.lds, (const char*)(F.ws + WS_YB), 256, S, E); \
        } \
        xcd_barrier(xbar); PB1(4); PB0(5); \
          \
        RELOAD(); \
        if (PH(6)) { \
            pg8::SchedDense S; S.init(NT, D, 512, F.G, F.bx, F.ws + WS_WO + (size_t)l * D * D); \
            pg8::EpiX E{(const bf16_t*)(F.ws + WS_XB), (bf16_t*)(F.ws + WS_V16), (const float*)(F.ws + WS_MOD) + (size_t)l * 16 * 6144}; \
            pg8::gemm_phase<true, 0x7f7f7f7fu>(F.lds, (const char*)(F.ws + WS_MIX), 512, S, E); \
        } \
        xcd_barrier(xbar); PB1(5); PB0(6); \
        RELOAD(); \
        if (PH(7)) phase_ln_router(F, l); \
        xcd_barrier(xbar); PB1(6); PB0(7); \
          \
        RELOAD(); \
        build_blk(F, l); \
        if (PH(8)) { \
            LAS int* blk = (LAS int*)(F.lds + LDS_BLK); \
            LAS unsigned short* idx = (LAS unsigned short*)(F.lds + LDS_IDX); \
            pg8::SchedMoE<true> S; S.init(blk, idx, 8, 512, F.G, F.bx, (const unsigned char*)(F.ws + WS_WGU) + (size_t)l * 32 * 2048 * D, (size_t)2048 * D); \
            const unsigned* cnt = (const unsigned*)(F.ws + WS_CNT) + l * 2048; const unsigned* tok = (const unsigned*)(F.ws + WS_TOK); \
            for (int i = 0; i < MAXU; ++i) { pg8::Unit u; if (!S.next(i, u)) break; \
                if (F.tid < 256) { int rank = (u.pm - blk[u.e]) * 256 + F.tid; const int ce = ((const LAS int*)(F.lds + LDS_CNT))[u.e]; rank = rank < ce ? rank : ce - 1; \
                    idx[i * 256 + F.tid] = (unsigned short)tok[(size_t)u.e * NT + rank]; } } \
            __syncthreads(); \
            pg8::EpiAct E{(unsigned char*)(F.ws + WS_ACT), F.in[24] + (size_t)l * 32 * 2048}; \
            pg8::gemm_phase<true, 0x7f7f7f7fu>(F.lds, (const char*)(F.ws + WS_H8), 512, S, E); \
        } \
        xcd_barrier(xbar); PB1(7); PB0(8); \
          \
        RELOAD(); \
        if (PH(9)) { \
            LAS int* blk = (LAS int*)(F.lds + LDS_BLK); \
            LAS unsigned short* idx = (LAS unsigned short*)(F.lds + LDS_IDX); \
            pg8::SchedMoE<false> S; S.init(blk, idx, 4, 512, F.G, F.bx, (const unsigned char*)(F.ws + WS_WDN) + (size_t)l * 32 * D * D, (size_t)D * D); \
            pg8::EpiYs E{F.ws + WS_YS, F.in[26] + (size_t)l * 32 * D, (const float*)(F.ws + WS_GATE), (const LAS int*)(F.lds + LDS_CNT), blk}; \
            pg8::gemm_phase<true, 0x7f7f7f7fu>(F.lds, (const char*)(F.ws + WS_ACT), 512, S, E); \
        } \
        xcd_barrier(xbar); PB1(8); PB0(9); \
        RELOAD(); \
        if (PH(10)) phase_combine(F, l); \
        if (l == 0) xcd_barrier(xbar); \
        PB1(9); \
 \
    } while (0)
__global__ void __launch_bounds__(NTHREADS, 2) fwd_megakernel(Params p) {
    extern __shared__ __attribute__((aligned(16))) unsigned char lds_raw[];
    cg::grid_group grid = cg::this_grid();
    Ctx F;
    F.lds = (LAS unsigned char*)lds_raw;
    F.G = gridDim.x; F.bx = blockIdx.x;
    volatile LAS unsigned* bst = (volatile LAS unsigned*)(F.lds + 147392);
    if (threadIdx.x < 2) bst[threadIdx.x] = 0u;
    __syncthreads();
    const XcdBarrier xbar = xcd_barrier_post((unsigned*)(p.ws + WS_BAR), bst);
    unsigned long long pb_t0 = 0, pb_acc = 0;
    PB0(0); RELOAD();
    if (PH(0)) phase0a(F);
    grid.sync();
    PB1(0); PB0(1); RELOAD();
    { const float* modp = (const float*)(F.ws + WS_MODP); float* mod = (float*)(F.ws + WS_MOD);
      for (int i = F.bx * NTHREADS + F.tid; i < 2 * 16 * 6144; i += F.G * NTHREADS) { float sm = 0.f;
#pragma unroll
          for (int kc = 0; kc < 8; ++kc) sm += modp[(size_t)kc * (2 * 16 * 6144) + i];
          mod[i] = sm; } }
    xcd_barrier(xbar);
    RELOAD();
    if (PH(1)) phase0b(F);
    xcd_barrier(xbar); PB1(1);

    LAYER_BODY(0);
    LAYER_BODY(1);
    if (PROBE_MASK != 0 && blockIdx.x == 0) { const unsigned long long te = __builtin_amdgcn_s_memrealtime(); while (__builtin_amdgcn_s_memrealtime() - te < pb_acc) __builtin_amdgcn_s_sleep(8); }
    (void)pb_t0; (void)pb_acc;
}

extern "C" void kernel_launch(void* const* d_in, const int* in_sizes, int n_in, void* d_out, int out_size, void* d_ws, size_t ws_size, hipStream_t stream) {
    static int grid = 0;
    if (grid == 0) {
        if (n_in != 29 || ws_size < WS_END) { fprintf(stderr, "kernel_launch: unexpected n_in %d / ws_size %zu (need %zu)\n", n_in, ws_size, (size_t)WS_END); grid = -1; return; }
        int dev = 0, cus = 0, per_cu = 0;
        hipGetDevice(&dev);
        hipDeviceGetAttribute(&cus, hipDeviceAttributeMultiprocessorCount, dev);
        if (hipFuncSetAttribute((const void*)fwd_megakernel, hipFuncAttributeMaxDynamicSharedMemorySize, LDS_BYTES) != hipSuccess) { fprintf(stderr, "kernel_launch: hipFuncSetAttribute failed\n"); grid = -1; return; }
        if (hipOccupancyMaxActiveBlocksPerMultiprocessor(&per_cu, (const void*)fwd_megakernel, NTHREADS, LDS_BYTES) != hipSuccess || per_cu < 1) { fprintf(stderr, "kernel_launch: occupancy query says %d blocks per CU\n", per_cu); per_cu = 1; }
        (void)hipGetLastError();
        grid = cus;
        if (grid != 256) fprintf(stderr, "kernel_launch: note: %d CUs (built for 256)\n", grid);
    }
    if (grid < 0) return;
    hipMemsetAsync((char*)d_ws, 0, WS_ZERO_BYTES, stream);
    Params p{};
    for (int i = 0; i < 29; ++i) p.in[i] = (const float*)d_in[i];
    p.out = (float*)d_out; p.ws = (unsigned char*)d_ws;
    void* args[] = {&p};
    hipError_t e = hipLaunchCooperativeKernel((const void*)fwd_megakernel, dim3(grid), dim3(NTHREADS), args, LDS_BYTES, stream);
    if (e != hipSuccess) fprintf(stderr, "kernel_launch: cooperative launch failed: %s (grid %d)\n", hipGetErrorString(e), grid);
}
```

```cpp
#include <hip/hip_runtime.h>
#include <hip/hip_cooperative_groups.h>
#include <cstdio>
#include <cstdint>
namespace cg = cooperative_groups;

#define LAS __attribute__((address_space(3)))
typedef unsigned short bf16_t;
typedef short bf16x8 __attribute__((ext_vector_type(8)));
typedef float f32x4 __attribute__((ext_vector_type(4)));
typedef float f32x16 __attribute__((ext_vector_type(16)));
typedef unsigned u32x4 __attribute__((ext_vector_type(4)));
typedef unsigned u32x2 __attribute__((ext_vector_type(2)));
typedef float f32x2 __attribute__((ext_vector_type(2)));
typedef int i32x4 __attribute__((ext_vector_type(4)));
typedef int i32x8 __attribute__((ext_vector_type(8)));

constexpr int D = 1024, NPROMPT = 32768, NT = 33280, INW = 4352, NEXP = 32;
constexpr float ALPHA = 1.41421356237f, LN_EPS = 1e-5f;
constexpr int NWAVES = 8, NTHREADS = 512;
constexpr int LDS_BYTES = 147456;
constexpr int LDS_BLK = 131072;
constexpr int LDS_IDX = 131072 + 256;
constexpr int MAXU = 20;
constexpr int LDS_BIASBUF = 141568;
constexpr int LDS_CNT = 145664;
constexpr size_t OKP = 34078720, OVP = 34340864, OCP = 34603008, OKS = 34619392, OVS = 34881536, OCS = 35143680;
constexpr size_t MiB = 1u << 20;
constexpr size_t WS_CNT = 0;
constexpr size_t WS_BAR = 16384;
constexpr size_t WS_MOD = 65536;
constexpr size_t WS_MODP = 192 * MiB;
constexpr size_t WS_ZERO_BYTES = 1 * MiB;
constexpr size_t WS_BIAS = 1 * MiB;
constexpr size_t WS_SLOT = 2 * MiB;
constexpr size_t WS_TOK = 3 * MiB;
constexpr size_t WS_GATE = 8 * MiB;
constexpr size_t WS_WIN = 16 * MiB;
constexpr size_t WS_WIN8 = 180 * MiB;
constexpr size_t WS_WOA = 34 * MiB;
constexpr size_t WS_WOB = 36 * MiB;
constexpr size_t WS_WO = 38 * MiB;
constexpr size_t WS_WGU = 48 * MiB;
constexpr size_t WS_WDN = 304 * MiB;
constexpr size_t WS_H = 432 * MiB;
constexpr size_t WS_H8 = 1600 * MiB;
constexpr size_t WS_Z = 498 * MiB;
constexpr size_t WS_YA = 776 * MiB;
constexpr size_t WS_YB = 810 * MiB;
constexpr size_t WS_T1 = 844 * MiB;
constexpr size_t WS_V16 = 910 * MiB;
constexpr size_t WS_XB = 1200 * MiB;
constexpr size_t WS_MIX = 976 * MiB;
constexpr size_t WS_ACT = 1042 * MiB;
constexpr size_t WS_YS = 1320 * MiB;
constexpr size_t WS_ZG8 = 1460 * MiB;
constexpr size_t WS_END = 1634 * MiB;

struct Params { const float* in[29]; float* out; unsigned char* ws; };

__device__ __forceinline__ unsigned cvt_pk_bf16(float lo, float hi) { unsigned r; asm("v_cvt_pk_bf16_f32 %0, %1, %2" : "=v"(r) : "v"(lo), "v"(hi)); return r; }
__device__ __forceinline__ unsigned pk4_fp8(float a, float b, float c, float d) { unsigned w = 0u; w = __builtin_amdgcn_cvt_pk_fp8_f32(a, b, w, false); w = __builtin_amdgcn_cvt_pk_fp8_f32(c, d, w, true); return w; }
__device__ __forceinline__ void unpk8_fp8(const u32x2 w, float (&o)[8]) { const f32x2 a = __builtin_amdgcn_cvt_pk_f32_fp8(w.x, false), b = __builtin_amdgcn_cvt_pk_f32_fp8(w.x, true), c = __builtin_amdgcn_cvt_pk_f32_fp8(w.y, false), d = __builtin_amdgcn_cvt_pk_f32_fp8(w.y, true);
    o[0] = a.x; o[1] = a.y; o[2] = b.x; o[3] = b.y; o[4] = c.x; o[5] = c.y; o[6] = d.x; o[7] = d.y; }
__device__ __forceinline__ void store_pair16(unsigned char* pa, unsigned char* pb, int fq, u32x2 wa, u32x2 wb) {
    const auto rx = __builtin_amdgcn_permlane16_swap(wa.x, wb.x, false, false);
    const auto ry = __builtin_amdgcn_permlane16_swap(wa.y, wb.y, false, false);
    u32x4 o; o.x = rx[0]; o.y = ry[0]; o.z = rx[1]; o.w = ry[1];
    *(u32x4*)((fq & 1) ? pb - 8 : pa) = o;
}
__device__ __forceinline__ void load_pair16(const unsigned char* pa, const unsigned char* pb, int fq, u32x2& wa, u32x2& wb) {
    const u32x4 x = *(const u32x4*)((fq & 1) ? pb - 8 : pa);
    const auto rx = __builtin_amdgcn_permlane16_swap(x.x, x.z, false, false);
    const auto ry = __builtin_amdgcn_permlane16_swap(x.y, x.w, false, false);
    wa.x = rx[0]; wa.y = ry[0]; wb.x = rx[1]; wb.y = ry[1];
}
__device__ __forceinline__ float bf_lo(unsigned w) { return __uint_as_float(w << 16); }
__device__ __forceinline__ float bf_hi(unsigned w) { return __uint_as_float(w & 0xffff0000u); }
__device__ __forceinline__ float sigmoidf_(float x) { return __builtin_amdgcn_rcpf(1.0f + __expf(-x)); }
__device__ __forceinline__ f32x2 sigmoid2(f32x2 x) {
    const f32x2 t = x * (-1.44269504089f);
    f32x2 e; e.x = __builtin_amdgcn_exp2f(t.x); e.y = __builtin_amdgcn_exp2f(t.y);
    const f32x2 d = e + 1.0f;
    f32x2 r; r.x = __builtin_amdgcn_rcpf(d.x); r.y = __builtin_amdgcn_rcpf(d.y);
    return r;
}
__device__ __forceinline__ float wave_sum(float v) {
#define WS_DPP_ADD(ctrl) v += __int_as_float(__builtin_amdgcn_update_dpp(0, __float_as_int(v), (ctrl), 0xf, 0xf, true))
    WS_DPP_ADD(0xB1);
    WS_DPP_ADD(0x4E);
    WS_DPP_ADD(0x141);
    WS_DPP_ADD(0x140);
#undef WS_DPP_ADD
    const int b = __float_as_int(v);
    const float r0 = __int_as_float(__builtin_amdgcn_readlane(b, 0)), r1 = __int_as_float(__builtin_amdgcn_readlane(b, 16)), r2 = __int_as_float(__builtin_amdgcn_readlane(b, 32)), r3 = __int_as_float(__builtin_amdgcn_readlane(b, 48));
    return (r0 + r1) + (r2 + r3);
}
__device__ __forceinline__ int batch_of(int row) { return row < NPROMPT ? (row >> 12) : 8 + ((row - NPROMPT) >> 6); }

namespace pg8 {
constexpr int BM = 256, BK = 64, HALF = 128, HTB = HALF * BK * 2, NXCD = 8, WGM = 8;
__device__ __forceinline__ int lds_byte(int r, int c) { const int st = (r >> 4) * 2 + (c >> 5), rr = r & 15, cc = c & 31, ob = rr * 64 + cc * 2; return st * 1024 + (ob ^ (((ob >> 9) & 1) << 5)); }
__device__ __forceinline__ void stage_rc(int b, int& R, int& C) { const int st = b / 1024, sb = b % 1024, swz = sb ^ (((sb >> 9) & 1) << 5); R = (st >> 1) * 16 + swz / 64; C = (st & 1) * 32 + (swz % 64) / 2; }
__device__ __forceinline__ int perm32(int rho) { const int n = rho >> 4, i = rho & 15; return 8 * (i >> 2) + 4 * n + (i & 3); }

struct Unit { int pm, pn, e; const char* b; };

struct SchedDense {
    int nM, nN, nwg, G, c, cbase, csplit, cskip; const char* Bt; size_t tstepB;
    __device__ __forceinline__ void init(int M, int N, int K, int G_, int c_, const void* Bt_, int cbase_ = 0, int csplit_ = 1 << 20, int cskip_ = 0) { nM = M / BM; nN = N / BM; nwg = nM * nN; G = G_; c = c_; Bt = (const char*)Bt_; tstepB = (size_t)BM * K * 2; cbase = cbase_; csplit = csplit_; cskip = cskip_; }
    __device__ __forceinline__ bool next(int i, Unit& u) const {
        const long L = (long)i * G + c; if (L >= nwg) return false;
        int wgid = (int)L; { const int q = nwg / NXCD, r = nwg % NXCD, xcd = wgid % NXCD, off = wgid / NXCD; wgid = (xcd < r ? xcd * (q + 1) : r * (q + 1) + (xcd - r) * q) + off; }
        const int nig = WGM * nN, gid = wgid / nig, fm = gid * WGM, gsz = (nM - fm) < WGM ? (nM - fm) : WGM;
        u.pm = fm + ((wgid % nig) % gsz); const int j = (wgid % nig) / gsz; u.pn = j < csplit ? j + cbase : j + cbase + cskip; u.e = 0; u.b = Bt + (size_t)u.pn * tstepB; return true;
    }
    __device__ __forceinline__ unsigned rowidx(int, const Unit& u, int r) const { return (unsigned)(u.pm * BM + r); }
};
template <bool GATHER> struct SchedMoE {
    const LAS int* blk; const LAS unsigned short* idx; int NB, RBX, NPN, NXs, perx, cx, cj; const char* Bt; size_t estep, tstepB;
    __device__ __forceinline__ void init(const LAS int* blk_, const LAS unsigned short* idx_, int NPN_, int K, int G, int c, const void* Bt_, size_t estep_) {
        blk = blk_; idx = idx_; NB = blk_[32]; NPN = NPN_; Bt = (const char*)Bt_; estep = estep_; tstepB = (size_t)BM * K * 2;
        if ((G & 7) == 0) { NXs = 8; perx = G >> 3; cx = c & 7; cj = c >> 3; } else { NXs = 1; perx = G; cx = 0; cj = c; }
        RBX = (NB + NXs - 1) / NXs;
    }
    __device__ __forceinline__ bool next(int i, Unit& u) const {
        const int j = i * perx + cj, rbl = j / NPN; if (rbl >= RBX) return false;
        const int rb = cx * RBX + rbl; if (rb >= NB) return false;
        int e = 0;
        for (int q = 1; q < 32; ++q) e = (blk[q] <= rb) ? q : e;
        u.pm = rb; u.pn = j - rbl * NPN; u.e = e; u.b = Bt + (size_t)e * estep + (size_t)u.pn * tstepB; return true;
    }
    __device__ __forceinline__ unsigned rowidx(int ui, const Unit& u, int r) const { if (GATHER) return (unsigned)idx[ui * 256 + r]; return (unsigned)(u.pm * BM + r); }
};

template <bool FP8, unsigned ASCALE, class Epi, class Sched>
__device__ __forceinline__ void gemm_phase(LAS unsigned char* lds, const char* Abase, const int K, const Sched& S, const Epi& E) {
    int tid_ = threadIdx.x; asm volatile("" : "+v"(tid_));
    const int tid = tid_, wid = __builtin_amdgcn_readfirstlane(tid >> 6), lane = tid & 63, wr = wid >> 2, wc = wid & 3, fr = lane & 15, fq = lane >> 4;
    int nt_ = K / BK; asm volatile("" : "+s"(nt_)); const int nt = nt_;
    unsigned voffB[2]; int RA[2], CA[2];
#pragma unroll
    for (int i = 0; i < 2; ++i) { int R, C; stage_rc(tid * 16 + i * 8192, R, C); const int Rb = Epi::PERM ? ((R & ~31) + perm32(R & 31)) : R;
        voffB[i] = (unsigned)(Rb * K + C) * 2u; RA[i] = R; CA[i] = C * 2; }
    const size_t kstep = (size_t)(BK * 2);
    const size_t hstep = (size_t)HALF * K * 2;
    const unsigned ldsw = (unsigned)wid * 1024u;
    const unsigned rowb = (unsigned)K * 2u;
    const int aoff = lds_byte(wr * 64 + fr, fq * 8), boff = lds_byte(wc * 32 + fr, fq * 8);
#define PG8_SA(b, h) (((b) * 2 + (h)) * HTB)
#define PG8_SB(b, h) ((4 + (b) * 2 + (h)) * HTB)
#define PG8_STAGE(bufoff, gbase, voff) do { _Pragma("unroll") for (int _i = 0; _i < 2; ++_i) \
        __builtin_amdgcn_global_load_lds((const unsigned*)((const char*)(gbase) + (voff)[_i]), (LAS unsigned*)(lds + (bufoff) + ldsw + _i * 8192), 16, 0, 0); } while (0)
#define PG8_LDA(dst, b, h) do { _Pragma("unroll") for (int m = 0; m < 4; ++m) _Pragma("unroll") for (int k = 0; k < 2; ++k) dst[m][k] = *(const LAS bf16x8*)(lds + PG8_SA(b, h) + aoff + m * 2048 + k * 1024); } while (0)
#define PG8_LDB(dst, b, h) do { _Pragma("unroll") for (int n = 0; n < 2; ++n) _Pragma("unroll") for (int k = 0; k < 2; ++k) dst[n][k] = *(const LAS bf16x8*)(lds + PG8_SB(b, h) + boff + n * 2048 + k * 1024); } while (0)
#define PG8_MMA(ai, bj, At, Bt) do { __builtin_amdgcn_s_setprio(1); _Pragma("unroll") for (int m = 0; m < 4; ++m) _Pragma("unroll") for (int n = 0; n < 2; ++n) { \
        if constexpr (FP8) { \
            const i32x8 wf_ = __builtin_shufflevector((i32x4)Bt[n][0], (i32x4)Bt[n][1], 0, 1, 2, 3, 4, 5, 6, 7), af_ = __builtin_shufflevector((i32x4)At[m][0], (i32x4)At[m][1], 0, 1, 2, 3, 4, 5, 6, 7); \
            acc[ai][bj][m][n] = __builtin_amdgcn_mfma_scale_f32_16x16x128_f8f6f4(wf_, af_, acc[ai][bj][m][n], 0, 0, 0, 0x79797979, 0, (int)ASCALE); \
        } else { _Pragma("unroll") for (int k = 0; k < 2; ++k) \
            acc[ai][bj][m][n] = __builtin_amdgcn_mfma_f32_16x16x32_bf16(Bt[n][k], At[m][k], acc[ai][bj][m][n], 0, 0, 0); } } \
        __builtin_amdgcn_s_setprio(0); } while (0)
#define PG8_WAIT_V(n) asm volatile("s_waitcnt vmcnt(" #n ")" ::: "memory")
#define PG8_WAIT_L(n) asm volatile("s_waitcnt lgkmcnt(" #n ")" ::: "memory")
#define PG8_BAR __builtin_amdgcn_s_barrier()
#define PG8_SCHED __builtin_amdgcn_sched_barrier(0)
#define PG8_LOADVA(ui_, u_) do { _Pragma("unroll") for (int _h = 0; _h < 2; ++_h) _Pragma("unroll") for (int _i = 0; _i < 2; ++_i) \
        vA[_h][_i] = S.rowidx((ui_), (u_), _h * HALF + RA[_i]) * rowb + (unsigned)CA[_i]; } while (0)
    Unit cur, nxt; int ui = 0;
    if (!S.next(0, cur)) return;
    f32x4 acc[2][2][4][2];
#pragma unroll
    for (int a = 0; a < 2; ++a)
#pragma unroll
        for (int b = 0; b < 2; ++b)
#pragma unroll
            for (int m = 0; m < 4; ++m)
#pragma unroll
                for (int n = 0; n < 2; ++n) acc[a][b][m][n] = (f32x4){0.f, 0.f, 0.f, 0.f};
    bf16x8 At[4][2], B0[2][2], B1[2][2];
    unsigned vA[2][2];
    PG8_LOADVA(0, cur);
    const char* cB = cur.b;
    if (Epi::BIAS && tid < 64) __builtin_amdgcn_global_load_lds((const unsigned*)E.bias_ptr(cur, tid), (LAS unsigned*)(lds + LDS_BIASBUF), 16, 0, 0);
    if (Epi::EXTRA && tid < 64) __builtin_amdgcn_global_load_lds((const unsigned*)E.extra_ptr(cur, tid), (LAS unsigned*)(lds + LDS_BIASBUF + 1024), 16, 0, 0);
    PG8_STAGE(PG8_SB(0, 0), cB, voffB); PG8_STAGE(PG8_SB(0, 1), cB + hstep, voffB); PG8_STAGE(PG8_SA(0, 0), Abase, vA[0]); PG8_STAGE(PG8_SA(0, 1), Abase, vA[1]);
    if (wr == 1) PG8_BAR;
    PG8_WAIT_V(2); PG8_BAR;
    PG8_STAGE(PG8_SB(1, 0), cB + kstep, voffB); PG8_STAGE(PG8_SA(1, 0), Abase + kstep, vA[0]); PG8_STAGE(PG8_SB(1, 1), cB + hstep + kstep, voffB);
    PG8_WAIT_V(6); PG8_BAR;
    for (;;) {
        const bool has_next = S.next(ui + 1, nxt);
        const char* nB = has_next ? nxt.b : cB;
#pragma unroll 1
        for (int t = 0; t < nt; t += 2) {
            const bool last = (t == nt - 2);
            const char* a1 = Abase + (size_t)(t + 1) * kstep;
            const char* a2 = last ? Abase : Abase + (size_t)(t + 2) * kstep;
            const char* b2 = last ? nB : cB + (size_t)(t + 2) * kstep;
            const char* a3 = a2 + kstep; const char* b3 = b2 + kstep;
            PG8_LDB(B0, 0, 0); PG8_LDB(B1, 0, 1); PG8_SCHED; PG8_LDA(At, 0, 0); PG8_STAGE(PG8_SA(1, 1), a1, vA[1]);
            if (last && has_next) { PG8_LOADVA(ui + 1, nxt);
                if (Epi::BIAS && tid < 64) __builtin_amdgcn_global_load_lds((const unsigned*)E.bias_ptr(nxt, tid), (LAS unsigned*)(lds + LDS_BIASBUF + ((ui + 1) & 1) * 2048), 16, 0, 0);
                if (Epi::EXTRA && tid < 64) __builtin_amdgcn_global_load_lds((const unsigned*)E.extra_ptr(nxt, tid), (LAS unsigned*)(lds + LDS_BIASBUF + ((ui + 1) & 1) * 2048 + 1024), 16, 0, 0); }
            PG8_WAIT_V(8); PG8_WAIT_L(0); PG8_BAR; PG8_MMA(0, 0, At, B0); PG8_MMA(0, 1, At, B1); PG8_BAR; PG8_SCHED;
            PG8_LDA(At, 0, 1); PG8_STAGE(PG8_SB(0, 0), b2, voffB); PG8_STAGE(PG8_SB(0, 1), b2 + hstep, voffB); PG8_STAGE(PG8_SA(0, 0), a2, vA[0]);
            PG8_WAIT_V(8); PG8_WAIT_L(0); PG8_BAR; PG8_MMA(1, 0, At, B0); PG8_MMA(1, 1, At, B1); PG8_BAR; PG8_SCHED;
            PG8_LDB(B0, 1, 0); PG8_LDB(B1, 1, 1); PG8_SCHED; PG8_LDA(At, 1, 0); PG8_STAGE(PG8_SA(0, 1), a2, vA[1]);
            PG8_WAIT_V(8); PG8_WAIT_L(0); PG8_BAR; PG8_MMA(0, 0, At, B0); PG8_MMA(0, 1, At, B1); PG8_BAR; PG8_SCHED;
            PG8_LDA(At, 1, 1); PG8_STAGE(PG8_SB(1, 0), b3, voffB); PG8_STAGE(PG8_SB(1, 1), b3 + hstep, voffB); PG8_STAGE(PG8_SA(1, 0), a3, vA[0]);
            PG8_WAIT_V(8); PG8_WAIT_L(0); PG8_BAR; PG8_MMA(1, 0, At, B0); PG8_MMA(1, 1, At, B1); PG8_BAR; PG8_SCHED;
        }
        if (wr == 0) PG8_BAR;
        E(acc, cur, wr, wc, fr, fq, (const LAS float*)(lds + LDS_BIASBUF + (ui & 1) * 2048));
        if (!has_next) break;
#pragma unroll
        for (int a = 0; a < 2; ++a)
#pragma unroll
            for (int b = 0; b < 2; ++b)
#pragma unroll
                for (int m = 0; m < 4; ++m)
#pragma unroll
                    for (int n = 0; n < 2; ++n) acc[a][b][m][n] = (f32x4){0.f, 0.f, 0.f, 0.f};
        cur = nxt; cB = nB; ++ui;
        if (wr == 1) PG8_BAR;
    }
    PG8_WAIT_V(0);
    PG8_BAR;
#undef PG8_SA
#undef PG8_SB
#undef PG8_STAGE
#undef PG8_LDA
#undef PG8_LDB
#undef PG8_MMA
#undef PG8_WAIT_V
#undef PG8_WAIT_L
#undef PG8_BAR
#undef PG8_SCHED
#undef PG8_LOADVA
}

typedef f32x4 Acc[2][2][4][2];

struct EpiZ {
    static constexpr bool PERM = true, BIAS = true, EXTRA = false;
    __device__ __forceinline__ const float* extra_ptr(const Unit&, int) const { return nullptr; }
    __device__ __forceinline__ const float* bias_ptr(const Unit& u, int t) const { return bias + u.pn * 256 + 4 * t; }
    bf16_t* Z; const float* bias; float* out; int l; unsigned char* ZG;
    __device__ __forceinline__ void operator()(const Acc& acc, const Unit& u, int wr, int wc, int fr, int fq, const LAS float* lb) const {
        const int row0 = u.pm * 256 + wr * 64 + fr, col0 = u.pn * 256 + wc * 32 + 8 * fq;
        u32x2 wprev[2];
        f32x4 bv[2][2];
#pragma unroll
        for (int bj = 0; bj < 2; ++bj)
#pragma unroll
            for (int n = 0; n < 2; ++n) bv[bj][n] = *(const LAS f32x4*)(lb + bj * 128 + wc * 32 + 8 * fq + 4 * n);
#pragma unroll
        for (int ai = 0; ai < 2; ++ai)
#pragma unroll
            for (int m = 0; m < 4; ++m) {
                const int row = row0 + ai * 128 + m * 16;
                bf16_t* rowp = Z + (size_t)row * INW + col0;
                float* ko = nullptr; float* vo = nullptr;
                if (u.pn == 2) {
                    if (row < NPROMPT) { const int t = row & 4095; if (t >= 3968) { const size_t o = ((size_t)(l * 8 + (row >> 12)) * 128 + (t - 3968)) * 128 + wc * 32 + 8 * fq; ko = out + OKP + o; vo = out + OVP + o; } }
                    else { const int rr = row - NPROMPT; const size_t o = ((size_t)(l * 8 + (rr >> 6)) * 128 + 64 + (rr & 63)) * 128 + wc * 32 + 8 * fq; ko = out + OKS + o; vo = out + OVS + o; }
                }
#pragma unroll
                for (int bj = 0; bj < 2; ++bj) {
                    const f32x4 v0 = acc[ai][bj][m][0] + bv[bj][0], v1 = acc[ai][bj][m][1] + bv[bj][1];
                    if (u.pn >= 9) { u32x2 w8; w8.x = pk4_fp8(v0[0], v0[1], v0[2], v0[3]); w8.y = pk4_fp8(v1[0], v1[1], v1[2], v1[3]);
                        unsigned char* pz = ZG + (size_t)row * 2048 + (col0 - 2304) + bj * 128;
                        if ((m & 1) == 0) wprev[bj] = w8; else store_pair16(pz - (size_t)16 * 2048, pz, fq, wprev[bj], w8); }
                    else { u32x4 w; w.x = cvt_pk_bf16(v0[0], v0[1]); w.y = cvt_pk_bf16(v0[2], v0[3]); w.z = cvt_pk_bf16(v1[0], v1[1]); w.w = cvt_pk_bf16(v1[2], v1[3]);
                        *(u32x4*)(rowp + bj * 128) = w; }
                    float* o = bj == 0 ? ko : vo;
                    if (o) { *(f32x4*)o = v0; *(f32x4*)(o + 4) = v1; }
                }
                asm volatile("" ::: "memory");
            }
    }
};
struct EpiT1 {
    static constexpr bool PERM = true, BIAS = false, EXTRA = false;
    __device__ __forceinline__ const float* extra_ptr(const Unit&, int) const { return nullptr; }
    __device__ __forceinline__ const float* bias_ptr(const Unit&, int) const { return nullptr; }
    unsigned char* T1; const unsigned char* ZG;
    __device__ __forceinline__ void operator()(const Acc& acc, const Unit& u, int wr, int wc, int fr, int fq, const LAS float* lb) const {
        const int row0 = u.pm * 256 + wr * 64 + fr, col0 = u.pn * 256 + wc * 32 + 8 * fq;
        u32x2 g[2][4][2];
#pragma unroll
        for (int ai = 0; ai < 2; ++ai)
#pragma unroll
            for (int m = 0; m < 4; m += 2)
#pragma unroll
                for (int bj = 0; bj < 2; ++bj) { const unsigned char* pa = ZG + (size_t)(row0 + ai * 128 + m * 16) * 2048 + col0 + bj * 128;
                    load_pair16(pa, pa + (size_t)16 * 2048, fq, g[ai][m][bj], g[ai][m + 1][bj]); }
        asm volatile("" ::: "memory");
        u32x2 wprev[2];
#pragma unroll
        for (int ai = 0; ai < 2; ++ai)
#pragma unroll
            for (int m = 0; m < 4; ++m) {
                const int row = row0 + ai * 128 + m * 16;
#pragma unroll
                for (int bj = 0; bj < 2; ++bj) {
                    const u32x2 gw = g[ai][m][bj];
                    const f32x2 s0 = sigmoid2(__builtin_amdgcn_cvt_pk_f32_fp8(gw.x, false)), s1 = sigmoid2(__builtin_amdgcn_cvt_pk_f32_fp8(gw.x, true)),
                                s2 = sigmoid2(__builtin_amdgcn_cvt_pk_f32_fp8(gw.y, false)), s3 = sigmoid2(__builtin_amdgcn_cvt_pk_f32_fp8(gw.y, true));
                    const f32x4 a0 = acc[ai][bj][m][0], a1 = acc[ai][bj][m][1];
                    const f32x2 p0 = ((f32x2){a0[0], a0[1]} * 16.0f) * s0, p1 = ((f32x2){a0[2], a0[3]} * 16.0f) * s1, p2 = ((f32x2){a1[0], a1[1]} * 16.0f) * s2, p3 = ((f32x2){a1[2], a1[3]} * 16.0f) * s3;
                    u32x2 w; w.x = pk4_fp8(p0.x, p0.y, p1.x, p1.y); w.y = pk4_fp8(p2.x, p2.y, p3.x, p3.y);
                    if ((m & 1) == 0) wprev[bj] = w;
                    else store_pair16(T1 + (size_t)(row - 16) * D + col0 + bj * 128, T1 + (size_t)row * D + col0 + bj * 128, fq, wprev[bj], w);
                }
            }
    }
};
struct EpiMix {
    static constexpr bool PERM = true, BIAS = false, EXTRA = false;
    __device__ __forceinline__ const float* extra_ptr(const Unit&, int) const { return nullptr; }
    __device__ __forceinline__ const float* bias_ptr(const Unit&, int) const { return nullptr; }
    const unsigned char* T1; const unsigned char* ZG; unsigned char* MIX;
    __device__ __forceinline__ void operator()(const Acc& acc, const Unit& u, int wr, int wc, int fr, int fq, const LAS float* lb) const {
        const int row0 = u.pm * 256 + wr * 64 + fr, col0 = u.pn * 256 + wc * 32 + 8 * fq;
        u32x2 g[2][4][2], t[2][4][2];
#pragma unroll
        for (int ai = 0; ai < 2; ++ai)
#pragma unroll
            for (int m = 0; m < 4; ++m)
#pragma unroll
                for (int bj = 0; bj < 2; ++bj) { if (m & 1) continue; const int row = row0 + ai * 128 + m * 16;
                    const unsigned char* pg = ZG + (size_t)row * 2048 + 1024 + col0 + bj * 128; const unsigned char* pt = T1 + (size_t)row * D + col0 + bj * 128;
                    load_pair16(pg, pg + (size_t)16 * 2048, fq, g[ai][m][bj], g[ai][m | 1][bj]);
                    load_pair16(pt, pt + (size_t)16 * D, fq, t[ai][m][bj], t[ai][m | 1][bj]); }
        asm volatile("" ::: "memory");
        u32x2 wprev[2];
#pragma unroll
        for (int ai = 0; ai < 2; ++ai)
#pragma unroll
            for (int m = 0; m < 4; ++m) {
                const int row = row0 + ai * 128 + m * 16;
#pragma unroll
                for (int bj = 0; bj < 2; ++bj) {
                    const u32x2 gw = g[ai][m][bj], tw = t[ai][m][bj];
                    const f32x2 s0 = sigmoid2(__builtin_amdgcn_cvt_pk_f32_fp8(gw.x, false)), s1 = sigmoid2(__builtin_amdgcn_cvt_pk_f32_fp8(gw.x, true)),
                                s2 = sigmoid2(__builtin_amdgcn_cvt_pk_f32_fp8(gw.y, false)), s3 = sigmoid2(__builtin_amdgcn_cvt_pk_f32_fp8(gw.y, true));
                    const f32x2 t0 = __builtin_amdgcn_cvt_pk_f32_fp8(tw.x, false), t1 = __builtin_amdgcn_cvt_pk_f32_fp8(tw.x, true), t2 = __builtin_amdgcn_cvt_pk_f32_fp8(tw.y, false), t3 = __builtin_amdgcn_cvt_pk_f32_fp8(tw.y, true);
                    const f32x4 a0 = acc[ai][bj][m][0], a1 = acc[ai][bj][m][1];
                    const f32x2 p0 = t0 * 0.0625f + (f32x2){a0[0], a0[1]} * s0, p1 = t1 * 0.0625f + (f32x2){a0[2], a0[3]} * s1, p2 = t2 * 0.0625f + (f32x2){a1[0], a1[1]} * s2, p3 = t3 * 0.0625f + (f32x2){a1[2], a1[3]} * s3;
                    u32x2 w; w.x = pk4_fp8(p0.x, p0.y, p1.x, p1.y); w.y = pk4_fp8(p2.x, p2.y, p3.x, p3.y);
                    if ((m & 1) == 0) wprev[bj] = w;
                    else store_pair16(MIX + (size_t)(row - 16) * D + col0 + bj * 128, MIX + (size_t)row * D + col0 + bj * 128, fq, wprev[bj], w);
                }
            }
    }
};
struct EpiX {
    static constexpr bool PERM = true, BIAS = false, EXTRA = false;
    __device__ __forceinline__ const float* extra_ptr(const Unit&, int) const { return nullptr; }
    __device__ __forceinline__ const float* bias_ptr(const Unit&, int) const { return nullptr; }
    const bf16_t* X; bf16_t* V; const float* modl;
    __device__ __forceinline__ void operator()(const Acc& acc, const Unit& u, int wr, int wc, int fr, int fq, const LAS float* lb) const {
        const int row0 = u.pm * 256 + wr * 64 + fr, col0 = u.pn * 256 + wc * 32 + 8 * fq;
        const bool uni = u.pm < 128;
        f32x4 g[2][2];
        if (uni) { const float* gp = modl + (size_t)(u.pm >> 4) * 6144 + 2048 + col0;
#pragma unroll
            for (int bj = 0; bj < 2; ++bj)
#pragma unroll
                for (int n = 0; n < 2; ++n) g[bj][n] = *(const f32x4*)(gp + bj * 128 + 4 * n) + 1.0f; }
#pragma unroll
        for (int ai = 0; ai < 2; ++ai) {
            u32x4 x[4][2];
#pragma unroll
            for (int m = 0; m < 4; ++m)
#pragma unroll
                for (int bj = 0; bj < 2; ++bj) x[m][bj] = *(const u32x4*)(X + (size_t)(row0 + ai * 128 + m * 16) * D + col0 + bj * 128);
            asm volatile("" ::: "memory");
#pragma unroll
            for (int m = 0; m < 4; ++m) {
                const int row = row0 + ai * 128 + m * 16;
                if (!uni) { const float* gp = modl + (size_t)batch_of(row) * 6144 + 2048 + col0;
#pragma unroll
                    for (int bj = 0; bj < 2; ++bj)
#pragma unroll
                        for (int n = 0; n < 2; ++n) g[bj][n] = *(const f32x4*)(gp + bj * 128 + 4 * n) + 1.0f; }
#pragma unroll
                for (int bj = 0; bj < 2; ++bj) {
                    const u32x4 xx = x[m][bj];
                    const f32x4 x0 = (f32x4){bf_lo(xx.x), bf_hi(xx.x), bf_lo(xx.y), bf_hi(xx.y)}, x1 = (f32x4){bf_lo(xx.z), bf_hi(xx.z), bf_lo(xx.w), bf_hi(xx.w)};
                    const f32x4 v0 = x0 * ALPHA + g[bj][0] * acc[ai][bj][m][0], v1 = x1 * ALPHA + g[bj][1] * acc[ai][bj][m][1];
                    u32x4 w; w.x = cvt_pk_bf16(v0[0], v0[1]); w.y = cvt_pk_bf16(v0[2], v0[3]); w.z = cvt_pk_bf16(v1[0], v1[1]); w.w = cvt_pk_bf16(v1[2], v1[3]);
                    *(u32x4*)(V + (size_t)row * D + col0 + bj * 128) = w;
                }
            }
            asm volatile("" ::: "memory");
        }
    }
};
struct EpiAct {
    static constexpr bool PERM = true, BIAS = true, EXTRA = false;
    __device__ __forceinline__ const float* extra_ptr(const Unit&, int) const { return nullptr; }
    __device__ __forceinline__ const float* bias_ptr(const Unit& u, int t) const { return bgu + (size_t)u.e * 2048 + u.pn * 128 + (t < 32 ? 4 * t : 1024 + 4 * (t - 32)); }
    unsigned char* ACT; const float* bgu;
    __device__ __forceinline__ void operator()(const Acc& acc, const Unit& u, int wr, int wc, int fr, int fq, const LAS float* lb) const {
        const int row0 = u.pm * 256 + wr * 64 + fr, c0 = u.pn * 128 + wc * 32 + 8 * fq;
        u32x2 wprev;
        f32x4 bg[2], bl[2];
#pragma unroll
        for (int n = 0; n < 2; ++n) { bg[n] = *(const LAS f32x4*)(lb + wc * 32 + 8 * fq + 4 * n); bl[n] = *(const LAS f32x4*)(lb + 128 + wc * 32 + 8 * fq + 4 * n); }
#pragma unroll
        for (int ai = 0; ai < 2; ++ai)
#pragma unroll
            for (int m = 0; m < 4; ++m) {
                const int row = row0 + ai * 128 + m * 16;
                float a[8];
#pragma unroll
                for (int n = 0; n < 2; ++n)
#pragma unroll
                    for (int jp = 0; jp < 2; ++jp) {
                        f32x2 g = (f32x2){acc[ai][0][m][n][2 * jp], acc[ai][0][m][n][2 * jp + 1]} + (f32x2){bg[n][2 * jp], bg[n][2 * jp + 1]};
                        f32x2 li = (f32x2){acc[ai][1][m][n][2 * jp], acc[ai][1][m][n][2 * jp + 1]} + (f32x2){bl[n][2 * jp], bl[n][2 * jp + 1]};
                        g = __builtin_elementwise_min(g, (f32x2){7.0f, 7.0f});
                        li = __builtin_elementwise_min(__builtin_elementwise_max(li, (f32x2){-7.0f, -7.0f}), (f32x2){7.0f, 7.0f});
                        const f32x2 t = g * (-1.702f * 1.44269504089f);
                        f32x2 e; e.x = __builtin_amdgcn_exp2f(t.x); e.y = __builtin_amdgcn_exp2f(t.y);
                        const f32x2 dd = e + 1.0f;
                        f32x2 r; r.x = __builtin_amdgcn_rcpf(dd.x); r.y = __builtin_amdgcn_rcpf(dd.y);
                        const f32x2 av = (g * r) * (li + 1.0f);
                        a[n * 4 + 2 * jp] = av.x; a[n * 4 + 2 * jp + 1] = av.y;
                    }
                u32x2 w; w.x = pk4_fp8(a[0], a[1], a[2], a[3]); w.y = pk4_fp8(a[4], a[5], a[6], a[7]);
                if ((m & 1) == 0) wprev = w;
                else store_pair16(ACT + (size_t)(row - 16) * D + c0, ACT + (size_t)row * D + c0, fq, wprev, w);
                asm volatile("" ::: "memory");
            }
    }
};
struct EpiYs {
    static constexpr bool PERM = true, BIAS = true, EXTRA = true;
    __device__ __forceinline__ const float* extra_ptr(const Unit& u, int t) const { return gate + (size_t)u.e * NT + (u.pm - blk[u.e]) * 256 + 4 * t; }
    __device__ __forceinline__ const float* bias_ptr(const Unit& u, int t) const { return bdn + (size_t)u.e * D + u.pn * 256 + 4 * t; }
    unsigned char* YS; const float* bdn; const float* gate; const LAS int* cnt; const LAS int* blk;
    __device__ __forceinline__ void operator()(const Acc& acc, const Unit& u, int wr, int wc, int fr, int fq, const LAS float* lb) const {
        const int r0 = wr * 64 + fr, col0 = u.pn * 256 + wc * 32 + 8 * fq;
        const int rank0 = (u.pm - blk[u.e]) * 256; const int ce = cnt[u.e];
        f32x4 bv[2][2];
#pragma unroll
        for (int bj = 0; bj < 2; ++bj)
#pragma unroll
            for (int n = 0; n < 2; ++n) bv[bj][n] = *(const LAS f32x4*)(lb + bj * 128 + wc * 32 + 8 * fq + 4 * n);
        float gts[2][4];
#pragma unroll
        for (int ai = 0; ai < 2; ++ai)
#pragma unroll
            for (int m = 0; m < 4; ++m) { const int rank = rank0 + r0 + ai * 128 + m * 16; const float gv = lb[256 + r0 + ai * 128 + m * 16]; gts[ai][m] = rank < ce ? 16.0f * gv : 0.0f; }
        asm volatile("" ::: "memory");
        u32x2 wprev[2];
#pragma unroll
        for (int ai = 0; ai < 2; ++ai)
#pragma unroll
            for (int m = 0; m < 4; ++m) {
                const int r = r0 + ai * 128 + m * 16;
                const float gt = gts[ai][m];
                unsigned char* rowp = YS + (size_t)(u.pm * 256 + r) * D + col0;
#pragma unroll
                for (int bj = 0; bj < 2; ++bj) {
                    const f32x4 v0 = (acc[ai][bj][m][0] + bv[bj][0]) * gt, v1 = (acc[ai][bj][m][1] + bv[bj][1]) * gt;
                    u32x2 w; w.x = pk4_fp8(v0[0], v0[1], v0[2], v0[3]); w.y = pk4_fp8(v1[0], v1[1], v1[2], v1[3]);
                    if ((m & 1) == 0) wprev[bj] = w;
                    else store_pair16(rowp - (size_t)16 * D + bj * 128, rowp + bj * 128, fq, wprev[bj], w);
                }
                asm volatile("" ::: "memory");
            }
    }
};
}


#define XB_TMO      128
#define XB_XCNT(j)  (256  + 64 * (j))
#define XB_XSUB(j)  (1280 + 64 * (j))
#define XB_XGEN(j)  (2304 + 64 * (j))
#define XB_TOP      3328
#define XB_TOPGEN   3392
#define XCD_BAR_WORDS 3456
#define XB_SPIN_CAP (1u << 21)
__device__ __forceinline__ unsigned xb_ld(unsigned* p)              { return __hip_atomic_load(p, __ATOMIC_RELAXED, __HIP_MEMORY_SCOPE_AGENT); }
__device__ __forceinline__ unsigned xb_add(unsigned* p, unsigned v) { return __hip_atomic_fetch_add(p, v, __ATOMIC_RELAXED, __HIP_MEMORY_SCOPE_AGENT); }
__device__ __forceinline__ unsigned xb_xcc_id() { return (unsigned)__builtin_amdgcn_s_getreg((3 << 11) | 20) & 0xFu; }
#define XB_SPIN(cond, bar) do { unsigned _sp = 0; while (cond) { __builtin_amdgcn_s_sleep(1); \
    if ((++_sp & 255u) == 0u) { if (xb_ld(&(bar)[XB_TMO])) break; if (_sp > XB_SPIN_CAP) { atomicAdd(&(bar)[XB_TMO], 1u); break; } } } } while (0)
struct XcdBarrier { unsigned* bar; unsigned x; volatile LAS unsigned* st; };
__device__ __forceinline__ XcdBarrier xcd_barrier_post(unsigned* bar, volatile LAS unsigned* st) {
    XcdBarrier b; b.bar = bar; b.x = xb_xcc_id(); b.st = st;
    if (threadIdx.x == 0) (void)xb_add(&bar[XB_XCNT(b.x)], 1u);
    return b;
}
__device__ __forceinline__ void xcd_barrier_complete(unsigned* bar, unsigned x, unsigned& nloc, unsigned& nx) {
    const unsigned G = gridDim.x * gridDim.y * gridDim.z;
    unsigned sum, cnt, mine, sp = 0u;
    for (;;) {
        sum = 0u; cnt = 0u; mine = 0u;
#pragma unroll
        for (unsigned j = 0; j < 16; ++j) { const unsigned c = xb_ld(&bar[XB_XCNT(j)]); sum += c; cnt += (c > 0u) ? 1u : 0u; mine = (j == x) ? c : mine; }
        if (sum == G) break;
        __builtin_amdgcn_s_sleep(1);
        if ((++sp & 255u) == 0u) { if (xb_ld(&bar[XB_TMO])) break; if (sp > XB_SPIN_CAP) { atomicAdd(&bar[XB_TMO], 1u); break; } }
    }
    nloc = mine > 0u ? mine : 1u; nx = cnt > 0u ? cnt : 1u;
}
__device__ __forceinline__ void xcd_barrier(const XcdBarrier& b) {
    asm volatile("s_waitcnt vmcnt(0)" ::: "memory");
    __syncthreads();
    if (threadIdx.x == 0) {
        unsigned* bar = b.bar;
        __builtin_amdgcn_s_waitcnt(0);
        unsigned nloc = b.st[0], nx = b.st[1];
        if (nloc == 0u) { xcd_barrier_complete(bar, b.x, nloc, nx); b.st[0] = nloc; b.st[1] = nx; }
        const unsigned old = xb_add(&bar[XB_XSUB(b.x)], 1u);
        const unsigned gen = old / nloc;
        if (old + 1u == (gen + 1u) * nloc) {
            __builtin_amdgcn_fence(__ATOMIC_RELEASE, "agent");
            asm volatile("s_waitcnt vmcnt(0)" ::: "memory");
            const unsigned og = xb_add(&bar[XB_TOP], 1u);
            const unsigned tg = og / nx;
            if (og + 1u == (tg + 1u) * nx) xb_add(&bar[XB_TOPGEN], 1u);
            else XB_SPIN(xb_ld(&bar[XB_TOPGEN]) == tg, bar);
            __builtin_amdgcn_fence(__ATOMIC_ACQUIRE, "agent");
            xb_add(&bar[XB_XGEN(b.x)], 1u);
            asm volatile("s_waitcnt vmcnt(0)" ::: "memory");
        } else {
            XB_SPIN(xb_ld(&bar[XB_XGEN(b.x)]) == gen, bar);
            __builtin_amdgcn_fence(__ATOMIC_ACQUIRE, "agent");
            asm volatile("s_waitcnt vmcnt(0)" ::: "memory");
        }
    }
    __syncthreads();
}

struct Ctx {
    LAS unsigned char* lds; int tid, lane, wave, G, bx;
    const float* const* in; float* out; unsigned char* ws;
};
#define LDS_WAIT() asm volatile("s_waitcnt lgkmcnt(0)" ::: "memory")

struct TDesc { const float* src; unsigned char* dst; int N, K, k0, n0, kind, f8; };
__device__ __forceinline__ void t64_load(const TDesc& d, float (&v)[64], int lane) {
    const float* src = d.src + (size_t)d.k0 * d.N + d.n0 + lane;
#pragma unroll
    for (int kk = 0; kk < 64; ++kk) v[kk] = src[(size_t)kk * d.N];
}
__device__ __forceinline__ void t64_finish(const TDesc& d, const float (&v)[64], LAS unsigned char* scr, int lane) {
    if (d.f8) {
        LAS unsigned char* wp = scr + lane * 80;
#pragma unroll
        for (int q = 0; q < 4; ++q) { u32x4 o;
            o.x = pk4_fp8(64.f * v[16 * q + 0], 64.f * v[16 * q + 1], 64.f * v[16 * q + 2], 64.f * v[16 * q + 3]);
            o.y = pk4_fp8(64.f * v[16 * q + 4], 64.f * v[16 * q + 5], 64.f * v[16 * q + 6], 64.f * v[16 * q + 7]);
            o.z = pk4_fp8(64.f * v[16 * q + 8], 64.f * v[16 * q + 9], 64.f * v[16 * q + 10], 64.f * v[16 * q + 11]);
            o.w = pk4_fp8(64.f * v[16 * q + 12], 64.f * v[16 * q + 13], 64.f * v[16 * q + 14], 64.f * v[16 * q + 15]);
            *(LAS u32x4*)(wp + q * 16) = o; }
        LDS_WAIT(); asm volatile("" ::: "memory");
        const int c = lane & 3;
#pragma unroll
        for (int j = 0; j < 4; ++j) { const int nl = (lane >> 2) + 16 * j; const u32x4 o = *(const LAS u32x4*)(scr + nl * 80 + c * 16);
            const int n = d.n0 + nl; int dr = n;
            if (d.kind == 1) { dr = (n < 1024) ? ((n >> 7) * 256 + (n & 127)) : (((n - 1024) >> 7) * 256 + 128 + (n & 127)); }
            *(u32x4*)(d.dst + (size_t)dr * d.K + d.k0 + c * 16) = o; }
    } else {
        LAS unsigned char* wp = scr + lane * 144;
#pragma unroll
        for (int q = 0; q < 8; ++q) { u32x4 o;
            o.x = cvt_pk_bf16(v[8 * q + 0], v[8 * q + 1]); o.y = cvt_pk_bf16(v[8 * q + 2], v[8 * q + 3]); o.z = cvt_pk_bf16(v[8 * q + 4], v[8 * q + 5]); o.w = cvt_pk_bf16(v[8 * q + 6], v[8 * q + 7]);
            *(LAS u32x4*)(wp + q * 16) = o; }
        LDS_WAIT(); asm volatile("" ::: "memory");
        const int c = lane & 7;
#pragma unroll
        for (int j = 0; j < 8; ++j) { const int nl = (lane >> 3) + 8 * j; const u32x4 o = *(const LAS u32x4*)(scr + nl * 144 + c * 16);
            *(u32x4*)(d.dst + ((size_t)(d.n0 + nl) * d.K + d.k0) * 2 + c * 16) = o; }
    }
    LDS_WAIT(); asm volatile("" ::: "memory");
}
__device__ __forceinline__ TDesc t64_decode(const float* const* in, unsigned char* ws, int it) {
    TDesc d; int r = it, item, nblk;
    if (r < 32768) { const int m = r >> 9; item = r & 511; d.src = in[23] + (size_t)m * 1024 * 2048; d.dst = ws + WS_WGU + (size_t)m * 2048 * 1024; d.N = 2048; d.K = 1024; d.kind = 1; d.f8 = 1; }
    else if ((r -= 32768) < 16384) { const int m = r >> 8; item = r & 255; d.src = in[25] + (size_t)m * 1024 * 1024; d.dst = ws + WS_WDN + (size_t)m * 1024 * 1024; d.N = 1024; d.K = 1024; d.kind = 0; d.f8 = 1; }
    else if ((r -= 16384) < 2176) { const int m = r / 1088; item = r % 1088; d.src = in[12] + (size_t)m * 1024 * INW; d.dst = ws + WS_WIN + (size_t)m * INW * 1024 * 2; d.N = INW; d.K = 1024; d.kind = 0; d.f8 = 0; }
    else if ((r -= 2176) < 2176) { const int m = r / 1088; item = r % 1088; d.src = in[12] + (size_t)m * 1024 * INW; d.dst = ws + WS_WIN8 + (size_t)m * INW * 1024; d.N = INW; d.K = 1024; d.kind = 0; d.f8 = 1; }
    else if ((r -= 2176) < 512) { const int m = r >> 8; item = r & 255; d.src = in[18] + (size_t)m * 1024 * 1024; d.dst = ws + WS_WO + (size_t)m * 1024 * 1024; d.N = 1024; d.K = 1024; d.kind = 0; d.f8 = 1; }
    else if ((r -= 512) < 256) { const int m = r >> 7; item = r & 127; d.src = in[16] + (size_t)m * 512 * 1024; d.dst = ws + WS_WOA + (size_t)m * 1024 * 512; d.N = 1024; d.K = 512; d.kind = 0; d.f8 = 1; }
    else { r -= 256; const int m = r >> 7; item = r & 127; d.src = in[17] + (size_t)m * 512 * 1024; d.dst = ws + WS_WOB + (size_t)m * 1024 * 512; d.N = 1024; d.K = 512; d.kind = 0; d.f8 = 1; }
    nblk = d.N >> 6; const int kb = item / nblk; d.k0 = kb * 64; d.n0 = (item - kb * nblk) * 64;
    return d;
}

__device__ __forceinline__ int rel_bucket(int rel) {
    const int n = rel < 0 ? -rel : rel;
    int v;
    if (n < 8) v = n;
    else { const float nf = (float)n; int large = 8 + (int)(logf(nf / 8.0f) / 2.7725887298583984f * 8.0f); v = large < 15 ? large : 15; }
    return (rel > 0 ? 16 : 0) + v;
}

__device__ __forceinline__ void phase0a(Ctx& F) {
    LAS float* scr = (LAS float*)(F.lds + F.wave * 16384);
    const int gw = F.bx * NWAVES + F.wave, NGW = F.G * NWAVES;
    unsigned char* ws = F.ws;
    {
        float* modp = (float*)(ws + WS_MODP);
        for (int it = gw; it < 2 * 96 * 8; it += NGW) {
            const int kc = it & 7, cgp = (it >> 3) % 96, l = it / (8 * 96), k0 = kc * 128, n0 = cgp * 64;
#pragma unroll 4
            for (int j = 0; j < 32; ++j) { const int idx = F.lane + 64 * j, r = idx >> 7, kk = idx & 127;
                const float c = r < 8 ? F.in[2][r * 1024 + k0 + kk] : F.in[3][(r - 8) * 1024 + k0 + kk];
                scr[kk * 16 + r] = c * sigmoidf_(c); }
            LDS_WAIT(); asm volatile("" ::: "memory");
            float a[16];
#pragma unroll
            for (int r = 0; r < 16; ++r) a[r] = 0.f;
            const float* wp = F.in[10] + ((size_t)l * 1024 + k0) * 6144 + n0 + F.lane;
#pragma unroll 16
            for (int kk = 0; kk < 128; ++kk) {
                const float w = wp[(size_t)kk * 6144];
                const LAS f32x4* sp = (const LAS f32x4*)(scr + kk * 16);
                const f32x4 s0 = sp[0], s1 = sp[1], s2 = sp[2], s3 = sp[3];
                a[0] += s0[0] * w; a[1] += s0[1] * w; a[2] += s0[2] * w; a[3] += s0[3] * w;
                a[4] += s1[0] * w; a[5] += s1[1] * w; a[6] += s1[2] * w; a[7] += s1[3] * w;
                a[8] += s2[0] * w; a[9] += s2[1] * w; a[10] += s2[2] * w; a[11] += s2[3] * w;
                a[12] += s3[0] * w; a[13] += s3[1] * w; a[14] += s3[2] * w; a[15] += s3[3] * w;
            }
            const float bb = (kc == 0) ? F.in[11][l * 6144 + n0 + F.lane] : 0.f;
#pragma unroll
            for (int r = 0; r < 16; ++r) modp[(size_t)kc * (2 * 16 * 6144) + ((size_t)(l * 16 + r)) * 6144 + n0 + F.lane] = a[r] + bb;
            LDS_WAIT(); asm volatile("" ::: "memory");
        }
    }
    if (F.bx == 0) {
        float* bt = (float*)(ws + WS_BIAS);
        for (int i = F.tid; i < 8 * 256; i += NTHREADS) { const int h = i >> 8, ri = i & 255; const int rel = ri - 191;
            bt[i] = (ri < 255) ? F.in[7][rel_bucket(rel) * 8 + h] : 0.f; }
    }
    for (int i = F.bx * NTHREADS + F.tid; i < 2 * 8 * 64 * 128; i += F.G * NTHREADS) {
        const int lb = i >> 13, rem = i & 8191;
        F.out[OKS + (size_t)lb * 16384 + rem] = F.in[4][(size_t)lb * 16384 + 8192 + rem];
        F.out[OVS + (size_t)lb * 16384 + rem] = F.in[5][(size_t)lb * 16384 + 8192 + rem];
    }
    LAS unsigned char* scrb = F.lds + F.wave * 16384;
    constexpr int NITEMS = 32768 + 16384 + 2176 + 2176 + 512 + 256 + 256;
    {
        float va[64], vb[64]; TDesc da, db;
        int it = gw;
        if (it < NITEMS) { da = t64_decode(F.in, ws, it); t64_load(da, va, F.lane); }
        while (it < NITEMS) {
            int itn = it + NGW;
            if (itn < NITEMS) { db = t64_decode(F.in, ws, itn); t64_load(db, vb, F.lane); }
            t64_finish(da, va, scrb, F.lane);
            it = itn; if (it >= NITEMS) break;
            itn = it + NGW;
            if (itn < NITEMS) { da = t64_decode(F.in, ws, itn); t64_load(da, va, F.lane); }
            t64_finish(db, vb, scrb, F.lane);
            it = itn;
        }
    }
}

__device__ __forceinline__ void ln_row(f32x4 (&v)[4], const float* g, const float* b, int lane) {
    float s = 0.f;
#pragma unroll
    for (int j = 0; j < 4; ++j) s += (v[j][0] + v[j][1]) + (v[j][2] + v[j][3]);
    const float mean = wave_sum(s) * (1.0f / D); float s2 = 0.f;
#pragma unroll
    for (int j = 0; j < 4; ++j) { v[j] = v[j] - mean; s2 += (v[j][0] * v[j][0] + v[j][1] * v[j][1]) + (v[j][2] * v[j][2] + v[j][3] * v[j][3]); }
    const float rstd = 1.0f / sqrtf(wave_sum(s2) * (1.0f / D) + LN_EPS);
#pragma unroll
    for (int j = 0; j < 4; ++j) { const f32x4 gg = *(const f32x4*)(g + 4 * lane + 256 * j), bb = *(const f32x4*)(b + 4 * lane + 256 * j); v[j] = v[j] * rstd * gg + bb; }
}
__device__ __forceinline__ void store_mod_row(const f32x4 (&v)[4], const float* sh, const float* sc, bf16_t* hrow, unsigned char* h8row, int lane) {
#pragma unroll
    for (int j = 0; j < 4; ++j) { const f32x4 a = *(const f32x4*)(sc + 4 * lane + 256 * j), b = *(const f32x4*)(sh + 4 * lane + 256 * j);
        const f32x4 h = v[j] * (a + 1.0f) + b; u32x2 w; w.x = cvt_pk_bf16(h[0], h[1]); w.y = cvt_pk_bf16(h[2], h[3]);
        *(u32x2*)(hrow + 4 * lane + 256 * j) = w;
        *(unsigned*)(h8row + 4 * lane + 256 * j) = pk4_fp8(h[0], h[1], h[2], h[3]); }
}

__device__ __forceinline__ void phase0b(Ctx& F) {
    const int gw = F.bx * NWAVES + F.wave, NGW = F.G * NWAVES;
    const float* mod = (const float*)(F.ws + WS_MOD);
    bf16_t* H = (bf16_t*)(F.ws + WS_H);
    for (int row = gw; row < NT; row += NGW) {
        const float* xr = row < NPROMPT ? F.in[0] + (size_t)row * D : F.in[1] + (size_t)(row - NPROMPT) * D;
        f32x4 v[4];
#pragma unroll
        for (int j = 0; j < 4; ++j) v[j] = *(const f32x4*)(xr + 4 * F.lane + 256 * j);
        ln_row(v, F.in[8], F.in[9], F.lane);
#pragma unroll
        for (int j = 0; j < 4; ++j) { u32x2 w; w.x = cvt_pk_bf16(v[j][0], v[j][1]); w.y = cvt_pk_bf16(v[j][2], v[j][3]); *(u32x2*)((bf16_t*)(F.ws + WS_XB) + (size_t)row * D + 4 * F.lane + 256 * j) = w; }
        const float* mb = mod + (size_t)batch_of(row) * 6144;
        store_mod_row(v, mb, mb + 1024, H + (size_t)row * D, F.ws + WS_H8 + (size_t)row * D, F.lane);
    }
}

__device__ __forceinline__ void phase_attn(Ctx& F, int l) {
    const bf16_t* Z = (const bf16_t*)(F.ws + WS_Z);
    unsigned char* YA = F.ws + WS_YA;
    unsigned char* YB = F.ws + WS_YB;
    const float* biasr = (const float*)(F.ws + WS_BIAS);
    LAS unsigned char* Ks = F.lds;
    LAS unsigned char* Vt = F.lds + 27648;
    LAS float* bt = (LAS float*)(F.lds + 53248);
    const int lane = F.lane, tid = F.tid;
    int bt_kv = -1;
    for (int au = F.bx; au < 1040; au += F.G) {
        const bool isS = au >= 1024;
        const int kv = au & 1;
        const int b = isS ? ((au - 1024) >> 1) : (au >> 7);
        const int n = isS ? 0 : ((au & 127) >> 1);
        __syncthreads();
        if (kv != bt_kv) { for (int i = tid; i < 1024; i += NTHREADS) bt[i] = biasr[(kv * 4 + (i >> 8)) * 256 + (i & 255)]; bt_kv = kv; }
#pragma unroll
        for (int jj = 0; jj < 3; ++jj) {
            const int p = tid + NTHREADS * jj, key = p >> 3, ds = p & 7;
            u32x4 kq = (u32x4){0u, 0u, 0u, 0u}, vq = (u32x4){0u, 0u, 0u, 0u};
            if (!isS) {
                const int t = n * 64 + key - 128;
                if (t >= 0) { const bf16_t* zr = Z + (size_t)(b * 4096 + t) * INW + kv * 64 + ds * 8; kq = *(const u32x4*)(zr + 512); vq = *(const u32x4*)(zr + 640); }
            } else if (key < 128) {
                const size_t o = ((size_t)((l * 8 + b) * 128 + key) * 2 + kv) * 64 + ds * 8;
                const f32x4 k0 = *(const f32x4*)(F.in[4] + o), k1 = *(const f32x4*)(F.in[4] + o + 4), v0 = *(const f32x4*)(F.in[5] + o), v1 = *(const f32x4*)(F.in[5] + o + 4);
                kq.x = cvt_pk_bf16(k0[0], k0[1]); kq.y = cvt_pk_bf16(k0[2], k0[3]); kq.z = cvt_pk_bf16(k1[0], k1[1]); kq.w = cvt_pk_bf16(k1[2], k1[3]);
                vq.x = cvt_pk_bf16(v0[0], v0[1]); vq.y = cvt_pk_bf16(v0[2], v0[3]); vq.z = cvt_pk_bf16(v1[0], v1[1]); vq.w = cvt_pk_bf16(v1[2], v1[3]);
            } else {
                const bf16_t* zr = Z + (size_t)(NPROMPT + b * 64 + key - 128) * INW + kv * 64 + ds * 8; kq = *(const u32x4*)(zr + 512); vq = *(const u32x4*)(zr + 640);
            }
            *(LAS u32x4*)(Ks + key * 144 + ds * 16) = kq;
            LAS unsigned short* vp = (LAS unsigned short*)Vt + (ds * 8) * 200 + key;
            vp[0 * 200] = (unsigned short)(vq.x & 0xffffu); vp[1 * 200] = (unsigned short)(vq.x >> 16);
            vp[2 * 200] = (unsigned short)(vq.y & 0xffffu); vp[3 * 200] = (unsigned short)(vq.y >> 16);
            vp[4 * 200] = (unsigned short)(vq.z & 0xffffu); vp[5 * 200] = (unsigned short)(vq.z >> 16);
            vp[6 * 200] = (unsigned short)(vq.w & 0xffffu); vp[7 * 200] = (unsigned short)(vq.w >> 16);
        }
        __syncthreads();
        const int g = F.wave >> 1, qi = (F.wave & 1) * 32 + (lane & 31), hh = lane >> 5, head = kv * 4 + g;
        const int qrow = isS ? NPROMPT + b * 64 + qi : b * 4096 + n * 64 + qi;
        bf16x8 Qf[4];
#pragma unroll
        for (int ks = 0; ks < 4; ++ks) Qf[ks] = *(const bf16x8*)(Z + (size_t)qrow * INW + head * 64 + ks * 16 + hh * 8);
        f32x16 S[6];
#pragma unroll
        for (int kb = 0; kb < 6; ++kb) {
#pragma unroll
            for (int j = 0; j < 16; ++j) S[kb][j] = 0.f;
#pragma unroll
            for (int ks = 0; ks < 4; ++ks) {
                const bf16x8 A = *(const LAS bf16x8*)(Ks + (kb * 32 + (lane & 31)) * 144 + (ks * 16 + hh * 8) * 2);
                S[kb] = __builtin_amdgcn_mfma_f32_32x32x16_bf16(A, Qf[ks], S[kb], 0, 0, 0);
            }
        }
        const float sinkv = F.in[14][l * 8 + head];
        float mx = sinkv;
        const int kmin = isS ? 0 : (128 - n * 64);
#pragma unroll
        for (int kb = 0; kb < 6; ++kb)
#pragma unroll
            for (int j = 0; j < 16; ++j) {
                const int key = kb * 32 + 8 * (j >> 2) + 4 * hh + (j & 3);
                float sv = S[kb][j] * 0.125f + bt[g * 256 + key - qi + 63];
                sv = key >= kmin ? sv : -1e30f;
                S[kb][j] = sv; mx = fmaxf(mx, sv);
            }
        mx = fmaxf(mx, __shfl_xor(mx, 32));
        float sum = 0.f;
#pragma unroll
        for (int kb = 0; kb < 6; ++kb)
#pragma unroll
            for (int j = 0; j < 16; ++j) { const float p = __expf(S[kb][j] - mx); S[kb][j] = p; sum += p; }
        sum += __shfl_xor(sum, 32);
        sum += __expf(sinkv - mx);
        const float inv = 1.0f / sum;
        f32x16 O[2];
#pragma unroll
        for (int db = 0; db < 2; ++db)
#pragma unroll
            for (int j = 0; j < 16; ++j) O[db][j] = 0.f;
#pragma unroll
        for (int kb = 0; kb < 6; ++kb)
#pragma unroll
            for (int s2 = 0; s2 < 2; ++s2) {
                union { bf16x8 v; unsigned u[4]; } P;
#pragma unroll
                for (int q = 0; q < 4; ++q) P.u[q] = cvt_pk_bf16(S[kb][8 * s2 + 2 * q], S[kb][8 * s2 + 2 * q + 1]);
#pragma unroll
                for (int db = 0; db < 2; ++db) {
                    const LAS unsigned char* vb = Vt + (db * 32 + (lane & 31)) * 400 + (kb * 32 + 16 * s2 + 4 * hh) * 2;
                    union { bf16x8 v; u32x2 h[2]; } Vf;
                    Vf.h[0] = *(const LAS u32x2*)vb; Vf.h[1] = *(const LAS u32x2*)(vb + 16);
                    O[db] = __builtin_amdgcn_mfma_f32_32x32x16_bf16(Vf.v, P.v, O[db], 0, 0, 0);
                }
            }
        unsigned char* orow = YA + (size_t)qrow * 512 + head * 64 + 4 * hh; const float inv8 = inv * 8.0f;
#pragma unroll
        for (int db = 0; db < 2; ++db)
#pragma unroll
            for (int jq = 0; jq < 4; ++jq) {
                *(unsigned*)(orow + db * 32 + 8 * jq) = pk4_fp8(O[db][4 * jq] * inv8, O[db][4 * jq + 1] * inv8, O[db][4 * jq + 2] * inv8, O[db][4 * jq + 3] * inv8);
            }
    }
    int nxtra = 1040 % F.G; if (1040 < F.G || 2 * nxtra > F.G) nxtra = 0;
    if (F.bx < nxtra) return;
    const int gw = (F.bx - nxtra) * NWAVES + F.wave, NGW = (F.G - nxtra) * NWAVES;
    const float* cw = F.in[15] + (size_t)l * 3 * 512 + 8 * lane;
    float w0[8], w1[8], w2[8];
#pragma unroll
    for (int e = 0; e < 8; ++e) { w0[e] = cw[e]; w1[e] = cw[512 + e]; w2[e] = cw[1024 + e]; }
    for (int row = gw; row < NT; row += NGW) {
        const bool isS = row >= NPROMPT; const int b = isS ? ((row - NPROMPT) >> 6) : (row >> 12), t = isS ? ((row - NPROMPT) & 63) : (row & 4095);
        const bf16_t* zr = Z + (size_t)row * INW + 8 * lane;
        const u32x4 cb = *(const u32x4*)(zr + 768);
        float u[3][8];
#pragma unroll
        for (int d = 0; d < 3; ++d) {
            if (t - d >= 0) {
                const bf16_t* zz = zr - (size_t)d * INW; const u32x4 cc = *(const u32x4*)(zz + 1280), cx = *(const u32x4*)(zz + 1792);
                u[d][0] = bf_lo(cc.x) * bf_lo(cx.x); u[d][1] = bf_hi(cc.x) * bf_hi(cx.x); u[d][2] = bf_lo(cc.y) * bf_lo(cx.y); u[d][3] = bf_hi(cc.y) * bf_hi(cx.y);
                u[d][4] = bf_lo(cc.z) * bf_lo(cx.z); u[d][5] = bf_hi(cc.z) * bf_hi(cx.z); u[d][6] = bf_lo(cc.w) * bf_lo(cx.w); u[d][7] = bf_hi(cc.w) * bf_hi(cx.w);
            } else if (isS) {
                const float* hp = F.in[6] + ((size_t)(l * 8 + b) * 2 + (2 + t - d)) * 512 + 8 * lane;
                const f32x4 h0 = *(const f32x4*)hp, h1 = *(const f32x4*)(hp + 4);
#pragma unroll
                for (int e = 0; e < 4; ++e) { u[d][e] = h0[e]; u[d][4 + e] = h1[e]; }
            } else {
#pragma unroll
                for (int e = 0; e < 8; ++e) u[d][e] = 0.f;
            }
        }
        const float cbf[8] = {bf_lo(cb.x), bf_hi(cb.x), bf_lo(cb.y), bf_hi(cb.y), bf_lo(cb.z), bf_hi(cb.z), bf_lo(cb.w), bf_hi(cb.w)};
        float y[8];
#pragma unroll
        for (int e = 0; e < 8; ++e) y[e] = cbf[e] * (w0[e] * u[2][e] + w1[e] * u[1][e] + w2[e] * u[0][e]);
        u32x2 w; w.x = pk4_fp8(y[0], y[1], y[2], y[3]); w.y = pk4_fp8(y[4], y[5], y[6], y[7]);
        *(u32x2*)(YB + (size_t)row * 512 + 8 * lane) = w;
        const int tl = isS ? 62 : 4094;
        if (t >= tl) {
            float* o = F.out + (isS ? OCS : OCP) + ((size_t)(l * 8 + b) * 2 + (t - tl)) * 512 + 8 * lane;
            *(f32x4*)o = (f32x4){u[0][0], u[0][1], u[0][2], u[0][3]}; *(f32x4*)(o + 4) = (f32x4){u[0][4], u[0][5], u[0][6], u[0][7]};
        }
    }
}

__device__ __forceinline__ void phase_ln_router(Ctx& F, int l) {
    bf16_t* XB = (bf16_t*)(F.ws + WS_XB); unsigned char* H8 = (unsigned char*)(F.ws + WS_H8); const bf16_t* V16 = (const bf16_t*)(F.ws + WS_V16);
    const float* mod = (const float*)(F.ws + WS_MOD) + (size_t)l * 16 * 6144;
    unsigned* cnt = (unsigned*)(F.ws + WS_CNT) + l * 2048;
    unsigned* tok = (unsigned*)(F.ws + WS_TOK); float* gate = (float*)(F.ws + WS_GATE); unsigned* slot = (unsigned*)(F.ws + WS_SLOT);
    const float* Wr = F.in[21] + (size_t)l * 1024 * 32;
    LAS float* hf = (LAS float*)F.lds;
    LAS unsigned char* Hh = F.lds;
    LAS unsigned char* Hl = F.lds + 66048;
    LAS unsigned* hist = (LAS unsigned*)(F.lds + 146432); LAS unsigned* hbase = hist + 32;
    LAS u32x4* rec = (LAS u32x4*)(F.lds + 132096);
    int nrec_tiles = 0;
    __syncthreads();
    if (F.tid < 32) hist[F.tid] = 0u;
    const int lane = F.lane, w = F.wave;
    bf16x8 bh[8], bl[8];
    {
#pragma unroll
        for (int ks = 0; ks < 8; ++ks) {
            const float* bp = Wr + (size_t)(128 * w + 16 * ks + 8 * (lane >> 5)) * 32 + (lane & 31);
            float wv[8];
#pragma unroll
            for (int j = 0; j < 8; ++j) wv[j] = bp[32 * j];
            union { bf16x8 v; unsigned u[4]; } ph, pl;
#pragma unroll
            for (int q = 0; q < 4; ++q) { const unsigned hw = cvt_pk_bf16(wv[2 * q], wv[2 * q + 1]); ph.u[q] = hw; pl.u[q] = cvt_pk_bf16(wv[2 * q] - bf_lo(hw), wv[2 * q + 1] - bf_hi(hw)); }
            bh[ks] = ph.v; bl[ks] = pl.v;
        }
    }
    for (int tidx = F.bx; tidx < 1024 + 256; tidx += F.G) {
        const int tile0 = tidx < 1024 ? tidx * 32 : NPROMPT + (tidx - 1024) * 2, nrows = tidx < 1024 ? 32 : 2;
        __syncthreads();
        if (w * 4 < nrows) {
            u32x2 pv[4][4];
#pragma unroll
            for (int rr = 0; rr < 4; ++rr) { const int rl = w * 4 + rr, row = rl < nrows ? tile0 + rl : tile0;
#pragma unroll
                for (int j = 0; j < 4; ++j) pv[rr][j] = *(const u32x2*)(V16 + (size_t)row * D + 4 * lane + 256 * j); }
#pragma unroll
            for (int rr = 0; rr < 4; ++rr) {
                const int rl = w * 4 + rr, row = tile0 + rl;
                if (rl < nrows) {
                    f32x4 v[4];
#pragma unroll
                    for (int j = 0; j < 4; ++j) v[j] = (f32x4){bf_lo(pv[rr][j].x), bf_hi(pv[rr][j].x), bf_lo(pv[rr][j].y), bf_hi(pv[rr][j].y)};
                    ln_row(v, F.in[19] + l * D, F.in[20] + l * D, lane);
#pragma unroll
                    for (int j = 0; j < 4; ++j) { u32x2 wq; wq.x = cvt_pk_bf16(v[j][0], v[j][1]); wq.y = cvt_pk_bf16(v[j][2], v[j][3]); *(u32x2*)(XB + (size_t)row * D + 4 * lane + 256 * j) = wq; }
                    const float* mb = mod + (size_t)batch_of(row) * 6144;
#pragma unroll
                    for (int j = 0; j < 4; ++j) { const f32x4 a = *(const f32x4*)(mb + 4096 + 4 * lane + 256 * j), b = *(const f32x4*)(mb + 3072 + 4 * lane + 256 * j);
                        const f32x4 h = v[j] * (a + 1.0f) + b;
                        *(unsigned*)(H8 + (size_t)row * D + 4 * lane + 256 * j) = pk4_fp8(h[0], h[1], h[2], h[3]);
                        u32x2 hw; hw.x = cvt_pk_bf16(h[0], h[1]); hw.y = cvt_pk_bf16(h[2], h[3]);
                        u32x2 lw; lw.x = cvt_pk_bf16(h[0] - bf_lo(hw.x), h[1] - bf_hi(hw.x)); lw.y = cvt_pk_bf16(h[2] - bf_lo(hw.y), h[3] - bf_hi(hw.y));
                        *(LAS u32x2*)(Hh + rl * 2064 + (4 * lane + 256 * j) * 2) = hw; *(LAS u32x2*)(Hl + rl * 2064 + (4 * lane + 256 * j) * 2) = lw; }
                }
            }
        }
        __syncthreads();
        f32x16 acc;
#pragma unroll
        for (int j = 0; j < 16; ++j) acc[j] = 0.f;
        {
            const int aoffb = (lane & 31) * 2064 + (128 * w + 8 * (lane >> 5)) * 2;
#pragma unroll
            for (int ks = 0; ks < 8; ++ks) {
                const bf16x8 ah = *(const LAS bf16x8*)(Hh + aoffb + ks * 32), al = *(const LAS bf16x8*)(Hl + aoffb + ks * 32);
                acc = __builtin_amdgcn_mfma_f32_32x32x16_bf16(ah, bh[ks], acc, 0, 0, 0);
                acc = __builtin_amdgcn_mfma_f32_32x32x16_bf16(ah, bl[ks], acc, 0, 0, 0);
                acc = __builtin_amdgcn_mfma_f32_32x32x16_bf16(al, bh[ks], acc, 0, 0, 0);
            }
        }
        __syncthreads();
        LAS float* red = hf;
#pragma unroll
        for (int j = 0; j < 16; ++j) red[(w * 32 + 8 * (j >> 2) + 4 * (lane >> 5) + (j & 3)) * 33 + (lane & 31)] = acc[j];
        __syncthreads();
        int e_sel[4]; float g_sel[4]; unsigned loc[4];
#pragma unroll
        for (int rr = 0; rr < 4; ++rr) {
            const int tk = w * 4 + rr;
            float val = -INFINITY;
            if (lane < 32) { float sacc = F.in[22][l * 32 + lane];
#pragma unroll
                for (int ww = 0; ww < 8; ++ww) sacc += red[(ww * 32 + tk) * 33 + lane];
                val = sacc; }
            float tv[4]; int te[4];
            {
                const int vbits = __float_as_int(val); int rank = 0;
#pragma unroll
                for (int j = 0; j < 32; ++j) { const float vj = __int_as_float(__builtin_amdgcn_readlane(vbits, j)); rank += (vj > val || (vj == val && j < lane)) ? 1 : 0; }
#pragma unroll
                for (int it = 0; it < 4; ++it) { const unsigned long long mk = __ballot(rank == it); const int ln = mk ? (__ffsll((long long)mk) - 1) : 0;
                    te[it] = ln; tv[it] = __int_as_float(__builtin_amdgcn_readlane(vbits, ln)); }
            }
            const float e1 = __expf(tv[1] - tv[0]), e2 = __expf(tv[2] - tv[0]), e3 = __expf(tv[3] - tv[0]);
            const float rs = 1.0f / (1.0f + e1 + e2 + e3);
            e_sel[rr] = lane == 0 ? te[0] : lane == 1 ? te[1] : lane == 2 ? te[2] : te[3];
            g_sel[rr] = (lane == 0 ? 1.0f : lane == 1 ? e1 : lane == 2 ? e2 : e3) * rs;
            loc[rr] = 0u;
            if (lane < 4 && tk < nrows) loc[rr] = atomicAdd((unsigned*)&hist[e_sel[rr]], 1u);
        }
        if (lane < 4) {
#pragma unroll
            for (int rr = 0; rr < 4; ++rr) {
                const int rl = w * 4 + rr;
                u32x4 rc; rc.x = (rl < nrows) ? (unsigned)(tile0 + rl) : 0xffffffffu; rc.y = (unsigned)(e_sel[rr] & 31); rc.z = loc[rr]; rc.w = __float_as_uint(g_sel[rr]);
                rec[(nrec_tiles * 32 + rl) * 4 + lane] = rc;
            }
        }
        ++nrec_tiles;
    }
    __syncthreads();
    if (F.tid < 32) { const unsigned hcount = hist[F.tid]; hbase[F.tid] = hcount ? atomicAdd(cnt + F.tid * 64, hcount) : 0u; }
    __syncthreads();
    for (int i = F.tid; i < nrec_tiles * 128; i += NTHREADS) {
        const u32x4 rc = rec[i];
        if (rc.x != 0xffffffffu) { const unsigned e = rc.y, rank = hbase[e] + rc.z;
            tok[(size_t)e * NT + rank] = rc.x; gate[(size_t)e * NT + rank] = __uint_as_float(rc.w); slot[(size_t)rc.x * 4 + (i & 3)] = (e << 24) | rank; }
    }
}

__device__ __forceinline__ void build_blk(Ctx& F, int l) {
    LAS int* blk = (LAS int*)(F.lds + LDS_BLK);
    const unsigned* cnt = (const unsigned*)(F.ws + WS_CNT) + l * 2048;
    __syncthreads();
    if (F.tid == 0) { LAS int* cl = (LAS int*)(F.lds + LDS_CNT); int s = 0; for (int e = 0; e < 32; ++e) { const int ce = (int)cnt[e * 64]; cl[e] = ce; blk[e] = s; s += (ce + 255) >> 8; } blk[32] = s; }
    __syncthreads();
}

__device__ __forceinline__ void phase_combine(Ctx& F, int l) {
    const LAS int* blk = (const LAS int*)(F.lds + LDS_BLK);
    float* X = F.out; bf16_t* XB = (bf16_t*)(F.ws + WS_XB); bf16_t* H = (bf16_t*)(F.ws + WS_H); const unsigned char* YS = F.ws + WS_YS;
    const unsigned* slot = (const unsigned*)(F.ws + WS_SLOT);
    const float* mod = (const float*)(F.ws + WS_MOD);
    const int gw = F.bx * NWAVES + F.wave, NGW = F.G * NWAVES, lane = F.lane;
    for (int row = gw; row < NT; row += NGW) {
        f32x4 ff[4];
#pragma unroll
        for (int j = 0; j < 4; ++j) ff[j] = (f32x4){0.f, 0.f, 0.f, 0.f};
#pragma unroll
        for (int k = 0; k < 4; ++k) {
            const unsigned s = slot[(size_t)row * 4 + k]; const int e = (int)(s >> 24), rank = (int)(s & 0xffffffu);
            const unsigned char* yr = YS + ((size_t)blk[e] * 256 + rank) * D + 4 * lane;
#pragma unroll
            for (int j = 0; j < 4; ++j) { const unsigned wv = *(const unsigned*)(yr + 256 * j); const f32x2 lo = __builtin_amdgcn_cvt_pk_f32_fp8(wv, false), hi = __builtin_amdgcn_cvt_pk_f32_fp8(wv, true);
                ff[j][0] += lo.x; ff[j][1] += lo.y; ff[j][2] += hi.x; ff[j][3] += hi.y; }
        }
        const int bi = batch_of(row);
        const float* mb = mod + (size_t)(l * 16 + bi) * 6144;
        f32x4 v[4];
#pragma unroll
        for (int j = 0; j < 4; ++j) { const u32x2 xw = *(const u32x2*)(XB + (size_t)row * D + 4 * lane + 256 * j); const f32x4 x = (f32x4){bf_lo(xw.x), bf_hi(xw.x), bf_lo(xw.y), bf_hi(xw.y)}, g2 = *(const f32x4*)(mb + 5120 + 4 * lane + 256 * j);
            v[j] = x * ALPHA + (g2 + 1.0f) * (ff[j] * 0.0625f); }
        ln_row(v, F.in[27] + l * D, F.in[28] + l * D, lane);
#pragma unroll
        for (int j = 0; j < 4; ++j) { if (l == 0) { u32x2 w; w.x = cvt_pk_bf16(v[j][0], v[j][1]); w.y = cvt_pk_bf16(v[j][2], v[j][3]); *(u32x2*)(XB + (size_t)row * D + 4 * lane + 256 * j) = w; }
            else *(f32x4*)(X + (size_t)row * D + 4 * lane + 256 * j) = v[j]; }
        if (l == 0) { const float* mn = mod + (size_t)(16 + bi) * 6144; store_mod_row(v, mn, mn + 1024, H + (size_t)row * D, F.ws + WS_H8 + (size_t)row * D, lane); }
    }
}

#ifndef PH_MASK
#define PH_MASK 0xFFFF
#endif
#define PH(b) ((PH_MASK >> (b)) & 1)
#ifndef PROBE_MASK
#define PROBE_MASK 0
#endif
#define PB0(id) do { if ((PROBE_MASK >> (id)) & 1) pb_t0 = __builtin_amdgcn_s_memrealtime(); } while (0)
#define PB1(id) do { if ((PROBE_MASK >> (id)) & 1) pb_acc += __builtin_amdgcn_s_memrealtime() - pb_t0; } while (0)
#define RELOAD() do { int t_ = threadIdx.x; asm volatile("" : "+v"(t_)); F.tid = t_; F.lane = t_ & 63; F.wave = __builtin_amdgcn_readfirstlane(t_ >> 6); \
    unsigned z_; asm volatile("s_mov_b32 %0, 0" : "=s"(z_)); F.in = p.in; F.out = p.out + z_; F.ws = p.ws + z_; } while (0)
#define LAYER_BODY(l) do { \
          \
        PB0(2); RELOAD(); \
        if (PH(2)) { \
              \
            pg8::SchedDense S; S.init(NT, 7 * 256, D, F.G, F.bx, (const bf16_t*)(F.ws + WS_WIN) + (size_t)l * INW * D, 2); \
            pg8::EpiZ E{(bf16_t*)(F.ws + WS_Z), F.in[13] + l * INW, F.out, l, F.ws + WS_ZG8}; \
            pg8::gemm_phase<false, 0u>(F.lds, (const char*)(F.ws + WS_H), D, S, E); \
        } \
        RELOAD(); \
        if (PH(2)) { \
              \
            pg8::SchedDense S; S.init(NT, 10 * 256, 512, F.G, (F.G == 256) ? ((F.bx + 112) & 255) : F.bx, F.ws + WS_WIN8 + (size_t)l * INW * D, 0, 2, 7); \
            pg8::EpiZ E{(bf16_t*)(F.ws + WS_Z), F.in[13] + l * INW, F.out, l, F.ws + WS_ZG8}; \
            pg8::gemm_phase<true, 0x7f7f7f7fu>(F.lds, (const char*)(F.ws + WS_H8), 512, S, E); \
        } \
        xcd_barrier(xbar); PB1(2); PB0(3); \
        RELOAD(); \
        if (PH(3)) phase_attn(F, l); \
        xcd_barrier(xbar); PB1(3); PB0(4); \
          \
        RELOAD(); \
        if (PH(4)) { \
            pg8::SchedDense S; S.init(NT, D, 256, F.G, F.bx, F.ws + WS_WOA + (size_t)l * D * 512); \
            pg8::EpiT1 E{F.ws + WS_T1, F.ws + WS_ZG8}; \
            pg8::gemm_phase<true, 0x7c7c7c7cu>(F.lds, (const char*)(F.ws + WS_YA), 256, S, E); \
        } \
        RELOAD(); \
        if (PH(5)) { \
            pg8::SchedDense S; S.init(NT, D, 256, F.G, F.bx, F.ws + WS_WOB + (size_t)l * D * 512); \
            pg8::EpiMix E{F.ws + WS_T1, F.ws + WS_ZG8, F.ws + WS_MIX}; \
            pg8::gemm_phase<true, 0x7f7f7f7fu>(F.lds, (const char*)(F.ws + WS_YB), 256, S, E); \
        } \
        xcd_barrier(xbar); PB1(4); PB0(5); \
          \
        RELOAD(); \
        if (PH(6)) { \
            pg8::SchedDense S; S.init(NT, D, 512, F.G, F.bx, F.ws + WS_WO + (size_t)l * D * D); \
            pg8::EpiX E{(const bf16_t*)(F.ws + WS_XB), (bf16_t*)(F.ws + WS_V16), (const float*)(F.ws + WS_MOD) + (size_t)l * 16 * 6144}; \
            pg8::gemm_phase<true, 0x7f7f7f7fu>(F.lds, (const char*)(F.ws + WS_MIX), 512, S, E); \
        } \
        xcd_barrier(xbar); PB1(5); PB0(6); \
        RELOAD(); \
        if (PH(7)) phase_ln_router(F, l); \
        xcd_barrier(xbar); PB1(6); PB0(7); \
          \
        RELOAD(); \
        build_blk(F, l); \
        if (PH(8)) { \
            LAS int* blk = (LAS int*)(F.lds + LDS_BLK); \
            LAS unsigned short* idx = (LAS unsigned short*)(F.lds + LDS_IDX); \
            pg8::SchedMoE<true> S; S.init(blk, idx, 8, 512, F.G, F.bx, (const unsigned char*)(F.ws + WS_WGU) + (size_t)l * 32 * 2048 * D, (size_t)2048 * D); \
            const unsigned* cnt = (const unsigned*)(F.ws + WS_CNT) + l * 2048; const unsigned* tok = (const unsigned*)(F.ws + WS_TOK); \
            for (int i = 0; i < MAXU; ++i) { pg8::Unit u; if (!S.next(i, u)) break; \
                if (F.tid < 256) { int rank = (u.pm - blk[u.e]) * 256 + F.tid; const int ce = ((const LAS int*)(F.lds + LDS_CNT))[u.e]; rank = rank < ce ? rank : ce - 1; \
                    idx[i * 256 + F.tid] = (unsigned short)tok[(size_t)u.e * NT + rank]; } } \
            __syncthreads(); \
            pg8::EpiAct E{(unsigned char*)(F.ws + WS_ACT), F.in[24] + (size_t)l * 32 * 2048}; \
            pg8::gemm_phase<true, 0x7f7f7f7fu>(F.lds, (const char*)(F.ws + WS_H8), 512, S, E); \
        } \
        xcd_barrier(xbar); PB1(7); PB0(8); \
          \
        RELOAD(); \
        if (PH(9)) { \
            LAS int* blk = (LAS int*)(F.lds + LDS_BLK); \
            LAS unsigned short* idx = (LAS unsigned short*)(F.lds + LDS_IDX); \
            pg8::SchedMoE<false> S; S.init(blk, idx, 4, 512, F.G, F.bx, (const unsigned char*)(F.ws + WS_WDN) + (size_t)l * 32 * D * D, (size_t)D * D); \
            pg8::EpiYs E{F.ws + WS_YS, F.in[26] + (size_t)l * 32 * D, (const float*)(F.ws + WS_GATE), (const LAS int*)(F.lds + LDS_CNT), blk}; \
            pg8::gemm_phase<true, 0x7f7f7f7fu>(F.lds, (const char*)(F.ws + WS_ACT), 512, S, E); \
        } \
        xcd_barrier(xbar); PB1(8); PB0(9); \
        RELOAD(); \
        if (PH(10)) phase_combine(F, l); \
        if (l == 0) xcd_barrier(xbar); \
        PB1(9); \
 \
    } while (0)
__global__ void __launch_bounds__(NTHREADS, 2) fwd_megakernel(Params p) {
    extern __shared__ __attribute__((aligned(16))) unsigned char lds_raw[];
    cg::grid_group grid = cg::this_grid();
    Ctx F;
    F.lds = (LAS unsigned char*)lds_raw;
    F.G = gridDim.x; F.bx = blockIdx.x;
    volatile LAS unsigned* bst = (volatile LAS unsigned*)(F.lds + 147392);
    if (threadIdx.x < 2) bst[threadIdx.x] = 0u;
    __syncthreads();
    const XcdBarrier xbar = xcd_barrier_post((unsigned*)(p.ws + WS_BAR), bst);
    unsigned long long pb_t0 = 0, pb_acc = 0;
    PB0(0); RELOAD();
    if (PH(0)) phase0a(F);
    grid.sync();
    PB1(0); PB0(1); RELOAD();
    { const float* modp = (const float*)(F.ws + WS_MODP); float* mod = (float*)(F.ws + WS_MOD);
      for (int i = F.bx * NTHREADS + F.tid; i < 2 * 16 * 6144; i += F.G * NTHREADS) { float sm = 0.f;
#pragma unroll
          for (int kc = 0; kc < 8; ++kc) sm += modp[(size_t)kc * (2 * 16 * 6144) + i];
          mod[i] = sm; } }
    xcd_barrier(xbar);
    RELOAD();
    if (PH(1)) phase0b(F);
    xcd_barrier(xbar); PB1(1);

    LAYER_BODY(0);
    LAYER_BODY(1);
    if (PROBE_MASK != 0 && blockIdx.x == 0) { const unsigned long long te = __builtin_amdgcn_s_memrealtime(); while (__builtin_amdgcn_s_memrealtime() - te < pb_acc) __builtin_amdgcn_s_sleep(8); }
    (void)pb_t0; (void)pb_acc;
}

extern "C" void kernel_launch(void* const* d_in, const int* in_sizes, int n_in, void* d_out, int out_size, void* d_ws, size_t ws_size, hipStream_t stream) {
    static int grid = 0;
    if (grid == 0) {
        if (n_in != 29 || ws_size < WS_END) { fprintf(stderr, "kernel_launch: unexpected n_in %d / ws_size %zu (need %zu)\n", n_in, ws_size, (size_t)WS_END); grid = -1; return; }
        int dev = 0, cus = 0, per_cu = 0;
        hipGetDevice(&dev);
        hipDeviceGetAttribute(&cus, hipDeviceAttributeMultiprocessorCount, dev);
        if (hipFuncSetAttribute((const void*)fwd_megakernel, hipFuncAttributeMaxDynamicSharedMemorySize, LDS_BYTES) != hipSuccess) { fprintf(stderr, "kernel_launch: hipFuncSetAttribute failed\n"); grid = -1; return; }
        if (hipOccupancyMaxActiveBlocksPerMultiprocessor(&per_cu, (const void*)fwd_megakernel, NTHREADS, LDS_BYTES) != hipSuccess || per_cu < 1) { fprintf(stderr, "kernel_launch: occupancy query says %d blocks per CU\n", per_cu); per_cu = 1; }
        (void)hipGetLastError();
        grid = cus;
        if (grid != 256) fprintf(stderr, "kernel_launch: note: %d CUs (built for 256)\n", grid);
    }
    if (grid < 0) return;
    hipMemsetAsync((char*)d_ws, 0, WS_ZERO_BYTES, stream);
    Params p{};
    for (int i = 0; i < 29; ++i) p.in[i] = (const float*)d_in[i];
    p.out = (float*)d_out; p.ws = (unsigned char*)d_ws;
    void* args[] = {&p};
    hipError_t e = hipLaunchCooperativeKernel((const void*)fwd_megakernel, dim3(grid), dim3(NTHREADS), args, LDS_BYTES, stream);
    if (e != hipSuccess) fprintf(stderr, "kernel_launch: cooperative launch failed: %s (grid %d)\n", hipGetErrorString(e), grid);
}
```

```cpp
#include <hip/hip_runtime.h>
#include <hip/hip_cooperative_groups.h>
#include <cstdio>
#include <cstdint>
namespace cg = cooperative_groups;

#define LAS __attribute__((address_space(3)))
typedef unsigned short bf16_t;
typedef short bf16x8 __attribute__((ext_vector_type(8)));
typedef float f32x4 __attribute__((ext_vector_type(4)));
typedef float f32x16 __attribute__((ext_vector_type(16)));
typedef unsigned u32x4 __attribute__((ext_vector_type(4)));
typedef unsigned u32x2 __attribute__((ext_vector_type(2)));
typedef float f32x2 __attribute__((ext_vector_type(2)));
typedef int i32x4 __attribute__((ext_vector_type(4)));
typedef int i32x8 __attribute__((ext_vector_type(8)));

constexpr int D = 1024, NPROMPT = 32768, NT = 33280, INW = 4352, NEXP = 32;
constexpr float ALPHA = 1.41421356237f, LN_EPS = 1e-5f;
constexpr int NWAVES = 8, NTHREADS = 512;
constexpr int LDS_BYTES = 147456;
constexpr int LDS_BLK = 131072;
constexpr int LDS_IDX = 131072 + 256;
constexpr int MAXU = 20;
constexpr int LDS_BIASBUF = 141568;
constexpr int LDS_CNT = 145664;
constexpr size_t OKP = 34078720, OVP = 34340864, OCP = 34603008, OKS = 34619392, OVS = 34881536, OCS = 35143680;
constexpr size_t MiB = 1u << 20;
constexpr size_t WS_CNT = 0;
constexpr size_t WS_BAR = 16384;
constexpr size_t WS_MOD = 65536;
constexpr size_t WS_MODP = 192 * MiB;
constexpr size_t WS_ZERO_BYTES = 1 * MiB;
constexpr size_t WS_BIAS = 1 * MiB;
constexpr size_t WS_SLOT = 2 * MiB;
constexpr size_t WS_TOK = 3 * MiB;
constexpr size_t WS_GATE = 8 * MiB;
constexpr size_t WS_WIN = 16 * MiB;
constexpr size_t WS_WIN8 = 180 * MiB;
constexpr size_t WS_WOA = 34 * MiB;
constexpr size_t WS_WOB = 36 * MiB;
constexpr size_t WS_WO = 38 * MiB;
constexpr size_t WS_WGU = 48 * MiB;
constexpr size_t WS_WDN = 304 * MiB;
constexpr size_t WS_H = 432 * MiB;
constexpr size_t WS_H8 = 1600 * MiB;
constexpr size_t WS_Z = 498 * MiB;
constexpr size_t WS_YA = 776 * MiB;
constexpr size_t WS_YB = 810 * MiB;
constexpr size_t WS_T1 = 844 * MiB;
constexpr size_t WS_V16 = 910 * MiB;
constexpr size_t WS_XB = 1200 * MiB;
constexpr size_t WS_MIX = 976 * MiB;
constexpr size_t WS_ACT = 1042 * MiB;
constexpr size_t WS_YS = 1320 * MiB;
constexpr size_t WS_ZG8 = 1460 * MiB;
constexpr size_t WS_END = 1634 * MiB;

struct Params { const float* in[29]; float* out; unsigned char* ws; };

__device__ __forceinline__ unsigned cvt_pk_bf16(float lo, float hi) { unsigned r; asm("v_cvt_pk_bf16_f32 %0, %1, %2" : "=v"(r) : "v"(lo), "v"(hi)); return r; }
__device__ __forceinline__ unsigned pk4_fp8(float a, float b, float c, float d) { unsigned w = 0u; w = __builtin_amdgcn_cvt_pk_fp8_f32(a, b, w, false); w = __builtin_amdgcn_cvt_pk_fp8_f32(c, d, w, true); return w; }
__device__ __forceinline__ void unpk8_fp8(const u32x2 w, float (&o)[8]) { const f32x2 a = __builtin_amdgcn_cvt_pk_f32_fp8(w.x, false), b = __builtin_amdgcn_cvt_pk_f32_fp8(w.x, true), c = __builtin_amdgcn_cvt_pk_f32_fp8(w.y, false), d = __builtin_amdgcn_cvt_pk_f32_fp8(w.y, true);
    o[0] = a.x; o[1] = a.y; o[2] = b.x; o[3] = b.y; o[4] = c.x; o[5] = c.y; o[6] = d.x; o[7] = d.y; }
__device__ __forceinline__ void store_pair16(unsigned char* pa, unsigned char* pb, int fq, u32x2 wa, u32x2 wb) {
    const auto rx = __builtin_amdgcn_permlane16_swap(wa.x, wb.x, false, false);
    const auto ry = __builtin_amdgcn_permlane16_swap(wa.y, wb.y, false, false);
    u32x4 o; o.x = rx[0]; o.y = ry[0]; o.z = rx[1]; o.w = ry[1];
    *(u32x4*)((fq & 1) ? pb - 8 : pa) = o;
}
__device__ __forceinline__ void load_pair16(const unsigned char* pa, const unsigned char* pb, int fq, u32x2& wa, u32x2& wb) {
    const u32x4 x = *(const u32x4*)((fq & 1) ? pb - 8 : pa);
    const auto rx = __builtin_amdgcn_permlane16_swap(x.x, x.z, false, false);
    const auto ry = __builtin_amdgcn_permlane16_swap(x.y, x.w, false, false);
    wa.x = rx[0]; wa.y = ry[0]; wb.x = rx[1]; wb.y = ry[1];
}
__device__ __forceinline__ float bf_lo(unsigned w) { return __uint_as_float(w << 16); }
__device__ __forceinline__ float bf_hi(unsigned w) { return __uint_as_float(w & 0xffff0000u); }
__device__ __forceinline__ float sigmoidf_(float x) { return __builtin_amdgcn_rcpf(1.0f + __expf(-x)); }
__device__ __forceinline__ f32x2 sigmoid2(f32x2 x) {
    const f32x2 t = x * (-1.44269504089f);
    f32x2 e; e.x = __builtin_amdgcn_exp2f(t.x); e.y = __builtin_amdgcn_exp2f(t.y);
    const f32x2 d = e + 1.0f;
    f32x2 r; r.x = __builtin_amdgcn_rcpf(d.x); r.y = __builtin_amdgcn_rcpf(d.y);
    return r;
}
__device__ __forceinline__ float wave_sum(float v) {
#define WS_DPP_ADD(ctrl) v += __int_as_float(__builtin_amdgcn_update_dpp(0, __float_as_int(v), (ctrl), 0xf, 0xf, true))
    WS_DPP_ADD(0xB1);
    WS_DPP_ADD(0x4E);
    WS_DPP_ADD(0x141);
    WS_DPP_ADD(0x140);
#undef WS_DPP_ADD
    const int b = __float_as_int(v);
    const float r0 = __int_as_float(__builtin_amdgcn_readlane(b, 0)), r1 = __int_as_float(__builtin_amdgcn_readlane(b, 16)), r2 = __int_as_float(__builtin_amdgcn_readlane(b, 32)), r3 = __int_as_float(__builtin_amdgcn_readlane(b, 48));
    return (r0 + r1) + (r2 + r3);
}
__device__ __forceinline__ int batch_of(int row) { return row < NPROMPT ? (row >> 12) : 8 + ((row - NPROMPT) >> 6); }

namespace pg8 {
constexpr int BM = 256, BK = 64, HALF = 128, HTB = HALF * BK * 2, NXCD = 8, WGM = 8;
__device__ __forceinline__ int lds_byte(int r, int c) { const int st = (r >> 4) * 2 + (c >> 5), rr = r & 15, cc = c & 31, ob = rr * 64 + cc * 2; return st * 1024 + (ob ^ (((ob >> 9) & 1) << 5)); }
__device__ __forceinline__ void stage_rc(int b, int& R, int& C) { const int st = b / 1024, sb = b % 1024, swz = sb ^ (((sb >> 9) & 1) << 5); R = (st >> 1) * 16 + swz / 64; C = (st & 1) * 32 + (swz % 64) / 2; }
__device__ __forceinline__ int perm32(int rho) { const int n = rho >> 4, i = rho & 15; return 8 * (i >> 2) + 4 * n + (i & 3); }

struct Unit { int pm, pn, e; const char* b; };

struct SchedDense {
    int nM, nN, nwg, G, c, cbase, csplit, cskip; const char* Bt; size_t tstepB;
    __device__ __forceinline__ void init(int M, int N, int K, int G_, int c_, const void* Bt_, int cbase_ = 0, int csplit_ = 1 << 20, int cskip_ = 0) { nM = M / BM; nN = N / BM; nwg = nM * nN; G = G_; c = c_; Bt = (const char*)Bt_; tstepB = (size_t)BM * K * 2; cbase = cbase_; csplit = csplit_; cskip = cskip_; }
    __device__ __forceinline__ bool next(int i, Unit& u) const {
        const long L = (long)i * G + c; if (L >= nwg) return false;
        int wgid = (int)L; { const int q = nwg / NXCD, r = nwg % NXCD, xcd = wgid % NXCD, off = wgid / NXCD; wgid = (xcd < r ? xcd * (q + 1) : r * (q + 1) + (xcd - r) * q) + off; }
        const int nig = WGM * nN, gid = wgid / nig, fm = gid * WGM, gsz = (nM - fm) < WGM ? (nM - fm) : WGM;
        u.pm = fm + ((wgid % nig) % gsz); const int j = (wgid % nig) / gsz; u.pn = j < csplit ? j + cbase : j + cbase + cskip; u.e = 0; u.b = Bt + (size_t)u.pn * tstepB; return true;
    }
    __device__ __forceinline__ unsigned rowidx(int, const Unit& u, int r) const { return (unsigned)(u.pm * BM + r); }
};
template <bool GATHER> struct SchedMoE {
    const LAS int* blk; const LAS unsigned short* idx; int NB, RBX, NPN, NXs, perx, cx, cj; const char* Bt; size_t estep, tstepB;
    __device__ __forceinline__ void init(const LAS int* blk_, const LAS unsigned short* idx_, int NPN_, int K, int G, int c, const void* Bt_, size_t estep_) {
        blk = blk_; idx = idx_; NB = blk_[32]; NPN = NPN_; Bt = (const char*)Bt_; estep = estep_; tstepB = (size_t)BM * K * 2;
        if ((G & 7) == 0) { NXs = 8; perx = G >> 3; cx = c & 7; cj = c >> 3; } else { NXs = 1; perx = G; cx = 0; cj = c; }
        RBX = (NB + NXs - 1) / NXs;
    }
    __device__ __forceinline__ bool next(int i, Unit& u) const {
        const int j = i * perx + cj, rbl = j / NPN; if (rbl >= RBX) return false;
        const int rb = cx * RBX + rbl; if (rb >= NB) return false;
        int e = 0;
        for (int q = 1; q < 32; ++q) e = (blk[q] <= rb) ? q : e;
        u.pm = rb; u.pn = j - rbl * NPN; u.e = e; u.b = Bt + (size_t)e * estep + (size_t)u.pn * tstepB; return true;
    }
    __device__ __forceinline__ unsigned rowidx(int ui, const Unit& u, int r) const { if (GATHER) return (unsigned)idx[ui * 256 + r]; return (unsigned)(u.pm * BM + r); }
};

template <bool FP8, unsigned ASCALE, class Epi, class Sched>
__device__ __forceinline__ void gemm_phase(LAS unsigned char* lds, const char* Abase, const int K, const Sched& S, const Epi& E) {
    int tid_ = threadIdx.x; asm volatile("" : "+v"(tid_));
    const int tid = tid_, wid = __builtin_amdgcn_readfirstlane(tid >> 6), lane = tid & 63, wr = wid >> 2, wc = wid & 3, fr = lane & 15, fq = lane >> 4;
    int nt_ = K / BK; asm volatile("" : "+s"(nt_)); const int nt = nt_;
    unsigned voffB[2]; int RA[2], CA[2];
#pragma unroll
    for (int i = 0; i < 2; ++i) { int R, C; stage_rc(tid * 16 + i * 8192, R, C); const int Rb = Epi::PERM ? ((R & ~31) + perm32(R & 31)) : R;
        voffB[i] = (unsigned)(Rb * K + C) * 2u; RA[i] = R; CA[i] = C * 2; }
    const size_t kstep = (size_t)(BK * 2);
    const size_t hstep = (size_t)HALF * K * 2;
    const unsigned ldsw = (unsigned)wid * 1024u;
    const unsigned rowb = (unsigned)K * 2u;
    const int aoff = lds_byte(wr * 64 + fr, fq * 8), boff = lds_byte(wc * 32 + fr, fq * 8);
#define PG8_SA(b, h) (((b) * 2 + (h)) * HTB)
#define PG8_SB(b, h) ((4 + (b) * 2 + (h)) * HTB)
#define PG8_STAGE(bufoff, gbase, voff) do { _Pragma("unroll") for (int _i = 0; _i < 2; ++_i) \
        __builtin_amdgcn_global_load_lds((const unsigned*)((const char*)(gbase) + (voff)[_i]), (LAS unsigned*)(lds + (bufoff) + ldsw + _i * 8192), 16, 0, 0); } while (0)
#define PG8_LDA(dst, b, h) do { _Pragma("unroll") for (int m = 0; m < 4; ++m) _Pragma("unroll") for (int k = 0; k < 2; ++k) dst[m][k] = *(const LAS bf16x8*)(lds + PG8_SA(b, h) + aoff + m * 2048 + k * 1024); } while (0)
#define PG8_LDB(dst, b, h) do { _Pragma("unroll") for (int n = 0; n < 2; ++n) _Pragma("unroll") for (int k = 0; k < 2; ++k) dst[n][k] = *(const LAS bf16x8*)(lds + PG8_SB(b, h) + boff + n * 2048 + k * 1024); } while (0)
#define PG8_MMA(ai, bj, At, Bt) do { __builtin_amdgcn_s_setprio(1); _Pragma("unroll") for (int m = 0; m < 4; ++m) _Pragma("unroll") for (int n = 0; n < 2; ++n) { \
        if constexpr (FP8) { \
            const i32x8 wf_ = __builtin_shufflevector((i32x4)Bt[n][0], (i32x4)Bt[n][1], 0, 1, 2, 3, 4, 5, 6, 7), af_ = __builtin_shufflevector((i32x4)At[m][0], (i32x4)At[m][1], 0, 1, 2, 3, 4, 5, 6, 7); \
            acc[ai][bj][m][n] = __builtin_amdgcn_mfma_scale_f32_16x16x128_f8f6f4(wf_, af_, acc[ai][bj][m][n], 0, 0, 0, 0x79797979, 0, (int)ASCALE); \
        } else { _Pragma("unroll") for (int k = 0; k < 2; ++k) \
            acc[ai][bj][m][n] = __builtin_amdgcn_mfma_f32_16x16x32_bf16(Bt[n][k], At[m][k], acc[ai][bj][m][n], 0, 0, 0); } } \
        __builtin_amdgcn_s_setprio(0); } while (0)
#define PG8_WAIT_V(n) asm volatile("s_waitcnt vmcnt(" #n ")" ::: "memory")
#define PG8_WAIT_L(n) asm volatile("s_waitcnt lgkmcnt(" #n ")" ::: "memory")
#define PG8_BAR __builtin_amdgcn_s_barrier()
#define PG8_SCHED __builtin_amdgcn_sched_barrier(0)
#define PG8_LOADVA(ui_, u_) do { _Pragma("unroll") for (int _h = 0; _h < 2; ++_h) _Pragma("unroll") for (int _i = 0; _i < 2; ++_i) \
        vA[_h][_i] = S.rowidx((ui_), (u_), _h * HALF + RA[_i]) * rowb + (unsigned)CA[_i]; } while (0)
    Unit cur, nxt; int ui = 0;
    if (!S.next(0, cur)) return;
    f32x4 acc[2][2][4][2];
#pragma unroll
    for (int a = 0; a < 2; ++a)
#pragma unroll
        for (int b = 0; b < 2; ++b)
#pragma unroll
            for (int m = 0; m < 4; ++m)
#pragma unroll
                for (int n = 0; n < 2; ++n) acc[a][b][m][n] = (f32x4){0.f, 0.f, 0.f, 0.f};
    bf16x8 At[4][2], B0[2][2], B1[2][2];
    unsigned vA[2][2];
    PG8_LOADVA(0, cur);
    const char* cB = cur.b;
    if (Epi::BIAS && tid < 64) __builtin_amdgcn_global_load_lds((const unsigned*)E.bias_ptr(cur, tid), (LAS unsigned*)(lds + LDS_BIASBUF), 16, 0, 0);
    if (Epi::EXTRA && tid < 64) __builtin_amdgcn_global_load_lds((const unsigned*)E.extra_ptr(cur, tid), (LAS unsigned*)(lds + LDS_BIASBUF + 1024), 16, 0, 0);
    PG8_STAGE(PG8_SB(0, 0), cB, voffB); PG8_STAGE(PG8_SB(0, 1), cB + hstep, voffB); PG8_STAGE(PG8_SA(0, 0), Abase, vA[0]); PG8_STAGE(PG8_SA(0, 1), Abase, vA[1]);
    if (wr == 1) PG8_BAR;
    PG8_WAIT_V(2); PG8_BAR;
    PG8_STAGE(PG8_SB(1, 0), cB + kstep, voffB); PG8_STAGE(PG8_SA(1, 0), Abase + kstep, vA[0]); PG8_STAGE(PG8_SB(1, 1), cB + hstep + kstep, voffB);
    PG8_WAIT_V(6); PG8_BAR;
    for (;;) {
        const bool has_next = S.next(ui + 1, nxt);
        const char* nB = has_next ? nxt.b : cB;
#pragma unroll 1
        for (int t = 0; t < nt; t += 2) {
            const bool last = (t == nt - 2);
            const char* a1 = Abase + (size_t)(t + 1) * kstep;
            const char* a2 = last ? Abase : Abase + (size_t)(t + 2) * kstep;
            const char* b2 = last ? nB : cB + (size_t)(t + 2) * kstep;
            const char* a3 = a2 + kstep; const char* b3 = b2 + kstep;
            PG8_LDB(B0, 0, 0); PG8_LDB(B1, 0, 1); PG8_SCHED; PG8_LDA(At, 0, 0); PG8_STAGE(PG8_SA(1, 1), a1, vA[1]);
            if (last && has_next) { PG8_LOADVA(ui + 1, nxt);
                if (Epi::BIAS && tid < 64) __builtin_amdgcn_global_load_lds((const unsigned*)E.bias_ptr(nxt, tid), (LAS unsigned*)(lds + LDS_BIASBUF + ((ui + 1) & 1) * 2048), 16, 0, 0);
                if (Epi::EXTRA && tid < 64) __builtin_amdgcn_global_load_lds((const unsigned*)E.extra_ptr(nxt, tid), (LAS unsigned*)(lds + LDS_BIASBUF + ((ui + 1) & 1) * 2048 + 1024), 16, 0, 0); }
            PG8_WAIT_V(8); PG8_WAIT_L(0); PG8_BAR; PG8_MMA(0, 0, At, B0); PG8_MMA(0, 1, At, B1); PG8_BAR; PG8_SCHED;
            PG8_LDA(At, 0, 1); PG8_STAGE(PG8_SB(0, 0), b2, voffB); PG8_STAGE(PG8_SB(0, 1), b2 + hstep, voffB); PG8_STAGE(PG8_SA(0, 0), a2, vA[0]);
            PG8_WAIT_V(8); PG8_WAIT_L(0); PG8_BAR; PG8_MMA(1, 0, At, B0); PG8_MMA(1, 1, At, B1); PG8_BAR; PG8_SCHED;
            PG8_LDB(B0, 1, 0); PG8_LDB(B1, 1, 1); PG8_SCHED; PG8_LDA(At, 1, 0); PG8_STAGE(PG8_SA(0, 1), a2, vA[1]);
            PG8_WAIT_V(8); PG8_WAIT_L(0); PG8_BAR; PG8_MMA(0, 0, At, B0); PG8_MMA(0, 1, At, B1); PG8_BAR; PG8_SCHED;
            PG8_LDA(At, 1, 1); PG8_STAGE(PG8_SB(1, 0), b3, voffB); PG8_STAGE(PG8_SB(1, 1), b3 + hstep, voffB); PG8_STAGE(PG8_SA(1, 0), a3, vA[0]);
            PG8_WAIT_V(8); PG8_WAIT_L(0); PG8_BAR; PG8_MMA(1, 0, At, B0); PG8_MMA(1, 1, At, B1); PG8_BAR; PG8_SCHED;
        }
        if (wr == 0) PG8_BAR;
        E(acc, cur, wr, wc, fr, fq, (const LAS float*)(lds + LDS_BIASBUF + (ui & 1) * 2048));
        if (!has_next) break;
#pragma unroll
        for (int a = 0; a < 2; ++a)
#pragma unroll
            for (int b = 0; b < 2; ++b)
#pragma unroll
                for (int m = 0; m < 4; ++m)
#pragma unroll
                    for (int n = 0; n < 2; ++n) acc[a][b][m][n] = (f32x4){0.f, 0.f, 0.f, 0.f};
        cur = nxt; cB = nB; ++ui;
        if (wr == 1) PG8_BAR;
    }
    PG8_WAIT_V(0);
    PG8_BAR;
#undef PG8_SA
#undef PG8_SB
#undef PG8_STAGE
#undef PG8_LDA
#undef PG8_LDB
#undef PG8_MMA
#undef PG8_WAIT_V
#undef PG8_WAIT_L
#undef PG8_BAR
#undef PG8_SCHED
#undef PG8_LOADVA
}

typedef f32x4 Acc[2][2][4][2];

struct EpiZ {
    static constexpr bool PERM = true, BIAS = true, EXTRA = false;
    __device__ __forceinline__ const float* extra_ptr(const Unit&, int) const { return nullptr; }
    __device__ __forceinline__ const float* bias_ptr(const Unit& u, int t) const { return bias + u.pn * 256 + 4 * t; }
    bf16_t* Z; const float* bias; float* out; int l; unsigned char* ZG;
    __device__ __forceinline__ void operator()(const Acc& acc, const Unit& u, int wr, int wc, int fr, int fq, const LAS float* lb) const {
        const int row0 = u.pm * 256 + wr * 64 + fr, col0 = u.pn * 256 + wc * 32 + 8 * fq;
        u32x2 wprev[2];
        f32x4 bv[2][2];
#pragma unroll
        for (int bj = 0; bj < 2; ++bj)
#pragma unroll
            for (int n = 0; n < 2; ++n) bv[bj][n] = *(const LAS f32x4*)(lb + bj * 128 + wc * 32 + 8 * fq + 4 * n);
#pragma unroll
        for (int ai = 0; ai < 2; ++ai)
#pragma unroll
            for (int m = 0; m < 4; ++m) {
                const int row = row0 + ai * 128 + m * 16;
                bf16_t* rowp = Z + (size_t)row * INW + col0;
                float* ko = nullptr; float* vo = nullptr;
                if (u.pn == 2) {
                    if (row < NPROMPT) { const int t = row & 4095; if (t >= 3968) { const size_t o = ((size_t)(l * 8 + (row >> 12)) * 128 + (t - 3968)) * 128 + wc * 32 + 8 * fq; ko = out + OKP + o; vo = out + OVP + o; } }
                    else { const int rr = row - NPROMPT; const size_t o = ((size_t)(l * 8 + (rr >> 6)) * 128 + 64 + (rr & 63)) * 128 + wc * 32 + 8 * fq; ko = out + OKS + o; vo = out + OVS + o; }
                }
#pragma unroll
                for (int bj = 0; bj < 2; ++bj) {
                    const f32x4 v0 = acc[ai][bj][m][0] + bv[bj][0], v1 = acc[ai][bj][m][1] + bv[bj][1];
                    if (u.pn >= 9) { u32x2 w8; w8.x = pk4_fp8(v0[0], v0[1], v0[2], v0[3]); w8.y = pk4_fp8(v1[0], v1[1], v1[2], v1[3]);
                        unsigned char* pz = ZG + (size_t)row * 2048 + (col0 - 2304) + bj * 128;
                        if ((m & 1) == 0) wprev[bj] = w8; else store_pair16(pz - (size_t)16 * 2048, pz, fq, wprev[bj], w8); }
                    else { u32x4 w; w.x = cvt_pk_bf16(v0[0], v0[1]); w.y = cvt_pk_bf16(v0[2], v0[3]); w.z = cvt_pk_bf16(v1[0], v1[1]); w.w = cvt_pk_bf16(v1[2], v1[3]);
                        *(u32x4*)(rowp + bj * 128) = w; }
                    float* o = bj == 0 ? ko : vo;
                    if (o) { *(f32x4*)o = v0; *(f32x4*)(o + 4) = v1; }
                }
                asm volatile("" ::: "memory");
            }
    }
};
struct EpiT1 {
    static constexpr bool PERM = true, BIAS = false, EXTRA = false;
    __device__ __forceinline__ const float* extra_ptr(const Unit&, int) const { return nullptr; }
    __device__ __forceinline__ const float* bias_ptr(const Unit&, int) const { return nullptr; }
    unsigned char* T1; const unsigned char* ZG;
    __device__ __forceinline__ void operator()(const Acc& acc, const Unit& u, int wr, int wc, int fr, int fq, const LAS float* lb) const {
        const int row0 = u.pm * 256 + wr * 64 + fr, col0 = u.pn * 256 + wc * 32 + 8 * fq;
        u32x2 g[2][4][2];
#pragma unroll
        for (int ai = 0; ai < 2; ++ai)
#pragma unroll
            for (int m = 0; m < 4; m += 2)
#pragma unroll
                for (int bj = 0; bj < 2; ++bj) { const unsigned char* pa = ZG + (size_t)(row0 + ai * 128 + m * 16) * 2048 + col0 + bj * 128;
                    load_pair16(pa, pa + (size_t)16 * 2048, fq, g[ai][m][bj], g[ai][m + 1][bj]); }
        asm volatile("" ::: "memory");
        u32x2 wprev[2];
#pragma unroll
        for (int ai = 0; ai < 2; ++ai)
#pragma unroll
            for (int m = 0; m < 4; ++m) {
                const int row = row0 + ai * 128 + m * 16;
#pragma unroll
                for (int bj = 0; bj < 2; ++bj) {
                    const u32x2 gw = g[ai][m][bj];
                    const f32x2 s0 = sigmoid2(__builtin_amdgcn_cvt_pk_f32_fp8(gw.x, false)), s1 = sigmoid2(__builtin_amdgcn_cvt_pk_f32_fp8(gw.x, true)),
                                s2 = sigmoid2(__builtin_amdgcn_cvt_pk_f32_fp8(gw.y, false)), s3 = sigmoid2(__builtin_amdgcn_cvt_pk_f32_fp8(gw.y, true));
                    const f32x4 a0 = acc[ai][bj][m][0], a1 = acc[ai][bj][m][1];
                    const f32x2 p0 = ((f32x2){a0[0], a0[1]} * 16.0f) * s0, p1 = ((f32x2){a0[2], a0[3]} * 16.0f) * s1, p2 = ((f32x2){a1[0], a1[1]} * 16.0f) * s2, p3 = ((f32x2){a1[2], a1[3]} * 16.0f) * s3;
                    u32x2 w; w.x = pk4_fp8(p0.x, p0.y, p1.x, p1.y); w.y = pk4_fp8(p2.x, p2.y, p3.x, p3.y);
                    if ((m & 1) == 0) wprev[bj] = w;
                    else store_pair16(T1 + (size_t)(row - 16) * D + col0 + bj * 128, T1 + (size_t)row * D + col0 + bj * 128, fq, wprev[bj], w);
                }
            }
    }
};
struct EpiMix {
    static constexpr bool PERM = true, BIAS = false, EXTRA = false;
    __device__ __forceinline__ const float* extra_ptr(const Unit&, int) const { return nullptr; }
    __device__ __forceinline__ const float* bias_ptr(const Unit&, int) const { return nullptr; }
    const unsigned char* T1; const unsigned char* ZG; unsigned char* MIX;
    __device__ __forceinline__ void operator()(const Acc& acc, const Unit& u, int wr, int wc, int fr, int fq, const LAS float* lb) const {
        const int row0 = u.pm * 256 + wr * 64 + fr, col0 = u.pn * 256 + wc * 32 + 8 * fq;
        u32x2 g[2][4][2], t[2][4][2];
#pragma unroll
        for (int ai = 0; ai < 2; ++ai)
#pragma unroll
            for (int m = 0; m < 4; ++m)
#pragma unroll
                for (int bj = 0; bj < 2; ++bj) { if (m & 1) continue; const int row = row0 + ai * 128 + m * 16;
                    const unsigned char* pg = ZG + (size_t)row * 2048 + 1024 + col0 + bj * 128; const unsigned char* pt = T1 + (size_t)row * D + col0 + bj * 128;
                    load_pair16(pg, pg + (size_t)16 * 2048, fq, g[ai][m][bj], g[ai][m | 1][bj]);
                    load_pair16(pt, pt + (size_t)16 * D, fq, t[ai][m][bj], t[ai][m | 1][bj]); }
        asm volatile("" ::: "memory");
        u32x2 wprev[2];
#pragma unroll
        for (int ai = 0; ai < 2; ++ai)
#pragma unroll
            for (int m = 0; m < 4; ++m) {
                const int row = row0 + ai * 128 + m * 16;
#pragma unroll
                for (int bj = 0; bj < 2; ++bj) {
                    const u32x2 gw = g[ai][m][bj], tw = t[ai][m][bj];
                    const f32x2 s0 = sigmoid2(__builtin_amdgcn_cvt_pk_f32_fp8(gw.x, false)), s1 = sigmoid2(__builtin_amdgcn_cvt_pk_f32_fp8(gw.x, true)),
                                s2 = sigmoid2(__builtin_amdgcn_cvt_pk_f32_fp8(gw.y, false)), s3 = sigmoid2(__builtin_amdgcn_cvt_pk_f32_fp8(gw.y, true));
                    const f32x2 t0 = __builtin_amdgcn_cvt_pk_f32_fp8(tw.x, false), t1 = __builtin_amdgcn_cvt_pk_f32_fp8(tw.x, true), t2 = __builtin_amdgcn_cvt_pk_f32_fp8(tw.y, false), t3 = __builtin_amdgcn_cvt_pk_f32_fp8(tw.y, true);
                    const f32x4 a0 = acc[ai][bj][m][0], a1 = acc[ai][bj][m][1];
                    const f32x2 p0 = t0 * 0.0625f + (f32x2){a0[0], a0[1]} * s0, p1 = t1 * 0.0625f + (f32x2){a0[2], a0[3]} * s1, p2 = t2 * 0.0625f + (f32x2){a1[0], a1[1]} * s2, p3 = t3 * 0.0625f + (f32x2){a1[2], a1[3]} * s3;
                    u32x2 w; w.x = pk4_fp8(p0.x, p0.y, p1.x, p1.y); w.y = pk4_fp8(p2.x, p2.y, p3.x, p3.y);
                    if ((m & 1) == 0) wprev[bj] = w;
                    else store_pair16(MIX + (size_t)(row - 16) * D + col0 + bj * 128, MIX + (size_t)row * D + col0 + bj * 128, fq, wprev[bj], w);
                }
            }
    }
};
struct EpiX {
    static constexpr bool PERM = true, BIAS = false, EXTRA = false;
    __device__ __forceinline__ const float* extra_ptr(const Unit&, int) const { return nullptr; }
    __device__ __forceinline__ const float* bias_ptr(const Unit&, int) const { return nullptr; }
    const bf16_t* X; bf16_t* V; const float* modl;
    __device__ __forceinline__ void operator()(const Acc& acc, const Unit& u, int wr, int wc, int fr, int fq, const LAS float* lb) const {
        const int row0 = u.pm * 256 + wr * 64 + fr, col0 = u.pn * 256 + wc * 32 + 8 * fq;
        const bool uni = u.pm < 128;
        f32x4 g[2][2];
        if (uni) { const float* gp = modl + (size_t)(u.pm >> 4) * 6144 + 2048 + col0;
#pragma unroll
            for (int bj = 0; bj < 2; ++bj)
#pragma unroll
                for (int n = 0; n < 2; ++n) g[bj][n] = *(const f32x4*)(gp + bj * 128 + 4 * n) + 1.0f; }
#pragma unroll
        for (int ai = 0; ai < 2; ++ai) {
            u32x4 x[4][2];
#pragma unroll
            for (int m = 0; m < 4; ++m)
#pragma unroll
                for (int bj = 0; bj < 2; ++bj) x[m][bj] = *(const u32x4*)(X + (size_t)(row0 + ai * 128 + m * 16) * D + col0 + bj * 128);
            asm volatile("" ::: "memory");
#pragma unroll
            for (int m = 0; m < 4; ++m) {
                const int row = row0 + ai * 128 + m * 16;
                if (!uni) { const float* gp = modl + (size_t)batch_of(row) * 6144 + 2048 + col0;
#pragma unroll
                    for (int bj = 0; bj < 2; ++bj)
#pragma unroll
                        for (int n = 0; n < 2; ++n) g[bj][n] = *(const f32x4*)(gp + bj * 128 + 4 * n) + 1.0f; }
#pragma unroll
                for (int bj = 0; bj < 2; ++bj) {
                    const u32x4 xx = x[m][bj];
                    const f32x4 x0 = (f32x4){bf_lo(xx.x), bf_hi(xx.x), bf_lo(xx.y), bf_hi(xx.y)}, x1 = (f32x4){bf_lo(xx.z), bf_hi(xx.z), bf_lo(xx.w), bf_hi(xx.w)};
                    const f32x4 v0 = x0 * ALPHA + g[bj][0] * acc[ai][bj][m][0], v1 = x1 * ALPHA + g[bj][1] * acc[ai][bj][m][1];
                    u32x4 w; w.x = cvt_pk_bf16(v0[0], v0[1]); w.y = cvt_pk_bf16(v0[2], v0[3]); w.z = cvt_pk_bf16(v1[0], v1[1]); w.w = cvt_pk_bf16(v1[2], v1[3]);
                    *(u32x4*)(V + (size_t)row * D + col0 + bj * 128) = w;
                }
            }
            asm volatile("" ::: "memory");
        }
    }
};
struct EpiAct {
    static constexpr bool PERM = true, BIAS = true, EXTRA = false;
    __device__ __forceinline__ const float* extra_ptr(const Unit&, int) const { return nullptr; }
    __device__ __forceinline__ const float* bias_ptr(const Unit& u, int t) const { return bgu + (size_t)u.e * 2048 + u.pn * 128 + (t < 32 ? 4 * t : 1024 + 4 * (t - 32)); }
    unsigned char* ACT; const float* bgu;
    __device__ __forceinline__ void operator()(const Acc& acc, const Unit& u, int wr, int wc, int fr, int fq, const LAS float* lb) const {
        const int row0 = u.pm * 256 + wr * 64 + fr, c0 = u.pn * 128 + wc * 32 + 8 * fq;
        u32x2 wprev;
        f32x4 bg[2], bl[2];
#pragma unroll
        for (int n = 0; n < 2; ++n) { bg[n] = *(const LAS f32x4*)(lb + wc * 32 + 8 * fq + 4 * n); bl[n] = *(const LAS f32x4*)(lb + 128 + wc * 32 + 8 * fq + 4 * n); }
#pragma unroll
        for (int ai = 0; ai < 2; ++ai)
#pragma unroll
            for (int m = 0; m < 4; ++m) {
                const int row = row0 + ai * 128 + m * 16;
                float a[8];
#pragma unroll
                for (int n = 0; n < 2; ++n)
#pragma unroll
                    for (int jp = 0; jp < 2; ++jp) {
                        f32x2 g = (f32x2){acc[ai][0][m][n][2 * jp], acc[ai][0][m][n][2 * jp + 1]} + (f32x2){bg[n][2 * jp], bg[n][2 * jp + 1]};
                        f32x2 li = (f32x2){acc[ai][1][m][n][2 * jp], acc[ai][1][m][n][2 * jp + 1]} + (f32x2){bl[n][2 * jp], bl[n][2 * jp + 1]};
                        g = __builtin_elementwise_min(g, (f32x2){7.0f, 7.0f});
                        li = __builtin_elementwise_min(__builtin_elementwise_max(li, (f32x2){-7.0f, -7.0f}), (f32x2){7.0f, 7.0f});
                        const f32x2 t = g * (-1.702f * 1.44269504089f);
                        f32x2 e; e.x = __builtin_amdgcn_exp2f(t.x); e.y = __builtin_amdgcn_exp2f(t.y);
                        const f32x2 dd = e + 1.0f;
                        f32x2 r; r.x = __builtin_amdgcn_rcpf(dd.x); r.y = __builtin_amdgcn_rcpf(dd.y);
                        const f32x2 av = (g * r) * (li + 1.0f);
                        a[n * 4 + 2 * jp] = av.x; a[n * 4 + 2 * jp + 1] = av.y;
                    }
                u32x2 w; w.x = pk4_fp8(a[0], a[1], a[2], a[3]); w.y = pk4_fp8(a[4], a[5], a[6], a[7]);
                if ((m & 1) == 0) wprev = w;
                else store_pair16(ACT + (size_t)(row - 16) * D + c0, ACT + (size_t)row * D + c0, fq, wprev, w);
                asm volatile("" ::: "memory");
            }
    }
};
struct EpiYs {
    static constexpr bool PERM = true, BIAS = true, EXTRA = true;
    __device__ __forceinline__ const float* extra_ptr(const Unit& u, int t) const { return gate + (size_t)u.e * NT + (u.pm - blk[u.e]) * 256 + 4 * t; }
    __device__ __forceinline__ const float* bias_ptr(const Unit& u, int t) const { return bdn + (size_t)u.e * D + u.pn * 256 + 4 * t; }
    unsigned char* YS; const float* bdn; const float* gate; const LAS int* cnt; const LAS int* blk;
    __device__ __forceinline__ void operator()(const Acc& acc, const Unit& u, int wr, int wc, int fr, int fq, const LAS float* lb) const {
        const int r0 = wr * 64 + fr, col0 = u.pn * 256 + wc * 32 + 8 * fq;
        const int rank0 = (u.pm - blk[u.e]) * 256; const int ce = cnt[u.e];
        f32x4 bv[2][2];
#pragma unroll
        for (int bj = 0; bj < 2; ++bj)
#pragma unroll
            for (int n = 0; n < 2; ++n) bv[bj][n] = *(const LAS f32x4*)(lb + bj * 128 + wc * 32 + 8 * fq + 4 * n);
        float gts[2][4];
#pragma unroll
        for (int ai = 0; ai < 2; ++ai)
#pragma unroll
            for (int m = 0; m < 4; ++m) { const int rank = rank0 + r0 + ai * 128 + m * 16; const float gv = lb[256 + r0 + ai * 128 + m * 16]; gts[ai][m] = rank < ce ? 16.0f * gv : 0.0f; }
        asm volatile("" ::: "memory");
        u32x2 wprev[2];
#pragma unroll
        for (int ai = 0; ai < 2; ++ai)
#pragma unroll
            for (int m = 0; m < 4; ++m) {
                const int r = r0 + ai * 128 + m * 16;
                const float gt = gts[ai][m];
                unsigned char* rowp = YS + (size_t)(u.pm * 256 + r) * D + col0;
#pragma unroll
                for (int bj = 0; bj < 2; ++bj) {
                    const f32x4 v0 = (acc[ai][bj][m][0] + bv[bj][0]) * gt, v1 = (acc[ai][bj][m][1] + bv[bj][1]) * gt;
                    u32x2 w; w.x = pk4_fp8(v0[0], v0[1], v0[2], v0[3]); w.y = pk4_fp8(v1[0], v1[1], v1[2], v1[3]);
                    if ((m & 1) == 0) wprev[bj] = w;
                    else store_pair16(rowp - (size_t)16 * D + bj * 128, rowp + bj * 128, fq, wprev[bj], w);
                }
                asm volatile("" ::: "memory");
            }
    }
};
}


#define XB_TMO      128
#define XB_XCNT(j)  (256  + 64 * (j))
#define XB_XSUB(j)  (1280 + 64 * (j))
#define XB_XGEN(j)  (2304 + 64 * (j))
#define XB_TOP      3328
#define XB_TOPGEN   3392
#define XCD_BAR_WORDS 3456
#define XB_SPIN_CAP (1u << 21)
__device__ __forceinline__ unsigned xb_ld(unsigned* p)              { return __hip_atomic_load(p, __ATOMIC_RELAXED, __HIP_MEMORY_SCOPE_AGENT); }
__device__ __forceinline__ unsigned xb_add(unsigned* p, unsigned v) { return __hip_atomic_fetch_add(p, v, __ATOMIC_RELAXED, __HIP_MEMORY_SCOPE_AGENT); }
__device__ __forceinline__ unsigned xb_xcc_id() { return (unsigned)__builtin_amdgcn_s_getreg((3 << 11) | 20) & 0xFu; }
#define XB_SPIN(cond, bar) do { unsigned _sp = 0; while (cond) { __builtin_amdgcn_s_sleep(1); \
    if ((++_sp & 255u) == 0u) { if (xb_ld(&(bar)[XB_TMO])) break; if (_sp > XB_SPIN_CAP) { atomicAdd(&(bar)[XB_TMO], 1u); break; } } } } while (0)
struct XcdBarrier { unsigned* bar; unsigned x; volatile LAS unsigned* st; };
__device__ __forceinline__ XcdBarrier xcd_barrier_post(unsigned* bar, volatile LAS unsigned* st) {
    XcdBarrier b; b.bar = bar; b.x = xb_xcc_id(); b.st = st;
    if (threadIdx.x == 0) (void)xb_add(&bar[XB_XCNT(b.x)], 1u);
    return b;
}
__device__ __forceinline__ void xcd_barrier_complete(unsigned* bar, unsigned x, unsigned& nloc, unsigned& nx) {
    const unsigned G = gridDim.x * gridDim.y * gridDim.z;
    unsigned sum, cnt, mine, sp = 0u;
    for (;;) {
        sum = 0u; cnt = 0u; mine = 0u;
#pragma unroll
        for (unsigned j = 0; j < 16; ++j) { const unsigned c = xb_ld(&bar[XB_XCNT(j)]); sum += c; cnt += (c > 0u) ? 1u : 0u; mine = (j == x) ? c : mine; }
        if (sum == G) break;
        __builtin_amdgcn_s_sleep(1);
        if ((++sp & 255u) == 0u) { if (xb_ld(&bar[XB_TMO])) break; if (sp > XB_SPIN_CAP) { atomicAdd(&bar[XB_TMO], 1u); break; } }
    }
    nloc = mine > 0u ? mine : 1u; nx = cnt > 0u ? cnt : 1u;
}
__device__ __forceinline__ void xcd_barrier(const XcdBarrier& b) {
    asm volatile("s_waitcnt vmcnt(0)" ::: "memory");
    __syncthreads();
    if (threadIdx.x == 0) {
        unsigned* bar = b.bar;
        __builtin_amdgcn_s_waitcnt(0);
        unsigned nloc = b.st[0], nx = b.st[1];
        if (nloc == 0u) { xcd_barrier_complete(bar, b.x, nloc, nx); b.st[0] = nloc; b.st[1] = nx; }
        const unsigned old = xb_add(&bar[XB_XSUB(b.x)], 1u);
        const unsigned gen = old / nloc;
        if (old + 1u == (gen + 1u) * nloc) {
            __builtin_amdgcn_fence(__ATOMIC_RELEASE, "agent");
            asm volatile("s_waitcnt vmcnt(0)" ::: "memory");
            const unsigned og = xb_add(&bar[XB_TOP], 1u);
            const unsigned tg = og / nx;
            if (og + 1u == (tg + 1u) * nx) xb_add(&bar[XB_TOPGEN], 1u);
            else XB_SPIN(xb_ld(&bar[XB_TOPGEN]) == tg, bar);
            __builtin_amdgcn_fence(__ATOMIC_ACQUIRE, "agent");
            xb_add(&bar[XB_XGEN(b.x)], 1u);
            asm volatile("s_waitcnt vmcnt(0)" ::: "memory");
        } else {
            XB_SPIN(xb_ld(&bar[XB_XGEN(b.x)]) == gen, bar);
            __builtin_amdgcn_fence(__ATOMIC_ACQUIRE, "agent");
            asm volatile("s_waitcnt vmcnt(0)" ::: "memory");
        }
    }
    __syncthreads();
}

struct Ctx {
    LAS unsigned char* lds; int tid, lane, wave, G, bx;
    const float* const* in; float* out; unsigned char* ws;
};
#define LDS_WAIT() asm volatile("s_waitcnt lgkmcnt(0)" ::: "memory")

struct TDesc { const float* src; unsigned char* dst; int N, K, k0, n0, kind, f8; };
__device__ __forceinline__ void t64_load(const TDesc& d, float (&v)[64], int lane) {
    const float* src = d.src + (size_t)d.k0 * d.N + d.n0 + lane;
#pragma unroll
    for (int kk = 0; kk < 64; ++kk) v[kk] = src[(size_t)kk * d.N];
}
__device__ __forceinline__ void t64_finish(const TDesc& d, const float (&v)[64], LAS unsigned char* scr, int lane) {
    if (d.f8) {
        LAS unsigned char* wp = scr + lane * 80;
#pragma unroll
        for (int q = 0; q < 4; ++q) { u32x4 o;
            o.x = pk4_fp8(64.f * v[16 * q + 0], 64.f * v[16 * q + 1], 64.f * v[16 * q + 2], 64.f * v[16 * q + 3]);
            o.y = pk4_fp8(64.f * v[16 * q + 4], 64.f * v[16 * q + 5], 64.f * v[16 * q + 6], 64.f * v[16 * q + 7]);
            o.z = pk4_fp8(64.f * v[16 * q + 8], 64.f * v[16 * q + 9], 64.f * v[16 * q + 10], 64.f * v[16 * q + 11]);
            o.w = pk4_fp8(64.f * v[16 * q + 12], 64.f * v[16 * q + 13], 64.f * v[16 * q + 14], 64.f * v[16 * q + 15]);
            *(LAS u32x4*)(wp + q * 16) = o; }
        LDS_WAIT(); asm volatile("" ::: "memory");
        const int c = lane & 3;
#pragma unroll
        for (int j = 0; j < 4; ++j) { const int nl = (lane >> 2) + 16 * j; const u32x4 o = *(const LAS u32x4*)(scr + nl * 80 + c * 16);
            const int n = d.n0 + nl; int dr = n;
            if (d.kind == 1) { dr = (n < 1024) ? ((n >> 7) * 256 + (n & 127)) : (((n - 1024) >> 7) * 256 + 128 + (n & 127)); }
            *(u32x4*)(d.dst + (size_t)dr * d.K + d.k0 + c * 16) = o; }
    } else {
        LAS unsigned char* wp = scr + lane * 144;
#pragma unroll
        for (int q = 0; q < 8; ++q) { u32x4 o;
            o.x = cvt_pk_bf16(v[8 * q + 0], v[8 * q + 1]); o.y = cvt_pk_bf16(v[8 * q + 2], v[8 * q + 3]); o.z = cvt_pk_bf16(v[8 * q + 4], v[8 * q + 5]); o.w = cvt_pk_bf16(v[8 * q + 6], v[8 * q + 7]);
            *(LAS u32x4*)(wp + q * 16) = o; }
        LDS_WAIT(); asm volatile("" ::: "memory");
        const int c = lane & 7;
#pragma unroll
        for (int j = 0; j < 8; ++j) { const int nl = (lane >> 3) + 8 * j; const u32x4 o = *(const LAS u32x4*)(scr + nl * 144 + c * 16);
            *(u32x4*)(d.dst + ((size_t)(d.n0 + nl) * d.K + d.k0) * 2 + c * 16) = o; }
    }
    LDS_WAIT(); asm volatile("" ::: "memory");
}
__device__ __forceinline__ TDesc t64_decode(const float* const* in, unsigned char* ws, int it) {
    TDesc d; int r = it, item, nblk;
    if (r < 32768) { const int m = r >> 9; item = r & 511; d.src = in[23] + (size_t)m * 1024 * 2048; d.dst = ws + WS_WGU + (size_t)m * 2048 * 1024; d.N = 2048; d.K = 1024; d.kind = 1; d.f8 = 1; }
    else if ((r -= 32768) < 16384) { const int m = r >> 8; item = r & 255; d.src = in[25] + (size_t)m * 1024 * 1024; d.dst = ws + WS_WDN + (size_t)m * 1024 * 1024; d.N = 1024; d.K = 1024; d.kind = 0; d.f8 = 1; }
    else if ((r -= 16384) < 2176) { const int m = r / 1088; item = r % 1088; d.src = in[12] + (size_t)m * 1024 * INW; d.dst = ws + WS_WIN + (size_t)m * INW * 1024 * 2; d.N = INW; d.K = 1024; d.kind = 0; d.f8 = 0; }
    else if ((r -= 2176) < 2176) { const int m = r / 1088; item = r % 1088; d.src = in[12] + (size_t)m * 1024 * INW; d.dst = ws + WS_WIN8 + (size_t)m * INW * 1024; d.N = INW; d.K = 1024; d.kind = 0; d.f8 = 1; }
    else if ((r -= 2176) < 512) { const int m = r >> 8; item = r & 255; d.src = in[18] + (size_t)m * 1024 * 1024; d.dst = ws + WS_WO + (size_t)m * 1024 * 1024; d.N = 1024; d.K = 1024; d.kind = 0; d.f8 = 1; }
    else if ((r -= 512) < 256) { const int m = r >> 7; item = r & 127; d.src = in[16] + (size_t)m * 512 * 1024; d.dst = ws + WS_WOA + (size_t)m * 1024 * 512; d.N = 1024; d.K = 512; d.kind = 0; d.f8 = 1; }
    else { r -= 256; const int m = r >> 7; item = r & 127; d.src = in[17] + (size_t)m * 512 * 1024; d.dst = ws + WS_WOB + (size_t)m * 1024 * 512; d.N = 1024; d.K = 512; d.kind = 0; d.f8 = 1; }
    nblk = d.N >> 6; const int kb = item / nblk; d.k0 = kb * 64; d.n0 = (item - kb * nblk) * 64;
    return d;
}

__device__ __forceinline__ int rel_bucket(int rel) {
    const int n = rel < 0 ? -rel : rel;
    int v;
    if (n < 8) v = n;
    else { const float nf = (float)n; int large = 8 + (int)(logf(nf / 8.0f) / 2.7725887298583984f * 8.0f); v = large < 15 ? large : 15; }
    return (rel > 0 ? 16 : 0) + v;
}

__device__ __forceinline__ void phase0a(Ctx& F) {
    LAS float* scr = (LAS float*)(F.lds + F.wave * 16384);
    const int gw = F.bx * NWAVES + F.wave, NGW = F.G * NWAVES;
    unsigned char* ws = F.ws;
    {
        float* modp = (float*)(ws + WS_MODP);
        for (int it = gw; it < 2 * 96 * 8; it += NGW) {
            const int kc = it & 7, cgp = (it >> 3) % 96, l = it / (8 * 96), k0 = kc * 128, n0 = cgp * 64;
#pragma unroll 4
            for (int j = 0; j < 32; ++j) { const int idx = F.lane + 64 * j, r = idx >> 7, kk = idx & 127;
                const float c = r < 8 ? F.in[2][r * 1024 + k0 + kk] : F.in[3][(r - 8) * 1024 + k0 + kk];
                scr[kk * 16 + r] = c * sigmoidf_(c); }
            LDS_WAIT(); asm volatile("" ::: "memory");
            float a[16];
#pragma unroll
            for (int r = 0; r < 16; ++r) a[r] = 0.f;
            const float* wp = F.in[10] + ((size_t)l * 1024 + k0) * 6144 + n0 + F.lane;
#pragma unroll 16
            for (int kk = 0; kk < 128; ++kk) {
                const float w = wp[(size_t)kk * 6144];
                const LAS f32x4* sp = (const LAS f32x4*)(scr + kk * 16);
                const f32x4 s0 = sp[0], s1 = sp[1], s2 = sp[2], s3 = sp[3];
                a[0] += s0[0] * w; a[1] += s0[1] * w; a[2] += s0[2] * w; a[3] += s0[3] * w;
                a[4] += s1[0] * w; a[5] += s1[1] * w; a[6] += s1[2] * w; a[7] += s1[3] * w;
                a[8] += s2[0] * w; a[9] += s2[1] * w; a[10] += s2[2] * w; a[11] += s2[3] * w;
                a[12] += s3[0] * w; a[13] += s3[1] * w; a[14] += s3[2] * w; a[15] += s3[3] * w;
            }
            const float bb = (kc == 0) ? F.in[11][l * 6144 + n0 + F.lane] : 0.f;
#pragma unroll
            for (int r = 0; r < 16; ++r) modp[(size_t)kc * (2 * 16 * 6144) + ((size_t)(l * 16 + r)) * 6144 + n0 + F.lane] = a[r] + bb;
            LDS_WAIT(); asm volatile("" ::: "memory");
        }
    }
    if (F.bx == 0) {
        float* bt = (float*)(ws + WS_BIAS);
        for (int i = F.tid; i < 8 * 256; i += NTHREADS) { const int h = i >> 8, ri = i & 255; const int rel = ri - 191;
            bt[i] = (ri < 255) ? F.in[7][rel_bucket(rel) * 8 + h] : 0.f; }
    }
    for (int i = F.bx * NTHREADS + F.tid; i < 2 * 8 * 64 * 128; i += F.G * NTHREADS) {
        const int lb = i >> 13, rem = i & 8191;
        F.out[OKS + (size_t)lb * 16384 + rem] = F.in[4][(size_t)lb * 16384 + 8192 + rem];
        F.out[OVS + (size_t)lb * 16384 + rem] = F.in[5][(size_t)lb * 16384 + 8192 + rem];
    }
    LAS unsigned char* scrb = F.lds + F.wave * 16384;
    constexpr int NITEMS = 32768 + 16384 + 2176 + 2176 + 512 + 256 + 256;
    {
        float va[64], vb[64]; TDesc da, db;
        int it = gw;
        if (it < NITEMS) { da = t64_decode(F.in, ws, it); t64_load(da, va, F.lane); }
        while (it < NITEMS) {
            int itn = it + NGW;
            if (itn < NITEMS) { db = t64_decode(F.in, ws, itn); t64_load(db, vb, F.lane); }
            t64_finish(da, va, scrb, F.lane);
            it = itn; if (it >= NITEMS) break;
            itn = it + NGW;
            if (itn < NITEMS) { da = t64_decode(F.in, ws, itn); t64_load(da, va, F.lane); }
            t64_finish(db, vb, scrb, F.lane);
            it = itn;
        }
    }
}

__device__ __forceinline__ void ln_row(f32x4 (&v)[4], const float* g, const float* b, int lane) {
    float s = 0.f;
#pragma unroll
    for (int j = 0; j < 4; ++j) s += (v[j][0] + v[j][1]) + (v[j][2] + v[j][3]);
    const float mean = wave_sum(s) * (1.0f / D); float s2 = 0.f;
#pragma unroll
    for (int j = 0; j < 4; ++j) { v[j] = v[j] - mean; s2 += (v[j][0] * v[j][0] + v[j][1] * v[j][1]) + (v[j][2] * v[j][2] + v[j][3] * v[j][3]); }
    const float rstd = 1.0f / sqrtf(wave_sum(s2) * (1.0f / D) + LN_EPS);
#pragma unroll
    for (int j = 0; j < 4; ++j) { const f32x4 gg = *(const f32x4*)(g + 4 * lane + 256 * j), bb = *(const f32x4*)(b + 4 * lane + 256 * j); v[j] = v[j] * rstd * gg + bb; }
}
__device__ __forceinline__ void store_mod_row(const f32x4 (&v)[4], const float* sh, const float* sc, bf16_t* hrow, unsigned char* h8row, int lane) {
#pragma unroll
    for (int j = 0; j < 4; ++j) { const f32x4 a = *(const f32x4*)(sc + 4 * lane + 256 * j), b = *(const f32x4*)(sh + 4 * lane + 256 * j);
        const f32x4 h = v[j] * (a + 1.0f) + b; u32x2 w; w.x = cvt_pk_bf16(h[0], h[1]); w.y = cvt_pk_bf16(h[2], h[3]);
        *(u32x2*)(hrow + 4 * lane + 256 * j) = w;
        *(unsigned*)(h8row + 4 * lane + 256 * j) = pk4_fp8(h[0], h[1], h[2], h[3]); }
}

__device__ __forceinline__ void phase0b(Ctx& F) {
    const int gw = F.bx * NWAVES + F.wave, NGW = F.G * NWAVES;
    const float* mod = (const float*)(F.ws + WS_MOD);
    bf16_t* H = (bf16_t*)(F.ws + WS_H);
    for (int row = gw; row < NT; row += NGW) {
        const float* xr = row < NPROMPT ? F.in[0] + (size_t)row * D : F.in[1] + (size_t)(row - NPROMPT) * D;
        f32x4 v[4];
#pragma unroll
        for (int j = 0; j < 4; ++j) v[j] = *(const f32x4*)(xr + 4 * F.lane + 256 * j);
        ln_row(v, F.in[8], F.in[9], F.lane);
#pragma unroll
        for (int j = 0; j < 4; ++j) { u32x2 w; w.x = cvt_pk_bf16(v[j][0], v[j][1]); w.y = cvt_pk_bf16(v[j][2], v[j][3]); *(u32x2*)((bf16_t*)(F.ws + WS_XB) + (size_t)row * D + 4 * F.lane + 256 * j) = w; }
        const float* mb = mod + (size_t)batch_of(row) * 6144;
        store_mod_row(v, mb, mb + 1024, H + (size_t)row * D, F.ws + WS_H8 + (size_t)row * D, F.lane);
    }
}

__device__ __forceinline__ void phase_attn(Ctx& F, int l) {
    const bf16_t* Z = (const bf16_t*)(F.ws + WS_Z);
    unsigned char* YA = F.ws + WS_YA;
    unsigned char* YB = F.ws + WS_YB;
    const float* biasr = (const float*)(F.ws + WS_BIAS);
    LAS unsigned char* Ks = F.lds;
    LAS unsigned char* Vt = F.lds + 27648;
    LAS float* bt = (LAS float*)(F.lds + 53248);
    const int lane = F.lane, tid = F.tid;
    int bt_kv = -1;
    for (int au = F.bx; au < 1040; au += F.G) {
        const bool isS = au >= 1024;
        const int kv = au & 1;
        const int b = isS ? ((au - 1024) >> 1) : (au >> 7);
        const int n = isS ? 0 : ((au & 127) >> 1);
        __syncthreads();
        if (kv != bt_kv) { for (int i = tid; i < 1024; i += NTHREADS) bt[i] = biasr[(kv * 4 + (i >> 8)) * 256 + (i & 255)]; bt_kv = kv; }
#pragma unroll
        for (int jj = 0; jj < 3; ++jj) {
            const int p = tid + NTHREADS * jj, key = p >> 3, ds = p & 7;
            u32x4 kq = (u32x4){0u, 0u, 0u, 0u}, vq = (u32x4){0u, 0u, 0u, 0u};
            if (!isS) {
                const int t = n * 64 + key - 128;
                if (t >= 0) { const bf16_t* zr = Z + (size_t)(b * 4096 + t) * INW + kv * 64 + ds * 8; kq = *(const u32x4*)(zr + 512); vq = *(const u32x4*)(zr + 640); }
            } else if (key < 128) {
                const size_t o = ((size_t)((l * 8 + b) * 128 + key) * 2 + kv) * 64 + ds * 8;
                const f32x4 k0 = *(const f32x4*)(F.in[4] + o), k1 = *(const f32x4*)(F.in[4] + o + 4), v0 = *(const f32x4*)(F.in[5] + o), v1 = *(const f32x4*)(F.in[5] + o + 4);
                kq.x = cvt_pk_bf16(k0[0], k0[1]); kq.y = cvt_pk_bf16(k0[2], k0[3]); kq.z = cvt_pk_bf16(k1[0], k1[1]); kq.w = cvt_pk_bf16(k1[2], k1[3]);
                vq.x = cvt_pk_bf16(v0[0], v0[1]); vq.y = cvt_pk_bf16(v0[2], v0[3]); vq.z = cvt_pk_bf16(v1[0], v1[1]); vq.w = cvt_pk_bf16(v1[2], v1[3]);
            } else {
                const bf16_t* zr = Z + (size_t)(NPROMPT + b * 64 + key - 128) * INW + kv * 64 + ds * 8; kq = *(const u32x4*)(zr + 512); vq = *(const u32x4*)(zr + 640);
            }
            *(LAS u32x4*)(Ks + key * 144 + ds * 16) = kq;
            LAS unsigned short* vp = (LAS unsigned short*)Vt + (ds * 8) * 200 + key;
            vp[0 * 200] = (unsigned short)(vq.x & 0xffffu); vp[1 * 200] = (unsigned short)(vq.x >> 16);
            vp[2 * 200] = (unsigned short)(vq.y & 0xffffu); vp[3 * 200] = (unsigned short)(vq.y >> 16);
            vp[4 * 200] = (unsigned short)(vq.z & 0xffffu); vp[5 * 200] = (unsigned short)(vq.z >> 16);
            vp[6 * 200] = (unsigned short)(vq.w & 0xffffu); vp[7 * 200] = (unsigned short)(vq.w >> 16);
        }
        __syncthreads();
        const int g = F.wave >> 1, qi = (F.wave & 1) * 32 + (lane & 31), hh = lane >> 5, head = kv * 4 + g;
        const int qrow = isS ? NPROMPT + b * 64 + qi : b * 4096 + n * 64 + qi;
        bf16x8 Qf[4];
#pragma unroll
        for (int ks = 0; ks < 4; ++ks) Qf[ks] = *(const bf16x8*)(Z + (size_t)qrow * INW + head * 64 + ks * 16 + hh * 8);
        f32x16 S[6];
#pragma unroll
        for (int kb = 0; kb < 6; ++kb) {
#pragma unroll
            for (int j = 0; j < 16; ++j) S[kb][j] = 0.f;
#pragma unroll
            for (int ks = 0; ks < 4; ++ks) {
                const bf16x8 A = *(const LAS bf16x8*)(Ks + (kb * 32 + (lane & 31)) * 144 + (ks * 16 + hh * 8) * 2);
                S[kb] = __builtin_amdgcn_mfma_f32_32x32x16_bf16(A, Qf[ks], S[kb], 0, 0, 0);
            }
        }
        const float sinkv = F.in[14][l * 8 + head];
        float mx = sinkv;
        const int kmin = isS ? 0 : (128 - n * 64);
#pragma unroll
        for (int kb = 0; kb < 6; ++kb)
#pragma unroll
            for (int j = 0; j < 16; ++j) {
                const int key = kb * 32 + 8 * (j >> 2) + 4 * hh + (j & 3);
                float sv = S[kb][j] * 0.125f + bt[g * 256 + key - qi + 63];
                sv = key >= kmin ? sv : -1e30f;
                S[kb][j] = sv; mx = fmaxf(mx, sv);
            }
        mx = fmaxf(mx, __shfl_xor(mx, 32));
        float sum = 0.f;
#pragma unroll
        for (int kb = 0; kb < 6; ++kb)
#pragma unroll
            for (int j = 0; j < 16; ++j) { const float p = __expf(S[kb][j] - mx); S[kb][j] = p; sum += p; }
        sum += __shfl_xor(sum, 32);
        sum += __expf(sinkv - mx);
        const float inv = 1.0f / sum;
        f32x16 O[2];
#pragma unroll
        for (int db = 0; db < 2; ++db)
#pragma unroll
            for (int j = 0; j < 16; ++j) O[db][j] = 0.f;
#pragma unroll
        for (int kb = 0; kb < 6; ++kb)
#pragma unroll
            for (int s2 = 0; s2 < 2; ++s2) {
                union { bf16x8 v; unsigned u[4]; } P;
#pragma unroll
                for (int q = 0; q < 4; ++q) P.u[q] = cvt_pk_bf16(S[kb][8 * s2 + 2 * q], S[kb][8 * s2 + 2 * q + 1]);
#pragma unroll
                for (int db = 0; db < 2; ++db) {
                    const LAS unsigned char* vb = Vt + (db * 32 + (lane & 31)) * 400 + (kb * 32 + 16 * s2 + 4 * hh) * 2;
                    union { bf16x8 v; u32x2 h[2]; } Vf;
                    Vf.h[0] = *(const LAS u32x2*)vb; Vf.h[1] = *(const LAS u32x2*)(vb + 16);
                    O[db] = __builtin_amdgcn_mfma_f32_32x32x16_bf16(Vf.v, P.v, O[db], 0, 0, 0);
                }
            }
        unsigned char* orow = YA + (size_t)qrow * 512 + head * 64 + 8 * hh; const float inv8 = inv * 8.0f;
#pragma unroll
        for (int db = 0; db < 2; ++db)
#pragma unroll
            for (int jq = 0; jq < 4; jq += 2) {
                const unsigned wa = pk4_fp8(O[db][4 * jq] * inv8, O[db][4 * jq + 1] * inv8, O[db][4 * jq + 2] * inv8, O[db][4 * jq + 3] * inv8);
                const unsigned wb = pk4_fp8(O[db][4 * jq + 4] * inv8, O[db][4 * jq + 5] * inv8, O[db][4 * jq + 6] * inv8, O[db][4 * jq + 7] * inv8);
                const auto r = __builtin_amdgcn_permlane32_swap(wa, wb, false, false);
                u32x2 w; w.x = r[0]; w.y = r[1];
                *(u32x2*)(orow + db * 32 + 8 * jq) = w;
            }
    }
    int nxtra = 1040 % F.G; if (1040 < F.G || 2 * nxtra > F.G) nxtra = 0;
    if (F.bx < nxtra) return;
    const int gw = (F.bx - nxtra) * NWAVES + F.wave, NGW = (F.G - nxtra) * NWAVES;
    const float* cw = F.in[15] + (size_t)l * 3 * 512 + 8 * lane;
    float w0[8], w1[8], w2[8];
#pragma unroll
    for (int e = 0; e < 8; ++e) { w0[e] = cw[e]; w1[e] = cw[512 + e]; w2[e] = cw[1024 + e]; }
    for (int row = gw; row < NT; row += NGW) {
        const bool isS = row >= NPROMPT; const int b = isS ? ((row - NPROMPT) >> 6) : (row >> 12), t = isS ? ((row - NPROMPT) & 63) : (row & 4095);
        const bf16_t* zr = Z + (size_t)row * INW + 8 * lane;
        const u32x4 cb = *(const u32x4*)(zr + 768);
        float u[3][8];
#pragma unroll
        for (int d = 0; d < 3; ++d) {
            if (t - d >= 0) {
                const bf16_t* zz = zr - (size_t)d * INW; const u32x4 cc = *(const u32x4*)(zz + 1280), cx = *(const u32x4*)(zz + 1792);
                u[d][0] = bf_lo(cc.x) * bf_lo(cx.x); u[d][1] = bf_hi(cc.x) * bf_hi(cx.x); u[d][2] = bf_lo(cc.y) * bf_lo(cx.y); u[d][3] = bf_hi(cc.y) * bf_hi(cx.y);
                u[d][4] = bf_lo(cc.z) * bf_lo(cx.z); u[d][5] = bf_hi(cc.z) * bf_hi(cx.z); u[d][6] = bf_lo(cc.w) * bf_lo(cx.w); u[d][7] = bf_hi(cc.w) * bf_hi(cx.w);
            } else if (isS) {
                const float* hp = F.in[6] + ((size_t)(l * 8 + b) * 2 + (2 + t - d)) * 512 + 8 * lane;
                const f32x4 h0 = *(const f32x4*)hp, h1 = *(const f32x4*)(hp + 4);
#pragma unroll
                for (int e = 0; e < 4; ++e) { u[d][e] = h0[e]; u[d][4 + e] = h1[e]; }
            } else {
#pragma unroll
                for (int e = 0; e < 8; ++e) u[d][e] = 0.f;
            }
        }
        const float cbf[8] = {bf_lo(cb.x), bf_hi(cb.x), bf_lo(cb.y), bf_hi(cb.y), bf_lo(cb.z), bf_hi(cb.z), bf_lo(cb.w), bf_hi(cb.w)};
        float y[8];
#pragma unroll
        for (int e = 0; e < 8; ++e) y[e] = cbf[e] * (w0[e] * u[2][e] + w1[e] * u[1][e] + w2[e] * u[0][e]);
        u32x2 w; w.x = pk4_fp8(y[0], y[1], y[2], y[3]); w.y = pk4_fp8(y[4], y[5], y[6], y[7]);
        *(u32x2*)(YB + (size_t)row * 512 + 8 * lane) = w;
        const int tl = isS ? 62 : 4094;
        if (t >= tl) {
            float* o = F.out + (isS ? OCS : OCP) + ((size_t)(l * 8 + b) * 2 + (t - tl)) * 512 + 8 * lane;
            *(f32x4*)o = (f32x4){u[0][0], u[0][1], u[0][2], u[0][3]}; *(f32x4*)(o + 4) = (f32x4){u[0][4], u[0][5], u[0][6], u[0][7]};
        }
    }
}

__device__ __forceinline__ void phase_ln_router(Ctx& F, int l) {
    bf16_t* XB = (bf16_t*)(F.ws + WS_XB); unsigned char* H8 = (unsigned char*)(F.ws + WS_H8); const bf16_t* V16 = (const bf16_t*)(F.ws + WS_V16);
    const float* mod = (const float*)(F.ws + WS_MOD) + (size_t)l * 16 * 6144;
    unsigned* cnt = (unsigned*)(F.ws + WS_CNT) + l * 2048;
    unsigned* tok = (unsigned*)(F.ws + WS_TOK); float* gate = (float*)(F.ws + WS_GATE); unsigned* slot = (unsigned*)(F.ws + WS_SLOT);
    const float* Wr = F.in[21] + (size_t)l * 1024 * 32;
    LAS float* hf = (LAS float*)F.lds;
    LAS unsigned char* Hh = F.lds;
    LAS unsigned char* Hl = F.lds + 66048;
    LAS unsigned* hist = (LAS unsigned*)(F.lds + 146432); LAS unsigned* hbase = hist + 32;
    LAS u32x4* rec = (LAS u32x4*)(F.lds + 132096);
    int nrec_tiles = 0;
    __syncthreads();
    if (F.tid < 32) hist[F.tid] = 0u;
    const int lane = F.lane, w = F.wave;
    bf16x8 bh[8], bl[8];
    {
#pragma unroll
        for (int ks = 0; ks < 8; ++ks) {
            const float* bp = Wr + (size_t)(128 * w + 16 * ks + 8 * (lane >> 5)) * 32 + (lane & 31);
            float wv[8];
#pragma unroll
            for (int j = 0; j < 8; ++j) wv[j] = bp[32 * j];
            union { bf16x8 v; unsigned u[4]; } ph, pl;
#pragma unroll
            for (int q = 0; q < 4; ++q) { const unsigned hw = cvt_pk_bf16(wv[2 * q], wv[2 * q + 1]); ph.u[q] = hw; pl.u[q] = cvt_pk_bf16(wv[2 * q] - bf_lo(hw), wv[2 * q + 1] - bf_hi(hw)); }
            bh[ks] = ph.v; bl[ks] = pl.v;
        }
    }
    for (int tidx = F.bx; tidx < 1024 + 256; tidx += F.G) {
        const int tile0 = tidx < 1024 ? tidx * 32 : NPROMPT + (tidx - 1024) * 2, nrows = tidx < 1024 ? 32 : 2;
        __syncthreads();
        if (w * 4 < nrows) {
            u32x2 pv[4][4];
#pragma unroll
            for (int rr = 0; rr < 4; ++rr) { const int rl = w * 4 + rr, row = rl < nrows ? tile0 + rl : tile0;
#pragma unroll
                for (int j = 0; j < 4; ++j) pv[rr][j] = *(const u32x2*)(V16 + (size_t)row * D + 4 * lane + 256 * j); }
#pragma unroll
            for (int rr = 0; rr < 4; ++rr) {
                const int rl = w * 4 + rr, row = tile0 + rl;
                if (rl < nrows) {
                    f32x4 v[4];
#pragma unroll
                    for (int j = 0; j < 4; ++j) v[j] = (f32x4){bf_lo(pv[rr][j].x), bf_hi(pv[rr][j].x), bf_lo(pv[rr][j].y), bf_hi(pv[rr][j].y)};
                    ln_row(v, F.in[19] + l * D, F.in[20] + l * D, lane);
#pragma unroll
                    for (int j = 0; j < 4; ++j) { u32x2 wq; wq.x = cvt_pk_bf16(v[j][0], v[j][1]); wq.y = cvt_pk_bf16(v[j][2], v[j][3]); *(u32x2*)(XB + (size_t)row * D + 4 * lane + 256 * j) = wq; }
                    const float* mb = mod + (size_t)batch_of(row) * 6144;
#pragma unroll
                    for (int j = 0; j < 4; ++j) { const f32x4 a = *(const f32x4*)(mb + 4096 + 4 * lane + 256 * j), b = *(const f32x4*)(mb + 3072 + 4 * lane + 256 * j);
                        const f32x4 h = v[j] * (a + 1.0f) + b;
                        *(unsigned*)(H8 + (size_t)row * D + 4 * lane + 256 * j) = pk4_fp8(h[0], h[1], h[2], h[3]);
                        u32x2 hw; hw.x = cvt_pk_bf16(h[0], h[1]); hw.y = cvt_pk_bf16(h[2], h[3]);
                        u32x2 lw; lw.x = cvt_pk_bf16(h[0] - bf_lo(hw.x), h[1] - bf_hi(hw.x)); lw.y = cvt_pk_bf16(h[2] - bf_lo(hw.y), h[3] - bf_hi(hw.y));
                        *(LAS u32x2*)(Hh + rl * 2064 + (4 * lane + 256 * j) * 2) = hw; *(LAS u32x2*)(Hl + rl * 2064 + (4 * lane + 256 * j) * 2) = lw; }
                }
            }
        }
        __syncthreads();
        f32x16 acc;
#pragma unroll
        for (int j = 0; j < 16; ++j) acc[j] = 0.f;
        {
            const int aoffb = (lane & 31) * 2064 + (128 * w + 8 * (lane >> 5)) * 2;
#pragma unroll
            for (int ks = 0; ks < 8; ++ks) {
                const bf16x8 ah = *(const LAS bf16x8*)(Hh + aoffb + ks * 32), al = *(const LAS bf16x8*)(Hl + aoffb + ks * 32);
                acc = __builtin_amdgcn_mfma_f32_32x32x16_bf16(ah, bh[ks], acc, 0, 0, 0);
                acc = __builtin_amdgcn_mfma_f32_32x32x16_bf16(ah, bl[ks], acc, 0, 0, 0);
                acc = __builtin_amdgcn_mfma_f32_32x32x16_bf16(al, bh[ks], acc, 0, 0, 0);
            }
        }
        __syncthreads();
        LAS float* red = hf;
#pragma unroll
        for (int j = 0; j < 16; ++j) red[(w * 32 + 8 * (j >> 2) + 4 * (lane >> 5) + (j & 3)) * 33 + (lane & 31)] = acc[j];
        __syncthreads();
        int e_sel[4]; float g_sel[4]; unsigned loc[4];
#pragma unroll
        for (int rr = 0; rr < 4; ++rr) {
            const int tk = w * 4 + rr;
            float val = -INFINITY;
            if (lane < 32) { float sacc = F.in[22][l * 32 + lane];
#pragma unroll
                for (int ww = 0; ww < 8; ++ww) sacc += red[(ww * 32 + tk) * 33 + lane];
                val = sacc; }
            float tv[4]; int te[4];
            {
                const int vbits = __float_as_int(val); int rank = 0;
#pragma unroll
                for (int j = 0; j < 32; ++j) { const float vj = __int_as_float(__builtin_amdgcn_readlane(vbits, j)); rank += (vj > val || (vj == val && j < lane)) ? 1 : 0; }
#pragma unroll
                for (int it = 0; it < 4; ++it) { const unsigned long long mk = __ballot(rank == it); const int ln = mk ? (__ffsll((long long)mk) - 1) : 0;
                    te[it] = ln; tv[it] = __int_as_float(__builtin_amdgcn_readlane(vbits, ln)); }
            }
            const float e1 = __expf(tv[1] - tv[0]), e2 = __expf(tv[2] - tv[0]), e3 = __expf(tv[3] - tv[0]);
            const float rs = 1.0f / (1.0f + e1 + e2 + e3);
            e_sel[rr] = lane == 0 ? te[0] : lane == 1 ? te[1] : lane == 2 ? te[2] : te[3];
            g_sel[rr] = (lane == 0 ? 1.0f : lane == 1 ? e1 : lane == 2 ? e2 : e3) * rs;
            loc[rr] = 0u;
            if (lane < 4 && tk < nrows) loc[rr] = atomicAdd((unsigned*)&hist[e_sel[rr]], 1u);
        }
        if (lane < 4) {
#pragma unroll
            for (int rr = 0; rr < 4; ++rr) {
                const int rl = w * 4 + rr;
                u32x4 rc; rc.x = (rl < nrows) ? (unsigned)(tile0 + rl) : 0xffffffffu; rc.y = (unsigned)(e_sel[rr] & 31); rc.z = loc[rr]; rc.w = __float_as_uint(g_sel[rr]);
                rec[(nrec_tiles * 32 + rl) * 4 + lane] = rc;
            }
        }
        ++nrec_tiles;
    }
    __syncthreads();
    if (F.tid < 32) { const unsigned hcount = hist[F.tid]; hbase[F.tid] = hcount ? atomicAdd(cnt + F.tid * 64, hcount) : 0u; }
    __syncthreads();
    for (int i = F.tid; i < nrec_tiles * 128; i += NTHREADS) {
        const u32x4 rc = rec[i];
        if (rc.x != 0xffffffffu) { const unsigned e = rc.y, rank = hbase[e] + rc.z;
            tok[(size_t)e * NT + rank] = rc.x; gate[(size_t)e * NT + rank] = __uint_as_float(rc.w); slot[(size_t)rc.x * 4 + (i & 3)] = (e << 24) | rank; }
    }
}

__device__ __forceinline__ void build_blk(Ctx& F, int l) {
    LAS int* blk = (LAS int*)(F.lds + LDS_BLK);
    const unsigned* cnt = (const unsigned*)(F.ws + WS_CNT) + l * 2048;
    __syncthreads();
    if (F.tid == 0) { LAS int* cl = (LAS int*)(F.lds + LDS_CNT); int s = 0; for (int e = 0; e < 32; ++e) { const int ce = (int)cnt[e * 64]; cl[e] = ce; blk[e] = s; s += (ce + 255) >> 8; } blk[32] = s; }
    __syncthreads();
}

__device__ __forceinline__ void phase_combine(Ctx& F, int l) {
    const LAS int* blk = (const LAS int*)(F.lds + LDS_BLK);
    float* X = F.out; bf16_t* XB = (bf16_t*)(F.ws + WS_XB); bf16_t* H = (bf16_t*)(F.ws + WS_H); const unsigned char* YS = F.ws + WS_YS;
    const unsigned* slot = (const unsigned*)(F.ws + WS_SLOT);
    const float* mod = (const float*)(F.ws + WS_MOD);
    const int gw = F.bx * NWAVES + F.wave, NGW = F.G * NWAVES, lane = F.lane;
    for (int row = gw; row < NT; row += NGW) {
        f32x4 ff[4];
#pragma unroll
        for (int j = 0; j < 4; ++j) ff[j] = (f32x4){0.f, 0.f, 0.f, 0.f};
#pragma unroll
        for (int k = 0; k < 4; ++k) {
            const unsigned s = slot[(size_t)row * 4 + k]; const int e = (int)(s >> 24), rank = (int)(s & 0xffffffu);
            const unsigned char* yr = YS + ((size_t)blk[e] * 256 + rank) * D + 4 * lane;
#pragma unroll
            for (int j = 0; j < 4; ++j) { const unsigned wv = *(const unsigned*)(yr + 256 * j); const f32x2 lo = __builtin_amdgcn_cvt_pk_f32_fp8(wv, false), hi = __builtin_amdgcn_cvt_pk_f32_fp8(wv, true);
                ff[j][0] += lo.x; ff[j][1] += lo.y; ff[j][2] += hi.x; ff[j][3] += hi.y; }
        }
        const int bi = batch_of(row);
        const float* mb = mod + (size_t)(l * 16 + bi) * 6144;
        f32x4 v[4];
#pragma unroll
        for (int j = 0; j < 4; ++j) { const u32x2 xw = *(const u32x2*)(XB + (size_t)row * D + 4 * lane + 256 * j); const f32x4 x = (f32x4){bf_lo(xw.x), bf_hi(xw.x), bf_lo(xw.y), bf_hi(xw.y)}, g2 = *(const f32x4*)(mb + 5120 + 4 * lane + 256 * j);
            v[j] = x * ALPHA + (g2 + 1.0f) * (ff[j] * 0.0625f); }
        ln_row(v, F.in[27] + l * D, F.in[28] + l * D, lane);
#pragma unroll
        for (int j = 0; j < 4; ++j) { if (l == 0) { u32x2 w; w.x = cvt_pk_bf16(v[j][0], v[j][1]); w.y = cvt_pk_bf16(v[j][2], v[j][3]); *(u32x2*)(XB + (size_t)row * D + 4 * lane + 256 * j) = w; }
            else *(f32x4*)(X + (size_t)row * D + 4 * lane + 256 * j) = v[j]; }
        if (l == 0) { const float* mn = mod + (size_t)(16 + bi) * 6144; store_mod_row(v, mn, mn + 1024, H + (size_t)row * D, F.ws + WS_H8 + (size_t)row * D, lane); }
    }
}

#ifndef PH_MASK
#define PH_MASK 0xFFFF
#endif
#define PH(b) ((PH_MASK >> (b)) & 1)
#ifndef PROBE_MASK
#define PROBE_MASK 0
#endif
#define PB0(id) do { if ((PROBE_MASK >> (id)) & 1) pb_t0 = __builtin_amdgcn_s_memrealtime(); } while (0)
#define PB1(id) do { if ((PROBE_MASK >> (id)) & 1) pb_acc += __builtin_amdgcn_s_memrealtime() - pb_t0; } while (0)
#define RELOAD() do { int t_ = threadIdx.x; asm volatile("" : "+v"(t_)); F.tid = t_; F.lane = t_ & 63; F.wave = __builtin_amdgcn_readfirstlane(t_ >> 6); \
    unsigned z_; asm volatile("s_mov_b32 %0, 0" : "=s"(z_)); F.in = p.in; F.out = p.out + z_; F.ws = p.ws + z_; } while (0)
#define LAYER_BODY(l) do { \
          \
        PB0(2); RELOAD(); \
        if (PH(2)) { \
              \
            pg8::SchedDense S; S.init(NT, 7 * 256, D, F.G, F.bx, (const bf16_t*)(F.ws + WS_WIN) + (size_t)l * INW * D, 2); \
            pg8::EpiZ E{(bf16_t*)(F.ws + WS_Z), F.in[13] + l * INW, F.out, l, F.ws + WS_ZG8}; \
            pg8::gemm_phase<false, 0u>(F.lds, (const char*)(F.ws + WS_H), D, S, E); \
        } \
        RELOAD(); \
        if (PH(2)) { \
              \
            pg8::SchedDense S; S.init(NT, 10 * 256, 512, F.G, (F.G == 256) ? ((F.bx + 112) & 255) : F.bx, F.ws + WS_WIN8 + (size_t)l * INW * D, 0, 2, 7); \
            pg8::EpiZ E{(bf16_t*)(F.ws + WS_Z), F.in[13] + l * INW, F.out, l, F.ws + WS_ZG8}; \
            pg8::gemm_phase<true, 0x7f7f7f7fu>(F.lds, (const char*)(F.ws + WS_H8), 512, S, E); \
        } \
        xcd_barrier(xbar); PB1(2); PB0(3); \
        RELOAD(); \
        if (PH(3)) phase_attn(F, l); \
        xcd_barrier(xbar); PB1(3); PB0(4); \
          \
        RELOAD(); \
        if (PH(4)) { \
            pg8::SchedDense S; S.init(NT, D, 256, F.G, F.bx, F.ws + WS_WOA + (size_t)l * D * 512); \
            pg8::EpiT1 E{F.ws + WS_T1, F.ws + WS_ZG8}; \
            pg8::gemm_phase<true, 0x7c7c7c7cu>(F.lds, (const char*)(F.ws + WS_YA), 256, S, E); \
        } \
        RELOAD(); \
        if (PH(5)) { \
            pg8::SchedDense S; S.init(NT, D, 256, F.G, F.bx, F.ws + WS_WOB + (size_t)l * D * 512); \
            pg8::EpiMix E{F.ws + WS_T1, F.ws + WS_ZG8, F.ws + WS_MIX}; \
            pg8::gemm_phase<true, 0x7f7f7f7fu>(F.lds, (const char*)(F.ws + WS_YB), 256, S, E); \
        } \
        xcd_barrier(xbar); PB1(4); PB0(5); \
          \
        RELOAD(); \
        if (PH(6)) { \
            pg8::SchedDense S; S.init(NT, D, 512, F.G, F.bx, F.ws + WS_WO + (size_t)l * D * D); \
            pg8::EpiX E{(const bf16_t*)(F.ws + WS_XB), (bf16_t*)(F.ws + WS_V16), (const float*)(F.ws + WS_MOD) + (size_t)l * 16 * 6144}; \
            pg8::gemm_phase<true, 0x7f7f7f7fu>(F.lds, (const char*)(F.ws + WS_MIX), 512, S, E); \
        } \
        xcd_barrier(xbar); PB1(5); PB0(6); \
        RELOAD(); \
        if (PH(7)) phase_ln_router(F, l); \
        xcd_barrier(xbar); PB1(6); PB0(7); \
          \
        RELOAD(); \
        build_blk(F, l); \
        if (PH(8)) { \
            LAS int* blk = (LAS int*)(F.lds + LDS_BLK); \
            LAS unsigned short* idx = (LAS unsigned short*)(F.lds + LDS_IDX); \
            pg8::SchedMoE<true> S; S.init(blk, idx, 8, 512, F.G, F.bx, (const unsigned char*)(F.ws + WS_WGU) + (size_t)l * 32 * 2048 * D, (size_t)2048 * D); \
            const unsigned* cnt = (const unsigned*)(F.ws + WS_CNT) + l * 2048; const unsigned* tok = (const unsigned*)(F.ws + WS_TOK); \
            for (int i = 0; i < MAXU; ++i) { pg8::Unit u; if (!S.next(i, u)) break; \
                if (F.tid < 256) { int rank = (u.pm - blk[u.e]) * 256 + F.tid; const int ce = ((const LAS int*)(F.lds + LDS_CNT))[u.e]; rank = rank < ce ? rank : ce - 1; \
                    idx[i * 256 + F.tid] = (unsigned short)tok[(size_t)u.e * NT + rank]; } } \
            __syncthreads(); \
            pg8::EpiAct E{(unsigned char*)(F.ws + WS_ACT), F.in[24] + (size_t)l * 32 * 2048}; \
            pg8::gemm_phase<true, 0x7f7f7f7fu>(F.lds, (const char*)(F.ws + WS_H8), 512, S, E); \
        } \
        xcd_barrier(xbar); PB1(7); PB0(8); \
          \
        RELOAD(); \
        if (PH(9)) { \
            LAS int* blk = (LAS int*)(F.lds + LDS_BLK); \
            LAS unsigned short* idx = (LAS unsigned short*)(F.lds + LDS_IDX); \
            pg8::SchedMoE<false> S; S.init(blk, idx, 4, 512, F.G, F.bx, (const unsigned char*)(F.ws + WS_WDN) + (size_t)l * 32 * D * D, (size_t)D * D); \
            pg8::EpiYs E{F.ws + WS_YS, F.in[26] + (size_t)l * 32 * D, (const float*)(F.ws + WS_GATE), (const LAS int*)(F.lds + LDS_CNT), blk}; \
            pg8::gemm_phase<true, 0x7f7f7f7fu>(F.lds, (const char*)(F.ws + WS_ACT), 512, S, E); \
        } \
        xcd_barrier(xbar); PB1(8); PB0(9); \
        RELOAD(); \
        if (PH(10)) phase_combine(F, l); \
        if (l == 0) xcd_barrier(xbar); \
        PB1(9); \
 \
    } while (0)
__global__ void __launch_bounds__(NTHREADS, 2) fwd_megakernel(Params p) {
    extern __shared__ __attribute__((aligned(16))) unsigned char lds_raw[];
    cg::grid_group grid = cg::this_grid();
    Ctx F;
    F.lds = (LAS unsigned char*)lds_raw;
    F.G = gridDim.x; F.bx = blockIdx.x;
    volatile LAS unsigned* bst = (volatile LAS unsigned*)(F.lds + 147392);
    if (threadIdx.x < 2) bst[threadIdx.x] = 0u;
    __syncthreads();
    const XcdBarrier xbar = xcd_barrier_post((unsigned*)(p.ws + WS_BAR), bst);
    unsigned long long pb_t0 = 0, pb_acc = 0;
    PB0(0); RELOAD();
    if (PH(0)) phase0a(F);
    grid.sync();
    PB1(0); PB0(1); RELOAD();
    { const float* modp = (const float*)(F.ws + WS_MODP); float* mod = (float*)(F.ws + WS_MOD);
      for (int i = F.bx * NTHREADS + F.tid; i < 2 * 16 * 6144; i += F.G * NTHREADS) { float sm = 0.f;
#pragma unroll
          for (int kc = 0; kc < 8; ++kc) sm += modp[(size_t)kc * (2 * 16 * 6144) + i];
          mod[i] = sm; } }
    xcd_barrier(xbar);
    RELOAD();
    if (PH(1)) phase0b(F);
    xcd_barrier(xbar); PB1(1);

    LAYER_BODY(0);
    LAYER_BODY(1);
    if (PROBE_MASK != 0 && blockIdx.x == 0) { const unsigned long long te = __builtin_amdgcn_s_memrealtime(); while (__builtin_amdgcn_s_memrealtime() - te < pb_acc) __builtin_amdgcn_s_sleep(8); }
    (void)pb_t0; (void)pb_acc;
}

extern "C" void kernel_launch(void* const* d_in, const int* in_sizes, int n_in, void* d_out, int out_size, void* d_ws, size_t ws_size, hipStream_t stream) {
    static int grid = 0;
    if (grid == 0) {
        if (n_in != 29 || ws_size < WS_END) { fprintf(stderr, "kernel_launch: unexpected n_in %d / ws_size %zu (need %zu)\n", n_in, ws_size, (size_t)WS_END); grid = -1; return; }
        int dev = 0, cus = 0, per_cu = 0;
        hipGetDevice(&dev);
        hipDeviceGetAttribute(&cus, hipDeviceAttributeMultiprocessorCount, dev);
        if (hipFuncSetAttribute((const void*)fwd_megakernel, hipFuncAttributeMaxDynamicSharedMemorySize, LDS_BYTES) != hipSuccess) { fprintf(stderr, "kernel_launch: hipFuncSetAttribute failed\n"); grid = -1; return; }
        if (hipOccupancyMaxActiveBlocksPerMultiprocessor(&per_cu, (const void*)fwd_megakernel, NTHREADS, LDS_BYTES) != hipSuccess || per_cu < 1) { fprintf(stderr, "kernel_launch: occupancy query says %d blocks per CU\n", per_cu); per_cu = 1; }
        (void)hipGetLastError();
        grid = cus;
        if (grid != 256) fprintf(stderr, "kernel_launch: note: %d CUs (built for 256)\n", grid);
    }
    if (grid < 0) return;
    hipMemsetAsync((char*)d_ws, 0, WS_ZERO_BYTES, stream);
    Params p{};
    for (int i = 0; i < 29; ++i) p.in[i] = (const float*)d_in[i];
    p.out = (float*)d_out; p.ws = (unsigned char*)d_ws;
    void* args[] = {&p};
    hipError_t e = hipLaunchCooperativeKernel((const void*)fwd_megakernel, dim3(grid), dim3(NTHREADS), args, LDS_BYTES, stream);
    if (e != hipSuccess) fprintf(stderr, "kernel_launch: cooperative launch failed: %s (grid %d)\n", hipGetErrorString(e), grid);
}
```
